# Optimizing an MI355X kernel written in HIP

```python
import jax
import jax.numpy as jnp
from jax import lax
import numpy as np

D_MODEL = 1024
BATCH = 16
SEQ = 256
DEPTH = 1
DEC_BATCH = 4
DEC_SEQ = 2048
PAST_LEN = 512

GRID_W = 64
CHUNK = 64
RET_HEADS = 4
RET_DK = 128
RET_DV = 256
DN_HEADS = 4
DN_DK = 128
DN_DV = 256
CONV_WIDTH = 3
ROPE_BASE = 10000.0
EPS = 1e-6
D_FF = (((8 * D_MODEL + 2) // 3) + 255) // 256 * 256
RET_QK = RET_HEADS * RET_DK
RET_VW = RET_HEADS * RET_DV
DN_QK = DN_HEADS * DN_DK
DN_VW = DN_HEADS * DN_DV
DN_CONV_CH = 2 * DN_QK + DN_VW
IN_WIDTHS = (RET_QK, RET_QK, RET_VW, RET_VW, DN_QK, DN_QK, DN_VW, DN_VW, 2 * DN_HEADS, 2 * DN_HEADS, D_MODEL, D_MODEL)
IN_COLS = 2 * RET_QK + 2 * RET_VW + 2 * DN_QK + 2 * DN_VW + 4 * DN_HEADS + 2 * D_MODEL

kernel_name = 'hybrid_retention_gdn_diffusion_step'


def _split_cols(t, widths):
    idx, acc = [], 0
    for w in widths[:-1]:
        acc += w
        idx.append(acc)
    return jnp.split(t, idx, axis=-1)


def _rmsnorm(x, w):
    xf = x.astype(jnp.float32)
    y = xf * lax.rsqrt(jnp.mean(xf * xf, axis=-1, keepdims=True) + EPS)
    return (y * w.astype(jnp.float32)).astype(x.dtype)


def _l2norm(x):
    xf = x.astype(jnp.float32)
    return xf * lax.rsqrt(jnp.sum(xf * xf, axis=-1, keepdims=True) + EPS)


def _flip(t):
    return t[:, ::-1]


def _to_chunks(t):
    B, L = t.shape[:2]
    t = t.reshape((B, L // CHUNK, CHUNK) + t.shape[2:])
    perm = (1, 0, 3, 2) + tuple(range(4, t.ndim))
    return jnp.transpose(t, perm)


def _from_chunks(t):
    n, B, H, C, d = t.shape
    return jnp.transpose(t, (1, 0, 3, 2, 4)).reshape(B, n * C, H, d)


def _grid_rope(L):
    rows = L // GRID_W
    row_idx = jnp.repeat(jnp.arange(rows, dtype=jnp.float32), GRID_W)
    col_idx = (jnp.arange(L) % GRID_W).astype(jnp.float32)
    n_freq = RET_DK // 4
    freqs = ROPE_BASE ** (-jnp.arange(n_freq, dtype=jnp.float32) / n_freq)
    ang = jnp.concatenate([row_idx[:, None] * freqs, col_idx[:, None] * freqs], axis=-1)
    return jnp.cos(ang), jnp.sin(ang)


def _apply_rope(x, cos, sin):
    xp = x.astype(jnp.float32).reshape(x.shape[:-1] + (x.shape[-1] // 2, 2))
    x0, x1 = xp[..., 0], xp[..., 1]
    c, s = cos[None, :, None, :], sin[None, :, None, :]
    out = jnp.stack([x0 * c - x1 * s, x0 * s + x1 * c], axis=-1)
    return out.reshape(x.shape).astype(x.dtype)


def _short_conv(x, w):
    C = x.shape[-1]
    pad = CONV_WIDTH // 2
    return lax.conv_general_dilated(x, w[:, None, :].astype(x.dtype), window_strides=(1,), padding=[(pad, pad)], dimension_numbers=('NWC', 'WIO', 'NWC'), feature_group_count=C)


def _retention_chunked(q, k, v, log_gamma, s0):
    qc, kc, vc = (_to_chunks(t.astype(jnp.float32)) for t in (q, k, v))
    pos = jnp.arange(CHUNK, dtype=jnp.float32)
    diff = pos[:, None] - pos[None, :]
    lower = diff >= 0
    lg = log_gamma.astype(jnp.float32)[:, None, None]
    intra = jnp.where(lower, jnp.exp(lg * jnp.where(lower, diff, 0.0)), 0.0)
    q_dec = jnp.exp(lg[:, :, 0] * (pos + 1.0))
    k_dec = jnp.exp(lg[:, :, 0] * (CHUNK - 1.0 - pos))
    c_dec = jnp.exp(lg[:, 0, 0] * CHUNK)

    def step(S, inp):
        qi, ki, vi = inp
        scores = jnp.einsum('bhid,bhjd->bhij', qi, ki) * intra
        o = jnp.einsum('bhij,bhjv->bhiv', scores, vi) + jnp.einsum('bhid,bhdv->bhiv', qi, S) * q_dec[..., None]
        S = S * c_dec[:, None, None] + jnp.einsum('bhjd,bhjv->bhdv', ki * k_dec[..., None], vi)
        return S, o

    S, oc = lax.scan(step, s0.astype(jnp.float32), (qc, kc, vc))
    return _from_chunks(oc), S


def _gated_delta_chunked(q, k, v, beta, log_alpha, s0):
    qc, kc, vc = (_to_chunks(t.astype(jnp.float32)) for t in (q, k, v))
    bc, ac = _to_chunks(beta.astype(jnp.float32)), _to_chunks(log_alpha.astype(jnp.float32))
    tril = jnp.tril(jnp.ones((CHUNK, CHUNK), dtype=bool))
    strict = jnp.tril(jnp.ones((CHUNK, CHUNK), dtype=bool), -1)
    eye = jnp.eye(CHUNK, dtype=jnp.float32)

    def step(S, inp):
        qi, ki, vi, bi, ai = inp
        g = jnp.cumsum(ai, axis=-1)
        decay = jnp.exp(jnp.where(tril, g[..., :, None] - g[..., None, :], -jnp.inf))
        kb = ki * bi[..., None]
        a_mat = eye + jnp.where(strict, jnp.einsum('bhid,bhjd->bhij', kb, ki) * decay, 0.0)
        u = lax.linalg.triangular_solve(a_mat, vi * bi[..., None], left_side=True, lower=True, unit_diagonal=True)
        w = lax.linalg.triangular_solve(a_mat, kb * jnp.exp(g)[..., None], left_side=True, lower=True, unit_diagonal=True)
        v_new = u - jnp.einsum('bhcd,bhdv->bhcv', w, S)
        scores = jnp.einsum('bhid,bhjd->bhij', qi, ki) * decay
        o = jnp.einsum('bhcd,bhdv->bhcv', qi * jnp.exp(g)[..., None], S) + jnp.einsum('bhij,bhjv->bhiv', scores, v_new)
        g_last = g[..., -1:]
        S = S * jnp.exp(g_last)[..., None] + jnp.einsum('bhcd,bhcv->bhdv', ki * jnp.exp(g_last - g)[..., None], v_new)
        return S, o

    S, oc = lax.scan(step, s0.astype(jnp.float32), (qc, kc, vc, bc, ac))
    return _from_chunks(oc), S


def _token_mixers(h, p, s_ret0, s_dn0, rope):
    B, L, _ = h.shape
    proj = h @ p['w_in']
    r_q, r_k, r_v, r_g, d_q, d_k, d_v, d_z, d_b, d_a, g_r, g_d = _split_cols(proj, IN_WIDTHS)

    rq = r_q.reshape(B, L, RET_HEADS, RET_DK) * (RET_DK ** -0.5)
    rk = r_k.reshape(B, L, RET_HEADS, RET_DK)
    rv = r_v.reshape(B, L, RET_HEADS, RET_DV)
    if rope is not None:
        rq = _apply_rope(rq, rope[0], rope[1])
        rk = _apply_rope(rk, rope[0], rope[1])
    log_gamma = jax.nn.log_sigmoid(p['ret_decay_logit'].astype(jnp.float32))
    o_f, sr_f = _retention_chunked(rq, rk, rv, log_gamma[0], s_ret0[:, 0])
    o_b, sr_b = _retention_chunked(_flip(rq), _flip(rk), _flip(rv), log_gamma[1], s_ret0[:, 1])
    o_r = o_f + _flip(o_b)
    mu = jnp.mean(o_r, axis=-1, keepdims=True)
    var = jnp.mean(jnp.square(o_r - mu), axis=-1, keepdims=True)
    o_r = (o_r - mu) * lax.rsqrt(var + EPS) * p['ret_gn_w'].astype(jnp.float32).reshape(RET_HEADS, RET_DV)
    y_r = (jax.nn.silu(r_g) * o_r.reshape(B, L, RET_VW).astype(h.dtype)) @ p['w_ret_o']

    qkv = jax.nn.silu(_short_conv(jnp.concatenate([d_q, d_k, d_v], axis=-1), p['conv_w']))
    dq, dk, dv = _split_cols(qkv, (DN_QK, DN_QK, DN_VW))
    dq = _l2norm(dq.reshape(B, L, DN_HEADS, DN_DK)) * (DN_DK ** -0.5)
    dk = _l2norm(dk.reshape(B, L, DN_HEADS, DN_DK))
    dv = dv.reshape(B, L, DN_HEADS, DN_DV)
    beta = jax.nn.sigmoid(d_b.astype(jnp.float32)).reshape(B, L, 2, DN_HEADS)
    log_alpha = -jnp.exp(p['dn_a_log'].astype(jnp.float32)) * jax.nn.softplus(d_a.astype(jnp.float32).reshape(B, L, 2, DN_HEADS) + p['dn_dt_bias'].astype(jnp.float32))
    od_f, sd_f = _gated_delta_chunked(dq, dk, dv, beta[:, :, 0], log_alpha[:, :, 0], s_dn0[:, 0])
    od_b, sd_b = _gated_delta_chunked(_flip(dq), _flip(dk), _flip(dv), _flip(beta[:, :, 1]), _flip(log_alpha[:, :, 1]), s_dn0[:, 1])
    o_d = od_f + _flip(od_b)
    o_d = o_d * lax.rsqrt(jnp.mean(o_d * o_d, axis=-1, keepdims=True) + EPS) * p['dn_norm_w'].astype(jnp.float32)
    o_d = o_d * jax.nn.silu(d_z.astype(jnp.float32).reshape(B, L, DN_HEADS, DN_DV))
    y_d = o_d.reshape(B, L, DN_VW).astype(h.dtype) @ p['w_dn_o']

    merged = jax.nn.sigmoid(g_r) * y_r + jax.nn.sigmoid(g_d) * y_d
    out = merged @ p['w_out']
    return out, jnp.stack([sr_f, sr_b], axis=1), jnp.stack([sd_f, sd_b], axis=1)


def _layer(x, cond, s_ret0, s_dn0, rope, p):
    mod = (jax.nn.silu(cond) @ p['w_mod'] + p['b_mod'])[:, None, :]
    sh1, sc1, g1, sh2, sc2, g2 = jnp.split(mod, 6, axis=-1)
    nw = p['norm_w']
    h = _rmsnorm(x, nw[0]) * (1 + sc1) + sh1
    m, s_ret, s_dn = _token_mixers(h, p, s_ret0, s_dn0, rope)
    x = x + g1 * _rmsnorm(m, nw[1])
    h = _rmsnorm(x, nw[2]) * (1 + sc2) + sh2
    gate, up = jnp.split(h @ p['w_ffn_in'], 2, axis=-1)
    f = (jax.nn.silu(gate) * up) @ p['w_ffn_out']
    x = x + g2 * _rmsnorm(f, nw[3])
    return x, s_ret, s_dn


def setup_inputs(seed: int = 0) -> dict:
    key = jax.random.key(seed)
    ks = jax.random.split(key, 24)
    f32 = jnp.float32

    def nrm(k, shape, scale):
        return jax.random.normal(k, shape, f32) * scale

    heads_exp = 5.0 + jnp.arange(RET_HEADS, dtype=f32)
    ret_logit0 = jnp.log(jnp.exp2(heads_exp) - 1.0)
    dt = jnp.exp(jax.random.uniform(ks[12], (DEPTH, 2, DN_HEADS), f32, np.log(1e-3), np.log(1e-1)))
    return {
        'x_prompt': nrm(ks[0], (BATCH, SEQ, D_MODEL), 1.0),
        'x_sample': nrm(ks[1], (DEC_BATCH, DEC_SEQ, D_MODEL), 1.0),
        'c': nrm(ks[2], (DEC_BATCH, D_MODEL), 1.0),
        'state_ret': nrm(ks[3], (DEC_BATCH, DEPTH, 2, RET_HEADS, RET_DK, RET_DV), 0.1),
        'state_dn': nrm(ks[4], (DEC_BATCH, DEPTH, 2, DN_HEADS, DN_DK, DN_DV), 0.1),
        'c_ctx': nrm(ks[5], (D_MODEL,), 1.0),
        'w_mod': nrm(ks[6], (DEPTH, D_MODEL, 6 * D_MODEL), 0.5 * D_MODEL ** -0.5),
        'b_mod': nrm(ks[7], (DEPTH, 6 * D_MODEL), 0.02),
        'norm_w': 1.0 + nrm(ks[8], (DEPTH, 4, D_MODEL), 0.02),
        'w_in': nrm(ks[9], (DEPTH, D_MODEL, IN_COLS), D_MODEL ** -0.5),
        'conv_w': nrm(ks[10], (DEPTH, CONV_WIDTH, DN_CONV_CH), CONV_WIDTH ** -0.5),
        'ret_decay_logit': ret_logit0 + nrm(ks[11], (DEPTH, 2, RET_HEADS), 0.1),
        'ret_gn_w': 1.0 + nrm(ks[13], (DEPTH, RET_VW), 0.02),
        'dn_a_log': jnp.log(jax.random.uniform(ks[14], (DEPTH, 2, DN_HEADS), f32, 1.0, 16.0)),
        'dn_dt_bias': dt + jnp.log(-jnp.expm1(-dt)),
        'dn_norm_w': 1.0 + nrm(ks[15], (DEPTH, DN_DV), 0.02),
        'w_ret_o': nrm(ks[16], (DEPTH, RET_VW, D_MODEL), RET_VW ** -0.5),
        'w_dn_o': nrm(ks[17], (DEPTH, DN_VW, D_MODEL), DN_VW ** -0.5),
        'w_out': nrm(ks[18], (DEPTH, D_MODEL, D_MODEL), D_MODEL ** -0.5),
        'w_ffn_in': nrm(ks[19], (DEPTH, D_MODEL, 2 * D_FF), D_MODEL ** -0.5),
        'w_ffn_out': nrm(ks[20], (DEPTH, D_FF, D_MODEL), D_FF ** -0.5),
    }


def reference(x_prompt, x_sample, c, state_ret, state_dn, c_ctx, w_mod, b_mod, norm_w, w_in, conv_w, ret_decay_logit, ret_gn_w, dn_a_log, dn_dt_bias, dn_norm_w, w_ret_o, w_dn_o, w_out, w_ffn_in, w_ffn_out):
    rope = _grid_rope(x_sample.shape[1])
    ctx_cond = c_ctx[None, :]
    n_ctx = x_prompt.shape[0]
    zero_ret = jnp.zeros((n_ctx, 2, RET_HEADS, RET_DK, RET_DV), jnp.float32)
    zero_dn = jnp.zeros((n_ctx, 2, DN_HEADS, DN_DK, DN_DV), jnp.float32)
    y_prompt, y_sample = x_prompt, x_sample
    ret_states, dn_states = [], []
    for l in range(DEPTH):
        p = {'w_mod': w_mod[l], 'b_mod': b_mod[l], 'norm_w': norm_w[l], 'w_in': w_in[l], 'conv_w': conv_w[l],
             'ret_decay_logit': ret_decay_logit[l], 'ret_gn_w': ret_gn_w[l], 'dn_a_log': dn_a_log[l],
             'dn_dt_bias': dn_dt_bias[l], 'dn_norm_w': dn_norm_w[l], 'w_ret_o': w_ret_o[l], 'w_dn_o': w_dn_o[l],
             'w_out': w_out[l], 'w_ffn_in': w_ffn_in[l], 'w_ffn_out': w_ffn_out[l]}
        y_prompt, s_ret, s_dn = _layer(y_prompt, ctx_cond, zero_ret, zero_dn, None, p)
        ret_states.append(s_ret)
        dn_states.append(s_dn)
        y_sample, _, _ = _layer(y_sample, c, state_ret[:, l], state_dn[:, l], rope, p)
    new_state_ret = jnp.stack(ret_states, axis=1).astype(x_prompt.dtype)
    new_state_dn = jnp.stack(dn_states, axis=1).astype(x_prompt.dtype)
    return (y_prompt, y_sample, new_state_ret, new_state_dn)
```

```cpp
#include <hip/hip_runtime.h>
#include <cstdio>
#include <cstdint>

namespace nv {
constexpr int D = 1024, NCTX = 16, LCTX = 256, NLAT = 4, LLAT = 2048;
constexpr int MCTX = NCTX * LCTX, MLAT = NLAT * LLAT, MTOT = MCTX + MLAT;
constexpr int H = 4, DK = 128, DV = 256, QK = 512, VW = 1024;
constexpr int DFF = 2816, INC = 8208;
constexpr float EPS = 1e-6f;
constexpr int GROWS = 2048;
constexpr int C_RQ = 0, C_RK = 512, C_RV = 1024, C_RG = 2048, C_DQ = 3072, C_DK = 3584, C_DV = 4096, C_DZ = 5120, C_DB = 6144, C_DA = 6152, C_GR = 6160, C_GD = 7184;

__device__ __forceinline__ float siluf(float x) { return x / (1.f + expf(-x)); }
__device__ __forceinline__ float sigmf(float x) { return 1.f / (1.f + expf(-x)); }
__device__ __forceinline__ float softplusf(float x) { return x > 20.f ? x : log1pf(expf(x)); }

__device__ __forceinline__ float wave_sum(float v) {
#pragma unroll
  for (int o = 1; o < 64; o <<= 1) v += __shfl_xor(v, o);
  return v;
}

__global__ void k_mod(const float* c_ctx, const float* c, const float* w_mod, const float* b_mod, float* mod) {
  int n = blockIdx.x * blockDim.x + threadIdx.x;
  if (n >= 6 * D) return;
  float acc[5] = {0, 0, 0, 0, 0};
  for (int k = 0; k < D; ++k) {
    float w = w_mod[(size_t)k * 6 * D + n];
    acc[0] += siluf(c_ctx[k]) * w;
#pragma unroll
    for (int j = 0; j < 4; ++j) acc[1 + j] += siluf(c[j * D + k]) * w;
  }
  for (int j = 0; j < 5; ++j) mod[j * 6 * D + n] = acc[j] + b_mod[n];
}

__global__ void k_norm_mod(const float* x, const float* nw, const float* mod, int sh_off, int sc_off, int row0_global, float* out, int rows) {
  int wave = (blockIdx.x * blockDim.x + threadIdx.x) >> 6, lane = threadIdx.x & 63;
  if (wave >= rows) return;
  int m = row0_global + wave;
  int cidx = m < MCTX ? 0 : 1 + (m - MCTX) / LLAT;
  const float* xr = x + (size_t)wave * D;
  float v[16]; float s = 0.f;
#pragma unroll
  for (int j = 0; j < 16; ++j) { v[j] = xr[lane + 64 * j]; s += v[j] * v[j]; }
  s = wave_sum(s);
  float r = rsqrtf(s / D + EPS);
  const float* md = mod + (size_t)cidx * 6 * D;
#pragma unroll
  for (int j = 0; j < 16; ++j) { int cidn = lane + 64 * j; out[(size_t)wave * D + cidn] = v[j] * r * nw[cidn] * (1.f + md[sc_off + cidn]) + md[sh_off + cidn]; }
}

__global__ void __launch_bounds__(256) k_sgemm(const float* A, int lda, const float* B, int ldb, float* C, int ldc, int M, int N, int K) {
  __shared__ float sA[16][64 + 4];
  __shared__ float sB[16][64 + 4];
  int bm = blockIdx.y * 64, bn = blockIdx.x * 64;
  int tid = threadIdx.x, tx = tid & 15, ty = tid >> 4;
  float acc[4][4] = {};
  for (int k0 = 0; k0 < K; k0 += 16) {
#pragma unroll
    for (int i = 0; i < 4; ++i) { int e = tid + 256 * i; int r = e >> 4, kk = e & 15; sA[kk][r] = A[(size_t)(bm + r) * lda + k0 + kk]; }
#pragma unroll
    for (int i = 0; i < 4; ++i) { int e = tid + 256 * i; int kk = e >> 6, cn = e & 63; int n = bn + cn; sB[kk][cn] = n < N ? B[(size_t)(k0 + kk) * ldb + n] : 0.f; }
    __syncthreads();
#pragma unroll
    for (int kk = 0; kk < 16; ++kk) {
      float a[4], b[4];
#pragma unroll
      for (int i = 0; i < 4; ++i) { a[i] = sA[kk][ty * 4 + i]; b[i] = sB[kk][tx * 4 + i]; }
#pragma unroll
      for (int i = 0; i < 4; ++i)
#pragma unroll
        for (int j = 0; j < 4; ++j) acc[i][j] += a[i] * b[j];
    }
    __syncthreads();
  }
#pragma unroll
  for (int i = 0; i < 4; ++i)
#pragma unroll
    for (int j = 0; j < 4; ++j) { int n = bn + tx * 4 + j; if (n < N) C[(size_t)(bm + ty * 4 + i) * ldc + n] = acc[i][j]; }
}

__global__ void k_ret_prep(float* proj, int row0_global, int rows) {
  int idx = blockIdx.x * blockDim.x + threadIdx.x;
  int total = rows * H * 64;
  if (idx >= total) return;
  int pair = idx & 63, h = (idx >> 6) & 3, r = idx >> 8;
  int m = row0_global + r;
  float* q = proj + (size_t)r * INC + C_RQ + h * DK + 2 * pair;
  float* k = proj + (size_t)r * INC + C_RK + h * DK + 2 * pair;
  float q0 = q[0] * 0.08838834764831845f, q1 = q[1] * 0.08838834764831845f, k0 = k[0], k1 = k[1];
  if (m >= MCTX) {
    int l = (m - MCTX) % LLAT;
    int ri = l / 64, ci = l % 64;
    int fi = pair & 31;
    float freq = powf(10000.f, -(float)fi / 32.f);
    float ang = (pair < 32 ? (float)ri : (float)ci) * freq;
    float cs = cosf(ang), sn = sinf(ang);
    float a = q0 * cs - q1 * sn, b = q0 * sn + q1 * cs; q0 = a; q1 = b;
    a = k0 * cs - k1 * sn; b = k0 * sn + k1 * cs; k0 = a; k1 = b;
  }
  q[0] = q0; q[1] = q1; k[0] = k0; k[1] = k1;
}

__global__ void k_conv(const float* proj, const float* conv_w, float* dqkv, int rows, int seq_len) {
  int idx = blockIdx.x * blockDim.x + threadIdx.x;
  if (idx >= rows * 2048) return;
  int ch = idx & 2047, r = idx >> 11;
  int t = r % seq_len;
  float acc = 0.f;
#pragma unroll
  for (int w = 0; w < 3; ++w) {
    int tt = t + w - 1;
    if (tt >= 0 && tt < seq_len) acc += proj[(size_t)(r + w - 1) * INC + C_DQ + ch] * conv_w[w * 2048 + ch];
  }
  dqkv[idx] = siluf(acc);
}
__global__ void k_l2norm(float* dqkv, int rows) {
  int wave = (blockIdx.x * blockDim.x + threadIdx.x) >> 6, lane = threadIdx.x & 63;
  if (wave >= rows * 8) return;
  int which = wave & 1, h = (wave >> 1) & 3, r = wave >> 3;
  float* p = dqkv + (size_t)r * 2048 + which * 512 + h * DK;
  float a = p[lane], b = p[lane + 64];
  float s = wave_sum(a * a + b * b);
  float sc = rsqrtf(s + EPS) * (which == 0 ? 0.08838834764831845f : 1.f);
  p[lane] = a * sc; p[lane + 64] = b * sc;
}
__global__ void k_ba(const float* proj, const float* a_log, const float* dt_bias, float* ba, int rows) {
  int idx = blockIdx.x * blockDim.x + threadIdx.x;
  if (idx >= rows * 8) return;
  int j = idx & 7, r = idx >> 3;
  float db = proj[(size_t)r * INC + C_DB + j], da = proj[(size_t)r * INC + C_DA + j];
  ba[r * 16 + j] = sigmf(db);
  ba[r * 16 + 8 + j] = -expf(a_log[j]) * softplusf(da + dt_bias[j]);
}

__global__ void __launch_bounds__(256) k_ret_scan(const float* proj, const float* decay_logit, const float* s0, float* o_f, float* o_b, float* s_out,
                                                  int seq_len, int nseq, int seq0_global, int is_latent) {
  int b = blockIdx.x; int dir = b & 1, h = (b >> 1) & 3, sq = b >> 3;
  int dv = threadIdx.x;
  __shared__ float sq_[DK], sk_[DK];
  float lg = -softplusf(-decay_logit[dir * 4 + h]);
  float gamma = expf(lg);
  float S[DK];
  if (is_latent) { const float* p = s0 + ((((size_t)(seq0_global + sq) * 2 + dir) * H + h) * DK) * DV + dv;
#pragma unroll
    for (int d = 0; d < DK; ++d) S[d] = p[(size_t)d * DV]; }
  else {
#pragma unroll
    for (int d = 0; d < DK; ++d) S[d] = 0.f; }
  float* o = dir ? o_b : o_f;
  for (int step = 0; step < seq_len; ++step) {
    int t = dir ? seq_len - 1 - step : step;
    size_t r = (size_t)sq * seq_len + t;
    const float* pr = proj + r * INC;
    if (dv < DK) sq_[dv] = pr[C_RQ + h * DK + dv]; else sk_[dv - DK] = pr[C_RK + h * DK + dv - DK];
    float v = pr[C_RV + h * DV + dv];
    __syncthreads();
    float acc = 0.f;
#pragma unroll
    for (int d = 0; d < DK; ++d) { S[d] = gamma * S[d] + sk_[d] * v; acc += sq_[d] * S[d]; }
    o[r * VW + h * DV + dv] = acc;
    __syncthreads();
  }
  if (!is_latent) { float* p = s_out + ((((size_t)(seq0_global + sq) * 2 + dir) * H + h) * DK) * DV + dv;
#pragma unroll
    for (int d = 0; d < DK; ++d) p[(size_t)d * DV] = S[d]; }
}
__global__ void __launch_bounds__(256) k_dn_scan(const float* dqkv, const float* ba, const float* s0, float* o_f, float* o_b, float* s_out,
                                                 int seq_len, int nseq, int seq0_global, int is_latent) {
  int b = blockIdx.x; int dir = b & 1, h = (b >> 1) & 3, sq = b >> 3;
  int dv = threadIdx.x;
  __shared__ float sq_[DK], sk_[DK];
  float S[DK];
  if (is_latent) { const float* p = s0 + ((((size_t)(seq0_global + sq) * 2 + dir) * H + h) * DK) * DV + dv;
#pragma unroll
    for (int d = 0; d < DK; ++d) S[d] = p[(size_t)d * DV]; }
  else {
#pragma unroll
    for (int d = 0; d < DK; ++d) S[d] = 0.f; }
  float* o = dir ? o_b : o_f;
  for (int step = 0; step < seq_len; ++step) {
    int t = dir ? seq_len - 1 - step : step;
    size_t r = (size_t)sq * seq_len + t;
    const float* pr = dqkv + r * 2048;
    if (dv < DK) sq_[dv] = pr[h * DK + dv]; else sk_[dv - DK] = pr[512 + h * DK + dv - DK];
    float v = pr[1024 + h * DV + dv];
    float beta = ba[r * 16 + dir * 4 + h], alpha = expf(ba[r * 16 + 8 + dir * 4 + h]);
    __syncthreads();
    float ks = 0.f;
#pragma unroll
    for (int d = 0; d < DK; ++d) ks += sk_[d] * S[d];
    float vn = beta * (v - alpha * ks);
    float acc = 0.f;
#pragma unroll
    for (int d = 0; d < DK; ++d) { S[d] = alpha * S[d] + sk_[d] * vn; acc += sq_[d] * S[d]; }
    o[r * VW + h * DV + dv] = acc;
    __syncthreads();
  }
  if (!is_latent) { float* p = s_out + ((((size_t)(seq0_global + sq) * 2 + dir) * H + h) * DK) * DV + dv;
#pragma unroll
    for (int d = 0; d < DK; ++d) p[(size_t)d * DV] = S[d]; }
}

__global__ void k_combine(const float* o_rf, const float* o_rb, const float* o_df, const float* o_db, const float* proj,
                          const float* gn_w, const float* dnw, float* a_r, float* a_d, int rows) {
  int wave = (blockIdx.x * blockDim.x + threadIdx.x) >> 6, lane = threadIdx.x & 63;
  if (wave >= rows * H) return;
  int h = wave & 3, r = wave >> 2;
  size_t base = (size_t)r * VW + h * DV;
  float v[4], s = 0.f;
#pragma unroll
  for (int j = 0; j < 4; ++j) { v[j] = o_rf[base + lane + 64 * j] + o_rb[base + lane + 64 * j]; s += v[j]; }
  float mu = wave_sum(s) / DV; float q = 0.f;
#pragma unroll
  for (int j = 0; j < 4; ++j) { v[j] -= mu; q += v[j] * v[j]; }
  float rs = rsqrtf(wave_sum(q) / DV + EPS);
#pragma unroll
  for (int j = 0; j < 4; ++j) { int cidn = h * DV + lane + 64 * j; a_r[(size_t)r * VW + cidn] = siluf(proj[(size_t)r * INC + C_RG + cidn]) * (v[j] * rs * gn_w[cidn]); }
  s = 0.f;
#pragma unroll
  for (int j = 0; j < 4; ++j) { v[j] = o_df[base + lane + 64 * j] + o_db[base + lane + 64 * j]; s += v[j] * v[j]; }
  rs = rsqrtf(wave_sum(s) / DV + EPS);
#pragma unroll
  for (int j = 0; j < 4; ++j) { int cidn = h * DV + lane + 64 * j; a_d[(size_t)r * VW + cidn] = v[j] * rs * dnw[lane + 64 * j] * siluf(proj[(size_t)r * INC + C_DZ + cidn]); }
}
__global__ void k_merge(const float* proj, float* y_r, const float* y_d, int rows) {
  int idx = blockIdx.x * blockDim.x + threadIdx.x;
  if (idx >= rows * D) return;
  int n = idx & 1023, r = idx >> 10;
  y_r[idx] = sigmf(proj[(size_t)r * INC + C_GR + n]) * y_r[idx] + sigmf(proj[(size_t)r * INC + C_GD + n]) * y_d[idx];
}
__global__ void k_resnorm(const float* x, const float* mm, const float* nw, const float* mod, int g_off, int row0_global, float* out, int rows) {
  int wave = (blockIdx.x * blockDim.x + threadIdx.x) >> 6, lane = threadIdx.x & 63;
  if (wave >= rows) return;
  int m = row0_global + wave;
  int cidx = m < MCTX ? 0 : 1 + (m - MCTX) / LLAT;
  const float* mr = mm + (size_t)wave * D;
  float v[16]; float s = 0.f;
#pragma unroll
  for (int j = 0; j < 16; ++j) { v[j] = mr[lane + 64 * j]; s += v[j] * v[j]; }
  float r = rsqrtf(wave_sum(s) / D + EPS);
  const float* md = mod + (size_t)cidx * 6 * D;
#pragma unroll
  for (int j = 0; j < 16; ++j) { int cidn = lane + 64 * j; out[(size_t)wave * D + cidn] = x[(size_t)wave * D + cidn] + md[g_off + cidn] * (v[j] * r * nw[cidn]); }
}
__global__ void k_swiglu(const float* f1, float* act, int rows) {
  int idx = blockIdx.x * blockDim.x + threadIdx.x;
  if (idx >= rows * DFF) return;
  int n = idx % DFF, r = idx / DFF;
  act[idx] = siluf(f1[(size_t)r * 2 * DFF + n]) * f1[(size_t)r * 2 * DFF + DFF + n];
}
}

static void nv_sgemm(const float* A, int lda, const float* B, int ldb, float* C, int ldc, int M, int N, int K, hipStream_t s) {
  dim3 g((N + 63) / 64, M / 64);
  nv::k_sgemm<<<g, 256, 0, s>>>(A, lda, B, ldb, C, ldc, M, N, K);
}

extern "C" void kernel_launch(void* const* d_in, const int* in_sizes, int n_in, void* d_out, int out_size, void* d_ws, size_t ws_size, hipStream_t stream) {
  using namespace nv;
  const float* x_prompt = (const float*)d_in[0]; const float* x_sample = (const float*)d_in[1]; const float* c = (const float*)d_in[2];
  const float* state_ret = (const float*)d_in[3]; const float* state_dn = (const float*)d_in[4]; const float* c_ctx = (const float*)d_in[5];
  const float* w_mod = (const float*)d_in[6]; const float* b_mod = (const float*)d_in[7]; const float* norm_w = (const float*)d_in[8];
  const float* w_in = (const float*)d_in[9]; const float* conv_w = (const float*)d_in[10]; const float* ret_decay = (const float*)d_in[11];
  const float* ret_gn_w = (const float*)d_in[12]; const float* dn_a_log = (const float*)d_in[13]; const float* dn_dt_bias = (const float*)d_in[14];
  const float* dn_norm_w = (const float*)d_in[15]; const float* w_ret_o = (const float*)d_in[16]; const float* w_dn_o = (const float*)d_in[17];
  const float* w_out = (const float*)d_in[18]; const float* w_ffn_in = (const float*)d_in[19]; const float* w_ffn_out = (const float*)d_in[20];
  float* out = (float*)d_out;
  float* y_prompt = out; float* y_sample = out + (size_t)MCTX * D; float* ns_ret = y_sample + (size_t)MLAT * D; float* ns_dn = ns_ret + (size_t)NCTX * 2 * H * DK * DV;
  float* ws = (float*)d_ws;
  size_t off = 0;
  auto take = [&](size_t n) { float* p = ws + off; off += (n + 63) & ~(size_t)63; return p; };
  float* mod = take(5 * 6 * D);
  float* PROJ = take((size_t)GROWS * INC);
  float* Hb = take((size_t)GROWS * D);
  float* DQKV = take((size_t)GROWS * 2048);
  float* BA = take((size_t)GROWS * 16);
  float* Orf = take((size_t)GROWS * D); float* Orb = take((size_t)GROWS * D); float* Odf = take((size_t)GROWS * D); float* Odb = take((size_t)GROWS * D);
  float* Ar = take((size_t)GROWS * D); float* Ad = take((size_t)GROWS * D);
  float* Yr = take((size_t)GROWS * D); float* Yd = take((size_t)GROWS * D);
  float* OUT = take((size_t)GROWS * D); float* X1 = take((size_t)GROWS * D);
  float* ACT = take((size_t)GROWS * DFF);
  float* FFN1 = PROJ;
  k_mod<<<(6 * D + 255) / 256, 256, 0, stream>>>(c_ctx, c, w_mod, b_mod, mod);
  for (int g = 0; g < MTOT / GROWS; ++g) {
    const int row0 = g * GROWS; const bool lat = row0 >= MCTX;
    const float* x = lat ? x_sample + (size_t)(row0 - MCTX) * D : x_prompt + (size_t)row0 * D;
    float* y = lat ? y_sample + (size_t)(row0 - MCTX) * D : y_prompt + (size_t)row0 * D;
    const int seq_len = lat ? LLAT : LCTX, nseq = GROWS / seq_len, seq0 = lat ? (row0 - MCTX) / LLAT : row0 / LCTX;
    k_norm_mod<<<GROWS / 4, 256, 0, stream>>>(x, norm_w + 0 * D, mod, 0 * D, 1 * D, row0, Hb, GROWS);
    nv_sgemm(Hb, D, w_in, INC, PROJ, INC, GROWS, INC, D, stream);
    k_ret_prep<<<(GROWS * H * 64 + 255) / 256, 256, 0, stream>>>(PROJ, row0, GROWS);
    k_conv<<<(GROWS * 2048 + 255) / 256, 256, 0, stream>>>(PROJ, conv_w, DQKV, GROWS, seq_len);
    k_l2norm<<<(GROWS * 8 * 64 + 255) / 256, 256, 0, stream>>>(DQKV, GROWS);
    k_ba<<<(GROWS * 8 + 255) / 256, 256, 0, stream>>>(PROJ, dn_a_log, dn_dt_bias, BA, GROWS);
    k_ret_scan<<<nseq * 8, 256, 0, stream>>>(PROJ, ret_decay, state_ret, Orf, Orb, ns_ret, seq_len, nseq, seq0, lat ? 1 : 0);
    k_dn_scan<<<nseq * 8, 256, 0, stream>>>(DQKV, BA, state_dn, Odf, Odb, ns_dn, seq_len, nseq, seq0, lat ? 1 : 0);
    k_combine<<<GROWS * H / 4, 256, 0, stream>>>(Orf, Orb, Odf, Odb, PROJ, ret_gn_w, dn_norm_w, Ar, Ad, GROWS);
    nv_sgemm(Ar, D, w_ret_o, D, Yr, D, GROWS, D, D, stream);
    nv_sgemm(Ad, D, w_dn_o, D, Yd, D, GROWS, D, D, stream);
    k_merge<<<GROWS * D / 256, 256, 0, stream>>>(PROJ, Yr, Yd, GROWS);
    nv_sgemm(Yr, D, w_out, D, OUT, D, GROWS, D, D, stream);
    k_resnorm<<<GROWS / 4, 256, 0, stream>>>(x, OUT, norm_w + 1 * D, mod, 2 * D, row0, X1, GROWS);
    k_norm_mod<<<GROWS / 4, 256, 0, stream>>>(X1, norm_w + 2 * D, mod, 3 * D, 4 * D, row0, Hb, GROWS);
    nv_sgemm(Hb, D, w_ffn_in, 2 * DFF, FFN1, 2 * DFF, GROWS, 2 * DFF, D, stream);
    k_swiglu<<<(GROWS * DFF + 255) / 256, 256, 0, stream>>>(FFN1, ACT, GROWS);
    nv_sgemm(ACT, DFF, w_ffn_out, D, OUT, D, GROWS, D, DFF, stream);
    k_resnorm<<<GROWS / 4, 256, 0, stream>>>(X1, OUT, norm_w + 3 * D, mod, 5 * D, row0, y, GROWS);
  }
}
```

```cpp
#include <hip/hip_runtime.h>
#include <hip/hip_cooperative_groups.h>
#include <cstdio>
#include <cstdint>
namespace cg = cooperative_groups;

#define LAS __attribute__((address_space(3)))
typedef unsigned short bf16_t;
typedef short bf16x8 __attribute__((ext_vector_type(8)));
typedef float f32x4 __attribute__((ext_vector_type(4)));
typedef float f32x2 __attribute__((ext_vector_type(2)));
typedef unsigned u32x4 __attribute__((ext_vector_type(4)));
typedef unsigned u32x2 __attribute__((ext_vector_type(2)));

constexpr int D = 1024, MCTX = 4096, MLAT = 8192, MTOT = 12288, LCTX = 256, LLAT = 2048, NCTX = 16, NLAT = 4;
constexpr int NH = 4, DK = 128, DV = 256, DFF = 2816, INC = 8208;
constexpr float EPS = 1e-6f;
constexpr float QSCALE = 0.08838834764831845f;
constexpr int NTHREADS = 512, NWAVES = 8;
constexpr int LDS_BYTES = 135168;
constexpr int Q_RQ = 0, Q_RK = 512, Q_RV = 1024, Q_DQ = 2048, Q_DK = 2560, Q_DV = 3072, LDQ = 4096;
constexpr int G_RG = 0, G_DZ = 1024, G_GR = 2048, G_GD = 3072, LDG = 4096;
constexpr int C_RQ = 0, C_RG = 2048, C_DQ = 3072, C_DZ = 5120, C_DB = 6144, C_GR = 6160;

constexpr size_t MiB = 1u << 20;
constexpr size_t WS_MOD = 0;
constexpr size_t WS_ROPE = 128 * 1024;
constexpr size_t WS_BA = 1280 * 1024;
constexpr size_t WS_WQKV = 2 * MiB;
constexpr size_t WS_WGATE = 10 * MiB;
constexpr size_t WS_WRO = 18 * MiB, WS_WDO = 20 * MiB, WS_WOUT = 22 * MiB;
constexpr size_t WS_H = 24 * MiB;
constexpr size_t WS_QKV = 48 * MiB;
constexpr size_t WS_DQ = 144 * MiB;
constexpr size_t WS_O = 192 * MiB;
constexpr size_t WS_END = 240 * MiB;
constexpr size_t WS_AR = WS_DQ, WS_AD = WS_DQ + 24 * MiB, WS_MERGED = WS_DQ;
constexpr size_t WS_WF1 = WS_DQ, WS_WF2 = WS_DQ + 11 * MiB;

struct Params {
  const float* in[21];
  float* out;
  unsigned char* ws;
};
enum { I_XP = 0, I_XS, I_C, I_SRET, I_SDN, I_CCTX, I_WMOD, I_BMOD, I_NORMW, I_WIN, I_CONVW, I_DECAY, I_GNW, I_ALOG, I_DTB, I_DNW, I_WRO, I_WDO, I_WOUT, I_WF1, I_WF2 };

__device__ __forceinline__ float bf2f(unsigned short b) { return __uint_as_float((unsigned)b << 16); }
__device__ __forceinline__ unsigned f2bf(float f) { unsigned u = __float_as_uint(f); return (u + 0x7fffu + ((u >> 16) & 1u)) >> 16; }
__device__ __forceinline__ unsigned pk2(float lo, float hi) { return f2bf(lo) | (f2bf(hi) << 16); }
__device__ __forceinline__ unsigned cvt_pk_bf16(float lo, float hi) { unsigned r; asm volatile("v_cvt_pk_bf16_f32 %0, %1, %2" : "=v"(r) : "v"(lo), "v"(hi)); return r; }
__device__ __forceinline__ float lo_bf(unsigned w) { return __uint_as_float(w << 16); }
__device__ __forceinline__ float hi_bf(unsigned w) { return __uint_as_float(w & 0xffff0000u); }
__device__ __forceinline__ float siluf(float x) { return x / (1.f + __expf(-x)); }
__device__ __forceinline__ float sigmf(float x) { return 1.f / (1.f + __expf(-x)); }
__device__ __forceinline__ float softplusf(float x) { return x > 20.f ? x : log1pf(expf(x)); }
__device__ __forceinline__ float wave_sum(float v) {
#pragma unroll
  for (int o = 1; o < 64; o <<= 1) v += __shfl_xor(v, o);
  return v;
}
__device__ __forceinline__ int cond_of_row(int m) { return m < MCTX ? 0 : 1 + (m - MCTX) / LLAT; }
__device__ __forceinline__ const float* xrow(const Params& p, int m) { return m < MCTX ? p.in[I_XP] + (size_t)m * D : p.in[I_XS] + (size_t)(m - MCTX) * D; }

namespace pg8 {
constexpr int BM = 256, BK = 64, HALF = 128, HTB = HALF * BK * 2, STAGE_BYTES = 8 * HTB, NXCD = 8, WGM = 8;
__host__ __device__ __forceinline__ int lds_byte(int r, int c) { const int st = (r >> 4) * 2 + (c >> 5), rr = r & 15, cc = c & 31, ob = rr * 64 + cc * 2; return st * 1024 + (ob ^ (((ob >> 9) & 1) << 5)); }
__host__ __device__ __forceinline__ void stage_rc(int b, int& R, int& C) { const int st = b / 1024, sb = b % 1024, swz = sb ^ (((sb >> 9) & 1) << 5); R = (st >> 1) * 16 + swz / 64; C = (st & 1) * 32 + (swz % 64) / 2; }
__host__ __device__ __forceinline__ int perm32(int rho) { const int n = rho >> 4, i = rho & 15; return 8 * (i >> 2) + 4 * n + (i & 3); }
struct Unit { int pm, pn; };
struct Gemm { const bf16_t* A; const bf16_t* Bt; int M, N, K; };
struct StaticOrder {
  int nM, nN, nwg, G, c;
  __host__ __device__ void init(int M, int N, int G_, int c_) { nM = M / BM; nN = N / BM; nwg = nM * nN; G = G_; c = c_; }
  __host__ __device__ bool next(int i, Unit& u) const {
    const long L = (long)i * G + c; if (L >= nwg) return false;
    int wgid = (int)L; { const int q = nwg / NXCD, r = nwg % NXCD, xcd = wgid % NXCD, off = wgid / NXCD; wgid = (xcd < r ? xcd * (q + 1) : r * (q + 1) + (xcd - r) * q) + off; }
    const int nig = WGM * nN, gid = wgid / nig, fm = gid * WGM, gsz = (nM - fm) < WGM ? (nM - fm) : WGM;
    u.pm = fm + ((wgid % nig) % gsz); u.pn = (wgid % nig) / gsz; return true;
  }
  __device__ __forceinline__ void a_ready(const Unit&) const {}
  __device__ __forceinline__ void done(const Unit&) const {}
};

template <int MODE  > struct EpiBf16Act {
  static constexpr bool PERM = true, AFTER_DRAIN = false;
  bf16_t* O; int ldc;
  __device__ __forceinline__ void operator()(const f32x4 (&acc)[2][2][4][2], const Unit& u, int wr, int wc, int fr, int fq) const {
    const int row0 = u.pm * BM + wr * 64 + fr, col0 = u.pn * BM + wc * 32 + 8 * fq;
    const bool sg = u.pn >= 8;
#pragma unroll
    for (int ai = 0; ai < 2; ++ai)
#pragma unroll
      for (int m = 0; m < 4; ++m) { bf16_t* rowp = O + (size_t)(row0 + ai * HALF + m * 16) * ldc + col0;
#pragma unroll
        for (int bj = 0; bj < 2; ++bj) { f32x4 v0 = acc[ai][bj][m][0], v1 = acc[ai][bj][m][1];
          if (MODE == 1) {
#pragma unroll
            for (int i = 0; i < 4; ++i) { const float s0 = __builtin_amdgcn_rcpf(1.f + __expf(-v0[i])), s1 = __builtin_amdgcn_rcpf(1.f + __expf(-v1[i]));
              v0[i] = sg ? s0 : v0[i] * s0; v1[i] = sg ? s1 : v1[i] * s1; } }
          u32x4 w; w.x = cvt_pk_bf16(v0[0], v0[1]); w.y = cvt_pk_bf16(v0[2], v0[3]); w.z = cvt_pk_bf16(v1[0], v1[1]); w.w = cvt_pk_bf16(v1[2], v1[3]);
          *(u32x4*)(rowp + bj * HALF) = w; } }
  }
};
struct EpiGateMul {
  static constexpr bool PERM = true, AFTER_DRAIN = false;
  bf16_t* O; int ldc; const bf16_t* G; int ldg; const bf16_t* Add;
  __device__ __forceinline__ void operator()(const f32x4 (&acc)[2][2][4][2], const Unit& u, int wr, int wc, int fr, int fq) const {
    const int row0 = u.pm * BM + wr * 64 + fr, col0 = u.pn * BM + wc * 32 + 8 * fq;
#pragma unroll
    for (int ai = 0; ai < 2; ++ai)
#pragma unroll
      for (int m = 0; m < 4; ++m) { const size_t r = (size_t)(row0 + ai * HALF + m * 16);
#pragma unroll
        for (int bj = 0; bj < 2; ++bj) { const f32x4 v0 = acc[ai][bj][m][0], v1 = acc[ai][bj][m][1];
          const u32x4 g = *(const u32x4*)(G + r * ldg + col0 + bj * HALF);
          float o[8] = {v0[0] * lo_bf(g.x), v0[1] * hi_bf(g.x), v0[2] * lo_bf(g.y), v0[3] * hi_bf(g.y), v1[0] * lo_bf(g.z), v1[1] * hi_bf(g.z), v1[2] * lo_bf(g.w), v1[3] * hi_bf(g.w)};
          if (Add) { const u32x4 a = *(const u32x4*)(Add + r * ldc + col0 + bj * HALF);
            o[0] += lo_bf(a.x); o[1] += hi_bf(a.x); o[2] += lo_bf(a.y); o[3] += hi_bf(a.y); o[4] += lo_bf(a.z); o[5] += hi_bf(a.z); o[6] += lo_bf(a.w); o[7] += hi_bf(a.w); }
          u32x4 w; w.x = cvt_pk_bf16(o[0], o[1]); w.y = cvt_pk_bf16(o[2], o[3]); w.z = cvt_pk_bf16(o[4], o[5]); w.w = cvt_pk_bf16(o[6], o[7]);
          *(u32x4*)(O + r * ldc + col0 + bj * HALF) = w; } }
  }
};
struct EpiF32 {
  static constexpr bool PERM = false, AFTER_DRAIN = false;
  float* O; int ldc;
  __device__ __forceinline__ void operator()(const f32x4 (&acc)[2][2][4][2], const Unit& u, int wr, int wc, int fr, int fq) const {
    const int row0 = u.pm * BM + wr * 64 + fr, col0 = u.pn * BM + wc * 32 + 4 * fq;
#pragma unroll
    for (int ai = 0; ai < 2; ++ai)
#pragma unroll
      for (int m = 0; m < 4; ++m) { float* rowp = O + (size_t)(row0 + ai * HALF + m * 16) * ldc + col0;
#pragma unroll
        for (int bj = 0; bj < 2; ++bj)
#pragma unroll
          for (int n = 0; n < 2; ++n) *(f32x4*)(rowp + bj * HALF + n * 16) = acc[ai][bj][m][n]; }
  }
};
struct EpiSwiGLU {
  static constexpr bool PERM = true, AFTER_DRAIN = false;
  bf16_t* O; int ldc;
  __device__ __forceinline__ void operator()(const f32x4 (&acc)[2][2][4][2], const Unit& u, int wr, int wc, int fr, int fq) const {
    const int row0 = u.pm * BM + wr * 64 + fr, col0 = u.pn * HALF + wc * 32 + 8 * fq;
#pragma unroll
    for (int ai = 0; ai < 2; ++ai)
#pragma unroll
      for (int m = 0; m < 4; ++m) { bf16_t* rowp = O + (size_t)(row0 + ai * HALF + m * 16) * ldc + col0;
        float o[8];
#pragma unroll
        for (int n = 0; n < 2; ++n)
#pragma unroll
          for (int i = 0; i < 4; ++i) { const float g = acc[ai][0][m][n][i], up = acc[ai][1][m][n][i]; o[4 * n + i] = g * __builtin_amdgcn_rcpf(1.f + __expf(-g)) * up; }
        u32x4 w; w.x = cvt_pk_bf16(o[0], o[1]); w.y = cvt_pk_bf16(o[2], o[3]); w.z = cvt_pk_bf16(o[4], o[5]); w.w = cvt_pk_bf16(o[6], o[7]);
        *(u32x4*)rowp = w; }
  }
};

template <class Epi, class Sched, bool ALIGN_EPI = false, bool SP2 = false>
__device__ __forceinline__ void gemm_phase(LAS unsigned char* lds, const Gemm g, const Sched& S, const Epi& E) {
  const int tid = threadIdx.x, wid = __builtin_amdgcn_readfirstlane(tid >> 6), lane = tid & 63, wr = wid >> 2, wc = wid & 3, fr = lane & 15, fq = lane >> 4;
  const int K = g.K, nt = K / BK;
  unsigned voffA[2], voffB[2];
#pragma unroll
  for (int i = 0; i < 2; ++i) { int R, C; stage_rc(tid * 16 + i * 8192, R, C); const int Rb = Epi::PERM ? ((R & ~31) + perm32(R & 31)) : R;
    voffA[i] = (unsigned)(R * K + C) * 2u; voffB[i] = (unsigned)(Rb * K + C) * 2u; }
  const size_t kstep = (size_t)(BK * 2);
  const size_t hstep = (size_t)HALF * K * 2;
  const size_t tstep = 2 * hstep;
  const unsigned ldsw = (unsigned)wid * 1024u;
  const int aoff = lds_byte(wr * 64 + fr, fq * 8), boff = lds_byte(wc * 32 + fr, fq * 8);
#define PG8_SA(b, h) (((b) * 2 + (h)) * HTB)
#define PG8_SB(b, h) ((4 + (b) * 2 + (h)) * HTB)
#define PG8_STAGE(bufoff, gbase, voff) do { _Pragma("unroll") for (int _i = 0; _i < 2; ++_i) \
    __builtin_amdgcn_global_load_lds((const unsigned*)((const char*)(gbase) + (voff)[_i]), (LAS unsigned*)(lds + (bufoff) + ldsw + _i * 8192), 16, 0, 0); } while (0)
#define PG8_LDA(dst, b, h) do { _Pragma("unroll") for (int m = 0; m < 4; ++m) _Pragma("unroll") for (int k = 0; k < 2; ++k) dst[m][k] = *(const LAS bf16x8*)(lds + PG8_SA(b, h) + aoff + m * 2048 + k * 1024); } while (0)
#define PG8_LDB(dst, b, h) do { _Pragma("unroll") for (int n = 0; n < 2; ++n) _Pragma("unroll") for (int k = 0; k < 2; ++k) dst[n][k] = *(const LAS bf16x8*)(lds + PG8_SB(b, h) + boff + n * 2048 + k * 1024); } while (0)
#define PG8_MMA(ai, bj, At, Bt) do { __builtin_amdgcn_s_setprio(1); _Pragma("unroll") for (int m = 0; m < 4; ++m) _Pragma("unroll") for (int n = 0; n < 2; ++n) _Pragma("unroll") for (int k = 0; k < 2; ++k) \
    acc[ai][bj][m][n] = __builtin_amdgcn_mfma_f32_16x16x32_bf16(Bt[n][k], At[m][k], acc[ai][bj][m][n], 0, 0, 0); __builtin_amdgcn_s_setprio(0); } while (0)
#define PG8_WAIT_V(n) asm volatile("s_waitcnt vmcnt(" #n ")" ::: "memory")
#define PG8_WAIT_L(n) asm volatile("s_waitcnt lgkmcnt(" #n ")" ::: "memory")
#define PG8_BAR __builtin_amdgcn_s_barrier()
#define PG8_SCHED __builtin_amdgcn_sched_barrier(0)
  Unit cur, nxt; int ui = 0;
  if (!S.next(0, cur)) return;
  f32x4 acc[2][2][4][2];
#pragma unroll
  for (int a = 0; a < 2; ++a)
#pragma unroll
    for (int b = 0; b < 2; ++b)
#pragma unroll
      for (int m = 0; m < 4; ++m)
#pragma unroll
        for (int n = 0; n < 2; ++n) acc[a][b][m][n] = (f32x4){0.f, 0.f, 0.f, 0.f};
  bf16x8 At[4][2], B0[2][2], B1[2][2];
  const char* cA = (const char*)g.A + (size_t)cur.pm * tstep; const char* cB = (const char*)g.Bt + (size_t)cur.pn * tstep;
  S.a_ready(cur);
  if constexpr (SP2) {
    PG8_STAGE(PG8_SB(0, 0), cB, voffB); PG8_STAGE(PG8_SB(0, 1), cB + hstep, voffB); PG8_STAGE(PG8_SA(0, 0), cA, voffA); PG8_STAGE(PG8_SA(0, 1), cA + hstep, voffA);
    if (wr == 1) PG8_BAR;
    PG8_WAIT_V(2); PG8_BAR;
    PG8_STAGE(PG8_SB(1, 0), cB + kstep, voffB); PG8_STAGE(PG8_SA(1, 0), cA + kstep, voffA); PG8_STAGE(PG8_SB(1, 1), cB + hstep + kstep, voffB);
    PG8_WAIT_V(6); PG8_BAR;
  } else {
    PG8_STAGE(PG8_SB(0, 0), cB, voffB); PG8_STAGE(PG8_SA(0, 0), cA, voffA); PG8_STAGE(PG8_SB(0, 1), cB + hstep, voffB); PG8_STAGE(PG8_SA(0, 1), cA + hstep, voffA);
    if (wr == 1) PG8_BAR;
    PG8_WAIT_V(4); PG8_BAR;
    PG8_STAGE(PG8_SB(1, 0), cB + kstep, voffB); PG8_STAGE(PG8_SA(1, 0), cA + kstep, voffA); PG8_STAGE(PG8_SB(1, 1), cB + hstep + kstep, voffB);
    PG8_WAIT_V(6); PG8_BAR;
  }
  for (;;) {
    const bool has_next = S.next(ui + 1, nxt);
    const char* nA = has_next ? (const char*)g.A + (size_t)nxt.pm * tstep : cA; const char* nB = has_next ? (const char*)g.Bt + (size_t)nxt.pn * tstep : cB;
    for (int t = 0; t < nt; t += 2) {
      const bool last = (t == nt - 2);
      const char* a1 = cA + (size_t)(t + 1) * kstep;
      const char* a2 = last ? nA : cA + (size_t)(t + 2) * kstep; const char* b2 = last ? nB : cB + (size_t)(t + 2) * kstep;
      const char* a3 = a2 + kstep; const char* b3 = b2 + kstep;
      if (last && has_next) S.a_ready(nxt);
      if constexpr (SP2) {
        PG8_LDB(B0, 0, 0); PG8_LDB(B1, 0, 1); PG8_SCHED; PG8_LDA(At, 0, 0); PG8_STAGE(PG8_SA(1, 1), a1 + hstep, voffA);
        PG8_WAIT_V(8); PG8_WAIT_L(0); PG8_BAR; PG8_MMA(0, 0, At, B0); PG8_MMA(0, 1, At, B1); PG8_BAR; PG8_SCHED;
        PG8_LDA(At, 0, 1); PG8_STAGE(PG8_SB(0, 0), b2, voffB); PG8_STAGE(PG8_SB(0, 1), b2 + hstep, voffB); PG8_STAGE(PG8_SA(0, 0), a2, voffA);
        PG8_WAIT_V(8); PG8_WAIT_L(0); PG8_BAR; PG8_MMA(1, 0, At, B0); PG8_MMA(1, 1, At, B1); PG8_BAR; PG8_SCHED;
        PG8_LDB(B0, 1, 0); PG8_LDB(B1, 1, 1); PG8_SCHED; PG8_LDA(At, 1, 0); PG8_STAGE(PG8_SA(0, 1), a2 + hstep, voffA);
        PG8_WAIT_V(8); PG8_WAIT_L(0); PG8_BAR; PG8_MMA(0, 0, At, B0); PG8_MMA(0, 1, At, B1); PG8_BAR; PG8_SCHED;
        PG8_LDA(At, 1, 1); PG8_STAGE(PG8_SB(1, 0), b3, voffB); PG8_STAGE(PG8_SB(1, 1), b3 + hstep, voffB); PG8_STAGE(PG8_SA(1, 0), a3, voffA);
        PG8_WAIT_V(8); PG8_WAIT_L(0); PG8_BAR; PG8_MMA(1, 0, At, B0); PG8_MMA(1, 1, At, B1); PG8_BAR; PG8_SCHED;
      } else {
        PG8_LDB(B0, 0, 0); PG8_SCHED; PG8_LDA(At, 0, 0); PG8_STAGE(PG8_SA(1, 1), a1 + hstep, voffA);
        PG8_WAIT_L(8); PG8_BAR; PG8_WAIT_L(0); PG8_MMA(0, 0, At, B0); PG8_BAR; PG8_SCHED;
        PG8_LDB(B1, 0, 1); PG8_STAGE(PG8_SB(0, 0), b2, voffB);
        PG8_BAR; PG8_WAIT_L(0); PG8_MMA(0, 1, At, B1); PG8_BAR;
        PG8_LDA(At, 0, 1); PG8_STAGE(PG8_SA(0, 0), a2, voffA);
        PG8_BAR; PG8_WAIT_L(0); PG8_MMA(1, 0, At, B0); PG8_BAR; PG8_SCHED;
        PG8_STAGE(PG8_SB(0, 1), b2 + hstep, voffB);
        PG8_WAIT_V(6); PG8_BAR; PG8_MMA(1, 1, At, B1); PG8_BAR;
        PG8_LDB(B0, 1, 0); PG8_SCHED; PG8_LDA(At, 1, 0); PG8_STAGE(PG8_SA(0, 1), a2 + hstep, voffA);
        PG8_WAIT_L(8); PG8_BAR; PG8_WAIT_L(0); PG8_MMA(0, 0, At, B0); PG8_BAR; PG8_SCHED;
        PG8_LDB(B1, 1, 1); PG8_STAGE(PG8_SB(1, 0), b3, voffB);
        PG8_BAR; PG8_WAIT_L(0); PG8_MMA(0, 1, At, B1); PG8_BAR;
        PG8_LDA(At, 1, 1); PG8_STAGE(PG8_SA(1, 0), a3, voffA);
        PG8_BAR; PG8_WAIT_L(0); PG8_MMA(1, 0, At, B0); PG8_BAR; PG8_SCHED;
        PG8_STAGE(PG8_SB(1, 1), b3 + hstep, voffB);
        PG8_WAIT_V(6); PG8_BAR; PG8_MMA(1, 1, At, B1); PG8_BAR;
      }
    }
    if constexpr (ALIGN_EPI) { if (wr == 0) PG8_BAR; }
    if constexpr (!Epi::AFTER_DRAIN) { E(acc, cur, wr, wc, fr, fq); S.done(cur); }
    if (!has_next) break;
#pragma unroll
    for (int a = 0; a < 2; ++a)
#pragma unroll
      for (int b = 0; b < 2; ++b)
#pragma unroll
        for (int m = 0; m < 4; ++m)
#pragma unroll
          for (int n = 0; n < 2; ++n) acc[a][b][m][n] = (f32x4){0.f, 0.f, 0.f, 0.f};
    cur = nxt; cA = nA; cB = nB; ++ui;
    if constexpr (ALIGN_EPI) { if (wr == 1) PG8_BAR; }
  }
  PG8_WAIT_V(0);
  if constexpr (!ALIGN_EPI) { if (wr == 0) PG8_BAR; }
  PG8_BAR;
#undef PG8_SA
#undef PG8_SB
#undef PG8_STAGE
#undef PG8_LDA
#undef PG8_LDB
#undef PG8_MMA
#undef PG8_WAIT_V
#undef PG8_WAIT_L
#undef PG8_BAR
#undef PG8_SCHED
}
}

__device__ __forceinline__ void transpose_item(const float* W, int ldw, int K, int src_col0, bf16_t* WT, int dst_row0, int k0, LAS float* scr, int lane) {
#pragma unroll 8
  for (int i = 0; i < 32; ++i) { const int kk = 2 * i + (lane >> 5); scr[kk * 33 + (lane & 31)] = W[(size_t)(k0 + kk) * ldw + src_col0 + (lane & 31)]; }
  asm volatile("s_waitcnt lgkmcnt(0)" ::: "memory");
  const int c = lane & 7;
#pragma unroll
  for (int j = 0; j < 4; ++j) { const int n = (lane >> 3) + 8 * j; const LAS float* s = scr + (8 * c) * 33 + n;
    u32x4 o; o.x = pk2(s[0 * 33], s[1 * 33]); o.y = pk2(s[2 * 33], s[3 * 33]); o.z = pk2(s[4 * 33], s[5 * 33]); o.w = pk2(s[6 * 33], s[7 * 33]);
    *(u32x4*)(WT + (size_t)(dst_row0 + n) * K + k0 + 8 * c) = o; }
  asm volatile("s_waitcnt lgkmcnt(0)" ::: "memory");
}

template <class ColMap> __device__ __forceinline__ void transpose_matrix(const float* W, int ldw, int K, int N, bf16_t* WT, ColMap cm, LAS float* scr, int gw, int ngw, int lane) {
  const int nblk = N / 32, items = (K / 64) * nblk;
  for (int it = gw; it < items; it += ngw) { const int kb = it / nblk, nb = it % nblk; transpose_item(W, ldw, K, cm(32 * nb), WT, 32 * nb, 64 * kb, scr, lane); }
}

__global__ void __launch_bounds__(NTHREADS) fwd_megakernel(Params p) {
  extern __shared__ __attribute__((aligned(16))) unsigned char lds_raw[];
  LAS unsigned char* lds = (LAS unsigned char*)lds_raw;
  cg::grid_group grid = cg::this_grid();
  const int tid = threadIdx.x, lane = tid & 63, wave = __builtin_amdgcn_readfirstlane(tid >> 6);
  const int G = gridDim.x, bid = blockIdx.x;
  const int gw = bid * NWAVES + wave, ngw = G * NWAVES;
  unsigned char* ws = p.ws;
  float* MOD = (float*)(ws + WS_MOD);
  f32x2* ROPE = (f32x2*)(ws + WS_ROPE);
  float* BA = (float*)(ws + WS_BA);
  bf16_t* WQKV = (bf16_t*)(ws + WS_WQKV); bf16_t* WGATE = (bf16_t*)(ws + WS_WGATE);
  bf16_t* WRO = (bf16_t*)(ws + WS_WRO); bf16_t* WDO = (bf16_t*)(ws + WS_WDO); bf16_t* WOUT = (bf16_t*)(ws + WS_WOUT);
  bf16_t* HB = (bf16_t*)(ws + WS_H);
  bf16_t* QKV = (bf16_t*)(ws + WS_QKV);
  bf16_t* DQ = (bf16_t*)(ws + WS_DQ);
  bf16_t* ODF = (bf16_t*)(ws + WS_O); bf16_t* ODB = ODF + (size_t)MTOT * D;
  bf16_t* ORF = (bf16_t*)p.out; bf16_t* ORB = ORF + (size_t)MTOT * D;
  float* NS_RET = p.out + (size_t)MTOT * D; float* NS_DN = NS_RET + (size_t)NCTX * 2 * NH * DK * DV;

  {
    LAS float* scr = (LAS float*)(lds + wave * 16384);
    transpose_matrix(p.in[I_WIN], INC, D, 4096, WQKV, [](int n) { return n < 2048 ? n : n + 1024; }, scr, gw, ngw, lane);
    transpose_matrix(p.in[I_WIN], INC, D, 4096, WGATE, [](int n) { return n < 1024 ? C_RG + n : (n < 2048 ? C_DZ + (n - 1024) : C_GR + (n - 2048)); }, scr, gw, ngw, lane);
    transpose_matrix(p.in[I_WRO], D, D, D, WRO, [](int n) { return n; }, scr, gw, ngw, lane);
    transpose_matrix(p.in[I_WDO], D, D, D, WDO, [](int n) { return n; }, scr, gw, ngw, lane);
    transpose_matrix(p.in[I_WOUT], D, D, D, WOUT, [](int n) { return n; }, scr, gw, ngw, lane);
    for (int it = gw; it < 6 * D / 64; it += ngw) {
      const int n = it * 64 + lane;
      float acc[5] = {0.f, 0.f, 0.f, 0.f, 0.f};
      const float* wm = p.in[I_WMOD] + n;
#pragma unroll 4
      for (int k = 0; k < D; ++k) { const float w = wm[(size_t)k * 6 * D];
        acc[0] += siluf(p.in[I_CCTX][k]) * w;
#pragma unroll
        for (int j = 0; j < 4; ++j) acc[1 + j] += siluf(p.in[I_C][j * D + k]) * w; }
      const float b = p.in[I_BMOD][n];
#pragma unroll
      for (int j = 0; j < 5; ++j) MOD[j * 6 * D + n] = acc[j] + b;
    }
    for (int i = bid * NTHREADS + tid; i < LLAT * 64; i += G * NTHREADS) { const int l = i >> 6, pr = i & 63;
      const float freq = powf(10000.f, -(float)(pr & 31) / 32.f); const float ang = (pr < 32 ? (float)(l >> 6) : (float)(l & 63)) * freq;
      ROPE[i] = (f32x2){cosf(ang), sinf(ang)}; }
  }
  grid.sync();

  {
    LAS float* wba = (LAS float*)lds;
    for (int i = tid; i < D * 16; i += NTHREADS) wba[i] = p.in[I_WIN][(size_t)(i >> 4) * INC + C_DB + (i & 15)];
    __syncthreads();
    const float* nw = p.in[I_NORMW];
    for (int m = gw; m < MTOT; m += ngw) {
      const float* xr = xrow(p, m); const float* md = MOD + (size_t)cond_of_row(m) * 6 * D;
      float s = 0.f;
#pragma unroll
      for (int j = 0; j < 4; ++j) { const f32x4 x4 = *(const f32x4*)(xr + 4 * lane + 256 * j); s += (x4.x * x4.x + x4.y * x4.y) + (x4.z * x4.z + x4.w * x4.w); }
      const float r = rsqrtf(wave_sum(s) * (1.f / D) + EPS);
      float dots[16];
#pragma unroll
      for (int n = 0; n < 16; ++n) dots[n] = 0.f;
#pragma unroll 1
      for (int j = 0; j < 4; ++j) { const int c0 = 4 * lane + 256 * j;
        const f32x4 x4 = *(const f32x4*)(xr + c0);
        const f32x4 w4 = *(const f32x4*)(nw + c0), sc = *(const f32x4*)(md + D + c0), sh = *(const f32x4*)(md + c0);
        f32x4 h = x4 * r * w4 * (sc + 1.f) + sh;
        u32x2 o; o.x = pk2(h.x, h.y); o.y = pk2(h.z, h.w);
        *(u32x2*)(HB + (size_t)m * D + c0) = o;
#pragma unroll
        for (int e = 0; e < 4; ++e) {
#pragma unroll
          for (int q = 0; q < 4; ++q) { const f32x4 wv = *(const LAS f32x4*)(wba + (c0 + e) * 16 + 4 * q);
            dots[4 * q + 0] += h[e] * wv.x; dots[4 * q + 1] += h[e] * wv.y; dots[4 * q + 2] += h[e] * wv.z; dots[4 * q + 3] += h[e] * wv.w; } }
      }
#pragma unroll
      for (int n = 0; n < 16; ++n) dots[n] = wave_sum(dots[n]);
      if (lane < 8) {
        float db = dots[0], da = dots[8];
#pragma unroll
        for (int n = 1; n < 8; ++n) { db = lane == n ? dots[n] : db; da = lane == n ? dots[8 + n] : da; }
        BA[(size_t)m * 16 + lane] = sigmf(db);
        BA[(size_t)m * 16 + 8 + lane] = -expf(p.in[I_ALOG][lane]) * softplusf(da + p.in[I_DTB][lane]);
      }
    }
  }
  grid.sync();

  {
    pg8::Gemm g{HB, WQKV, MTOT, 4096, D}; pg8::StaticOrder S; S.init(MTOT, 4096, G, bid);
    pg8::EpiBf16Act<0> E{QKV, LDQ};
    pg8::gemm_phase<pg8::EpiBf16Act<0>, pg8::StaticOrder, true, true>(lds, g, S, E);
  }
  grid.sync();

  {
    for (long i = (long)bid * NTHREADS + tid; i < (long)MTOT * 256; i += (long)G * NTHREADS) {
      const int m = (int)(i >> 8), hp = (int)(i & 255), h = hp >> 6, pr = hp & 63;
      unsigned* qp = (unsigned*)(QKV + (size_t)m * LDQ + Q_RQ + h * DK + 2 * pr);
      unsigned* kp = (unsigned*)(QKV + (size_t)m * LDQ + Q_RK + h * DK + 2 * pr);
      const unsigned qw = *qp;
      float q0 = lo_bf(qw) * QSCALE, q1 = hi_bf(qw) * QSCALE;
      if (m >= MCTX) {
        const unsigned kw = *kp; float k0 = lo_bf(kw), k1 = hi_bf(kw);
        const f32x2 cs = ROPE[((m - MCTX) & (LLAT - 1)) * 64 + pr];
        const float a = q0 * cs.x - q1 * cs.y, b = q0 * cs.y + q1 * cs.x; q0 = a; q1 = b;
        const float c = k0 * cs.x - k1 * cs.y, d = k0 * cs.y + k1 * cs.x;
        *kp = pk2(c, d);
      }
      *qp = pk2(q0, q1);
    }
    const float* cw = p.in[I_CONVW];
    for (int m = gw; m < MTOT; m += ngw) {
      const int t = m < MCTX ? (m & (LCTX - 1)) : ((m - MCTX) & (LLAT - 1)); const int L = m < MCTX ? LCTX : LLAT;
      float a[32];
#pragma unroll
      for (int e = 0; e < 32; ++e) a[e] = 0.f;
#pragma unroll
      for (int w = 0; w < 3; ++w) {
        const int tt = t + w - 1;
        if (tt >= 0 && tt < L) {
          const bf16_t* src = QKV + (size_t)(m + w - 1) * LDQ + Q_DQ + 32 * lane;
#pragma unroll
          for (int c4 = 0; c4 < 4; ++c4) { const u32x4 x = *(const u32x4*)(src + 8 * c4);
            const f32x4 w0 = *(const f32x4*)(cw + w * 2048 + 32 * lane + 8 * c4), w1 = *(const f32x4*)(cw + w * 2048 + 32 * lane + 8 * c4 + 4);
            a[8 * c4 + 0] += lo_bf(x.x) * w0.x; a[8 * c4 + 1] += hi_bf(x.x) * w0.y; a[8 * c4 + 2] += lo_bf(x.y) * w0.z; a[8 * c4 + 3] += hi_bf(x.y) * w0.w;
            a[8 * c4 + 4] += lo_bf(x.z) * w1.x; a[8 * c4 + 5] += hi_bf(x.z) * w1.y; a[8 * c4 + 6] += lo_bf(x.w) * w1.z; a[8 * c4 + 7] += hi_bf(x.w) * w1.w; }
        }
      }
      float ss = 0.f;
#pragma unroll
      for (int e = 0; e < 32; ++e) { a[e] = siluf(a[e]); ss += a[e] * a[e]; }
      ss += __shfl_xor(ss, 1); ss += __shfl_xor(ss, 2);
      float sc = 1.f;
      if (lane < 16) sc = rsqrtf(ss + EPS) * QSCALE; else if (lane < 32) sc = rsqrtf(ss + EPS);
      bf16_t* dst = DQ + (size_t)m * 2048 + 32 * lane;
#pragma unroll
      for (int c4 = 0; c4 < 4; ++c4) { u32x4 o; o.x = pk2(a[8 * c4] * sc, a[8 * c4 + 1] * sc); o.y = pk2(a[8 * c4 + 2] * sc, a[8 * c4 + 3] * sc);
        o.z = pk2(a[8 * c4 + 4] * sc, a[8 * c4 + 5] * sc); o.w = pk2(a[8 * c4 + 6] * sc, a[8 * c4 + 7] * sc); *(u32x4*)(dst + 8 * c4) = o; }
    }
  }
  grid.sync();

  {
    LAS float* sqk = (LAS float*)lds;
    const int half = tid >> 8, dv = tid & 255;
    for (int item = bid; item < 160; item += G) {
      int type, sq, h, L, row_base; bool lat;
      if (item < 32) { lat = true; type = item >> 4; sq = (item >> 2) & 3; h = item & 3; L = LLAT; row_base = MCTX + sq * LLAT; }
      else { const int j = item - 32; lat = false; type = j >> 6; sq = (j >> 2) & 15; h = j & 3; L = LCTX; row_base = sq * LCTX; }
      const int dir = half;
      float S[DK];
      const float* s0 = (type ? p.in[I_SDN] : p.in[I_SRET]) + ((((size_t)sq * 2 + dir) * NH + h) * DK) * DV + dv;
      if (lat) {
#pragma unroll
        for (int d = 0; d < DK; ++d) S[d] = s0[(size_t)d * DV]; }
      else {
#pragma unroll
        for (int d = 0; d < DK; ++d) S[d] = 0.f; }
      float gamma = 0.f;
      if (type == 0) gamma = expf(-softplusf(-p.in[I_DECAY][dir * 4 + h]));
      const bf16_t* src = type ? DQ : QKV; const int ld = type ? 2048 : LDQ;
      const int qoff = type ? h * DK : Q_RQ + h * DK, koff = type ? 512 + h * DK : Q_RK + h * DK, voff = type ? 1024 + h * DV : Q_RV + h * DV;
      bf16_t* O = type ? (dir ? ODB : ODF) : (dir ? ORB : ORF);
      int t = dir ? L - 1 : 0;
      size_t r = (size_t)(row_base + t);
      unsigned short qk = src[r * ld + (dv < DK ? qoff + dv : koff + dv - DK)];
      unsigned short vv = src[r * ld + voff + dv];
      float beta = 0.f, la = 0.f;
      if (type) { beta = BA[r * 16 + dir * 4 + h]; la = BA[r * 16 + 8 + dir * 4 + h]; }
      for (int step = 0; step < L; ++step) {
        sqk[half * 256 + dv] = bf2f(qk);
        const float v = bf2f(vv); const float bcur = beta, alpha = __expf(la); const size_t rcur = r;
        __syncthreads();
        if (step + 1 < L) { t = dir ? L - 2 - step : step + 1; r = (size_t)(row_base + t);
          qk = src[r * ld + (dv < DK ? qoff + dv : koff + dv - DK)]; vv = src[r * ld + voff + dv];
          if (type) { beta = BA[r * 16 + dir * 4 + h]; la = BA[r * 16 + 8 + dir * 4 + h]; } }
        const LAS float* q_ = sqk + half * 256; const LAS float* k_ = q_ + DK;
        float acc = 0.f;
        float ks = 0.f;
        if (type) {
#pragma unroll
          for (int d0 = 0; d0 < DK; d0 += 16) { asm volatile("" ::: "memory");
#pragma unroll
            for (int d = d0; d < d0 + 16; ++d) ks += k_[d] * S[d]; }
        }
        const float dec = type ? alpha : gamma;
        const float vn = type ? bcur * (v - alpha * ks) : v;
#pragma unroll
        for (int d0 = 0; d0 < DK; d0 += 16) { asm volatile("" ::: "memory");
#pragma unroll
          for (int d = d0; d < d0 + 16; ++d) { S[d] = dec * S[d] + k_[d] * vn; acc += q_[d] * S[d]; } }
        O[rcur * D + h * DV + dv] = (bf16_t)f2bf(acc);
        __syncthreads();
      }
      if (!lat) { float* so = (type ? NS_DN : NS_RET) + ((((size_t)sq * 2 + dir) * NH + h) * DK) * DV + dv;
#pragma unroll
        for (int d = 0; d < DK; ++d) so[(size_t)d * DV] = S[d]; }
    }
  }
  grid.sync();

  bf16_t* GATES = QKV;
  {
    pg8::Gemm g{HB, WGATE, MTOT, 4096, D}; pg8::StaticOrder S; S.init(MTOT, 4096, G, bid);
    pg8::EpiBf16Act<1> E{GATES, LDG};
    pg8::gemm_phase<pg8::EpiBf16Act<1>, pg8::StaticOrder, true, true>(lds, g, S, E);
  }
  grid.sync();

  bf16_t* AR = (bf16_t*)(ws + WS_AR); bf16_t* AD = (bf16_t*)(ws + WS_AD);
  {
    for (int it = gw; it < MTOT * NH; it += ngw) {
      const int h = it & 3, m = it >> 2; const size_t base = (size_t)m * D + h * DV + 4 * lane;
      {
        const u32x2 a = *(const u32x2*)(ORF + base), b = *(const u32x2*)(ORB + base);
        float v[4] = {lo_bf(a.x) + lo_bf(b.x), hi_bf(a.x) + hi_bf(b.x), lo_bf(a.y) + lo_bf(b.y), hi_bf(a.y) + hi_bf(b.y)};
        const float mu = wave_sum((v[0] + v[1]) + (v[2] + v[3])) * (1.f / DV);
        float q = 0.f;
#pragma unroll
        for (int e = 0; e < 4; ++e) { v[e] -= mu; q += v[e] * v[e]; }
        const float rs = rsqrtf(wave_sum(q) * (1.f / DV) + EPS);
        const f32x4 gw4 = *(const f32x4*)(p.in[I_GNW] + h * DV + 4 * lane);
        const u32x2 gt = *(const u32x2*)(GATES + (size_t)m * LDG + G_RG + h * DV + 4 * lane);
        u32x2 o; o.x = pk2(lo_bf(gt.x) * (v[0] * rs * gw4.x), hi_bf(gt.x) * (v[1] * rs * gw4.y)); o.y = pk2(lo_bf(gt.y) * (v[2] * rs * gw4.z), hi_bf(gt.y) * (v[3] * rs * gw4.w));
        *(u32x2*)(AR + base) = o;
      }
      {
        const u32x2 a = *(const u32x2*)(ODF + base), b = *(const u32x2*)(ODB + base);
        float v[4] = {lo_bf(a.x) + lo_bf(b.x), hi_bf(a.x) + hi_bf(b.x), lo_bf(a.y) + lo_bf(b.y), hi_bf(a.y) + hi_bf(b.y)};
        const float rs = rsqrtf(wave_sum((v[0] * v[0] + v[1] * v[1]) + (v[2] * v[2] + v[3] * v[3])) * (1.f / DV) + EPS);
        const f32x4 dw4 = *(const f32x4*)(p.in[I_DNW] + 4 * lane);
        const u32x2 gt = *(const u32x2*)(GATES + (size_t)m * LDG + G_DZ + h * DV + 4 * lane);
        u32x2 o; o.x = pk2(v[0] * rs * dw4.x * lo_bf(gt.x), v[1] * rs * dw4.y * hi_bf(gt.x)); o.y = pk2(v[2] * rs * dw4.z * lo_bf(gt.y), v[3] * rs * dw4.w * hi_bf(gt.y));
        *(u32x2*)(AD + base) = o;
      }
    }
  }
  grid.sync();

  bf16_t* T1 = HB;
  {
    pg8::Gemm g{AR, WRO, MTOT, D, D}; pg8::StaticOrder S; S.init(MTOT, D, G, bid);
    pg8::EpiGateMul E{T1, D, GATES + G_GR, LDG, nullptr};
    pg8::gemm_phase<pg8::EpiGateMul, pg8::StaticOrder, true, true>(lds, g, S, E);
  }
  grid.sync();
  bf16_t* MERGED = (bf16_t*)(ws + WS_MERGED);
  {
    pg8::Gemm g{AD, WDO, MTOT, D, D}; pg8::StaticOrder S; S.init(MTOT, D, G, bid);
    pg8::EpiGateMul E{MERGED, D, GATES + G_GD, LDG, T1};
    pg8::gemm_phase<pg8::EpiGateMul, pg8::StaticOrder, true, true>(lds, g, S, E);
  }
  grid.sync();
  float* M1 = (float*)(ws + WS_O);
  {
    pg8::Gemm g{MERGED, WOUT, MTOT, D, D}; pg8::StaticOrder S; S.init(MTOT, D, G, bid);
    pg8::EpiF32 E{M1, D};
    pg8::gemm_phase<pg8::EpiF32, pg8::StaticOrder, true, true>(lds, g, S, E);
  }
  grid.sync();

  bf16_t* WF1 = (bf16_t*)(ws + WS_WF1); bf16_t* WF2 = (bf16_t*)(ws + WS_WF2);
  {
    LAS float* scr = (LAS float*)(lds + wave * 16384);
    transpose_matrix(p.in[I_WF1], 2 * DFF, D, 2 * DFF, WF1, [](int n) { const int pn = n >> 8, w = n & 255; return w < 128 ? 128 * pn + w : DFF + 128 * pn + (w - 128); }, scr, gw, ngw, lane);
    transpose_matrix(p.in[I_WF2], D, DFF, D, WF2, [](int n) { return n; }, scr, gw, ngw, lane);
    const float* nw1 = p.in[I_NORMW] + D; const float* nw2 = p.in[I_NORMW] + 2 * D;
    for (int m = gw; m < MTOT; m += ngw) {
      const float* xr = xrow(p, m); const float* md = MOD + (size_t)cond_of_row(m) * 6 * D; const float* mr = M1 + (size_t)m * D;
      f32x4 v[4]; float s = 0.f;
#pragma unroll
      for (int j = 0; j < 4; ++j) { v[j] = *(const f32x4*)(mr + 4 * lane + 256 * j); s += (v[j].x * v[j].x + v[j].y * v[j].y) + (v[j].z * v[j].z + v[j].w * v[j].w); }
      const float r = rsqrtf(wave_sum(s) * (1.f / D) + EPS);
      float s2 = 0.f;
#pragma unroll
      for (int j = 0; j < 4; ++j) { const int c0 = 4 * lane + 256 * j;
        v[j] = *(const f32x4*)(xr + c0) + *(const f32x4*)(md + 2 * D + c0) * (v[j] * r * *(const f32x4*)(nw1 + c0));
        *(f32x4*)(p.out + (size_t)m * D + c0) = v[j];
        s2 += (v[j].x * v[j].x + v[j].y * v[j].y) + (v[j].z * v[j].z + v[j].w * v[j].w); }
      const float r2 = rsqrtf(wave_sum(s2) * (1.f / D) + EPS);
#pragma unroll
      for (int j = 0; j < 4; ++j) { const int c0 = 4 * lane + 256 * j;
        const f32x4 h = v[j] * r2 * *(const f32x4*)(nw2 + c0) * (*(const f32x4*)(md + 4 * D + c0) + 1.f) + *(const f32x4*)(md + 3 * D + c0);
        u32x2 o; o.x = pk2(h.x, h.y); o.y = pk2(h.z, h.w); *(u32x2*)(HB + (size_t)m * D + c0) = o; }
    }
  }
  grid.sync();

  bf16_t* ACT = QKV;
  {
    pg8::Gemm g{HB, WF1, MTOT, 2 * DFF, D}; pg8::StaticOrder S; S.init(MTOT, 2 * DFF, G, bid);
    pg8::EpiSwiGLU E{ACT, DFF};
    pg8::gemm_phase<pg8::EpiSwiGLU, pg8::StaticOrder, true, true>(lds, g, S, E);
  }
  grid.sync();
  float* F = (float*)(ws + WS_O);
  {
    pg8::Gemm g{ACT, WF2, MTOT, D, DFF}; pg8::StaticOrder S; S.init(MTOT, D, G, bid);
    pg8::EpiF32 E{F, D};
    pg8::gemm_phase<pg8::EpiF32, pg8::StaticOrder, true, true>(lds, g, S, E);
  }
  grid.sync();
  {
    const float* nw3 = p.in[I_NORMW] + 3 * D;
    for (int m = gw; m < MTOT; m += ngw) {
      const float* md = MOD + (size_t)cond_of_row(m) * 6 * D; const float* fr = F + (size_t)m * D; float* orow = p.out + (size_t)m * D;
      f32x4 v[4]; float s = 0.f;
#pragma unroll
      for (int j = 0; j < 4; ++j) { v[j] = *(const f32x4*)(fr + 4 * lane + 256 * j); s += (v[j].x * v[j].x + v[j].y * v[j].y) + (v[j].z * v[j].z + v[j].w * v[j].w); }
      const float r = rsqrtf(wave_sum(s) * (1.f / D) + EPS);
#pragma unroll
      for (int j = 0; j < 4; ++j) { const int c0 = 4 * lane + 256 * j;
        *(f32x4*)(orow + c0) = *(const f32x4*)(orow + c0) + *(const f32x4*)(md + 5 * D + c0) * (v[j] * r * *(const f32x4*)(nw3 + c0)); }
    }
  }
}

extern "C" void kernel_launch(void* const* d_in, const int* in_sizes, int n_in, void* d_out, int out_size, void* d_ws, size_t ws_size, hipStream_t stream) {
  static int grid_blocks = 0;
  if (!grid_blocks) {
    int dev = 0, cus = 0, per_cu = 0;
    (void)hipGetDevice(&dev);
    (void)hipDeviceGetAttribute(&cus, hipDeviceAttributeMultiprocessorCount, dev);
    (void)hipFuncSetAttribute((const void*)fwd_megakernel, hipFuncAttributeMaxDynamicSharedMemorySize, LDS_BYTES);
    (void)hipOccupancyMaxActiveBlocksPerMultiprocessor(&per_cu, (const void*)fwd_megakernel, NTHREADS, LDS_BYTES);
    if (per_cu < 1) per_cu = 1;
    grid_blocks = cus * per_cu;
    if (n_in != 21 || ws_size < WS_END) fprintf(stderr, "kernel_launch: unexpected n_in %d / ws_size %zu\n", n_in, ws_size);
    fprintf(stderr, "kernel_launch: cus %d per_cu %d grid %d ws %zu out %d\n", cus, per_cu, grid_blocks, ws_size, out_size);
  }
  Params p{};
  for (int i = 0; i < 21; ++i) p.in[i] = (const float*)d_in[i];
  p.out = (float*)d_out; p.ws = (unsigned char*)d_ws;
  void* args[] = {&p};
  hipError_t e = hipLaunchCooperativeKernel((const void*)fwd_megakernel, dim3(grid_blocks), dim3(NTHREADS), args, LDS_BYTES, stream);
  if (e != hipSuccess) fprintf(stderr, "cooperative launch failed: %s (grid %d)\n", hipGetErrorString(e), grid_blocks);
}
```

```cpp
#include <hip/hip_runtime.h>
#include <hip/hip_cooperative_groups.h>
#include <cstdio>
#include <cstdint>
namespace cg = cooperative_groups;

#define LAS __attribute__((address_space(3)))
typedef unsigned short bf16_t;
typedef short bf16x8 __attribute__((ext_vector_type(8)));
typedef float f32x4 __attribute__((ext_vector_type(4)));
typedef float f32x2 __attribute__((ext_vector_type(2)));
typedef unsigned u32x4 __attribute__((ext_vector_type(4)));
typedef unsigned u32x2 __attribute__((ext_vector_type(2)));

constexpr int D = 1024, MCTX = 4096, MLAT = 8192, MTOT = 12288, LCTX = 256, LLAT = 2048, NCTX = 16, NLAT = 4;
constexpr int NH = 4, DK = 128, DV = 256, DFF = 2816, INC = 8208;
constexpr float EPS = 1e-6f;
constexpr float QSCALE = 0.08838834764831845f;
constexpr int NTHREADS = 512, NWAVES = 8;
constexpr int LDS_BYTES = 135168;
constexpr int Q_RQ = 0, Q_RK = 512, Q_RV = 1024, Q_DQ = 2048, Q_DK = 2560, Q_DV = 3072, LDQ = 4096;
constexpr int G_RG = 0, G_DZ = 1024, G_GR = 2048, G_GD = 3072, LDG = 4096;
constexpr int C_RQ = 0, C_RG = 2048, C_DQ = 3072, C_DZ = 5120, C_DB = 6144, C_GR = 6160;

constexpr size_t MiB = 1u << 20;
constexpr size_t WS_MOD = 0;
constexpr size_t WS_ROPE = 128 * 1024;
constexpr size_t WS_BA = 1280 * 1024;
constexpr size_t WS_WQKV = 2 * MiB;
constexpr size_t WS_WGATE = 10 * MiB;
constexpr size_t WS_WRO = 18 * MiB, WS_WDO = 20 * MiB, WS_WOUT = 22 * MiB;
constexpr size_t WS_H = 24 * MiB;
constexpr size_t WS_QKV = 48 * MiB;
constexpr size_t WS_MATS_DN = 144 * MiB;
constexpr size_t WS_MATS_RT = 170 * MiB;
constexpr size_t WS_KB = 182 * MiB;
constexpr size_t WS_HALO = 194 * MiB;
constexpr size_t WS_O = 196 * MiB;
constexpr size_t WS_END = 244 * MiB;
constexpr size_t WS_AR = 144 * MiB, WS_AD = 168 * MiB, WS_MERGED = 144 * MiB;
constexpr size_t WS_WF1 = 144 * MiB, WS_WF2 = 155 * MiB;

struct Params {
  const float* in[21];
  float* out;
  unsigned char* ws;
};
enum { I_XP = 0, I_XS, I_C, I_SRET, I_SDN, I_CCTX, I_WMOD, I_BMOD, I_NORMW, I_WIN, I_CONVW, I_DECAY, I_GNW, I_ALOG, I_DTB, I_DNW, I_WRO, I_WDO, I_WOUT, I_WF1, I_WF2 };

__device__ __forceinline__ float bf2f(unsigned short b) { return __uint_as_float((unsigned)b << 16); }
__device__ __forceinline__ unsigned f2bf(float f) { unsigned u = __float_as_uint(f); return (u + 0x7fffu + ((u >> 16) & 1u)) >> 16; }
__device__ __forceinline__ unsigned pk2(float lo, float hi) { return f2bf(lo) | (f2bf(hi) << 16); }
__device__ __forceinline__ unsigned cvt_pk_bf16(float lo, float hi) { unsigned r; asm volatile("v_cvt_pk_bf16_f32 %0, %1, %2" : "=v"(r) : "v"(lo), "v"(hi)); return r; }
__device__ __forceinline__ float lo_bf(unsigned w) { return __uint_as_float(w << 16); }
__device__ __forceinline__ float hi_bf(unsigned w) { return __uint_as_float(w & 0xffff0000u); }
__device__ __forceinline__ float siluf(float x) { return x / (1.f + __expf(-x)); }
__device__ __forceinline__ float sigmf(float x) { return 1.f / (1.f + __expf(-x)); }
__device__ __forceinline__ float softplusf(float x) { return x > 20.f ? x : log1pf(expf(x)); }
__device__ __forceinline__ float wave_sum(float v) {
#pragma unroll
  for (int o = 1; o < 64; o <<= 1) v += __shfl_xor(v, o);
  return v;
}
__device__ __forceinline__ int cond_of_row(int m) { return m < MCTX ? 0 : 1 + (m - MCTX) / LLAT; }
__device__ __forceinline__ const float* xrow(const Params& p, int m) { return m < MCTX ? p.in[I_XP] + (size_t)m * D : p.in[I_XS] + (size_t)(m - MCTX) * D; }

namespace pg8 {
constexpr int BM = 256, BK = 64, HALF = 128, HTB = HALF * BK * 2, STAGE_BYTES = 8 * HTB, NXCD = 8, WGM = 8;
__host__ __device__ __forceinline__ int lds_byte(int r, int c) { const int st = (r >> 4) * 2 + (c >> 5), rr = r & 15, cc = c & 31, ob = rr * 64 + cc * 2; return st * 1024 + (ob ^ (((ob >> 9) & 1) << 5)); }
__host__ __device__ __forceinline__ void stage_rc(int b, int& R, int& C) { const int st = b / 1024, sb = b % 1024, swz = sb ^ (((sb >> 9) & 1) << 5); R = (st >> 1) * 16 + swz / 64; C = (st & 1) * 32 + (swz % 64) / 2; }
__host__ __device__ __forceinline__ int perm32(int rho) { const int n = rho >> 4, i = rho & 15; return 8 * (i >> 2) + 4 * n + (i & 3); }
struct Unit { int pm, pn; };
struct Gemm { const bf16_t* A; const bf16_t* Bt; int M, N, K; };
struct StaticOrder {
  int nM, nN, nwg, G, c;
  __host__ __device__ void init(int M, int N, int G_, int c_) { nM = M / BM; nN = N / BM; nwg = nM * nN; G = G_; c = c_; }
  __host__ __device__ bool next(int i, Unit& u) const {
    const long L = (long)i * G + c; if (L >= nwg) return false;
    int wgid = (int)L; { const int q = nwg / NXCD, r = nwg % NXCD, xcd = wgid % NXCD, off = wgid / NXCD; wgid = (xcd < r ? xcd * (q + 1) : r * (q + 1) + (xcd - r) * q) + off; }
    const int nig = WGM * nN, gid = wgid / nig, fm = gid * WGM, gsz = (nM - fm) < WGM ? (nM - fm) : WGM;
    u.pm = fm + ((wgid % nig) % gsz); u.pn = (wgid % nig) / gsz; return true;
  }
  __device__ __forceinline__ void a_ready(const Unit&) const {}
  __device__ __forceinline__ void done(const Unit&) const {}
};

template <int MODE  > struct EpiBf16Act {
  static constexpr bool PERM = true, AFTER_DRAIN = false;
  bf16_t* O; int ldc;
  __device__ __forceinline__ void operator()(const f32x4 (&acc)[2][2][4][2], const Unit& u, int wr, int wc, int fr, int fq) const {
    const int row0 = u.pm * BM + wr * 64 + fr, col0 = u.pn * BM + wc * 32 + 8 * fq;
    const bool sg = u.pn >= 8;
#pragma unroll
    for (int ai = 0; ai < 2; ++ai)
#pragma unroll
      for (int m = 0; m < 4; ++m) { bf16_t* rowp = O + (size_t)(row0 + ai * HALF + m * 16) * ldc + col0;
#pragma unroll
        for (int bj = 0; bj < 2; ++bj) { f32x4 v0 = acc[ai][bj][m][0], v1 = acc[ai][bj][m][1];
          if (MODE == 1) {
#pragma unroll
            for (int i = 0; i < 4; ++i) { const float s0 = __builtin_amdgcn_rcpf(1.f + __expf(-v0[i])), s1 = __builtin_amdgcn_rcpf(1.f + __expf(-v1[i]));
              v0[i] = sg ? s0 : v0[i] * s0; v1[i] = sg ? s1 : v1[i] * s1; } }
          u32x4 w; w.x = cvt_pk_bf16(v0[0], v0[1]); w.y = cvt_pk_bf16(v0[2], v0[3]); w.z = cvt_pk_bf16(v1[0], v1[1]); w.w = cvt_pk_bf16(v1[2], v1[3]);
          *(u32x4*)(rowp + bj * HALF) = w; } }
  }
};
struct EpiQKV {
  static constexpr bool PERM = true, AFTER_DRAIN = false;
  bf16_t* O; int ldc; bf16_t* HALO;
  __device__ __forceinline__ void operator()(const f32x4 (&acc)[2][2][4][2], const Unit& u, int wr, int wc, int fr, int fq) const {
    const int row0 = u.pm * BM + wr * 64 + fr, col0 = u.pn * BM + wc * 32 + 8 * fq;
#pragma unroll
    for (int ai = 0; ai < 2; ++ai)
#pragma unroll
      for (int m = 0; m < 4; ++m) { const int row = row0 + ai * HALF + m * 16; bf16_t* rowp = O + (size_t)row * ldc + col0;
#pragma unroll
        for (int bj = 0; bj < 2; ++bj) { const f32x4 v0 = acc[ai][bj][m][0], v1 = acc[ai][bj][m][1];
          u32x4 w; w.x = cvt_pk_bf16(v0[0], v0[1]); w.y = cvt_pk_bf16(v0[2], v0[3]); w.z = cvt_pk_bf16(v1[0], v1[1]); w.w = cvt_pk_bf16(v1[2], v1[3]);
          *(u32x4*)(rowp + bj * HALF) = w;
          if (u.pn >= 8 && ((m == 0 && fr == 0) || (m == 3 && fr == 15)))
            *(u32x4*)(HALO + ((size_t)(row >> 6) * 2 + (m == 3 ? 1 : 0)) * 2048 + (col0 - 2048) + bj * HALF) = w; } }
  }
};
struct EpiGateMul {
  static constexpr bool PERM = true, AFTER_DRAIN = false;
  bf16_t* O; int ldc; const bf16_t* G; int ldg; const bf16_t* Add;
  __device__ __forceinline__ void operator()(const f32x4 (&acc)[2][2][4][2], const Unit& u, int wr, int wc, int fr, int fq) const {
    const int row0 = u.pm * BM + wr * 64 + fr, col0 = u.pn * BM + wc * 32 + 8 * fq;
#pragma unroll
    for (int ai = 0; ai < 2; ++ai)
#pragma unroll
      for (int m = 0; m < 4; ++m) { const size_t r = (size_t)(row0 + ai * HALF + m * 16);
#pragma unroll
        for (int bj = 0; bj < 2; ++bj) { const f32x4 v0 = acc[ai][bj][m][0], v1 = acc[ai][bj][m][1];
          const u32x4 g = *(const u32x4*)(G + r * ldg + col0 + bj * HALF);
          float o[8] = {v0[0] * lo_bf(g.x), v0[1] * hi_bf(g.x), v0[2] * lo_bf(g.y), v0[3] * hi_bf(g.y), v1[0] * lo_bf(g.z), v1[1] * hi_bf(g.z), v1[2] * lo_bf(g.w), v1[3] * hi_bf(g.w)};
          if (Add) { const u32x4 a = *(const u32x4*)(Add + r * ldc + col0 + bj * HALF);
            o[0] += lo_bf(a.x); o[1] += hi_bf(a.x); o[2] += lo_bf(a.y); o[3] += hi_bf(a.y); o[4] += lo_bf(a.z); o[5] += hi_bf(a.z); o[6] += lo_bf(a.w); o[7] += hi_bf(a.w); }
          u32x4 w; w.x = cvt_pk_bf16(o[0], o[1]); w.y = cvt_pk_bf16(o[2], o[3]); w.z = cvt_pk_bf16(o[4], o[5]); w.w = cvt_pk_bf16(o[6], o[7]);
          *(u32x4*)(O + r * ldc + col0 + bj * HALF) = w; } }
  }
};
struct EpiF32 {
  static constexpr bool PERM = false, AFTER_DRAIN = false;
  float* O; int ldc;
  __device__ __forceinline__ void operator()(const f32x4 (&acc)[2][2][4][2], const Unit& u, int wr, int wc, int fr, int fq) const {
    const int row0 = u.pm * BM + wr * 64 + fr, col0 = u.pn * BM + wc * 32 + 4 * fq;
#pragma unroll
    for (int ai = 0; ai < 2; ++ai)
#pragma unroll
      for (int m = 0; m < 4; ++m) { float* rowp = O + (size_t)(row0 + ai * HALF + m * 16) * ldc + col0;
#pragma unroll
        for (int bj = 0; bj < 2; ++bj)
#pragma unroll
          for (int n = 0; n < 2; ++n) *(f32x4*)(rowp + bj * HALF + n * 16) = acc[ai][bj][m][n]; }
  }
};
struct EpiSwiGLU {
  static constexpr bool PERM = true, AFTER_DRAIN = false;
  bf16_t* O; int ldc;
  __device__ __forceinline__ void operator()(const f32x4 (&acc)[2][2][4][2], const Unit& u, int wr, int wc, int fr, int fq) const {
    const int row0 = u.pm * BM + wr * 64 + fr, col0 = u.pn * HALF + wc * 32 + 8 * fq;
#pragma unroll
    for (int ai = 0; ai < 2; ++ai)
#pragma unroll
      for (int m = 0; m < 4; ++m) { bf16_t* rowp = O + (size_t)(row0 + ai * HALF + m * 16) * ldc + col0;
        float o[8];
#pragma unroll
        for (int n = 0; n < 2; ++n)
#pragma unroll
          for (int i = 0; i < 4; ++i) { const float g = acc[ai][0][m][n][i], up = acc[ai][1][m][n][i]; o[4 * n + i] = g * __builtin_amdgcn_rcpf(1.f + __expf(-g)) * up; }
        u32x4 w; w.x = cvt_pk_bf16(o[0], o[1]); w.y = cvt_pk_bf16(o[2], o[3]); w.z = cvt_pk_bf16(o[4], o[5]); w.w = cvt_pk_bf16(o[6], o[7]);
        *(u32x4*)rowp = w; }
  }
};

template <class Epi, class Sched, bool ALIGN_EPI = false, bool SP2 = false>
__device__ __forceinline__ void gemm_phase(LAS unsigned char* lds, const Gemm g, const Sched& S, const Epi& E) {
  int tid_o = threadIdx.x; asm volatile("" : "+v"(tid_o));
  const int tid = tid_o, wid = __builtin_amdgcn_readfirstlane(tid >> 6), lane = tid & 63, wr = wid >> 2, wc = wid & 3, fr = lane & 15, fq = lane >> 4;
  const int K = g.K, nt = K / BK;
  unsigned voffA[2], voffB[2];
#pragma unroll
  for (int i = 0; i < 2; ++i) { int R, C; stage_rc(tid * 16 + i * 8192, R, C); const int Rb = Epi::PERM ? ((R & ~31) + perm32(R & 31)) : R;
    voffA[i] = (unsigned)(R * K + C) * 2u; voffB[i] = (unsigned)(Rb * K + C) * 2u; }
  const size_t kstep = (size_t)(BK * 2);
  const size_t hstep = (size_t)HALF * K * 2;
  const size_t tstep = 2 * hstep;
  const unsigned ldsw = (unsigned)wid * 1024u;
  const int aoff = lds_byte(wr * 64 + fr, fq * 8), boff = lds_byte(wc * 32 + fr, fq * 8);
#define PG8_SA(b, h) (((b) * 2 + (h)) * HTB)
#define PG8_SB(b, h) ((4 + (b) * 2 + (h)) * HTB)
#define PG8_STAGE(bufoff, gbase, voff) do { _Pragma("unroll") for (int _i = 0; _i < 2; ++_i) \
    __builtin_amdgcn_global_load_lds((const unsigned*)((const char*)(gbase) + (voff)[_i]), (LAS unsigned*)(lds + (bufoff) + ldsw + _i * 8192), 16, 0, 0); } while (0)
#define PG8_LDA(dst, b, h) do { _Pragma("unroll") for (int m = 0; m < 4; ++m) _Pragma("unroll") for (int k = 0; k < 2; ++k) dst[m][k] = *(const LAS bf16x8*)(lds + PG8_SA(b, h) + aoff + m * 2048 + k * 1024); } while (0)
#define PG8_LDB(dst, b, h) do { _Pragma("unroll") for (int n = 0; n < 2; ++n) _Pragma("unroll") for (int k = 0; k < 2; ++k) dst[n][k] = *(const LAS bf16x8*)(lds + PG8_SB(b, h) + boff + n * 2048 + k * 1024); } while (0)
#define PG8_MMA(ai, bj, At, Bt) do { __builtin_amdgcn_s_setprio(1); _Pragma("unroll") for (int m = 0; m < 4; ++m) _Pragma("unroll") for (int n = 0; n < 2; ++n) _Pragma("unroll") for (int k = 0; k < 2; ++k) \
    acc[ai][bj][m][n] = __builtin_amdgcn_mfma_f32_16x16x32_bf16(Bt[n][k], At[m][k], acc[ai][bj][m][n], 0, 0, 0); __builtin_amdgcn_s_setprio(0); } while (0)
#define PG8_WAIT_V(n) asm volatile("s_waitcnt vmcnt(" #n ")" ::: "memory")
#define PG8_WAIT_L(n) asm volatile("s_waitcnt lgkmcnt(" #n ")" ::: "memory")
#define PG8_BAR __builtin_amdgcn_s_barrier()
#define PG8_SCHED __builtin_amdgcn_sched_barrier(0)
  Unit cur, nxt; int ui = 0;
  if (!S.next(0, cur)) return;
  f32x4 acc[2][2][4][2];
#pragma unroll
  for (int a = 0; a < 2; ++a)
#pragma unroll
    for (int b = 0; b < 2; ++b)
#pragma unroll
      for (int m = 0; m < 4; ++m)
#pragma unroll
        for (int n = 0; n < 2; ++n) acc[a][b][m][n] = (f32x4){0.f, 0.f, 0.f, 0.f};
  bf16x8 At[4][2], B0[2][2], B1[2][2];
  const char* cA = (const char*)g.A + (size_t)cur.pm * tstep; const char* cB = (const char*)g.Bt + (size_t)cur.pn * tstep;
  S.a_ready(cur);
  if constexpr (SP2) {
    PG8_STAGE(PG8_SB(0, 0), cB, voffB); PG8_STAGE(PG8_SB(0, 1), cB + hstep, voffB); PG8_STAGE(PG8_SA(0, 0), cA, voffA); PG8_STAGE(PG8_SA(0, 1), cA + hstep, voffA);
    if (wr == 1) PG8_BAR;
    PG8_WAIT_V(2); PG8_BAR;
    PG8_STAGE(PG8_SB(1, 0), cB + kstep, voffB); PG8_STAGE(PG8_SA(1, 0), cA + kstep, voffA); PG8_STAGE(PG8_SB(1, 1), cB + hstep + kstep, voffB);
    PG8_WAIT_V(6); PG8_BAR;
  } else {
    PG8_STAGE(PG8_SB(0, 0), cB, voffB); PG8_STAGE(PG8_SA(0, 0), cA, voffA); PG8_STAGE(PG8_SB(0, 1), cB + hstep, voffB); PG8_STAGE(PG8_SA(0, 1), cA + hstep, voffA);
    if (wr == 1) PG8_BAR;
    PG8_WAIT_V(4); PG8_BAR;
    PG8_STAGE(PG8_SB(1, 0), cB + kstep, voffB); PG8_STAGE(PG8_SA(1, 0), cA + kstep, voffA); PG8_STAGE(PG8_SB(1, 1), cB + hstep + kstep, voffB);
    PG8_WAIT_V(6); PG8_BAR;
  }
  for (;;) {
    const bool has_next = S.next(ui + 1, nxt);
    const char* nA = has_next ? (const char*)g.A + (size_t)nxt.pm * tstep : cA; const char* nB = has_next ? (const char*)g.Bt + (size_t)nxt.pn * tstep : cB;
    for (int t = 0; t < nt; t += 2) {
      const bool last = (t == nt - 2);
      const char* a1 = cA + (size_t)(t + 1) * kstep;
      const char* a2 = last ? nA : cA + (size_t)(t + 2) * kstep; const char* b2 = last ? nB : cB + (size_t)(t + 2) * kstep;
      const char* a3 = a2 + kstep; const char* b3 = b2 + kstep;
      if (last && has_next) S.a_ready(nxt);
      if constexpr (SP2) {
        PG8_LDB(B0, 0, 0); PG8_LDB(B1, 0, 1); PG8_SCHED; PG8_LDA(At, 0, 0); PG8_STAGE(PG8_SA(1, 1), a1 + hstep, voffA);
        PG8_WAIT_V(8); PG8_WAIT_L(0); PG8_BAR; PG8_MMA(0, 0, At, B0); PG8_MMA(0, 1, At, B1); PG8_BAR; PG8_SCHED;
        PG8_LDA(At, 0, 1); PG8_STAGE(PG8_SB(0, 0), b2, voffB); PG8_STAGE(PG8_SB(0, 1), b2 + hstep, voffB); PG8_STAGE(PG8_SA(0, 0), a2, voffA);
        PG8_WAIT_V(8); PG8_WAIT_L(0); PG8_BAR; PG8_MMA(1, 0, At, B0); PG8_MMA(1, 1, At, B1); PG8_BAR; PG8_SCHED;
        PG8_LDB(B0, 1, 0); PG8_LDB(B1, 1, 1); PG8_SCHED; PG8_LDA(At, 1, 0); PG8_STAGE(PG8_SA(0, 1), a2 + hstep, voffA);
        PG8_WAIT_V(8); PG8_WAIT_L(0); PG8_BAR; PG8_MMA(0, 0, At, B0); PG8_MMA(0, 1, At, B1); PG8_BAR; PG8_SCHED;
        PG8_LDA(At, 1, 1); PG8_STAGE(PG8_SB(1, 0), b3, voffB); PG8_STAGE(PG8_SB(1, 1), b3 + hstep, voffB); PG8_STAGE(PG8_SA(1, 0), a3, voffA);
        PG8_WAIT_V(8); PG8_WAIT_L(0); PG8_BAR; PG8_MMA(1, 0, At, B0); PG8_MMA(1, 1, At, B1); PG8_BAR; PG8_SCHED;
      } else {
        PG8_LDB(B0, 0, 0); PG8_SCHED; PG8_LDA(At, 0, 0); PG8_STAGE(PG8_SA(1, 1), a1 + hstep, voffA);
        PG8_WAIT_L(8); PG8_BAR; PG8_WAIT_L(0); PG8_MMA(0, 0, At, B0); PG8_BAR; PG8_SCHED;
        PG8_LDB(B1, 0, 1); PG8_STAGE(PG8_SB(0, 0), b2, voffB);
        PG8_BAR; PG8_WAIT_L(0); PG8_MMA(0, 1, At, B1); PG8_BAR;
        PG8_LDA(At, 0, 1); PG8_STAGE(PG8_SA(0, 0), a2, voffA);
        PG8_BAR; PG8_WAIT_L(0); PG8_MMA(1, 0, At, B0); PG8_BAR; PG8_SCHED;
        PG8_STAGE(PG8_SB(0, 1), b2 + hstep, voffB);
        PG8_WAIT_V(6); PG8_BAR; PG8_MMA(1, 1, At, B1); PG8_BAR;
        PG8_LDB(B0, 1, 0); PG8_SCHED; PG8_LDA(At, 1, 0); PG8_STAGE(PG8_SA(0, 1), a2 + hstep, voffA);
        PG8_WAIT_L(8); PG8_BAR; PG8_WAIT_L(0); PG8_MMA(0, 0, At, B0); PG8_BAR; PG8_SCHED;
        PG8_LDB(B1, 1, 1); PG8_STAGE(PG8_SB(1, 0), b3, voffB);
        PG8_BAR; PG8_WAIT_L(0); PG8_MMA(0, 1, At, B1); PG8_BAR;
        PG8_LDA(At, 1, 1); PG8_STAGE(PG8_SA(1, 0), a3, voffA);
        PG8_BAR; PG8_WAIT_L(0); PG8_MMA(1, 0, At, B0); PG8_BAR; PG8_SCHED;
        PG8_STAGE(PG8_SB(1, 1), b3 + hstep, voffB);
        PG8_WAIT_V(6); PG8_BAR; PG8_MMA(1, 1, At, B1); PG8_BAR;
      }
    }
    if constexpr (ALIGN_EPI) { if (wr == 0) PG8_BAR; }
    if constexpr (!Epi::AFTER_DRAIN) { E(acc, cur, wr, wc, fr, fq); S.done(cur); }
    if (!has_next) break;
#pragma unroll
    for (int a = 0; a < 2; ++a)
#pragma unroll
      for (int b = 0; b < 2; ++b)
#pragma unroll
        for (int m = 0; m < 4; ++m)
#pragma unroll
          for (int n = 0; n < 2; ++n) acc[a][b][m][n] = (f32x4){0.f, 0.f, 0.f, 0.f};
    cur = nxt; cA = nA; cB = nB; ++ui;
    if constexpr (ALIGN_EPI) { if (wr == 1) PG8_BAR; }
  }
  PG8_WAIT_V(0);
  if constexpr (!ALIGN_EPI) { if (wr == 0) PG8_BAR; }
  PG8_BAR;
#undef PG8_SA
#undef PG8_SB
#undef PG8_STAGE
#undef PG8_LDA
#undef PG8_LDB
#undef PG8_MMA
#undef PG8_WAIT_V
#undef PG8_WAIT_L
#undef PG8_BAR
#undef PG8_SCHED
}
}

typedef float f32x16 __attribute__((ext_vector_type(16)));
typedef float f32x8 __attribute__((ext_vector_type(8)));
typedef short s16x4 __attribute__((ext_vector_type(4)));
typedef __bf16 bfx8 __attribute__((ext_vector_type(8)));
#define MFMA32(a, b, c) __builtin_amdgcn_mfma_f32_32x32x16_bf16((a), (b), (c), 0, 0, 0)
__device__ __forceinline__ bf16x8 cvt8(f32x8 t) { return __builtin_bit_cast(bf16x8, __builtin_convertvector(t, bfx8)); }
__device__ __forceinline__ bf16x8 pack8(const f32x16& x, int s) {
  const f32x8 t = {x[8 * s], x[8 * s + 1], x[8 * s + 2], x[8 * s + 3], x[8 * s + 4], x[8 * s + 5], x[8 * s + 6], x[8 * s + 7]};
  return cvt8(t);
}
__device__ __forceinline__ f32x16 zero16() { f32x16 z; for (int i = 0; i < 16; ++i) z[i] = 0.f; return z; }
__device__ __forceinline__ unsigned off_b(unsigned row, unsigned ch) { return 256u * row + 16u * (ch ^ (((row & 3u) << 2) | ((row >> 2) & 3u))); }
__device__ __forceinline__ int swap12(int p) { return ((p & 1) << 1) | (p >> 1); }
__device__ __forceinline__ bf16x8 lds_rd128(LAS unsigned char* lds, unsigned off) { return *(const LAS bf16x8*)(lds + off); }
__device__ __forceinline__ bf16x8 lds_tr2(LAS unsigned char* lds, unsigned off_lo, unsigned off_hi) {
  const s16x4 lo = __builtin_amdgcn_ds_read_tr16_b64_v4i16((LAS s16x4*)(lds + off_lo));
  const s16x4 hi = __builtin_amdgcn_ds_read_tr16_b64_v4i16((LAS s16x4*)(lds + off_hi));
  return __builtin_shufflevector(lo, hi, 0, 1, 2, 3, 4, 5, 6, 7);
}
__device__ __forceinline__ void glds16(const void* g, LAS unsigned char* l) { __builtin_amdgcn_global_load_lds((const unsigned*)g, (LAS unsigned*)l, 16, 0, 0); }
__device__ __forceinline__ unsigned rowfrag_off(int lane, int mt, int ks) { return off_b(32 * mt + (lane & 31), 2 * ks + (lane >> 5)); }
__device__ __forceinline__ unsigned vtr_off(int lane, int cb, int ks, int sec) {
  const int g = lane >> 4, i = lane & 15, hh = g >> 1, half16 = g & 1, qq = i >> 2, p = i & 3;
  const int row = 16 * ks + 4 * hh + 8 * sec + qq, col = cb + 16 * half16 + 4 * p;
  return off_b(row, col >> 3) + (col & 7) * 2;
}
__device__ __forceinline__ unsigned ktr_off(int lane, int mt, int ks, int sec) {
  const int g = lane >> 4, i = lane & 15, hh = g >> 1, half16 = g & 1, qq = i >> 2, p = i & 3;
  const int row = 16 * ks + 4 * hh + 8 * sec + qq, col = 32 * mt + 16 * half16 + 4 * swap12(p);
  return off_b(row, col >> 3) + (col & 7) * 2;
}
__device__ __forceinline__ int crow(int reg, int h) { return (reg & 3) + 8 * (reg >> 2) + 4 * h; }
__device__ __forceinline__ int srow(int reg, int h) { return 16 * (reg >> 3) + 8 * h + 4 * ((reg >> 2) & 1) + (reg & 3); }
__device__ __forceinline__ void rowscale(f32x16& a, const LAS float* vec, int h, float sgn) {
#pragma unroll
  for (int g4 = 0; g4 < 4; ++g4) { const f32x4 s = *(const LAS f32x4*)(vec + 8 * g4 + 4 * h);
    a[4 * g4] *= s.x * sgn; a[4 * g4 + 1] *= s.y * sgn; a[4 * g4 + 2] *= s.z * sgn; a[4 * g4 + 3] *= s.w * sgn; }
}
__device__ __forceinline__ void stage_img_piece(const unsigned char* src, size_t pitch, LAS unsigned char* img, int pc, int lane) {
  const unsigned row = 4 * pc + (lane >> 4), chp = lane & 15, ch = chp ^ (((row & 3u) << 2) | ((row >> 2) & 3u));
  glds16(src + (size_t)row * pitch + ch * 16, img + 1024 * pc);
}
constexpr int SC_BUF = 50176, SC_Q = 0, SC_K = 16384, SC_M = 32768, SC_V = 2 * SC_BUF, SC_VEC = SC_V + 32768;
constexpr int DN_BLOB = 17408, RT_BLOB = 8192;
__device__ __forceinline__ void scan_stage(LAS unsigned char* lds, int buf, int type, int dir, int h, int gc, const bf16_t* QKV, const bf16_t* KBUF,
                                           const unsigned char* MATS_RT, const unsigned char* MATS_DN, int w, int lane) {
  const size_t row0 = (size_t)gc * 64;
  const unsigned char* rowp = (const unsigned char*)(QKV + row0 * LDQ);
  const unsigned char* qsrc = rowp + (type ? Q_DQ + h * DK : Q_RQ + h * DK) * 2;
  const unsigned char* ksrc = rowp + (type ? Q_DK + h * DK : Q_RK + h * DK) * 2; size_t kpitch = LDQ * 2;
  if (!type && dir) { ksrc = (const unsigned char*)(KBUF + row0 * 512 + h * DK); kpitch = 1024; }
  const unsigned char* vsrc = rowp + (type ? Q_DV + h * DV : Q_RV + h * DV) * 2;
  LAS unsigned char* B = lds + buf * SC_BUF;
#pragma unroll
  for (int i = 0; i < 2; ++i) { const int pc = w + 8 * i;
    stage_img_piece(qsrc, LDQ * 2, B + SC_Q, pc, lane); stage_img_piece(ksrc, kpitch, B + SC_K, pc, lane);
    stage_img_piece(vsrc, LDQ * 2, lds + SC_V, pc, lane); stage_img_piece(vsrc + 256, LDQ * 2, lds + SC_V + 16384, pc, lane); }
  const unsigned char* blob = type ? MATS_DN + (size_t)((gc * 4 + h) * 2 + dir) * DN_BLOB : MATS_RT + (size_t)((gc * 4 + h) * 2 + dir) * RT_BLOB;
  const int np = type ? 17 : 8;
  for (int pc = w; pc < np; pc += 8) glds16(blob + pc * 1024 + lane * 16, B + SC_M + pc * 1024);
}

__device__ __forceinline__ void transpose_item(const float* W, int ldw, int K, int src_col0, bf16_t* WT, int dst_row0, int k0, LAS float* scr, int lane) {
#pragma unroll 8
  for (int i = 0; i < 32; ++i) { const int kk = 2 * i + (lane >> 5); scr[kk * 33 + (lane & 31)] = W[(size_t)(k0 + kk) * ldw + src_col0 + (lane & 31)]; }
  asm volatile("s_waitcnt lgkmcnt(0)" ::: "memory");
  const int c = lane & 7;
#pragma unroll
  for (int j = 0; j < 4; ++j) { const int n = (lane >> 3) + 8 * j; const LAS float* s = scr + (8 * c) * 33 + n;
    u32x4 o; o.x = pk2(s[0 * 33], s[1 * 33]); o.y = pk2(s[2 * 33], s[3 * 33]); o.z = pk2(s[4 * 33], s[5 * 33]); o.w = pk2(s[6 * 33], s[7 * 33]);
    *(u32x4*)(WT + (size_t)(dst_row0 + n) * K + k0 + 8 * c) = o; }
  asm volatile("s_waitcnt lgkmcnt(0)" ::: "memory");
}

template <class ColMap> __device__ __forceinline__ void transpose_matrix(const float* W, int ldw, int K, int N, bf16_t* WT, ColMap cm, LAS float* scr, int gw, int ngw, int lane) {
  const int nblk = N / 32, items = (K / 64) * nblk;
  for (int it = gw; it < items; it += ngw) { const int kb = it / nblk, nb = it % nblk; transpose_item(W, ldw, K, cm(32 * nb), WT, 32 * nb, 64 * kb, scr, lane); }
}

__global__ void __launch_bounds__(NTHREADS) fwd_megakernel(Params p) {
  extern __shared__ __attribute__((aligned(16))) unsigned char lds_raw[];
  LAS unsigned char* lds = (LAS unsigned char*)lds_raw;
  cg::grid_group grid = cg::this_grid();
  const int wave = __builtin_amdgcn_readfirstlane(threadIdx.x >> 6);
#define PHASE_TID() int tid_p = threadIdx.x; asm volatile("" : "+v"(tid_p)); const int tid = tid_p, lane = tid & 63; (void)lane;
  const int G = gridDim.x, bid = blockIdx.x;
  const int gw = bid * NWAVES + wave, ngw = G * NWAVES;
  unsigned char* ws = p.ws;
  float* MOD = (float*)(ws + WS_MOD);
  f32x2* ROPE = (f32x2*)(ws + WS_ROPE);
  float* BA = (float*)(ws + WS_BA);
  float* DECLG = (float*)(ws + WS_MOD + 122880);
  bf16_t* WQKV = (bf16_t*)(ws + WS_WQKV); bf16_t* WGATE = (bf16_t*)(ws + WS_WGATE);
  bf16_t* WRO = (bf16_t*)(ws + WS_WRO); bf16_t* WDO = (bf16_t*)(ws + WS_WDO); bf16_t* WOUT = (bf16_t*)(ws + WS_WOUT);
  bf16_t* HB = (bf16_t*)(ws + WS_H);
  bf16_t* QKV = (bf16_t*)(ws + WS_QKV);
  bf16_t* KBUF = (bf16_t*)(ws + WS_KB); bf16_t* HALO = (bf16_t*)(ws + WS_HALO);
  unsigned char* MATS_RT = ws + WS_MATS_RT; unsigned char* MATS_DN = ws + WS_MATS_DN;
  bf16_t* ODF = (bf16_t*)(ws + WS_O); bf16_t* ODB = ODF + (size_t)MTOT * D;
  bf16_t* ORF = (bf16_t*)p.out; bf16_t* ORB = ORF + (size_t)MTOT * D;
  float* NS_RET = p.out + (size_t)MTOT * D; float* NS_DN = NS_RET + (size_t)NCTX * 2 * NH * DK * DV;

  {
    PHASE_TID();
    LAS float* scr = (LAS float*)(lds + wave * 16384);
    transpose_matrix(p.in[I_WIN], INC, D, 4096, WQKV, [](int n) { return n < 2048 ? n : n + 1024; }, scr, gw, ngw, lane);
    transpose_matrix(p.in[I_WIN], INC, D, 4096, WGATE, [](int n) { return n < 1024 ? C_RG + n : (n < 2048 ? C_DZ + (n - 1024) : C_GR + (n - 2048)); }, scr, gw, ngw, lane);
    transpose_matrix(p.in[I_WRO], D, D, D, WRO, [](int n) { return n; }, scr, gw, ngw, lane);
    transpose_matrix(p.in[I_WDO], D, D, D, WDO, [](int n) { return n; }, scr, gw, ngw, lane);
    transpose_matrix(p.in[I_WOUT], D, D, D, WOUT, [](int n) { return n; }, scr, gw, ngw, lane);
    for (int it = gw; it < 6 * D / 64; it += ngw) {
      const int n = it * 64 + lane;
      float acc[5] = {0.f, 0.f, 0.f, 0.f, 0.f};
      const float* wm = p.in[I_WMOD] + n;
#pragma unroll 4
      for (int k = 0; k < D; ++k) { const float w = wm[(size_t)k * 6 * D];
        acc[0] += siluf(p.in[I_CCTX][k]) * w;
#pragma unroll
        for (int j = 0; j < 4; ++j) acc[1 + j] += siluf(p.in[I_C][j * D + k]) * w; }
      const float b = p.in[I_BMOD][n];
#pragma unroll
      for (int j = 0; j < 5; ++j) MOD[j * 6 * D + n] = acc[j] + b;
    }
    for (int i = bid * NTHREADS + tid; i < LLAT * 64; i += G * NTHREADS) { const int l = i >> 6, pr = i & 63;
      const float freq = powf(10000.f, -(float)(pr & 31) / 32.f); const float ang = (pr < 32 ? (float)(l >> 6) : (float)(l & 63)) * freq;
      ROPE[i] = (f32x2){cosf(ang), sinf(ang)}; }
    if (bid == 0 && tid < 8) DECLG[tid] = -softplusf(-p.in[I_DECAY][tid]);
  }
  grid.sync();

  {
    PHASE_TID();
    LAS float* wba = (LAS float*)lds;
    for (int i = tid; i < D * 16; i += NTHREADS) wba[i] = p.in[I_WIN][(size_t)(i >> 4) * INC + C_DB + (i & 15)];
    __syncthreads();
    const float* nw = p.in[I_NORMW];
    for (int m = gw; m < MTOT; m += ngw) {
      const float* xr = xrow(p, m); const float* md = MOD + (size_t)cond_of_row(m) * 6 * D;
      float s = 0.f;
#pragma unroll
      for (int j = 0; j < 4; ++j) { const f32x4 x4 = *(const f32x4*)(xr + 4 * lane + 256 * j); s += (x4.x * x4.x + x4.y * x4.y) + (x4.z * x4.z + x4.w * x4.w); }
      const float r = rsqrtf(wave_sum(s) * (1.f / D) + EPS);
      float dots[16];
#pragma unroll
      for (int n = 0; n < 16; ++n) dots[n] = 0.f;
#pragma unroll 1
      for (int j = 0; j < 4; ++j) { const int c0 = 4 * lane + 256 * j;
        const f32x4 x4 = *(const f32x4*)(xr + c0);
        const f32x4 w4 = *(const f32x4*)(nw + c0), sc = *(const f32x4*)(md + D + c0), sh = *(const f32x4*)(md + c0);
        f32x4 h = x4 * r * w4 * (sc + 1.f) + sh;
        u32x2 o; o.x = pk2(h.x, h.y); o.y = pk2(h.z, h.w);
        *(u32x2*)(HB + (size_t)m * D + c0) = o;
#pragma unroll
        for (int e = 0; e < 4; ++e) {
#pragma unroll
          for (int q = 0; q < 4; ++q) { const f32x4 wv = *(const LAS f32x4*)(wba + (c0 + e) * 16 + 4 * q);
            dots[4 * q + 0] += h[e] * wv.x; dots[4 * q + 1] += h[e] * wv.y; dots[4 * q + 2] += h[e] * wv.z; dots[4 * q + 3] += h[e] * wv.w; } }
      }
#pragma unroll
      for (int n = 0; n < 16; ++n) dots[n] = wave_sum(dots[n]);
      if (lane < 8) {
        float db = dots[0], da = dots[8];
#pragma unroll
        for (int n = 1; n < 8; ++n) { db = lane == n ? dots[n] : db; da = lane == n ? dots[8 + n] : da; }
        BA[(size_t)m * 16 + lane] = sigmf(db);
        BA[(size_t)m * 16 + 8 + lane] = -expf(p.in[I_ALOG][lane]) * softplusf(da + p.in[I_DTB][lane]);
      }
    }
  }
  grid.sync();

  {
    pg8::Gemm g{HB, WQKV, MTOT, 4096, D}; pg8::StaticOrder S; S.init(MTOT, 4096, G, bid);
    pg8::EpiQKV E{QKV, LDQ, HALO};
    pg8::gemm_phase<pg8::EpiQKV, pg8::StaticOrder, true, true>(lds, g, S, E);
  }
  grid.sync();

  {
    PHASE_TID();
    constexpr int PI_RQ = 0, PI_RK = 16384, PI_DQ = 32768, PI_DK = 49152;
    constexpr int PM_QKR = 65536, PM_QKD = PM_QKR + 17408, PM_KKD = PM_QKD + 17408;
    constexpr int PV = PM_KKD + 17408;
    constexpr int PL_F = 0, PL_B = 17408, PT_F = 34816, PT_B = 52224;
    const int w = wave;
    const float* cw = p.in[I_CONVW];
    for (int item = bid; item < 768; item += G) {
      int tid_o = threadIdx.x; asm volatile("" : "+v"(tid_o));
      const int tid = tid_o, lane = tid & 63, r32 = lane & 31, hl = lane >> 5;
      const int gc = item >> 2, h = item & 3, row0 = gc * 64; const bool lat = row0 >= MCTX;
      const int L = lat ? LLAT : LCTX, t0 = lat ? ((row0 - MCTX) & (LLAT - 1)) : (row0 & (LCTX - 1));
      const float lgf = DECLG[h], lgb = DECLG[4 + h];
      __syncthreads();
      {
        const int row = tid >> 3; const size_t m = (size_t)row0 + row;
        const float kfs = __expf(lgf * (float)(63 - row)), kbs = __expf(lgb * (float)row);
#pragma unroll
        for (int c = 0; c < 2; ++c) { const int ch = (tid & 7) * 2 + c;
          bf16_t* qp = QKV + m * LDQ + Q_RQ + h * DK + ch * 8; bf16_t* kp = QKV + m * LDQ + Q_RK + h * DK + ch * 8;
          const u32x4 qw = *(const u32x4*)qp, kw = *(const u32x4*)kp;
          float q[8] = {lo_bf(qw.x), hi_bf(qw.x), lo_bf(qw.y), hi_bf(qw.y), lo_bf(qw.z), hi_bf(qw.z), lo_bf(qw.w), hi_bf(qw.w)};
          float k[8] = {lo_bf(kw.x), hi_bf(kw.x), lo_bf(kw.y), hi_bf(kw.y), lo_bf(kw.z), hi_bf(kw.z), lo_bf(kw.w), hi_bf(kw.w)};
#pragma unroll
          for (int e = 0; e < 8; ++e) q[e] *= QSCALE;
          if (lat) {
#pragma unroll
            for (int e = 0; e < 4; ++e) { const f32x2 cs = ROPE[(t0 + row) * 64 + ch * 4 + e];
              const float a = q[2 * e] * cs.x - q[2 * e + 1] * cs.y, b = q[2 * e] * cs.y + q[2 * e + 1] * cs.x; q[2 * e] = a; q[2 * e + 1] = b;
              const float c2 = k[2 * e] * cs.x - k[2 * e + 1] * cs.y, d2 = k[2 * e] * cs.y + k[2 * e + 1] * cs.x; k[2 * e] = c2; k[2 * e + 1] = d2; }
          }
          u32x4 o; o.x = pk2(q[0], q[1]); o.y = pk2(q[2], q[3]); o.z = pk2(q[4], q[5]); o.w = pk2(q[6], q[7]);
          *(u32x4*)qp = o; *(LAS u32x4*)(lds + PI_RQ + off_b(row, ch)) = o;
          o.x = pk2(k[0], k[1]); o.y = pk2(k[2], k[3]); o.z = pk2(k[4], k[5]); o.w = pk2(k[6], k[7]);
          *(LAS u32x4*)(lds + PI_RK + off_b(row, ch)) = o;
          o.x = pk2(k[0] * kfs, k[1] * kfs); o.y = pk2(k[2] * kfs, k[3] * kfs); o.z = pk2(k[4] * kfs, k[5] * kfs); o.w = pk2(k[6] * kfs, k[7] * kfs);
          *(u32x4*)kp = o;
          o.x = pk2(k[0] * kbs, k[1] * kbs); o.y = pk2(k[2] * kbs, k[3] * kbs); o.z = pk2(k[4] * kbs, k[5] * kbs); o.w = pk2(k[6] * kbs, k[7] * kbs);
          *(u32x4*)(KBUF + m * 512 + h * DK + ch * 8) = o;
        }
      }
      {
        const int ch = tid & 15;
        u32x4 raw[2][2][3];
#pragma unroll
        for (int ps = 0; ps < 2; ++ps)
#pragma unroll
          for (int wh = 0; wh < 2; ++wh)
#pragma unroll
            for (int wd = 0; wd < 3; ++wd) { const int row = (tid >> 4) + 32 * ps, rr = row + wd - 1, t = t0 + rr; const int dch = wh * 512 + h * DK + ch * 8;
              u32x4 x = (u32x4){0u, 0u, 0u, 0u};
              if (t >= 0 && t < L) {
                if (rr < 0) x = *(const u32x4*)(HALO + ((size_t)(gc - 1) * 2 + 1) * 2048 + dch);
                else if (rr > 63) x = *(const u32x4*)(HALO + ((size_t)(gc + 1) * 2 + 0) * 2048 + dch);
                else x = *(const u32x4*)(QKV + (size_t)(row0 + rr) * LDQ + Q_DQ + dch); }
              raw[ps][wh][wd] = x; }
        __syncthreads();
#pragma unroll
        for (int ps = 0; ps < 2; ++ps)
#pragma unroll
          for (int wh = 0; wh < 2; ++wh) { const int row = (tid >> 4) + 32 * ps; const int dch = wh * 512 + h * DK + ch * 8;
            float a[8] = {0.f, 0.f, 0.f, 0.f, 0.f, 0.f, 0.f, 0.f};
#pragma unroll
            for (int wd = 0; wd < 3; ++wd) { const u32x4 x = raw[ps][wh][wd]; const f32x4 w0 = *(const f32x4*)(cw + wd * 2048 + dch), w1 = *(const f32x4*)(cw + wd * 2048 + dch + 4);
              a[0] += lo_bf(x.x) * w0.x; a[1] += hi_bf(x.x) * w0.y; a[2] += lo_bf(x.y) * w0.z; a[3] += hi_bf(x.y) * w0.w;
              a[4] += lo_bf(x.z) * w1.x; a[5] += hi_bf(x.z) * w1.y; a[6] += lo_bf(x.w) * w1.z; a[7] += hi_bf(x.w) * w1.w; }
            float ss = 0.f;
#pragma unroll
            for (int e = 0; e < 8; ++e) { a[e] = siluf(a[e]); ss += a[e] * a[e]; }
            ss += __shfl_xor(ss, 1); ss += __shfl_xor(ss, 2); ss += __shfl_xor(ss, 4); ss += __shfl_xor(ss, 8);
            const float sc = rsqrtf(ss + EPS) * (wh == 0 ? QSCALE : 1.f);
            u32x4 o; o.x = pk2(a[0] * sc, a[1] * sc); o.y = pk2(a[2] * sc, a[3] * sc); o.z = pk2(a[4] * sc, a[5] * sc); o.w = pk2(a[6] * sc, a[7] * sc);
            *(u32x4*)(QKV + (size_t)(row0 + row) * LDQ + Q_DQ + dch) = o;
            *(LAS u32x4*)(lds + (wh ? PI_DK : PI_DQ) + off_b(row, ch)) = o; }
      }
      {
        u32x4 raw[4][3];
#pragma unroll
        for (int n = 0; n < 4; ++n)
#pragma unroll
          for (int wd = 0; wd < 3; ++wd) { const int idx = tid + 512 * n, row = idx >> 5, ch = idx & 31, rr = row + wd - 1, t = t0 + rr; const int dch = 1024 + h * DV + ch * 8;
            u32x4 x = (u32x4){0u, 0u, 0u, 0u};
            if (t >= 0 && t < L) {
              if (rr < 0) x = *(const u32x4*)(HALO + ((size_t)(gc - 1) * 2 + 1) * 2048 + dch);
              else if (rr > 63) x = *(const u32x4*)(HALO + ((size_t)(gc + 1) * 2 + 0) * 2048 + dch);
              else x = *(const u32x4*)(QKV + (size_t)(row0 + rr) * LDQ + Q_DQ + dch); }
            raw[n][wd] = x; }
        __syncthreads();
#pragma unroll
        for (int n = 0; n < 4; ++n) { const int idx = tid + 512 * n, row = idx >> 5, ch = idx & 31; const int dch = 1024 + h * DV + ch * 8;
          float a[8] = {0.f, 0.f, 0.f, 0.f, 0.f, 0.f, 0.f, 0.f};
#pragma unroll
          for (int wd = 0; wd < 3; ++wd) { const u32x4 x = raw[n][wd]; const f32x4 w0 = *(const f32x4*)(cw + wd * 2048 + dch), w1 = *(const f32x4*)(cw + wd * 2048 + dch + 4);
            a[0] += lo_bf(x.x) * w0.x; a[1] += hi_bf(x.x) * w0.y; a[2] += lo_bf(x.y) * w0.z; a[3] += hi_bf(x.y) * w0.w;
            a[4] += lo_bf(x.z) * w1.x; a[5] += hi_bf(x.z) * w1.y; a[6] += lo_bf(x.w) * w1.z; a[7] += hi_bf(x.w) * w1.w; }
          u32x4 o; o.x = pk2(siluf(a[0]), siluf(a[1])); o.y = pk2(siluf(a[2]), siluf(a[3])); o.z = pk2(siluf(a[4]), siluf(a[5])); o.w = pk2(siluf(a[6]), siluf(a[7]));
          *(u32x4*)(QKV + (size_t)(row0 + row) * LDQ + Q_DQ + dch) = o; }
      }
      __syncthreads();
      {
        const int mi = (w >> 1) & 1, nj = w & 1;
        if (w < 4) {
          f32x16 a1 = zero16(), a2 = zero16();
#pragma unroll 2
          for (int ks = 0; ks < 8; ++ks) { a1 = MFMA32(lds_rd128(lds + PI_RQ, rowfrag_off(lane, mi, ks)), lds_rd128(lds + PI_RK, rowfrag_off(lane, nj, ks)), a1);
            a2 = MFMA32(lds_rd128(lds + PI_DQ, rowfrag_off(lane, mi, ks)), lds_rd128(lds + PI_DK, rowfrag_off(lane, nj, ks)), a2); }
          LAS float* m1 = (LAS float*)(lds + PM_QKR); LAS float* m2 = (LAS float*)(lds + PM_QKD);
#pragma unroll
          for (int reg = 0; reg < 16; ++reg) { const int o = (32 * mi + crow(reg, hl)) * 68 + 32 * nj + r32; m1[o] = a1[reg]; m2[o] = a2[reg]; }
        } else {
          f32x16 a1 = zero16();
#pragma unroll 2
          for (int ks = 0; ks < 8; ++ks) a1 = MFMA32(lds_rd128(lds + PI_DK, rowfrag_off(lane, mi, ks)), lds_rd128(lds + PI_DK, rowfrag_off(lane, nj, ks)), a1);
          LAS float* m1 = (LAS float*)(lds + PM_KKD);
#pragma unroll
          for (int reg = 0; reg < 16; ++reg) m1[(32 * mi + crow(reg, hl)) * 68 + 32 * nj + r32] = a1[reg];
        }
      }
      LAS float* vecs = (LAS float*)(lds + PV);
      if (tid < 64) {
        const float* ba = BA + (size_t)(row0 + tid) * 16;
        const float bf = ba[h], bb = ba[4 + h], af = ba[8 + h], ab = ba[12 + h];
        float xf = af, xb = ab;
#pragma unroll
        for (int o = 1; o < 64; o <<= 1) { const float yf = __shfl_up(xf, o), yb = __shfl_up(xb, o); if (lane >= o) { xf += yf; xb += yb; } }
        const float totf = __shfl(xf, 63), totb = __shfl(xb, 63);
        vecs[tid] = bf; vecs[64 + tid] = bb; vecs[128 + tid] = xf; vecs[192 + tid] = totb - xb + ab;
        if (tid == 0) { vecs[256] = totf; vecs[257] = totb; }
      }
      __syncthreads();
      unsigned char* blob_rt = MATS_RT + (size_t)((gc * 4 + h) * 2) * RT_BLOB; unsigned char* blob_dn = MATS_DN + (size_t)((gc * 4 + h) * 2) * DN_BLOB;
      const int lp = tid & 63, fi = tid >> 6, fmt = fi >> 2, fks = fi & 3, frow = 32 * fmt + (lp & 31), fhq = lp >> 5;
      {
        const LAS float* m1 = (const LAS float*)(lds + PM_QKR); const LAS float* m2 = (const LAS float*)(lds + PM_QKD);
        const float gfi = vecs[128 + frow], gbi = vecs[192 + frow];
        f32x8 pf, pb, df, db;
#pragma unroll
        for (int jj = 0; jj < 8; ++jj) { const int j = 16 * fks + 8 * (jj >> 2) + 4 * fhq + (jj & 3);
          const float x = m1[frow * 68 + j], y = m2[frow * 68 + j];
          pf[jj] = j <= frow ? x * __expf(lgf * (float)(frow - j)) : 0.f; pb[jj] = j >= frow ? x * __expf(lgb * (float)(j - frow)) : 0.f;
          df[jj] = j <= frow ? y * __expf(gfi - vecs[128 + j]) : 0.f; db[jj] = j >= frow ? y * __expf(gbi - vecs[192 + j]) : 0.f; }
        *(bf16x8*)(blob_rt + (fi * 64 + lp) * 16) = cvt8(pf); *(bf16x8*)(blob_rt + RT_BLOB + (fi * 64 + lp) * 16) = cvt8(pb);
        *(bf16x8*)(blob_dn + 8192 + (fi * 64 + lp) * 16) = cvt8(df); *(bf16x8*)(blob_dn + DN_BLOB + 8192 + (fi * 64 + lp) * 16) = cvt8(db);
        const LAS float* m3 = (const LAS float*)(lds + PM_KKD); LAS float* lf = (LAS float*)(lds + PL_F); LAS float* lb = (LAS float*)(lds + PL_B);
#pragma unroll
        for (int n = 0; n < 8; ++n) { const int e = tid + 512 * n, i = e >> 6, j = e & 63; const float kk = m3[i * 68 + j];
          lf[i * 68 + j] = j < i ? vecs[i] * kk * __expf(vecs[128 + i] - vecs[128 + j]) : 0.f;
          lb[i * 68 + j] = j > i ? vecs[64 + i] * kk * __expf(vecs[192 + i] - vecs[192 + j]) : 0.f; }
        if (tid < 64) { const float gf = vecs[128 + tid], gb = vecs[192 + tid], glf = vecs[256], glb = vecs[257];
          float* vf = (float*)(blob_dn + 16384); float* vb = (float*)(blob_dn + DN_BLOB + 16384);
          vf[tid] = __expf(gf); vf[64 + tid] = __expf(glf - gf); vb[tid] = __expf(gb); vb[64 + tid] = __expf(glb - gb);
          if (tid == 0) { vf[128] = __expf(glf); vb[128] = __expf(glb); } }
      }
      __syncthreads();
      if (w < 2) {
        const bool flip = (w == 1);
        const LAS float* Lm = (const LAS float*)(lds + (flip ? PL_B : PL_F)); LAS float* Tm = (LAS float*)(lds + (flip ? PT_B : PT_F));
        const int cl = flip ? 63 - lane : lane;
        float T[64];
#pragma unroll
        for (int i = 0; i < 64; ++i) {
          const float lrow = Lm[(flip ? 63 - i : i) * 68 + cl];
          float t = (lane == i) ? 1.f : 0.f;
#pragma unroll
          for (int j = 0; j < i; ++j) t -= __int_as_float(__builtin_amdgcn_readlane(__float_as_int(lrow), j)) * T[j];
          T[i] = t;
          __builtin_amdgcn_sched_barrier(0);
        }
        const float bc = vecs[(flip ? 64 : 0) + cl];
#pragma unroll
        for (int i = 0; i < 64; ++i) Tm[(flip ? 63 - i : i) * 68 + cl] = T[i] * bc;
      }
      __syncthreads();
      {
        const LAS float* tf = (const LAS float*)(lds + PT_F); const LAS float* tb = (const LAS float*)(lds + PT_B);
        f32x8 a, b;
#pragma unroll
        for (int jj = 0; jj < 8; ++jj) { const int j = 16 * fks + 8 * (jj >> 2) + 4 * fhq + (jj & 3); a[jj] = tf[frow * 68 + j]; b[jj] = tb[frow * 68 + j]; }
        *(bf16x8*)(blob_dn + (fi * 64 + lp) * 16) = cvt8(a); *(bf16x8*)(blob_dn + DN_BLOB + (fi * 64 + lp) * 16) = cvt8(b);
      }
    }
  }
  grid.sync();

  {
    PHASE_TID();
    const int w = wave, vsub = w >> 2, cb = (w & 3) * 32;
    LAS float* qdec = (LAS float*)(lds + SC_VEC);
    const int stride = bid < 64 ? 1000000 : (G - 64);
    for (int ci = bid; ci < 320; ci += stride) {
      int tid_c = threadIdx.x; asm volatile("" : "+v"(tid_c));
      const int tid = tid_c, lane = tid & 63, r32 = lane & 31, hl = lane >> 5;
      int type, sq, h, dir, chunk0, nsteps; bool lat;
      if (ci < 64) { lat = true; type = ci >> 5; sq = (ci >> 3) & 3; h = (ci >> 1) & 3; dir = ci & 1; chunk0 = 64 + 32 * sq; nsteps = 32; }
      else { const int c = ci - 64; lat = false; type = c >> 7; sq = (c >> 3) & 15; h = (c >> 1) & 3; dir = c & 1; chunk0 = 4 * sq; nsteps = 4; }
      f32x16 S[4];
      {
        const float* s0 = (type ? p.in[I_SDN] : p.in[I_SRET]) + ((((size_t)sq * 2 + dir) * NH + h) * DK) * DV + 32 * w + r32;
        if (lat) {
#pragma unroll
          for (int mt = 0; mt < 4; ++mt)
#pragma unroll
            for (int reg = 0; reg < 16; ++reg) S[mt][reg] = s0[(size_t)(32 * mt + srow(reg, hl)) * DV];
        } else {
#pragma unroll
          for (int mt = 0; mt < 4; ++mt) S[mt] = zero16();
        }
      }
      const float lg = DECLG[dir * 4 + h];
      const float c64 = __expf(64.f * lg);
      __syncthreads();
      if (tid < 64) qdec[tid] = __expf(lg * (dir ? (float)(64 - tid) : (float)(tid + 1)));
      scan_stage(lds, 0, type, dir, h, chunk0 + (dir ? nsteps - 1 : 0), QKV, KBUF, MATS_RT, MATS_DN, w, lane);
      bf16_t* O = type ? (dir ? ODB : ODF) : (dir ? ORB : ORF);
      for (int s = 0; s < nsteps; ++s) {
        int ln = lane; asm volatile("" : "+v"(ln));
        const int r32s = ln & 31, hls = ln >> 5;
        const int buf = s & 1, gc = chunk0 + (dir ? nsteps - 1 - s : s);
        asm volatile("s_waitcnt vmcnt(0)" ::: "memory");
        __syncthreads();
        bf16x8 Bv[4];
#pragma unroll
        for (int ks = 0; ks < 4; ++ks) Bv[ks] = lds_tr2(lds + SC_V + vsub * 16384, vtr_off(ln, cb, ks, 0), vtr_off(ln, cb, ks, 1));
        __syncthreads();
        if (s + 1 < nsteps) scan_stage(lds, buf ^ 1, type, dir, h, chunk0 + (dir ? nsteps - 2 - s : s + 1), QKV, KBUF, MATS_RT, MATS_DN, w, ln);
        LAS unsigned char* B = lds + buf * SC_BUF;
        bf16_t* ob = O + (size_t)gc * 64 * D + h * DV + 32 * w + r32s;
        if (type) {
          const LAS float* eg = (const LAS float*)(B + SC_M + 16384); const LAS float* cgv = eg + 64; const float egl = eg[128];
          bf16x8 Br[4];
#pragma unroll
          for (int mt = 0; mt < 2; ++mt) { f32x16 ra = zero16();
#pragma unroll
            for (int ks = 0; ks < 8; ++ks) ra = MFMA32(lds_rd128(B + SC_K, rowfrag_off(ln, mt, ks)), pack8(S[ks >> 1], ks & 1), ra);
            rowscale(ra, eg + 32 * mt, hls, -1.f); Br[2 * mt] = pack8(ra, 0); Br[2 * mt + 1] = pack8(ra, 1);
            __builtin_amdgcn_sched_barrier(0); }
          f32x16 vn[2];
#pragma unroll
          for (int mt = 0; mt < 2; ++mt) { vn[mt] = zero16();
#pragma unroll
            for (int ks = 0; ks < 4; ++ks) { const bf16x8 tf = lds_rd128(B + SC_M, (mt * 4 + ks) * 1024 + ln * 16);
              vn[mt] = MFMA32(tf, Bv[ks], vn[mt]); vn[mt] = MFMA32(tf, Br[ks], vn[mt]); }
            __builtin_amdgcn_sched_barrier(0); }
          bf16x8 Bn[4];
#pragma unroll
          for (int mt = 0; mt < 2; ++mt) { Bn[2 * mt] = pack8(vn[mt], 0); Bn[2 * mt + 1] = pack8(vn[mt], 1); }
          __builtin_amdgcn_sched_barrier(0);
#pragma unroll
          for (int mt = 0; mt < 2; ++mt) { f32x16 oa = zero16();
#pragma unroll
            for (int ks = 0; ks < 8; ++ks) oa = MFMA32(lds_rd128(B + SC_Q, rowfrag_off(ln, mt, ks)), pack8(S[ks >> 1], ks & 1), oa);
            rowscale(oa, eg + 32 * mt, hls, 1.f);
#pragma unroll
            for (int ks = 0; ks < 4; ++ks) oa = MFMA32(lds_rd128(B + SC_M, 8192 + (mt * 4 + ks) * 1024 + ln * 16), Bn[ks], oa);
#pragma unroll
            for (int s2 = 0; s2 < 2; ++s2) { const bf16x8 pk = pack8(oa, s2);
#pragma unroll
              for (int j = 0; j < 8; ++j) ob[(size_t)(32 * mt + crow(8 * s2 + j, hls)) * D] = (bf16_t)pk[j]; }
            __builtin_amdgcn_sched_barrier(0); }
#pragma unroll
          for (int mt = 0; mt < 2; ++mt) { rowscale(vn[mt], cgv + 32 * mt, hls, 1.f); Bn[2 * mt] = pack8(vn[mt], 0); Bn[2 * mt + 1] = pack8(vn[mt], 1); }
          __builtin_amdgcn_sched_barrier(0);
#pragma unroll
          for (int mt = 0; mt < 4; ++mt) { S[mt] = S[mt] * egl;
#pragma unroll
            for (int ks = 0; ks < 4; ++ks) S[mt] = MFMA32(lds_tr2(B + SC_K, ktr_off(ln, mt, ks, 0), ktr_off(ln, mt, ks, 1)), Bn[ks], S[mt]);
            __builtin_amdgcn_sched_barrier(0); }
        } else {
#pragma unroll
          for (int mt = 0; mt < 2; ++mt) { f32x16 oa = zero16();
#pragma unroll
            for (int ks = 0; ks < 8; ++ks) oa = MFMA32(lds_rd128(B + SC_Q, rowfrag_off(ln, mt, ks)), pack8(S[ks >> 1], ks & 1), oa);
            rowscale(oa, qdec + 32 * mt, hls, 1.f);
#pragma unroll
            for (int ks = 0; ks < 4; ++ks) oa = MFMA32(lds_rd128(B + SC_M, (mt * 4 + ks) * 1024 + ln * 16), Bv[ks], oa);
#pragma unroll
            for (int s2 = 0; s2 < 2; ++s2) { const bf16x8 pk = pack8(oa, s2);
#pragma unroll
              for (int j = 0; j < 8; ++j) ob[(size_t)(32 * mt + crow(8 * s2 + j, hls)) * D] = (bf16_t)pk[j]; }
            __builtin_amdgcn_sched_barrier(0); }
#pragma unroll
          for (int mt = 0; mt < 4; ++mt) { S[mt] = S[mt] * c64;
#pragma unroll
            for (int ks = 0; ks < 4; ++ks) S[mt] = MFMA32(lds_tr2(B + SC_K, ktr_off(ln, mt, ks, 0), ktr_off(ln, mt, ks, 1)), Bv[ks], S[mt]);
            __builtin_amdgcn_sched_barrier(0); }
        }
      }
      if (!lat) {
        int ln3 = threadIdx.x & 63; asm volatile("" : "+v"(ln3)); const int hl3 = ln3 >> 5;
        float* so = (type ? NS_DN : NS_RET) + ((((size_t)sq * 2 + dir) * NH + h) * DK) * DV + 32 * w + (ln3 & 31);
#pragma unroll
        for (int mt = 0; mt < 4; ++mt)
#pragma unroll
          for (int reg = 0; reg < 16; ++reg) so[(size_t)(32 * mt + srow(reg, hl3)) * DV] = S[mt][reg];
      }
    }
  }
  grid.sync();

  bf16_t* GATES = QKV;
  {
    pg8::Gemm g{HB, WGATE, MTOT, 4096, D}; pg8::StaticOrder S; S.init(MTOT, 4096, G, bid);
    pg8::EpiBf16Act<1> E{GATES, LDG};
    pg8::gemm_phase<pg8::EpiBf16Act<1>, pg8::StaticOrder, true, true>(lds, g, S, E);
  }
  grid.sync();

  bf16_t* AR = (bf16_t*)(ws + WS_AR); bf16_t* AD = (bf16_t*)(ws + WS_AD);
  {
    PHASE_TID();
    for (int it = gw; it < MTOT * NH; it += ngw) {
      const int h = it & 3, m = it >> 2; const size_t base = (size_t)m * D + h * DV + 4 * lane;
      {
        const u32x2 a = *(const u32x2*)(ORF + base), b = *(const u32x2*)(ORB + base);
        float v[4] = {lo_bf(a.x) + lo_bf(b.x), hi_bf(a.x) + hi_bf(b.x), lo_bf(a.y) + lo_bf(b.y), hi_bf(a.y) + hi_bf(b.y)};
        const float mu = wave_sum((v[0] + v[1]) + (v[2] + v[3])) * (1.f / DV);
        float q = 0.f;
#pragma unroll
        for (int e = 0; e < 4; ++e) { v[e] -= mu; q += v[e] * v[e]; }
        const float rs = rsqrtf(wave_sum(q) * (1.f / DV) + EPS);
        const f32x4 gw4 = *(const f32x4*)(p.in[I_GNW] + h * DV + 4 * lane);
        const u32x2 gt = *(const u32x2*)(GATES + (size_t)m * LDG + G_RG + h * DV + 4 * lane);
        u32x2 o; o.x = pk2(lo_bf(gt.x) * (v[0] * rs * gw4.x), hi_bf(gt.x) * (v[1] * rs * gw4.y)); o.y = pk2(lo_bf(gt.y) * (v[2] * rs * gw4.z), hi_bf(gt.y) * (v[3] * rs * gw4.w));
        *(u32x2*)(AR + base) = o;
      }
      {
        const u32x2 a = *(const u32x2*)(ODF + base), b = *(const u32x2*)(ODB + base);
        float v[4] = {lo_bf(a.x) + lo_bf(b.x), hi_bf(a.x) + hi_bf(b.x), lo_bf(a.y) + lo_bf(b.y), hi_bf(a.y) + hi_bf(b.y)};
        const float rs = rsqrtf(wave_sum((v[0] * v[0] + v[1] * v[1]) + (v[2] * v[2] + v[3] * v[3])) * (1.f / DV) + EPS);
        const f32x4 dw4 = *(const f32x4*)(p.in[I_DNW] + 4 * lane);
        const u32x2 gt = *(const u32x2*)(GATES + (size_t)m * LDG + G_DZ + h * DV + 4 * lane);
        u32x2 o; o.x = pk2(v[0] * rs * dw4.x * lo_bf(gt.x), v[1] * rs * dw4.y * hi_bf(gt.x)); o.y = pk2(v[2] * rs * dw4.z * lo_bf(gt.y), v[3] * rs * dw4.w * hi_bf(gt.y));
        *(u32x2*)(AD + base) = o;
      }
    }
  }
  grid.sync();

  bf16_t* T1 = HB;
  {
    pg8::Gemm g{AR, WRO, MTOT, D, D}; pg8::StaticOrder S; S.init(MTOT, D, G, bid);
    pg8::EpiGateMul E{T1, D, GATES + G_GR, LDG, nullptr};
    pg8::gemm_phase<pg8::EpiGateMul, pg8::StaticOrder, true, true>(lds, g, S, E);
  }
  grid.sync();
  bf16_t* MERGED = (bf16_t*)(ws + WS_MERGED);
  {
    pg8::Gemm g{AD, WDO, MTOT, D, D}; pg8::StaticOrder S; S.init(MTOT, D, G, bid);
    pg8::EpiGateMul E{MERGED, D, GATES + G_GD, LDG, T1};
    pg8::gemm_phase<pg8::EpiGateMul, pg8::StaticOrder, true, true>(lds, g, S, E);
  }
  grid.sync();
  float* M1 = (float*)(ws + WS_O);
  {
    pg8::Gemm g{MERGED, WOUT, MTOT, D, D}; pg8::StaticOrder S; S.init(MTOT, D, G, bid);
    pg8::EpiF32 E{M1, D};
    pg8::gemm_phase<pg8::EpiF32, pg8::StaticOrder, true, true>(lds, g, S, E);
  }
  grid.sync();

  bf16_t* WF1 = (bf16_t*)(ws + WS_WF1); bf16_t* WF2 = (bf16_t*)(ws + WS_WF2);
  {
    PHASE_TID();
    LAS float* scr = (LAS float*)(lds + wave * 16384);
    transpose_matrix(p.in[I_WF1], 2 * DFF, D, 2 * DFF, WF1, [](int n) { const int pn = n >> 8, w = n & 255; return w < 128 ? 128 * pn + w : DFF + 128 * pn + (w - 128); }, scr, gw, ngw, lane);
    transpose_matrix(p.in[I_WF2], D, DFF, D, WF2, [](int n) { return n; }, scr, gw, ngw, lane);
    const float* nw1 = p.in[I_NORMW] + D; const float* nw2 = p.in[I_NORMW] + 2 * D;
    for (int m = gw; m < MTOT; m += ngw) {
      const float* xr = xrow(p, m); const float* md = MOD + (size_t)cond_of_row(m) * 6 * D; const float* mr = M1 + (size_t)m * D;
      f32x4 v[4]; float s = 0.f;
#pragma unroll
      for (int j = 0; j < 4; ++j) { v[j] = *(const f32x4*)(mr + 4 * lane + 256 * j); s += (v[j].x * v[j].x + v[j].y * v[j].y) + (v[j].z * v[j].z + v[j].w * v[j].w); }
      const float r = rsqrtf(wave_sum(s) * (1.f / D) + EPS);
      float s2 = 0.f;
#pragma unroll
      for (int j = 0; j < 4; ++j) { const int c0 = 4 * lane + 256 * j;
        v[j] = *(const f32x4*)(xr + c0) + *(const f32x4*)(md + 2 * D + c0) * (v[j] * r * *(const f32x4*)(nw1 + c0));
        *(f32x4*)(p.out + (size_t)m * D + c0) = v[j];
        s2 += (v[j].x * v[j].x + v[j].y * v[j].y) + (v[j].z * v[j].z + v[j].w * v[j].w); }
      const float r2 = rsqrtf(wave_sum(s2) * (1.f / D) + EPS);
#pragma unroll
      for (int j = 0; j < 4; ++j) { const int c0 = 4 * lane + 256 * j;
        const f32x4 h = v[j] * r2 * *(const f32x4*)(nw2 + c0) * (*(const f32x4*)(md + 4 * D + c0) + 1.f) + *(const f32x4*)(md + 3 * D + c0);
        u32x2 o; o.x = pk2(h.x, h.y); o.y = pk2(h.z, h.w); *(u32x2*)(HB + (size_t)m * D + c0) = o; }
    }
  }
  grid.sync();

  bf16_t* ACT = QKV;
  {
    pg8::Gemm g{HB, WF1, MTOT, 2 * DFF, D}; pg8::StaticOrder S; S.init(MTOT, 2 * DFF, G, bid);
    pg8::EpiSwiGLU E{ACT, DFF};
    pg8::gemm_phase<pg8::EpiSwiGLU, pg8::StaticOrder, true, true>(lds, g, S, E);
  }
  grid.sync();
  float* F = (float*)(ws + WS_O);
  {
    pg8::Gemm g{ACT, WF2, MTOT, D, DFF}; pg8::StaticOrder S; S.init(MTOT, D, G, bid);
    pg8::EpiF32 E{F, D};
    pg8::gemm_phase<pg8::EpiF32, pg8::StaticOrder, true, true>(lds, g, S, E);
  }
  grid.sync();
  {
    PHASE_TID();
    const float* nw3 = p.in[I_NORMW] + 3 * D;
    for (int m = gw; m < MTOT; m += ngw) {
      const float* md = MOD + (size_t)cond_of_row(m) * 6 * D; const float* fr = F + (size_t)m * D; float* orow = p.out + (size_t)m * D;
      f32x4 v[4]; float s = 0.f;
#pragma unroll
      for (int j = 0; j < 4; ++j) { v[j] = *(const f32x4*)(fr + 4 * lane + 256 * j); s += (v[j].x * v[j].x + v[j].y * v[j].y) + (v[j].z * v[j].z + v[j].w * v[j].w); }
      const float r = rsqrtf(wave_sum(s) * (1.f / D) + EPS);
#pragma unroll
      for (int j = 0; j < 4; ++j) { const int c0 = 4 * lane + 256 * j;
        *(f32x4*)(orow + c0) = *(const f32x4*)(orow + c0) + *(const f32x4*)(md + 5 * D + c0) * (v[j] * r * *(const f32x4*)(nw3 + c0)); }
    }
  }
}

extern "C" void kernel_launch(void* const* d_in, const int* in_sizes, int n_in, void* d_out, int out_size, void* d_ws, size_t ws_size, hipStream_t stream) {
  static int grid_blocks = 0;
  if (!grid_blocks) {
    int dev = 0, cus = 0, per_cu = 0;
    (void)hipGetDevice(&dev);
    (void)hipDeviceGetAttribute(&cus, hipDeviceAttributeMultiprocessorCount, dev);
    (void)hipFuncSetAttribute((const void*)fwd_megakernel, hipFuncAttributeMaxDynamicSharedMemorySize, LDS_BYTES);
    (void)hipOccupancyMaxActiveBlocksPerMultiprocessor(&per_cu, (const void*)fwd_megakernel, NTHREADS, LDS_BYTES);
    if (per_cu < 1) per_cu = 1;
    grid_blocks = cus * per_cu;
    if (n_in != 21 || ws_size < WS_END) fprintf(stderr, "kernel_launch: unexpected n_in %d / ws_size %zu\n", n_in, ws_size);
    fprintf(stderr, "kernel_launch: cus %d per_cu %d grid %d ws %zu out %d\n", cus, per_cu, grid_blocks, ws_size, out_size);
  }
  Params p{};
  for (int i = 0; i < 21; ++i) p.in[i] = (const float*)d_in[i];
  p.out = (float*)d_out; p.ws = (unsigned char*)d_ws;
  void* args[] = {&p};
  hipError_t e = hipLaunchCooperativeKernel((const void*)fwd_megakernel, dim3(grid_blocks), dim3(NTHREADS), args, LDS_BYTES, stream);
  if (e != hipSuccess) fprintf(stderr, "cooperative launch failed: %s (grid %d)\n", hipGetErrorString(e), grid_blocks);
}
```

```cpp
#include <hip/hip_runtime.h>
#include <hip/hip_cooperative_groups.h>
#include <cstdio>
#include <cstdint>
namespace cg = cooperative_groups;

#define LAS __attribute__((address_space(3)))
typedef unsigned short bf16_t;
typedef short bf16x8 __attribute__((ext_vector_type(8)));
typedef float f32x4 __attribute__((ext_vector_type(4)));
typedef float f32x2 __attribute__((ext_vector_type(2)));
typedef unsigned u32x4 __attribute__((ext_vector_type(4)));
typedef unsigned u32x2 __attribute__((ext_vector_type(2)));

constexpr int D = 1024, MCTX = 4096, MLAT = 8192, MTOT = 12288, LCTX = 256, LLAT = 2048, NCTX = 16, NLAT = 4;
constexpr int NH = 4, DK = 128, DV = 256, DFF = 2816, INC = 8208;
constexpr float EPS = 1e-6f;
constexpr float QSCALE = 0.08838834764831845f;
constexpr int NTHREADS = 512, NWAVES = 8;
constexpr int LDS_BYTES = 135168;
constexpr int Q_RQ = 0, Q_RK = 512, Q_RV = 1024, Q_DQ = 2048, Q_DK = 2560, Q_DV = 3072, LDQ = 4096;
constexpr int G_RG = 0, G_DZ = 1024, G_GR = 2048, G_GD = 3072, LDG = 4096;
constexpr int C_RQ = 0, C_RG = 2048, C_DQ = 3072, C_DZ = 5120, C_DB = 6144, C_GR = 6160;

constexpr size_t MiB = 1u << 20;
constexpr size_t WS_MOD = 0;
constexpr size_t WS_ROPE = 128 * 1024;
constexpr size_t WS_BAR = 1152 * 1024;
constexpr size_t WS_BA = 1280 * 1024;
constexpr size_t WS_WQKV = 2 * MiB;
constexpr size_t WS_WGATE = 10 * MiB;
constexpr size_t WS_WRO = 18 * MiB, WS_WDO = 20 * MiB, WS_WOUT = 22 * MiB;
constexpr size_t WS_H = 24 * MiB;
constexpr size_t WS_QKV = 48 * MiB;
constexpr size_t WS_MATS_DN = 144 * MiB;
constexpr size_t WS_MATS_RT = 170 * MiB;
constexpr size_t WS_KB = 182 * MiB;
constexpr size_t WS_HALO = 194 * MiB;
constexpr size_t WS_O = 196 * MiB;
constexpr size_t WS_END = 244 * MiB;
constexpr size_t WS_AR = 144 * MiB, WS_AD = 168 * MiB, WS_MERGED = 144 * MiB;
constexpr size_t WS_WF1 = 144 * MiB, WS_WF2 = 155 * MiB;

struct Params {
  const float* in[21];
  float* out;
  unsigned char* ws;
};
enum { I_XP = 0, I_XS, I_C, I_SRET, I_SDN, I_CCTX, I_WMOD, I_BMOD, I_NORMW, I_WIN, I_CONVW, I_DECAY, I_GNW, I_ALOG, I_DTB, I_DNW, I_WRO, I_WDO, I_WOUT, I_WF1, I_WF2 };

__device__ __forceinline__ float bf2f(unsigned short b) { return __uint_as_float((unsigned)b << 16); }
__device__ __forceinline__ unsigned f2bf(float f) { unsigned u = __float_as_uint(f); return (u + 0x7fffu + ((u >> 16) & 1u)) >> 16; }
__device__ __forceinline__ unsigned pk2(float lo, float hi) { return f2bf(lo) | (f2bf(hi) << 16); }
__device__ __forceinline__ unsigned cvt_pk_bf16(float lo, float hi) { unsigned r; asm volatile("v_cvt_pk_bf16_f32 %0, %1, %2" : "=v"(r) : "v"(lo), "v"(hi)); return r; }
__device__ __forceinline__ float lo_bf(unsigned w) { return __uint_as_float(w << 16); }
__device__ __forceinline__ float hi_bf(unsigned w) { return __uint_as_float(w & 0xffff0000u); }
__device__ __forceinline__ float siluf(float x) { return x / (1.f + __expf(-x)); }
__device__ __forceinline__ float sigmf(float x) { return 1.f / (1.f + __expf(-x)); }
__device__ __forceinline__ float softplusf(float x) { return x > 20.f ? x : log1pf(expf(x)); }
__device__ __forceinline__ float wave_sum(float v) {
#pragma unroll
  for (int o = 1; o < 64; o <<= 1) v += __shfl_xor(v, o);
  return v;
}
__device__ __forceinline__ int cond_of_row(int m) { return m < MCTX ? 0 : 1 + (m - MCTX) / LLAT; }
__device__ __forceinline__ const float* xrow(const Params& p, int m) { return m < MCTX ? p.in[I_XP] + (size_t)m * D : p.in[I_XS] + (size_t)(m - MCTX) * D; }


#define XB_TMO      128
#define XB_XCNT(j)  (256  + 64 * (j))
#define XB_XSUB(j)  (1280 + 64 * (j))
#define XB_XGEN(j)  (2304 + 64 * (j))
#define XB_TOP      3328
#define XB_TOPGEN   3392
#define XCD_BAR_WORDS 3456
#define XB_SPIN_CAP (1u << 18)
__device__ __forceinline__ unsigned xb_ld(unsigned* p)              { return __hip_atomic_load(p, __ATOMIC_RELAXED, __HIP_MEMORY_SCOPE_AGENT); }
__device__ __forceinline__ unsigned xb_add(unsigned* p, unsigned v) { return __hip_atomic_fetch_add(p, v, __ATOMIC_RELAXED, __HIP_MEMORY_SCOPE_AGENT); }
__device__ __forceinline__ unsigned xb_xcc_id() { return (unsigned)__builtin_amdgcn_s_getreg((3 << 11) | 20) & 0xFu; }
#define XB_SPIN(cond, bar) do { unsigned _sp = 0; while (cond) { __builtin_amdgcn_s_sleep(1); \
    if ((++_sp & 255u) == 0u) { if (xb_ld(&(bar)[XB_TMO])) break; if (_sp > XB_SPIN_CAP) { atomicAdd(&(bar)[XB_TMO], 1u); break; } } } } while (0)
struct XcdBarrier { unsigned* bar; unsigned x; volatile LAS unsigned* st; };
__device__ __forceinline__ XcdBarrier xcd_barrier_post(unsigned* bar, volatile LAS unsigned* st) {
  XcdBarrier b; b.bar = bar; b.x = xb_xcc_id(); b.st = st;
  if (threadIdx.x == 0) (void)xb_add(&bar[XB_XCNT(b.x)], 1u);
  return b;
}
__device__ __forceinline__ void xcd_barrier_complete(unsigned* bar, unsigned x, unsigned& nloc, unsigned& nx) {
  const unsigned G = gridDim.x * gridDim.y * gridDim.z;
  unsigned sum, cnt, mine, sp = 0u;
  for (;;) {
    sum = 0u; cnt = 0u; mine = 0u;
#pragma unroll
    for (unsigned j = 0; j < 16; ++j) { const unsigned c = xb_ld(&bar[XB_XCNT(j)]); sum += c; cnt += (c > 0u) ? 1u : 0u; mine = (j == x) ? c : mine; }
    if (sum == G) break;
    __builtin_amdgcn_s_sleep(1);
    if ((++sp & 255u) == 0u) { if (xb_ld(&bar[XB_TMO])) break; if (sp > XB_SPIN_CAP) { atomicAdd(&bar[XB_TMO], 1u); break; } }
  }
  nloc = mine > 0u ? mine : 1u; nx = cnt > 0u ? cnt : 1u;
}
__device__ __forceinline__ void xcd_barrier(const XcdBarrier& b) {
  asm volatile("s_waitcnt vmcnt(0)" ::: "memory");
  __syncthreads();
  if (threadIdx.x == 0) {
    unsigned* bar = b.bar;
    __builtin_amdgcn_s_waitcnt(0);
    unsigned nloc = b.st[0], nx = b.st[1];
    if (nloc == 0u) { xcd_barrier_complete(bar, b.x, nloc, nx); b.st[0] = nloc; b.st[1] = nx; }
    const unsigned old = xb_add(&bar[XB_XSUB(b.x)], 1u);
    const unsigned gen = old / nloc;
    if (old + 1u == (gen + 1u) * nloc) {
      __builtin_amdgcn_fence(__ATOMIC_RELEASE, "agent");
      asm volatile("s_waitcnt vmcnt(0)" ::: "memory");
      const unsigned og = xb_add(&bar[XB_TOP], 1u);
      const unsigned tg = og / nx;
      if (og + 1u == (tg + 1u) * nx) xb_add(&bar[XB_TOPGEN], 1u);
      else XB_SPIN(xb_ld(&bar[XB_TOPGEN]) == tg, bar);
      __builtin_amdgcn_fence(__ATOMIC_ACQUIRE, "agent");
      xb_add(&bar[XB_XGEN(b.x)], 1u);
      asm volatile("s_waitcnt vmcnt(0)" ::: "memory");
    } else {
      XB_SPIN(xb_ld(&bar[XB_XGEN(b.x)]) == gen, bar);
      __builtin_amdgcn_fence(__ATOMIC_ACQUIRE, "agent");
      asm volatile("s_waitcnt vmcnt(0)" ::: "memory");
    }
  }
  __syncthreads();
}

namespace pg8 {
constexpr int BM = 256, BK = 64, HALF = 128, HTB = HALF * BK * 2, STAGE_BYTES = 8 * HTB, NXCD = 8, WGM = 8;
__host__ __device__ __forceinline__ int lds_byte(int r, int c) { const int st = (r >> 4) * 2 + (c >> 5), rr = r & 15, cc = c & 31, ob = rr * 64 + cc * 2; return st * 1024 + (ob ^ (((ob >> 9) & 1) << 5)); }
__host__ __device__ __forceinline__ void stage_rc(int b, int& R, int& C) { const int st = b / 1024, sb = b % 1024, swz = sb ^ (((sb >> 9) & 1) << 5); R = (st >> 1) * 16 + swz / 64; C = (st & 1) * 32 + (swz % 64) / 2; }
__host__ __device__ __forceinline__ int perm32(int rho) { const int n = rho >> 4, i = rho & 15; return 8 * (i >> 2) + 4 * n + (i & 3); }
struct Unit { int pm, pn; };
struct Gemm { const bf16_t* A; const bf16_t* Bt; int M, N, K; };
struct StaticOrder {
  int nM, nN, nwg, G, c;
  __host__ __device__ void init(int M, int N, int G_, int c_) { nM = M / BM; nN = N / BM; nwg = nM * nN; G = G_; c = c_; }
  __host__ __device__ bool next(int i, Unit& u) const {
    const long L = (long)i * G + c; if (L >= nwg) return false;
    int wgid = (int)L; { const int q = nwg / NXCD, r = nwg % NXCD, xcd = wgid % NXCD, off = wgid / NXCD; wgid = (xcd < r ? xcd * (q + 1) : r * (q + 1) + (xcd - r) * q) + off; }
    const int nig = WGM * nN, gid = wgid / nig, fm = gid * WGM, gsz = (nM - fm) < WGM ? (nM - fm) : WGM;
    u.pm = fm + ((wgid % nig) % gsz); u.pn = (wgid % nig) / gsz; return true;
  }
  __device__ __forceinline__ void a_ready(const Unit&) const {}
  __device__ __forceinline__ void done(const Unit&) const {}
};

template <int MODE  > struct EpiBf16Act {
  static constexpr bool PERM = true, AFTER_DRAIN = false;
  bf16_t* O; int ldc;
  __device__ __forceinline__ void operator()(const f32x4 (&acc)[2][2][4][2], const Unit& u, int wr, int wc, int fr, int fq) const {
    const int row0 = u.pm * BM + wr * 64 + fr, col0 = u.pn * BM + wc * 32 + 8 * fq;
    const bool sg = u.pn >= 8;
#pragma unroll
    for (int ai = 0; ai < 2; ++ai)
#pragma unroll
      for (int m = 0; m < 4; ++m) { bf16_t* rowp = O + (size_t)(row0 + ai * HALF + m * 16) * ldc + col0;
#pragma unroll
        for (int bj = 0; bj < 2; ++bj) { f32x4 v0 = acc[ai][bj][m][0], v1 = acc[ai][bj][m][1];
          if (MODE == 1) {
#pragma unroll
            for (int i = 0; i < 4; ++i) { const float s0 = __builtin_amdgcn_rcpf(1.f + __expf(-v0[i])), s1 = __builtin_amdgcn_rcpf(1.f + __expf(-v1[i]));
              v0[i] = sg ? s0 : v0[i] * s0; v1[i] = sg ? s1 : v1[i] * s1; } }
          u32x4 w; w.x = cvt_pk_bf16(v0[0], v0[1]); w.y = cvt_pk_bf16(v0[2], v0[3]); w.z = cvt_pk_bf16(v1[0], v1[1]); w.w = cvt_pk_bf16(v1[2], v1[3]);
          *(u32x4*)(rowp + bj * HALF) = w; } }
  }
};
struct EpiQKV {
  static constexpr bool PERM = true, AFTER_DRAIN = false;
  bf16_t* O; int ldc; bf16_t* HALO;
  __device__ __forceinline__ void operator()(const f32x4 (&acc)[2][2][4][2], const Unit& u, int wr, int wc, int fr, int fq) const {
    const int row0 = u.pm * BM + wr * 64 + fr, col0 = u.pn * BM + wc * 32 + 8 * fq;
#pragma unroll
    for (int ai = 0; ai < 2; ++ai)
#pragma unroll
      for (int m = 0; m < 4; ++m) { const int row = row0 + ai * HALF + m * 16; bf16_t* rowp = O + (size_t)row * ldc + col0;
#pragma unroll
        for (int bj = 0; bj < 2; ++bj) { const f32x4 v0 = acc[ai][bj][m][0], v1 = acc[ai][bj][m][1];
          u32x4 w; w.x = cvt_pk_bf16(v0[0], v0[1]); w.y = cvt_pk_bf16(v0[2], v0[3]); w.z = cvt_pk_bf16(v1[0], v1[1]); w.w = cvt_pk_bf16(v1[2], v1[3]);
          *(u32x4*)(rowp + bj * HALF) = w;
          if (u.pn >= 8 && ((m == 0 && fr == 0) || (m == 3 && fr == 15)))
            *(u32x4*)(HALO + ((size_t)(row >> 6) * 2 + (m == 3 ? 1 : 0)) * 2048 + (col0 - 2048) + bj * HALF) = w; } }
  }
};
struct EpiGateMul {
  static constexpr bool PERM = true, AFTER_DRAIN = false;
  bf16_t* O; int ldc; const bf16_t* G; int ldg; const bf16_t* Add;
  __device__ __forceinline__ void operator()(const f32x4 (&acc)[2][2][4][2], const Unit& u, int wr, int wc, int fr, int fq) const {
    const int row0 = u.pm * BM + wr * 64 + fr, col0 = u.pn * BM + wc * 32 + 8 * fq;
#pragma unroll
    for (int ai = 0; ai < 2; ++ai)
#pragma unroll
      for (int m = 0; m < 4; ++m) { const size_t r = (size_t)(row0 + ai * HALF + m * 16);
#pragma unroll
        for (int bj = 0; bj < 2; ++bj) { const f32x4 v0 = acc[ai][bj][m][0], v1 = acc[ai][bj][m][1];
          const u32x4 g = *(const u32x4*)(G + r * ldg + col0 + bj * HALF);
          float o[8] = {v0[0] * lo_bf(g.x), v0[1] * hi_bf(g.x), v0[2] * lo_bf(g.y), v0[3] * hi_bf(g.y), v1[0] * lo_bf(g.z), v1[1] * hi_bf(g.z), v1[2] * lo_bf(g.w), v1[3] * hi_bf(g.w)};
          if (Add) { const u32x4 a = *(const u32x4*)(Add + r * ldc + col0 + bj * HALF);
            o[0] += lo_bf(a.x); o[1] += hi_bf(a.x); o[2] += lo_bf(a.y); o[3] += hi_bf(a.y); o[4] += lo_bf(a.z); o[5] += hi_bf(a.z); o[6] += lo_bf(a.w); o[7] += hi_bf(a.w); }
          u32x4 w; w.x = cvt_pk_bf16(o[0], o[1]); w.y = cvt_pk_bf16(o[2], o[3]); w.z = cvt_pk_bf16(o[4], o[5]); w.w = cvt_pk_bf16(o[6], o[7]);
          *(u32x4*)(O + r * ldc + col0 + bj * HALF) = w; } }
  }
};
struct EpiF32 {
  static constexpr bool PERM = false, AFTER_DRAIN = false;
  float* O; int ldc;
  __device__ __forceinline__ void operator()(const f32x4 (&acc)[2][2][4][2], const Unit& u, int wr, int wc, int fr, int fq) const {
    const int row0 = u.pm * BM + wr * 64 + fr, col0 = u.pn * BM + wc * 32 + 4 * fq;
#pragma unroll
    for (int ai = 0; ai < 2; ++ai)
#pragma unroll
      for (int m = 0; m < 4; ++m) { float* rowp = O + (size_t)(row0 + ai * HALF + m * 16) * ldc + col0;
#pragma unroll
        for (int bj = 0; bj < 2; ++bj)
#pragma unroll
          for (int n = 0; n < 2; ++n) *(f32x4*)(rowp + bj * HALF + n * 16) = acc[ai][bj][m][n]; }
  }
};
struct EpiSwiGLU {
  static constexpr bool PERM = true, AFTER_DRAIN = false;
  bf16_t* O; int ldc;
  __device__ __forceinline__ void operator()(const f32x4 (&acc)[2][2][4][2], const Unit& u, int wr, int wc, int fr, int fq) const {
    const int row0 = u.pm * BM + wr * 64 + fr, col0 = u.pn * HALF + wc * 32 + 8 * fq;
#pragma unroll
    for (int ai = 0; ai < 2; ++ai)
#pragma unroll
      for (int m = 0; m < 4; ++m) { bf16_t* rowp = O + (size_t)(row0 + ai * HALF + m * 16) * ldc + col0;
        float o[8];
#pragma unroll
        for (int n = 0; n < 2; ++n)
#pragma unroll
          for (int i = 0; i < 4; ++i) { const float g = acc[ai][0][m][n][i], up = acc[ai][1][m][n][i]; o[4 * n + i] = g * __builtin_amdgcn_rcpf(1.f + __expf(-g)) * up; }
        u32x4 w; w.x = cvt_pk_bf16(o[0], o[1]); w.y = cvt_pk_bf16(o[2], o[3]); w.z = cvt_pk_bf16(o[4], o[5]); w.w = cvt_pk_bf16(o[6], o[7]);
        *(u32x4*)rowp = w; }
  }
};

template <class Epi, class Sched, bool ALIGN_EPI = false, bool SP2 = false>
__device__ __forceinline__ void gemm_phase(LAS unsigned char* lds, const Gemm g, const Sched& S, const Epi& E) {
  int tid_o = threadIdx.x; asm volatile("" : "+v"(tid_o));
  const int tid = tid_o, wid = __builtin_amdgcn_readfirstlane(tid >> 6), lane = tid & 63, wr = wid >> 2, wc = wid & 3, fr = lane & 15, fq = lane >> 4;
  const int K = g.K, nt = K / BK;
  unsigned voffA[2], voffB[2];
#pragma unroll
  for (int i = 0; i < 2; ++i) { int R, C; stage_rc(tid * 16 + i * 8192, R, C); const int Rb = Epi::PERM ? ((R & ~31) + perm32(R & 31)) : R;
    voffA[i] = (unsigned)(R * K + C) * 2u; voffB[i] = (unsigned)(Rb * K + C) * 2u; }
  const size_t kstep = (size_t)(BK * 2);
  const size_t hstep = (size_t)HALF * K * 2;
  const size_t tstep = 2 * hstep;
  const unsigned ldsw = (unsigned)wid * 1024u;
  const int aoff = lds_byte(wr * 64 + fr, fq * 8), boff = lds_byte(wc * 32 + fr, fq * 8);
#define PG8_SA(b, h) (((b) * 2 + (h)) * HTB)
#define PG8_SB(b, h) ((4 + (b) * 2 + (h)) * HTB)
#define PG8_STAGE(bufoff, gbase, voff) do { _Pragma("unroll") for (int _i = 0; _i < 2; ++_i) \
    __builtin_amdgcn_global_load_lds((const unsigned*)((const char*)(gbase) + (voff)[_i]), (LAS unsigned*)(lds + (bufoff) + ldsw + _i * 8192), 16, 0, 0); } while (0)
#define PG8_LDA(dst, b, h) do { _Pragma("unroll") for (int m = 0; m < 4; ++m) _Pragma("unroll") for (int k = 0; k < 2; ++k) dst[m][k] = *(const LAS bf16x8*)(lds + PG8_SA(b, h) + aoff + m * 2048 + k * 1024); } while (0)
#define PG8_LDB(dst, b, h) do { _Pragma("unroll") for (int n = 0; n < 2; ++n) _Pragma("unroll") for (int k = 0; k < 2; ++k) dst[n][k] = *(const LAS bf16x8*)(lds + PG8_SB(b, h) + boff + n * 2048 + k * 1024); } while (0)
#define PG8_MMA(ai, bj, At, Bt) do { __builtin_amdgcn_s_setprio(1); _Pragma("unroll") for (int m = 0; m < 4; ++m) _Pragma("unroll") for (int n = 0; n < 2; ++n) _Pragma("unroll") for (int k = 0; k < 2; ++k) \
    acc[ai][bj][m][n] = __builtin_amdgcn_mfma_f32_16x16x32_bf16(Bt[n][k], At[m][k], acc[ai][bj][m][n], 0, 0, 0); __builtin_amdgcn_s_setprio(0); } while (0)
#define PG8_WAIT_V(n) asm volatile("s_waitcnt vmcnt(" #n ")" ::: "memory")
#define PG8_WAIT_L(n) asm volatile("s_waitcnt lgkmcnt(" #n ")" ::: "memory")
#define PG8_BAR __builtin_amdgcn_s_barrier()
#define PG8_SCHED __builtin_amdgcn_sched_barrier(0)
  Unit cur, nxt; int ui = 0;
  if (!S.next(0, cur)) return;
  f32x4 acc[2][2][4][2];
#pragma unroll
  for (int a = 0; a < 2; ++a)
#pragma unroll
    for (int b = 0; b < 2; ++b)
#pragma unroll
      for (int m = 0; m < 4; ++m)
#pragma unroll
        for (int n = 0; n < 2; ++n) acc[a][b][m][n] = (f32x4){0.f, 0.f, 0.f, 0.f};
  bf16x8 At[4][2], B0[2][2], B1[2][2];
  const char* cA = (const char*)g.A + (size_t)cur.pm * tstep; const char* cB = (const char*)g.Bt + (size_t)cur.pn * tstep;
  S.a_ready(cur);
  if constexpr (SP2) {
    PG8_STAGE(PG8_SB(0, 0), cB, voffB); PG8_STAGE(PG8_SB(0, 1), cB + hstep, voffB); PG8_STAGE(PG8_SA(0, 0), cA, voffA); PG8_STAGE(PG8_SA(0, 1), cA + hstep, voffA);
    if (wr == 1) PG8_BAR;
    PG8_WAIT_V(2); PG8_BAR;
    PG8_STAGE(PG8_SB(1, 0), cB + kstep, voffB); PG8_STAGE(PG8_SA(1, 0), cA + kstep, voffA); PG8_STAGE(PG8_SB(1, 1), cB + hstep + kstep, voffB);
    PG8_WAIT_V(6); PG8_BAR;
  } else {
    PG8_STAGE(PG8_SB(0, 0), cB, voffB); PG8_STAGE(PG8_SA(0, 0), cA, voffA); PG8_STAGE(PG8_SB(0, 1), cB + hstep, voffB); PG8_STAGE(PG8_SA(0, 1), cA + hstep, voffA);
    if (wr == 1) PG8_BAR;
    PG8_WAIT_V(4); PG8_BAR;
    PG8_STAGE(PG8_SB(1, 0), cB + kstep, voffB); PG8_STAGE(PG8_SA(1, 0), cA + kstep, voffA); PG8_STAGE(PG8_SB(1, 1), cB + hstep + kstep, voffB);
    PG8_WAIT_V(6); PG8_BAR;
  }
  for (;;) {
    const bool has_next = S.next(ui + 1, nxt);
    const char* nA = has_next ? (const char*)g.A + (size_t)nxt.pm * tstep : cA; const char* nB = has_next ? (const char*)g.Bt + (size_t)nxt.pn * tstep : cB;
    for (int t = 0; t < nt; t += 2) {
      const bool last = (t == nt - 2);
      const char* a1 = cA + (size_t)(t + 1) * kstep;
      const char* a2 = last ? nA : cA + (size_t)(t + 2) * kstep; const char* b2 = last ? nB : cB + (size_t)(t + 2) * kstep;
      const char* a3 = a2 + kstep; const char* b3 = b2 + kstep;
      if (last && has_next) S.a_ready(nxt);
      if constexpr (SP2) {
        PG8_LDB(B0, 0, 0); PG8_LDB(B1, 0, 1); PG8_SCHED; PG8_LDA(At, 0, 0); PG8_STAGE(PG8_SA(1, 1), a1 + hstep, voffA);
        PG8_WAIT_V(8); PG8_WAIT_L(0); PG8_BAR; PG8_MMA(0, 0, At, B0); PG8_MMA(0, 1, At, B1); PG8_BAR; PG8_SCHED;
        PG8_LDA(At, 0, 1); PG8_STAGE(PG8_SB(0, 0), b2, voffB); PG8_STAGE(PG8_SB(0, 1), b2 + hstep, voffB); PG8_STAGE(PG8_SA(0, 0), a2, voffA);
        PG8_WAIT_V(8); PG8_WAIT_L(0); PG8_BAR; PG8_MMA(1, 0, At, B0); PG8_MMA(1, 1, At, B1); PG8_BAR; PG8_SCHED;
        PG8_LDB(B0, 1, 0); PG8_LDB(B1, 1, 1); PG8_SCHED; PG8_LDA(At, 1, 0); PG8_STAGE(PG8_SA(0, 1), a2 + hstep, voffA);
        PG8_WAIT_V(8); PG8_WAIT_L(0); PG8_BAR; PG8_MMA(0, 0, At, B0); PG8_MMA(0, 1, At, B1); PG8_BAR; PG8_SCHED;
        PG8_LDA(At, 1, 1); PG8_STAGE(PG8_SB(1, 0), b3, voffB); PG8_STAGE(PG8_SB(1, 1), b3 + hstep, voffB); PG8_STAGE(PG8_SA(1, 0), a3, voffA);
        PG8_WAIT_V(8); PG8_WAIT_L(0); PG8_BAR; PG8_MMA(1, 0, At, B0); PG8_MMA(1, 1, At, B1); PG8_BAR; PG8_SCHED;
      } else {
        PG8_LDB(B0, 0, 0); PG8_SCHED; PG8_LDA(At, 0, 0); PG8_STAGE(PG8_SA(1, 1), a1 + hstep, voffA);
        PG8_WAIT_L(8); PG8_BAR; PG8_WAIT_L(0); PG8_MMA(0, 0, At, B0); PG8_BAR; PG8_SCHED;
        PG8_LDB(B1, 0, 1); PG8_STAGE(PG8_SB(0, 0), b2, voffB);
        PG8_BAR; PG8_WAIT_L(0); PG8_MMA(0, 1, At, B1); PG8_BAR;
        PG8_LDA(At, 0, 1); PG8_STAGE(PG8_SA(0, 0), a2, voffA);
        PG8_BAR; PG8_WAIT_L(0); PG8_MMA(1, 0, At, B0); PG8_BAR; PG8_SCHED;
        PG8_STAGE(PG8_SB(0, 1), b2 + hstep, voffB);
        PG8_WAIT_V(6); PG8_BAR; PG8_MMA(1, 1, At, B1); PG8_BAR;
        PG8_LDB(B0, 1, 0); PG8_SCHED; PG8_LDA(At, 1, 0); PG8_STAGE(PG8_SA(0, 1), a2 + hstep, voffA);
        PG8_WAIT_L(8); PG8_BAR; PG8_WAIT_L(0); PG8_MMA(0, 0, At, B0); PG8_BAR; PG8_SCHED;
        PG8_LDB(B1, 1, 1); PG8_STAGE(PG8_SB(1, 0), b3, voffB);
        PG8_BAR; PG8_WAIT_L(0); PG8_MMA(0, 1, At, B1); PG8_BAR;
        PG8_LDA(At, 1, 1); PG8_STAGE(PG8_SA(1, 0), a3, voffA);
        PG8_BAR; PG8_WAIT_L(0); PG8_MMA(1, 0, At, B0); PG8_BAR; PG8_SCHED;
        PG8_STAGE(PG8_SB(1, 1), b3 + hstep, voffB);
        PG8_WAIT_V(6); PG8_BAR; PG8_MMA(1, 1, At, B1); PG8_BAR;
      }
    }
    if constexpr (ALIGN_EPI) { if (wr == 0) PG8_BAR; }
    if constexpr (!Epi::AFTER_DRAIN) { E(acc, cur, wr, wc, fr, fq); S.done(cur); }
    if (!has_next) break;
#pragma unroll
    for (int a = 0; a < 2; ++a)
#pragma unroll
      for (int b = 0; b < 2; ++b)
#pragma unroll
        for (int m = 0; m < 4; ++m)
#pragma unroll
          for (int n = 0; n < 2; ++n) acc[a][b][m][n] = (f32x4){0.f, 0.f, 0.f, 0.f};
    cur = nxt; cA = nA; cB = nB; ++ui;
    if constexpr (ALIGN_EPI) { if (wr == 1) PG8_BAR; }
  }
  PG8_WAIT_V(0);
  if constexpr (!ALIGN_EPI) { if (wr == 0) PG8_BAR; }
  PG8_BAR;
#undef PG8_SA
#undef PG8_SB
#undef PG8_STAGE
#undef PG8_LDA
#undef PG8_LDB
#undef PG8_MMA
#undef PG8_WAIT_V
#undef PG8_WAIT_L
#undef PG8_BAR
#undef PG8_SCHED
}
}

typedef float f32x16 __attribute__((ext_vector_type(16)));
typedef float f32x8 __attribute__((ext_vector_type(8)));
typedef short s16x4 __attribute__((ext_vector_type(4)));
typedef __bf16 bfx8 __attribute__((ext_vector_type(8)));
#define MFMA32(a, b, c) __builtin_amdgcn_mfma_f32_32x32x16_bf16((a), (b), (c), 0, 0, 0)
__device__ __forceinline__ bf16x8 cvt8(f32x8 t) { return __builtin_bit_cast(bf16x8, __builtin_convertvector(t, bfx8)); }
__device__ __forceinline__ bf16x8 pack8(const f32x16& x, int s) {
  const f32x8 t = {x[8 * s], x[8 * s + 1], x[8 * s + 2], x[8 * s + 3], x[8 * s + 4], x[8 * s + 5], x[8 * s + 6], x[8 * s + 7]};
  return cvt8(t);
}
__device__ __forceinline__ f32x16 zero16() { f32x16 z; for (int i = 0; i < 16; ++i) z[i] = 0.f; return z; }
__device__ __forceinline__ unsigned off_b(unsigned row, unsigned ch) { return 256u * row + 16u * (ch ^ (((row & 3u) << 2) | ((row >> 2) & 3u))); }
__device__ __forceinline__ int swap12(int p) { return ((p & 1) << 1) | (p >> 1); }
__device__ __forceinline__ bf16x8 lds_rd128(LAS unsigned char* lds, unsigned off) { return *(const LAS bf16x8*)(lds + off); }
__device__ __forceinline__ bf16x8 lds_tr2(LAS unsigned char* lds, unsigned off_lo, unsigned off_hi) {
  const s16x4 lo = __builtin_amdgcn_ds_read_tr16_b64_v4i16((LAS s16x4*)(lds + off_lo));
  const s16x4 hi = __builtin_amdgcn_ds_read_tr16_b64_v4i16((LAS s16x4*)(lds + off_hi));
  return __builtin_shufflevector(lo, hi, 0, 1, 2, 3, 4, 5, 6, 7);
}
__device__ __forceinline__ void glds16(const void* g, LAS unsigned char* l) { __builtin_amdgcn_global_load_lds((const unsigned*)g, (LAS unsigned*)l, 16, 0, 0); }
__device__ __forceinline__ unsigned rowfrag_off(int lane, int mt, int ks) { return off_b(32 * mt + (lane & 31), 2 * ks + (lane >> 5)); }
__device__ __forceinline__ unsigned vtr_off(int lane, int cb, int ks, int sec) {
  const int g = lane >> 4, i = lane & 15, hh = g >> 1, half16 = g & 1, qq = i >> 2, p = i & 3;
  const int row = 16 * ks + 4 * hh + 8 * sec + qq, col = cb + 16 * half16 + 4 * p;
  return off_b(row, col >> 3) + (col & 7) * 2;
}
__device__ __forceinline__ unsigned ktr_off(int lane, int mt, int ks, int sec) {
  const int g = lane >> 4, i = lane & 15, hh = g >> 1, half16 = g & 1, qq = i >> 2, p = i & 3;
  const int row = 16 * ks + 4 * hh + 8 * sec + qq, col = 32 * mt + 16 * half16 + 4 * swap12(p);
  return off_b(row, col >> 3) + (col & 7) * 2;
}
__device__ __forceinline__ int crow(int reg, int h) { return (reg & 3) + 8 * (reg >> 2) + 4 * h; }
__device__ __forceinline__ int srow(int reg, int h) { return 16 * (reg >> 3) + 8 * h + 4 * ((reg >> 2) & 1) + (reg & 3); }
__device__ __forceinline__ void rowscale(f32x16& a, const LAS float* vec, int h, float sgn) {
#pragma unroll
  for (int g4 = 0; g4 < 4; ++g4) { const f32x4 s = *(const LAS f32x4*)(vec + 8 * g4 + 4 * h);
    a[4 * g4] *= s.x * sgn; a[4 * g4 + 1] *= s.y * sgn; a[4 * g4 + 2] *= s.z * sgn; a[4 * g4 + 3] *= s.w * sgn; }
}
__device__ __forceinline__ void stage_img_piece(const unsigned char* src, size_t pitch, LAS unsigned char* img, int pc, int lane) {
  const unsigned row = 4 * pc + (lane >> 4), chp = lane & 15, ch = chp ^ (((row & 3u) << 2) | ((row >> 2) & 3u));
  glds16(src + (size_t)row * pitch + ch * 16, img + 1024 * pc);
}
constexpr int SC_BUF = 50176, SC_Q = 0, SC_K = 16384, SC_M = 32768, SC_V = 2 * SC_BUF, SC_VEC = SC_V + 32768;
constexpr int DN_BLOB = 17408, RT_BLOB = 8192;
__device__ __forceinline__ void scan_stage(LAS unsigned char* lds, int buf, int type, int dir, int h, int gc, const bf16_t* QKV, const bf16_t* KBUF,
                                           const unsigned char* MATS_RT, const unsigned char* MATS_DN, int w, int lane) {
  const size_t row0 = (size_t)gc * 64;
  const unsigned char* rowp = (const unsigned char*)(QKV + row0 * LDQ);
  const unsigned char* qsrc = rowp + (type ? Q_DQ + h * DK : Q_RQ + h * DK) * 2;
  const unsigned char* ksrc = rowp + (type ? Q_DK + h * DK : Q_RK + h * DK) * 2; size_t kpitch = LDQ * 2;
  if (!type && dir) { ksrc = (const unsigned char*)(KBUF + row0 * 512 + h * DK); kpitch = 1024; }
  const unsigned char* vsrc = rowp + (type ? Q_DV + h * DV : Q_RV + h * DV) * 2;
  LAS unsigned char* B = lds + buf * SC_BUF;
#pragma unroll
  for (int i = 0; i < 2; ++i) { const int pc = w + 8 * i;
    stage_img_piece(qsrc, LDQ * 2, B + SC_Q, pc, lane); stage_img_piece(ksrc, kpitch, B + SC_K, pc, lane);
    stage_img_piece(vsrc, LDQ * 2, lds + SC_V, pc, lane); stage_img_piece(vsrc + 256, LDQ * 2, lds + SC_V + 16384, pc, lane); }
  const unsigned char* blob = type ? MATS_DN + (size_t)((gc * 4 + h) * 2 + dir) * DN_BLOB : MATS_RT + (size_t)((gc * 4 + h) * 2 + dir) * RT_BLOB;
  const int np = type ? 17 : 8;
  for (int pc = w; pc < np; pc += 8) glds16(blob + pc * 1024 + lane * 16, B + SC_M + pc * 1024);
}

__device__ __forceinline__ void transpose_item(const float* W, int ldw, int K, int src_col0, bf16_t* WT, int dst_row0, int k0, LAS float* scr, int lane) {
#pragma unroll 8
  for (int i = 0; i < 32; ++i) { const int kk = 2 * i + (lane >> 5); scr[kk * 33 + (lane & 31)] = W[(size_t)(k0 + kk) * ldw + src_col0 + (lane & 31)]; }
  asm volatile("s_waitcnt lgkmcnt(0)" ::: "memory");
  const int c = lane & 7;
#pragma unroll
  for (int j = 0; j < 4; ++j) { const int n = (lane >> 3) + 8 * j; const LAS float* s = scr + (8 * c) * 33 + n;
    u32x4 o; o.x = pk2(s[0 * 33], s[1 * 33]); o.y = pk2(s[2 * 33], s[3 * 33]); o.z = pk2(s[4 * 33], s[5 * 33]); o.w = pk2(s[6 * 33], s[7 * 33]);
    *(u32x4*)(WT + (size_t)(dst_row0 + n) * K + k0 + 8 * c) = o; }
  asm volatile("s_waitcnt lgkmcnt(0)" ::: "memory");
}

template <class ColMap> __device__ __forceinline__ void transpose_matrix(const float* W, int ldw, int K, int N, bf16_t* WT, ColMap cm, LAS float* scr, int gw, int ngw, int lane) {
  const int nblk = N / 32, items = (K / 64) * nblk;
  for (int it = gw; it < items; it += ngw) { const int kb = it / nblk, nb = it % nblk; transpose_item(W, ldw, K, cm(32 * nb), WT, 32 * nb, 64 * kb, scr, lane); }
}

__global__ void __launch_bounds__(NTHREADS) fwd_megakernel(Params p) {
  extern __shared__ __attribute__((aligned(16))) unsigned char lds_raw[];
  LAS unsigned char* lds = (LAS unsigned char*)lds_raw;
  cg::grid_group grid = cg::this_grid();
  volatile LAS unsigned* bar_st = (volatile LAS unsigned*)(lds + LDS_BYTES - 64);
  if (threadIdx.x < 2) bar_st[threadIdx.x] = 0u;
  __syncthreads();
  const XcdBarrier xbar = xcd_barrier_post((unsigned*)(p.ws + WS_BAR), bar_st);
  if (p.ws == nullptr) grid.sync();
#define GRID_BARRIER() xcd_barrier(xbar)
  const int wave = __builtin_amdgcn_readfirstlane(threadIdx.x >> 6);
#define PHASE_TID() int tid_p = threadIdx.x; asm volatile("" : "+v"(tid_p)); const int tid = tid_p, lane = tid & 63; (void)lane;
  const int G = gridDim.x, bid = blockIdx.x;
  const int gw = bid * NWAVES + wave, ngw = G * NWAVES;
  unsigned char* ws = p.ws;
  float* MOD = (float*)(ws + WS_MOD);
  f32x2* ROPE = (f32x2*)(ws + WS_ROPE);
  float* BA = (float*)(ws + WS_BA);
  float* DECLG = (float*)(ws + WS_MOD + 122880);
  bf16_t* WQKV = (bf16_t*)(ws + WS_WQKV); bf16_t* WGATE = (bf16_t*)(ws + WS_WGATE);
  bf16_t* WRO = (bf16_t*)(ws + WS_WRO); bf16_t* WDO = (bf16_t*)(ws + WS_WDO); bf16_t* WOUT = (bf16_t*)(ws + WS_WOUT);
  bf16_t* HB = (bf16_t*)(ws + WS_H);
  bf16_t* QKV = (bf16_t*)(ws + WS_QKV);
  bf16_t* KBUF = (bf16_t*)(ws + WS_KB); bf16_t* HALO = (bf16_t*)(ws + WS_HALO);
  unsigned char* MATS_RT = ws + WS_MATS_RT; unsigned char* MATS_DN = ws + WS_MATS_DN;
  bf16_t* ODF = (bf16_t*)(ws + WS_O); bf16_t* ODB = ODF + (size_t)MTOT * D;
  bf16_t* ORF = (bf16_t*)p.out; bf16_t* ORB = ORF + (size_t)MTOT * D;
  float* NS_RET = p.out + (size_t)MTOT * D; float* NS_DN = NS_RET + (size_t)NCTX * 2 * NH * DK * DV;

  {
    PHASE_TID();
    LAS float* scr = (LAS float*)(lds + wave * 16384);
    transpose_matrix(p.in[I_WIN], INC, D, 4096, WQKV, [](int n) { return n < 2048 ? n : n + 1024; }, scr, gw, ngw, lane);
    transpose_matrix(p.in[I_WIN], INC, D, 4096, WGATE, [](int n) { return n < 1024 ? C_RG + n : (n < 2048 ? C_DZ + (n - 1024) : C_GR + (n - 2048)); }, scr, gw, ngw, lane);
    transpose_matrix(p.in[I_WRO], D, D, D, WRO, [](int n) { return n; }, scr, gw, ngw, lane);
    transpose_matrix(p.in[I_WDO], D, D, D, WDO, [](int n) { return n; }, scr, gw, ngw, lane);
    transpose_matrix(p.in[I_WOUT], D, D, D, WOUT, [](int n) { return n; }, scr, gw, ngw, lane);
    {
      __syncthreads();
      LAS float* scond = (LAS float*)lds;
      LAS float* red = scond + 5 * D;
      for (int i = tid; i < 5 * D; i += NTHREADS) { const int c = i >> 10, k = i & 1023; scond[i] = siluf(c == 0 ? p.in[I_CCTX][k] : p.in[I_C][(c - 1) * D + k]); }
      __syncthreads();
      for (int it = bid; it < 6 * D / 32; it += G) {
        const int col = it * 32 + (lane & 31), rpar = lane >> 5;
        float acc[5] = {0.f, 0.f, 0.f, 0.f, 0.f};
        const float* wm = p.in[I_WMOD] + (size_t)(128 * wave + rpar) * 6 * D + col;
#pragma unroll 16
        for (int i = 0; i < 64; ++i) { const float wv = wm[(size_t)(2 * i) * 6 * D]; const int k = 128 * wave + 2 * i + rpar;
#pragma unroll
          for (int c = 0; c < 5; ++c) acc[c] += scond[c * D + k] * wv; }
#pragma unroll
        for (int c = 0; c < 5; ++c) { acc[c] += __shfl_xor(acc[c], 32); if (lane < 32) red[(wave * 5 + c) * 32 + lane] = acc[c]; }
        __syncthreads();
        if (tid < 160) { const int c = tid >> 5, n = tid & 31; float s = 0.f;
#pragma unroll
          for (int ww = 0; ww < 8; ++ww) s += red[(ww * 5 + c) * 32 + n];
          MOD[c * 6 * D + it * 32 + n] = s + p.in[I_BMOD][it * 32 + n]; }
        __syncthreads();
      }
    }
    for (int i = bid * NTHREADS + tid; i < LLAT * 64; i += G * NTHREADS) { const int l = i >> 6, pr = i & 63;
      const float freq = powf(10000.f, -(float)(pr & 31) / 32.f); const float ang = (pr < 32 ? (float)(l >> 6) : (float)(l & 63)) * freq;
      ROPE[i] = (f32x2){cosf(ang), sinf(ang)}; }
    if (bid == 0 && tid < 8) DECLG[tid] = -softplusf(-p.in[I_DECAY][tid]);
  }
  GRID_BARRIER();

  {
    PHASE_TID();
    LAS float* wba = (LAS float*)lds;
    for (int i = tid; i < D * 16; i += NTHREADS) wba[i] = p.in[I_WIN][(size_t)(i >> 4) * INC + C_DB + (i & 15)];
    __syncthreads();
    const float* nw = p.in[I_NORMW];
    for (int m = gw; m < MTOT; m += ngw) {
      const float* xr = xrow(p, m); const float* md = MOD + (size_t)cond_of_row(m) * 6 * D;
      float s = 0.f;
#pragma unroll
      for (int j = 0; j < 4; ++j) { const f32x4 x4 = *(const f32x4*)(xr + 4 * lane + 256 * j); s += (x4.x * x4.x + x4.y * x4.y) + (x4.z * x4.z + x4.w * x4.w); }
      const float r = rsqrtf(wave_sum(s) * (1.f / D) + EPS);
      float dots[16];
#pragma unroll
      for (int n = 0; n < 16; ++n) dots[n] = 0.f;
#pragma unroll 1
      for (int j = 0; j < 4; ++j) { const int c0 = 4 * lane + 256 * j;
        const f32x4 x4 = *(const f32x4*)(xr + c0);
        const f32x4 w4 = *(const f32x4*)(nw + c0), sc = *(const f32x4*)(md + D + c0), sh = *(const f32x4*)(md + c0);
        f32x4 h = x4 * r * w4 * (sc + 1.f) + sh;
        u32x2 o; o.x = pk2(h.x, h.y); o.y = pk2(h.z, h.w);
        *(u32x2*)(HB + (size_t)m * D + c0) = o;
#pragma unroll
        for (int e = 0; e < 4; ++e) {
#pragma unroll
          for (int q = 0; q < 4; ++q) { const f32x4 wv = *(const LAS f32x4*)(wba + (c0 + e) * 16 + 4 * q);
            dots[4 * q + 0] += h[e] * wv.x; dots[4 * q + 1] += h[e] * wv.y; dots[4 * q + 2] += h[e] * wv.z; dots[4 * q + 3] += h[e] * wv.w; } }
      }
#pragma unroll
      for (int n = 0; n < 16; ++n) dots[n] = wave_sum(dots[n]);
      if (lane < 8) {
        float db = dots[0], da = dots[8];
#pragma unroll
        for (int n = 1; n < 8; ++n) { db = lane == n ? dots[n] : db; da = lane == n ? dots[8 + n] : da; }
        BA[(size_t)m * 16 + lane] = sigmf(db);
        BA[(size_t)m * 16 + 8 + lane] = -expf(p.in[I_ALOG][lane]) * softplusf(da + p.in[I_DTB][lane]);
      }
    }
  }
  GRID_BARRIER();

  {
    pg8::Gemm g{HB, WQKV, MTOT, 4096, D}; pg8::StaticOrder S; S.init(MTOT, 4096, G, bid);
    pg8::EpiQKV E{QKV, LDQ, HALO};
    pg8::gemm_phase<pg8::EpiQKV, pg8::StaticOrder, true, true>(lds, g, S, E);
  }
  GRID_BARRIER();

  {
    PHASE_TID();
    constexpr int PI_RQ = 0, PI_RK = 16384, PI_DQ = 32768, PI_DK = 49152;
    constexpr int PM_QKR = 65536, PM_QKD = PM_QKR + 17408, PM_KKD = PM_QKD + 17408;
    constexpr int PV = PM_KKD + 17408;
    constexpr int PL_F = 0, PL_B = 17408, PT_F = 34816, PT_B = 52224;
    const int w = wave;
    const float* cw = p.in[I_CONVW];
    for (int item = bid; item < 768; item += G) {
      int tid_o = threadIdx.x; asm volatile("" : "+v"(tid_o));
      const int tid = tid_o, lane = tid & 63, r32 = lane & 31, hl = lane >> 5;
      const int gc = item >> 2, h = item & 3, row0 = gc * 64; const bool lat = row0 >= MCTX;
      const int L = lat ? LLAT : LCTX, t0 = lat ? ((row0 - MCTX) & (LLAT - 1)) : (row0 & (LCTX - 1));
      const float lgf = DECLG[h], lgb = DECLG[4 + h];
      __syncthreads();
      {
        const int row = tid >> 3; const size_t m = (size_t)row0 + row;
        const float kfs = __expf(lgf * (float)(63 - row)), kbs = __expf(lgb * (float)row);
#pragma unroll
        for (int c = 0; c < 2; ++c) { const int ch = (tid & 7) * 2 + c;
          bf16_t* qp = QKV + m * LDQ + Q_RQ + h * DK + ch * 8; bf16_t* kp = QKV + m * LDQ + Q_RK + h * DK + ch * 8;
          const u32x4 qw = *(const u32x4*)qp, kw = *(const u32x4*)kp;
          float q[8] = {lo_bf(qw.x), hi_bf(qw.x), lo_bf(qw.y), hi_bf(qw.y), lo_bf(qw.z), hi_bf(qw.z), lo_bf(qw.w), hi_bf(qw.w)};
          float k[8] = {lo_bf(kw.x), hi_bf(kw.x), lo_bf(kw.y), hi_bf(kw.y), lo_bf(kw.z), hi_bf(kw.z), lo_bf(kw.w), hi_bf(kw.w)};
#pragma unroll
          for (int e = 0; e < 8; ++e) q[e] *= QSCALE;
          if (lat) {
#pragma unroll
            for (int e = 0; e < 4; ++e) { const f32x2 cs = ROPE[(t0 + row) * 64 + ch * 4 + e];
              const float a = q[2 * e] * cs.x - q[2 * e + 1] * cs.y, b = q[2 * e] * cs.y + q[2 * e + 1] * cs.x; q[2 * e] = a; q[2 * e + 1] = b;
              const float c2 = k[2 * e] * cs.x - k[2 * e + 1] * cs.y, d2 = k[2 * e] * cs.y + k[2 * e + 1] * cs.x; k[2 * e] = c2; k[2 * e + 1] = d2; }
          }
          u32x4 o; o.x = pk2(q[0], q[1]); o.y = pk2(q[2], q[3]); o.z = pk2(q[4], q[5]); o.w = pk2(q[6], q[7]);
          *(u32x4*)qp = o; *(LAS u32x4*)(lds + PI_RQ + off_b(row, ch)) = o;
          o.x = pk2(k[0], k[1]); o.y = pk2(k[2], k[3]); o.z = pk2(k[4], k[5]); o.w = pk2(k[6], k[7]);
          *(LAS u32x4*)(lds + PI_RK + off_b(row, ch)) = o;
          o.x = pk2(k[0] * kfs, k[1] * kfs); o.y = pk2(k[2] * kfs, k[3] * kfs); o.z = pk2(k[4] * kfs, k[5] * kfs); o.w = pk2(k[6] * kfs, k[7] * kfs);
          *(u32x4*)kp = o;
          o.x = pk2(k[0] * kbs, k[1] * kbs); o.y = pk2(k[2] * kbs, k[3] * kbs); o.z = pk2(k[4] * kbs, k[5] * kbs); o.w = pk2(k[6] * kbs, k[7] * kbs);
          *(u32x4*)(KBUF + m * 512 + h * DK + ch * 8) = o;
        }
      }
      {
        const int ch = tid & 15;
        u32x4 raw[2][2][3];
#pragma unroll
        for (int ps = 0; ps < 2; ++ps)
#pragma unroll
          for (int wh = 0; wh < 2; ++wh)
#pragma unroll
            for (int wd = 0; wd < 3; ++wd) { const int row = (tid >> 4) + 32 * ps, rr = row + wd - 1, t = t0 + rr; const int dch = wh * 512 + h * DK + ch * 8;
              u32x4 x = (u32x4){0u, 0u, 0u, 0u};
              if (t >= 0 && t < L) {
                if (rr < 0) x = *(const u32x4*)(HALO + ((size_t)(gc - 1) * 2 + 1) * 2048 + dch);
                else if (rr > 63) x = *(const u32x4*)(HALO + ((size_t)(gc + 1) * 2 + 0) * 2048 + dch);
                else x = *(const u32x4*)(QKV + (size_t)(row0 + rr) * LDQ + Q_DQ + dch); }
              raw[ps][wh][wd] = x; }
        __syncthreads();
#pragma unroll
        for (int ps = 0; ps < 2; ++ps)
#pragma unroll
          for (int wh = 0; wh < 2; ++wh) { const int row = (tid >> 4) + 32 * ps; const int dch = wh * 512 + h * DK + ch * 8;
            float a[8] = {0.f, 0.f, 0.f, 0.f, 0.f, 0.f, 0.f, 0.f};
#pragma unroll
            for (int wd = 0; wd < 3; ++wd) { const u32x4 x = raw[ps][wh][wd]; const f32x4 w0 = *(const f32x4*)(cw + wd * 2048 + dch), w1 = *(const f32x4*)(cw + wd * 2048 + dch + 4);
              a[0] += lo_bf(x.x) * w0.x; a[1] += hi_bf(x.x) * w0.y; a[2] += lo_bf(x.y) * w0.z; a[3] += hi_bf(x.y) * w0.w;
              a[4] += lo_bf(x.z) * w1.x; a[5] += hi_bf(x.z) * w1.y; a[6] += lo_bf(x.w) * w1.z; a[7] += hi_bf(x.w) * w1.w; }
            float ss = 0.f;
#pragma unroll
            for (int e = 0; e < 8; ++e) { a[e] = siluf(a[e]); ss += a[e] * a[e]; }
            ss += __shfl_xor(ss, 1); ss += __shfl_xor(ss, 2); ss += __shfl_xor(ss, 4); ss += __shfl_xor(ss, 8);
            const float sc = rsqrtf(ss + EPS) * (wh == 0 ? QSCALE : 1.f);
            u32x4 o; o.x = pk2(a[0] * sc, a[1] * sc); o.y = pk2(a[2] * sc, a[3] * sc); o.z = pk2(a[4] * sc, a[5] * sc); o.w = pk2(a[6] * sc, a[7] * sc);
            *(u32x4*)(QKV + (size_t)(row0 + row) * LDQ + Q_DQ + dch) = o;
            *(LAS u32x4*)(lds + (wh ? PI_DK : PI_DQ) + off_b(row, ch)) = o; }
      }
      {
        u32x4 raw[4][3];
#pragma unroll
        for (int n = 0; n < 4; ++n)
#pragma unroll
          for (int wd = 0; wd < 3; ++wd) { const int idx = tid + 512 * n, row = idx >> 5, ch = idx & 31, rr = row + wd - 1, t = t0 + rr; const int dch = 1024 + h * DV + ch * 8;
            u32x4 x = (u32x4){0u, 0u, 0u, 0u};
            if (t >= 0 && t < L) {
              if (rr < 0) x = *(const u32x4*)(HALO + ((size_t)(gc - 1) * 2 + 1) * 2048 + dch);
              else if (rr > 63) x = *(const u32x4*)(HALO + ((size_t)(gc + 1) * 2 + 0) * 2048 + dch);
              else x = *(const u32x4*)(QKV + (size_t)(row0 + rr) * LDQ + Q_DQ + dch); }
            raw[n][wd] = x; }
        __syncthreads();
#pragma unroll
        for (int n = 0; n < 4; ++n) { const int idx = tid + 512 * n, row = idx >> 5, ch = idx & 31; const int dch = 1024 + h * DV + ch * 8;
          float a[8] = {0.f, 0.f, 0.f, 0.f, 0.f, 0.f, 0.f, 0.f};
#pragma unroll
          for (int wd = 0; wd < 3; ++wd) { const u32x4 x = raw[n][wd]; const f32x4 w0 = *(const f32x4*)(cw + wd * 2048 + dch), w1 = *(const f32x4*)(cw + wd * 2048 + dch + 4);
            a[0] += lo_bf(x.x) * w0.x; a[1] += hi_bf(x.x) * w0.y; a[2] += lo_bf(x.y) * w0.z; a[3] += hi_bf(x.y) * w0.w;
            a[4] += lo_bf(x.z) * w1.x; a[5] += hi_bf(x.z) * w1.y; a[6] += lo_bf(x.w) * w1.z; a[7] += hi_bf(x.w) * w1.w; }
          u32x4 o; o.x = pk2(siluf(a[0]), siluf(a[1])); o.y = pk2(siluf(a[2]), siluf(a[3])); o.z = pk2(siluf(a[4]), siluf(a[5])); o.w = pk2(siluf(a[6]), siluf(a[7]));
          *(u32x4*)(QKV + (size_t)(row0 + row) * LDQ + Q_DQ + dch) = o; }
      }
      __syncthreads();
      {
        const int mi = (w >> 1) & 1, nj = w & 1;
        if (w < 4) {
          f32x16 a1 = zero16(), a2 = zero16();
#pragma unroll 2
          for (int ks = 0; ks < 8; ++ks) { a1 = MFMA32(lds_rd128(lds + PI_RQ, rowfrag_off(lane, mi, ks)), lds_rd128(lds + PI_RK, rowfrag_off(lane, nj, ks)), a1);
            a2 = MFMA32(lds_rd128(lds + PI_DQ, rowfrag_off(lane, mi, ks)), lds_rd128(lds + PI_DK, rowfrag_off(lane, nj, ks)), a2); }
          LAS float* m1 = (LAS float*)(lds + PM_QKR); LAS float* m2 = (LAS float*)(lds + PM_QKD);
#pragma unroll
          for (int reg = 0; reg < 16; ++reg) { const int o = (32 * mi + crow(reg, hl)) * 68 + 32 * nj + r32; m1[o] = a1[reg]; m2[o] = a2[reg]; }
        } else {
          f32x16 a1 = zero16();
#pragma unroll 2
          for (int ks = 0; ks < 8; ++ks) a1 = MFMA32(lds_rd128(lds + PI_DK, rowfrag_off(lane, mi, ks)), lds_rd128(lds + PI_DK, rowfrag_off(lane, nj, ks)), a1);
          LAS float* m1 = (LAS float*)(lds + PM_KKD);
#pragma unroll
          for (int reg = 0; reg < 16; ++reg) m1[(32 * mi + crow(reg, hl)) * 68 + 32 * nj + r32] = a1[reg];
        }
      }
      LAS float* vecs = (LAS float*)(lds + PV);
      if (tid < 64) {
        const float* ba = BA + (size_t)(row0 + tid) * 16;
        const float bf = ba[h], bb = ba[4 + h], af = ba[8 + h], ab = ba[12 + h];
        float xf = af, xb = ab;
#pragma unroll
        for (int o = 1; o < 64; o <<= 1) { const float yf = __shfl_up(xf, o), yb = __shfl_up(xb, o); if (lane >= o) { xf += yf; xb += yb; } }
        const float totf = __shfl(xf, 63), totb = __shfl(xb, 63);
        vecs[tid] = bf; vecs[64 + tid] = bb; vecs[128 + tid] = xf; vecs[192 + tid] = totb - xb + ab;
        if (tid == 0) { vecs[256] = totf; vecs[257] = totb; }
      }
      __syncthreads();
      unsigned char* blob_rt = MATS_RT + (size_t)((gc * 4 + h) * 2) * RT_BLOB; unsigned char* blob_dn = MATS_DN + (size_t)((gc * 4 + h) * 2) * DN_BLOB;
      const int lp = tid & 63, fi = tid >> 6, fmt = fi >> 2, fks = fi & 3, frow = 32 * fmt + (lp & 31), fhq = lp >> 5;
      {
        const LAS float* m1 = (const LAS float*)(lds + PM_QKR); const LAS float* m2 = (const LAS float*)(lds + PM_QKD);
        const float gfi = vecs[128 + frow], gbi = vecs[192 + frow];
        f32x8 pf, pb, df, db;
#pragma unroll
        for (int jj = 0; jj < 8; ++jj) { const int j = 16 * fks + 8 * (jj >> 2) + 4 * fhq + (jj & 3);
          const float x = m1[frow * 68 + j], y = m2[frow * 68 + j];
          pf[jj] = j <= frow ? x * __expf(lgf * (float)(frow - j)) : 0.f; pb[jj] = j >= frow ? x * __expf(lgb * (float)(j - frow)) : 0.f;
          df[jj] = j <= frow ? y * __expf(gfi - vecs[128 + j]) : 0.f; db[jj] = j >= frow ? y * __expf(gbi - vecs[192 + j]) : 0.f; }
        *(bf16x8*)(blob_rt + (fi * 64 + lp) * 16) = cvt8(pf); *(bf16x8*)(blob_rt + RT_BLOB + (fi * 64 + lp) * 16) = cvt8(pb);
        *(bf16x8*)(blob_dn + 8192 + (fi * 64 + lp) * 16) = cvt8(df); *(bf16x8*)(blob_dn + DN_BLOB + 8192 + (fi * 64 + lp) * 16) = cvt8(db);
        const LAS float* m3 = (const LAS float*)(lds + PM_KKD); LAS float* lf = (LAS float*)(lds + PL_F); LAS float* lb = (LAS float*)(lds + PL_B);
#pragma unroll
        for (int n = 0; n < 8; ++n) { const int e = tid + 512 * n, i = e >> 6, j = e & 63; const float kk = m3[i * 68 + j];
          lf[i * 68 + j] = j < i ? vecs[i] * kk * __expf(vecs[128 + i] - vecs[128 + j]) : 0.f;
          lb[i * 68 + j] = j > i ? vecs[64 + i] * kk * __expf(vecs[192 + i] - vecs[192 + j]) : 0.f; }
        if (tid < 64) { const float gf = vecs[128 + tid], gb = vecs[192 + tid], glf = vecs[256], glb = vecs[257];
          float* vf = (float*)(blob_dn + 16384); float* vb = (float*)(blob_dn + DN_BLOB + 16384);
          vf[tid] = __expf(gf); vf[64 + tid] = __expf(glf - gf); vb[tid] = __expf(gb); vb[64 + tid] = __expf(glb - gb);
          if (tid == 0) { vf[128] = __expf(glf); vb[128] = __expf(glb); } }
      }
      __syncthreads();
      if (w < 2) {
        const bool flip = (w == 1);
        const LAS float* Lm = (const LAS float*)(lds + (flip ? PL_B : PL_F)); LAS float* Tm = (LAS float*)(lds + (flip ? PT_B : PT_F));
        const int cl = flip ? 63 - lane : lane;
        float T[64];
#pragma unroll
        for (int i = 0; i < 64; ++i) {
          const float lrow = Lm[(flip ? 63 - i : i) * 68 + cl];
          float t = (lane == i) ? 1.f : 0.f;
#pragma unroll
          for (int j = 0; j < i; ++j) t -= __int_as_float(__builtin_amdgcn_readlane(__float_as_int(lrow), j)) * T[j];
          T[i] = t;
          __builtin_amdgcn_sched_barrier(0);
        }
        const float bc = vecs[(flip ? 64 : 0) + cl];
#pragma unroll
        for (int i = 0; i < 64; ++i) Tm[(flip ? 63 - i : i) * 68 + cl] = T[i] * bc;
      }
      __syncthreads();
      {
        const LAS float* tf = (const LAS float*)(lds + PT_F); const LAS float* tb = (const LAS float*)(lds + PT_B);
        f32x8 a, b;
#pragma unroll
        for (int jj = 0; jj < 8; ++jj) { const int j = 16 * fks + 8 * (jj >> 2) + 4 * fhq + (jj & 3); a[jj] = tf[frow * 68 + j]; b[jj] = tb[frow * 68 + j]; }
        *(bf16x8*)(blob_dn + (fi * 64 + lp) * 16) = cvt8(a); *(bf16x8*)(blob_dn + DN_BLOB + (fi * 64 + lp) * 16) = cvt8(b);
      }
    }
  }
  GRID_BARRIER();

  {
    PHASE_TID();
    const int w = wave, vsub = w >> 2, cb = (w & 3) * 32;
    LAS float* qdec = (LAS float*)(lds + SC_VEC);
    const int stride = bid < 64 ? 1000000 : (G - 64);
    for (int ci = bid; ci < 320; ci += stride) {
      int tid_c = threadIdx.x; asm volatile("" : "+v"(tid_c));
      const int tid = tid_c, lane = tid & 63, r32 = lane & 31, hl = lane >> 5;
      int type, sq, h, dir, chunk0, nsteps; bool lat;
      if (ci < 64) { lat = true; type = ci >> 5; sq = (ci >> 3) & 3; h = (ci >> 1) & 3; dir = ci & 1; chunk0 = 64 + 32 * sq; nsteps = 32; }
      else { const int c = ci - 64; lat = false; type = c >> 7; sq = (c >> 3) & 15; h = (c >> 1) & 3; dir = c & 1; chunk0 = 4 * sq; nsteps = 4; }
      f32x16 S[4];
      {
        const float* s0 = (type ? p.in[I_SDN] : p.in[I_SRET]) + ((((size_t)sq * 2 + dir) * NH + h) * DK) * DV + 32 * w + r32;
        if (lat) {
#pragma unroll
          for (int mt = 0; mt < 4; ++mt)
#pragma unroll
            for (int reg = 0; reg < 16; ++reg) S[mt][reg] = s0[(size_t)(32 * mt + srow(reg, hl)) * DV];
        } else {
#pragma unroll
          for (int mt = 0; mt < 4; ++mt) S[mt] = zero16();
        }
      }
      const float lg = DECLG[dir * 4 + h];
      const float c64 = __expf(64.f * lg);
      __syncthreads();
      if (tid < 64) qdec[tid] = __expf(lg * (dir ? (float)(64 - tid) : (float)(tid + 1)));
      scan_stage(lds, 0, type, dir, h, chunk0 + (dir ? nsteps - 1 : 0), QKV, KBUF, MATS_RT, MATS_DN, w, lane);
      bf16_t* O = type ? (dir ? ODB : ODF) : (dir ? ORB : ORF);
      for (int s = 0; s < nsteps; ++s) {
        int ln = lane; asm volatile("" : "+v"(ln));
        const int r32s = ln & 31, hls = ln >> 5;
        const int buf = s & 1, gc = chunk0 + (dir ? nsteps - 1 - s : s);
        asm volatile("s_waitcnt vmcnt(0)" ::: "memory");
        __syncthreads();
        bf16x8 Bv[4];
#pragma unroll
        for (int ks = 0; ks < 4; ++ks) Bv[ks] = lds_tr2(lds + SC_V + vsub * 16384, vtr_off(ln, cb, ks, 0), vtr_off(ln, cb, ks, 1));
        __syncthreads();
        if (s + 1 < nsteps) scan_stage(lds, buf ^ 1, type, dir, h, chunk0 + (dir ? nsteps - 2 - s : s + 1), QKV, KBUF, MATS_RT, MATS_DN, w, ln);
        LAS unsigned char* B = lds + buf * SC_BUF;
        bf16_t* ob = O + (size_t)gc * 64 * D + h * DV + 32 * w + r32s;
        if (type) {
          const LAS float* eg = (const LAS float*)(B + SC_M + 16384); const LAS float* cgv = eg + 64; const float egl = eg[128];
          bf16x8 Br[4];
#pragma unroll
          for (int mt = 0; mt < 2; ++mt) { f32x16 ra = zero16();
#pragma unroll
            for (int ks = 0; ks < 8; ++ks) ra = MFMA32(lds_rd128(B + SC_K, rowfrag_off(ln, mt, ks)), pack8(S[ks >> 1], ks & 1), ra);
            rowscale(ra, eg + 32 * mt, hls, -1.f); Br[2 * mt] = pack8(ra, 0); Br[2 * mt + 1] = pack8(ra, 1);
            __builtin_amdgcn_sched_barrier(0); }
          f32x16 vn[2];
#pragma unroll
          for (int mt = 0; mt < 2; ++mt) { vn[mt] = zero16();
#pragma unroll
            for (int ks = 0; ks < 4; ++ks) { const bf16x8 tf = lds_rd128(B + SC_M, (mt * 4 + ks) * 1024 + ln * 16);
              vn[mt] = MFMA32(tf, Bv[ks], vn[mt]); vn[mt] = MFMA32(tf, Br[ks], vn[mt]); }
            __builtin_amdgcn_sched_barrier(0); }
          bf16x8 Bn[4];
#pragma unroll
          for (int mt = 0; mt < 2; ++mt) { Bn[2 * mt] = pack8(vn[mt], 0); Bn[2 * mt + 1] = pack8(vn[mt], 1); }
          __builtin_amdgcn_sched_barrier(0);
#pragma unroll
          for (int mt = 0; mt < 2; ++mt) { f32x16 oa = zero16();
#pragma unroll
            for (int ks = 0; ks < 8; ++ks) oa = MFMA32(lds_rd128(B + SC_Q, rowfrag_off(ln, mt, ks)), pack8(S[ks >> 1], ks & 1), oa);
            rowscale(oa, eg + 32 * mt, hls, 1.f);
#pragma unroll
            for (int ks = 0; ks < 4; ++ks) oa = MFMA32(lds_rd128(B + SC_M, 8192 + (mt * 4 + ks) * 1024 + ln * 16), Bn[ks], oa);
#pragma unroll
            for (int s2 = 0; s2 < 2; ++s2) { const bf16x8 pk = pack8(oa, s2);
#pragma unroll
              for (int j = 0; j < 8; ++j) ob[(size_t)(32 * mt + crow(8 * s2 + j, hls)) * D] = (bf16_t)pk[j]; }
            __builtin_amdgcn_sched_barrier(0); }
#pragma unroll
          for (int mt = 0; mt < 2; ++mt) { rowscale(vn[mt], cgv + 32 * mt, hls, 1.f); Bn[2 * mt] = pack8(vn[mt], 0); Bn[2 * mt + 1] = pack8(vn[mt], 1); }
          __builtin_amdgcn_sched_barrier(0);
#pragma unroll
          for (int mt = 0; mt < 4; ++mt) { S[mt] = S[mt] * egl;
#pragma unroll
            for (int ks = 0; ks < 4; ++ks) S[mt] = MFMA32(lds_tr2(B + SC_K, ktr_off(ln, mt, ks, 0), ktr_off(ln, mt, ks, 1)), Bn[ks], S[mt]);
            __builtin_amdgcn_sched_barrier(0); }
        } else {
#pragma unroll
          for (int mt = 0; mt < 2; ++mt) { f32x16 oa = zero16();
#pragma unroll
            for (int ks = 0; ks < 8; ++ks) oa = MFMA32(lds_rd128(B + SC_Q, rowfrag_off(ln, mt, ks)), pack8(S[ks >> 1], ks & 1), oa);
            rowscale(oa, qdec + 32 * mt, hls, 1.f);
#pragma unroll
            for (int ks = 0; ks < 4; ++ks) oa = MFMA32(lds_rd128(B + SC_M, (mt * 4 + ks) * 1024 + ln * 16), Bv[ks], oa);
#pragma unroll
            for (int s2 = 0; s2 < 2; ++s2) { const bf16x8 pk = pack8(oa, s2);
#pragma unroll
              for (int j = 0; j < 8; ++j) ob[(size_t)(32 * mt + crow(8 * s2 + j, hls)) * D] = (bf16_t)pk[j]; }
            __builtin_amdgcn_sched_barrier(0); }
#pragma unroll
          for (int mt = 0; mt < 4; ++mt) { S[mt] = S[mt] * c64;
#pragma unroll
            for (int ks = 0; ks < 4; ++ks) S[mt] = MFMA32(lds_tr2(B + SC_K, ktr_off(ln, mt, ks, 0), ktr_off(ln, mt, ks, 1)), Bv[ks], S[mt]);
            __builtin_amdgcn_sched_barrier(0); }
        }
      }
      if (!lat) {
        int ln3 = threadIdx.x & 63; asm volatile("" : "+v"(ln3)); const int hl3 = ln3 >> 5;
        float* so = (type ? NS_DN : NS_RET) + ((((size_t)sq * 2 + dir) * NH + h) * DK) * DV + 32 * w + (ln3 & 31);
#pragma unroll
        for (int mt = 0; mt < 4; ++mt)
#pragma unroll
          for (int reg = 0; reg < 16; ++reg) so[(size_t)(32 * mt + srow(reg, hl3)) * DV] = S[mt][reg];
      }
    }
  }
  GRID_BARRIER();

  bf16_t* GATES = QKV;
  {
    pg8::Gemm g{HB, WGATE, MTOT, 4096, D}; pg8::StaticOrder S; S.init(MTOT, 4096, G, bid);
    pg8::EpiBf16Act<1> E{GATES, LDG};
    pg8::gemm_phase<pg8::EpiBf16Act<1>, pg8::StaticOrder, true, true>(lds, g, S, E);
  }
  GRID_BARRIER();

  bf16_t* AR = (bf16_t*)(ws + WS_AR); bf16_t* AD = (bf16_t*)(ws + WS_AD);
  {
    PHASE_TID();
    for (int it = gw; it < MTOT * NH; it += ngw) {
      const int h = it & 3, m = it >> 2; const size_t base = (size_t)m * D + h * DV + 4 * lane;
      {
        const u32x2 a = *(const u32x2*)(ORF + base), b = *(const u32x2*)(ORB + base);
        float v[4] = {lo_bf(a.x) + lo_bf(b.x), hi_bf(a.x) + hi_bf(b.x), lo_bf(a.y) + lo_bf(b.y), hi_bf(a.y) + hi_bf(b.y)};
        const float mu = wave_sum((v[0] + v[1]) + (v[2] + v[3])) * (1.f / DV);
        float q = 0.f;
#pragma unroll
        for (int e = 0; e < 4; ++e) { v[e] -= mu; q += v[e] * v[e]; }
        const float rs = rsqrtf(wave_sum(q) * (1.f / DV) + EPS);
        const f32x4 gw4 = *(const f32x4*)(p.in[I_GNW] + h * DV + 4 * lane);
        const u32x2 gt = *(const u32x2*)(GATES + (size_t)m * LDG + G_RG + h * DV + 4 * lane);
        u32x2 o; o.x = pk2(lo_bf(gt.x) * (v[0] * rs * gw4.x), hi_bf(gt.x) * (v[1] * rs * gw4.y)); o.y = pk2(lo_bf(gt.y) * (v[2] * rs * gw4.z), hi_bf(gt.y) * (v[3] * rs * gw4.w));
        *(u32x2*)(AR + base) = o;
      }
      {
        const u32x2 a = *(const u32x2*)(ODF + base), b = *(const u32x2*)(ODB + base);
        float v[4] = {lo_bf(a.x) + lo_bf(b.x), hi_bf(a.x) + hi_bf(b.x), lo_bf(a.y) + lo_bf(b.y), hi_bf(a.y) + hi_bf(b.y)};
        const float rs = rsqrtf(wave_sum((v[0] * v[0] + v[1] * v[1]) + (v[2] * v[2] + v[3] * v[3])) * (1.f / DV) + EPS);
        const f32x4 dw4 = *(const f32x4*)(p.in[I_DNW] + 4 * lane);
        const u32x2 gt = *(const u32x2*)(GATES + (size_t)m * LDG + G_DZ + h * DV + 4 * lane);
        u32x2 o; o.x = pk2(v[0] * rs * dw4.x * lo_bf(gt.x), v[1] * rs * dw4.y * hi_bf(gt.x)); o.y = pk2(v[2] * rs * dw4.z * lo_bf(gt.y), v[3] * rs * dw4.w * hi_bf(gt.y));
        *(u32x2*)(AD + base) = o;
      }
    }
  }
  GRID_BARRIER();

  bf16_t* T1 = HB;
  {
    pg8::Gemm g{AR, WRO, MTOT, D, D}; pg8::StaticOrder S; S.init(MTOT, D, G, bid);
    pg8::EpiGateMul E{T1, D, GATES + G_GR, LDG, nullptr};
    pg8::gemm_phase<pg8::EpiGateMul, pg8::StaticOrder, true, true>(lds, g, S, E);
  }
  GRID_BARRIER();
  bf16_t* MERGED = (bf16_t*)(ws + WS_MERGED);
  {
    pg8::Gemm g{AD, WDO, MTOT, D, D}; pg8::StaticOrder S; S.init(MTOT, D, G, bid);
    pg8::EpiGateMul E{MERGED, D, GATES + G_GD, LDG, T1};
    pg8::gemm_phase<pg8::EpiGateMul, pg8::StaticOrder, true, true>(lds, g, S, E);
  }
  GRID_BARRIER();
  float* M1 = (float*)(ws + WS_O);
  {
    pg8::Gemm g{MERGED, WOUT, MTOT, D, D}; pg8::StaticOrder S; S.init(MTOT, D, G, bid);
    pg8::EpiF32 E{M1, D};
    pg8::gemm_phase<pg8::EpiF32, pg8::StaticOrder, true, true>(lds, g, S, E);
  }
  GRID_BARRIER();

  bf16_t* WF1 = (bf16_t*)(ws + WS_WF1); bf16_t* WF2 = (bf16_t*)(ws + WS_WF2);
  {
    PHASE_TID();
    LAS float* scr = (LAS float*)(lds + wave * 16384);
    transpose_matrix(p.in[I_WF1], 2 * DFF, D, 2 * DFF, WF1, [](int n) { const int pn = n >> 8, w = n & 255; return w < 128 ? 128 * pn + w : DFF + 128 * pn + (w - 128); }, scr, gw, ngw, lane);
    transpose_matrix(p.in[I_WF2], D, DFF, D, WF2, [](int n) { return n; }, scr, gw, ngw, lane);
    const float* nw1 = p.in[I_NORMW] + D; const float* nw2 = p.in[I_NORMW] + 2 * D;
    for (int m = gw; m < MTOT; m += ngw) {
      const float* xr = xrow(p, m); const float* md = MOD + (size_t)cond_of_row(m) * 6 * D; const float* mr = M1 + (size_t)m * D;
      f32x4 v[4]; float s = 0.f;
#pragma unroll
      for (int j = 0; j < 4; ++j) { v[j] = *(const f32x4*)(mr + 4 * lane + 256 * j); s += (v[j].x * v[j].x + v[j].y * v[j].y) + (v[j].z * v[j].z + v[j].w * v[j].w); }
      const float r = rsqrtf(wave_sum(s) * (1.f / D) + EPS);
      float s2 = 0.f;
#pragma unroll
      for (int j = 0; j < 4; ++j) { const int c0 = 4 * lane + 256 * j;
        v[j] = *(const f32x4*)(xr + c0) + *(const f32x4*)(md + 2 * D + c0) * (v[j] * r * *(const f32x4*)(nw1 + c0));
        *(f32x4*)(p.out + (size_t)m * D + c0) = v[j];
        s2 += (v[j].x * v[j].x + v[j].y * v[j].y) + (v[j].z * v[j].z + v[j].w * v[j].w); }
      const float r2 = rsqrtf(wave_sum(s2) * (1.f / D) + EPS);
#pragma unroll
      for (int j = 0; j < 4; ++j) { const int c0 = 4 * lane + 256 * j;
        const f32x4 h = v[j] * r2 * *(const f32x4*)(nw2 + c0) * (*(const f32x4*)(md + 4 * D + c0) + 1.f) + *(const f32x4*)(md + 3 * D + c0);
        u32x2 o; o.x = pk2(h.x, h.y); o.y = pk2(h.z, h.w); *(u32x2*)(HB + (size_t)m * D + c0) = o; }
    }
  }
  GRID_BARRIER();

  bf16_t* ACT = QKV;
  {
    pg8::Gemm g{HB, WF1, MTOT, 2 * DFF, D}; pg8::StaticOrder S; S.init(MTOT, 2 * DFF, G, bid);
    pg8::EpiSwiGLU E{ACT, DFF};
    pg8::gemm_phase<pg8::EpiSwiGLU, pg8::StaticOrder, true, true>(lds, g, S, E);
  }
  GRID_BARRIER();
  float* F = (float*)(ws + WS_O);
  {
    pg8::Gemm g{ACT, WF2, MTOT, D, DFF}; pg8::StaticOrder S; S.init(MTOT, D, G, bid);
    pg8::EpiF32 E{F, D};
    pg8::gemm_phase<pg8::EpiF32, pg8::StaticOrder, true, true>(lds, g, S, E);
  }
  GRID_BARRIER();
  {
    PHASE_TID();
    const float* nw3 = p.in[I_NORMW] + 3 * D;
    for (int m = gw; m < MTOT; m += ngw) {
      const float* md = MOD + (size_t)cond_of_row(m) * 6 * D; const float* fr = F + (size_t)m * D; float* orow = p.out + (size_t)m * D;
      f32x4 v[4]; float s = 0.f;
#pragma unroll
      for (int j = 0; j < 4; ++j) { v[j] = *(const f32x4*)(fr + 4 * lane + 256 * j); s += (v[j].x * v[j].x + v[j].y * v[j].y) + (v[j].z * v[j].z + v[j].w * v[j].w); }
      const float r = rsqrtf(wave_sum(s) * (1.f / D) + EPS);
#pragma unroll
      for (int j = 0; j < 4; ++j) { const int c0 = 4 * lane + 256 * j;
        *(f32x4*)(orow + c0) = *(const f32x4*)(orow + c0) + *(const f32x4*)(md + 5 * D + c0) * (v[j] * r * *(const f32x4*)(nw3 + c0)); }
    }
  }
}

extern "C" void kernel_launch(void* const* d_in, const int* in_sizes, int n_in, void* d_out, int out_size, void* d_ws, size_t ws_size, hipStream_t stream) {
  static int grid_blocks = 0;
  if (!grid_blocks) {
    int dev = 0, cus = 0, per_cu = 0;
    (void)hipGetDevice(&dev);
    (void)hipDeviceGetAttribute(&cus, hipDeviceAttributeMultiprocessorCount, dev);
    (void)hipFuncSetAttribute((const void*)fwd_megakernel, hipFuncAttributeMaxDynamicSharedMemorySize, LDS_BYTES);
    (void)hipOccupancyMaxActiveBlocksPerMultiprocessor(&per_cu, (const void*)fwd_megakernel, NTHREADS, LDS_BYTES);
    if (per_cu < 1) per_cu = 1;
    grid_blocks = cus * per_cu;
    if (n_in != 21 || ws_size < WS_END) fprintf(stderr, "kernel_launch: unexpected n_in %d / ws_size %zu\n", n_in, ws_size);
    fprintf(stderr, "kernel_launch: cus %d per_cu %d grid %d ws %zu out %d\n", cus, per_cu, grid_blocks, ws_size, out_size);
  }
  (void)hipMemsetAsync((unsigned char*)d_ws + WS_BAR, 0, 16384, stream);
  Params p{};
  for (int i = 0; i < 21; ++i) p.in[i] = (const float*)d_in[i];
  p.out = (float*)d_out; p.ws = (unsigned char*)d_ws;
  void* args[] = {&p};
  hipError_t e = hipLaunchCooperativeKernel((const void*)fwd_megakernel, dim3(grid_blocks), dim3(NTHREADS), args, LDS_BYTES, stream);
  if (e != hipSuccess) fprintf(stderr, "cooperative launch failed: %s (grid %d)\n", hipGetErrorString(e), grid_blocks);
}
```

```cpp
#include <hip/hip_runtime.h>
#include <hip/hip_cooperative_groups.h>
#include <cstdio>
#include <cstdint>
namespace cg = cooperative_groups;

#define LAS __attribute__((address_space(3)))
typedef unsigned short bf16_t;
typedef short bf16x8 __attribute__((ext_vector_type(8)));
typedef float f32x4 __attribute__((ext_vector_type(4)));
typedef float f32x2 __attribute__((ext_vector_type(2)));
typedef unsigned u32x4 __attribute__((ext_vector_type(4)));
typedef unsigned u32x2 __attribute__((ext_vector_type(2)));

constexpr int D = 1024, MCTX = 4096, MLAT = 8192, MTOT = 12288, LCTX = 256, LLAT = 2048, NCTX = 16, NLAT = 4;
constexpr int NH = 4, DK = 128, DV = 256, DFF = 2816, INC = 8208;
constexpr float EPS = 1e-6f;
constexpr float QSCALE = 0.08838834764831845f;
constexpr int NTHREADS = 512, NWAVES = 8;
constexpr int LDS_BYTES = 135168;
constexpr int Q_RQ = 0, Q_RK = 512, Q_RV = 1024, Q_DQ = 2048, Q_DK = 2560, Q_DV = 3072, LDQ = 4096;
constexpr int G_RG = 0, G_DZ = 1024, G_GR = 2048, G_GD = 3072, LDG = 4096;
constexpr int C_RQ = 0, C_RG = 2048, C_DQ = 3072, C_DZ = 5120, C_DB = 6144, C_GR = 6160;

constexpr size_t MiB = 1u << 20;
constexpr size_t WS_MOD = 0;
constexpr size_t WS_ROPE = 128 * 1024;
constexpr size_t WS_BAR = 1152 * 1024;
constexpr size_t WS_BA = 1280 * 1024;
constexpr size_t WS_WQKV = 2 * MiB;
constexpr size_t WS_WGATE = 10 * MiB;
constexpr size_t WS_WRO = 18 * MiB, WS_WDO = 20 * MiB, WS_WOUT = 22 * MiB;
constexpr size_t WS_H = 24 * MiB;
constexpr size_t WS_QKV = 48 * MiB;
constexpr size_t WS_MATS_DN = 144 * MiB;
constexpr size_t WS_MATS_RT = 170 * MiB;
constexpr size_t WS_KB = 182 * MiB;
constexpr size_t WS_HALO = 194 * MiB;
constexpr size_t WS_O = 196 * MiB;
constexpr size_t WS_END = 244 * MiB;
constexpr size_t WS_AR = 144 * MiB, WS_AD = 168 * MiB, WS_MERGED = 144 * MiB;
constexpr size_t WS_WF1 = 144 * MiB, WS_WF2 = 155 * MiB;

struct Params {
  const float* in[21];
  float* out;
  unsigned char* ws;
};
enum { I_XP = 0, I_XS, I_C, I_SRET, I_SDN, I_CCTX, I_WMOD, I_BMOD, I_NORMW, I_WIN, I_CONVW, I_DECAY, I_GNW, I_ALOG, I_DTB, I_DNW, I_WRO, I_WDO, I_WOUT, I_WF1, I_WF2 };

__device__ __forceinline__ float bf2f(unsigned short b) { return __uint_as_float((unsigned)b << 16); }
__device__ __forceinline__ unsigned f2bf(float f) { unsigned u = __float_as_uint(f); return (u + 0x7fffu + ((u >> 16) & 1u)) >> 16; }
__device__ __forceinline__ unsigned pk2(float lo, float hi) { return f2bf(lo) | (f2bf(hi) << 16); }
__device__ __forceinline__ unsigned cvt_pk_bf16(float lo, float hi) { unsigned r; asm volatile("v_cvt_pk_bf16_f32 %0, %1, %2" : "=v"(r) : "v"(lo), "v"(hi)); return r; }
__device__ __forceinline__ float lo_bf(unsigned w) { return __uint_as_float(w << 16); }
__device__ __forceinline__ float hi_bf(unsigned w) { return __uint_as_float(w & 0xffff0000u); }
__device__ __forceinline__ float siluf(float x) { return x / (1.f + __expf(-x)); }
__device__ __forceinline__ float sigmf(float x) { return 1.f / (1.f + __expf(-x)); }
__device__ __forceinline__ float softplusf(float x) { return x > 20.f ? x : log1pf(expf(x)); }
__device__ __forceinline__ float wave_sum(float v) {
#pragma unroll
  for (int o = 1; o < 64; o <<= 1) v += __shfl_xor(v, o);
  return v;
}
__device__ __forceinline__ int lane_id() { return (int)__builtin_amdgcn_mbcnt_hi(~0u, __builtin_amdgcn_mbcnt_lo(~0u, 0u)); }
__device__ __forceinline__ int cond_of_row(int m) { return m < MCTX ? 0 : 1 + (m - MCTX) / LLAT; }
__device__ __forceinline__ const float* xrow(const Params& p, int m) { return m < MCTX ? p.in[I_XP] + (size_t)m * D : p.in[I_XS] + (size_t)(m - MCTX) * D; }


__device__ __forceinline__ int lane_id();
#define XB_TMO      128
#define XB_XCNT(j)  (256  + 64 * (j))
#define XB_XSUB(j)  (1280 + 64 * (j))
#define XB_XGEN(j)  (2304 + 64 * (j))
#define XB_TOP      3328
#define XB_TOPGEN   3392
#define XCD_BAR_WORDS 3456
#define XB_SPIN_CAP (1u << 18)
__device__ __forceinline__ unsigned xb_ld(unsigned* p)              { return __hip_atomic_load(p, __ATOMIC_RELAXED, __HIP_MEMORY_SCOPE_AGENT); }
__device__ __forceinline__ unsigned xb_add(unsigned* p, unsigned v) { return __hip_atomic_fetch_add(p, v, __ATOMIC_RELAXED, __HIP_MEMORY_SCOPE_AGENT); }
__device__ __forceinline__ unsigned xb_xcc_id() { return (unsigned)__builtin_amdgcn_s_getreg((3 << 11) | 20) & 0xFu; }
#define XB_SPIN(cond, bar) do { unsigned _sp = 0; while (cond) { __builtin_amdgcn_s_sleep(1); \
    if ((++_sp & 255u) == 0u) { if (xb_ld(&(bar)[XB_TMO])) break; if (_sp > XB_SPIN_CAP) { atomicAdd(&(bar)[XB_TMO], 1u); break; } } } } while (0)
struct XcdBarrier { unsigned* bar; unsigned x; volatile LAS unsigned* st; };
__device__ __forceinline__ XcdBarrier xcd_barrier_post(unsigned* bar, volatile LAS unsigned* st) {
  XcdBarrier b; b.bar = bar; b.x = xb_xcc_id(); b.st = st;
  if (threadIdx.x == 0) (void)xb_add(&bar[XB_XCNT(b.x)], 1u);
  return b;
}
__device__ __forceinline__ void xcd_barrier_complete(unsigned* bar, unsigned x, unsigned& nloc, unsigned& nx) {
  const unsigned G = gridDim.x * gridDim.y * gridDim.z;
  unsigned sum, cnt, mine, sp = 0u;
  for (;;) {
    sum = 0u; cnt = 0u; mine = 0u;
#pragma unroll
    for (unsigned j = 0; j < 16; ++j) { const unsigned c = xb_ld(&bar[XB_XCNT(j)]); sum += c; cnt += (c > 0u) ? 1u : 0u; mine = (j == x) ? c : mine; }
    if (sum == G) break;
    __builtin_amdgcn_s_sleep(1);
    if ((++sp & 255u) == 0u) { if (xb_ld(&bar[XB_TMO])) break; if (sp > XB_SPIN_CAP) { atomicAdd(&bar[XB_TMO], 1u); break; } }
  }
  nloc = mine > 0u ? mine : 1u; nx = cnt > 0u ? cnt : 1u;
}
__device__ __forceinline__ void xcd_barrier(const XcdBarrier& b, const int wave) {
  asm volatile("s_waitcnt vmcnt(0)" ::: "memory");
  __syncthreads();
  if (wave == 0 && lane_id() == 0) {
    unsigned* bar = b.bar;
    __builtin_amdgcn_s_waitcnt(0);
    unsigned nloc = b.st[0], nx = b.st[1];
    if (nloc == 0u) { xcd_barrier_complete(bar, b.x, nloc, nx); b.st[0] = nloc; b.st[1] = nx; }
    const unsigned old = xb_add(&bar[XB_XSUB(b.x)], 1u);
    const unsigned gen = old / nloc;
    if (old + 1u == (gen + 1u) * nloc) {
      __builtin_amdgcn_fence(__ATOMIC_RELEASE, "agent");
      asm volatile("s_waitcnt vmcnt(0)" ::: "memory");
      const unsigned og = xb_add(&bar[XB_TOP], 1u);
      const unsigned tg = og / nx;
      if (og + 1u == (tg + 1u) * nx) xb_add(&bar[XB_TOPGEN], 1u);
      else XB_SPIN(xb_ld(&bar[XB_TOPGEN]) == tg, bar);
      __builtin_amdgcn_fence(__ATOMIC_ACQUIRE, "agent");
      xb_add(&bar[XB_XGEN(b.x)], 1u);
      asm volatile("s_waitcnt vmcnt(0)" ::: "memory");
    } else {
      XB_SPIN(xb_ld(&bar[XB_XGEN(b.x)]) == gen, bar);
      __builtin_amdgcn_fence(__ATOMIC_ACQUIRE, "agent");
      asm volatile("s_waitcnt vmcnt(0)" ::: "memory");
    }
  }
  __syncthreads();
}

namespace pg8 {
constexpr int BM = 256, BK = 64, HALF = 128, HTB = HALF * BK * 2, STAGE_BYTES = 8 * HTB, NXCD = 8, WGM = 8;
__host__ __device__ __forceinline__ int lds_byte(int r, int c) { const int st = (r >> 4) * 2 + (c >> 5), rr = r & 15, cc = c & 31, ob = rr * 64 + cc * 2; return st * 1024 + (ob ^ (((ob >> 9) & 1) << 5)); }
__host__ __device__ __forceinline__ void stage_rc(int b, int& R, int& C) { const int st = b / 1024, sb = b % 1024, swz = sb ^ (((sb >> 9) & 1) << 5); R = (st >> 1) * 16 + swz / 64; C = (st & 1) * 32 + (swz % 64) / 2; }
__host__ __device__ __forceinline__ int perm32(int rho) { const int n = rho >> 4, i = rho & 15; return 8 * (i >> 2) + 4 * n + (i & 3); }
struct Unit { int pm, pn; };
struct Gemm { const bf16_t* A; const bf16_t* Bt; int M, N, K; };
struct StaticOrder {
  int nM, nN, nwg, G, c;
  __host__ __device__ void init(int M, int N, int G_, int c_) { nM = M / BM; nN = N / BM; nwg = nM * nN; G = G_; c = c_; }
  __host__ __device__ bool next(int i, Unit& u) const {
    const long L = (long)i * G + c; if (L >= nwg) return false;
    int wgid = (int)L; { const int q = nwg / NXCD, r = nwg % NXCD, xcd = wgid % NXCD, off = wgid / NXCD; wgid = (xcd < r ? xcd * (q + 1) : r * (q + 1) + (xcd - r) * q) + off; }
    const int nig = WGM * nN, gid = wgid / nig, fm = gid * WGM, gsz = (nM - fm) < WGM ? (nM - fm) : WGM;
    u.pm = fm + ((wgid % nig) % gsz); u.pn = (wgid % nig) / gsz; return true;
  }
  __device__ __forceinline__ void a_ready(const Unit&) const {}
  __device__ __forceinline__ void done(const Unit&) const {}
};

template <int MODE  > struct EpiBf16Act {
  static constexpr bool PERM = true, AFTER_DRAIN = false;
  bf16_t* O; int ldc;
  __device__ __forceinline__ void operator()(const f32x4 (&acc)[2][2][4][2], const Unit& u, int wr, int wc, int fr, int fq) const {
    const int row0 = u.pm * BM + wr * 64 + fr, col0 = u.pn * BM + wc * 32 + 8 * fq;
    const bool sg = u.pn >= 8;
#pragma unroll
    for (int ai = 0; ai < 2; ++ai)
#pragma unroll
      for (int m = 0; m < 4; ++m) { bf16_t* rowp = O + (size_t)(row0 + ai * HALF + m * 16) * ldc + col0;
#pragma unroll
        for (int bj = 0; bj < 2; ++bj) { f32x4 v0 = acc[ai][bj][m][0], v1 = acc[ai][bj][m][1];
          if (MODE == 1) {
#pragma unroll
            for (int i = 0; i < 4; ++i) { const float s0 = __builtin_amdgcn_rcpf(1.f + __expf(-v0[i])), s1 = __builtin_amdgcn_rcpf(1.f + __expf(-v1[i]));
              v0[i] = sg ? s0 : v0[i] * s0; v1[i] = sg ? s1 : v1[i] * s1; } }
          u32x4 w; w.x = cvt_pk_bf16(v0[0], v0[1]); w.y = cvt_pk_bf16(v0[2], v0[3]); w.z = cvt_pk_bf16(v1[0], v1[1]); w.w = cvt_pk_bf16(v1[2], v1[3]);
          *(u32x4*)(rowp + bj * HALF) = w; } }
  }
};
struct EpiQKV {
  static constexpr bool PERM = true, AFTER_DRAIN = false;
  bf16_t* O; int ldc; bf16_t* HALO;
  __device__ __forceinline__ void operator()(const f32x4 (&acc)[2][2][4][2], const Unit& u, int wr, int wc, int fr, int fq) const {
    const int row0 = u.pm * BM + wr * 64 + fr, col0 = u.pn * BM + wc * 32 + 8 * fq;
#pragma unroll
    for (int ai = 0; ai < 2; ++ai)
#pragma unroll
      for (int m = 0; m < 4; ++m) { const int row = row0 + ai * HALF + m * 16; bf16_t* rowp = O + (size_t)row * ldc + col0;
#pragma unroll
        for (int bj = 0; bj < 2; ++bj) { const f32x4 v0 = acc[ai][bj][m][0], v1 = acc[ai][bj][m][1];
          u32x4 w; w.x = cvt_pk_bf16(v0[0], v0[1]); w.y = cvt_pk_bf16(v0[2], v0[3]); w.z = cvt_pk_bf16(v1[0], v1[1]); w.w = cvt_pk_bf16(v1[2], v1[3]);
          *(u32x4*)(rowp + bj * HALF) = w;
          if (u.pn >= 8 && ((m == 0 && fr == 0) || (m == 3 && fr == 15)))
            *(u32x4*)(HALO + ((size_t)(row >> 6) * 2 + (m == 3 ? 1 : 0)) * 2048 + (col0 - 2048) + bj * HALF) = w; } }
  }
};
struct EpiGateMul {
  static constexpr bool PERM = true, AFTER_DRAIN = false;
  bf16_t* O; int ldc; const bf16_t* G; int ldg; const bf16_t* Add;
  __device__ __forceinline__ void operator()(const f32x4 (&acc)[2][2][4][2], const Unit& u, int wr, int wc, int fr, int fq) const {
    const int row0 = u.pm * BM + wr * 64 + fr, col0 = u.pn * BM + wc * 32 + 8 * fq;
#pragma unroll
    for (int ai = 0; ai < 2; ++ai)
#pragma unroll
      for (int m = 0; m < 4; ++m) { const size_t r = (size_t)(row0 + ai * HALF + m * 16);
#pragma unroll
        for (int bj = 0; bj < 2; ++bj) { const f32x4 v0 = acc[ai][bj][m][0], v1 = acc[ai][bj][m][1];
          const u32x4 g = *(const u32x4*)(G + r * ldg + col0 + bj * HALF);
          float o[8] = {v0[0] * lo_bf(g.x), v0[1] * hi_bf(g.x), v0[2] * lo_bf(g.y), v0[3] * hi_bf(g.y), v1[0] * lo_bf(g.z), v1[1] * hi_bf(g.z), v1[2] * lo_bf(g.w), v1[3] * hi_bf(g.w)};
          if (Add) { const u32x4 a = *(const u32x4*)(Add + r * ldc + col0 + bj * HALF);
            o[0] += lo_bf(a.x); o[1] += hi_bf(a.x); o[2] += lo_bf(a.y); o[3] += hi_bf(a.y); o[4] += lo_bf(a.z); o[5] += hi_bf(a.z); o[6] += lo_bf(a.w); o[7] += hi_bf(a.w); }
          u32x4 w; w.x = cvt_pk_bf16(o[0], o[1]); w.y = cvt_pk_bf16(o[2], o[3]); w.z = cvt_pk_bf16(o[4], o[5]); w.w = cvt_pk_bf16(o[6], o[7]);
          *(u32x4*)(O + r * ldc + col0 + bj * HALF) = w; } }
  }
};
struct EpiF32 {
  static constexpr bool PERM = false, AFTER_DRAIN = false;
  float* O; int ldc;
  __device__ __forceinline__ void operator()(const f32x4 (&acc)[2][2][4][2], const Unit& u, int wr, int wc, int fr, int fq) const {
    const int row0 = u.pm * BM + wr * 64 + fr, col0 = u.pn * BM + wc * 32 + 4 * fq;
#pragma unroll
    for (int ai = 0; ai < 2; ++ai)
#pragma unroll
      for (int m = 0; m < 4; ++m) { float* rowp = O + (size_t)(row0 + ai * HALF + m * 16) * ldc + col0;
#pragma unroll
        for (int bj = 0; bj < 2; ++bj)
#pragma unroll
          for (int n = 0; n < 2; ++n) *(f32x4*)(rowp + bj * HALF + n * 16) = acc[ai][bj][m][n]; }
  }
};
struct EpiSwiGLU {
  static constexpr bool PERM = true, AFTER_DRAIN = false;
  bf16_t* O; int ldc;
  __device__ __forceinline__ void operator()(const f32x4 (&acc)[2][2][4][2], const Unit& u, int wr, int wc, int fr, int fq) const {
    const int row0 = u.pm * BM + wr * 64 + fr, col0 = u.pn * HALF + wc * 32 + 8 * fq;
#pragma unroll
    for (int ai = 0; ai < 2; ++ai)
#pragma unroll
      for (int m = 0; m < 4; ++m) { bf16_t* rowp = O + (size_t)(row0 + ai * HALF + m * 16) * ldc + col0;
        float o[8];
#pragma unroll
        for (int n = 0; n < 2; ++n)
#pragma unroll
          for (int i = 0; i < 4; ++i) { const float g = acc[ai][0][m][n][i], up = acc[ai][1][m][n][i]; o[4 * n + i] = g * __builtin_amdgcn_rcpf(1.f + __expf(-g)) * up; }
        u32x4 w; w.x = cvt_pk_bf16(o[0], o[1]); w.y = cvt_pk_bf16(o[2], o[3]); w.z = cvt_pk_bf16(o[4], o[5]); w.w = cvt_pk_bf16(o[6], o[7]);
        *(u32x4*)rowp = w; }
  }
};

template <class Epi, class Sched, bool ALIGN_EPI = false, bool SP2 = false>
__device__ __forceinline__ void gemm_phase(LAS unsigned char* lds, const Gemm g, const Sched& S, const Epi& E, const int wid) {
  int lane_o = lane_id(); asm volatile("" : "+v"(lane_o));
  const int lane = lane_o, tid = (wid << 6) | lane, wr = wid >> 2, wc = wid & 3, fr = lane & 15, fq = lane >> 4;
  const int K = g.K, nt = K / BK;
  unsigned voffA[2], voffB[2];
#pragma unroll
  for (int i = 0; i < 2; ++i) { int R, C; stage_rc(tid * 16 + i * 8192, R, C); const int Rb = Epi::PERM ? ((R & ~31) + perm32(R & 31)) : R;
    voffA[i] = (unsigned)(R * K + C) * 2u; voffB[i] = (unsigned)(Rb * K + C) * 2u; }
  const size_t kstep = (size_t)(BK * 2);
  const size_t hstep = (size_t)HALF * K * 2;
  const size_t tstep = 2 * hstep;
  const unsigned ldsw = (unsigned)wid * 1024u;
  const int aoff = lds_byte(wr * 64 + fr, fq * 8), boff = lds_byte(wc * 32 + fr, fq * 8);
#define PG8_SA(b, h) (((b) * 2 + (h)) * HTB)
#define PG8_SB(b, h) ((4 + (b) * 2 + (h)) * HTB)
#define PG8_STAGE(bufoff, gbase, voff) do { _Pragma("unroll") for (int _i = 0; _i < 2; ++_i) \
    __builtin_amdgcn_global_load_lds((const unsigned*)((const char*)(gbase) + (voff)[_i]), (LAS unsigned*)(lds + (bufoff) + ldsw + _i * 8192), 16, 0, 0); } while (0)
#define PG8_LDA(dst, b, h) do { _Pragma("unroll") for (int m = 0; m < 4; ++m) _Pragma("unroll") for (int k = 0; k < 2; ++k) dst[m][k] = *(const LAS bf16x8*)(lds + PG8_SA(b, h) + aoff + m * 2048 + k * 1024); } while (0)
#define PG8_LDB(dst, b, h) do { _Pragma("unroll") for (int n = 0; n < 2; ++n) _Pragma("unroll") for (int k = 0; k < 2; ++k) dst[n][k] = *(const LAS bf16x8*)(lds + PG8_SB(b, h) + boff + n * 2048 + k * 1024); } while (0)
#define PG8_MMA(ai, bj, At, Bt) do { __builtin_amdgcn_s_setprio(1); _Pragma("unroll") for (int m = 0; m < 4; ++m) _Pragma("unroll") for (int n = 0; n < 2; ++n) _Pragma("unroll") for (int k = 0; k < 2; ++k) \
    acc[ai][bj][m][n] = __builtin_amdgcn_mfma_f32_16x16x32_bf16(Bt[n][k], At[m][k], acc[ai][bj][m][n], 0, 0, 0); __builtin_amdgcn_s_setprio(0); } while (0)
#define PG8_WAIT_V(n) asm volatile("s_waitcnt vmcnt(" #n ")" ::: "memory")
#define PG8_WAIT_L(n) asm volatile("s_waitcnt lgkmcnt(" #n ")" ::: "memory")
#define PG8_BAR __builtin_amdgcn_s_barrier()
#define PG8_SCHED __builtin_amdgcn_sched_barrier(0)
  Unit cur, nxt; int ui = 0;
  if (!S.next(0, cur)) return;
  f32x4 acc[2][2][4][2];
#pragma unroll
  for (int a = 0; a < 2; ++a)
#pragma unroll
    for (int b = 0; b < 2; ++b)
#pragma unroll
      for (int m = 0; m < 4; ++m)
#pragma unroll
        for (int n = 0; n < 2; ++n) acc[a][b][m][n] = (f32x4){0.f, 0.f, 0.f, 0.f};
  bf16x8 At[4][2], B0[2][2], B1[2][2];
  const char* cA = (const char*)g.A + (size_t)cur.pm * tstep; const char* cB = (const char*)g.Bt + (size_t)cur.pn * tstep;
  S.a_ready(cur);
  if constexpr (SP2) {
    PG8_STAGE(PG8_SB(0, 0), cB, voffB); PG8_STAGE(PG8_SB(0, 1), cB + hstep, voffB); PG8_STAGE(PG8_SA(0, 0), cA, voffA); PG8_STAGE(PG8_SA(0, 1), cA + hstep, voffA);
    if (wr == 1) PG8_BAR;
    PG8_WAIT_V(2); PG8_BAR;
    PG8_STAGE(PG8_SB(1, 0), cB + kstep, voffB); PG8_STAGE(PG8_SA(1, 0), cA + kstep, voffA); PG8_STAGE(PG8_SB(1, 1), cB + hstep + kstep, voffB);
    PG8_WAIT_V(6); PG8_BAR;
  } else {
    PG8_STAGE(PG8_SB(0, 0), cB, voffB); PG8_STAGE(PG8_SA(0, 0), cA, voffA); PG8_STAGE(PG8_SB(0, 1), cB + hstep, voffB); PG8_STAGE(PG8_SA(0, 1), cA + hstep, voffA);
    if (wr == 1) PG8_BAR;
    PG8_WAIT_V(4); PG8_BAR;
    PG8_STAGE(PG8_SB(1, 0), cB + kstep, voffB); PG8_STAGE(PG8_SA(1, 0), cA + kstep, voffA); PG8_STAGE(PG8_SB(1, 1), cB + hstep + kstep, voffB);
    PG8_WAIT_V(6); PG8_BAR;
  }
  for (;;) {
    const bool has_next = S.next(ui + 1, nxt);
    const char* nA = has_next ? (const char*)g.A + (size_t)nxt.pm * tstep : cA; const char* nB = has_next ? (const char*)g.Bt + (size_t)nxt.pn * tstep : cB;
    for (int t = 0; t < nt; t += 2) {
      const bool last = (t == nt - 2);
      const char* a1 = cA + (size_t)(t + 1) * kstep;
      const char* a2 = last ? nA : cA + (size_t)(t + 2) * kstep; const char* b2 = last ? nB : cB + (size_t)(t + 2) * kstep;
      const char* a3 = a2 + kstep; const char* b3 = b2 + kstep;
      if (last && has_next) S.a_ready(nxt);
      if constexpr (SP2) {
        PG8_LDB(B0, 0, 0); PG8_LDB(B1, 0, 1); PG8_SCHED; PG8_LDA(At, 0, 0); PG8_STAGE(PG8_SA(1, 1), a1 + hstep, voffA);
        PG8_WAIT_V(8); PG8_WAIT_L(0); PG8_BAR; PG8_MMA(0, 0, At, B0); PG8_MMA(0, 1, At, B1); PG8_BAR; PG8_SCHED;
        PG8_LDA(At, 0, 1); PG8_STAGE(PG8_SB(0, 0), b2, voffB); PG8_STAGE(PG8_SB(0, 1), b2 + hstep, voffB); PG8_STAGE(PG8_SA(0, 0), a2, voffA);
        PG8_WAIT_V(8); PG8_WAIT_L(0); PG8_BAR; PG8_MMA(1, 0, At, B0); PG8_MMA(1, 1, At, B1); PG8_BAR; PG8_SCHED;
        PG8_LDB(B0, 1, 0); PG8_LDB(B1, 1, 1); PG8_SCHED; PG8_LDA(At, 1, 0); PG8_STAGE(PG8_SA(0, 1), a2 + hstep, voffA);
        PG8_WAIT_V(8); PG8_WAIT_L(0); PG8_BAR; PG8_MMA(0, 0, At, B0); PG8_MMA(0, 1, At, B1); PG8_BAR; PG8_SCHED;
        PG8_LDA(At, 1, 1); PG8_STAGE(PG8_SB(1, 0), b3, voffB); PG8_STAGE(PG8_SB(1, 1), b3 + hstep, voffB); PG8_STAGE(PG8_SA(1, 0), a3, voffA);
        PG8_WAIT_V(8); PG8_WAIT_L(0); PG8_BAR; PG8_MMA(1, 0, At, B0); PG8_MMA(1, 1, At, B1); PG8_BAR; PG8_SCHED;
      } else {
        PG8_LDB(B0, 0, 0); PG8_SCHED; PG8_LDA(At, 0, 0); PG8_STAGE(PG8_SA(1, 1), a1 + hstep, voffA);
        PG8_WAIT_L(8); PG8_BAR; PG8_WAIT_L(0); PG8_MMA(0, 0, At, B0); PG8_BAR; PG8_SCHED;
        PG8_LDB(B1, 0, 1); PG8_STAGE(PG8_SB(0, 0), b2, voffB);
        PG8_BAR; PG8_WAIT_L(0); PG8_MMA(0, 1, At, B1); PG8_BAR;
        PG8_LDA(At, 0, 1); PG8_STAGE(PG8_SA(0, 0), a2, voffA);
        PG8_BAR; PG8_WAIT_L(0); PG8_MMA(1, 0, At, B0); PG8_BAR; PG8_SCHED;
        PG8_STAGE(PG8_SB(0, 1), b2 + hstep, voffB);
        PG8_WAIT_V(6); PG8_BAR; PG8_MMA(1, 1, At, B1); PG8_BAR;
        PG8_LDB(B0, 1, 0); PG8_SCHED; PG8_LDA(At, 1, 0); PG8_STAGE(PG8_SA(0, 1), a2 + hstep, voffA);
        PG8_WAIT_L(8); PG8_BAR; PG8_WAIT_L(0); PG8_MMA(0, 0, At, B0); PG8_BAR; PG8_SCHED;
        PG8_LDB(B1, 1, 1); PG8_STAGE(PG8_SB(1, 0), b3, voffB);
        PG8_BAR; PG8_WAIT_L(0); PG8_MMA(0, 1, At, B1); PG8_BAR;
        PG8_LDA(At, 1, 1); PG8_STAGE(PG8_SA(1, 0), a3, voffA);
        PG8_BAR; PG8_WAIT_L(0); PG8_MMA(1, 0, At, B0); PG8_BAR; PG8_SCHED;
        PG8_STAGE(PG8_SB(1, 1), b3 + hstep, voffB);
        PG8_WAIT_V(6); PG8_BAR; PG8_MMA(1, 1, At, B1); PG8_BAR;
      }
    }
    if constexpr (ALIGN_EPI) { if (wr == 0) PG8_BAR; }
    if constexpr (!Epi::AFTER_DRAIN) { E(acc, cur, wr, wc, fr, fq); S.done(cur); }
    if (!has_next) break;
#pragma unroll
    for (int a = 0; a < 2; ++a)
#pragma unroll
      for (int b = 0; b < 2; ++b)
#pragma unroll
        for (int m = 0; m < 4; ++m)
#pragma unroll
          for (int n = 0; n < 2; ++n) acc[a][b][m][n] = (f32x4){0.f, 0.f, 0.f, 0.f};
    cur = nxt; cA = nA; cB = nB; ++ui;
    if constexpr (ALIGN_EPI) { if (wr == 1) PG8_BAR; }
  }
  PG8_WAIT_V(0);
  if constexpr (!ALIGN_EPI) { if (wr == 0) PG8_BAR; }
  PG8_BAR;
#undef PG8_SA
#undef PG8_SB
#undef PG8_STAGE
#undef PG8_LDA
#undef PG8_LDB
#undef PG8_MMA
#undef PG8_WAIT_V
#undef PG8_WAIT_L
#undef PG8_BAR
#undef PG8_SCHED
}
}

typedef float f32x16 __attribute__((ext_vector_type(16)));
typedef float f32x8 __attribute__((ext_vector_type(8)));
typedef short s16x4 __attribute__((ext_vector_type(4)));
typedef __bf16 bfx8 __attribute__((ext_vector_type(8)));
#define MFMA32(a, b, c) __builtin_amdgcn_mfma_f32_32x32x16_bf16((a), (b), (c), 0, 0, 0)
__device__ __forceinline__ bf16x8 cvt8(f32x8 t) { return __builtin_bit_cast(bf16x8, __builtin_convertvector(t, bfx8)); }
__device__ __forceinline__ bf16x8 pack8(const f32x16& x, int s) {
  const f32x8 t = {x[8 * s], x[8 * s + 1], x[8 * s + 2], x[8 * s + 3], x[8 * s + 4], x[8 * s + 5], x[8 * s + 6], x[8 * s + 7]};
  return cvt8(t);
}
__device__ __forceinline__ f32x16 zero16() { f32x16 z; for (int i = 0; i < 16; ++i) z[i] = 0.f; return z; }
__device__ __forceinline__ unsigned off_b(unsigned row, unsigned ch) { return 256u * row + 16u * (ch ^ (((row & 3u) << 2) | ((row >> 2) & 3u))); }
__device__ __forceinline__ int swap12(int p) { return ((p & 1) << 1) | (p >> 1); }
__device__ __forceinline__ bf16x8 lds_rd128(LAS unsigned char* lds, unsigned off) { return *(const LAS bf16x8*)(lds + off); }
__device__ __forceinline__ bf16x8 lds_tr2(LAS unsigned char* lds, unsigned off_lo, unsigned off_hi) {
  const s16x4 lo = __builtin_amdgcn_ds_read_tr16_b64_v4i16((LAS s16x4*)(lds + off_lo));
  const s16x4 hi = __builtin_amdgcn_ds_read_tr16_b64_v4i16((LAS s16x4*)(lds + off_hi));
  return __builtin_shufflevector(lo, hi, 0, 1, 2, 3, 4, 5, 6, 7);
}
__device__ __forceinline__ void glds16(const void* g, LAS unsigned char* l) {
  unsigned keep; const unsigned dst = __builtin_amdgcn_readfirstlane((unsigned)(size_t)l);
  asm volatile("s_mov_b32 %0, m0\n\ts_mov_b32 m0, %2\n\ts_nop 0\n\tglobal_load_lds_dwordx4 %1, off\n\ts_mov_b32 m0, %0" : "=&s"(keep) : "v"(g), "s"(dst) : "memory");
}
__device__ __forceinline__ unsigned rowfrag_off(int lane, int mt, int ks) { return off_b(32 * mt + (lane & 31), 2 * ks + (lane >> 5)); }
__device__ __forceinline__ unsigned vtr_off(int lane, int cb, int ks, int sec) {
  const int g = lane >> 4, i = lane & 15, hh = g >> 1, half16 = g & 1, qq = i >> 2, p = i & 3;
  const int row = 16 * ks + 4 * hh + 8 * sec + qq, col = cb + 16 * half16 + 4 * p;
  return off_b(row, col >> 3) + (col & 7) * 2;
}
__device__ __forceinline__ unsigned ktr_off(int lane, int mt, int ks, int sec) {
  const int g = lane >> 4, i = lane & 15, hh = g >> 1, half16 = g & 1, qq = i >> 2, p = i & 3;
  const int row = 16 * ks + 4 * hh + 8 * sec + qq, col = 32 * mt + 16 * half16 + 4 * swap12(p);
  return off_b(row, col >> 3) + (col & 7) * 2;
}
__device__ __forceinline__ int crow(int reg, int h) { return (reg & 3) + 8 * (reg >> 2) + 4 * h; }
__device__ __forceinline__ int srow(int reg, int h) { return 16 * (reg >> 3) + 8 * h + 4 * ((reg >> 2) & 1) + (reg & 3); }
__device__ __forceinline__ void rowscale(f32x16& a, const LAS float* vec, int h, float sgn) {
#pragma unroll
  for (int g4 = 0; g4 < 4; ++g4) { const f32x4 s = *(const LAS f32x4*)(vec + 8 * g4 + 4 * h);
    a[4 * g4] *= s.x * sgn; a[4 * g4 + 1] *= s.y * sgn; a[4 * g4 + 2] *= s.z * sgn; a[4 * g4 + 3] *= s.w * sgn; }
}
__device__ __forceinline__ void stage_img_piece(const unsigned char* src, size_t pitch, LAS unsigned char* img, int pc, int lane) {
  const unsigned row = 4 * pc + (lane >> 4), chp = lane & 15, ch = chp ^ (((row & 3u) << 2) | ((row >> 2) & 3u));
  glds16(src + (size_t)row * pitch + ch * 16, img + 1024 * pc);
}
constexpr int SC_BUF = 66560, SC_Q = 0, SC_K = 16384, SC_M = 32768, SC_V = 50176, SC_VEC = 2 * SC_BUF;
constexpr int DN_BLOB = 17408, RT_BLOB = 8192;
__device__ __forceinline__ void scan_stage(LAS unsigned char* lds, int buf, int type, int dir, int h, int gc, const bf16_t* QKV, const bf16_t* KBUF,
                                           const unsigned char* MATS_RT, const unsigned char* MATS_DN, int half, int w, int lane) {
  const size_t row0 = (size_t)gc * 64;
  const unsigned char* rowp = (const unsigned char*)(QKV + row0 * LDQ);
  const unsigned char* qsrc = rowp + (type ? Q_DQ + h * DK : Q_RQ + h * DK) * 2;
  const unsigned char* ksrc = rowp + (type ? Q_DK + h * DK : Q_RK + h * DK) * 2; size_t kpitch = LDQ * 2;
  if (!type && dir) { ksrc = (const unsigned char*)(KBUF + row0 * 512 + h * DK); kpitch = 1024; }
  const unsigned char* vsrc = rowp + (type ? Q_DV + h * DV : Q_RV + h * DV) * 2 + half * 256;
  LAS unsigned char* B = lds + buf * SC_BUF;
#pragma unroll
  for (int i = 0; i < 2; ++i) { const int pc = w + 8 * i;
    stage_img_piece(qsrc, LDQ * 2, B + SC_Q, pc, lane); stage_img_piece(ksrc, kpitch, B + SC_K, pc, lane);
    stage_img_piece(vsrc, LDQ * 2, B + SC_V, pc, lane); }
  const unsigned char* blob = type ? MATS_DN + (size_t)((gc * 4 + h) * 2 + dir) * DN_BLOB : MATS_RT + (size_t)((gc * 4 + h) * 2 + dir) * RT_BLOB;
  const int np = type ? 17 : 8;
  for (int pc = w; pc < np; pc += 8) glds16(blob + pc * 1024 + lane * 16, B + SC_M + pc * 1024);
}

__device__ __forceinline__ void transpose_item(const float* W, int ldw, int K, int src_col0, bf16_t* WT, int dst_row0, int k0, LAS float* scr, int lane) {
#pragma unroll 8
  for (int i = 0; i < 32; ++i) { const int kk = 2 * i + (lane >> 5); scr[kk * 33 + (lane & 31)] = W[(size_t)(k0 + kk) * ldw + src_col0 + (lane & 31)]; }
  asm volatile("s_waitcnt lgkmcnt(0)" ::: "memory");
  const int c = lane & 7;
#pragma unroll
  for (int j = 0; j < 4; ++j) { const int n = (lane >> 3) + 8 * j; const LAS float* s = scr + (8 * c) * 33 + n;
    u32x4 o; o.x = pk2(s[0 * 33], s[1 * 33]); o.y = pk2(s[2 * 33], s[3 * 33]); o.z = pk2(s[4 * 33], s[5 * 33]); o.w = pk2(s[6 * 33], s[7 * 33]);
    *(u32x4*)(WT + (size_t)(dst_row0 + n) * K + k0 + 8 * c) = o; }
  asm volatile("s_waitcnt lgkmcnt(0)" ::: "memory");
}

template <class ColMap> __device__ __forceinline__ void transpose_matrix(const float* W, int ldw, int K, int N, bf16_t* WT, ColMap cm, LAS float* scr, int gw, int ngw, int lane) {
  const int nblk = N / 32, items = (K / 64) * nblk;
  for (int it = gw; it < items; it += ngw) { const int kb = it / nblk, nb = it % nblk; transpose_item(W, ldw, K, cm(32 * nb), WT, 32 * nb, 64 * kb, scr, lane); }
}

__global__ void __launch_bounds__(NTHREADS) fwd_megakernel(Params p) {
  extern __shared__ __attribute__((aligned(16))) unsigned char lds_raw[];
  LAS unsigned char* lds = (LAS unsigned char*)lds_raw;
  cg::grid_group grid = cg::this_grid();
  volatile LAS unsigned* bar_st = (volatile LAS unsigned*)(lds + LDS_BYTES - 64);
  if (threadIdx.x < 2) bar_st[threadIdx.x] = 0u;
  __syncthreads();
  const XcdBarrier xbar = xcd_barrier_post((unsigned*)(p.ws + WS_BAR), bar_st);
  if (p.ws == nullptr) grid.sync();
#define GRID_BARRIER() xcd_barrier(xbar, wave)
  const int wave = __builtin_amdgcn_readfirstlane(threadIdx.x >> 6);
#define PHASE_TID() int lane_p = lane_id(); asm volatile("" : "+v"(lane_p)); const int lane = lane_p, tid = (wave << 6) | lane; (void)tid;
  const int G = gridDim.x, bid = blockIdx.x;
  const int gw = bid * NWAVES + wave, ngw = G * NWAVES;
  unsigned char* ws = p.ws;
  float* MOD = (float*)(ws + WS_MOD);
  f32x2* ROPE = (f32x2*)(ws + WS_ROPE);
  float* BA = (float*)(ws + WS_BA);
  float* DECLG = (float*)(ws + WS_MOD + 122880);
  bf16_t* WQKV = (bf16_t*)(ws + WS_WQKV); bf16_t* WGATE = (bf16_t*)(ws + WS_WGATE);
  bf16_t* WRO = (bf16_t*)(ws + WS_WRO); bf16_t* WDO = (bf16_t*)(ws + WS_WDO); bf16_t* WOUT = (bf16_t*)(ws + WS_WOUT);
  bf16_t* HB = (bf16_t*)(ws + WS_H);
  bf16_t* QKV = (bf16_t*)(ws + WS_QKV);
  bf16_t* KBUF = (bf16_t*)(ws + WS_KB); bf16_t* HALO = (bf16_t*)(ws + WS_HALO);
  unsigned char* MATS_RT = ws + WS_MATS_RT; unsigned char* MATS_DN = ws + WS_MATS_DN;
  unsigned char* LSCR = ws + WS_O; constexpr int LSCR_STRIDE = 16896;
  bf16_t* ODF = (bf16_t*)(ws + WS_O); bf16_t* ODB = ODF + (size_t)MTOT * D;
  bf16_t* ORF = (bf16_t*)p.out; bf16_t* ORB = ORF + (size_t)MTOT * D;
  float* NS_RET = p.out + (size_t)MTOT * D; float* NS_DN = NS_RET + (size_t)NCTX * 2 * NH * DK * DV;

  {
    PHASE_TID();
    LAS float* scr = (LAS float*)(lds + wave * 16384);
    transpose_matrix(p.in[I_WIN], INC, D, 4096, WQKV, [](int n) { return n < 2048 ? n : n + 1024; }, scr, gw, ngw, lane);
    transpose_matrix(p.in[I_WIN], INC, D, 4096, WGATE, [](int n) { return n < 1024 ? C_RG + n : (n < 2048 ? C_DZ + (n - 1024) : C_GR + (n - 2048)); }, scr, gw, ngw, lane);
    transpose_matrix(p.in[I_WRO], D, D, D, WRO, [](int n) { return n; }, scr, gw, ngw, lane);
    transpose_matrix(p.in[I_WDO], D, D, D, WDO, [](int n) { return n; }, scr, gw, ngw, lane);
    transpose_matrix(p.in[I_WOUT], D, D, D, WOUT, [](int n) { return n; }, scr, gw, ngw, lane);
    {
      __syncthreads();
      LAS float* scond = (LAS float*)lds;
      LAS float* red = scond + 5 * D;
      for (int i = tid; i < 5 * D; i += NTHREADS) { const int c = i >> 10, k = i & 1023; scond[i] = siluf(c == 0 ? p.in[I_CCTX][k] : p.in[I_C][(c - 1) * D + k]); }
      __syncthreads();
      for (int it = bid; it < 6 * D / 32; it += G) {
        const int col = it * 32 + (lane & 31), rpar = lane >> 5;
        float acc[5] = {0.f, 0.f, 0.f, 0.f, 0.f};
        const float* wm = p.in[I_WMOD] + (size_t)(128 * wave + rpar) * 6 * D + col;
#pragma unroll 16
        for (int i = 0; i < 64; ++i) { const float wv = wm[(size_t)(2 * i) * 6 * D]; const int k = 128 * wave + 2 * i + rpar;
#pragma unroll
          for (int c = 0; c < 5; ++c) acc[c] += scond[c * D + k] * wv; }
#pragma unroll
        for (int c = 0; c < 5; ++c) { acc[c] += __shfl_xor(acc[c], 32); if (lane < 32) red[(wave * 5 + c) * 32 + lane] = acc[c]; }
        __syncthreads();
        if (tid < 160) { const int c = tid >> 5, n = tid & 31; float s = 0.f;
#pragma unroll
          for (int ww = 0; ww < 8; ++ww) s += red[(ww * 5 + c) * 32 + n];
          MOD[c * 6 * D + it * 32 + n] = s + p.in[I_BMOD][it * 32 + n]; }
        __syncthreads();
      }
    }
    for (int i = bid * NTHREADS + tid; i < LLAT * 64; i += G * NTHREADS) { const int l = i >> 6, pr = i & 63;
      const float freq = powf(10000.f, -(float)(pr & 31) / 32.f); const float ang = (pr < 32 ? (float)(l >> 6) : (float)(l & 63)) * freq;
      ROPE[i] = (f32x2){cosf(ang), sinf(ang)}; }
    if (bid == 0 && tid < 8) DECLG[tid] = -softplusf(-p.in[I_DECAY][tid]);
  }
  GRID_BARRIER();

  {
    PHASE_TID();
    LAS float* wba = (LAS float*)lds;
    for (int i = tid; i < D * 16; i += NTHREADS) wba[(i & 15) * 1028 + (i >> 4)] = p.in[I_WIN][(size_t)(i >> 4) * INC + C_DB + (i & 15)];
    __syncthreads();
    const float* nw = p.in[I_NORMW];
    for (int m = gw; m < MTOT; m += ngw) {
      const float* xr = xrow(p, m); const float* md = MOD + (size_t)cond_of_row(m) * 6 * D;
      f32x4 x4[4], w4[4], sc4[4], sh4[4]; float s = 0.f;
#pragma unroll
      for (int j = 0; j < 4; ++j) { const int c0 = 4 * lane + 256 * j; x4[j] = *(const f32x4*)(xr + c0); w4[j] = *(const f32x4*)(nw + c0); sc4[j] = *(const f32x4*)(md + D + c0); sh4[j] = *(const f32x4*)(md + c0); }
#pragma unroll
      for (int j = 0; j < 4; ++j) s += (x4[j].x * x4[j].x + x4[j].y * x4[j].y) + (x4[j].z * x4[j].z + x4[j].w * x4[j].w);
      const float r = rsqrtf(wave_sum(s) * (1.f / D) + EPS);
      float dots[16];
#pragma unroll
      for (int n = 0; n < 16; ++n) dots[n] = 0.f;
#pragma unroll
      for (int j = 0; j < 4; ++j) { const int c0 = 4 * lane + 256 * j;
        const f32x4 h = x4[j] * r * w4[j] * (sc4[j] + 1.f) + sh4[j];
        u32x2 o; o.x = pk2(h.x, h.y); o.y = pk2(h.z, h.w);
        *(u32x2*)(HB + (size_t)m * D + c0) = o;
#pragma unroll
        for (int n = 0; n < 16; ++n) { const f32x4 wv = *(const LAS f32x4*)(wba + n * 1028 + c0); dots[n] += (h.x * wv.x + h.y * wv.y) + (h.z * wv.z + h.w * wv.w); }
        __builtin_amdgcn_sched_barrier(0);
      }
#pragma unroll
      for (int n = 0; n < 16; ++n) dots[n] = wave_sum(dots[n]);
      if (lane < 8) {
        float db = dots[0], da = dots[8];
#pragma unroll
        for (int n = 1; n < 8; ++n) { db = lane == n ? dots[n] : db; da = lane == n ? dots[8 + n] : da; }
        BA[(size_t)m * 16 + lane] = sigmf(db);
        BA[(size_t)m * 16 + 8 + lane] = -expf(p.in[I_ALOG][lane]) * softplusf(da + p.in[I_DTB][lane]);
      }
    }
  }
  GRID_BARRIER();

  {
    pg8::Gemm g{HB, WQKV, MTOT, 4096, D}; pg8::StaticOrder S; S.init(MTOT, 4096, G, bid);
    pg8::EpiQKV E{QKV, LDQ, HALO};
    pg8::gemm_phase<pg8::EpiQKV, pg8::StaticOrder, true, true>(lds, g, S, E, wave);
  }
  GRID_BARRIER();

  {
    PHASE_TID();
    constexpr int PI_RQ = 0, PI_RK = 16384, PI_DQ = 32768, PI_DK = 49152;
    constexpr int PM_QKR = 65536, PM_QKD = PM_QKR + 17408, PM_KKD = PM_QKD + 17408;
    constexpr int PV = PM_KKD + 17408;
    constexpr int PL_F = 0, PL_B = 17408, PT_F = 34816, PT_B = 52224;
    const int w = wave;
    const float* cw = p.in[I_CONVW];
    for (int item = bid; item < 768; item += G) {
      int lane_o = lane_id(); asm volatile("" : "+v"(lane_o));
      const int lane = lane_o, tid = (wave << 6) | lane, r32 = lane & 31, hl = lane >> 5;
      const int gc = item >> 2, h = item & 3, row0 = gc * 64; const bool lat = row0 >= MCTX;
      const int L = lat ? LLAT : LCTX, t0 = lat ? ((row0 - MCTX) & (LLAT - 1)) : (row0 & (LCTX - 1));
      const float lgf = DECLG[h], lgb = DECLG[4 + h];
      __syncthreads();
      const int s1row = tid >> 3; const size_t s1m = (size_t)row0 + s1row;
      u32x4 qraw[2], kraw[2];
#pragma unroll
      for (int c = 0; c < 2; ++c) { const int ch = (tid & 7) * 2 + c;
        qraw[c] = *(const u32x4*)(QKV + s1m * LDQ + Q_RQ + h * DK + ch * 8); kraw[c] = *(const u32x4*)(QKV + s1m * LDQ + Q_RK + h * DK + ch * 8); }
      const int ach = tid & 15;
      u32x4 rawa[2][2][3];
#pragma unroll
      for (int ps = 0; ps < 2; ++ps)
#pragma unroll
        for (int wh = 0; wh < 2; ++wh)
#pragma unroll
          for (int wd = 0; wd < 3; ++wd) { const int row = (tid >> 4) + 32 * ps, rr = row + wd - 1, t = t0 + rr; const int dch = wh * 512 + h * DK + ach * 8;
            u32x4 x = (u32x4){0u, 0u, 0u, 0u};
            if (t >= 0 && t < L) {
              if (rr < 0) x = *(const u32x4*)(HALO + ((size_t)(gc - 1) * 2 + 1) * 2048 + dch);
              else if (rr > 63) x = *(const u32x4*)(HALO + ((size_t)(gc + 1) * 2 + 0) * 2048 + dch);
              else x = *(const u32x4*)(QKV + (size_t)(row0 + rr) * LDQ + Q_DQ + dch); }
            rawa[ps][wh][wd] = x; }
      u32x4 rawb[4][3];
#pragma unroll
      for (int n = 0; n < 4; ++n)
#pragma unroll
        for (int wd = 0; wd < 3; ++wd) { const int idx = tid + 512 * n, row = idx >> 5, ch = idx & 31, rr = row + wd - 1, t = t0 + rr; const int dch = 1024 + h * DV + ch * 8;
          u32x4 x = (u32x4){0u, 0u, 0u, 0u};
          if (t >= 0 && t < L) {
            if (rr < 0) x = *(const u32x4*)(HALO + ((size_t)(gc - 1) * 2 + 1) * 2048 + dch);
            else if (rr > 63) x = *(const u32x4*)(HALO + ((size_t)(gc + 1) * 2 + 0) * 2048 + dch);
            else x = *(const u32x4*)(QKV + (size_t)(row0 + rr) * LDQ + Q_DQ + dch); }
          rawb[n][wd] = x; }
      float ba4[4] = {0.f, 0.f, 0.f, 0.f};
      if (tid < 64) { const float* ba = BA + (size_t)(row0 + tid) * 16; ba4[0] = ba[h]; ba4[1] = ba[4 + h]; ba4[2] = ba[8 + h]; ba4[3] = ba[12 + h]; }
      asm volatile("s_waitcnt vmcnt(0)" ::: "memory");
      __syncthreads();
      {
        const int row = s1row; const size_t m = s1m;
        const float kfs = __expf(lgf * (float)(63 - row)), kbs = __expf(lgb * (float)row);
#pragma unroll
        for (int c = 0; c < 2; ++c) { const int ch = (tid & 7) * 2 + c;
          bf16_t* qp = QKV + m * LDQ + Q_RQ + h * DK + ch * 8; bf16_t* kp = QKV + m * LDQ + Q_RK + h * DK + ch * 8;
          const u32x4 qw = qraw[c], kw = kraw[c];
          float q[8] = {lo_bf(qw.x), hi_bf(qw.x), lo_bf(qw.y), hi_bf(qw.y), lo_bf(qw.z), hi_bf(qw.z), lo_bf(qw.w), hi_bf(qw.w)};
          float k[8] = {lo_bf(kw.x), hi_bf(kw.x), lo_bf(kw.y), hi_bf(kw.y), lo_bf(kw.z), hi_bf(kw.z), lo_bf(kw.w), hi_bf(kw.w)};
#pragma unroll
          for (int e = 0; e < 8; ++e) q[e] *= QSCALE;
          if (lat) {
#pragma unroll
            for (int e = 0; e < 4; ++e) { const f32x2 cs = ROPE[(t0 + row) * 64 + ch * 4 + e];
              const float a = q[2 * e] * cs.x - q[2 * e + 1] * cs.y, b = q[2 * e] * cs.y + q[2 * e + 1] * cs.x; q[2 * e] = a; q[2 * e + 1] = b;
              const float c2 = k[2 * e] * cs.x - k[2 * e + 1] * cs.y, d2 = k[2 * e] * cs.y + k[2 * e + 1] * cs.x; k[2 * e] = c2; k[2 * e + 1] = d2; }
          }
          u32x4 o; o.x = pk2(q[0], q[1]); o.y = pk2(q[2], q[3]); o.z = pk2(q[4], q[5]); o.w = pk2(q[6], q[7]);
          *(u32x4*)qp = o; *(LAS u32x4*)(lds + PI_RQ + off_b(row, ch)) = o;
          o.x = pk2(k[0], k[1]); o.y = pk2(k[2], k[3]); o.z = pk2(k[4], k[5]); o.w = pk2(k[6], k[7]);
          *(LAS u32x4*)(lds + PI_RK + off_b(row, ch)) = o;
          o.x = pk2(k[0] * kfs, k[1] * kfs); o.y = pk2(k[2] * kfs, k[3] * kfs); o.z = pk2(k[4] * kfs, k[5] * kfs); o.w = pk2(k[6] * kfs, k[7] * kfs);
          *(u32x4*)kp = o;
          o.x = pk2(k[0] * kbs, k[1] * kbs); o.y = pk2(k[2] * kbs, k[3] * kbs); o.z = pk2(k[4] * kbs, k[5] * kbs); o.w = pk2(k[6] * kbs, k[7] * kbs);
          *(u32x4*)(KBUF + m * 512 + h * DK + ch * 8) = o;
        }
      }
      {
        const int ch = ach;
#pragma unroll
        for (int ps = 0; ps < 2; ++ps)
#pragma unroll
          for (int wh = 0; wh < 2; ++wh) { const int row = (tid >> 4) + 32 * ps; const int dch = wh * 512 + h * DK + ch * 8;
            float a[8] = {0.f, 0.f, 0.f, 0.f, 0.f, 0.f, 0.f, 0.f};
#pragma unroll
            for (int wd = 0; wd < 3; ++wd) { const u32x4 x = rawa[ps][wh][wd]; const f32x4 w0 = *(const f32x4*)(cw + wd * 2048 + dch), w1 = *(const f32x4*)(cw + wd * 2048 + dch + 4);
              a[0] += lo_bf(x.x) * w0.x; a[1] += hi_bf(x.x) * w0.y; a[2] += lo_bf(x.y) * w0.z; a[3] += hi_bf(x.y) * w0.w;
              a[4] += lo_bf(x.z) * w1.x; a[5] += hi_bf(x.z) * w1.y; a[6] += lo_bf(x.w) * w1.z; a[7] += hi_bf(x.w) * w1.w; }
            float ss = 0.f;
#pragma unroll
            for (int e = 0; e < 8; ++e) { a[e] = siluf(a[e]); ss += a[e] * a[e]; }
            ss += __shfl_xor(ss, 1); ss += __shfl_xor(ss, 2); ss += __shfl_xor(ss, 4); ss += __shfl_xor(ss, 8);
            const float sc = rsqrtf(ss + EPS) * (wh == 0 ? QSCALE : 1.f);
            u32x4 o; o.x = pk2(a[0] * sc, a[1] * sc); o.y = pk2(a[2] * sc, a[3] * sc); o.z = pk2(a[4] * sc, a[5] * sc); o.w = pk2(a[6] * sc, a[7] * sc);
            *(u32x4*)(QKV + (size_t)(row0 + row) * LDQ + Q_DQ + dch) = o;
            *(LAS u32x4*)(lds + (wh ? PI_DK : PI_DQ) + off_b(row, ch)) = o; }
      }
      {
#pragma unroll
        for (int n = 0; n < 4; ++n) { const int idx = tid + 512 * n, row = idx >> 5, ch = idx & 31; const int dch = 1024 + h * DV + ch * 8;
          float a[8] = {0.f, 0.f, 0.f, 0.f, 0.f, 0.f, 0.f, 0.f};
#pragma unroll
          for (int wd = 0; wd < 3; ++wd) { const u32x4 x = rawb[n][wd]; const f32x4 w0 = *(const f32x4*)(cw + wd * 2048 + dch), w1 = *(const f32x4*)(cw + wd * 2048 + dch + 4);
            a[0] += lo_bf(x.x) * w0.x; a[1] += hi_bf(x.x) * w0.y; a[2] += lo_bf(x.y) * w0.z; a[3] += hi_bf(x.y) * w0.w;
            a[4] += lo_bf(x.z) * w1.x; a[5] += hi_bf(x.z) * w1.y; a[6] += lo_bf(x.w) * w1.z; a[7] += hi_bf(x.w) * w1.w; }
          u32x4 o; o.x = pk2(siluf(a[0]), siluf(a[1])); o.y = pk2(siluf(a[2]), siluf(a[3])); o.z = pk2(siluf(a[4]), siluf(a[5])); o.w = pk2(siluf(a[6]), siluf(a[7]));
          *(u32x4*)(QKV + (size_t)(row0 + row) * LDQ + Q_DQ + dch) = o; }
      }
      __syncthreads();
      {
        const int mi = (w >> 1) & 1, nj = w & 1;
        if (w < 4) {
          f32x16 a1 = zero16(), a2 = zero16();
#pragma unroll 2
          for (int ks = 0; ks < 8; ++ks) { a1 = MFMA32(lds_rd128(lds + PI_RQ, rowfrag_off(lane, mi, ks)), lds_rd128(lds + PI_RK, rowfrag_off(lane, nj, ks)), a1);
            a2 = MFMA32(lds_rd128(lds + PI_DQ, rowfrag_off(lane, mi, ks)), lds_rd128(lds + PI_DK, rowfrag_off(lane, nj, ks)), a2); }
          LAS float* m1 = (LAS float*)(lds + PM_QKR); LAS float* m2 = (LAS float*)(lds + PM_QKD);
#pragma unroll
          for (int reg = 0; reg < 16; ++reg) { const int o = (32 * mi + crow(reg, hl)) * 68 + 32 * nj + r32; m1[o] = a1[reg]; m2[o] = a2[reg]; }
        } else {
          f32x16 a1 = zero16();
#pragma unroll 2
          for (int ks = 0; ks < 8; ++ks) a1 = MFMA32(lds_rd128(lds + PI_DK, rowfrag_off(lane, mi, ks)), lds_rd128(lds + PI_DK, rowfrag_off(lane, nj, ks)), a1);
          LAS float* m1 = (LAS float*)(lds + PM_KKD);
#pragma unroll
          for (int reg = 0; reg < 16; ++reg) m1[(32 * mi + crow(reg, hl)) * 68 + 32 * nj + r32] = a1[reg];
        }
      }
      LAS float* vecs = (LAS float*)(lds + PV);
      if (tid < 64) {
        const float bf = ba4[0], bb = ba4[1], af = ba4[2], ab = ba4[3];
        float xf = af, xb = ab;
#pragma unroll
        for (int o = 1; o < 64; o <<= 1) { const float yf = __shfl_up(xf, o), yb = __shfl_up(xb, o); if (lane >= o) { xf += yf; xb += yb; } }
        const float totf = __shfl(xf, 63), totb = __shfl(xb, 63);
        vecs[tid] = bf; vecs[64 + tid] = bb; vecs[128 + tid] = xf; vecs[192 + tid] = totb - xb + ab;
        if (tid == 0) { vecs[256] = totf; vecs[257] = totb; }
      }
      __syncthreads();
      unsigned char* blob_rt = MATS_RT + (size_t)((gc * 4 + h) * 2) * RT_BLOB; unsigned char* blob_dn = MATS_DN + (size_t)((gc * 4 + h) * 2) * DN_BLOB;
      const int lp = tid & 63, fi = tid >> 6, fmt = fi >> 2, fks = fi & 3, frow = 32 * fmt + (lp & 31), fhq = lp >> 5;
      {
        const LAS float* m1 = (const LAS float*)(lds + PM_QKR); const LAS float* m2 = (const LAS float*)(lds + PM_QKD);
        const float gfi = vecs[128 + frow], gbi = vecs[192 + frow];
        f32x8 pf, pb, df, db;
#pragma unroll
        for (int jj = 0; jj < 8; ++jj) { const int j = 16 * fks + 8 * (jj >> 2) + 4 * fhq + (jj & 3);
          const float x = m1[frow * 68 + j], y = m2[frow * 68 + j];
          pf[jj] = j <= frow ? x * __expf(lgf * (float)(frow - j)) : 0.f; pb[jj] = j >= frow ? x * __expf(lgb * (float)(j - frow)) : 0.f;
          df[jj] = j <= frow ? y * __expf(gfi - vecs[128 + j]) : 0.f; db[jj] = j >= frow ? y * __expf(gbi - vecs[192 + j]) : 0.f; }
        *(bf16x8*)(blob_rt + (fi * 64 + lp) * 16) = cvt8(pf); *(bf16x8*)(blob_rt + RT_BLOB + (fi * 64 + lp) * 16) = cvt8(pb);
        *(bf16x8*)(blob_dn + 8192 + (fi * 64 + lp) * 16) = cvt8(df); *(bf16x8*)(blob_dn + DN_BLOB + 8192 + (fi * 64 + lp) * 16) = cvt8(db);
        const LAS float* m3 = (const LAS float*)(lds + PM_KKD);
        float* lf = (float*)(LSCR + (size_t)((gc * 4 + h) * 2) * LSCR_STRIDE); float* lb = (float*)(LSCR + (size_t)((gc * 4 + h) * 2 + 1) * LSCR_STRIDE);
#pragma unroll
        for (int n = 0; n < 8; ++n) { const int e = tid + 512 * n, i = e >> 6, j = e & 63; const float kk = m3[i * 68 + j];
          lf[e] = j < i ? vecs[i] * kk * __expf(vecs[128 + i] - vecs[128 + j]) : 0.f;
          lb[e] = j > i ? vecs[64 + i] * kk * __expf(vecs[192 + i] - vecs[192 + j]) : 0.f; }
        if (tid < 64) { lf[4096 + tid] = vecs[tid]; lb[4096 + tid] = vecs[64 + tid]; }
        if (tid < 64) { const float gf = vecs[128 + tid], gb = vecs[192 + tid], glf = vecs[256], glb = vecs[257];
          float* vf = (float*)(blob_dn + 16384); float* vb = (float*)(blob_dn + DN_BLOB + 16384);
          vf[tid] = __expf(gf); vf[64 + tid] = __expf(glf - gf); vb[tid] = __expf(gb); vb[64 + tid] = __expf(glb - gb);
          if (tid == 0) { vf[128] = __expf(glf); vb[128] = __expf(glb); } }
      }
    }
  }
  GRID_BARRIER();

  {
    PHASE_TID();
    LAS unsigned short* tl = (LAS unsigned short*)(lds + wave * 16384);
    for (int it = gw; it < 1536; it += ngw) {
      int lane_o = lane_id(); asm volatile("" : "+v"(lane_o));
      const int ln = lane_o; const bool flip = it & 1; const int cl = flip ? 63 - ln : ln;
      const float* Lm = (const float*)(LSCR + (size_t)it * LSCR_STRIDE);
      float T[64], Lr[64];
#pragma unroll
      for (int i = 0; i < 64; ++i) Lr[i] = Lm[(flip ? 63 - i : i) * 64 + cl];
      const float bc = Lm[4096 + cl];
      __builtin_amdgcn_sched_barrier(0);
#pragma unroll
      for (int i = 0; i < 64; ++i) {
        const float lrow = Lr[i];
        float t0 = (ln == i) ? 1.f : 0.f, t1 = 0.f;
#pragma unroll
        for (int j = 0; j < i; ++j) { const float lj = __int_as_float(__builtin_amdgcn_readlane(__float_as_int(lrow), j)); if (j & 1) t1 -= lj * T[j]; else t0 -= lj * T[j]; }
        T[i] = t0 + t1;
        __builtin_amdgcn_sched_barrier(0);
      }
#pragma unroll
      for (int i = 0; i < 64; ++i) tl[(flip ? 63 - i : i) * 72 + cl] = (unsigned short)f2bf(T[i] * bc);
      asm volatile("s_waitcnt lgkmcnt(0)" ::: "memory");
      unsigned char* blob = MATS_DN + (size_t)it * DN_BLOB;
      const int frow = ln & 31, fhq = ln >> 5;
#pragma unroll
      for (int f = 0; f < 8; ++f) { const int mt = f >> 2, ks = f & 3;
        const LAS unsigned short* rp = tl + (32 * mt + frow) * 72 + 16 * ks + 4 * fhq;
        const u32x2 lo = *(const LAS u32x2*)rp, hi = *(const LAS u32x2*)(rp + 8);
        *(u32x4*)(blob + (f * 64 + ln) * 16) = (u32x4){lo.x, lo.y, hi.x, hi.y}; }
      asm volatile("s_waitcnt lgkmcnt(0)" ::: "memory");
    }
  }
  GRID_BARRIER();

  {
    PHASE_TID();
    const int w = wave, cb = (w & 3) * 32; const bool act = w < 4;
    LAS float* qdec = (LAS float*)(lds + SC_VEC);
    const int stride = bid < 128 ? 1000000 : (G - 128);
    for (int item = bid; item < 640; item += stride) {
      const int ci = item >> 1, half = item & 1;
      int lane_c = lane_id(); asm volatile("" : "+v"(lane_c));
      const int lane = lane_c, tid = (wave << 6) | lane, r32 = lane & 31, hl = lane >> 5;
      int type, sq, h, dir, chunk0, nsteps; bool lat;
      if (ci < 64) { lat = true; type = ci >> 5; sq = (ci >> 3) & 3; h = (ci >> 1) & 3; dir = ci & 1; chunk0 = 64 + 32 * sq; nsteps = 32; }
      else { const int c = ci - 64; lat = false; type = c >> 7; sq = (c >> 3) & 15; h = (c >> 1) & 3; dir = c & 1; chunk0 = 4 * sq; nsteps = 4; }
      f32x16 S[4];
      {
        const float* s0 = (type ? p.in[I_SDN] : p.in[I_SRET]) + ((((size_t)sq * 2 + dir) * NH + h) * DK) * DV + 128 * half + cb + r32;
        if (lat) {
#pragma unroll
          for (int mt = 0; mt < 4; ++mt)
#pragma unroll
            for (int reg = 0; reg < 16; ++reg) S[mt][reg] = s0[(size_t)(32 * mt + srow(reg, hl)) * DV];
        } else {
#pragma unroll
          for (int mt = 0; mt < 4; ++mt) S[mt] = zero16();
        }
      }
      const float lg = DECLG[dir * 4 + h];
      const float c64 = __expf(64.f * lg);
      __syncthreads();
      if (tid < 64) qdec[tid] = __expf(lg * (dir ? (float)(64 - tid) : (float)(tid + 1)));
      scan_stage(lds, 0, type, dir, h, chunk0 + (dir ? nsteps - 1 : 0), QKV, KBUF, MATS_RT, MATS_DN, half, w, lane);
      bf16_t* O = type ? (dir ? ODB : ODF) : (dir ? ORB : ORF);
      for (int s = 0; s < nsteps; ++s) {
        int ln = lane; asm volatile("" : "+v"(ln));
        const int r32s = ln & 31, hls = ln >> 5;
        const int buf = s & 1, gc = chunk0 + (dir ? nsteps - 1 - s : s);
        asm volatile("s_waitcnt vmcnt(0)" ::: "memory");
        __syncthreads();
        if (s + 1 < nsteps) scan_stage(lds, buf ^ 1, type, dir, h, chunk0 + (dir ? nsteps - 2 - s : s + 1), QKV, KBUF, MATS_RT, MATS_DN, half, w, ln);
        if (!act) continue;
        LAS unsigned char* B = lds + buf * SC_BUF;
        bf16x8 Bv[4];
#pragma unroll
        for (int ks = 0; ks < 4; ++ks) Bv[ks] = lds_tr2(B + SC_V, vtr_off(ln, cb, ks, 0), vtr_off(ln, cb, ks, 1));
        bf16_t* ob = O + (size_t)gc * 64 * D + h * DV + 128 * half + cb + r32s;
        if (type) {
          const LAS float* eg = (const LAS float*)(B + SC_M + 16384); const LAS float* cgv = eg + 64; const float egl = eg[128];
          bf16x8 Br[4];
          {
            f32x16 ra[2]; ra[0] = zero16(); ra[1] = zero16();
#pragma unroll
            for (int ks = 0; ks < 8; ++ks) { const bf16x8 sb = pack8(S[ks >> 1], ks & 1);
              ra[0] = MFMA32(lds_rd128(B + SC_K, rowfrag_off(ln, 0, ks)), sb, ra[0]); ra[1] = MFMA32(lds_rd128(B + SC_K, rowfrag_off(ln, 1, ks)), sb, ra[1]); }
#pragma unroll
            for (int mt = 0; mt < 2; ++mt) { rowscale(ra[mt], eg + 32 * mt, hls, -1.f); Br[2 * mt] = pack8(ra[mt], 0); Br[2 * mt + 1] = pack8(ra[mt], 1); }
          }
          __builtin_amdgcn_sched_barrier(0);
          f32x16 vn[2]; vn[0] = zero16(); vn[1] = zero16();
#pragma unroll
          for (int ks = 0; ks < 4; ++ks)
#pragma unroll
            for (int mt = 0; mt < 2; ++mt) { const bf16x8 tf = lds_rd128(B + SC_M, (mt * 4 + ks) * 1024 + ln * 16);
              vn[mt] = MFMA32(tf, Bv[ks], vn[mt]); vn[mt] = MFMA32(tf, Br[ks], vn[mt]); }
          bf16x8 Bn[4];
#pragma unroll
          for (int mt = 0; mt < 2; ++mt) { Bn[2 * mt] = pack8(vn[mt], 0); Bn[2 * mt + 1] = pack8(vn[mt], 1); }
          __builtin_amdgcn_sched_barrier(0);
          {
            f32x16 oa[2]; oa[0] = zero16(); oa[1] = zero16();
#pragma unroll
            for (int ks = 0; ks < 8; ++ks) { const bf16x8 sb = pack8(S[ks >> 1], ks & 1);
              oa[0] = MFMA32(lds_rd128(B + SC_Q, rowfrag_off(ln, 0, ks)), sb, oa[0]); oa[1] = MFMA32(lds_rd128(B + SC_Q, rowfrag_off(ln, 1, ks)), sb, oa[1]); }
#pragma unroll
            for (int mt = 0; mt < 2; ++mt) rowscale(oa[mt], eg + 32 * mt, hls, 1.f);
#pragma unroll
            for (int ks = 0; ks < 4; ++ks)
#pragma unroll
              for (int mt = 0; mt < 2; ++mt) oa[mt] = MFMA32(lds_rd128(B + SC_M, 8192 + (mt * 4 + ks) * 1024 + ln * 16), Bn[ks], oa[mt]);
#pragma unroll
            for (int mt = 0; mt < 2; ++mt)
#pragma unroll
              for (int s2 = 0; s2 < 2; ++s2) { const bf16x8 pk = pack8(oa[mt], s2);
#pragma unroll
                for (int j = 0; j < 8; ++j) ob[(size_t)(32 * mt + crow(8 * s2 + j, hls)) * D] = (bf16_t)pk[j]; }
          }
          __builtin_amdgcn_sched_barrier(0);
#pragma unroll
          for (int mt = 0; mt < 2; ++mt) { rowscale(vn[mt], cgv + 32 * mt, hls, 1.f); Bn[2 * mt] = pack8(vn[mt], 0); Bn[2 * mt + 1] = pack8(vn[mt], 1); }
#pragma unroll
          for (int mt = 0; mt < 4; ++mt) S[mt] = S[mt] * egl;
#pragma unroll
          for (int ks = 0; ks < 4; ++ks)
#pragma unroll
            for (int mt = 0; mt < 4; ++mt) S[mt] = MFMA32(lds_tr2(B + SC_K, ktr_off(ln, mt, ks, 0), ktr_off(ln, mt, ks, 1)), Bn[ks], S[mt]);
          __builtin_amdgcn_sched_barrier(0);
        } else {
          {
            f32x16 oa[2]; oa[0] = zero16(); oa[1] = zero16();
#pragma unroll
            for (int ks = 0; ks < 8; ++ks) { const bf16x8 sb = pack8(S[ks >> 1], ks & 1);
              oa[0] = MFMA32(lds_rd128(B + SC_Q, rowfrag_off(ln, 0, ks)), sb, oa[0]); oa[1] = MFMA32(lds_rd128(B + SC_Q, rowfrag_off(ln, 1, ks)), sb, oa[1]); }
#pragma unroll
            for (int mt = 0; mt < 2; ++mt) rowscale(oa[mt], qdec + 32 * mt, hls, 1.f);
#pragma unroll
            for (int ks = 0; ks < 4; ++ks)
#pragma unroll
              for (int mt = 0; mt < 2; ++mt) oa[mt] = MFMA32(lds_rd128(B + SC_M, (mt * 4 + ks) * 1024 + ln * 16), Bv[ks], oa[mt]);
#pragma unroll
            for (int mt = 0; mt < 2; ++mt)
#pragma unroll
              for (int s2 = 0; s2 < 2; ++s2) { const bf16x8 pk = pack8(oa[mt], s2);
#pragma unroll
                for (int j = 0; j < 8; ++j) ob[(size_t)(32 * mt + crow(8 * s2 + j, hls)) * D] = (bf16_t)pk[j]; }
          }
          __builtin_amdgcn_sched_barrier(0);
#pragma unroll
          for (int mt = 0; mt < 4; ++mt) S[mt] = S[mt] * c64;
#pragma unroll
          for (int ks = 0; ks < 4; ++ks)
#pragma unroll
            for (int mt = 0; mt < 4; ++mt) S[mt] = MFMA32(lds_tr2(B + SC_K, ktr_off(ln, mt, ks, 0), ktr_off(ln, mt, ks, 1)), Bv[ks], S[mt]);
          __builtin_amdgcn_sched_barrier(0);
        }
      }
      if (!lat && act) {
        int ln3 = lane_id(); asm volatile("" : "+v"(ln3)); const int hl3 = ln3 >> 5;
        float* so = (type ? NS_DN : NS_RET) + ((((size_t)sq * 2 + dir) * NH + h) * DK) * DV + 128 * half + cb + (ln3 & 31);
#pragma unroll
        for (int mt = 0; mt < 4; ++mt)
#pragma unroll
          for (int reg = 0; reg < 16; ++reg) so[(size_t)(32 * mt + srow(reg, hl3)) * DV] = S[mt][reg];
      }
    }
  }
  GRID_BARRIER();

  bf16_t* GATES = QKV;
  {
    pg8::Gemm g{HB, WGATE, MTOT, 4096, D}; pg8::StaticOrder S; S.init(MTOT, 4096, G, bid);
    pg8::EpiBf16Act<1> E{GATES, LDG};
    pg8::gemm_phase<pg8::EpiBf16Act<1>, pg8::StaticOrder, true, true>(lds, g, S, E, wave);
  }
  GRID_BARRIER();

  bf16_t* AR = (bf16_t*)(ws + WS_AR); bf16_t* AD = (bf16_t*)(ws + WS_AD);
  {
    PHASE_TID();
    for (int m = gw; m < MTOT; m += ngw) {
      u32x2 rf[4], rb[4], df[4], db[4], gr[4], gd[4]; f32x4 gw4[4];
#pragma unroll
      for (int h = 0; h < 4; ++h) { const size_t base = (size_t)m * D + h * DV + 4 * lane;
        rf[h] = *(const u32x2*)(ORF + base); rb[h] = *(const u32x2*)(ORB + base); df[h] = *(const u32x2*)(ODF + base); db[h] = *(const u32x2*)(ODB + base);
        gr[h] = *(const u32x2*)(GATES + (size_t)m * LDG + G_RG + h * DV + 4 * lane); gd[h] = *(const u32x2*)(GATES + (size_t)m * LDG + G_DZ + h * DV + 4 * lane);
        gw4[h] = *(const f32x4*)(p.in[I_GNW] + h * DV + 4 * lane); }
      const f32x4 dw4 = *(const f32x4*)(p.in[I_DNW] + 4 * lane);
      float v[4][4], u[4][4], mu[4], rs[4], rd[4];
#pragma unroll
      for (int h = 0; h < 4; ++h) { v[h][0] = lo_bf(rf[h].x) + lo_bf(rb[h].x); v[h][1] = hi_bf(rf[h].x) + hi_bf(rb[h].x); v[h][2] = lo_bf(rf[h].y) + lo_bf(rb[h].y); v[h][3] = hi_bf(rf[h].y) + hi_bf(rb[h].y);
        u[h][0] = lo_bf(df[h].x) + lo_bf(db[h].x); u[h][1] = hi_bf(df[h].x) + hi_bf(db[h].x); u[h][2] = lo_bf(df[h].y) + lo_bf(db[h].y); u[h][3] = hi_bf(df[h].y) + hi_bf(db[h].y);
        mu[h] = (v[h][0] + v[h][1]) + (v[h][2] + v[h][3]); rd[h] = (u[h][0] * u[h][0] + u[h][1] * u[h][1]) + (u[h][2] * u[h][2] + u[h][3] * u[h][3]); }
#pragma unroll
      for (int o = 1; o < 64; o <<= 1) {
#pragma unroll
        for (int h = 0; h < 4; ++h) { mu[h] += __shfl_xor(mu[h], o); rd[h] += __shfl_xor(rd[h], o); } }
#pragma unroll
      for (int h = 0; h < 4; ++h) { mu[h] *= (1.f / DV); float q = 0.f;
#pragma unroll
        for (int e = 0; e < 4; ++e) { v[h][e] -= mu[h]; q += v[h][e] * v[h][e]; }
        rs[h] = q; }
#pragma unroll
      for (int o = 1; o < 64; o <<= 1) {
#pragma unroll
        for (int h = 0; h < 4; ++h) rs[h] += __shfl_xor(rs[h], o); }
#pragma unroll
      for (int h = 0; h < 4; ++h) { const size_t base = (size_t)m * D + h * DV + 4 * lane;
        const float r1 = rsqrtf(rs[h] * (1.f / DV) + EPS), r2 = rsqrtf(rd[h] * (1.f / DV) + EPS);
        u32x2 o; o.x = pk2(lo_bf(gr[h].x) * (v[h][0] * r1 * gw4[h].x), hi_bf(gr[h].x) * (v[h][1] * r1 * gw4[h].y)); o.y = pk2(lo_bf(gr[h].y) * (v[h][2] * r1 * gw4[h].z), hi_bf(gr[h].y) * (v[h][3] * r1 * gw4[h].w));
        *(u32x2*)(AR + base) = o;
        o.x = pk2(u[h][0] * r2 * dw4.x * lo_bf(gd[h].x), u[h][1] * r2 * dw4.y * hi_bf(gd[h].x)); o.y = pk2(u[h][2] * r2 * dw4.z * lo_bf(gd[h].y), u[h][3] * r2 * dw4.w * hi_bf(gd[h].y));
        *(u32x2*)(AD + base) = o; }
    }
  }
  GRID_BARRIER();

  bf16_t* T1 = HB;
  {
    pg8::Gemm g{AR, WRO, MTOT, D, D}; pg8::StaticOrder S; S.init(MTOT, D, G, bid);
    pg8::EpiGateMul E{T1, D, GATES + G_GR, LDG, nullptr};
    pg8::gemm_phase<pg8::EpiGateMul, pg8::StaticOrder, true, true>(lds, g, S, E, wave);
  }
  GRID_BARRIER();
  bf16_t* MERGED = (bf16_t*)(ws + WS_MERGED);
  {
    pg8::Gemm g{AD, WDO, MTOT, D, D}; pg8::StaticOrder S; S.init(MTOT, D, G, bid);
    pg8::EpiGateMul E{MERGED, D, GATES + G_GD, LDG, T1};
    pg8::gemm_phase<pg8::EpiGateMul, pg8::StaticOrder, true, true>(lds, g, S, E, wave);
  }
  GRID_BARRIER();
  float* M1 = (float*)(ws + WS_O);
  {
    pg8::Gemm g{MERGED, WOUT, MTOT, D, D}; pg8::StaticOrder S; S.init(MTOT, D, G, bid);
    pg8::EpiF32 E{M1, D};
    pg8::gemm_phase<pg8::EpiF32, pg8::StaticOrder, true, true>(lds, g, S, E, wave);
  }
  GRID_BARRIER();

  bf16_t* WF1 = (bf16_t*)(ws + WS_WF1); bf16_t* WF2 = (bf16_t*)(ws + WS_WF2);
  {
    PHASE_TID();
    LAS float* scr = (LAS float*)(lds + wave * 16384);
    transpose_matrix(p.in[I_WF1], 2 * DFF, D, 2 * DFF, WF1, [](int n) { const int pn = n >> 8, w = n & 255; return w < 128 ? 128 * pn + w : DFF + 128 * pn + (w - 128); }, scr, gw, ngw, lane);
    transpose_matrix(p.in[I_WF2], D, DFF, D, WF2, [](int n) { return n; }, scr, gw, ngw, lane);
    const float* nw1 = p.in[I_NORMW] + D; const float* nw2 = p.in[I_NORMW] + 2 * D;
    for (int m0 = gw; m0 < MTOT; m0 += 2 * ngw) {
      f32x4 v[2][4], xv[2][4], g1v[2][4]; float s[2] = {0.f, 0.f};
#pragma unroll
      for (int u = 0; u < 2; ++u) { const int m = (m0 + u * ngw < MTOT) ? m0 + u * ngw : m0; const float* xr = xrow(p, m); const float* md = MOD + (size_t)cond_of_row(m) * 6 * D; const float* mr = M1 + (size_t)m * D;
#pragma unroll
        for (int j = 0; j < 4; ++j) { const int c0 = 4 * lane + 256 * j; v[u][j] = *(const f32x4*)(mr + c0); xv[u][j] = *(const f32x4*)(xr + c0); g1v[u][j] = *(const f32x4*)(md + 2 * D + c0); } }
#pragma unroll
      for (int u = 0; u < 2; ++u)
#pragma unroll
        for (int j = 0; j < 4; ++j) s[u] += (v[u][j].x * v[u][j].x + v[u][j].y * v[u][j].y) + (v[u][j].z * v[u][j].z + v[u][j].w * v[u][j].w);
#pragma unroll
      for (int o = 1; o < 64; o <<= 1) { s[0] += __shfl_xor(s[0], o); s[1] += __shfl_xor(s[1], o); }
      float s2[2] = {0.f, 0.f};
#pragma unroll
      for (int u = 0; u < 2; ++u) { const int m = m0 + u * ngw; const float r = rsqrtf(s[u] * (1.f / D) + EPS);
#pragma unroll
        for (int j = 0; j < 4; ++j) { const int c0 = 4 * lane + 256 * j;
          v[u][j] = xv[u][j] + g1v[u][j] * (v[u][j] * r * *(const f32x4*)(nw1 + c0));
          if (m < MTOT) *(f32x4*)(p.out + (size_t)m * D + c0) = v[u][j];
          s2[u] += (v[u][j].x * v[u][j].x + v[u][j].y * v[u][j].y) + (v[u][j].z * v[u][j].z + v[u][j].w * v[u][j].w); } }
#pragma unroll
      for (int o = 1; o < 64; o <<= 1) { s2[0] += __shfl_xor(s2[0], o); s2[1] += __shfl_xor(s2[1], o); }
#pragma unroll
      for (int u = 0; u < 2; ++u) { const int m = m0 + u * ngw; if (m >= MTOT) continue; const float* md = MOD + (size_t)cond_of_row(m) * 6 * D; const float r2 = rsqrtf(s2[u] * (1.f / D) + EPS);
#pragma unroll
        for (int j = 0; j < 4; ++j) { const int c0 = 4 * lane + 256 * j;
          const f32x4 h = v[u][j] * r2 * *(const f32x4*)(nw2 + c0) * (*(const f32x4*)(md + 4 * D + c0) + 1.f) + *(const f32x4*)(md + 3 * D + c0);
          u32x2 o; o.x = pk2(h.x, h.y); o.y = pk2(h.z, h.w); *(u32x2*)(HB + (size_t)m * D + c0) = o; } }
    }
  }
  GRID_BARRIER();

  bf16_t* ACT = QKV;
  {
    pg8::Gemm g{HB, WF1, MTOT, 2 * DFF, D}; pg8::StaticOrder S; S.init(MTOT, 2 * DFF, G, bid);
    pg8::EpiSwiGLU E{ACT, DFF};
    pg8::gemm_phase<pg8::EpiSwiGLU, pg8::StaticOrder, true, true>(lds, g, S, E, wave);
  }
  GRID_BARRIER();
  float* F = (float*)(ws + WS_O);
  {
    pg8::Gemm g{ACT, WF2, MTOT, D, DFF}; pg8::StaticOrder S; S.init(MTOT, D, G, bid);
    pg8::EpiF32 E{F, D};
    pg8::gemm_phase<pg8::EpiF32, pg8::StaticOrder, true, true>(lds, g, S, E, wave);
  }
  GRID_BARRIER();
  {
    PHASE_TID();
    const float* nw3 = p.in[I_NORMW] + 3 * D;
    for (int m0 = gw; m0 < MTOT; m0 += 2 * ngw) {
      f32x4 v[2][4], xv[2][4], gv[2][4]; float s[2] = {0.f, 0.f};
#pragma unroll
      for (int u = 0; u < 2; ++u) { const int m = (m0 + u * ngw < MTOT) ? m0 + u * ngw : m0; const float* md = MOD + (size_t)cond_of_row(m) * 6 * D; const float* fr = F + (size_t)m * D; const float* orow = p.out + (size_t)m * D;
#pragma unroll
        for (int j = 0; j < 4; ++j) { const int c0 = 4 * lane + 256 * j; v[u][j] = *(const f32x4*)(fr + c0); xv[u][j] = *(const f32x4*)(orow + c0); gv[u][j] = *(const f32x4*)(md + 5 * D + c0); } }
#pragma unroll
      for (int u = 0; u < 2; ++u)
#pragma unroll
        for (int j = 0; j < 4; ++j) s[u] += (v[u][j].x * v[u][j].x + v[u][j].y * v[u][j].y) + (v[u][j].z * v[u][j].z + v[u][j].w * v[u][j].w);
#pragma unroll
      for (int o = 1; o < 64; o <<= 1) { s[0] += __shfl_xor(s[0], o); s[1] += __shfl_xor(s[1], o); }
#pragma unroll
      for (int u = 0; u < 2; ++u) { const int m = m0 + u * ngw; if (m >= MTOT) continue; const float r = rsqrtf(s[u] * (1.f / D) + EPS); float* orow = p.out + (size_t)m * D;
#pragma unroll
        for (int j = 0; j < 4; ++j) { const int c0 = 4 * lane + 256 * j; *(f32x4*)(orow + c0) = xv[u][j] + gv[u][j] * (v[u][j] * r * *(const f32x4*)(nw3 + c0)); } }
    }
  }
}

extern "C" void kernel_launch(void* const* d_in, const int* in_sizes, int n_in, void* d_out, int out_size, void* d_ws, size_t ws_size, hipStream_t stream) {
  static int grid_blocks = 0;
  if (!grid_blocks) {
    int dev = 0, cus = 0, per_cu = 0;
    (void)hipGetDevice(&dev);
    (void)hipDeviceGetAttribute(&cus, hipDeviceAttributeMultiprocessorCount, dev);
    (void)hipFuncSetAttribute((const void*)fwd_megakernel, hipFuncAttributeMaxDynamicSharedMemorySize, LDS_BYTES);
    (void)hipOccupancyMaxActiveBlocksPerMultiprocessor(&per_cu, (const void*)fwd_megakernel, NTHREADS, LDS_BYTES);
    if (per_cu < 1) per_cu = 1;
    grid_blocks = cus * per_cu;
    if (n_in != 21 || ws_size < WS_END) fprintf(stderr, "kernel_launch: unexpected n_in %d / ws_size %zu\n", n_in, ws_size);
    fprintf(stderr, "kernel_launch: cus %d per_cu %d grid %d ws %zu out %d\n", cus, per_cu, grid_blocks, ws_size, out_size);
  }
  (void)hipMemsetAsync((unsigned char*)d_ws + WS_BAR, 0, 16384, stream);
  Params p{};
  for (int i = 0; i < 21; ++i) p.in[i] = (const float*)d_in[i];
  p.out = (float*)d_out; p.ws = (unsigned char*)d_ws;
  void* args[] = {&p};
  hipError_t e = hipLaunchCooperativeKernel((const void*)fwd_megakernel, dim3(grid_blocks), dim3(NTHREADS), args, LDS_BYTES, stream);
  if (e != hipSuccess) fprintf(stderr, "cooperative launch failed: %s (grid %d)\n", hipGetErrorString(e), grid_blocks);
}
```

```cpp
#include <hip/hip_runtime.h>
#include <hip/hip_cooperative_groups.h>
#include <cstdio>
#include <cstdint>
namespace cg = cooperative_groups;

#define LAS __attribute__((address_space(3)))
typedef unsigned short bf16_t;
typedef short bf16x8 __attribute__((ext_vector_type(8)));
typedef float f32x4 __attribute__((ext_vector_type(4)));
typedef float f32x2 __attribute__((ext_vector_type(2)));
typedef unsigned u32x4 __attribute__((ext_vector_type(4)));
typedef unsigned u32x2 __attribute__((ext_vector_type(2)));

constexpr int D = 1024, MCTX = 4096, MLAT = 8192, MTOT = 12288, LCTX = 256, LLAT = 2048, NCTX = 16, NLAT = 4;
constexpr int NH = 4, DK = 128, DV = 256, DFF = 2816, INC = 8208;
constexpr float EPS = 1e-6f;
constexpr float QSCALE = 0.08838834764831845f;
constexpr int NTHREADS = 512, NWAVES = 8;
constexpr int LDS_BYTES = 135168;
constexpr int Q_RQ = 0, Q_RK = 512, Q_RV = 1024, Q_DQ = 2048, Q_DK = 2560, Q_DV = 3072, LDQ = 4096;
constexpr int G_RG = 0, G_DZ = 1024, G_GR = 2048, G_GD = 3072, LDG = 4096;
constexpr int C_RQ = 0, C_RG = 2048, C_DQ = 3072, C_DZ = 5120, C_DB = 6144, C_GR = 6160;

constexpr size_t MiB = 1u << 20;
constexpr size_t WS_MOD = 0;
constexpr size_t WS_ROPE = 128 * 1024;
constexpr size_t WS_BAR = 1152 * 1024;
constexpr size_t WS_BA = 1280 * 1024;
constexpr size_t WS_WQKV = 2 * MiB;
constexpr size_t WS_WGATE = 10 * MiB;
constexpr size_t WS_WRO = 18 * MiB, WS_WDO = 20 * MiB, WS_WOUT = 22 * MiB;
constexpr size_t WS_H = 24 * MiB;
constexpr size_t WS_QKV = 48 * MiB;
constexpr size_t WS_MATS_DN = 144 * MiB;
constexpr size_t WS_MATS_RT = 170 * MiB;
constexpr size_t WS_KB = 182 * MiB;
constexpr size_t WS_HALO = 194 * MiB;
constexpr size_t WS_O = 196 * MiB;
constexpr size_t WS_END = 244 * MiB;
constexpr size_t WS_AR = 144 * MiB, WS_AD = 168 * MiB, WS_MERGED = 144 * MiB;
constexpr size_t WS_WF1 = 144 * MiB, WS_WF2 = 155 * MiB;

struct Params {
  const float* in[21];
  float* out;
  unsigned char* ws;
};
enum { I_XP = 0, I_XS, I_C, I_SRET, I_SDN, I_CCTX, I_WMOD, I_BMOD, I_NORMW, I_WIN, I_CONVW, I_DECAY, I_GNW, I_ALOG, I_DTB, I_DNW, I_WRO, I_WDO, I_WOUT, I_WF1, I_WF2 };

__device__ __forceinline__ float bf2f(unsigned short b) { return __uint_as_float((unsigned)b << 16); }
__device__ __forceinline__ unsigned f2bf(float f) { unsigned u = __float_as_uint(f); return (u + 0x7fffu + ((u >> 16) & 1u)) >> 16; }
typedef __bf16 bfx2_t __attribute__((ext_vector_type(2)));
__device__ __forceinline__ unsigned pk2(float lo, float hi) { const f32x2 t = {lo, hi}; return __builtin_bit_cast(unsigned, __builtin_convertvector(t, bfx2_t)); }
__device__ __forceinline__ unsigned cvt_pk_bf16(float lo, float hi) { unsigned r; asm volatile("v_cvt_pk_bf16_f32 %0, %1, %2" : "=v"(r) : "v"(lo), "v"(hi)); return r; }
__device__ __forceinline__ float lo_bf(unsigned w) { return __uint_as_float(w << 16); }
__device__ __forceinline__ float hi_bf(unsigned w) { return __uint_as_float(w & 0xffff0000u); }
__device__ __forceinline__ float siluf(float x) { return x * __builtin_amdgcn_rcpf(1.f + __expf(-x)); }
__device__ __forceinline__ float sigmf(float x) { return __builtin_amdgcn_rcpf(1.f + __expf(-x)); }
__device__ __forceinline__ float softplusf(float x) { return x > 20.f ? x : log1pf(expf(x)); }
__device__ __forceinline__ float wave_sum(float v) {
#pragma unroll
  for (int o = 1; o < 64; o <<= 1) v += __shfl_xor(v, o);
  return v;
}
__device__ __forceinline__ int lane_id() { return (int)__builtin_amdgcn_mbcnt_hi(~0u, __builtin_amdgcn_mbcnt_lo(~0u, 0u)); }
__device__ __forceinline__ int cond_of_row(int m) { return m < MCTX ? 0 : 1 + (m - MCTX) / LLAT; }
__device__ __forceinline__ const float* xrow(const Params& p, int m) { return m < MCTX ? p.in[I_XP] + (size_t)m * D : p.in[I_XS] + (size_t)(m - MCTX) * D; }


__device__ __forceinline__ int lane_id();
#define XB_TMO      128
#define XB_XCNT(j)  (256  + 64 * (j))
#define XB_XSUB(j)  (1280 + 64 * (j))
#define XB_XGEN(j)  (2304 + 64 * (j))
#define XB_TOP      3328
#define XB_TOPGEN   3392
#define XCD_BAR_WORDS 3456
#define XB_SPIN_CAP (1u << 18)
__device__ __forceinline__ unsigned xb_ld(unsigned* p)              { return __hip_atomic_load(p, __ATOMIC_RELAXED, __HIP_MEMORY_SCOPE_AGENT); }
__device__ __forceinline__ unsigned xb_add(unsigned* p, unsigned v) { return __hip_atomic_fetch_add(p, v, __ATOMIC_RELAXED, __HIP_MEMORY_SCOPE_AGENT); }
__device__ __forceinline__ unsigned xb_xcc_id() { return (unsigned)__builtin_amdgcn_s_getreg((3 << 11) | 20) & 0xFu; }
#define XB_SPIN(cond, bar) do { unsigned _sp = 0; while (cond) { __builtin_amdgcn_s_sleep(1); \
    if ((++_sp & 255u) == 0u) { if (xb_ld(&(bar)[XB_TMO])) break; if (_sp > XB_SPIN_CAP) { atomicAdd(&(bar)[XB_TMO], 1u); break; } } } } while (0)
struct XcdBarrier { unsigned* bar; unsigned x; volatile LAS unsigned* st; };
__device__ __forceinline__ XcdBarrier xcd_barrier_post(unsigned* bar, volatile LAS unsigned* st) {
  XcdBarrier b; b.bar = bar; b.x = xb_xcc_id(); b.st = st;
  if (threadIdx.x == 0) (void)xb_add(&bar[XB_XCNT(b.x)], 1u);
  return b;
}
__device__ __forceinline__ void xcd_barrier_complete(unsigned* bar, unsigned x, unsigned& nloc, unsigned& nx) {
  const unsigned G = gridDim.x * gridDim.y * gridDim.z;
  unsigned sum, cnt, mine, sp = 0u;
  for (;;) {
    sum = 0u; cnt = 0u; mine = 0u;
#pragma unroll
    for (unsigned j = 0; j < 16; ++j) { const unsigned c = xb_ld(&bar[XB_XCNT(j)]); sum += c; cnt += (c > 0u) ? 1u : 0u; mine = (j == x) ? c : mine; }
    if (sum == G) break;
    __builtin_amdgcn_s_sleep(1);
    if ((++sp & 255u) == 0u) { if (xb_ld(&bar[XB_TMO])) break; if (sp > XB_SPIN_CAP) { atomicAdd(&bar[XB_TMO], 1u); break; } }
  }
  nloc = mine > 0u ? mine : 1u; nx = cnt > 0u ? cnt : 1u;
}
__device__ __forceinline__ void xcd_barrier(const XcdBarrier& b, const int wave) {
  asm volatile("s_waitcnt vmcnt(0)" ::: "memory");
  __syncthreads();
  if (wave == 0 && lane_id() == 0) {
    unsigned* bar = b.bar;
    __builtin_amdgcn_s_waitcnt(0);
    unsigned nloc = b.st[0], nx = b.st[1];
    if (nloc == 0u) { xcd_barrier_complete(bar, b.x, nloc, nx); b.st[0] = nloc; b.st[1] = nx; }
    const unsigned old = xb_add(&bar[XB_XSUB(b.x)], 1u);
    const unsigned gen = old / nloc;
    if (old + 1u == (gen + 1u) * nloc) {
      __builtin_amdgcn_fence(__ATOMIC_RELEASE, "agent");
      asm volatile("s_waitcnt vmcnt(0)" ::: "memory");
      const unsigned og = xb_add(&bar[XB_TOP], 1u);
      const unsigned tg = og / nx;
      if (og + 1u == (tg + 1u) * nx) xb_add(&bar[XB_TOPGEN], 1u);
      else XB_SPIN(xb_ld(&bar[XB_TOPGEN]) == tg, bar);
      __builtin_amdgcn_fence(__ATOMIC_ACQUIRE, "agent");
      xb_add(&bar[XB_XGEN(b.x)], 1u);
      asm volatile("s_waitcnt vmcnt(0)" ::: "memory");
    } else {
      XB_SPIN(xb_ld(&bar[XB_XGEN(b.x)]) == gen, bar);
      __builtin_amdgcn_fence(__ATOMIC_ACQUIRE, "agent");
      asm volatile("s_waitcnt vmcnt(0)" ::: "memory");
    }
  }
  __syncthreads();
}

namespace pg8 {
constexpr int BM = 256, BK = 64, HALF = 128, HTB = HALF * BK * 2, STAGE_BYTES = 8 * HTB, NXCD = 8, WGM = 8;
__host__ __device__ __forceinline__ int lds_byte(int r, int c) { const int st = (r >> 4) * 2 + (c >> 5), rr = r & 15, cc = c & 31, ob = rr * 64 + cc * 2; return st * 1024 + (ob ^ (((ob >> 9) & 1) << 5)); }
__host__ __device__ __forceinline__ void stage_rc(int b, int& R, int& C) { const int st = b / 1024, sb = b % 1024, swz = sb ^ (((sb >> 9) & 1) << 5); R = (st >> 1) * 16 + swz / 64; C = (st & 1) * 32 + (swz % 64) / 2; }
__host__ __device__ __forceinline__ int perm32(int rho) { const int n = rho >> 4, i = rho & 15; return 8 * (i >> 2) + 4 * n + (i & 3); }
struct Unit { int pm, pn; };
struct Gemm { const bf16_t* A; const bf16_t* Bt; int M, N, K; };
struct StaticOrder {
  int nM, nN, nwg, G, c;
  __host__ __device__ void init(int M, int N, int G_, int c_) { nM = M / BM; nN = N / BM; nwg = nM * nN; G = G_; c = c_; }
  __host__ __device__ bool next(int i, Unit& u) const {
    const long L = (long)i * G + c; if (L >= nwg) return false;
    int wgid = (int)L; { const int q = nwg / NXCD, r = nwg % NXCD, xcd = wgid % NXCD, off = wgid / NXCD; wgid = (xcd < r ? xcd * (q + 1) : r * (q + 1) + (xcd - r) * q) + off; }
    const int nig = WGM * nN, gid = wgid / nig, fm = gid * WGM, gsz = (nM - fm) < WGM ? (nM - fm) : WGM;
    u.pm = fm + ((wgid % nig) % gsz); u.pn = (wgid % nig) / gsz; return true;
  }
  __device__ __forceinline__ void a_ready(const Unit&) const {}
  __device__ __forceinline__ void done(const Unit&) const {}
};

template <int MODE  > struct EpiBf16Act {
  static constexpr bool PERM = true, AFTER_DRAIN = false;
  bf16_t* O; int ldc;
  __device__ __forceinline__ void operator()(const f32x4 (&acc)[2][2][4][2], const Unit& u, int wr, int wc, int fr, int fq) const {
    const int row0 = u.pm * BM + wr * 64 + fr, col0 = u.pn * BM + wc * 32 + 8 * fq;
    const bool sg = u.pn >= 8;
#pragma unroll
    for (int ai = 0; ai < 2; ++ai)
#pragma unroll
      for (int m = 0; m < 4; ++m) { bf16_t* rowp = O + (size_t)(row0 + ai * HALF + m * 16) * ldc + col0;
#pragma unroll
        for (int bj = 0; bj < 2; ++bj) { f32x4 v0 = acc[ai][bj][m][0], v1 = acc[ai][bj][m][1];
          if (MODE == 1) {
#pragma unroll
            for (int i = 0; i < 4; ++i) { const float s0 = __builtin_amdgcn_rcpf(1.f + __expf(-v0[i])), s1 = __builtin_amdgcn_rcpf(1.f + __expf(-v1[i]));
              v0[i] = sg ? s0 : v0[i] * s0; v1[i] = sg ? s1 : v1[i] * s1; } }
          u32x4 w; w.x = cvt_pk_bf16(v0[0], v0[1]); w.y = cvt_pk_bf16(v0[2], v0[3]); w.z = cvt_pk_bf16(v1[0], v1[1]); w.w = cvt_pk_bf16(v1[2], v1[3]);
          *(u32x4*)(rowp + bj * HALF) = w; } }
  }
};
struct EpiQKV {
  static constexpr bool PERM = true, AFTER_DRAIN = false;
  bf16_t* O; int ldc; bf16_t* HALO;
  __device__ __forceinline__ void operator()(const f32x4 (&acc)[2][2][4][2], const Unit& u, int wr, int wc, int fr, int fq) const {
    const int row0 = u.pm * BM + wr * 64 + fr, col0 = u.pn * BM + wc * 32 + 8 * fq;
#pragma unroll
    for (int ai = 0; ai < 2; ++ai)
#pragma unroll
      for (int m = 0; m < 4; ++m) { const int row = row0 + ai * HALF + m * 16; bf16_t* rowp = O + (size_t)row * ldc + col0;
#pragma unroll
        for (int bj = 0; bj < 2; ++bj) { const f32x4 v0 = acc[ai][bj][m][0], v1 = acc[ai][bj][m][1];
          u32x4 w; w.x = cvt_pk_bf16(v0[0], v0[1]); w.y = cvt_pk_bf16(v0[2], v0[3]); w.z = cvt_pk_bf16(v1[0], v1[1]); w.w = cvt_pk_bf16(v1[2], v1[3]);
          *(u32x4*)(rowp + bj * HALF) = w;
          if (u.pn >= 8 && ((m == 0 && fr == 0) || (m == 3 && fr == 15)))
            *(u32x4*)(HALO + ((size_t)(row >> 6) * 2 + (m == 3 ? 1 : 0)) * 2048 + (col0 - 2048) + bj * HALF) = w; } }
  }
};
struct EpiGateMul {
  static constexpr bool PERM = true, AFTER_DRAIN = false;
  bf16_t* O; int ldc; const bf16_t* G; int ldg; const bf16_t* Add;
  __device__ __forceinline__ void operator()(const f32x4 (&acc)[2][2][4][2], const Unit& u, int wr, int wc, int fr, int fq) const {
    const int row0 = u.pm * BM + wr * 64 + fr, col0 = u.pn * BM + wc * 32 + 8 * fq;
#pragma unroll
    for (int ai = 0; ai < 2; ++ai)
#pragma unroll
      for (int m = 0; m < 4; ++m) { const size_t r = (size_t)(row0 + ai * HALF + m * 16);
#pragma unroll
        for (int bj = 0; bj < 2; ++bj) { const f32x4 v0 = acc[ai][bj][m][0], v1 = acc[ai][bj][m][1];
          const u32x4 g = *(const u32x4*)(G + r * ldg + col0 + bj * HALF);
          float o[8] = {v0[0] * lo_bf(g.x), v0[1] * hi_bf(g.x), v0[2] * lo_bf(g.y), v0[3] * hi_bf(g.y), v1[0] * lo_bf(g.z), v1[1] * hi_bf(g.z), v1[2] * lo_bf(g.w), v1[3] * hi_bf(g.w)};
          if (Add) { const u32x4 a = *(const u32x4*)(Add + r * ldc + col0 + bj * HALF);
            o[0] += lo_bf(a.x); o[1] += hi_bf(a.x); o[2] += lo_bf(a.y); o[3] += hi_bf(a.y); o[4] += lo_bf(a.z); o[5] += hi_bf(a.z); o[6] += lo_bf(a.w); o[7] += hi_bf(a.w); }
          u32x4 w; w.x = cvt_pk_bf16(o[0], o[1]); w.y = cvt_pk_bf16(o[2], o[3]); w.z = cvt_pk_bf16(o[4], o[5]); w.w = cvt_pk_bf16(o[6], o[7]);
          *(u32x4*)(O + r * ldc + col0 + bj * HALF) = w; } }
  }
};
struct EpiF32 {
  static constexpr bool PERM = false, AFTER_DRAIN = false;
  float* O; int ldc;
  __device__ __forceinline__ void operator()(const f32x4 (&acc)[2][2][4][2], const Unit& u, int wr, int wc, int fr, int fq) const {
    const int row0 = u.pm * BM + wr * 64 + fr, col0 = u.pn * BM + wc * 32 + 4 * fq;
#pragma unroll
    for (int ai = 0; ai < 2; ++ai)
#pragma unroll
      for (int m = 0; m < 4; ++m) { float* rowp = O + (size_t)(row0 + ai * HALF + m * 16) * ldc + col0;
#pragma unroll
        for (int bj = 0; bj < 2; ++bj)
#pragma unroll
          for (int n = 0; n < 2; ++n) *(f32x4*)(rowp + bj * HALF + n * 16) = acc[ai][bj][m][n]; }
  }
};
struct EpiSwiGLU {
  static constexpr bool PERM = true, AFTER_DRAIN = false;
  bf16_t* O; int ldc;
  __device__ __forceinline__ void operator()(const f32x4 (&acc)[2][2][4][2], const Unit& u, int wr, int wc, int fr, int fq) const {
    const int row0 = u.pm * BM + wr * 64 + fr, col0 = u.pn * HALF + wc * 32 + 8 * fq;
#pragma unroll
    for (int ai = 0; ai < 2; ++ai)
#pragma unroll
      for (int m = 0; m < 4; ++m) { bf16_t* rowp = O + (size_t)(row0 + ai * HALF + m * 16) * ldc + col0;
        float o[8];
#pragma unroll
        for (int n = 0; n < 2; ++n)
#pragma unroll
          for (int i = 0; i < 4; ++i) { const float g = acc[ai][0][m][n][i], up = acc[ai][1][m][n][i]; o[4 * n + i] = g * __builtin_amdgcn_rcpf(1.f + __expf(-g)) * up; }
        u32x4 w; w.x = cvt_pk_bf16(o[0], o[1]); w.y = cvt_pk_bf16(o[2], o[3]); w.z = cvt_pk_bf16(o[4], o[5]); w.w = cvt_pk_bf16(o[6], o[7]);
        *(u32x4*)rowp = w; }
  }
};

template <class Epi, class Sched, bool ALIGN_EPI = false, bool SP2 = false>
__device__ __forceinline__ void gemm_phase(LAS unsigned char* lds, const Gemm g, const Sched& S, const Epi& E, const int wid) {
  int lane_o = lane_id(); asm volatile("" : "+v"(lane_o));
  const int lane = lane_o, tid = (wid << 6) | lane, wr = wid >> 2, wc = wid & 3, fr = lane & 15, fq = lane >> 4;
  const int K = g.K, nt = K / BK;
  unsigned voffA[2], voffB[2];
#pragma unroll
  for (int i = 0; i < 2; ++i) { int R, C; stage_rc(tid * 16 + i * 8192, R, C); const int Rb = Epi::PERM ? ((R & ~31) + perm32(R & 31)) : R;
    voffA[i] = (unsigned)(R * K + C) * 2u; voffB[i] = (unsigned)(Rb * K + C) * 2u; }
  const size_t kstep = (size_t)(BK * 2);
  const size_t hstep = (size_t)HALF * K * 2;
  const size_t tstep = 2 * hstep;
  const unsigned ldsw = (unsigned)wid * 1024u;
  const int aoff = lds_byte(wr * 64 + fr, fq * 8), boff = lds_byte(wc * 32 + fr, fq * 8);
#define PG8_SA(b, h) (((b) * 2 + (h)) * HTB)
#define PG8_SB(b, h) ((4 + (b) * 2 + (h)) * HTB)
#define PG8_STAGE(bufoff, gbase, voff) do { _Pragma("unroll") for (int _i = 0; _i < 2; ++_i) \
    __builtin_amdgcn_global_load_lds((const unsigned*)((const char*)(gbase) + (voff)[_i]), (LAS unsigned*)(lds + (bufoff) + ldsw + _i * 8192), 16, 0, 0); } while (0)
#define PG8_LDA(dst, b, h) do { _Pragma("unroll") for (int m = 0; m < 4; ++m) _Pragma("unroll") for (int k = 0; k < 2; ++k) dst[m][k] = *(const LAS bf16x8*)(lds + PG8_SA(b, h) + aoff + m * 2048 + k * 1024); } while (0)
#define PG8_LDB(dst, b, h) do { _Pragma("unroll") for (int n = 0; n < 2; ++n) _Pragma("unroll") for (int k = 0; k < 2; ++k) dst[n][k] = *(const LAS bf16x8*)(lds + PG8_SB(b, h) + boff + n * 2048 + k * 1024); } while (0)
#define PG8_MMA(ai, bj, At, Bt) do { __builtin_amdgcn_s_setprio(1); _Pragma("unroll") for (int m = 0; m < 4; ++m) _Pragma("unroll") for (int n = 0; n < 2; ++n) _Pragma("unroll") for (int k = 0; k < 2; ++k) \
    acc[ai][bj][m][n] = __builtin_amdgcn_mfma_f32_16x16x32_bf16(Bt[n][k], At[m][k], acc[ai][bj][m][n], 0, 0, 0); __builtin_amdgcn_s_setprio(0); } while (0)
#define PG8_WAIT_V(n) asm volatile("s_waitcnt vmcnt(" #n ")" ::: "memory")
#define PG8_WAIT_L(n) asm volatile("s_waitcnt lgkmcnt(" #n ")" ::: "memory")
#define PG8_BAR __builtin_amdgcn_s_barrier()
#define PG8_SCHED __builtin_amdgcn_sched_barrier(0)
  Unit cur, nxt; int ui = 0;
  if (!S.next(0, cur)) return;
  f32x4 acc[2][2][4][2];
#pragma unroll
  for (int a = 0; a < 2; ++a)
#pragma unroll
    for (int b = 0; b < 2; ++b)
#pragma unroll
      for (int m = 0; m < 4; ++m)
#pragma unroll
        for (int n = 0; n < 2; ++n) acc[a][b][m][n] = (f32x4){0.f, 0.f, 0.f, 0.f};
  bf16x8 At[4][2], B0[2][2], B1[2][2];
  const char* cA = (const char*)g.A + (size_t)cur.pm * tstep; const char* cB = (const char*)g.Bt + (size_t)cur.pn * tstep;
  S.a_ready(cur);
  if constexpr (SP2) {
    PG8_STAGE(PG8_SB(0, 0), cB, voffB); PG8_STAGE(PG8_SB(0, 1), cB + hstep, voffB); PG8_STAGE(PG8_SA(0, 0), cA, voffA); PG8_STAGE(PG8_SA(0, 1), cA + hstep, voffA);
    if (wr == 1) PG8_BAR;
    PG8_WAIT_V(2); PG8_BAR;
    PG8_STAGE(PG8_SB(1, 0), cB + kstep, voffB); PG8_STAGE(PG8_SA(1, 0), cA + kstep, voffA); PG8_STAGE(PG8_SB(1, 1), cB + hstep + kstep, voffB);
    PG8_WAIT_V(6); PG8_BAR;
  } else {
    PG8_STAGE(PG8_SB(0, 0), cB, voffB); PG8_STAGE(PG8_SA(0, 0), cA, voffA); PG8_STAGE(PG8_SB(0, 1), cB + hstep, voffB); PG8_STAGE(PG8_SA(0, 1), cA + hstep, voffA);
    if (wr == 1) PG8_BAR;
    PG8_WAIT_V(4); PG8_BAR;
    PG8_STAGE(PG8_SB(1, 0), cB + kstep, voffB); PG8_STAGE(PG8_SA(1, 0), cA + kstep, voffA); PG8_STAGE(PG8_SB(1, 1), cB + hstep + kstep, voffB);
    PG8_WAIT_V(6); PG8_BAR;
  }
  for (;;) {
    const bool has_next = S.next(ui + 1, nxt);
    const char* nA = has_next ? (const char*)g.A + (size_t)nxt.pm * tstep : cA; const char* nB = has_next ? (const char*)g.Bt + (size_t)nxt.pn * tstep : cB;
    for (int t = 0; t < nt; t += 2) {
      const bool last = (t == nt - 2);
      const char* a1 = cA + (size_t)(t + 1) * kstep;
      const char* a2 = last ? nA : cA + (size_t)(t + 2) * kstep; const char* b2 = last ? nB : cB + (size_t)(t + 2) * kstep;
      const char* a3 = a2 + kstep; const char* b3 = b2 + kstep;
      if (last && has_next) S.a_ready(nxt);
      if constexpr (SP2) {
        PG8_LDB(B0, 0, 0); PG8_LDB(B1, 0, 1); PG8_SCHED; PG8_LDA(At, 0, 0); PG8_STAGE(PG8_SA(1, 1), a1 + hstep, voffA);
        PG8_WAIT_V(8); PG8_WAIT_L(0); PG8_BAR; PG8_MMA(0, 0, At, B0); PG8_MMA(0, 1, At, B1); PG8_BAR; PG8_SCHED;
        PG8_LDA(At, 0, 1); PG8_STAGE(PG8_SB(0, 0), b2, voffB); PG8_STAGE(PG8_SB(0, 1), b2 + hstep, voffB); PG8_STAGE(PG8_SA(0, 0), a2, voffA);
        PG8_WAIT_V(8); PG8_WAIT_L(0); PG8_BAR; PG8_MMA(1, 0, At, B0); PG8_MMA(1, 1, At, B1); PG8_BAR; PG8_SCHED;
        PG8_LDB(B0, 1, 0); PG8_LDB(B1, 1, 1); PG8_SCHED; PG8_LDA(At, 1, 0); PG8_STAGE(PG8_SA(0, 1), a2 + hstep, voffA);
        PG8_WAIT_V(8); PG8_WAIT_L(0); PG8_BAR; PG8_MMA(0, 0, At, B0); PG8_MMA(0, 1, At, B1); PG8_BAR; PG8_SCHED;
        PG8_LDA(At, 1, 1); PG8_STAGE(PG8_SB(1, 0), b3, voffB); PG8_STAGE(PG8_SB(1, 1), b3 + hstep, voffB); PG8_STAGE(PG8_SA(1, 0), a3, voffA);
        PG8_WAIT_V(8); PG8_WAIT_L(0); PG8_BAR; PG8_MMA(1, 0, At, B0); PG8_MMA(1, 1, At, B1); PG8_BAR; PG8_SCHED;
      } else {
        PG8_LDB(B0, 0, 0); PG8_SCHED; PG8_LDA(At, 0, 0); PG8_STAGE(PG8_SA(1, 1), a1 + hstep, voffA);
        PG8_WAIT_L(8); PG8_BAR; PG8_WAIT_L(0); PG8_MMA(0, 0, At, B0); PG8_BAR; PG8_SCHED;
        PG8_LDB(B1, 0, 1); PG8_STAGE(PG8_SB(0, 0), b2, voffB);
        PG8_BAR; PG8_WAIT_L(0); PG8_MMA(0, 1, At, B1); PG8_BAR;
        PG8_LDA(At, 0, 1); PG8_STAGE(PG8_SA(0, 0), a2, voffA);
        PG8_BAR; PG8_WAIT_L(0); PG8_MMA(1, 0, At, B0); PG8_BAR; PG8_SCHED;
        PG8_STAGE(PG8_SB(0, 1), b2 + hstep, voffB);
        PG8_WAIT_V(6); PG8_BAR; PG8_MMA(1, 1, At, B1); PG8_BAR;
        PG8_LDB(B0, 1, 0); PG8_SCHED; PG8_LDA(At, 1, 0); PG8_STAGE(PG8_SA(0, 1), a2 + hstep, voffA);
        PG8_WAIT_L(8); PG8_BAR; PG8_WAIT_L(0); PG8_MMA(0, 0, At, B0); PG8_BAR; PG8_SCHED;
        PG8_LDB(B1, 1, 1); PG8_STAGE(PG8_SB(1, 0), b3, voffB);
        PG8_BAR; PG8_WAIT_L(0); PG8_MMA(0, 1, At, B1); PG8_BAR;
        PG8_LDA(At, 1, 1); PG8_STAGE(PG8_SA(1, 0), a3, voffA);
        PG8_BAR; PG8_WAIT_L(0); PG8_MMA(1, 0, At, B0); PG8_BAR; PG8_SCHED;
        PG8_STAGE(PG8_SB(1, 1), b3 + hstep, voffB);
        PG8_WAIT_V(6); PG8_BAR; PG8_MMA(1, 1, At, B1); PG8_BAR;
      }
    }
    if constexpr (ALIGN_EPI) { if (wr == 0) PG8_BAR; }
    if constexpr (!Epi::AFTER_DRAIN) { E(acc, cur, wr, wc, fr, fq); S.done(cur); }
    if (!has_next) break;
#pragma unroll
    for (int a = 0; a < 2; ++a)
#pragma unroll
      for (int b = 0; b < 2; ++b)
#pragma unroll
        for (int m = 0; m < 4; ++m)
#pragma unroll
          for (int n = 0; n < 2; ++n) acc[a][b][m][n] = (f32x4){0.f, 0.f, 0.f, 0.f};
    cur = nxt; cA = nA; cB = nB; ++ui;
    if constexpr (ALIGN_EPI) { if (wr == 1) PG8_BAR; }
  }
  PG8_WAIT_V(0);
  if constexpr (!ALIGN_EPI) { if (wr == 0) PG8_BAR; }
  PG8_BAR;
#undef PG8_SA
#undef PG8_SB
#undef PG8_STAGE
#undef PG8_LDA
#undef PG8_LDB
#undef PG8_MMA
#undef PG8_WAIT_V
#undef PG8_WAIT_L
#undef PG8_BAR
#undef PG8_SCHED
}
}

typedef float f32x16 __attribute__((ext_vector_type(16)));
typedef float f32x8 __attribute__((ext_vector_type(8)));
typedef short s16x4 __attribute__((ext_vector_type(4)));
typedef __bf16 bfx8 __attribute__((ext_vector_type(8)));
#define MFMA32(a, b, c) __builtin_amdgcn_mfma_f32_32x32x16_bf16((a), (b), (c), 0, 0, 0)
__device__ __forceinline__ bf16x8 cvt8(f32x8 t) { return __builtin_bit_cast(bf16x8, __builtin_convertvector(t, bfx8)); }
__device__ __forceinline__ bf16x8 pack8(const f32x16& x, int s) {
  const f32x8 t = {x[8 * s], x[8 * s + 1], x[8 * s + 2], x[8 * s + 3], x[8 * s + 4], x[8 * s + 5], x[8 * s + 6], x[8 * s + 7]};
  return cvt8(t);
}
__device__ __forceinline__ f32x16 zero16() { f32x16 z; for (int i = 0; i < 16; ++i) z[i] = 0.f; return z; }
__device__ __forceinline__ unsigned off_b(unsigned row, unsigned ch) { return 256u * row + 16u * (ch ^ (((row & 3u) << 2) | ((row >> 2) & 3u))); }
__device__ __forceinline__ int swap12(int p) { return ((p & 1) << 1) | (p >> 1); }
__device__ __forceinline__ bf16x8 lds_rd128(LAS unsigned char* lds, unsigned off) { return *(const LAS bf16x8*)(lds + off); }
__device__ __forceinline__ bf16x8 lds_tr2(LAS unsigned char* lds, unsigned off_lo, unsigned off_hi) {
  const s16x4 lo = __builtin_amdgcn_ds_read_tr16_b64_v4i16((LAS s16x4*)(lds + off_lo));
  const s16x4 hi = __builtin_amdgcn_ds_read_tr16_b64_v4i16((LAS s16x4*)(lds + off_hi));
  return __builtin_shufflevector(lo, hi, 0, 1, 2, 3, 4, 5, 6, 7);
}
__device__ __forceinline__ void glds16(const void* g, LAS unsigned char* l) {
  unsigned keep; const unsigned dst = __builtin_amdgcn_readfirstlane((unsigned)(size_t)l);
  asm volatile("s_mov_b32 %0, m0\n\ts_mov_b32 m0, %2\n\ts_nop 0\n\tglobal_load_lds_dwordx4 %1, off\n\ts_mov_b32 m0, %0" : "=&s"(keep) : "v"(g), "s"(dst) : "memory");
}
__device__ __forceinline__ unsigned rowfrag_off(int lane, int mt, int ks) { return off_b(32 * mt + (lane & 31), 2 * ks + (lane >> 5)); }
__device__ __forceinline__ unsigned vtr_off(int lane, int cb, int ks, int sec) {
  const int g = lane >> 4, i = lane & 15, hh = g >> 1, half16 = g & 1, qq = i >> 2, p = i & 3;
  const int row = 16 * ks + 4 * hh + 8 * sec + qq, col = cb + 16 * half16 + 4 * p;
  return off_b(row, col >> 3) + (col & 7) * 2;
}
__device__ __forceinline__ unsigned ktr_off(int lane, int mt, int ks, int sec) {
  const int g = lane >> 4, i = lane & 15, hh = g >> 1, half16 = g & 1, qq = i >> 2, p = i & 3;
  const int row = 16 * ks + 4 * hh + 8 * sec + qq, col = 32 * mt + 16 * half16 + 4 * swap12(p);
  return off_b(row, col >> 3) + (col & 7) * 2;
}
__device__ __forceinline__ int crow(int reg, int h) { return (reg & 3) + 8 * (reg >> 2) + 4 * h; }
__device__ __forceinline__ int srow(int reg, int h) { return 16 * (reg >> 3) + 8 * h + 4 * ((reg >> 2) & 1) + (reg & 3); }
__device__ __forceinline__ void rowscale(f32x16& a, const LAS float* vec, int h, float sgn) {
#pragma unroll
  for (int g4 = 0; g4 < 4; ++g4) { const f32x4 s = *(const LAS f32x4*)(vec + 8 * g4 + 4 * h);
    a[4 * g4] *= s.x * sgn; a[4 * g4 + 1] *= s.y * sgn; a[4 * g4 + 2] *= s.z * sgn; a[4 * g4 + 3] *= s.w * sgn; }
}
__device__ __forceinline__ void stage_img_piece(const unsigned char* src, size_t pitch, LAS unsigned char* img, int pc, int lane) {
  const unsigned row = 4 * pc + (lane >> 4), chp = lane & 15, ch = chp ^ (((row & 3u) << 2) | ((row >> 2) & 3u));
  glds16(src + (size_t)row * pitch + ch * 16, img + 1024 * pc);
}
constexpr int SC_BUF = 66560, SC_Q = 0, SC_K = 16384, SC_M = 32768, SC_V = 50176, SC_VEC = 2 * SC_BUF;
constexpr int DN_BLOB = 17408, RT_BLOB = 8192;
__device__ __forceinline__ void scan_stage(LAS unsigned char* lds, int buf, int type, int dir, int h, int gc, const bf16_t* QKV, const bf16_t* KBUF,
                                           const unsigned char* MATS_RT, const unsigned char* MATS_DN, int half, int w, int lane) {
  const size_t row0 = (size_t)gc * 64;
  const unsigned char* rowp = (const unsigned char*)(QKV + row0 * LDQ);
  const unsigned char* qsrc = rowp + (type ? Q_DQ + h * DK : Q_RQ + h * DK) * 2;
  const unsigned char* ksrc = rowp + (type ? Q_DK + h * DK : Q_RK + h * DK) * 2; size_t kpitch = LDQ * 2;
  if (!type && dir) { ksrc = (const unsigned char*)(KBUF + row0 * 512 + h * DK); kpitch = 1024; }
  const unsigned char* vsrc = rowp + (type ? Q_DV + h * DV : Q_RV + h * DV) * 2 + half * 256;
  LAS unsigned char* B = lds + buf * SC_BUF;
#pragma unroll
  for (int i = 0; i < 2; ++i) { const int pc = w + 8 * i;
    stage_img_piece(qsrc, LDQ * 2, B + SC_Q, pc, lane); stage_img_piece(ksrc, kpitch, B + SC_K, pc, lane);
    stage_img_piece(vsrc, LDQ * 2, B + SC_V, pc, lane); }
  const unsigned char* blob = type ? MATS_DN + (size_t)((gc * 4 + h) * 2 + dir) * DN_BLOB : MATS_RT + (size_t)((gc * 4 + h) * 2 + dir) * RT_BLOB;
  const int np = type ? 17 : 8;
  for (int pc = w; pc < np; pc += 8) glds16(blob + pc * 1024 + lane * 16, B + SC_M + pc * 1024);
}

__device__ __forceinline__ void transpose_item(const float* W, int ldw, int K, int src_col0, bf16_t* WT, int dst_row0, int k0, LAS float* scr, int lane) {
#pragma unroll 8
  for (int i = 0; i < 32; ++i) { const int kk = 2 * i + (lane >> 5); scr[kk * 33 + (lane & 31)] = W[(size_t)(k0 + kk) * ldw + src_col0 + (lane & 31)]; }
  asm volatile("s_waitcnt lgkmcnt(0)" ::: "memory");
  const int c = lane & 7;
#pragma unroll
  for (int j = 0; j < 4; ++j) { const int n = (lane >> 3) + 8 * j; const LAS float* s = scr + (8 * c) * 33 + n;
    u32x4 o; o.x = pk2(s[0 * 33], s[1 * 33]); o.y = pk2(s[2 * 33], s[3 * 33]); o.z = pk2(s[4 * 33], s[5 * 33]); o.w = pk2(s[6 * 33], s[7 * 33]);
    *(u32x4*)(WT + (size_t)(dst_row0 + n) * K + k0 + 8 * c) = o; }
  asm volatile("s_waitcnt lgkmcnt(0)" ::: "memory");
}

template <class ColMap> __device__ __forceinline__ void transpose_matrix(const float* W, int ldw, int K, int N, bf16_t* WT, ColMap cm, LAS float* scr, int gw, int ngw, int lane) {
  const int nblk = N / 32, items = (K / 64) * nblk;
  for (int it = gw; it < items; it += ngw) { const int kb = it / nblk, nb = it % nblk; transpose_item(W, ldw, K, cm(32 * nb), WT, 32 * nb, 64 * kb, scr, lane); }
}

__global__ void __launch_bounds__(NTHREADS) fwd_megakernel(Params p) {
  extern __shared__ __attribute__((aligned(16))) unsigned char lds_raw[];
  LAS unsigned char* lds = (LAS unsigned char*)lds_raw;
  cg::grid_group grid = cg::this_grid();
  volatile LAS unsigned* bar_st = (volatile LAS unsigned*)(lds + LDS_BYTES - 64);
  if (threadIdx.x < 2) bar_st[threadIdx.x] = 0u;
  __syncthreads();
  const XcdBarrier xbar = xcd_barrier_post((unsigned*)(p.ws + WS_BAR), bar_st);
  if (p.ws == nullptr) grid.sync();
#define GRID_BARRIER() xcd_barrier(xbar, wave)
  const int wave = __builtin_amdgcn_readfirstlane(threadIdx.x >> 6);
#define PHASE_TID() int lane_p = lane_id(); asm volatile("" : "+v"(lane_p)); const int lane = lane_p, tid = (wave << 6) | lane; (void)tid;
  const int G = gridDim.x, bid = blockIdx.x;
  const int gw = bid * NWAVES + wave, ngw = G * NWAVES;
  unsigned char* ws = p.ws;
  float* MOD = (float*)(ws + WS_MOD);
  f32x2* ROPE = (f32x2*)(ws + WS_ROPE);
  float* BA = (float*)(ws + WS_BA);
  float* DECLG = (float*)(ws + WS_MOD + 122880);
  bf16_t* WQKV = (bf16_t*)(ws + WS_WQKV); bf16_t* WGATE = (bf16_t*)(ws + WS_WGATE);
  bf16_t* WRO = (bf16_t*)(ws + WS_WRO); bf16_t* WDO = (bf16_t*)(ws + WS_WDO); bf16_t* WOUT = (bf16_t*)(ws + WS_WOUT);
  bf16_t* HB = (bf16_t*)(ws + WS_H);
  bf16_t* QKV = (bf16_t*)(ws + WS_QKV);
  bf16_t* KBUF = (bf16_t*)(ws + WS_KB); bf16_t* HALO = (bf16_t*)(ws + WS_HALO);
  unsigned char* MATS_RT = ws + WS_MATS_RT; unsigned char* MATS_DN = ws + WS_MATS_DN;
  unsigned char* LSCR = ws + WS_O; constexpr int LSCR_STRIDE = 16896;
  bf16_t* ODF = (bf16_t*)(ws + WS_O); bf16_t* ODB = ODF + (size_t)MTOT * D;
  bf16_t* ORF = (bf16_t*)p.out; bf16_t* ORB = ORF + (size_t)MTOT * D;
  float* NS_RET = p.out + (size_t)MTOT * D; float* NS_DN = NS_RET + (size_t)NCTX * 2 * NH * DK * DV;

  {
    PHASE_TID();
    LAS float* scr = (LAS float*)(lds + wave * 16384);
    transpose_matrix(p.in[I_WIN], INC, D, 4096, WQKV, [](int n) { return n < 2048 ? n : n + 1024; }, scr, gw, ngw, lane);
    transpose_matrix(p.in[I_WIN], INC, D, 4096, WGATE, [](int n) { return n < 1024 ? C_RG + n : (n < 2048 ? C_DZ + (n - 1024) : C_GR + (n - 2048)); }, scr, gw, ngw, lane);
    transpose_matrix(p.in[I_WRO], D, D, D, WRO, [](int n) { return n; }, scr, gw, ngw, lane);
    transpose_matrix(p.in[I_WDO], D, D, D, WDO, [](int n) { return n; }, scr, gw, ngw, lane);
    transpose_matrix(p.in[I_WOUT], D, D, D, WOUT, [](int n) { return n; }, scr, gw, ngw, lane);
    {
      __syncthreads();
      LAS float* scond = (LAS float*)lds;
      LAS float* red = scond + 5 * D;
      for (int i = tid; i < 5 * D; i += NTHREADS) { const int c = i >> 10, k = i & 1023; scond[i] = siluf(c == 0 ? p.in[I_CCTX][k] : p.in[I_C][(c - 1) * D + k]); }
      __syncthreads();
      for (int it = bid; it < 6 * D / 32; it += G) {
        const int col = it * 32 + (lane & 31), rpar = lane >> 5;
        float acc[5] = {0.f, 0.f, 0.f, 0.f, 0.f};
        const float* wm = p.in[I_WMOD] + (size_t)(128 * wave + rpar) * 6 * D + col;
#pragma unroll 16
        for (int i = 0; i < 64; ++i) { const float wv = wm[(size_t)(2 * i) * 6 * D]; const int k = 128 * wave + 2 * i + rpar;
#pragma unroll
          for (int c = 0; c < 5; ++c) acc[c] += scond[c * D + k] * wv; }
#pragma unroll
        for (int c = 0; c < 5; ++c) { acc[c] += __shfl_xor(acc[c], 32); if (lane < 32) red[(wave * 5 + c) * 32 + lane] = acc[c]; }
        __syncthreads();
        if (tid < 160) { const int c = tid >> 5, n = tid & 31; float s = 0.f;
#pragma unroll
          for (int ww = 0; ww < 8; ++ww) s += red[(ww * 5 + c) * 32 + n];
          MOD[c * 6 * D + it * 32 + n] = s + p.in[I_BMOD][it * 32 + n]; }
        __syncthreads();
      }
    }
    for (int i = bid * NTHREADS + tid; i < LLAT * 64; i += G * NTHREADS) { const int l = i >> 6, pr = i & 63;
      const float freq = powf(10000.f, -(float)(pr & 31) / 32.f); const float ang = (pr < 32 ? (float)(l >> 6) : (float)(l & 63)) * freq;
      ROPE[i] = (f32x2){cosf(ang), sinf(ang)}; }
    if (bid == 0 && tid < 8) DECLG[tid] = -softplusf(-p.in[I_DECAY][tid]);
  }
  GRID_BARRIER();

  {
    PHASE_TID();
    LAS float* wba = (LAS float*)lds;
    for (int i = tid; i < D * 16; i += NTHREADS) wba[(i & 15) * 1028 + (i >> 4)] = p.in[I_WIN][(size_t)(i >> 4) * INC + C_DB + (i & 15)];
    __syncthreads();
    const float* nw = p.in[I_NORMW];
    for (int m = gw; m < MTOT; m += ngw) {
      const float* xr = xrow(p, m); const float* md = MOD + (size_t)cond_of_row(m) * 6 * D;
      f32x4 x4[4], w4[4], sc4[4], sh4[4]; float s = 0.f;
#pragma unroll
      for (int j = 0; j < 4; ++j) { const int c0 = 4 * lane + 256 * j; x4[j] = *(const f32x4*)(xr + c0); w4[j] = *(const f32x4*)(nw + c0); sc4[j] = *(const f32x4*)(md + D + c0); sh4[j] = *(const f32x4*)(md + c0); }
#pragma unroll
      for (int j = 0; j < 4; ++j) s += (x4[j].x * x4[j].x + x4[j].y * x4[j].y) + (x4[j].z * x4[j].z + x4[j].w * x4[j].w);
      const float r = rsqrtf(wave_sum(s) * (1.f / D) + EPS);
      float dots[16];
#pragma unroll
      for (int n = 0; n < 16; ++n) dots[n] = 0.f;
#pragma unroll
      for (int j = 0; j < 4; ++j) { const int c0 = 4 * lane + 256 * j;
        const f32x4 h = x4[j] * r * w4[j] * (sc4[j] + 1.f) + sh4[j];
        u32x2 o; o.x = pk2(h.x, h.y); o.y = pk2(h.z, h.w);
        *(u32x2*)(HB + (size_t)m * D + c0) = o;
#pragma unroll
        for (int n = 0; n < 16; ++n) { const f32x4 wv = *(const LAS f32x4*)(wba + n * 1028 + c0); dots[n] += (h.x * wv.x + h.y * wv.y) + (h.z * wv.z + h.w * wv.w); }
        __builtin_amdgcn_sched_barrier(0);
      }
#pragma unroll
      for (int n = 0; n < 16; ++n) dots[n] = wave_sum(dots[n]);
      if (lane < 8) {
        float db = dots[0], da = dots[8];
#pragma unroll
        for (int n = 1; n < 8; ++n) { db = lane == n ? dots[n] : db; da = lane == n ? dots[8 + n] : da; }
        BA[(size_t)m * 16 + lane] = sigmf(db);
        BA[(size_t)m * 16 + 8 + lane] = -expf(p.in[I_ALOG][lane]) * softplusf(da + p.in[I_DTB][lane]);
      }
    }
  }
  GRID_BARRIER();

  {
    pg8::Gemm g{HB, WQKV, MTOT, 4096, D}; pg8::StaticOrder S; S.init(MTOT, 4096, G, bid);
    pg8::EpiQKV E{QKV, LDQ, HALO};
    pg8::gemm_phase<pg8::EpiQKV, pg8::StaticOrder, true, true>(lds, g, S, E, wave);
  }
  GRID_BARRIER();

  {
    PHASE_TID();
    constexpr int PI_RQ = 0, PI_RK = 16384, PI_DQ = 32768, PI_DK = 49152;
    constexpr int PM_QKR = 65536, PM_QKD = PM_QKR + 17408, PM_KKD = PM_QKD + 17408;
    constexpr int PV = PM_KKD + 17408;
    constexpr int PL_F = 0, PL_B = 17408, PT_F = 34816, PT_B = 52224;
    const int w = wave;
    const float* cw = p.in[I_CONVW];
    u32x4 qraw[2], kraw[2], rawa[2][2][3], rawb[4][3]; float ba4[4] = {0.f, 0.f, 0.f, 0.f};
#define P2_LOADS(ITEM, TID) do { const int gc_ = (ITEM) >> 2, h_ = (ITEM) & 3, row0_ = gc_ * 64; const bool lat_ = row0_ >= MCTX; \
      const int L_ = lat_ ? LLAT : LCTX, t0_ = lat_ ? ((row0_ - MCTX) & (LLAT - 1)) : (row0_ & (LCTX - 1)); \
      const size_t s1m_ = (size_t)row0_ + ((TID) >> 3); \
      _Pragma("unroll") for (int c = 0; c < 2; ++c) { const int ch = ((TID) & 7) * 2 + c; \
        qraw[c] = *(const u32x4*)(QKV + s1m_ * LDQ + Q_RQ + h_ * DK + ch * 8); kraw[c] = *(const u32x4*)(QKV + s1m_ * LDQ + Q_RK + h_ * DK + ch * 8); } \
      _Pragma("unroll") for (int ps = 0; ps < 2; ++ps) _Pragma("unroll") for (int wh = 0; wh < 2; ++wh) _Pragma("unroll") for (int wd = 0; wd < 3; ++wd) { \
          const int row = ((TID) >> 4) + 32 * ps, rr = row + wd - 1, t = t0_ + rr; const int dch = wh * 512 + h_ * DK + ((TID) & 15) * 8; \
          u32x4 x = (u32x4){0u, 0u, 0u, 0u}; \
          if (t >= 0 && t < L_) { \
            if (rr < 0) x = *(const u32x4*)(HALO + ((size_t)(gc_ - 1) * 2 + 1) * 2048 + dch); \
            else if (rr > 63) x = *(const u32x4*)(HALO + ((size_t)(gc_ + 1) * 2 + 0) * 2048 + dch); \
            else x = *(const u32x4*)(QKV + (size_t)(row0_ + rr) * LDQ + Q_DQ + dch); } \
          rawa[ps][wh][wd] = x; } \
      _Pragma("unroll") for (int n = 0; n < 4; ++n) _Pragma("unroll") for (int wd = 0; wd < 3; ++wd) { \
          const int idx = (TID) + 512 * n, row = idx >> 5, ch = idx & 31, rr = row + wd - 1, t = t0_ + rr; const int dch = 1024 + h_ * DV + ch * 8; \
          u32x4 x = (u32x4){0u, 0u, 0u, 0u}; \
          if (t >= 0 && t < L_) { \
            if (rr < 0) x = *(const u32x4*)(HALO + ((size_t)(gc_ - 1) * 2 + 1) * 2048 + dch); \
            else if (rr > 63) x = *(const u32x4*)(HALO + ((size_t)(gc_ + 1) * 2 + 0) * 2048 + dch); \
            else x = *(const u32x4*)(QKV + (size_t)(row0_ + rr) * LDQ + Q_DQ + dch); } \
          rawb[n][wd] = x; } \
      if ((TID) < 64) { const float* ba = BA + (size_t)(row0_ + (TID)) * 16; ba4[0] = ba[h_]; ba4[1] = ba[4 + h_]; ba4[2] = ba[8 + h_]; ba4[3] = ba[12 + h_]; } } while (0)
    if (bid < 768) { int lane_q = lane_id(); asm volatile("" : "+v"(lane_q)); const int tid_q = (wave << 6) | lane_q; P2_LOADS(bid, tid_q); }
    for (int item = bid; item < 768; item += G) {
      int lane_o = lane_id(); asm volatile("" : "+v"(lane_o));
      const int lane = lane_o, tid = (wave << 6) | lane, r32 = lane & 31, hl = lane >> 5;
      const int gc = item >> 2, h = item & 3, row0 = gc * 64; const bool lat = row0 >= MCTX;
      const int t0 = lat ? ((row0 - MCTX) & (LLAT - 1)) : (row0 & (LCTX - 1));
      const float lgf = DECLG[h], lgb = DECLG[4 + h];
      const int s1row = tid >> 3; const size_t s1m = (size_t)row0 + s1row;
      const int ach = tid & 15;
      asm volatile("s_waitcnt vmcnt(0)" ::: "memory");
      __syncthreads();
      const float ba_bf = ba4[0], ba_bb = ba4[1], ba_af = ba4[2], ba_ab = ba4[3];
      {
        const int row = s1row; const size_t m = s1m;
        const float kfs = __expf(lgf * (float)(63 - row)), kbs = __expf(lgb * (float)row);
#pragma unroll
        for (int c = 0; c < 2; ++c) { const int ch = (tid & 7) * 2 + c;
          bf16_t* qp = QKV + m * LDQ + Q_RQ + h * DK + ch * 8; bf16_t* kp = QKV + m * LDQ + Q_RK + h * DK + ch * 8;
          const u32x4 qw = qraw[c], kw = kraw[c];
          float q[8] = {lo_bf(qw.x), hi_bf(qw.x), lo_bf(qw.y), hi_bf(qw.y), lo_bf(qw.z), hi_bf(qw.z), lo_bf(qw.w), hi_bf(qw.w)};
          float k[8] = {lo_bf(kw.x), hi_bf(kw.x), lo_bf(kw.y), hi_bf(kw.y), lo_bf(kw.z), hi_bf(kw.z), lo_bf(kw.w), hi_bf(kw.w)};
#pragma unroll
          for (int e = 0; e < 8; ++e) q[e] *= QSCALE;
          if (lat) {
#pragma unroll
            for (int e = 0; e < 4; ++e) { const f32x2 cs = ROPE[(t0 + row) * 64 + ch * 4 + e];
              const float a = q[2 * e] * cs.x - q[2 * e + 1] * cs.y, b = q[2 * e] * cs.y + q[2 * e + 1] * cs.x; q[2 * e] = a; q[2 * e + 1] = b;
              const float c2 = k[2 * e] * cs.x - k[2 * e + 1] * cs.y, d2 = k[2 * e] * cs.y + k[2 * e + 1] * cs.x; k[2 * e] = c2; k[2 * e + 1] = d2; }
          }
          u32x4 o; o.x = pk2(q[0], q[1]); o.y = pk2(q[2], q[3]); o.z = pk2(q[4], q[5]); o.w = pk2(q[6], q[7]);
          *(u32x4*)qp = o; *(LAS u32x4*)(lds + PI_RQ + off_b(row, ch)) = o;
          o.x = pk2(k[0], k[1]); o.y = pk2(k[2], k[3]); o.z = pk2(k[4], k[5]); o.w = pk2(k[6], k[7]);
          *(LAS u32x4*)(lds + PI_RK + off_b(row, ch)) = o;
          o.x = pk2(k[0] * kfs, k[1] * kfs); o.y = pk2(k[2] * kfs, k[3] * kfs); o.z = pk2(k[4] * kfs, k[5] * kfs); o.w = pk2(k[6] * kfs, k[7] * kfs);
          *(u32x4*)kp = o;
          o.x = pk2(k[0] * kbs, k[1] * kbs); o.y = pk2(k[2] * kbs, k[3] * kbs); o.z = pk2(k[4] * kbs, k[5] * kbs); o.w = pk2(k[6] * kbs, k[7] * kbs);
          *(u32x4*)(KBUF + m * 512 + h * DK + ch * 8) = o;
        }
      }
      {
        const int ch = ach;
#pragma unroll
        for (int ps = 0; ps < 2; ++ps)
#pragma unroll
          for (int wh = 0; wh < 2; ++wh) { const int row = (tid >> 4) + 32 * ps; const int dch = wh * 512 + h * DK + ch * 8;
            float a[8] = {0.f, 0.f, 0.f, 0.f, 0.f, 0.f, 0.f, 0.f};
#pragma unroll
            for (int wd = 0; wd < 3; ++wd) { const u32x4 x = rawa[ps][wh][wd]; const f32x4 w0 = *(const f32x4*)(cw + wd * 2048 + dch), w1 = *(const f32x4*)(cw + wd * 2048 + dch + 4);
              a[0] += lo_bf(x.x) * w0.x; a[1] += hi_bf(x.x) * w0.y; a[2] += lo_bf(x.y) * w0.z; a[3] += hi_bf(x.y) * w0.w;
              a[4] += lo_bf(x.z) * w1.x; a[5] += hi_bf(x.z) * w1.y; a[6] += lo_bf(x.w) * w1.z; a[7] += hi_bf(x.w) * w1.w; }
            float ss = 0.f;
#pragma unroll
            for (int e = 0; e < 8; ++e) { a[e] = siluf(a[e]); ss += a[e] * a[e]; }
            ss += __shfl_xor(ss, 1); ss += __shfl_xor(ss, 2); ss += __shfl_xor(ss, 4); ss += __shfl_xor(ss, 8);
            const float sc = rsqrtf(ss + EPS) * (wh == 0 ? QSCALE : 1.f);
            u32x4 o; o.x = pk2(a[0] * sc, a[1] * sc); o.y = pk2(a[2] * sc, a[3] * sc); o.z = pk2(a[4] * sc, a[5] * sc); o.w = pk2(a[6] * sc, a[7] * sc);
            *(u32x4*)(QKV + (size_t)(row0 + row) * LDQ + Q_DQ + dch) = o;
            *(LAS u32x4*)(lds + (wh ? PI_DK : PI_DQ) + off_b(row, ch)) = o; }
      }
      {
#pragma unroll
        for (int n = 0; n < 4; ++n) { const int idx = tid + 512 * n, row = idx >> 5, ch = idx & 31; const int dch = 1024 + h * DV + ch * 8;
          float a[8] = {0.f, 0.f, 0.f, 0.f, 0.f, 0.f, 0.f, 0.f};
#pragma unroll
          for (int wd = 0; wd < 3; ++wd) { const u32x4 x = rawb[n][wd]; const f32x4 w0 = *(const f32x4*)(cw + wd * 2048 + dch), w1 = *(const f32x4*)(cw + wd * 2048 + dch + 4);
            a[0] += lo_bf(x.x) * w0.x; a[1] += hi_bf(x.x) * w0.y; a[2] += lo_bf(x.y) * w0.z; a[3] += hi_bf(x.y) * w0.w;
            a[4] += lo_bf(x.z) * w1.x; a[5] += hi_bf(x.z) * w1.y; a[6] += lo_bf(x.w) * w1.z; a[7] += hi_bf(x.w) * w1.w; }
          u32x4 o; o.x = pk2(siluf(a[0]), siluf(a[1])); o.y = pk2(siluf(a[2]), siluf(a[3])); o.z = pk2(siluf(a[4]), siluf(a[5])); o.w = pk2(siluf(a[6]), siluf(a[7]));
          *(u32x4*)(QKV + (size_t)(row0 + row) * LDQ + Q_DQ + dch) = o; }
      }
      if (item + G < 768) P2_LOADS(item + G, tid);
      __syncthreads();
      {
        const int mi = (w >> 1) & 1, nj = w & 1;
        if (w < 4) {
          f32x16 a1 = zero16(), a2 = zero16();
#pragma unroll 2
          for (int ks = 0; ks < 8; ++ks) { a1 = MFMA32(lds_rd128(lds + PI_RQ, rowfrag_off(lane, mi, ks)), lds_rd128(lds + PI_RK, rowfrag_off(lane, nj, ks)), a1);
            a2 = MFMA32(lds_rd128(lds + PI_DQ, rowfrag_off(lane, mi, ks)), lds_rd128(lds + PI_DK, rowfrag_off(lane, nj, ks)), a2); }
          LAS float* m1 = (LAS float*)(lds + PM_QKR); LAS float* m2 = (LAS float*)(lds + PM_QKD);
#pragma unroll
          for (int reg = 0; reg < 16; ++reg) { const int o = (32 * mi + crow(reg, hl)) * 68 + 32 * nj + r32; m1[o] = a1[reg]; m2[o] = a2[reg]; }
        } else {
          f32x16 a1 = zero16();
#pragma unroll 2
          for (int ks = 0; ks < 8; ++ks) a1 = MFMA32(lds_rd128(lds + PI_DK, rowfrag_off(lane, mi, ks)), lds_rd128(lds + PI_DK, rowfrag_off(lane, nj, ks)), a1);
          LAS float* m1 = (LAS float*)(lds + PM_KKD);
#pragma unroll
          for (int reg = 0; reg < 16; ++reg) m1[(32 * mi + crow(reg, hl)) * 68 + 32 * nj + r32] = a1[reg];
        }
      }
      LAS float* vecs = (LAS float*)(lds + PV);
      if (tid < 64) {
        const float bf = ba_bf, bb = ba_bb, af = ba_af, ab = ba_ab;
        float xf = af, xb = ab;
#pragma unroll
        for (int o = 1; o < 64; o <<= 1) { const float yf = __shfl_up(xf, o), yb = __shfl_up(xb, o); if (lane >= o) { xf += yf; xb += yb; } }
        const float totf = __shfl(xf, 63), totb = __shfl(xb, 63);
        vecs[tid] = bf; vecs[64 + tid] = bb; vecs[128 + tid] = xf; vecs[192 + tid] = totb - xb + ab;
        if (tid == 0) { vecs[256] = totf; vecs[257] = totb; }
      }
      __syncthreads();
      unsigned char* blob_rt = MATS_RT + (size_t)((gc * 4 + h) * 2) * RT_BLOB; unsigned char* blob_dn = MATS_DN + (size_t)((gc * 4 + h) * 2) * DN_BLOB;
      const int lp = tid & 63, fi = tid >> 6, fmt = fi >> 2, fks = fi & 3, frow = 32 * fmt + (lp & 31), fhq = lp >> 5;
      {
        const LAS float* m1 = (const LAS float*)(lds + PM_QKR); const LAS float* m2 = (const LAS float*)(lds + PM_QKD);
        const float gfi = vecs[128 + frow], gbi = vecs[192 + frow];
        f32x8 pf, pb, df, db;
#pragma unroll
        for (int jj = 0; jj < 8; ++jj) { const int j = 16 * fks + 8 * (jj >> 2) + 4 * fhq + (jj & 3);
          const float x = m1[frow * 68 + j], y = m2[frow * 68 + j];
          pf[jj] = j <= frow ? x * __expf(lgf * (float)(frow - j)) : 0.f; pb[jj] = j >= frow ? x * __expf(lgb * (float)(j - frow)) : 0.f;
          df[jj] = j <= frow ? y * __expf(gfi - vecs[128 + j]) : 0.f; db[jj] = j >= frow ? y * __expf(gbi - vecs[192 + j]) : 0.f; }
        *(bf16x8*)(blob_rt + (fi * 64 + lp) * 16) = cvt8(pf); *(bf16x8*)(blob_rt + RT_BLOB + (fi * 64 + lp) * 16) = cvt8(pb);
        *(bf16x8*)(blob_dn + 8192 + (fi * 64 + lp) * 16) = cvt8(df); *(bf16x8*)(blob_dn + DN_BLOB + 8192 + (fi * 64 + lp) * 16) = cvt8(db);
        const LAS float* m3 = (const LAS float*)(lds + PM_KKD);
        float* lf = (float*)(LSCR + (size_t)((gc * 4 + h) * 2) * LSCR_STRIDE); float* lb = (float*)(LSCR + (size_t)((gc * 4 + h) * 2 + 1) * LSCR_STRIDE);
#pragma unroll
        for (int n = 0; n < 8; ++n) { const int e = tid + 512 * n, i = e >> 6, j = e & 63; const float kk = m3[i * 68 + j];
          lf[e] = j < i ? vecs[i] * kk * __expf(vecs[128 + i] - vecs[128 + j]) : 0.f;
          lb[e] = j > i ? vecs[64 + i] * kk * __expf(vecs[192 + i] - vecs[192 + j]) : 0.f; }
        if (tid < 64) { lf[4096 + tid] = vecs[tid]; lb[4096 + tid] = vecs[64 + tid]; }
        if (tid < 64) { const float gf = vecs[128 + tid], gb = vecs[192 + tid], glf = vecs[256], glb = vecs[257];
          float* vf = (float*)(blob_dn + 16384); float* vb = (float*)(blob_dn + DN_BLOB + 16384);
          vf[tid] = __expf(gf); vf[64 + tid] = __expf(glf - gf); vb[tid] = __expf(gb); vb[64 + tid] = __expf(glb - gb);
          if (tid == 0) { vf[128] = __expf(glf); vb[128] = __expf(glb); } }
      }
    }
  }
  GRID_BARRIER();

  {
    PHASE_TID();
    LAS unsigned short* tl = (LAS unsigned short*)(lds + wave * 16384);
    for (int it = gw; it < 1536; it += ngw) {
      int lane_o = lane_id(); asm volatile("" : "+v"(lane_o));
      const int ln = lane_o; const bool flip = it & 1; const int cl = flip ? 63 - ln : ln;
      const float* Lm = (const float*)(LSCR + (size_t)it * LSCR_STRIDE);
      float T[64], Lr[64];
#pragma unroll
      for (int i = 0; i < 64; ++i) Lr[i] = Lm[(flip ? 63 - i : i) * 64 + cl];
      const float bc = Lm[4096 + cl];
      __builtin_amdgcn_sched_barrier(0);
#pragma unroll
      for (int i = 0; i < 64; ++i) {
        const float lrow = Lr[i];
        float t0 = (ln == i) ? 1.f : 0.f, t1 = 0.f;
#pragma unroll
        for (int j = 0; j < i; ++j) { const float lj = __int_as_float(__builtin_amdgcn_readlane(__float_as_int(lrow), j)); if (j & 1) t1 -= lj * T[j]; else t0 -= lj * T[j]; }
        T[i] = t0 + t1;
        __builtin_amdgcn_sched_barrier(0);
      }
#pragma unroll
      for (int i = 0; i < 64; ++i) tl[(flip ? 63 - i : i) * 72 + cl] = (unsigned short)f2bf(T[i] * bc);
      asm volatile("s_waitcnt lgkmcnt(0)" ::: "memory");
      unsigned char* blob = MATS_DN + (size_t)it * DN_BLOB;
      const int frow = ln & 31, fhq = ln >> 5;
#pragma unroll
      for (int f = 0; f < 8; ++f) { const int mt = f >> 2, ks = f & 3;
        const LAS unsigned short* rp = tl + (32 * mt + frow) * 72 + 16 * ks + 4 * fhq;
        const u32x2 lo = *(const LAS u32x2*)rp, hi = *(const LAS u32x2*)(rp + 8);
        *(u32x4*)(blob + (f * 64 + ln) * 16) = (u32x4){lo.x, lo.y, hi.x, hi.y}; }
      asm volatile("s_waitcnt lgkmcnt(0)" ::: "memory");
    }
  }
  GRID_BARRIER();

  {
    PHASE_TID();
    const int w = wave, cb = (w & 3) * 32; const bool act = w < 4;
    LAS float* qdec = (LAS float*)(lds + SC_VEC);
    const int stride = bid < 128 ? 1000000 : (G - 128);
    for (int item = bid; item < 640; item += stride) {
      const int ci = item >> 1, half = item & 1;
      int lane_c = lane_id(); asm volatile("" : "+v"(lane_c));
      const int lane = lane_c, tid = (wave << 6) | lane, r32 = lane & 31, hl = lane >> 5;
      int type, sq, h, dir, chunk0, nsteps; bool lat;
      if (ci < 64) { lat = true; type = ci >> 5; sq = (ci >> 3) & 3; h = (ci >> 1) & 3; dir = ci & 1; chunk0 = 64 + 32 * sq; nsteps = 32; }
      else { const int c = ci - 64; lat = false; type = c >> 7; sq = (c >> 3) & 15; h = (c >> 1) & 3; dir = c & 1; chunk0 = 4 * sq; nsteps = 4; }
      f32x16 S[4];
      {
        const float* s0 = (type ? p.in[I_SDN] : p.in[I_SRET]) + ((((size_t)sq * 2 + dir) * NH + h) * DK) * DV + 128 * half + cb + r32;
        if (lat) {
#pragma unroll
          for (int mt = 0; mt < 4; ++mt)
#pragma unroll
            for (int reg = 0; reg < 16; ++reg) S[mt][reg] = s0[(size_t)(32 * mt + srow(reg, hl)) * DV];
        } else {
#pragma unroll
          for (int mt = 0; mt < 4; ++mt) S[mt] = zero16();
        }
      }
      const float lg = DECLG[dir * 4 + h];
      const float c64 = __expf(64.f * lg);
      __syncthreads();
      if (tid < 64) qdec[tid] = __expf(lg * (dir ? (float)(64 - tid) : (float)(tid + 1)));
      scan_stage(lds, 0, type, dir, h, chunk0 + (dir ? nsteps - 1 : 0), QKV, KBUF, MATS_RT, MATS_DN, half, w, lane);
      bf16_t* O = type ? (dir ? ODB : ODF) : (dir ? ORB : ORF);
      for (int s = 0; s < nsteps; ++s) {
        int ln = lane; asm volatile("" : "+v"(ln));
        const int r32s = ln & 31, hls = ln >> 5;
        const int buf = s & 1, gc = chunk0 + (dir ? nsteps - 1 - s : s);
        asm volatile("s_waitcnt vmcnt(0)" ::: "memory");
        __syncthreads();
        if (s + 1 < nsteps) scan_stage(lds, buf ^ 1, type, dir, h, chunk0 + (dir ? nsteps - 2 - s : s + 1), QKV, KBUF, MATS_RT, MATS_DN, half, w, ln);
        if (!act) continue;
        LAS unsigned char* B = lds + buf * SC_BUF;
        bf16x8 Bv[4];
#pragma unroll
        for (int ks = 0; ks < 4; ++ks) Bv[ks] = lds_tr2(B + SC_V, vtr_off(ln, cb, ks, 0), vtr_off(ln, cb, ks, 1));
        bf16_t* ob = O + (size_t)gc * 64 * D + h * DV + 128 * half + cb + r32s;
        if (type) {
          const LAS float* eg = (const LAS float*)(B + SC_M + 16384); const LAS float* cgv = eg + 64; const float egl = eg[128];
          bf16x8 Br[4];
          {
            f32x16 ra[2]; ra[0] = zero16(); ra[1] = zero16();
#pragma unroll
            for (int ks = 0; ks < 8; ++ks) { const bf16x8 sb = pack8(S[ks >> 1], ks & 1);
              ra[0] = MFMA32(lds_rd128(B + SC_K, rowfrag_off(ln, 0, ks)), sb, ra[0]); ra[1] = MFMA32(lds_rd128(B + SC_K, rowfrag_off(ln, 1, ks)), sb, ra[1]); }
#pragma unroll
            for (int mt = 0; mt < 2; ++mt) { rowscale(ra[mt], eg + 32 * mt, hls, -1.f); Br[2 * mt] = pack8(ra[mt], 0); Br[2 * mt + 1] = pack8(ra[mt], 1); }
          }
          __builtin_amdgcn_sched_barrier(0);
          f32x16 vn[2]; vn[0] = zero16(); vn[1] = zero16();
#pragma unroll
          for (int ks = 0; ks < 4; ++ks)
#pragma unroll
            for (int mt = 0; mt < 2; ++mt) { const bf16x8 tf = lds_rd128(B + SC_M, (mt * 4 + ks) * 1024 + ln * 16);
              vn[mt] = MFMA32(tf, Bv[ks], vn[mt]); vn[mt] = MFMA32(tf, Br[ks], vn[mt]); }
          bf16x8 Bn[4];
#pragma unroll
          for (int mt = 0; mt < 2; ++mt) { Bn[2 * mt] = pack8(vn[mt], 0); Bn[2 * mt + 1] = pack8(vn[mt], 1); }
          __builtin_amdgcn_sched_barrier(0);
          {
            f32x16 oa[2]; oa[0] = zero16(); oa[1] = zero16();
#pragma unroll
            for (int ks = 0; ks < 8; ++ks) { const bf16x8 sb = pack8(S[ks >> 1], ks & 1);
              oa[0] = MFMA32(lds_rd128(B + SC_Q, rowfrag_off(ln, 0, ks)), sb, oa[0]); oa[1] = MFMA32(lds_rd128(B + SC_Q, rowfrag_off(ln, 1, ks)), sb, oa[1]); }
#pragma unroll
            for (int mt = 0; mt < 2; ++mt) rowscale(oa[mt], eg + 32 * mt, hls, 1.f);
#pragma unroll
            for (int ks = 0; ks < 4; ++ks)
#pragma unroll
              for (int mt = 0; mt < 2; ++mt) oa[mt] = MFMA32(lds_rd128(B + SC_M, 8192 + (mt * 4 + ks) * 1024 + ln * 16), Bn[ks], oa[mt]);
#pragma unroll
            for (int mt = 0; mt < 2; ++mt)
#pragma unroll
              for (int s2 = 0; s2 < 2; ++s2) { const bf16x8 pk = pack8(oa[mt], s2);
#pragma unroll
                for (int j = 0; j < 8; ++j) ob[(size_t)(32 * mt + crow(8 * s2 + j, hls)) * D] = (bf16_t)pk[j]; }
          }
          __builtin_amdgcn_sched_barrier(0);
#pragma unroll
          for (int mt = 0; mt < 2; ++mt) { rowscale(vn[mt], cgv + 32 * mt, hls, 1.f); Bn[2 * mt] = pack8(vn[mt], 0); Bn[2 * mt + 1] = pack8(vn[mt], 1); }
#pragma unroll
          for (int mt = 0; mt < 4; ++mt) S[mt] = S[mt] * egl;
#pragma unroll
          for (int ks = 0; ks < 4; ++ks)
#pragma unroll
            for (int mt = 0; mt < 4; ++mt) S[mt] = MFMA32(lds_tr2(B + SC_K, ktr_off(ln, mt, ks, 0), ktr_off(ln, mt, ks, 1)), Bn[ks], S[mt]);
          __builtin_amdgcn_sched_barrier(0);
        } else {
          {
            f32x16 oa[2]; oa[0] = zero16(); oa[1] = zero16();
#pragma unroll
            for (int ks = 0; ks < 8; ++ks) { const bf16x8 sb = pack8(S[ks >> 1], ks & 1);
              oa[0] = MFMA32(lds_rd128(B + SC_Q, rowfrag_off(ln, 0, ks)), sb, oa[0]); oa[1] = MFMA32(lds_rd128(B + SC_Q, rowfrag_off(ln, 1, ks)), sb, oa[1]); }
#pragma unroll
            for (int mt = 0; mt < 2; ++mt) rowscale(oa[mt], qdec + 32 * mt, hls, 1.f);
#pragma unroll
            for (int ks = 0; ks < 4; ++ks)
#pragma unroll
              for (int mt = 0; mt < 2; ++mt) oa[mt] = MFMA32(lds_rd128(B + SC_M, (mt * 4 + ks) * 1024 + ln * 16), Bv[ks], oa[mt]);
#pragma unroll
            for (int mt = 0; mt < 2; ++mt)
#pragma unroll
              for (int s2 = 0; s2 < 2; ++s2) { const bf16x8 pk = pack8(oa[mt], s2);
#pragma unroll
                for (int j = 0; j < 8; ++j) ob[(size_t)(32 * mt + crow(8 * s2 + j, hls)) * D] = (bf16_t)pk[j]; }
          }
          __builtin_amdgcn_sched_barrier(0);
#pragma unroll
          for (int mt = 0; mt < 4; ++mt) S[mt] = S[mt] * c64;
#pragma unroll
          for (int ks = 0; ks < 4; ++ks)
#pragma unroll
            for (int mt = 0; mt < 4; ++mt) S[mt] = MFMA32(lds_tr2(B + SC_K, ktr_off(ln, mt, ks, 0), ktr_off(ln, mt, ks, 1)), Bv[ks], S[mt]);
          __builtin_amdgcn_sched_barrier(0);
        }
      }
      if (!lat && act) {
        int ln3 = lane_id(); asm volatile("" : "+v"(ln3)); const int hl3 = ln3 >> 5;
        float* so = (type ? NS_DN : NS_RET) + ((((size_t)sq * 2 + dir) * NH + h) * DK) * DV + 128 * half + cb + (ln3 & 31);
#pragma unroll
        for (int mt = 0; mt < 4; ++mt)
#pragma unroll
          for (int reg = 0; reg < 16; ++reg) so[(size_t)(32 * mt + srow(reg, hl3)) * DV] = S[mt][reg];
      }
    }
  }
  GRID_BARRIER();

  bf16_t* GATES = QKV;
  {
    pg8::Gemm g{HB, WGATE, MTOT, 4096, D}; pg8::StaticOrder S; S.init(MTOT, 4096, G, bid);
    pg8::EpiBf16Act<1> E{GATES, LDG};
    pg8::gemm_phase<pg8::EpiBf16Act<1>, pg8::StaticOrder, true, true>(lds, g, S, E, wave);
  }
  GRID_BARRIER();

  bf16_t* AR = (bf16_t*)(ws + WS_AR); bf16_t* AD = (bf16_t*)(ws + WS_AD);
  {
    PHASE_TID();
    for (int m = gw; m < MTOT; m += ngw) {
      u32x2 rf[4], rb[4], df[4], db[4], gr[4], gd[4]; f32x4 gw4[4];
#pragma unroll
      for (int h = 0; h < 4; ++h) { const size_t base = (size_t)m * D + h * DV + 4 * lane;
        rf[h] = *(const u32x2*)(ORF + base); rb[h] = *(const u32x2*)(ORB + base); df[h] = *(const u32x2*)(ODF + base); db[h] = *(const u32x2*)(ODB + base);
        gr[h] = *(const u32x2*)(GATES + (size_t)m * LDG + G_RG + h * DV + 4 * lane); gd[h] = *(const u32x2*)(GATES + (size_t)m * LDG + G_DZ + h * DV + 4 * lane);
        gw4[h] = *(const f32x4*)(p.in[I_GNW] + h * DV + 4 * lane); }
      const f32x4 dw4 = *(const f32x4*)(p.in[I_DNW] + 4 * lane);
      float v[4][4], u[4][4], mu[4], rs[4], rd[4];
#pragma unroll
      for (int h = 0; h < 4; ++h) { v[h][0] = lo_bf(rf[h].x) + lo_bf(rb[h].x); v[h][1] = hi_bf(rf[h].x) + hi_bf(rb[h].x); v[h][2] = lo_bf(rf[h].y) + lo_bf(rb[h].y); v[h][3] = hi_bf(rf[h].y) + hi_bf(rb[h].y);
        u[h][0] = lo_bf(df[h].x) + lo_bf(db[h].x); u[h][1] = hi_bf(df[h].x) + hi_bf(db[h].x); u[h][2] = lo_bf(df[h].y) + lo_bf(db[h].y); u[h][3] = hi_bf(df[h].y) + hi_bf(db[h].y);
        mu[h] = (v[h][0] + v[h][1]) + (v[h][2] + v[h][3]); rd[h] = (u[h][0] * u[h][0] + u[h][1] * u[h][1]) + (u[h][2] * u[h][2] + u[h][3] * u[h][3]); }
#pragma unroll
      for (int o = 1; o < 64; o <<= 1) {
#pragma unroll
        for (int h = 0; h < 4; ++h) { mu[h] += __shfl_xor(mu[h], o); rd[h] += __shfl_xor(rd[h], o); } }
#pragma unroll
      for (int h = 0; h < 4; ++h) { mu[h] *= (1.f / DV); float q = 0.f;
#pragma unroll
        for (int e = 0; e < 4; ++e) { v[h][e] -= mu[h]; q += v[h][e] * v[h][e]; }
        rs[h] = q; }
#pragma unroll
      for (int o = 1; o < 64; o <<= 1) {
#pragma unroll
        for (int h = 0; h < 4; ++h) rs[h] += __shfl_xor(rs[h], o); }
#pragma unroll
      for (int h = 0; h < 4; ++h) { const size_t base = (size_t)m * D + h * DV + 4 * lane;
        const float r1 = rsqrtf(rs[h] * (1.f / DV) + EPS), r2 = rsqrtf(rd[h] * (1.f / DV) + EPS);
        u32x2 o; o.x = pk2(lo_bf(gr[h].x) * (v[h][0] * r1 * gw4[h].x), hi_bf(gr[h].x) * (v[h][1] * r1 * gw4[h].y)); o.y = pk2(lo_bf(gr[h].y) * (v[h][2] * r1 * gw4[h].z), hi_bf(gr[h].y) * (v[h][3] * r1 * gw4[h].w));
        *(u32x2*)(AR + base) = o;
        o.x = pk2(u[h][0] * r2 * dw4.x * lo_bf(gd[h].x), u[h][1] * r2 * dw4.y * hi_bf(gd[h].x)); o.y = pk2(u[h][2] * r2 * dw4.z * lo_bf(gd[h].y), u[h][3] * r2 * dw4.w * hi_bf(gd[h].y));
        *(u32x2*)(AD + base) = o; }
    }
  }
  GRID_BARRIER();

  bf16_t* T1 = HB;
  {
    pg8::Gemm g{AR, WRO, MTOT, D, D}; pg8::StaticOrder S; S.init(MTOT, D, G, bid);
    pg8::EpiGateMul E{T1, D, GATES + G_GR, LDG, nullptr};
    pg8::gemm_phase<pg8::EpiGateMul, pg8::StaticOrder, true, true>(lds, g, S, E, wave);
  }
  GRID_BARRIER();
  bf16_t* MERGED = (bf16_t*)(ws + WS_MERGED);
  {
    pg8::Gemm g{AD, WDO, MTOT, D, D}; pg8::StaticOrder S; S.init(MTOT, D, G, bid);
    pg8::EpiGateMul E{MERGED, D, GATES + G_GD, LDG, T1};
    pg8::gemm_phase<pg8::EpiGateMul, pg8::StaticOrder, true, true>(lds, g, S, E, wave);
  }
  GRID_BARRIER();
  float* M1 = (float*)(ws + WS_O);
  {
    pg8::Gemm g{MERGED, WOUT, MTOT, D, D}; pg8::StaticOrder S; S.init(MTOT, D, G, bid);
    pg8::EpiF32 E{M1, D};
    pg8::gemm_phase<pg8::EpiF32, pg8::StaticOrder, true, true>(lds, g, S, E, wave);
  }
  GRID_BARRIER();

  bf16_t* WF1 = (bf16_t*)(ws + WS_WF1); bf16_t* WF2 = (bf16_t*)(ws + WS_WF2);
  {
    PHASE_TID();
    LAS float* scr = (LAS float*)(lds + wave * 16384);
    transpose_matrix(p.in[I_WF1], 2 * DFF, D, 2 * DFF, WF1, [](int n) { const int pn = n >> 8, w = n & 255; return w < 128 ? 128 * pn + w : DFF + 128 * pn + (w - 128); }, scr, gw, ngw, lane);
    transpose_matrix(p.in[I_WF2], D, DFF, D, WF2, [](int n) { return n; }, scr, gw, ngw, lane);
    const float* nw1 = p.in[I_NORMW] + D; const float* nw2 = p.in[I_NORMW] + 2 * D;
    for (int m0 = gw; m0 < MTOT; m0 += 2 * ngw) {
      f32x4 v[2][4], xv[2][4], g1v[2][4]; float s[2] = {0.f, 0.f};
#pragma unroll
      for (int u = 0; u < 2; ++u) { const int m = (m0 + u * ngw < MTOT) ? m0 + u * ngw : m0; const float* xr = xrow(p, m); const float* md = MOD + (size_t)cond_of_row(m) * 6 * D; const float* mr = M1 + (size_t)m * D;
#pragma unroll
        for (int j = 0; j < 4; ++j) { const int c0 = 4 * lane + 256 * j; v[u][j] = *(const f32x4*)(mr + c0); xv[u][j] = *(const f32x4*)(xr + c0); g1v[u][j] = *(const f32x4*)(md + 2 * D + c0); } }
#pragma unroll
      for (int u = 0; u < 2; ++u)
#pragma unroll
        for (int j = 0; j < 4; ++j) s[u] += (v[u][j].x * v[u][j].x + v[u][j].y * v[u][j].y) + (v[u][j].z * v[u][j].z + v[u][j].w * v[u][j].w);
#pragma unroll
      for (int o = 1; o < 64; o <<= 1) { s[0] += __shfl_xor(s[0], o); s[1] += __shfl_xor(s[1], o); }
      float s2[2] = {0.f, 0.f};
#pragma unroll
      for (int u = 0; u < 2; ++u) { const int m = m0 + u * ngw; const float r = rsqrtf(s[u] * (1.f / D) + EPS);
#pragma unroll
        for (int j = 0; j < 4; ++j) { const int c0 = 4 * lane + 256 * j;
          v[u][j] = xv[u][j] + g1v[u][j] * (v[u][j] * r * *(const f32x4*)(nw1 + c0));
          if (m < MTOT) *(f32x4*)(p.out + (size_t)m * D + c0) = v[u][j];
          s2[u] += (v[u][j].x * v[u][j].x + v[u][j].y * v[u][j].y) + (v[u][j].z * v[u][j].z + v[u][j].w * v[u][j].w); } }
#pragma unroll
      for (int o = 1; o < 64; o <<= 1) { s2[0] += __shfl_xor(s2[0], o); s2[1] += __shfl_xor(s2[1], o); }
#pragma unroll
      for (int u = 0; u < 2; ++u) { const int m = m0 + u * ngw; if (m >= MTOT) continue; const float* md = MOD + (size_t)cond_of_row(m) * 6 * D; const float r2 = rsqrtf(s2[u] * (1.f / D) + EPS);
#pragma unroll
        for (int j = 0; j < 4; ++j) { const int c0 = 4 * lane + 256 * j;
          const f32x4 h = v[u][j] * r2 * *(const f32x4*)(nw2 + c0) * (*(const f32x4*)(md + 4 * D + c0) + 1.f) + *(const f32x4*)(md + 3 * D + c0);
          u32x2 o; o.x = pk2(h.x, h.y); o.y = pk2(h.z, h.w); *(u32x2*)(HB + (size_t)m * D + c0) = o; } }
    }
  }
  GRID_BARRIER();

  bf16_t* ACT = QKV;
  {
    pg8::Gemm g{HB, WF1, MTOT, 2 * DFF, D}; pg8::StaticOrder S; S.init(MTOT, 2 * DFF, G, bid);
    pg8::EpiSwiGLU E{ACT, DFF};
    pg8::gemm_phase<pg8::EpiSwiGLU, pg8::StaticOrder, true, true>(lds, g, S, E, wave);
  }
  GRID_BARRIER();
  float* F = (float*)(ws + WS_O);
  {
    pg8::Gemm g{ACT, WF2, MTOT, D, DFF}; pg8::StaticOrder S; S.init(MTOT, D, G, bid);
    pg8::EpiF32 E{F, D};
    pg8::gemm_phase<pg8::EpiF32, pg8::StaticOrder, true, true>(lds, g, S, E, wave);
  }
  GRID_BARRIER();
  {
    PHASE_TID();
    const float* nw3 = p.in[I_NORMW] + 3 * D;
    for (int m0 = gw; m0 < MTOT; m0 += 2 * ngw) {
      f32x4 v[2][4], xv[2][4], gv[2][4]; float s[2] = {0.f, 0.f};
#pragma unroll
      for (int u = 0; u < 2; ++u) { const int m = (m0 + u * ngw < MTOT) ? m0 + u * ngw : m0; const float* md = MOD + (size_t)cond_of_row(m) * 6 * D; const float* fr = F + (size_t)m * D; const float* orow = p.out + (size_t)m * D;
#pragma unroll
        for (int j = 0; j < 4; ++j) { const int c0 = 4 * lane + 256 * j; v[u][j] = *(const f32x4*)(fr + c0); xv[u][j] = *(const f32x4*)(orow + c0); gv[u][j] = *(const f32x4*)(md + 5 * D + c0); } }
#pragma unroll
      for (int u = 0; u < 2; ++u)
#pragma unroll
        for (int j = 0; j < 4; ++j) s[u] += (v[u][j].x * v[u][j].x + v[u][j].y * v[u][j].y) + (v[u][j].z * v[u][j].z + v[u][j].w * v[u][j].w);
#pragma unroll
      for (int o = 1; o < 64; o <<= 1) { s[0] += __shfl_xor(s[0], o); s[1] += __shfl_xor(s[1], o); }
#pragma unroll
      for (int u = 0; u < 2; ++u) { const int m = m0 + u * ngw; if (m >= MTOT) continue; const float r = rsqrtf(s[u] * (1.f / D) + EPS); float* orow = p.out + (size_t)m * D;
#pragma unroll
        for (int j = 0; j < 4; ++j) { const int c0 = 4 * lane + 256 * j; *(f32x4*)(orow + c0) = xv[u][j] + gv[u][j] * (v[u][j] * r * *(const f32x4*)(nw3 + c0)); } }
    }
  }
}

extern "C" void kernel_launch(void* const* d_in, const int* in_sizes, int n_in, void* d_out, int out_size, void* d_ws, size_t ws_size, hipStream_t stream) {
  static int grid_blocks = 0;
  if (!grid_blocks) {
    int dev = 0, cus = 0, per_cu = 0;
    (void)hipGetDevice(&dev);
    (void)hipDeviceGetAttribute(&cus, hipDeviceAttributeMultiprocessorCount, dev);
    (void)hipFuncSetAttribute((const void*)fwd_megakernel, hipFuncAttributeMaxDynamicSharedMemorySize, LDS_BYTES);
    (void)hipOccupancyMaxActiveBlocksPerMultiprocessor(&per_cu, (const void*)fwd_megakernel, NTHREADS, LDS_BYTES);
    if (per_cu < 1) per_cu = 1;
    grid_blocks = cus * per_cu;
    if (n_in != 21 || ws_size < WS_END) fprintf(stderr, "kernel_launch: unexpected n_in %d / ws_size %zu\n", n_in, ws_size);
    fprintf(stderr, "kernel_launch: cus %d per_cu %d grid %d ws %zu out %d\n", cus, per_cu, grid_blocks, ws_size, out_size);
  }
  (void)hipMemsetAsync((unsigned char*)d_ws + WS_BAR, 0, 16384, stream);
  Params p{};
  for (int i = 0; i < 21; ++i) p.in[i] = (const float*)d_in[i];
  p.out = (float*)d_out; p.ws = (unsigned char*)d_ws;
  void* args[] = {&p};
  hipError_t e = hipLaunchCooperativeKernel((const void*)fwd_megakernel, dim3(grid_blocks), dim3(NTHREADS), args, LDS_BYTES, stream);
  if (e != hipSuccess) fprintf(stderr, "cooperative launch failed: %s (grid %d)\n", hipGetErrorString(e), grid_blocks);
}
```

```cpp
#include <hip/hip_runtime.h>
#include <hip/hip_cooperative_groups.h>
#include <cstdio>
#include <cstdint>
namespace cg = cooperative_groups;

#define LAS __attribute__((address_space(3)))
typedef unsigned short bf16_t;
typedef short bf16x8 __attribute__((ext_vector_type(8)));
typedef float f32x4 __attribute__((ext_vector_type(4)));
typedef float f32x2 __attribute__((ext_vector_type(2)));
typedef unsigned u32x4 __attribute__((ext_vector_type(4)));
typedef unsigned u32x2 __attribute__((ext_vector_type(2)));

constexpr int D = 1024, MCTX = 4096, MLAT = 8192, MTOT = 12288, LCTX = 256, LLAT = 2048, NCTX = 16, NLAT = 4;
constexpr int NH = 4, DK = 128, DV = 256, DFF = 2816, INC = 8208;
constexpr float EPS = 1e-6f;
constexpr float QSCALE = 0.08838834764831845f;
constexpr int NTHREADS = 512, NWAVES = 8;
constexpr int LDS_BYTES = 135168;
constexpr int Q_RQ = 0, Q_RK = 512, Q_RV = 1024, Q_DQ = 2048, Q_DK = 2560, Q_DV = 3072, LDQ = 4096;
constexpr int G_RG = 0, G_DZ = 1024, G_GR = 2048, G_GD = 3072, LDG = 4096;
constexpr int C_RQ = 0, C_RG = 2048, C_DQ = 3072, C_DZ = 5120, C_DB = 6144, C_GR = 6160;

constexpr size_t MiB = 1u << 20;
constexpr size_t WS_MOD = 0;
constexpr size_t WS_ROPE = 128 * 1024;
constexpr size_t WS_BAR = 1152 * 1024;
constexpr size_t WS_BA = 1280 * 1024;
constexpr size_t WS_WQKV = 2 * MiB;
constexpr size_t WS_WGATE = 10 * MiB;
constexpr size_t WS_WRO = 18 * MiB, WS_WDO = 20 * MiB, WS_WOUT = 22 * MiB;
constexpr size_t WS_H = 24 * MiB;
constexpr size_t WS_QKV = 48 * MiB;
constexpr size_t WS_MATS_DN = 144 * MiB;
constexpr size_t WS_MATS_RT = 170 * MiB;
constexpr size_t WS_KB = 182 * MiB;
constexpr size_t WS_HALO = 194 * MiB;
constexpr size_t WS_O = 196 * MiB;
constexpr size_t WS_END = 244 * MiB;
constexpr size_t WS_AR = 144 * MiB, WS_AD = 168 * MiB, WS_MERGED = 144 * MiB;
constexpr size_t WS_WF1 = 144 * MiB, WS_WF2 = 155 * MiB;

struct Params {
  const float* in[21];
  float* out;
  unsigned char* ws;
};
enum { I_XP = 0, I_XS, I_C, I_SRET, I_SDN, I_CCTX, I_WMOD, I_BMOD, I_NORMW, I_WIN, I_CONVW, I_DECAY, I_GNW, I_ALOG, I_DTB, I_DNW, I_WRO, I_WDO, I_WOUT, I_WF1, I_WF2 };

__device__ __forceinline__ float bf2f(unsigned short b) { return __uint_as_float((unsigned)b << 16); }
__device__ __forceinline__ unsigned f2bf(float f) { unsigned u = __float_as_uint(f); return (u + 0x7fffu + ((u >> 16) & 1u)) >> 16; }
typedef __bf16 bfx2_t __attribute__((ext_vector_type(2)));
__device__ __forceinline__ unsigned pk2(float lo, float hi) { const f32x2 t = {lo, hi}; return __builtin_bit_cast(unsigned, __builtin_convertvector(t, bfx2_t)); }
__device__ __forceinline__ unsigned cvt_pk_bf16(float lo, float hi) { unsigned r; asm volatile("v_cvt_pk_bf16_f32 %0, %1, %2" : "=v"(r) : "v"(lo), "v"(hi)); return r; }
__device__ __forceinline__ float lo_bf(unsigned w) { return __uint_as_float(w << 16); }
__device__ __forceinline__ float hi_bf(unsigned w) { return __uint_as_float(w & 0xffff0000u); }
__device__ __forceinline__ float siluf(float x) { return x * __builtin_amdgcn_rcpf(1.f + __expf(-x)); }
__device__ __forceinline__ float sigmf(float x) { return __builtin_amdgcn_rcpf(1.f + __expf(-x)); }
__device__ __forceinline__ float softplusf(float x) { return x > 20.f ? x : log1pf(expf(x)); }
__device__ __forceinline__ float wave_sum(float v) {
#pragma unroll
  for (int o = 1; o < 64; o <<= 1) v += __shfl_xor(v, o);
  return v;
}
__device__ __forceinline__ int lane_id() { return (int)__builtin_amdgcn_mbcnt_hi(~0u, __builtin_amdgcn_mbcnt_lo(~0u, 0u)); }
__device__ __forceinline__ int cond_of_row(int m) { return m < MCTX ? 0 : 1 + (m - MCTX) / LLAT; }
__device__ __forceinline__ const float* xrow(const Params& p, int m) { return m < MCTX ? p.in[I_XP] + (size_t)m * D : p.in[I_XS] + (size_t)(m - MCTX) * D; }


__device__ __forceinline__ int lane_id();
#define XB_TMO      128
#define XB_XCNT(j)  (256  + 64 * (j))
#define XB_XSUB(j)  (1280 + 64 * (j))
#define XB_XGEN(j)  (2304 + 64 * (j))
#define XB_TOP      3328
#define XB_TOPGEN   3392
#define XCD_BAR_WORDS 3456
#define XB_SPIN_CAP (1u << 18)
__device__ __forceinline__ unsigned xb_ld(unsigned* p)              { return __hip_atomic_load(p, __ATOMIC_RELAXED, __HIP_MEMORY_SCOPE_AGENT); }
__device__ __forceinline__ unsigned xb_add(unsigned* p, unsigned v) { return __hip_atomic_fetch_add(p, v, __ATOMIC_RELAXED, __HIP_MEMORY_SCOPE_AGENT); }
__device__ __forceinline__ unsigned xb_xcc_id() { return (unsigned)__builtin_amdgcn_s_getreg((3 << 11) | 20) & 0xFu; }
#define XB_SPIN(cond, bar) do { unsigned _sp = 0; while (cond) { __builtin_amdgcn_s_sleep(1); \
    if ((++_sp & 255u) == 0u) { if (xb_ld(&(bar)[XB_TMO])) break; if (_sp > XB_SPIN_CAP) { atomicAdd(&(bar)[XB_TMO], 1u); break; } } } } while (0)
struct XcdBarrier { unsigned* bar; unsigned x; volatile LAS unsigned* st; };
__device__ __forceinline__ XcdBarrier xcd_barrier_post(unsigned* bar, volatile LAS unsigned* st) {
  XcdBarrier b; b.bar = bar; b.x = xb_xcc_id(); b.st = st;
  if (threadIdx.x == 0) (void)xb_add(&bar[XB_XCNT(b.x)], 1u);
  return b;
}
__device__ __forceinline__ void xcd_barrier_complete(unsigned* bar, unsigned x, unsigned& nloc, unsigned& nx) {
  const unsigned G = gridDim.x * gridDim.y * gridDim.z;
  unsigned sum, cnt, mine, sp = 0u;
  for (;;) {
    sum = 0u; cnt = 0u; mine = 0u;
#pragma unroll
    for (unsigned j = 0; j < 16; ++j) { const unsigned c = xb_ld(&bar[XB_XCNT(j)]); sum += c; cnt += (c > 0u) ? 1u : 0u; mine = (j == x) ? c : mine; }
    if (sum == G) break;
    __builtin_amdgcn_s_sleep(1);
    if ((++sp & 255u) == 0u) { if (xb_ld(&bar[XB_TMO])) break; if (sp > XB_SPIN_CAP) { atomicAdd(&bar[XB_TMO], 1u); break; } }
  }
  nloc = mine > 0u ? mine : 1u; nx = cnt > 0u ? cnt : 1u;
}
__device__ __forceinline__ void xcd_barrier(const XcdBarrier& b, const int wave) {
  asm volatile("s_waitcnt vmcnt(0)" ::: "memory");
  __syncthreads();
  if (wave == 0 && lane_id() == 0) {
    unsigned* bar = b.bar;
    __builtin_amdgcn_s_waitcnt(0);
    unsigned nloc = b.st[0], nx = b.st[1];
    if (nloc == 0u) { xcd_barrier_complete(bar, b.x, nloc, nx); b.st[0] = nloc; b.st[1] = nx; }
    const unsigned old = xb_add(&bar[XB_XSUB(b.x)], 1u);
    const unsigned gen = old / nloc;
    if (old + 1u == (gen + 1u) * nloc) {
      __builtin_amdgcn_fence(__ATOMIC_RELEASE, "agent");
      asm volatile("s_waitcnt vmcnt(0)" ::: "memory");
      const unsigned og = xb_add(&bar[XB_TOP], 1u);
      const unsigned tg = og / nx;
      if (og + 1u == (tg + 1u) * nx) xb_add(&bar[XB_TOPGEN], 1u);
      else XB_SPIN(xb_ld(&bar[XB_TOPGEN]) == tg, bar);
      __builtin_amdgcn_fence(__ATOMIC_ACQUIRE, "agent");
      xb_add(&bar[XB_XGEN(b.x)], 1u);
      asm volatile("s_waitcnt vmcnt(0)" ::: "memory");
    } else {
      XB_SPIN(xb_ld(&bar[XB_XGEN(b.x)]) == gen, bar);
      __builtin_amdgcn_fence(__ATOMIC_ACQUIRE, "agent");
      asm volatile("s_waitcnt vmcnt(0)" ::: "memory");
    }
  }
  __syncthreads();
}

namespace pg8 {
constexpr int BM = 256, BK = 64, HALF = 128, HTB = HALF * BK * 2, STAGE_BYTES = 8 * HTB, NXCD = 8, WGM = 8;
__host__ __device__ __forceinline__ int lds_byte(int r, int c) { const int st = (r >> 4) * 2 + (c >> 5), rr = r & 15, cc = c & 31, ob = rr * 64 + cc * 2; return st * 1024 + (ob ^ (((ob >> 9) & 1) << 5)); }
__host__ __device__ __forceinline__ void stage_rc(int b, int& R, int& C) { const int st = b / 1024, sb = b % 1024, swz = sb ^ (((sb >> 9) & 1) << 5); R = (st >> 1) * 16 + swz / 64; C = (st & 1) * 32 + (swz % 64) / 2; }
__host__ __device__ __forceinline__ int perm32(int rho) { const int n = rho >> 4, i = rho & 15; return 8 * (i >> 2) + 4 * n + (i & 3); }
struct Unit { int pm, pn; };
struct Gemm { const bf16_t* A; const bf16_t* Bt; int M, N, K; };
struct StaticOrder {
  int nM, nN, nwg, G, c;
  __host__ __device__ void init(int M, int N, int G_, int c_) { nM = M / BM; nN = N / BM; nwg = nM * nN; G = G_; c = c_; }
  __host__ __device__ bool next(int i, Unit& u) const {
    const long L = (long)i * G + c; if (L >= nwg) return false;
    int wgid = (int)L; { const int q = nwg / NXCD, r = nwg % NXCD, xcd = wgid % NXCD, off = wgid / NXCD; wgid = (xcd < r ? xcd * (q + 1) : r * (q + 1) + (xcd - r) * q) + off; }
    const int nig = WGM * nN, gid = wgid / nig, fm = gid * WGM, gsz = (nM - fm) < WGM ? (nM - fm) : WGM;
    u.pm = fm + ((wgid % nig) % gsz); u.pn = (wgid % nig) / gsz; return true;
  }
  __device__ __forceinline__ void a_ready(const Unit&) const {}
  __device__ __forceinline__ void done(const Unit&) const {}
};

template <int MODE  > struct EpiBf16Act {
  static constexpr bool PERM = true, AFTER_DRAIN = false;
  bf16_t* O; int ldc;
  __device__ __forceinline__ void operator()(const f32x4 (&acc)[2][2][4][2], const Unit& u, int wr, int wc, int fr, int fq) const {
    const int row0 = u.pm * BM + wr * 64 + fr, col0 = u.pn * BM + wc * 32 + 8 * fq;
    const bool sg = u.pn >= 8;
#pragma unroll
    for (int ai = 0; ai < 2; ++ai)
#pragma unroll
      for (int m = 0; m < 4; ++m) { bf16_t* rowp = O + (size_t)(row0 + ai * HALF + m * 16) * ldc + col0;
#pragma unroll
        for (int bj = 0; bj < 2; ++bj) { f32x4 v0 = acc[ai][bj][m][0], v1 = acc[ai][bj][m][1];
          if (MODE == 1) {
#pragma unroll
            for (int i = 0; i < 4; ++i) { const float s0 = __builtin_amdgcn_rcpf(1.f + __expf(-v0[i])), s1 = __builtin_amdgcn_rcpf(1.f + __expf(-v1[i]));
              v0[i] = sg ? s0 : v0[i] * s0; v1[i] = sg ? s1 : v1[i] * s1; } }
          u32x4 w; w.x = cvt_pk_bf16(v0[0], v0[1]); w.y = cvt_pk_bf16(v0[2], v0[3]); w.z = cvt_pk_bf16(v1[0], v1[1]); w.w = cvt_pk_bf16(v1[2], v1[3]);
          *(u32x4*)(rowp + bj * HALF) = w; } }
  }
};
struct EpiQKV {
  static constexpr bool PERM = true, AFTER_DRAIN = false;
  bf16_t* O; int ldc; bf16_t* HALO;
  __device__ __forceinline__ void operator()(const f32x4 (&acc)[2][2][4][2], const Unit& u, int wr, int wc, int fr, int fq) const {
    const int row0 = u.pm * BM + wr * 64 + fr, col0 = u.pn * BM + wc * 32 + 8 * fq;
#pragma unroll
    for (int ai = 0; ai < 2; ++ai)
#pragma unroll
      for (int m = 0; m < 4; ++m) { const int row = row0 + ai * HALF + m * 16; bf16_t* rowp = O + (size_t)row * ldc + col0;
#pragma unroll
        for (int bj = 0; bj < 2; ++bj) { const f32x4 v0 = acc[ai][bj][m][0], v1 = acc[ai][bj][m][1];
          u32x4 w; w.x = cvt_pk_bf16(v0[0], v0[1]); w.y = cvt_pk_bf16(v0[2], v0[3]); w.z = cvt_pk_bf16(v1[0], v1[1]); w.w = cvt_pk_bf16(v1[2], v1[3]);
          *(u32x4*)(rowp + bj * HALF) = w;
          if (u.pn >= 8 && ((m == 0 && fr == 0) || (m == 3 && fr == 15)))
            *(u32x4*)(HALO + ((size_t)(row >> 6) * 2 + (m == 3 ? 1 : 0)) * 2048 + (col0 - 2048) + bj * HALF) = w; } }
  }
};
struct EpiGateMul {
  static constexpr bool PERM = true, AFTER_DRAIN = false;
  bf16_t* O; int ldc; const bf16_t* G; int ldg; const bf16_t* Add;
  __device__ __forceinline__ void operator()(const f32x4 (&acc)[2][2][4][2], const Unit& u, int wr, int wc, int fr, int fq) const {
    const int row0 = u.pm * BM + wr * 64 + fr, col0 = u.pn * BM + wc * 32 + 8 * fq;
#pragma unroll
    for (int ai = 0; ai < 2; ++ai)
#pragma unroll
      for (int m = 0; m < 4; ++m) { const size_t r = (size_t)(row0 + ai * HALF + m * 16);
#pragma unroll
        for (int bj = 0; bj < 2; ++bj) { const f32x4 v0 = acc[ai][bj][m][0], v1 = acc[ai][bj][m][1];
          const u32x4 g = *(const u32x4*)(G + r * ldg + col0 + bj * HALF);
          float o[8] = {v0[0] * lo_bf(g.x), v0[1] * hi_bf(g.x), v0[2] * lo_bf(g.y), v0[3] * hi_bf(g.y), v1[0] * lo_bf(g.z), v1[1] * hi_bf(g.z), v1[2] * lo_bf(g.w), v1[3] * hi_bf(g.w)};
          if (Add) { const u32x4 a = *(const u32x4*)(Add + r * ldc + col0 + bj * HALF);
            o[0] += lo_bf(a.x); o[1] += hi_bf(a.x); o[2] += lo_bf(a.y); o[3] += hi_bf(a.y); o[4] += lo_bf(a.z); o[5] += hi_bf(a.z); o[6] += lo_bf(a.w); o[7] += hi_bf(a.w); }
          u32x4 w; w.x = cvt_pk_bf16(o[0], o[1]); w.y = cvt_pk_bf16(o[2], o[3]); w.z = cvt_pk_bf16(o[4], o[5]); w.w = cvt_pk_bf16(o[6], o[7]);
          *(u32x4*)(O + r * ldc + col0 + bj * HALF) = w; } }
  }
};
struct EpiF32 {
  static constexpr bool PERM = false, AFTER_DRAIN = false;
  float* O; int ldc;
  __device__ __forceinline__ void operator()(const f32x4 (&acc)[2][2][4][2], const Unit& u, int wr, int wc, int fr, int fq) const {
    const int row0 = u.pm * BM + wr * 64 + fr, col0 = u.pn * BM + wc * 32 + 4 * fq;
#pragma unroll
    for (int ai = 0; ai < 2; ++ai)
#pragma unroll
      for (int m = 0; m < 4; ++m) { float* rowp = O + (size_t)(row0 + ai * HALF + m * 16) * ldc + col0;
#pragma unroll
        for (int bj = 0; bj < 2; ++bj)
#pragma unroll
          for (int n = 0; n < 2; ++n) *(f32x4*)(rowp + bj * HALF + n * 16) = acc[ai][bj][m][n]; }
  }
};
struct EpiSwiGLU {
  static constexpr bool PERM = true, AFTER_DRAIN = false;
  bf16_t* O; int ldc;
  __device__ __forceinline__ void operator()(const f32x4 (&acc)[2][2][4][2], const Unit& u, int wr, int wc, int fr, int fq) const {
    const int row0 = u.pm * BM + wr * 64 + fr, col0 = u.pn * HALF + wc * 32 + 8 * fq;
#pragma unroll
    for (int ai = 0; ai < 2; ++ai)
#pragma unroll
      for (int m = 0; m < 4; ++m) { bf16_t* rowp = O + (size_t)(row0 + ai * HALF + m * 16) * ldc + col0;
        float o[8];
#pragma unroll
        for (int n = 0; n < 2; ++n)
#pragma unroll
          for (int i = 0; i < 4; ++i) { const float g = acc[ai][0][m][n][i], up = acc[ai][1][m][n][i]; o[4 * n + i] = g * __builtin_amdgcn_rcpf(1.f + __expf(-g)) * up; }
        u32x4 w; w.x = cvt_pk_bf16(o[0], o[1]); w.y = cvt_pk_bf16(o[2], o[3]); w.z = cvt_pk_bf16(o[4], o[5]); w.w = cvt_pk_bf16(o[6], o[7]);
        *(u32x4*)rowp = w; }
  }
};

template <class Epi, class Sched, bool ALIGN_EPI = false, bool SP2 = false>
__device__ __forceinline__ void gemm_phase(LAS unsigned char* lds, const Gemm g, const Sched& S, const Epi& E, const int wid) {
  int lane_o = lane_id(); asm volatile("" : "+v"(lane_o));
  const int lane = lane_o, tid = (wid << 6) | lane, wr = wid >> 2, wc = wid & 3, fr = lane & 15, fq = lane >> 4;
  const int K = g.K, nt = K / BK;
  unsigned voffA[2], voffB[2];
#pragma unroll
  for (int i = 0; i < 2; ++i) { int R, C; stage_rc(tid * 16 + i * 8192, R, C); const int Rb = Epi::PERM ? ((R & ~31) + perm32(R & 31)) : R;
    voffA[i] = (unsigned)(R * K + C) * 2u; voffB[i] = (unsigned)(Rb * K + C) * 2u; }
  const size_t kstep = (size_t)(BK * 2);
  const size_t hstep = (size_t)HALF * K * 2;
  const size_t tstep = 2 * hstep;
  const unsigned ldsw = (unsigned)wid * 1024u;
  const int aoff = lds_byte(wr * 64 + fr, fq * 8), boff = lds_byte(wc * 32 + fr, fq * 8);
#define PG8_SA(b, h) (((b) * 2 + (h)) * HTB)
#define PG8_SB(b, h) ((4 + (b) * 2 + (h)) * HTB)
#define PG8_STAGE(bufoff, gbase, voff) do { _Pragma("unroll") for (int _i = 0; _i < 2; ++_i) \
    __builtin_amdgcn_global_load_lds((const unsigned*)((const char*)(gbase) + (voff)[_i]), (LAS unsigned*)(lds + (bufoff) + ldsw + _i * 8192), 16, 0, 0); } while (0)
#define PG8_LDA(dst, b, h) do { _Pragma("unroll") for (int m = 0; m < 4; ++m) _Pragma("unroll") for (int k = 0; k < 2; ++k) dst[m][k] = *(const LAS bf16x8*)(lds + PG8_SA(b, h) + aoff + m * 2048 + k * 1024); } while (0)
#define PG8_LDB(dst, b, h) do { _Pragma("unroll") for (int n = 0; n < 2; ++n) _Pragma("unroll") for (int k = 0; k < 2; ++k) dst[n][k] = *(const LAS bf16x8*)(lds + PG8_SB(b, h) + boff + n * 2048 + k * 1024); } while (0)
#define PG8_MMA(ai, bj, At, Bt) do { __builtin_amdgcn_s_setprio(1); _Pragma("unroll") for (int m = 0; m < 4; ++m) _Pragma("unroll") for (int n = 0; n < 2; ++n) _Pragma("unroll") for (int k = 0; k < 2; ++k) \
    acc[ai][bj][m][n] = __builtin_amdgcn_mfma_f32_16x16x32_bf16(Bt[n][k], At[m][k], acc[ai][bj][m][n], 0, 0, 0); __builtin_amdgcn_s_setprio(0); } while (0)
#define PG8_WAIT_V(n) asm volatile("s_waitcnt vmcnt(" #n ")" ::: "memory")
#define PG8_WAIT_L(n) asm volatile("s_waitcnt lgkmcnt(" #n ")" ::: "memory")
#define PG8_BAR __builtin_amdgcn_s_barrier()
#define PG8_SCHED __builtin_amdgcn_sched_barrier(0)
  Unit cur, nxt; int ui = 0;
  if (!S.next(0, cur)) return;
  f32x4 acc[2][2][4][2];
#pragma unroll
  for (int a = 0; a < 2; ++a)
#pragma unroll
    for (int b = 0; b < 2; ++b)
#pragma unroll
      for (int m = 0; m < 4; ++m)
#pragma unroll
        for (int n = 0; n < 2; ++n) acc[a][b][m][n] = (f32x4){0.f, 0.f, 0.f, 0.f};
  bf16x8 At[4][2], B0[2][2], B1[2][2];
  const char* cA = (const char*)g.A + (size_t)cur.pm * tstep; const char* cB = (const char*)g.Bt + (size_t)cur.pn * tstep;
  S.a_ready(cur);
  if constexpr (SP2) {
    PG8_STAGE(PG8_SB(0, 0), cB, voffB); PG8_STAGE(PG8_SB(0, 1), cB + hstep, voffB); PG8_STAGE(PG8_SA(0, 0), cA, voffA); PG8_STAGE(PG8_SA(0, 1), cA + hstep, voffA);
    if (wr == 1) PG8_BAR;
    PG8_WAIT_V(2); PG8_BAR;
    PG8_STAGE(PG8_SB(1, 0), cB + kstep, voffB); PG8_STAGE(PG8_SA(1, 0), cA + kstep, voffA); PG8_STAGE(PG8_SB(1, 1), cB + hstep + kstep, voffB);
    PG8_WAIT_V(6); PG8_BAR;
  } else {
    PG8_STAGE(PG8_SB(0, 0), cB, voffB); PG8_STAGE(PG8_SA(0, 0), cA, voffA); PG8_STAGE(PG8_SB(0, 1), cB + hstep, voffB); PG8_STAGE(PG8_SA(0, 1), cA + hstep, voffA);
    if (wr == 1) PG8_BAR;
    PG8_WAIT_V(4); PG8_BAR;
    PG8_STAGE(PG8_SB(1, 0), cB + kstep, voffB); PG8_STAGE(PG8_SA(1, 0), cA + kstep, voffA); PG8_STAGE(PG8_SB(1, 1), cB + hstep + kstep, voffB);
    PG8_WAIT_V(6); PG8_BAR;
  }
  for (;;) {
    const bool has_next = S.next(ui + 1, nxt);
    const char* nA = has_next ? (const char*)g.A + (size_t)nxt.pm * tstep : cA; const char* nB = has_next ? (const char*)g.Bt + (size_t)nxt.pn * tstep : cB;
    for (int t = 0; t < nt; t += 2) {
      const bool last = (t == nt - 2);
      const char* a1 = cA + (size_t)(t + 1) * kstep;
      const char* a2 = last ? nA : cA + (size_t)(t + 2) * kstep; const char* b2 = last ? nB : cB + (size_t)(t + 2) * kstep;
      const char* a3 = a2 + kstep; const char* b3 = b2 + kstep;
      if (last && has_next) S.a_ready(nxt);
      if constexpr (SP2) {
        PG8_LDB(B0, 0, 0); PG8_LDB(B1, 0, 1); PG8_SCHED; PG8_LDA(At, 0, 0); PG8_STAGE(PG8_SA(1, 1), a1 + hstep, voffA);
        PG8_WAIT_V(8); PG8_WAIT_L(0); PG8_BAR; PG8_MMA(0, 0, At, B0); PG8_MMA(0, 1, At, B1); PG8_BAR; PG8_SCHED;
        PG8_LDA(At, 0, 1); PG8_STAGE(PG8_SB(0, 0), b2, voffB); PG8_STAGE(PG8_SB(0, 1), b2 + hstep, voffB); PG8_STAGE(PG8_SA(0, 0), a2, voffA);
        PG8_WAIT_V(8); PG8_WAIT_L(0); PG8_BAR; PG8_MMA(1, 0, At, B0); PG8_MMA(1, 1, At, B1); PG8_BAR; PG8_SCHED;
        PG8_LDB(B0, 1, 0); PG8_LDB(B1, 1, 1); PG8_SCHED; PG8_LDA(At, 1, 0); PG8_STAGE(PG8_SA(0, 1), a2 + hstep, voffA);
        PG8_WAIT_V(8); PG8_WAIT_L(0); PG8_BAR; PG8_MMA(0, 0, At, B0); PG8_MMA(0, 1, At, B1); PG8_BAR; PG8_SCHED;
        PG8_LDA(At, 1, 1); PG8_STAGE(PG8_SB(1, 0), b3, voffB); PG8_STAGE(PG8_SB(1, 1), b3 + hstep, voffB); PG8_STAGE(PG8_SA(1, 0), a3, voffA);
        PG8_WAIT_V(8); PG8_WAIT_L(0); PG8_BAR; PG8_MMA(1, 0, At, B0); PG8_MMA(1, 1, At, B1); PG8_BAR; PG8_SCHED;
      } else {
        PG8_LDB(B0, 0, 0); PG8_SCHED; PG8_LDA(At, 0, 0); PG8_STAGE(PG8_SA(1, 1), a1 + hstep, voffA);
        PG8_WAIT_L(8); PG8_BAR; PG8_WAIT_L(0); PG8_MMA(0, 0, At, B0); PG8_BAR; PG8_SCHED;
        PG8_LDB(B1, 0, 1); PG8_STAGE(PG8_SB(0, 0), b2, voffB);
        PG8_BAR; PG8_WAIT_L(0); PG8_MMA(0, 1, At, B1); PG8_BAR;
        PG8_LDA(At, 0, 1); PG8_STAGE(PG8_SA(0, 0), a2, voffA);
        PG8_BAR; PG8_WAIT_L(0); PG8_MMA(1, 0, At, B0); PG8_BAR; PG8_SCHED;
        PG8_STAGE(PG8_SB(0, 1), b2 + hstep, voffB);
        PG8_WAIT_V(6); PG8_BAR; PG8_MMA(1, 1, At, B1); PG8_BAR;
        PG8_LDB(B0, 1, 0); PG8_SCHED; PG8_LDA(At, 1, 0); PG8_STAGE(PG8_SA(0, 1), a2 + hstep, voffA);
        PG8_WAIT_L(8); PG8_BAR; PG8_WAIT_L(0); PG8_MMA(0, 0, At, B0); PG8_BAR; PG8_SCHED;
        PG8_LDB(B1, 1, 1); PG8_STAGE(PG8_SB(1, 0), b3, voffB);
        PG8_BAR; PG8_WAIT_L(0); PG8_MMA(0, 1, At, B1); PG8_BAR;
        PG8_LDA(At, 1, 1); PG8_STAGE(PG8_SA(1, 0), a3, voffA);
        PG8_BAR; PG8_WAIT_L(0); PG8_MMA(1, 0, At, B0); PG8_BAR; PG8_SCHED;
        PG8_STAGE(PG8_SB(1, 1), b3 + hstep, voffB);
        PG8_WAIT_V(6); PG8_BAR; PG8_MMA(1, 1, At, B1); PG8_BAR;
      }
    }
    if constexpr (ALIGN_EPI) { if (wr == 0) PG8_BAR; }
    if constexpr (!Epi::AFTER_DRAIN) { E(acc, cur, wr, wc, fr, fq); S.done(cur); }
    if (!has_next) break;
#pragma unroll
    for (int a = 0; a < 2; ++a)
#pragma unroll
      for (int b = 0; b < 2; ++b)
#pragma unroll
        for (int m = 0; m < 4; ++m)
#pragma unroll
          for (int n = 0; n < 2; ++n) acc[a][b][m][n] = (f32x4){0.f, 0.f, 0.f, 0.f};
    cur = nxt; cA = nA; cB = nB; ++ui;
    if constexpr (ALIGN_EPI) { if (wr == 1) PG8_BAR; }
  }
  PG8_WAIT_V(0);
  if constexpr (!ALIGN_EPI) { if (wr == 0) PG8_BAR; }
  PG8_BAR;
#undef PG8_SA
#undef PG8_SB
#undef PG8_STAGE
#undef PG8_LDA
#undef PG8_LDB
#undef PG8_MMA
#undef PG8_WAIT_V
#undef PG8_WAIT_L
#undef PG8_BAR
#undef PG8_SCHED
}
}

typedef float f32x16 __attribute__((ext_vector_type(16)));
typedef float f32x8 __attribute__((ext_vector_type(8)));
typedef short s16x4 __attribute__((ext_vector_type(4)));
typedef __bf16 bfx8 __attribute__((ext_vector_type(8)));
#define MFMA32(a, b, c) __builtin_amdgcn_mfma_f32_32x32x16_bf16((a), (b), (c), 0, 0, 0)
__device__ __forceinline__ bf16x8 cvt8(f32x8 t) { return __builtin_bit_cast(bf16x8, __builtin_convertvector(t, bfx8)); }
__device__ __forceinline__ bf16x8 pack8(const f32x16& x, int s) {
  const f32x8 t = {x[8 * s], x[8 * s + 1], x[8 * s + 2], x[8 * s + 3], x[8 * s + 4], x[8 * s + 5], x[8 * s + 6], x[8 * s + 7]};
  return cvt8(t);
}
__device__ __forceinline__ f32x16 zero16() { f32x16 z; for (int i = 0; i < 16; ++i) z[i] = 0.f; return z; }
__device__ __forceinline__ unsigned off_b(unsigned row, unsigned ch) { return 256u * row + 16u * (ch ^ (((row & 3u) << 2) | ((row >> 2) & 3u))); }
__device__ __forceinline__ int swap12(int p) { return ((p & 1) << 1) | (p >> 1); }
__device__ __forceinline__ bf16x8 lds_rd128(LAS unsigned char* lds, unsigned off) { return *(const LAS bf16x8*)(lds + off); }
__device__ __forceinline__ bf16x8 lds_tr2(LAS unsigned char* lds, unsigned off_lo, unsigned off_hi) {
  const s16x4 lo = __builtin_amdgcn_ds_read_tr16_b64_v4i16((LAS s16x4*)(lds + off_lo));
  const s16x4 hi = __builtin_amdgcn_ds_read_tr16_b64_v4i16((LAS s16x4*)(lds + off_hi));
  return __builtin_shufflevector(lo, hi, 0, 1, 2, 3, 4, 5, 6, 7);
}
__device__ __forceinline__ void glds16(const void* g, LAS unsigned char* l) {
  unsigned keep; const unsigned dst = __builtin_amdgcn_readfirstlane((unsigned)(size_t)l);
  asm volatile("s_mov_b32 %0, m0\n\ts_mov_b32 m0, %2\n\ts_nop 0\n\tglobal_load_lds_dwordx4 %1, off\n\ts_mov_b32 m0, %0" : "=&s"(keep) : "v"(g), "s"(dst) : "memory");
}
__device__ __forceinline__ unsigned rowfrag_off(int lane, int mt, int ks) { return off_b(32 * mt + (lane & 31), 2 * ks + (lane >> 5)); }
__device__ __forceinline__ unsigned vtr_off(int lane, int cb, int ks, int sec) {
  const int g = lane >> 4, i = lane & 15, hh = g >> 1, half16 = g & 1, qq = i >> 2, p = i & 3;
  const int row = 16 * ks + 4 * hh + 8 * sec + qq, col = cb + 16 * half16 + 4 * p;
  return off_b(row, col >> 3) + (col & 7) * 2;
}
__device__ __forceinline__ unsigned ktr_off(int lane, int mt, int ks, int sec) {
  const int g = lane >> 4, i = lane & 15, hh = g >> 1, half16 = g & 1, qq = i >> 2, p = i & 3;
  const int row = 16 * ks + 4 * hh + 8 * sec + qq, col = 32 * mt + 16 * half16 + 4 * swap12(p);
  return off_b(row, col >> 3) + (col & 7) * 2;
}
__device__ __forceinline__ int crow(int reg, int h) { return (reg & 3) + 8 * (reg >> 2) + 4 * h; }
__device__ __forceinline__ int srow(int reg, int h) { return 16 * (reg >> 3) + 8 * h + 4 * ((reg >> 2) & 1) + (reg & 3); }
__device__ __forceinline__ void rowscale(f32x16& a, const LAS float* vec, int h, float sgn) {
#pragma unroll
  for (int g4 = 0; g4 < 4; ++g4) { const f32x4 s = *(const LAS f32x4*)(vec + 8 * g4 + 4 * h);
    a[4 * g4] *= s.x * sgn; a[4 * g4 + 1] *= s.y * sgn; a[4 * g4 + 2] *= s.z * sgn; a[4 * g4 + 3] *= s.w * sgn; }
}
__device__ __forceinline__ void stage_img_piece(const unsigned char* src, size_t pitch, LAS unsigned char* img, int pc, int lane) {
  const unsigned row = 4 * pc + (lane >> 4), chp = lane & 15, ch = chp ^ (((row & 3u) << 2) | ((row >> 2) & 3u));
  glds16(src + (size_t)row * pitch + ch * 16, img + 1024 * pc);
}
constexpr int SC_BUF = 66560, SC_Q = 0, SC_K = 16384, SC_M = 32768, SC_V = 50176, SC_VEC = 2 * SC_BUF;
constexpr int DN_BLOB = 17408, RT_BLOB = 8192;
__device__ __forceinline__ void glds16_s(const unsigned char* base_uniform, unsigned voff, LAS unsigned char* l) {
  unsigned keep; const unsigned dst = __builtin_amdgcn_readfirstlane((unsigned)(size_t)l);
  const unsigned long long b = (unsigned long long)(size_t)base_uniform;
  const unsigned long long bs = ((unsigned long long)(unsigned)__builtin_amdgcn_readfirstlane((unsigned)(b >> 32)) << 32) | (unsigned)__builtin_amdgcn_readfirstlane((unsigned)b);
  asm volatile("s_mov_b32 %0, m0\n\ts_mov_b32 m0, %3\n\ts_nop 0\n\tglobal_load_lds_dwordx4 %1, %2\n\ts_mov_b32 m0, %0" : "=&s"(keep) : "v"(voff), "s"(bs), "s"(dst) : "memory");
}
struct StageOff { unsigned q[2], k[2], m; };
__device__ __forceinline__ StageOff scan_stage_offsets(int w, int lane, unsigned kpitch) {
  StageOff o;
#pragma unroll
  for (int i = 0; i < 2; ++i) { const unsigned pc = w + 8 * i, row = 4 * pc + (lane >> 4), chp = lane & 15, ch = chp ^ (((row & 3u) << 2) | ((row >> 2) & 3u));
    o.q[i] = row * (unsigned)(LDQ * 2) + ch * 16; o.k[i] = row * kpitch + ch * 16; }
  o.m = lane * 16;
  return o;
}
__device__ __forceinline__ void scan_stage(LAS unsigned char* lds, int buf, int type, int dir, int h, int gc, const bf16_t* QKV, const bf16_t* KBUF,
                                           const unsigned char* MATS_RT, const unsigned char* MATS_DN, int half, int w, const StageOff& so) {
  const size_t row0 = (size_t)gc * 64;
  const unsigned char* rowp = (const unsigned char*)(QKV + row0 * LDQ);
  const unsigned char* qsrc = rowp + (type ? Q_DQ + h * DK : Q_RQ + h * DK) * 2;
  const unsigned char* ksrc = rowp + (type ? Q_DK + h * DK : Q_RK + h * DK) * 2;
  if (!type && dir) ksrc = (const unsigned char*)(KBUF + row0 * 512 + h * DK);
  const unsigned char* vsrc = rowp + (type ? Q_DV + h * DV : Q_RV + h * DV) * 2 + half * 256;
  LAS unsigned char* B = lds + buf * SC_BUF;
#pragma unroll
  for (int i = 0; i < 2; ++i) { const int pc = w + 8 * i;
    glds16_s(qsrc, so.q[i], B + SC_Q + 1024 * pc); glds16_s(ksrc, so.k[i], B + SC_K + 1024 * pc); glds16_s(vsrc, so.q[i], B + SC_V + 1024 * pc); }
  const unsigned char* blob = type ? MATS_DN + (size_t)((gc * 4 + h) * 2 + dir) * DN_BLOB : MATS_RT + (size_t)((gc * 4 + h) * 2 + dir) * RT_BLOB;
  const int np = type ? 17 : 8;
  for (int pc = w; pc < np; pc += 8) glds16_s(blob + pc * 1024, so.m, B + SC_M + pc * 1024);
}

__device__ __forceinline__ void transpose_item(const float* W, int ldw, int K, int src_col0, bf16_t* WT, int dst_row0, int k0, LAS float* scr, int lane) {
#pragma unroll 8
  for (int i = 0; i < 32; ++i) { const int kk = 2 * i + (lane >> 5); scr[kk * 33 + (lane & 31)] = W[(size_t)(k0 + kk) * ldw + src_col0 + (lane & 31)]; }
  asm volatile("s_waitcnt lgkmcnt(0)" ::: "memory");
  const int c = lane & 7;
#pragma unroll
  for (int j = 0; j < 4; ++j) { const int n = (lane >> 3) + 8 * j; const LAS float* s = scr + (8 * c) * 33 + n;
    u32x4 o; o.x = pk2(s[0 * 33], s[1 * 33]); o.y = pk2(s[2 * 33], s[3 * 33]); o.z = pk2(s[4 * 33], s[5 * 33]); o.w = pk2(s[6 * 33], s[7 * 33]);
    *(u32x4*)(WT + (size_t)(dst_row0 + n) * K + k0 + 8 * c) = o; }
  asm volatile("s_waitcnt lgkmcnt(0)" ::: "memory");
}

template <class ColMap> __device__ __forceinline__ void transpose_matrix(const float* W, int ldw, int K, int N, bf16_t* WT, ColMap cm, LAS float* scr, int gw, int ngw, int lane) {
  const int nblk = N / 32, items = (K / 64) * nblk;
  for (int it = gw; it < items; it += ngw) { const int kb = it / nblk, nb = it % nblk; transpose_item(W, ldw, K, cm(32 * nb), WT, 32 * nb, 64 * kb, scr, lane); }
}

__global__ void __launch_bounds__(NTHREADS) fwd_megakernel(Params p) {
  extern __shared__ __attribute__((aligned(16))) unsigned char lds_raw[];
  LAS unsigned char* lds = (LAS unsigned char*)lds_raw;
  cg::grid_group grid = cg::this_grid();
  volatile LAS unsigned* bar_st = (volatile LAS unsigned*)(lds + LDS_BYTES - 64);
  if (threadIdx.x < 2) bar_st[threadIdx.x] = 0u;
  __syncthreads();
  const XcdBarrier xbar = xcd_barrier_post((unsigned*)(p.ws + WS_BAR), bar_st);
  if (p.ws == nullptr) grid.sync();
#define GRID_BARRIER() xcd_barrier(xbar, wave)
  const int wave = __builtin_amdgcn_readfirstlane(threadIdx.x >> 6);
#define PHASE_TID() int lane_p = lane_id(); asm volatile("" : "+v"(lane_p)); const int lane = lane_p, tid = (wave << 6) | lane; (void)tid;
  const int G = gridDim.x, bid = blockIdx.x;
  const int gw = bid * NWAVES + wave, ngw = G * NWAVES;
  unsigned char* ws = p.ws;
  float* MOD = (float*)(ws + WS_MOD);
  f32x2* ROPE = (f32x2*)(ws + WS_ROPE);
  float* BA = (float*)(ws + WS_BA);
  float* DECLG = (float*)(ws + WS_MOD + 122880);
  bf16_t* WQKV = (bf16_t*)(ws + WS_WQKV); bf16_t* WGATE = (bf16_t*)(ws + WS_WGATE);
  bf16_t* WRO = (bf16_t*)(ws + WS_WRO); bf16_t* WDO = (bf16_t*)(ws + WS_WDO); bf16_t* WOUT = (bf16_t*)(ws + WS_WOUT);
  bf16_t* HB = (bf16_t*)(ws + WS_H);
  bf16_t* QKV = (bf16_t*)(ws + WS_QKV);
  bf16_t* KBUF = (bf16_t*)(ws + WS_KB); bf16_t* HALO = (bf16_t*)(ws + WS_HALO);
  unsigned char* MATS_RT = ws + WS_MATS_RT; unsigned char* MATS_DN = ws + WS_MATS_DN;
  unsigned char* LSCR = ws + WS_O; constexpr int LSCR_STRIDE = 16896;
  bf16_t* ODF = (bf16_t*)(ws + WS_O); bf16_t* ODB = ODF + (size_t)MTOT * D;
  bf16_t* ORF = (bf16_t*)p.out; bf16_t* ORB = ORF + (size_t)MTOT * D;
  float* NS_RET = p.out + (size_t)MTOT * D; float* NS_DN = NS_RET + (size_t)NCTX * 2 * NH * DK * DV;

  {
    PHASE_TID();
    LAS float* scr = (LAS float*)(lds + wave * 16384);
    transpose_matrix(p.in[I_WIN], INC, D, 4096, WQKV, [](int n) { return n < 2048 ? n : n + 1024; }, scr, gw, ngw, lane);
    transpose_matrix(p.in[I_WIN], INC, D, 4096, WGATE, [](int n) { return n < 1024 ? C_RG + n : (n < 2048 ? C_DZ + (n - 1024) : C_GR + (n - 2048)); }, scr, gw, ngw, lane);
    transpose_matrix(p.in[I_WRO], D, D, D, WRO, [](int n) { return n; }, scr, gw, ngw, lane);
    transpose_matrix(p.in[I_WDO], D, D, D, WDO, [](int n) { return n; }, scr, gw, ngw, lane);
    transpose_matrix(p.in[I_WOUT], D, D, D, WOUT, [](int n) { return n; }, scr, gw, ngw, lane);
    {
      __syncthreads();
      LAS float* scond = (LAS float*)lds;
      LAS float* red = scond + 5 * D;
      for (int i = tid; i < 5 * D; i += NTHREADS) { const int c = i >> 10, k = i & 1023; scond[i] = siluf(c == 0 ? p.in[I_CCTX][k] : p.in[I_C][(c - 1) * D + k]); }
      __syncthreads();
      for (int it = bid; it < 6 * D / 32; it += G) {
        const int col = it * 32 + (lane & 31), rpar = lane >> 5;
        float acc[5] = {0.f, 0.f, 0.f, 0.f, 0.f};
        const float* wm = p.in[I_WMOD] + (size_t)(128 * wave + rpar) * 6 * D + col;
#pragma unroll 16
        for (int i = 0; i < 64; ++i) { const float wv = wm[(size_t)(2 * i) * 6 * D]; const int k = 128 * wave + 2 * i + rpar;
#pragma unroll
          for (int c = 0; c < 5; ++c) acc[c] += scond[c * D + k] * wv; }
#pragma unroll
        for (int c = 0; c < 5; ++c) { acc[c] += __shfl_xor(acc[c], 32); if (lane < 32) red[(wave * 5 + c) * 32 + lane] = acc[c]; }
        __syncthreads();
        if (tid < 160) { const int c = tid >> 5, n = tid & 31; float s = 0.f;
#pragma unroll
          for (int ww = 0; ww < 8; ++ww) s += red[(ww * 5 + c) * 32 + n];
          MOD[c * 6 * D + it * 32 + n] = s + p.in[I_BMOD][it * 32 + n]; }
        __syncthreads();
      }
    }
    for (int i = bid * NTHREADS + tid; i < LLAT * 64; i += G * NTHREADS) { const int l = i >> 6, pr = i & 63;
      const float freq = powf(10000.f, -(float)(pr & 31) / 32.f); const float ang = (pr < 32 ? (float)(l >> 6) : (float)(l & 63)) * freq;
      ROPE[i] = (f32x2){cosf(ang), sinf(ang)}; }
    if (bid == 0 && tid < 8) DECLG[tid] = -softplusf(-p.in[I_DECAY][tid]);
  }
  GRID_BARRIER();

  {
    PHASE_TID();
    LAS float* wba = (LAS float*)lds;
    for (int i = tid; i < D * 16; i += NTHREADS) wba[(i & 15) * 1028 + (i >> 4)] = p.in[I_WIN][(size_t)(i >> 4) * INC + C_DB + (i & 15)];
    __syncthreads();
    const float* nw = p.in[I_NORMW];
    for (int m = gw; m < MTOT; m += ngw) {
      const float* xr = xrow(p, m); const float* md = MOD + (size_t)cond_of_row(m) * 6 * D;
      f32x4 x4[4], w4[4], sc4[4], sh4[4]; float s = 0.f;
#pragma unroll
      for (int j = 0; j < 4; ++j) { const int c0 = 4 * lane + 256 * j; x4[j] = *(const f32x4*)(xr + c0); w4[j] = *(const f32x4*)(nw + c0); sc4[j] = *(const f32x4*)(md + D + c0); sh4[j] = *(const f32x4*)(md + c0); }
#pragma unroll
      for (int j = 0; j < 4; ++j) s += (x4[j].x * x4[j].x + x4[j].y * x4[j].y) + (x4[j].z * x4[j].z + x4[j].w * x4[j].w);
      const float r = rsqrtf(wave_sum(s) * (1.f / D) + EPS);
      float dots[16];
#pragma unroll
      for (int n = 0; n < 16; ++n) dots[n] = 0.f;
#pragma unroll
      for (int j = 0; j < 4; ++j) { const int c0 = 4 * lane + 256 * j;
        const f32x4 h = x4[j] * r * w4[j] * (sc4[j] + 1.f) + sh4[j];
        u32x2 o; o.x = pk2(h.x, h.y); o.y = pk2(h.z, h.w);
        *(u32x2*)(HB + (size_t)m * D + c0) = o;
#pragma unroll
        for (int n = 0; n < 16; ++n) { const f32x4 wv = *(const LAS f32x4*)(wba + n * 1028 + c0); dots[n] += (h.x * wv.x + h.y * wv.y) + (h.z * wv.z + h.w * wv.w); }
        __builtin_amdgcn_sched_barrier(0);
      }
#pragma unroll
      for (int n = 0; n < 16; ++n) dots[n] = wave_sum(dots[n]);
      if (lane < 8) {
        float db = dots[0], da = dots[8];
#pragma unroll
        for (int n = 1; n < 8; ++n) { db = lane == n ? dots[n] : db; da = lane == n ? dots[8 + n] : da; }
        BA[(size_t)m * 16 + lane] = sigmf(db);
        BA[(size_t)m * 16 + 8 + lane] = -expf(p.in[I_ALOG][lane]) * softplusf(da + p.in[I_DTB][lane]);
      }
    }
  }
  GRID_BARRIER();

  {
    pg8::Gemm g{HB, WQKV, MTOT, 4096, D}; pg8::StaticOrder S; S.init(MTOT, 4096, G, bid);
    pg8::EpiQKV E{QKV, LDQ, HALO};
    pg8::gemm_phase<pg8::EpiQKV, pg8::StaticOrder, true, true>(lds, g, S, E, wave);
  }
  GRID_BARRIER();

  {
    PHASE_TID();
    constexpr int PI_RQ = 0, PI_RK = 16384, PI_DQ = 32768, PI_DK = 49152;
    constexpr int PM_QKR = 65536, PM_QKD = PM_QKR + 17408, PM_KKD = PM_QKD + 17408;
    constexpr int PV = PM_KKD + 17408;
    constexpr int PL_F = 0, PL_B = 17408, PT_F = 34816, PT_B = 52224;
    const int w = wave;
    const float* cw = p.in[I_CONVW];
    u32x4 qraw[2], kraw[2], rawa[2][2][3], rawb[4][3]; float ba4[4] = {0.f, 0.f, 0.f, 0.f};
#define P2_LOADS(ITEM, TID) do { const int gc_ = (ITEM) >> 2, h_ = (ITEM) & 3, row0_ = gc_ * 64; const bool lat_ = row0_ >= MCTX; \
      const int L_ = lat_ ? LLAT : LCTX, t0_ = lat_ ? ((row0_ - MCTX) & (LLAT - 1)) : (row0_ & (LCTX - 1)); \
      const size_t s1m_ = (size_t)row0_ + ((TID) >> 3); \
      _Pragma("unroll") for (int c = 0; c < 2; ++c) { const int ch = ((TID) & 7) * 2 + c; \
        qraw[c] = *(const u32x4*)(QKV + s1m_ * LDQ + Q_RQ + h_ * DK + ch * 8); kraw[c] = *(const u32x4*)(QKV + s1m_ * LDQ + Q_RK + h_ * DK + ch * 8); } \
      _Pragma("unroll") for (int ps = 0; ps < 2; ++ps) _Pragma("unroll") for (int wh = 0; wh < 2; ++wh) _Pragma("unroll") for (int wd = 0; wd < 3; ++wd) { \
          const int row = ((TID) >> 4) + 32 * ps, rr = row + wd - 1, t = t0_ + rr; const int dch = wh * 512 + h_ * DK + ((TID) & 15) * 8; \
          u32x4 x = (u32x4){0u, 0u, 0u, 0u}; \
          if (t >= 0 && t < L_) { \
            if (rr < 0) x = *(const u32x4*)(HALO + ((size_t)(gc_ - 1) * 2 + 1) * 2048 + dch); \
            else if (rr > 63) x = *(const u32x4*)(HALO + ((size_t)(gc_ + 1) * 2 + 0) * 2048 + dch); \
            else x = *(const u32x4*)(QKV + (size_t)(row0_ + rr) * LDQ + Q_DQ + dch); } \
          rawa[ps][wh][wd] = x; } \
      _Pragma("unroll") for (int n = 0; n < 4; ++n) _Pragma("unroll") for (int wd = 0; wd < 3; ++wd) { \
          const int idx = (TID) + 512 * n, row = idx >> 5, ch = idx & 31, rr = row + wd - 1, t = t0_ + rr; const int dch = 1024 + h_ * DV + ch * 8; \
          u32x4 x = (u32x4){0u, 0u, 0u, 0u}; \
          if (t >= 0 && t < L_) { \
            if (rr < 0) x = *(const u32x4*)(HALO + ((size_t)(gc_ - 1) * 2 + 1) * 2048 + dch); \
            else if (rr > 63) x = *(const u32x4*)(HALO + ((size_t)(gc_ + 1) * 2 + 0) * 2048 + dch); \
            else x = *(const u32x4*)(QKV + (size_t)(row0_ + rr) * LDQ + Q_DQ + dch); } \
          rawb[n][wd] = x; } \
      if ((TID) < 64) { const float* ba = BA + (size_t)(row0_ + (TID)) * 16; ba4[0] = ba[h_]; ba4[1] = ba[4 + h_]; ba4[2] = ba[8 + h_]; ba4[3] = ba[12 + h_]; } } while (0)
    if (bid < 768) { int lane_q = lane_id(); asm volatile("" : "+v"(lane_q)); const int tid_q = (wave << 6) | lane_q; P2_LOADS(bid, tid_q); }
    for (int item = bid; item < 768; item += G) {
      int lane_o = lane_id(); asm volatile("" : "+v"(lane_o));
      const int lane = lane_o, tid = (wave << 6) | lane, r32 = lane & 31, hl = lane >> 5;
      const int gc = item >> 2, h = item & 3, row0 = gc * 64; const bool lat = row0 >= MCTX;
      const int t0 = lat ? ((row0 - MCTX) & (LLAT - 1)) : (row0 & (LCTX - 1));
      const float lgf = DECLG[h], lgb = DECLG[4 + h];
      const int s1row = tid >> 3; const size_t s1m = (size_t)row0 + s1row;
      const int ach = tid & 15;
      asm volatile("s_waitcnt vmcnt(0)" ::: "memory");
      __syncthreads();
      const float ba_bf = ba4[0], ba_bb = ba4[1], ba_af = ba4[2], ba_ab = ba4[3];
      {
        const int row = s1row; const size_t m = s1m;
        const float kfs = __expf(lgf * (float)(63 - row)), kbs = __expf(lgb * (float)row);
#pragma unroll
        for (int c = 0; c < 2; ++c) { const int ch = (tid & 7) * 2 + c;
          bf16_t* qp = QKV + m * LDQ + Q_RQ + h * DK + ch * 8; bf16_t* kp = QKV + m * LDQ + Q_RK + h * DK + ch * 8;
          const u32x4 qw = qraw[c], kw = kraw[c];
          float q[8] = {lo_bf(qw.x), hi_bf(qw.x), lo_bf(qw.y), hi_bf(qw.y), lo_bf(qw.z), hi_bf(qw.z), lo_bf(qw.w), hi_bf(qw.w)};
          float k[8] = {lo_bf(kw.x), hi_bf(kw.x), lo_bf(kw.y), hi_bf(kw.y), lo_bf(kw.z), hi_bf(kw.z), lo_bf(kw.w), hi_bf(kw.w)};
#pragma unroll
          for (int e = 0; e < 8; ++e) q[e] *= QSCALE;
          if (lat) {
#pragma unroll
            for (int e = 0; e < 4; ++e) { const f32x2 cs = ROPE[(t0 + row) * 64 + ch * 4 + e];
              const float a = q[2 * e] * cs.x - q[2 * e + 1] * cs.y, b = q[2 * e] * cs.y + q[2 * e + 1] * cs.x; q[2 * e] = a; q[2 * e + 1] = b;
              const float c2 = k[2 * e] * cs.x - k[2 * e + 1] * cs.y, d2 = k[2 * e] * cs.y + k[2 * e + 1] * cs.x; k[2 * e] = c2; k[2 * e + 1] = d2; }
          }
          u32x4 o; o.x = pk2(q[0], q[1]); o.y = pk2(q[2], q[3]); o.z = pk2(q[4], q[5]); o.w = pk2(q[6], q[7]);
          *(u32x4*)qp = o; *(LAS u32x4*)(lds + PI_RQ + off_b(row, ch)) = o;
          o.x = pk2(k[0], k[1]); o.y = pk2(k[2], k[3]); o.z = pk2(k[4], k[5]); o.w = pk2(k[6], k[7]);
          *(LAS u32x4*)(lds + PI_RK + off_b(row, ch)) = o;
          o.x = pk2(k[0] * kfs, k[1] * kfs); o.y = pk2(k[2] * kfs, k[3] * kfs); o.z = pk2(k[4] * kfs, k[5] * kfs); o.w = pk2(k[6] * kfs, k[7] * kfs);
          *(u32x4*)kp = o;
          o.x = pk2(k[0] * kbs, k[1] * kbs); o.y = pk2(k[2] * kbs, k[3] * kbs); o.z = pk2(k[4] * kbs, k[5] * kbs); o.w = pk2(k[6] * kbs, k[7] * kbs);
          *(u32x4*)(KBUF + m * 512 + h * DK + ch * 8) = o;
        }
      }
      {
        const int ch = ach;
#pragma unroll
        for (int ps = 0; ps < 2; ++ps)
#pragma unroll
          for (int wh = 0; wh < 2; ++wh) { const int row = (tid >> 4) + 32 * ps; const int dch = wh * 512 + h * DK + ch * 8;
            float a[8] = {0.f, 0.f, 0.f, 0.f, 0.f, 0.f, 0.f, 0.f};
#pragma unroll
            for (int wd = 0; wd < 3; ++wd) { const u32x4 x = rawa[ps][wh][wd]; const f32x4 w0 = *(const f32x4*)(cw + wd * 2048 + dch), w1 = *(const f32x4*)(cw + wd * 2048 + dch + 4);
              a[0] += lo_bf(x.x) * w0.x; a[1] += hi_bf(x.x) * w0.y; a[2] += lo_bf(x.y) * w0.z; a[3] += hi_bf(x.y) * w0.w;
              a[4] += lo_bf(x.z) * w1.x; a[5] += hi_bf(x.z) * w1.y; a[6] += lo_bf(x.w) * w1.z; a[7] += hi_bf(x.w) * w1.w; }
            float ss = 0.f;
#pragma unroll
            for (int e = 0; e < 8; ++e) { a[e] = siluf(a[e]); ss += a[e] * a[e]; }
            ss += __shfl_xor(ss, 1); ss += __shfl_xor(ss, 2); ss += __shfl_xor(ss, 4); ss += __shfl_xor(ss, 8);
            const float sc = rsqrtf(ss + EPS) * (wh == 0 ? QSCALE : 1.f);
            u32x4 o; o.x = pk2(a[0] * sc, a[1] * sc); o.y = pk2(a[2] * sc, a[3] * sc); o.z = pk2(a[4] * sc, a[5] * sc); o.w = pk2(a[6] * sc, a[7] * sc);
            *(u32x4*)(QKV + (size_t)(row0 + row) * LDQ + Q_DQ + dch) = o;
            *(LAS u32x4*)(lds + (wh ? PI_DK : PI_DQ) + off_b(row, ch)) = o; }
      }
      {
#pragma unroll
        for (int n = 0; n < 4; ++n) { const int idx = tid + 512 * n, row = idx >> 5, ch = idx & 31; const int dch = 1024 + h * DV + ch * 8;
          float a[8] = {0.f, 0.f, 0.f, 0.f, 0.f, 0.f, 0.f, 0.f};
#pragma unroll
          for (int wd = 0; wd < 3; ++wd) { const u32x4 x = rawb[n][wd]; const f32x4 w0 = *(const f32x4*)(cw + wd * 2048 + dch), w1 = *(const f32x4*)(cw + wd * 2048 + dch + 4);
            a[0] += lo_bf(x.x) * w0.x; a[1] += hi_bf(x.x) * w0.y; a[2] += lo_bf(x.y) * w0.z; a[3] += hi_bf(x.y) * w0.w;
            a[4] += lo_bf(x.z) * w1.x; a[5] += hi_bf(x.z) * w1.y; a[6] += lo_bf(x.w) * w1.z; a[7] += hi_bf(x.w) * w1.w; }
          u32x4 o; o.x = pk2(siluf(a[0]), siluf(a[1])); o.y = pk2(siluf(a[2]), siluf(a[3])); o.z = pk2(siluf(a[4]), siluf(a[5])); o.w = pk2(siluf(a[6]), siluf(a[7]));
          *(u32x4*)(QKV + (size_t)(row0 + row) * LDQ + Q_DQ + dch) = o; }
      }
      if (item + G < 768) P2_LOADS(item + G, tid);
      __syncthreads();
      {
        const int mi = (w >> 1) & 1, nj = w & 1;
        if (w < 4) {
          f32x16 a1 = zero16(), a2 = zero16();
#pragma unroll 2
          for (int ks = 0; ks < 8; ++ks) { a1 = MFMA32(lds_rd128(lds + PI_RQ, rowfrag_off(lane, mi, ks)), lds_rd128(lds + PI_RK, rowfrag_off(lane, nj, ks)), a1);
            a2 = MFMA32(lds_rd128(lds + PI_DQ, rowfrag_off(lane, mi, ks)), lds_rd128(lds + PI_DK, rowfrag_off(lane, nj, ks)), a2); }
          LAS float* m1 = (LAS float*)(lds + PM_QKR); LAS float* m2 = (LAS float*)(lds + PM_QKD);
#pragma unroll
          for (int reg = 0; reg < 16; ++reg) { const int o = (32 * mi + crow(reg, hl)) * 68 + 32 * nj + r32; m1[o] = a1[reg]; m2[o] = a2[reg]; }
        } else {
          f32x16 a1 = zero16();
#pragma unroll 2
          for (int ks = 0; ks < 8; ++ks) a1 = MFMA32(lds_rd128(lds + PI_DK, rowfrag_off(lane, mi, ks)), lds_rd128(lds + PI_DK, rowfrag_off(lane, nj, ks)), a1);
          LAS float* m1 = (LAS float*)(lds + PM_KKD);
#pragma unroll
          for (int reg = 0; reg < 16; ++reg) m1[(32 * mi + crow(reg, hl)) * 68 + 32 * nj + r32] = a1[reg];
        }
      }
      LAS float* vecs = (LAS float*)(lds + PV);
      if (tid < 64) {
        const float bf = ba_bf, bb = ba_bb, af = ba_af, ab = ba_ab;
        float xf = af, xb = ab;
#pragma unroll
        for (int o = 1; o < 64; o <<= 1) { const float yf = __shfl_up(xf, o), yb = __shfl_up(xb, o); if (lane >= o) { xf += yf; xb += yb; } }
        const float totf = __shfl(xf, 63), totb = __shfl(xb, 63);
        vecs[tid] = bf; vecs[64 + tid] = bb; vecs[128 + tid] = xf; vecs[192 + tid] = totb - xb + ab;
        if (tid == 0) { vecs[256] = totf; vecs[257] = totb; }
      }
      __syncthreads();
      unsigned char* blob_rt = MATS_RT + (size_t)((gc * 4 + h) * 2) * RT_BLOB; unsigned char* blob_dn = MATS_DN + (size_t)((gc * 4 + h) * 2) * DN_BLOB;
      const int lp = tid & 63, fi = tid >> 6, fmt = fi >> 2, fks = fi & 3, frow = 32 * fmt + (lp & 31), fhq = lp >> 5;
      {
        const LAS float* m1 = (const LAS float*)(lds + PM_QKR); const LAS float* m2 = (const LAS float*)(lds + PM_QKD);
        const float gfi = vecs[128 + frow], gbi = vecs[192 + frow];
        f32x8 pf, pb, df, db;
#pragma unroll
        for (int jj = 0; jj < 8; ++jj) { const int j = 16 * fks + 8 * (jj >> 2) + 4 * fhq + (jj & 3);
          const float x = m1[frow * 68 + j], y = m2[frow * 68 + j];
          pf[jj] = j <= frow ? x * __expf(lgf * (float)(frow - j)) : 0.f; pb[jj] = j >= frow ? x * __expf(lgb * (float)(j - frow)) : 0.f;
          df[jj] = j <= frow ? y * __expf(gfi - vecs[128 + j]) : 0.f; db[jj] = j >= frow ? y * __expf(gbi - vecs[192 + j]) : 0.f; }
        *(bf16x8*)(blob_rt + (fi * 64 + lp) * 16) = cvt8(pf); *(bf16x8*)(blob_rt + RT_BLOB + (fi * 64 + lp) * 16) = cvt8(pb);
        *(bf16x8*)(blob_dn + 8192 + (fi * 64 + lp) * 16) = cvt8(df); *(bf16x8*)(blob_dn + DN_BLOB + 8192 + (fi * 64 + lp) * 16) = cvt8(db);
        const LAS float* m3 = (const LAS float*)(lds + PM_KKD);
        float* lf = (float*)(LSCR + (size_t)((gc * 4 + h) * 2) * LSCR_STRIDE); float* lb = (float*)(LSCR + (size_t)((gc * 4 + h) * 2 + 1) * LSCR_STRIDE);
#pragma unroll
        for (int n = 0; n < 8; ++n) { const int e = tid + 512 * n, i = e >> 6, j = e & 63; const float kk = m3[i * 68 + j];
          lf[e] = j < i ? vecs[i] * kk * __expf(vecs[128 + i] - vecs[128 + j]) : 0.f;
          lb[e] = j > i ? vecs[64 + i] * kk * __expf(vecs[192 + i] - vecs[192 + j]) : 0.f; }
        if (tid < 64) { lf[4096 + tid] = vecs[tid]; lb[4096 + tid] = vecs[64 + tid]; }
        if (tid < 64) { const float gf = vecs[128 + tid], gb = vecs[192 + tid], glf = vecs[256], glb = vecs[257];
          float* vf = (float*)(blob_dn + 16384); float* vb = (float*)(blob_dn + DN_BLOB + 16384);
          vf[tid] = __expf(gf); vf[64 + tid] = __expf(glf - gf); vb[tid] = __expf(gb); vb[64 + tid] = __expf(glb - gb);
          if (tid == 0) { vf[128] = __expf(glf); vb[128] = __expf(glb); } }
      }
    }
  }
  GRID_BARRIER();

  {
    PHASE_TID();
    LAS unsigned short* tl = (LAS unsigned short*)(lds + wave * 16384);
    for (int it = gw; it < 1536; it += ngw) {
      int lane_o = lane_id(); asm volatile("" : "+v"(lane_o));
      const int ln = lane_o; const bool flip = it & 1; const int cl = flip ? 63 - ln : ln;
      const float* Lm = (const float*)(LSCR + (size_t)it * LSCR_STRIDE);
      float T[64], Lr[64];
#pragma unroll
      for (int i = 0; i < 64; ++i) Lr[i] = Lm[(flip ? 63 - i : i) * 64 + cl];
      const float bc = Lm[4096 + cl];
      __builtin_amdgcn_sched_barrier(0);
#pragma unroll
      for (int i = 0; i < 64; ++i) {
        const float lrow = Lr[i];
        float t0 = (ln == i) ? 1.f : 0.f, t1 = 0.f;
#pragma unroll
        for (int j = 0; j < i; ++j) { const float lj = __int_as_float(__builtin_amdgcn_readlane(__float_as_int(lrow), j)); if (j & 1) t1 -= lj * T[j]; else t0 -= lj * T[j]; }
        T[i] = t0 + t1;
        __builtin_amdgcn_sched_barrier(0);
      }
#pragma unroll
      for (int i = 0; i < 64; ++i) tl[(flip ? 63 - i : i) * 72 + cl] = (unsigned short)f2bf(T[i] * bc);
      asm volatile("s_waitcnt lgkmcnt(0)" ::: "memory");
      unsigned char* blob = MATS_DN + (size_t)it * DN_BLOB;
      const int frow = ln & 31, fhq = ln >> 5;
#pragma unroll
      for (int f = 0; f < 8; ++f) { const int mt = f >> 2, ks = f & 3;
        const LAS unsigned short* rp = tl + (32 * mt + frow) * 72 + 16 * ks + 4 * fhq;
        const u32x2 lo = *(const LAS u32x2*)rp, hi = *(const LAS u32x2*)(rp + 8);
        *(u32x4*)(blob + (f * 64 + ln) * 16) = (u32x4){lo.x, lo.y, hi.x, hi.y}; }
      asm volatile("s_waitcnt lgkmcnt(0)" ::: "memory");
    }
  }
  GRID_BARRIER();

  {
    PHASE_TID();
    const int w = wave, cb = (w & 3) * 32; const bool act = w < 4;
    LAS float* qdec = (LAS float*)(lds + SC_VEC);
    const int stride = bid < 128 ? 1000000 : (G - 128);
    for (int item = bid; item < 640; item += stride) {
      const int ci = item >> 1, half = item & 1;
      int lane_c = lane_id(); asm volatile("" : "+v"(lane_c));
      const int lane = lane_c, tid = (wave << 6) | lane, r32 = lane & 31, hl = lane >> 5;
      int type, sq, h, dir, chunk0, nsteps; bool lat;
      if (ci < 64) { lat = true; type = ci >> 5; sq = (ci >> 3) & 3; h = (ci >> 1) & 3; dir = ci & 1; chunk0 = 64 + 32 * sq; nsteps = 32; }
      else { const int c = ci - 64; lat = false; type = c >> 7; sq = (c >> 3) & 15; h = (c >> 1) & 3; dir = c & 1; chunk0 = 4 * sq; nsteps = 4; }
      f32x16 S[4];
      {
        const float* s0 = (type ? p.in[I_SDN] : p.in[I_SRET]) + ((((size_t)sq * 2 + dir) * NH + h) * DK) * DV + 128 * half + cb + r32;
        if (lat) {
#pragma unroll
          for (int mt = 0; mt < 4; ++mt)
#pragma unroll
            for (int reg = 0; reg < 16; ++reg) S[mt][reg] = s0[(size_t)(32 * mt + srow(reg, hl)) * DV];
        } else {
#pragma unroll
          for (int mt = 0; mt < 4; ++mt) S[mt] = zero16();
        }
      }
      const float lg = DECLG[dir * 4 + h];
      const float c64 = __expf(64.f * lg);
      __syncthreads();
      if (tid < 64) qdec[tid] = __expf(lg * (dir ? (float)(64 - tid) : (float)(tid + 1)));
      const StageOff soff = scan_stage_offsets(w, lane, (!type && dir) ? 1024u : (unsigned)(LDQ * 2));
      scan_stage(lds, 0, type, dir, h, chunk0 + (dir ? nsteps - 1 : 0), QKV, KBUF, MATS_RT, MATS_DN, half, w, soff);
      bf16_t* O = type ? (dir ? ODB : ODF) : (dir ? ORB : ORF);
      for (int s = 0; s < nsteps; ++s) {
        int ln = lane; asm volatile("" : "+v"(ln));
        const int r32s = ln & 31, hls = ln >> 5;
        const int buf = s & 1, gc = chunk0 + (dir ? nsteps - 1 - s : s);
        asm volatile("s_waitcnt vmcnt(0)" ::: "memory");
        __syncthreads();
        if (s + 1 < nsteps) scan_stage(lds, buf ^ 1, type, dir, h, chunk0 + (dir ? nsteps - 2 - s : s + 1), QKV, KBUF, MATS_RT, MATS_DN, half, w, soff);
        if (!act) continue;
        LAS unsigned char* B = lds + buf * SC_BUF;
        bf16_t* ob = O + (size_t)gc * 64 * D + h * DV + 128 * half + cb + r32s;
#define SB_ do { __builtin_amdgcn_sched_barrier(0); asm volatile("" : "+v"(ln)); } while (0)
#define STORE_O(acc) do { _Pragma("unroll") for (int mt_ = 0; mt_ < 2; ++mt_) _Pragma("unroll") for (int s2_ = 0; s2_ < 2; ++s2_) { const bf16x8 pk_ = pack8(acc[mt_], s2_); \
                          _Pragma("unroll") for (int j_ = 0; j_ < 8; ++j_) ob[(size_t)(32 * mt_ + crow(8 * s2_ + j_, ln >> 5)) * D] = (bf16_t)pk_[j_]; } } while (0)
#define LOAD_BV() do { _Pragma("unroll") for (int ks_ = 0; ks_ < 4; ++ks_) Bv[ks_] = lds_tr2(B + SC_V, vtr_off(ln, cb, ks_, 0), vtr_off(ln, cb, ks_, 1)); } while (0)
#define ROWS_AB(acc, IMG) do { bf16x8 f0_[2], f1_[2]; \
            f0_[0] = lds_rd128(B + (IMG), rowfrag_off(ln, 0, 0)); f0_[1] = lds_rd128(B + (IMG), rowfrag_off(ln, 1, 0)); \
            _Pragma("unroll") for (int ks_ = 0; ks_ < 8; ++ks_) { \
              if (ks_ + 1 < 8) { f1_[0] = lds_rd128(B + (IMG), rowfrag_off(ln, 0, ks_ + 1)); f1_[1] = lds_rd128(B + (IMG), rowfrag_off(ln, 1, ks_ + 1)); } \
              const bf16x8 sb_ = pack8(S[ks_ >> 1], ks_ & 1); \
              acc[0] = MFMA32(f0_[0], sb_, acc[0]); acc[1] = MFMA32(f0_[1], sb_, acc[1]); \
              f0_[0] = f1_[0]; f0_[1] = f1_[1]; } } while (0)
#define ROWS_T(acc, IMG) do { bf16x8 f0_[2], f1_[2];   \
            f0_[0] = lds_rd128(B + (IMG), rowfrag_off(ln, 0, 0)); f0_[1] = lds_rd128(B + (IMG), rowfrag_off(ln, 1, 0)); \
            _Pragma("unroll") for (int ks_ = 0; ks_ < 8; ++ks_) { \
              if (ks_ + 1 < 8) { f1_[0] = lds_rd128(B + (IMG), rowfrag_off(ln, 0, ks_ + 1)); f1_[1] = lds_rd128(B + (IMG), rowfrag_off(ln, 1, ks_ + 1)); } \
              const bf16x8 sb_ = pack8(S[ks_ >> 1], ks_ & 1); \
              acc[0] = MFMA32(sb_, f0_[0], acc[0]); acc[1] = MFMA32(sb_, f0_[1], acc[1]); \
              f0_[0] = f1_[0]; f0_[1] = f1_[1]; } } while (0)
#define STORE_OT(acc) do { _Pragma("unroll") for (int nt_ = 0; nt_ < 2; ++nt_) { bf16_t* orow_ = obt + (size_t)(32 * nt_) * D; \
            _Pragma("unroll") for (int g_ = 0; g_ < 4; ++g_) { u32x2 w_; w_.x = pk2(acc[nt_][4 * g_], acc[nt_][4 * g_ + 1]); w_.y = pk2(acc[nt_][4 * g_ + 2], acc[nt_][4 * g_ + 3]); \
              *(u32x2*)(orow_ + 8 * g_) = w_; } } } while (0)
#define S_UPDATE(X, SCL) do { bf16x8 g0_[4], g1_[4]; \
            _Pragma("unroll") for (int mt_ = 0; mt_ < 4; ++mt_) g0_[mt_] = lds_tr2(B + SC_K, ktr_off(ln, mt_, 0, 0), ktr_off(ln, mt_, 0, 1)); \
            _Pragma("unroll") for (int mt_ = 0; mt_ < 4; ++mt_) S[mt_] = S[mt_] * (SCL); \
            _Pragma("unroll") for (int ks_ = 0; ks_ < 4; ++ks_) { \
              if (ks_ + 1 < 4) { _Pragma("unroll") for (int mt_ = 0; mt_ < 4; ++mt_) g1_[mt_] = lds_tr2(B + SC_K, ktr_off(ln, mt_, ks_ + 1, 0), ktr_off(ln, mt_, ks_ + 1, 1)); } \
              _Pragma("unroll") for (int mt_ = 0; mt_ < 4; ++mt_) S[mt_] = MFMA32(g0_[mt_], X[ks_], S[mt_]); \
              _Pragma("unroll") for (int mt_ = 0; mt_ < 4; ++mt_) g0_[mt_] = g1_[mt_]; } } while (0)
        bf16x8 Bv[4];
        if (type) {
          const LAS float* eg = (const LAS float*)(B + SC_M + 16384); const LAS float* cgv = eg + 64; const float egl = eg[128];
          bf16x8 Br[4];
          { f32x16 ra[2]; ra[0] = zero16(); ra[1] = zero16();
            ROWS_AB(ra, SC_K);
#pragma unroll
            for (int mt = 0; mt < 2; ++mt) { rowscale(ra[mt], eg + 32 * mt, ln >> 5, -1.f); Br[2 * mt] = pack8(ra[mt], 0); Br[2 * mt + 1] = pack8(ra[mt], 1); } }
          SB_;
          LOAD_BV();
          bf16x8 tf[8];
#pragma unroll
          for (int i = 0; i < 8; ++i) tf[i] = lds_rd128(B + SC_M, i * 1024 + ln * 16);
          f32x16 vn[2]; vn[0] = zero16(); vn[1] = zero16();
#pragma unroll
          for (int ks = 0; ks < 4; ++ks)
#pragma unroll
            for (int mt = 0; mt < 2; ++mt) { vn[mt] = MFMA32(tf[mt * 4 + ks], Bv[ks], vn[mt]); vn[mt] = MFMA32(tf[mt * 4 + ks], Br[ks], vn[mt]); }
          SB_;
          bf16x8 Bn[4], Bc[4];
#pragma unroll
          for (int mt = 0; mt < 2; ++mt) { Bn[2 * mt] = pack8(vn[mt], 0); Bn[2 * mt + 1] = pack8(vn[mt], 1); rowscale(vn[mt], cgv + 32 * mt, ln >> 5, 1.f); Bc[2 * mt] = pack8(vn[mt], 0); Bc[2 * mt + 1] = pack8(vn[mt], 1); }
          SB_;
          f32x16 oa[2]; oa[0] = zero16(); oa[1] = zero16();
          ROWS_T(oa, SC_Q);
          SB_;
#pragma unroll
          for (int i = 0; i < 8; ++i) tf[i] = lds_rd128(B + SC_M, 8192 + i * 1024 + ln * 16);
#pragma unroll
          for (int nt = 0; nt < 2; ++nt) oa[nt] = oa[nt] * eg[32 * nt + (ln & 31)];
#pragma unroll
          for (int ks = 0; ks < 4; ++ks)
#pragma unroll
            for (int nt = 0; nt < 2; ++nt) oa[nt] = MFMA32(Bn[ks], tf[nt * 4 + ks], oa[nt]);
          SB_;
          { bf16_t* obt = O + ((size_t)gc * 64 + (ln & 31)) * D + h * DV + 128 * half + cb + 4 * (ln >> 5); STORE_OT(oa); }
          SB_;
          S_UPDATE(Bc, egl);
          SB_;
        } else {
          f32x16 oa[2]; oa[0] = zero16(); oa[1] = zero16();
          ROWS_T(oa, SC_Q);
          SB_;
          LOAD_BV();
          bf16x8 tf[8];
#pragma unroll
          for (int i = 0; i < 8; ++i) tf[i] = lds_rd128(B + SC_M, i * 1024 + ln * 16);
#pragma unroll
          for (int nt = 0; nt < 2; ++nt) oa[nt] = oa[nt] * qdec[32 * nt + (ln & 31)];
#pragma unroll
          for (int ks = 0; ks < 4; ++ks)
#pragma unroll
            for (int nt = 0; nt < 2; ++nt) oa[nt] = MFMA32(Bv[ks], tf[nt * 4 + ks], oa[nt]);
          SB_;
          { bf16_t* obt = O + ((size_t)gc * 64 + (ln & 31)) * D + h * DV + 128 * half + cb + 4 * (ln >> 5); STORE_OT(oa); }
          SB_;
          S_UPDATE(Bv, c64);
          SB_;
        }
#undef SB_
#undef STORE_O
#undef LOAD_BV
#undef ROWS_AB
#undef ROWS_T
#undef STORE_OT
#undef S_UPDATE
      }
      if (!lat && act) {
        int ln3 = lane_id(); asm volatile("" : "+v"(ln3)); const int hl3 = ln3 >> 5;
        float* so = (type ? NS_DN : NS_RET) + ((((size_t)sq * 2 + dir) * NH + h) * DK) * DV + 128 * half + cb + (ln3 & 31);
#pragma unroll
        for (int mt = 0; mt < 4; ++mt)
#pragma unroll
          for (int reg = 0; reg < 16; ++reg) so[(size_t)(32 * mt + srow(reg, hl3)) * DV] = S[mt][reg];
      }
    }
  }
  GRID_BARRIER();

  bf16_t* GATES = QKV;
  {
    pg8::Gemm g{HB, WGATE, MTOT, 4096, D}; pg8::StaticOrder S; S.init(MTOT, 4096, G, bid);
    pg8::EpiBf16Act<1> E{GATES, LDG};
    pg8::gemm_phase<pg8::EpiBf16Act<1>, pg8::StaticOrder, true, true>(lds, g, S, E, wave);
  }
  GRID_BARRIER();

  bf16_t* AR = (bf16_t*)(ws + WS_AR); bf16_t* AD = (bf16_t*)(ws + WS_AD);
  {
    PHASE_TID();
    for (int m = gw; m < MTOT; m += ngw) {
      u32x2 rf[4], rb[4], df[4], db[4], gr[4], gd[4]; f32x4 gw4[4];
#pragma unroll
      for (int h = 0; h < 4; ++h) { const size_t base = (size_t)m * D + h * DV + 4 * lane;
        rf[h] = *(const u32x2*)(ORF + base); rb[h] = *(const u32x2*)(ORB + base); df[h] = *(const u32x2*)(ODF + base); db[h] = *(const u32x2*)(ODB + base);
        gr[h] = *(const u32x2*)(GATES + (size_t)m * LDG + G_RG + h * DV + 4 * lane); gd[h] = *(const u32x2*)(GATES + (size_t)m * LDG + G_DZ + h * DV + 4 * lane);
        gw4[h] = *(const f32x4*)(p.in[I_GNW] + h * DV + 4 * lane); }
      const f32x4 dw4 = *(const f32x4*)(p.in[I_DNW] + 4 * lane);
      float v[4][4], u[4][4], mu[4], rs[4], rd[4];
#pragma unroll
      for (int h = 0; h < 4; ++h) { v[h][0] = lo_bf(rf[h].x) + lo_bf(rb[h].x); v[h][1] = hi_bf(rf[h].x) + hi_bf(rb[h].x); v[h][2] = lo_bf(rf[h].y) + lo_bf(rb[h].y); v[h][3] = hi_bf(rf[h].y) + hi_bf(rb[h].y);
        u[h][0] = lo_bf(df[h].x) + lo_bf(db[h].x); u[h][1] = hi_bf(df[h].x) + hi_bf(db[h].x); u[h][2] = lo_bf(df[h].y) + lo_bf(db[h].y); u[h][3] = hi_bf(df[h].y) + hi_bf(db[h].y);
        mu[h] = (v[h][0] + v[h][1]) + (v[h][2] + v[h][3]); rd[h] = (u[h][0] * u[h][0] + u[h][1] * u[h][1]) + (u[h][2] * u[h][2] + u[h][3] * u[h][3]); }
#pragma unroll
      for (int o = 1; o < 64; o <<= 1) {
#pragma unroll
        for (int h = 0; h < 4; ++h) { mu[h] += __shfl_xor(mu[h], o); rd[h] += __shfl_xor(rd[h], o); } }
#pragma unroll
      for (int h = 0; h < 4; ++h) { mu[h] *= (1.f / DV); float q = 0.f;
#pragma unroll
        for (int e = 0; e < 4; ++e) { v[h][e] -= mu[h]; q += v[h][e] * v[h][e]; }
        rs[h] = q; }
#pragma unroll
      for (int o = 1; o < 64; o <<= 1) {
#pragma unroll
        for (int h = 0; h < 4; ++h) rs[h] += __shfl_xor(rs[h], o); }
#pragma unroll
      for (int h = 0; h < 4; ++h) { const size_t base = (size_t)m * D + h * DV + 4 * lane;
        const float r1 = rsqrtf(rs[h] * (1.f / DV) + EPS), r2 = rsqrtf(rd[h] * (1.f / DV) + EPS);
        u32x2 o; o.x = pk2(lo_bf(gr[h].x) * (v[h][0] * r1 * gw4[h].x), hi_bf(gr[h].x) * (v[h][1] * r1 * gw4[h].y)); o.y = pk2(lo_bf(gr[h].y) * (v[h][2] * r1 * gw4[h].z), hi_bf(gr[h].y) * (v[h][3] * r1 * gw4[h].w));
        *(u32x2*)(AR + base) = o;
        o.x = pk2(u[h][0] * r2 * dw4.x * lo_bf(gd[h].x), u[h][1] * r2 * dw4.y * hi_bf(gd[h].x)); o.y = pk2(u[h][2] * r2 * dw4.z * lo_bf(gd[h].y), u[h][3] * r2 * dw4.w * hi_bf(gd[h].y));
        *(u32x2*)(AD + base) = o; }
    }
  }
  GRID_BARRIER();

  bf16_t* T1 = HB;
  {
    pg8::Gemm g{AR, WRO, MTOT, D, D}; pg8::StaticOrder S; S.init(MTOT, D, G, bid);
    pg8::EpiGateMul E{T1, D, GATES + G_GR, LDG, nullptr};
    pg8::gemm_phase<pg8::EpiGateMul, pg8::StaticOrder, true, true>(lds, g, S, E, wave);
  }
  GRID_BARRIER();
  bf16_t* MERGED = (bf16_t*)(ws + WS_MERGED);
  {
    pg8::Gemm g{AD, WDO, MTOT, D, D}; pg8::StaticOrder S; S.init(MTOT, D, G, bid);
    pg8::EpiGateMul E{MERGED, D, GATES + G_GD, LDG, T1};
    pg8::gemm_phase<pg8::EpiGateMul, pg8::StaticOrder, true, true>(lds, g, S, E, wave);
  }
  GRID_BARRIER();
  float* M1 = (float*)(ws + WS_O);
  {
    pg8::Gemm g{MERGED, WOUT, MTOT, D, D}; pg8::StaticOrder S; S.init(MTOT, D, G, bid);
    pg8::EpiF32 E{M1, D};
    pg8::gemm_phase<pg8::EpiF32, pg8::StaticOrder, true, true>(lds, g, S, E, wave);
  }
  GRID_BARRIER();

  bf16_t* WF1 = (bf16_t*)(ws + WS_WF1); bf16_t* WF2 = (bf16_t*)(ws + WS_WF2);
  {
    PHASE_TID();
    LAS float* scr = (LAS float*)(lds + wave * 16384);
    transpose_matrix(p.in[I_WF1], 2 * DFF, D, 2 * DFF, WF1, [](int n) { const int pn = n >> 8, w = n & 255; return w < 128 ? 128 * pn + w : DFF + 128 * pn + (w - 128); }, scr, gw, ngw, lane);
    transpose_matrix(p.in[I_WF2], D, DFF, D, WF2, [](int n) { return n; }, scr, gw, ngw, lane);
    const float* nw1 = p.in[I_NORMW] + D; const float* nw2 = p.in[I_NORMW] + 2 * D;
    for (int m0 = gw; m0 < MTOT; m0 += 2 * ngw) {
      f32x4 v[2][4], xv[2][4], g1v[2][4]; float s[2] = {0.f, 0.f};
#pragma unroll
      for (int u = 0; u < 2; ++u) { const int m = (m0 + u * ngw < MTOT) ? m0 + u * ngw : m0; const float* xr = xrow(p, m); const float* md = MOD + (size_t)cond_of_row(m) * 6 * D; const float* mr = M1 + (size_t)m * D;
#pragma unroll
        for (int j = 0; j < 4; ++j) { const int c0 = 4 * lane + 256 * j; v[u][j] = *(const f32x4*)(mr + c0); xv[u][j] = *(const f32x4*)(xr + c0); g1v[u][j] = *(const f32x4*)(md + 2 * D + c0); } }
#pragma unroll
      for (int u = 0; u < 2; ++u)
#pragma unroll
        for (int j = 0; j < 4; ++j) s[u] += (v[u][j].x * v[u][j].x + v[u][j].y * v[u][j].y) + (v[u][j].z * v[u][j].z + v[u][j].w * v[u][j].w);
#pragma unroll
      for (int o = 1; o < 64; o <<= 1) { s[0] += __shfl_xor(s[0], o); s[1] += __shfl_xor(s[1], o); }
      float s2[2] = {0.f, 0.f};
#pragma unroll
      for (int u = 0; u < 2; ++u) { const int m = m0 + u * ngw; const float r = rsqrtf(s[u] * (1.f / D) + EPS);
#pragma unroll
        for (int j = 0; j < 4; ++j) { const int c0 = 4 * lane + 256 * j;
          v[u][j] = xv[u][j] + g1v[u][j] * (v[u][j] * r * *(const f32x4*)(nw1 + c0));
          if (m < MTOT) *(f32x4*)(p.out + (size_t)m * D + c0) = v[u][j];
          s2[u] += (v[u][j].x * v[u][j].x + v[u][j].y * v[u][j].y) + (v[u][j].z * v[u][j].z + v[u][j].w * v[u][j].w); } }
#pragma unroll
      for (int o = 1; o < 64; o <<= 1) { s2[0] += __shfl_xor(s2[0], o); s2[1] += __shfl_xor(s2[1], o); }
#pragma unroll
      for (int u = 0; u < 2; ++u) { const int m = m0 + u * ngw; if (m >= MTOT) continue; const float* md = MOD + (size_t)cond_of_row(m) * 6 * D; const float r2 = rsqrtf(s2[u] * (1.f / D) + EPS);
#pragma unroll
        for (int j = 0; j < 4; ++j) { const int c0 = 4 * lane + 256 * j;
          const f32x4 h = v[u][j] * r2 * *(const f32x4*)(nw2 + c0) * (*(const f32x4*)(md + 4 * D + c0) + 1.f) + *(const f32x4*)(md + 3 * D + c0);
          u32x2 o; o.x = pk2(h.x, h.y); o.y = pk2(h.z, h.w); *(u32x2*)(HB + (size_t)m * D + c0) = o; } }
    }
  }
  GRID_BARRIER();

  bf16_t* ACT = QKV;
  {
    pg8::Gemm g{HB, WF1, MTOT, 2 * DFF, D}; pg8::StaticOrder S; S.init(MTOT, 2 * DFF, G, bid);
    pg8::EpiSwiGLU E{ACT, DFF};
    pg8::gemm_phase<pg8::EpiSwiGLU, pg8::StaticOrder, true, true>(lds, g, S, E, wave);
  }
  GRID_BARRIER();
  float* F = (float*)(ws + WS_O);
  {
    pg8::Gemm g{ACT, WF2, MTOT, D, DFF}; pg8::StaticOrder S; S.init(MTOT, D, G, bid);
    pg8::EpiF32 E{F, D};
    pg8::gemm_phase<pg8::EpiF32, pg8::StaticOrder, true, true>(lds, g, S, E, wave);
  }
  GRID_BARRIER();
  {
    PHASE_TID();
    const float* nw3 = p.in[I_NORMW] + 3 * D;
    for (int m0 = gw; m0 < MTOT; m0 += 2 * ngw) {
      f32x4 v[2][4], xv[2][4], gv[2][4]; float s[2] = {0.f, 0.f};
#pragma unroll
      for (int u = 0; u < 2; ++u) { const int m = (m0 + u * ngw < MTOT) ? m0 + u * ngw : m0; const float* md = MOD + (size_t)cond_of_row(m) * 6 * D; const float* fr = F + (size_t)m * D; const float* orow = p.out + (size_t)m * D;
#pragma unroll
        for (int j = 0; j < 4; ++j) { const int c0 = 4 * lane + 256 * j; v[u][j] = *(const f32x4*)(fr + c0); xv[u][j] = *(const f32x4*)(orow + c0); gv[u][j] = *(const f32x4*)(md + 5 * D + c0); } }
#pragma unroll
      for (int u = 0; u < 2; ++u)
#pragma unroll
        for (int j = 0; j < 4; ++j) s[u] += (v[u][j].x * v[u][j].x + v[u][j].y * v[u][j].y) + (v[u][j].z * v[u][j].z + v[u][j].w * v[u][j].w);
#pragma unroll
      for (int o = 1; o < 64; o <<= 1) { s[0] += __shfl_xor(s[0], o); s[1] += __shfl_xor(s[1], o); }
#pragma unroll
      for (int u = 0; u < 2; ++u) { const int m = m0 + u * ngw; if (m >= MTOT) continue; const float r = rsqrtf(s[u] * (1.f / D) + EPS); float* orow = p.out + (size_t)m * D;
#pragma unroll
        for (int j = 0; j < 4; ++j) { const int c0 = 4 * lane + 256 * j; *(f32x4*)(orow + c0) = xv[u][j] + gv[u][j] * (v[u][j] * r * *(const f32x4*)(nw3 + c0)); } }
    }
  }
}

extern "C" void kernel_launch(void* const* d_in, const int* in_sizes, int n_in, void* d_out, int out_size, void* d_ws, size_t ws_size, hipStream_t stream) {
  static int grid_blocks = 0;
  if (!grid_blocks) {
    int dev = 0, cus = 0, per_cu = 0;
    (void)hipGetDevice(&dev);
    (void)hipDeviceGetAttribute(&cus, hipDeviceAttributeMultiprocessorCount, dev);
    (void)hipFuncSetAttribute((const void*)fwd_megakernel, hipFuncAttributeMaxDynamicSharedMemorySize, LDS_BYTES);
    (void)hipOccupancyMaxActiveBlocksPerMultiprocessor(&per_cu, (const void*)fwd_megakernel, NTHREADS, LDS_BYTES);
    if (per_cu < 1) per_cu = 1;
    grid_blocks = cus * per_cu;
    if (n_in != 21 || ws_size < WS_END) fprintf(stderr, "kernel_launch: unexpected n_in %d / ws_size %zu\n", n_in, ws_size);
    fprintf(stderr, "kernel_launch: cus %d per_cu %d grid %d ws %zu out %d\n", cus, per_cu, grid_blocks, ws_size, out_size);
  }
  (void)hipMemsetAsync((unsigned char*)d_ws + WS_BAR, 0, 16384, stream);
  Params p{};
  for (int i = 0; i < 21; ++i) p.in[i] = (const float*)d_in[i];
  p.out = (float*)d_out; p.ws = (unsigned char*)d_ws;
  void* args[] = {&p};
  hipError_t e = hipLaunchCooperativeKernel((const void*)fwd_megakernel, dim3(grid_blocks), dim3(NTHREADS), args, LDS_BYTES, stream);
  if (e != hipSuccess) fprintf(stderr, "cooperative launch failed: %s (grid %d)\n", hipGetErrorString(e), grid_blocks);
}
```

```cpp
#include <hip/hip_runtime.h>
#include <hip/hip_cooperative_groups.h>
#include <cstdio>
#include <cstdint>
namespace cg = cooperative_groups;

#define LAS __attribute__((address_space(3)))
typedef unsigned short bf16_t;
typedef short bf16x8 __attribute__((ext_vector_type(8)));
typedef float f32x4 __attribute__((ext_vector_type(4)));
typedef float f32x2 __attribute__((ext_vector_type(2)));
typedef unsigned u32x4 __attribute__((ext_vector_type(4)));
typedef unsigned u32x2 __attribute__((ext_vector_type(2)));

constexpr int D = 1024, MCTX = 4096, MLAT = 8192, MTOT = 12288, LCTX = 256, LLAT = 2048, NCTX = 16, NLAT = 4;
constexpr int NH = 4, DK = 128, DV = 256, DFF = 2816, INC = 8208;
constexpr float EPS = 1e-6f;
constexpr float QSCALE = 0.08838834764831845f;
constexpr int NTHREADS = 512, NWAVES = 8;
constexpr int LDS_BYTES = 135168;
constexpr int Q_RQ = 0, Q_RK = 512, Q_RV = 1024, Q_DQ = 2048, Q_DK = 2560, Q_DV = 3072, LDQ = 4096;
constexpr int G_RG = 0, G_DZ = 1024, G_GR = 2048, G_GD = 3072, LDG = 4096;
constexpr int C_RQ = 0, C_RG = 2048, C_DQ = 3072, C_DZ = 5120, C_DB = 6144, C_GR = 6160;

constexpr size_t MiB = 1u << 20;
constexpr size_t WS_MOD = 0;
constexpr size_t WS_ROPE = 128 * 1024;
constexpr size_t WS_BAR = 1152 * 1024;
constexpr size_t WS_BA = 1280 * 1024;
constexpr size_t WS_WQKV = 2 * MiB;
constexpr size_t WS_WGATE = 10 * MiB;
constexpr size_t WS_WRO = 18 * MiB, WS_WDO = 20 * MiB, WS_WOUT = 22 * MiB;
constexpr size_t WS_H = 24 * MiB;
constexpr size_t WS_QKV = 48 * MiB;
constexpr size_t WS_MATS_DN = 144 * MiB;
constexpr size_t WS_MATS_RT = 170 * MiB;
constexpr size_t WS_KB = 182 * MiB;
constexpr size_t WS_HALO = 194 * MiB;
constexpr size_t WS_O = 196 * MiB;
constexpr size_t WS_END = 244 * MiB;
constexpr size_t WS_AR = 144 * MiB, WS_AD = 168 * MiB, WS_MERGED = 144 * MiB;
constexpr size_t WS_WF1 = 144 * MiB, WS_WF2 = 155 * MiB;

struct Params {
  const float* in[21];
  float* out;
  unsigned char* ws;
};
enum { I_XP = 0, I_XS, I_C, I_SRET, I_SDN, I_CCTX, I_WMOD, I_BMOD, I_NORMW, I_WIN, I_CONVW, I_DECAY, I_GNW, I_ALOG, I_DTB, I_DNW, I_WRO, I_WDO, I_WOUT, I_WF1, I_WF2 };

__device__ __forceinline__ float bf2f(unsigned short b) { return __uint_as_float((unsigned)b << 16); }
__device__ __forceinline__ unsigned f2bf(float f) { unsigned u = __float_as_uint(f); return (u + 0x7fffu + ((u >> 16) & 1u)) >> 16; }
typedef __bf16 bfx2_t __attribute__((ext_vector_type(2)));
__device__ __forceinline__ unsigned pk2(float lo, float hi) { const f32x2 t = {lo, hi}; return __builtin_bit_cast(unsigned, __builtin_convertvector(t, bfx2_t)); }
__device__ __forceinline__ unsigned cvt_pk_bf16(float lo, float hi) { return pk2(lo, hi); }

__device__ __forceinline__ float lo_bf(unsigned w) { return __uint_as_float(w << 16); }
__device__ __forceinline__ float hi_bf(unsigned w) { return __uint_as_float(w & 0xffff0000u); }
__device__ __forceinline__ float siluf(float x) { return x * __builtin_amdgcn_rcpf(1.f + __expf(-x)); }
__device__ __forceinline__ float sigmf(float x) { return __builtin_amdgcn_rcpf(1.f + __expf(-x)); }
__device__ __forceinline__ float softplusf(float x) { return x > 20.f ? x : log1pf(expf(x)); }
__device__ __forceinline__ float wave_sum(float v) {
#pragma unroll
  for (int o = 1; o < 64; o <<= 1) v += __shfl_xor(v, o);
  return v;
}
__device__ __forceinline__ int lane_id() { return (int)__builtin_amdgcn_mbcnt_hi(~0u, __builtin_amdgcn_mbcnt_lo(~0u, 0u)); }
__device__ __forceinline__ int cond_of_row(int m) { return m < MCTX ? 0 : 1 + (m - MCTX) / LLAT; }
__device__ __forceinline__ const float* xrow(const Params& p, int m) { return m < MCTX ? p.in[I_XP] + (size_t)m * D : p.in[I_XS] + (size_t)(m - MCTX) * D; }


__device__ __forceinline__ int lane_id();
#define XB_TMO      128
#define XB_XCNT(j)  (256  + 64 * (j))
#define XB_XSUB(j)  (1280 + 64 * (j))
#define XB_XGEN(j)  (2304 + 64 * (j))
#define XB_TOP      3328
#define XB_TOPGEN   3392
#define XCD_BAR_WORDS 3456
#define XB_SPIN_CAP (1u << 18)
__device__ __forceinline__ unsigned xb_ld(unsigned* p)              { return __hip_atomic_load(p, __ATOMIC_RELAXED, __HIP_MEMORY_SCOPE_AGENT); }
__device__ __forceinline__ unsigned xb_add(unsigned* p, unsigned v) { return __hip_atomic_fetch_add(p, v, __ATOMIC_RELAXED, __HIP_MEMORY_SCOPE_AGENT); }
__device__ __forceinline__ unsigned xb_xcc_id() { return (unsigned)__builtin_amdgcn_s_getreg((3 << 11) | 20) & 0xFu; }
#define XB_SPIN(cond, bar) do { unsigned _sp = 0; while (cond) { __builtin_amdgcn_s_sleep(1); \
    if ((++_sp & 255u) == 0u) { if (xb_ld(&(bar)[XB_TMO])) break; if (_sp > XB_SPIN_CAP) { atomicAdd(&(bar)[XB_TMO], 1u); break; } } } } while (0)
struct XcdBarrier { unsigned* bar; unsigned x; volatile LAS unsigned* st; };
__device__ __forceinline__ XcdBarrier xcd_barrier_post(unsigned* bar, volatile LAS unsigned* st) {
  XcdBarrier b; b.bar = bar; b.x = xb_xcc_id(); b.st = st;
  if (threadIdx.x == 0) (void)xb_add(&bar[XB_XCNT(b.x)], 1u);
  return b;
}
__device__ __forceinline__ void xcd_barrier_complete(unsigned* bar, unsigned x, unsigned& nloc, unsigned& nx) {
  const unsigned G = gridDim.x * gridDim.y * gridDim.z;
  unsigned sum, cnt, mine, sp = 0u;
  for (;;) {
    sum = 0u; cnt = 0u; mine = 0u;
#pragma unroll
    for (unsigned j = 0; j < 16; ++j) { const unsigned c = xb_ld(&bar[XB_XCNT(j)]); sum += c; cnt += (c > 0u) ? 1u : 0u; mine = (j == x) ? c : mine; }
    if (sum == G) break;
    __builtin_amdgcn_s_sleep(1);
    if ((++sp & 255u) == 0u) { if (xb_ld(&bar[XB_TMO])) break; if (sp > XB_SPIN_CAP) { atomicAdd(&bar[XB_TMO], 1u); break; } }
  }
  nloc = mine > 0u ? mine : 1u; nx = cnt > 0u ? cnt : 1u;
}
__device__ __forceinline__ void xcd_barrier(const XcdBarrier& b, const int wave) {
  asm volatile("s_waitcnt vmcnt(0)" ::: "memory");
  __syncthreads();
  if (wave == 0 && lane_id() == 0) {
    unsigned* bar = b.bar;
    __builtin_amdgcn_s_waitcnt(0);
    unsigned nloc = b.st[0], nx = b.st[1];
    if (nloc == 0u) { xcd_barrier_complete(bar, b.x, nloc, nx); b.st[0] = nloc; b.st[1] = nx; }
    const unsigned old = xb_add(&bar[XB_XSUB(b.x)], 1u);
    const unsigned gen = old / nloc;
    if (old + 1u == (gen + 1u) * nloc) {
      __builtin_amdgcn_fence(__ATOMIC_RELEASE, "agent");
      asm volatile("s_waitcnt vmcnt(0)" ::: "memory");
      const unsigned og = xb_add(&bar[XB_TOP], 1u);
      const unsigned tg = og / nx;
      if (og + 1u == (tg + 1u) * nx) xb_add(&bar[XB_TOPGEN], 1u);
      else XB_SPIN(xb_ld(&bar[XB_TOPGEN]) == tg, bar);
      __builtin_amdgcn_fence(__ATOMIC_ACQUIRE, "agent");
      xb_add(&bar[XB_XGEN(b.x)], 1u);
      asm volatile("s_waitcnt vmcnt(0)" ::: "memory");
    } else {
      XB_SPIN(xb_ld(&bar[XB_XGEN(b.x)]) == gen, bar);
      __builtin_amdgcn_fence(__ATOMIC_ACQUIRE, "agent");
      asm volatile("s_waitcnt vmcnt(0)" ::: "memory");
    }
  }
  __syncthreads();
}

namespace pg8 {
constexpr int BM = 256, BK = 64, HALF = 128, HTB = HALF * BK * 2, STAGE_BYTES = 8 * HTB, NXCD = 8, WGM = 8;
__host__ __device__ __forceinline__ int lds_byte(int r, int c) { const int st = (r >> 4) * 2 + (c >> 5), rr = r & 15, cc = c & 31, ob = rr * 64 + cc * 2; return st * 1024 + (ob ^ (((ob >> 9) & 1) << 5)); }
__host__ __device__ __forceinline__ void stage_rc(int b, int& R, int& C) { const int st = b / 1024, sb = b % 1024, swz = sb ^ (((sb >> 9) & 1) << 5); R = (st >> 1) * 16 + swz / 64; C = (st & 1) * 32 + (swz % 64) / 2; }
__host__ __device__ __forceinline__ int perm32(int rho) { const int n = rho >> 4, i = rho & 15; return 8 * (i >> 2) + 4 * n + (i & 3); }
struct Unit { int pm, pn; };
struct Gemm { const bf16_t* A; const bf16_t* Bt; int M, N, K; };
struct StaticOrder {
  int nM, nN, nwg, G, c;
  __host__ __device__ void init(int M, int N, int G_, int c_) { nM = M / BM; nN = N / BM; nwg = nM * nN; G = G_; c = c_; }
  __host__ __device__ bool next(int i, Unit& u) const {
    const long L = (long)i * G + c; if (L >= nwg) return false;
    int wgid = (int)L; { const int q = nwg / NXCD, r = nwg % NXCD, xcd = wgid % NXCD, off = wgid / NXCD; wgid = (xcd < r ? xcd * (q + 1) : r * (q + 1) + (xcd - r) * q) + off; }
    const int nig = WGM * nN, gid = wgid / nig, fm = gid * WGM, gsz = (nM - fm) < WGM ? (nM - fm) : WGM;
    u.pm = fm + ((wgid % nig) % gsz); u.pn = (wgid % nig) / gsz; return true;
  }
  __device__ __forceinline__ void a_ready(const Unit&) const {}
  __device__ __forceinline__ void done(const Unit&) const {}
};

template <int MODE  > struct EpiBf16Act {
  static constexpr bool PERM = true, AFTER_DRAIN = false;
  bf16_t* O; int ldc;
  __device__ __forceinline__ void operator()(const f32x4 (&acc)[2][2][4][2], const Unit& u, int wr, int wc, int fr, int fq) const {
    const int row0 = u.pm * BM + wr * 64 + fr, col0 = u.pn * BM + wc * 32 + 8 * fq;
    const bool sg = u.pn >= 8;
#pragma unroll
    for (int ai = 0; ai < 2; ++ai)
#pragma unroll
      for (int m = 0; m < 4; ++m) { bf16_t* rowp = O + (size_t)(row0 + ai * HALF + m * 16) * ldc + col0;
#pragma unroll
        for (int bj = 0; bj < 2; ++bj) { f32x4 v0 = acc[ai][bj][m][0], v1 = acc[ai][bj][m][1];
          if (MODE == 1) {
#pragma unroll
            for (int i = 0; i < 4; ++i) { const float s0 = __builtin_amdgcn_rcpf(1.f + __expf(-v0[i])), s1 = __builtin_amdgcn_rcpf(1.f + __expf(-v1[i]));
              v0[i] = sg ? s0 : v0[i] * s0; v1[i] = sg ? s1 : v1[i] * s1; } }
          u32x4 w; w.x = cvt_pk_bf16(v0[0], v0[1]); w.y = cvt_pk_bf16(v0[2], v0[3]); w.z = cvt_pk_bf16(v1[0], v1[1]); w.w = cvt_pk_bf16(v1[2], v1[3]);
          *(u32x4*)(rowp + bj * HALF) = w; } }
  }
};
struct EpiQKV {
  static constexpr bool PERM = true, AFTER_DRAIN = false;
  bf16_t* O; int ldc; bf16_t* HALO;
  __device__ __forceinline__ void operator()(const f32x4 (&acc)[2][2][4][2], const Unit& u, int wr, int wc, int fr, int fq) const {
    const int row0 = u.pm * BM + wr * 64 + fr, col0 = u.pn * BM + wc * 32 + 8 * fq;
#pragma unroll
    for (int ai = 0; ai < 2; ++ai)
#pragma unroll
      for (int m = 0; m < 4; ++m) { const int row = row0 + ai * HALF + m * 16; bf16_t* rowp = O + (size_t)row * ldc + col0;
#pragma unroll
        for (int bj = 0; bj < 2; ++bj) { const f32x4 v0 = acc[ai][bj][m][0], v1 = acc[ai][bj][m][1];
          u32x4 w; w.x = cvt_pk_bf16(v0[0], v0[1]); w.y = cvt_pk_bf16(v0[2], v0[3]); w.z = cvt_pk_bf16(v1[0], v1[1]); w.w = cvt_pk_bf16(v1[2], v1[3]);
          *(u32x4*)(rowp + bj * HALF) = w;
          if (u.pn >= 8 && ((m == 0 && fr == 0) || (m == 3 && fr == 15)))
            *(u32x4*)(HALO + ((size_t)(row >> 6) * 2 + (m == 3 ? 1 : 0)) * 2048 + (col0 - 2048) + bj * HALF) = w; } }
  }
};
struct EpiGateMul {
  static constexpr bool PERM = true, AFTER_DRAIN = false;
  bf16_t* O; int ldc; const bf16_t* G; int ldg; const bf16_t* Add;
  __device__ __forceinline__ void operator()(const f32x4 (&acc)[2][2][4][2], const Unit& u, int wr, int wc, int fr, int fq) const {
    const int row0 = u.pm * BM + wr * 64 + fr, col0 = u.pn * BM + wc * 32 + 8 * fq;
#pragma unroll
    for (int ai = 0; ai < 2; ++ai)
#pragma unroll
      for (int m = 0; m < 4; ++m) { const size_t r = (size_t)(row0 + ai * HALF + m * 16);
#pragma unroll
        for (int bj = 0; bj < 2; ++bj) { const f32x4 v0 = acc[ai][bj][m][0], v1 = acc[ai][bj][m][1];
          const u32x4 g = *(const u32x4*)(G + r * ldg + col0 + bj * HALF);
          float o[8] = {v0[0] * lo_bf(g.x), v0[1] * hi_bf(g.x), v0[2] * lo_bf(g.y), v0[3] * hi_bf(g.y), v1[0] * lo_bf(g.z), v1[1] * hi_bf(g.z), v1[2] * lo_bf(g.w), v1[3] * hi_bf(g.w)};
          if (Add) { const u32x4 a = *(const u32x4*)(Add + r * ldc + col0 + bj * HALF);
            o[0] += lo_bf(a.x); o[1] += hi_bf(a.x); o[2] += lo_bf(a.y); o[3] += hi_bf(a.y); o[4] += lo_bf(a.z); o[5] += hi_bf(a.z); o[6] += lo_bf(a.w); o[7] += hi_bf(a.w); }
          u32x4 w; w.x = cvt_pk_bf16(o[0], o[1]); w.y = cvt_pk_bf16(o[2], o[3]); w.z = cvt_pk_bf16(o[4], o[5]); w.w = cvt_pk_bf16(o[6], o[7]);
          *(u32x4*)(O + r * ldc + col0 + bj * HALF) = w; } }
  }
};
struct EpiF32 {
  static constexpr bool PERM = false, AFTER_DRAIN = false;
  float* O; int ldc;
  __device__ __forceinline__ void operator()(const f32x4 (&acc)[2][2][4][2], const Unit& u, int wr, int wc, int fr, int fq) const {
    const int row0 = u.pm * BM + wr * 64 + fr, col0 = u.pn * BM + wc * 32 + 4 * fq;
#pragma unroll
    for (int ai = 0; ai < 2; ++ai)
#pragma unroll
      for (int m = 0; m < 4; ++m) { float* rowp = O + (size_t)(row0 + ai * HALF + m * 16) * ldc + col0;
#pragma unroll
        for (int bj = 0; bj < 2; ++bj)
#pragma unroll
          for (int n = 0; n < 2; ++n) *(f32x4*)(rowp + bj * HALF + n * 16) = acc[ai][bj][m][n]; }
  }
};
struct EpiSwiGLU {
  static constexpr bool PERM = true, AFTER_DRAIN = false;
  bf16_t* O; int ldc;
  __device__ __forceinline__ void operator()(const f32x4 (&acc)[2][2][4][2], const Unit& u, int wr, int wc, int fr, int fq) const {
    const int row0 = u.pm * BM + wr * 64 + fr, col0 = u.pn * HALF + wc * 32 + 8 * fq;
#pragma unroll
    for (int ai = 0; ai < 2; ++ai)
#pragma unroll
      for (int m = 0; m < 4; ++m) { bf16_t* rowp = O + (size_t)(row0 + ai * HALF + m * 16) * ldc + col0;
        float o[8];
#pragma unroll
        for (int n = 0; n < 2; ++n)
#pragma unroll
          for (int i = 0; i < 4; ++i) { const float g = acc[ai][0][m][n][i], up = acc[ai][1][m][n][i]; o[4 * n + i] = g * __builtin_amdgcn_rcpf(1.f + __expf(-g)) * up; }
        u32x4 w; w.x = cvt_pk_bf16(o[0], o[1]); w.y = cvt_pk_bf16(o[2], o[3]); w.z = cvt_pk_bf16(o[4], o[5]); w.w = cvt_pk_bf16(o[6], o[7]);
        *(u32x4*)rowp = w; }
  }
};

template <class Epi, class Sched, bool ALIGN_EPI = false, bool SP2 = false>
__device__ __forceinline__ void gemm_phase(LAS unsigned char* lds, const Gemm g, const Sched& S, const Epi& E, const int wid) {
  int lane_o = lane_id(); asm volatile("" : "+v"(lane_o));
  const int lane = lane_o, tid = (wid << 6) | lane, wr = wid >> 2, wc = wid & 3, fr = lane & 15, fq = lane >> 4;
  const int K = g.K, nt = K / BK;
  unsigned voffA[2], voffB[2];
#pragma unroll
  for (int i = 0; i < 2; ++i) { int R, C; stage_rc(tid * 16 + i * 8192, R, C); const int Rb = Epi::PERM ? ((R & ~31) + perm32(R & 31)) : R;
    voffA[i] = (unsigned)(R * K + C) * 2u; voffB[i] = (unsigned)(Rb * K + C) * 2u; }
  const size_t kstep = (size_t)(BK * 2);
  const size_t hstep = (size_t)HALF * K * 2;
  const size_t tstep = 2 * hstep;
  const unsigned ldsw = (unsigned)wid * 1024u;
  const int aoff = lds_byte(wr * 64 + fr, fq * 8), boff = lds_byte(wc * 32 + fr, fq * 8);
#define PG8_SA(b, h) (((b) * 2 + (h)) * HTB)
#define PG8_SB(b, h) ((4 + (b) * 2 + (h)) * HTB)
#define PG8_STAGE(bufoff, gbase, voff) do { _Pragma("unroll") for (int _i = 0; _i < 2; ++_i) \
    __builtin_amdgcn_global_load_lds((const unsigned*)((const char*)(gbase) + (voff)[_i]), (LAS unsigned*)(lds + (bufoff) + ldsw + _i * 8192), 16, 0, 0); } while (0)
#define PG8_LDA(dst, b, h) do { _Pragma("unroll") for (int m = 0; m < 4; ++m) _Pragma("unroll") for (int k = 0; k < 2; ++k) dst[m][k] = *(const LAS bf16x8*)(lds + PG8_SA(b, h) + aoff + m * 2048 + k * 1024); } while (0)
#define PG8_LDB(dst, b, h) do { _Pragma("unroll") for (int n = 0; n < 2; ++n) _Pragma("unroll") for (int k = 0; k < 2; ++k) dst[n][k] = *(const LAS bf16x8*)(lds + PG8_SB(b, h) + boff + n * 2048 + k * 1024); } while (0)
#define PG8_MMA(ai, bj, At, Bt) do { __builtin_amdgcn_s_setprio(1); _Pragma("unroll") for (int m = 0; m < 4; ++m) _Pragma("unroll") for (int n = 0; n < 2; ++n) _Pragma("unroll") for (int k = 0; k < 2; ++k) \
    acc[ai][bj][m][n] = __builtin_amdgcn_mfma_f32_16x16x32_bf16(Bt[n][k], At[m][k], acc[ai][bj][m][n], 0, 0, 0); __builtin_amdgcn_s_setprio(0); } while (0)
#define PG8_WAIT_V(n) asm volatile("s_waitcnt vmcnt(" #n ")" ::: "memory")
#define PG8_WAIT_L(n) asm volatile("s_waitcnt lgkmcnt(" #n ")" ::: "memory")
#define PG8_BAR __builtin_amdgcn_s_barrier()
#define PG8_SCHED __builtin_amdgcn_sched_barrier(0)
  Unit cur, nxt; int ui = 0;
  if (!S.next(0, cur)) return;
  f32x4 acc[2][2][4][2];
#pragma unroll
  for (int a = 0; a < 2; ++a)
#pragma unroll
    for (int b = 0; b < 2; ++b)
#pragma unroll
      for (int m = 0; m < 4; ++m)
#pragma unroll
        for (int n = 0; n < 2; ++n) acc[a][b][m][n] = (f32x4){0.f, 0.f, 0.f, 0.f};
  bf16x8 At[4][2], B0[2][2], B1[2][2];
  const char* cA = (const char*)g.A + (size_t)cur.pm * tstep; const char* cB = (const char*)g.Bt + (size_t)cur.pn * tstep;
  S.a_ready(cur);
  if constexpr (SP2) {
    PG8_STAGE(PG8_SB(0, 0), cB, voffB); PG8_STAGE(PG8_SB(0, 1), cB + hstep, voffB); PG8_STAGE(PG8_SA(0, 0), cA, voffA); PG8_STAGE(PG8_SA(0, 1), cA + hstep, voffA);
    if (wr == 1) PG8_BAR;
    PG8_WAIT_V(2); PG8_BAR;
    PG8_STAGE(PG8_SB(1, 0), cB + kstep, voffB); PG8_STAGE(PG8_SA(1, 0), cA + kstep, voffA); PG8_STAGE(PG8_SB(1, 1), cB + hstep + kstep, voffB);
    PG8_WAIT_V(6); PG8_BAR;
  } else {
    PG8_STAGE(PG8_SB(0, 0), cB, voffB); PG8_STAGE(PG8_SA(0, 0), cA, voffA); PG8_STAGE(PG8_SB(0, 1), cB + hstep, voffB); PG8_STAGE(PG8_SA(0, 1), cA + hstep, voffA);
    if (wr == 1) PG8_BAR;
    PG8_WAIT_V(4); PG8_BAR;
    PG8_STAGE(PG8_SB(1, 0), cB + kstep, voffB); PG8_STAGE(PG8_SA(1, 0), cA + kstep, voffA); PG8_STAGE(PG8_SB(1, 1), cB + hstep + kstep, voffB);
    PG8_WAIT_V(6); PG8_BAR;
  }
  for (;;) {
    const bool has_next = S.next(ui + 1, nxt);
    const char* nA = has_next ? (const char*)g.A + (size_t)nxt.pm * tstep : cA; const char* nB = has_next ? (const char*)g.Bt + (size_t)nxt.pn * tstep : cB;
    for (int t = 0; t < nt; t += 2) {
      const bool last = (t == nt - 2);
      const char* a1 = cA + (size_t)(t + 1) * kstep;
      const char* a2 = last ? nA : cA + (size_t)(t + 2) * kstep; const char* b2 = last ? nB : cB + (size_t)(t + 2) * kstep;
      const char* a3 = a2 + kstep; const char* b3 = b2 + kstep;
      if (last && has_next) S.a_ready(nxt);
      if constexpr (SP2) {
        PG8_LDB(B0, 0, 0); PG8_LDB(B1, 0, 1); PG8_SCHED; PG8_LDA(At, 0, 0); PG8_STAGE(PG8_SA(1, 1), a1 + hstep, voffA);
        PG8_WAIT_V(8); PG8_WAIT_L(0); PG8_BAR; PG8_MMA(0, 0, At, B0); PG8_MMA(0, 1, At, B1); PG8_BAR; PG8_SCHED;
        PG8_LDA(At, 0, 1); PG8_STAGE(PG8_SB(0, 0), b2, voffB); PG8_STAGE(PG8_SB(0, 1), b2 + hstep, voffB); PG8_STAGE(PG8_SA(0, 0), a2, voffA);
        PG8_WAIT_V(8); PG8_WAIT_L(0); PG8_BAR; PG8_MMA(1, 0, At, B0); PG8_MMA(1, 1, At, B1); PG8_BAR; PG8_SCHED;
        PG8_LDB(B0, 1, 0); PG8_LDB(B1, 1, 1); PG8_SCHED; PG8_LDA(At, 1, 0); PG8_STAGE(PG8_SA(0, 1), a2 + hstep, voffA);
        PG8_WAIT_V(8); PG8_WAIT_L(0); PG8_BAR; PG8_MMA(0, 0, At, B0); PG8_MMA(0, 1, At, B1); PG8_BAR; PG8_SCHED;
        PG8_LDA(At, 1, 1); PG8_STAGE(PG8_SB(1, 0), b3, voffB); PG8_STAGE(PG8_SB(1, 1), b3 + hstep, voffB); PG8_STAGE(PG8_SA(1, 0), a3, voffA);
        PG8_WAIT_V(8); PG8_WAIT_L(0); PG8_BAR; PG8_MMA(1, 0, At, B0); PG8_MMA(1, 1, At, B1); PG8_BAR; PG8_SCHED;
      } else {
        PG8_LDB(B0, 0, 0); PG8_SCHED; PG8_LDA(At, 0, 0); PG8_STAGE(PG8_SA(1, 1), a1 + hstep, voffA);
        PG8_WAIT_L(8); PG8_BAR; PG8_WAIT_L(0); PG8_MMA(0, 0, At, B0); PG8_BAR; PG8_SCHED;
        PG8_LDB(B1, 0, 1); PG8_STAGE(PG8_SB(0, 0), b2, voffB);
        PG8_BAR; PG8_WAIT_L(0); PG8_MMA(0, 1, At, B1); PG8_BAR;
        PG8_LDA(At, 0, 1); PG8_STAGE(PG8_SA(0, 0), a2, voffA);
        PG8_BAR; PG8_WAIT_L(0); PG8_MMA(1, 0, At, B0); PG8_BAR; PG8_SCHED;
        PG8_STAGE(PG8_SB(0, 1), b2 + hstep, voffB);
        PG8_WAIT_V(6); PG8_BAR; PG8_MMA(1, 1, At, B1); PG8_BAR;
        PG8_LDB(B0, 1, 0); PG8_SCHED; PG8_LDA(At, 1, 0); PG8_STAGE(PG8_SA(0, 1), a2 + hstep, voffA);
        PG8_WAIT_L(8); PG8_BAR; PG8_WAIT_L(0); PG8_MMA(0, 0, At, B0); PG8_BAR; PG8_SCHED;
        PG8_LDB(B1, 1, 1); PG8_STAGE(PG8_SB(1, 0), b3, voffB);
        PG8_BAR; PG8_WAIT_L(0); PG8_MMA(0, 1, At, B1); PG8_BAR;
        PG8_LDA(At, 1, 1); PG8_STAGE(PG8_SA(1, 0), a3, voffA);
        PG8_BAR; PG8_WAIT_L(0); PG8_MMA(1, 0, At, B0); PG8_BAR; PG8_SCHED;
        PG8_STAGE(PG8_SB(1, 1), b3 + hstep, voffB);
        PG8_WAIT_V(6); PG8_BAR; PG8_MMA(1, 1, At, B1); PG8_BAR;
      }
    }
    if constexpr (ALIGN_EPI) { if (wr == 0) PG8_BAR; }
    if constexpr (!Epi::AFTER_DRAIN) { E(acc, cur, wr, wc, fr, fq); S.done(cur); }
    if (!has_next) break;
#pragma unroll
    for (int a = 0; a < 2; ++a)
#pragma unroll
      for (int b = 0; b < 2; ++b)
#pragma unroll
        for (int m = 0; m < 4; ++m)
#pragma unroll
          for (int n = 0; n < 2; ++n) acc[a][b][m][n] = (f32x4){0.f, 0.f, 0.f, 0.f};
    cur = nxt; cA = nA; cB = nB; ++ui;
    if constexpr (ALIGN_EPI) { if (wr == 1) PG8_BAR; }
  }
  PG8_WAIT_V(0);
  if constexpr (!ALIGN_EPI) { if (wr == 0) PG8_BAR; }
  PG8_BAR;
#undef PG8_SA
#undef PG8_SB
#undef PG8_STAGE
#undef PG8_LDA
#undef PG8_LDB
#undef PG8_MMA
#undef PG8_WAIT_V
#undef PG8_WAIT_L
#undef PG8_BAR
#undef PG8_SCHED
}
}

typedef float f32x16 __attribute__((ext_vector_type(16)));
typedef float f32x8 __attribute__((ext_vector_type(8)));
typedef short s16x4 __attribute__((ext_vector_type(4)));
typedef __bf16 bfx8 __attribute__((ext_vector_type(8)));
#define MFMA32(a, b, c) __builtin_amdgcn_mfma_f32_32x32x16_bf16((a), (b), (c), 0, 0, 0)
__device__ __forceinline__ bf16x8 cvt8(f32x8 t) { return __builtin_bit_cast(bf16x8, __builtin_convertvector(t, bfx8)); }
__device__ __forceinline__ bf16x8 pack8(const f32x16& x, int s) {
  const f32x8 t = {x[8 * s], x[8 * s + 1], x[8 * s + 2], x[8 * s + 3], x[8 * s + 4], x[8 * s + 5], x[8 * s + 6], x[8 * s + 7]};
  return cvt8(t);
}
__device__ __forceinline__ f32x16 zero16() { f32x16 z; for (int i = 0; i < 16; ++i) z[i] = 0.f; return z; }
__device__ __forceinline__ unsigned off_b(unsigned row, unsigned ch) { return 256u * row + 16u * (ch ^ (((row & 3u) << 2) | ((row >> 2) & 3u))); }
__device__ __forceinline__ int swap12(int p) { return ((p & 1) << 1) | (p >> 1); }
__device__ __forceinline__ bf16x8 lds_rd128(LAS unsigned char* lds, unsigned off) { return *(const LAS bf16x8*)(lds + off); }
__device__ __forceinline__ bf16x8 lds_tr2(LAS unsigned char* lds, unsigned off_lo, unsigned off_hi) {
  const s16x4 lo = __builtin_amdgcn_ds_read_tr16_b64_v4i16((LAS s16x4*)(lds + off_lo));
  const s16x4 hi = __builtin_amdgcn_ds_read_tr16_b64_v4i16((LAS s16x4*)(lds + off_hi));
  return __builtin_shufflevector(lo, hi, 0, 1, 2, 3, 4, 5, 6, 7);
}
__device__ __forceinline__ void glds16(const void* g, LAS unsigned char* l) {
  unsigned keep; const unsigned dst = __builtin_amdgcn_readfirstlane((unsigned)(size_t)l);
  asm volatile("s_mov_b32 %0, m0\n\ts_mov_b32 m0, %2\n\ts_nop 0\n\tglobal_load_lds_dwordx4 %1, off\n\ts_mov_b32 m0, %0" : "=&s"(keep) : "v"(g), "s"(dst) : "memory");
}
__device__ __forceinline__ unsigned rowfrag_off(int lane, int mt, int ks) { return off_b(32 * mt + (lane & 31), 2 * ks + (lane >> 5)); }
__device__ __forceinline__ unsigned vtr_off(int lane, int cb, int ks, int sec) {
  const int g = lane >> 4, i = lane & 15, hh = g >> 1, half16 = g & 1, qq = i >> 2, p = i & 3;
  const int row = 16 * ks + 4 * hh + 8 * sec + qq, col = cb + 16 * half16 + 4 * p;
  return off_b(row, col >> 3) + (col & 7) * 2;
}
__device__ __forceinline__ unsigned ktr_off(int lane, int mt, int ks, int sec) {
  const int g = lane >> 4, i = lane & 15, hh = g >> 1, half16 = g & 1, qq = i >> 2, p = i & 3;
  const int row = 16 * ks + 4 * hh + 8 * sec + qq, col = 32 * mt + 16 * half16 + 4 * swap12(p);
  return off_b(row, col >> 3) + (col & 7) * 2;
}
__device__ __forceinline__ int crow(int reg, int h) { return (reg & 3) + 8 * (reg >> 2) + 4 * h; }
__device__ __forceinline__ int srow(int reg, int h) { return 16 * (reg >> 3) + 8 * h + 4 * ((reg >> 2) & 1) + (reg & 3); }
__device__ __forceinline__ void rowscale(f32x16& a, const LAS float* vec, int h, float sgn) {
#pragma unroll
  for (int g4 = 0; g4 < 4; ++g4) { const f32x4 s = *(const LAS f32x4*)(vec + 8 * g4 + 4 * h);
    a[4 * g4] *= s.x * sgn; a[4 * g4 + 1] *= s.y * sgn; a[4 * g4 + 2] *= s.z * sgn; a[4 * g4 + 3] *= s.w * sgn; }
}
__device__ __forceinline__ void stage_img_piece(const unsigned char* src, size_t pitch, LAS unsigned char* img, int pc, int lane) {
  const unsigned row = 4 * pc + (lane >> 4), chp = lane & 15, ch = chp ^ (((row & 3u) << 2) | ((row >> 2) & 3u));
  glds16(src + (size_t)row * pitch + ch * 16, img + 1024 * pc);
}
constexpr int SC_BUF = 66560, SC_Q = 0, SC_K = 16384, SC_M = 32768, SC_V = 50176, SC_VEC = 2 * SC_BUF;
constexpr int DN_BLOB = 17408, RT_BLOB = 8192;
__device__ __forceinline__ void glds16_s(const unsigned char* base_uniform, unsigned voff, LAS unsigned char* l) {
  unsigned keep; const unsigned dst = __builtin_amdgcn_readfirstlane((unsigned)(size_t)l);
  const unsigned long long b = (unsigned long long)(size_t)base_uniform;
  const unsigned long long bs = ((unsigned long long)(unsigned)__builtin_amdgcn_readfirstlane((unsigned)(b >> 32)) << 32) | (unsigned)__builtin_amdgcn_readfirstlane((unsigned)b);
  asm volatile("s_mov_b32 %0, m0\n\ts_mov_b32 m0, %3\n\ts_nop 0\n\tglobal_load_lds_dwordx4 %1, %2\n\ts_mov_b32 m0, %0" : "=&s"(keep) : "v"(voff), "s"(bs), "s"(dst) : "memory");
}
struct StageOff { unsigned q[2], k[2], m; };
__device__ __forceinline__ StageOff scan_stage_offsets(int w, int lane, unsigned kpitch) {
  StageOff o;
#pragma unroll
  for (int i = 0; i < 2; ++i) { const unsigned pc = w + 8 * i, row = 4 * pc + (lane >> 4), chp = lane & 15, ch = chp ^ (((row & 3u) << 2) | ((row >> 2) & 3u));
    o.q[i] = row * (unsigned)(LDQ * 2) + ch * 16; o.k[i] = row * kpitch + ch * 16; }
  o.m = lane * 16;
  return o;
}
__device__ __forceinline__ void scan_stage(LAS unsigned char* lds, int buf, int type, int dir, int h, int gc, const bf16_t* QKV, const bf16_t* KBUF,
                                           const unsigned char* MATS_RT, const unsigned char* MATS_DN, int half, int w, const StageOff& so) {
  const size_t row0 = (size_t)gc * 64;
  const unsigned char* rowp = (const unsigned char*)(QKV + row0 * LDQ);
  const unsigned char* qsrc = rowp + (type ? Q_DQ + h * DK : Q_RQ + h * DK) * 2;
  const unsigned char* ksrc = rowp + (type ? Q_DK + h * DK : Q_RK + h * DK) * 2;
  if (!type && dir) ksrc = (const unsigned char*)(KBUF + row0 * 512 + h * DK);
  const unsigned char* vsrc = rowp + (type ? Q_DV + h * DV : Q_RV + h * DV) * 2 + half * 256;
  LAS unsigned char* B = lds + buf * SC_BUF;
#pragma unroll
  for (int i = 0; i < 2; ++i) { const int pc = w + 8 * i;
    glds16_s(qsrc, so.q[i], B + SC_Q + 1024 * pc); glds16_s(ksrc, so.k[i], B + SC_K + 1024 * pc); glds16_s(vsrc, so.q[i], B + SC_V + 1024 * pc); }
  const unsigned char* blob = type ? MATS_DN + (size_t)((gc * 4 + h) * 2 + dir) * DN_BLOB : MATS_RT + (size_t)((gc * 4 + h) * 2 + dir) * RT_BLOB;
  const int np = type ? 17 : 8;
  for (int pc = w; pc < np; pc += 8) glds16_s(blob + pc * 1024, so.m, B + SC_M + pc * 1024);
}

__device__ __forceinline__ void transpose_item(const float* W, int ldw, int K, int src_col0, bf16_t* WT, int dst_row0, int k0, LAS float* scr, int lane) {
#pragma unroll 8
  for (int i = 0; i < 32; ++i) { const int kk = 2 * i + (lane >> 5); scr[kk * 33 + (lane & 31)] = W[(size_t)(k0 + kk) * ldw + src_col0 + (lane & 31)]; }
  asm volatile("s_waitcnt lgkmcnt(0)" ::: "memory");
  const int c = lane & 7;
#pragma unroll
  for (int j = 0; j < 4; ++j) { const int n = (lane >> 3) + 8 * j; const LAS float* s = scr + (8 * c) * 33 + n;
    u32x4 o; o.x = pk2(s[0 * 33], s[1 * 33]); o.y = pk2(s[2 * 33], s[3 * 33]); o.z = pk2(s[4 * 33], s[5 * 33]); o.w = pk2(s[6 * 33], s[7 * 33]);
    *(u32x4*)(WT + (size_t)(dst_row0 + n) * K + k0 + 8 * c) = o; }
  asm volatile("s_waitcnt lgkmcnt(0)" ::: "memory");
}

template <class ColMap> __device__ __forceinline__ void transpose_matrix(const float* W, int ldw, int K, int N, bf16_t* WT, ColMap cm, LAS float* scr, int gw, int ngw, int lane) {
  const int nblk = N / 32, items = (K / 64) * nblk;
  for (int it = gw; it < items; it += ngw) { const int kb = it / nblk, nb = it % nblk; transpose_item(W, ldw, K, cm(32 * nb), WT, 32 * nb, 64 * kb, scr, lane); }
}

__global__ void __launch_bounds__(NTHREADS) fwd_megakernel(Params p) {
  extern __shared__ __attribute__((aligned(16))) unsigned char lds_raw[];
  LAS unsigned char* lds = (LAS unsigned char*)lds_raw;
  cg::grid_group grid = cg::this_grid();
  volatile LAS unsigned* bar_st = (volatile LAS unsigned*)(lds + LDS_BYTES - 64);
  if (threadIdx.x < 2) bar_st[threadIdx.x] = 0u;
  __syncthreads();
  const XcdBarrier xbar = xcd_barrier_post((unsigned*)(p.ws + WS_BAR), bar_st);
  if (p.ws == nullptr) grid.sync();
#define GRID_BARRIER() xcd_barrier(xbar, wave)
  const int wave = __builtin_amdgcn_readfirstlane(threadIdx.x >> 6);
#define PHASE_TID() int lane_p = lane_id(); asm volatile("" : "+v"(lane_p)); const int lane = lane_p, tid = (wave << 6) | lane; (void)tid;
  const int G = gridDim.x, bid = blockIdx.x;
  const int gw = bid * NWAVES + wave, ngw = G * NWAVES;
  unsigned char* ws = p.ws;
  float* MOD = (float*)(ws + WS_MOD);
  f32x2* ROPE = (f32x2*)(ws + WS_ROPE);
  float* BA = (float*)(ws + WS_BA);
  float* DECLG = (float*)(ws + WS_MOD + 122880);
  bf16_t* WQKV = (bf16_t*)(ws + WS_WQKV); bf16_t* WGATE = (bf16_t*)(ws + WS_WGATE);
  bf16_t* WRO = (bf16_t*)(ws + WS_WRO); bf16_t* WDO = (bf16_t*)(ws + WS_WDO); bf16_t* WOUT = (bf16_t*)(ws + WS_WOUT);
  bf16_t* HB = (bf16_t*)(ws + WS_H);
  bf16_t* QKV = (bf16_t*)(ws + WS_QKV);
  bf16_t* KBUF = (bf16_t*)(ws + WS_KB); bf16_t* HALO = (bf16_t*)(ws + WS_HALO);
  unsigned char* MATS_RT = ws + WS_MATS_RT; unsigned char* MATS_DN = ws + WS_MATS_DN;
  unsigned char* LSCR = ws + WS_O; constexpr int LSCR_STRIDE = 16896;
  bf16_t* ODF = (bf16_t*)(ws + WS_O); bf16_t* ODB = ODF + (size_t)MTOT * D;
  bf16_t* ORF = (bf16_t*)p.out; bf16_t* ORB = ORF + (size_t)MTOT * D;
  float* NS_RET = p.out + (size_t)MTOT * D; float* NS_DN = NS_RET + (size_t)NCTX * 2 * NH * DK * DV;

  {
    PHASE_TID();
    LAS float* scr = (LAS float*)(lds + wave * 16384);
    transpose_matrix(p.in[I_WIN], INC, D, 4096, WQKV, [](int n) { return n < 2048 ? n : n + 1024; }, scr, gw, ngw, lane);
    transpose_matrix(p.in[I_WIN], INC, D, 4096, WGATE, [](int n) { return n < 1024 ? C_RG + n : (n < 2048 ? C_DZ + (n - 1024) : C_GR + (n - 2048)); }, scr, gw, ngw, lane);
    transpose_matrix(p.in[I_WRO], D, D, D, WRO, [](int n) { return n; }, scr, gw, ngw, lane);
    transpose_matrix(p.in[I_WDO], D, D, D, WDO, [](int n) { return n; }, scr, gw, ngw, lane);
    transpose_matrix(p.in[I_WOUT], D, D, D, WOUT, [](int n) { return n; }, scr, gw, ngw, lane);
    {
      __syncthreads();
      LAS float* scond = (LAS float*)lds;
      LAS float* red = scond + 5 * D;
      for (int i = tid; i < 5 * D; i += NTHREADS) { const int c = i >> 10, k = i & 1023; scond[i] = siluf(c == 0 ? p.in[I_CCTX][k] : p.in[I_C][(c - 1) * D + k]); }
      __syncthreads();
      for (int it = bid; it < 6 * D / 32; it += G) {
        const int col = it * 32 + (lane & 31), rpar = lane >> 5;
        float acc[5] = {0.f, 0.f, 0.f, 0.f, 0.f};
        const float* wm = p.in[I_WMOD] + (size_t)(128 * wave + rpar) * 6 * D + col;
#pragma unroll 16
        for (int i = 0; i < 64; ++i) { const float wv = wm[(size_t)(2 * i) * 6 * D]; const int k = 128 * wave + 2 * i + rpar;
#pragma unroll
          for (int c = 0; c < 5; ++c) acc[c] += scond[c * D + k] * wv; }
#pragma unroll
        for (int c = 0; c < 5; ++c) { acc[c] += __shfl_xor(acc[c], 32); if (lane < 32) red[(wave * 5 + c) * 32 + lane] = acc[c]; }
        __syncthreads();
        if (tid < 160) { const int c = tid >> 5, n = tid & 31; float s = 0.f;
#pragma unroll
          for (int ww = 0; ww < 8; ++ww) s += red[(ww * 5 + c) * 32 + n];
          MOD[c * 6 * D + it * 32 + n] = s + p.in[I_BMOD][it * 32 + n]; }
        __syncthreads();
      }
    }
    for (int i = bid * NTHREADS + tid; i < LLAT * 64; i += G * NTHREADS) { const int l = i >> 6, pr = i & 63;
      const float freq = powf(10000.f, -(float)(pr & 31) / 32.f); const float ang = (pr < 32 ? (float)(l >> 6) : (float)(l & 63)) * freq;
      ROPE[i] = (f32x2){cosf(ang), sinf(ang)}; }
    if (bid == 0 && tid < 8) DECLG[tid] = -softplusf(-p.in[I_DECAY][tid]);
  }
  GRID_BARRIER();

  {
    PHASE_TID();
    LAS float* wba = (LAS float*)lds;
    for (int i = tid; i < D * 16; i += NTHREADS) wba[(i & 15) * 1028 + (i >> 4)] = p.in[I_WIN][(size_t)(i >> 4) * INC + C_DB + (i & 15)];
    __syncthreads();
    const float* nw = p.in[I_NORMW];
    for (int m = gw; m < MTOT; m += ngw) {
      const float* xr = xrow(p, m); const float* md = MOD + (size_t)cond_of_row(m) * 6 * D;
      f32x4 x4[4], w4[4], sc4[4], sh4[4]; float s = 0.f;
#pragma unroll
      for (int j = 0; j < 4; ++j) { const int c0 = 4 * lane + 256 * j; x4[j] = *(const f32x4*)(xr + c0); w4[j] = *(const f32x4*)(nw + c0); sc4[j] = *(const f32x4*)(md + D + c0); sh4[j] = *(const f32x4*)(md + c0); }
#pragma unroll
      for (int j = 0; j < 4; ++j) s += (x4[j].x * x4[j].x + x4[j].y * x4[j].y) + (x4[j].z * x4[j].z + x4[j].w * x4[j].w);
      const float r = rsqrtf(wave_sum(s) * (1.f / D) + EPS);
      float dots[16];
#pragma unroll
      for (int n = 0; n < 16; ++n) dots[n] = 0.f;
#pragma unroll
      for (int j = 0; j < 4; ++j) { const int c0 = 4 * lane + 256 * j;
        const f32x4 h = x4[j] * r * w4[j] * (sc4[j] + 1.f) + sh4[j];
        u32x2 o; o.x = pk2(h.x, h.y); o.y = pk2(h.z, h.w);
        *(u32x2*)(HB + (size_t)m * D + c0) = o;
#pragma unroll
        for (int n = 0; n < 16; ++n) { const f32x4 wv = *(const LAS f32x4*)(wba + n * 1028 + c0); dots[n] += (h.x * wv.x + h.y * wv.y) + (h.z * wv.z + h.w * wv.w); }
        __builtin_amdgcn_sched_barrier(0);
      }
#pragma unroll
      for (int n = 0; n < 16; ++n) dots[n] = wave_sum(dots[n]);
      if (lane < 8) {
        float db = dots[0], da = dots[8];
#pragma unroll
        for (int n = 1; n < 8; ++n) { db = lane == n ? dots[n] : db; da = lane == n ? dots[8 + n] : da; }
        BA[(size_t)m * 16 + lane] = sigmf(db);
        BA[(size_t)m * 16 + 8 + lane] = -expf(p.in[I_ALOG][lane]) * softplusf(da + p.in[I_DTB][lane]);
      }
    }
  }
  GRID_BARRIER();

  {
    pg8::Gemm g{HB, WQKV, MTOT, 4096, D}; pg8::StaticOrder S; S.init(MTOT, 4096, G, bid);
    pg8::EpiQKV E{QKV, LDQ, HALO};
    pg8::gemm_phase<pg8::EpiQKV, pg8::StaticOrder, true, true>(lds, g, S, E, wave);
  }
  GRID_BARRIER();

  {
    PHASE_TID();
    constexpr int PI_RQ = 0, PI_RK = 16384, PI_DQ = 32768, PI_DK = 49152;
    constexpr int PM_QKR = 65536, PM_QKD = PM_QKR + 17408, PM_KKD = PM_QKD + 17408;
    constexpr int PV = PM_KKD + 17408;
    constexpr int PL_F = 0, PL_B = 17408, PT_F = 34816, PT_B = 52224;
    const int w = wave;
    const float* cw = p.in[I_CONVW];
    u32x4 qraw[2], kraw[2], rawa[2][2][3], rawb[4][3]; float ba4[4] = {0.f, 0.f, 0.f, 0.f};
#define P2_LOADS(ITEM, TID) do { const int gc_ = (ITEM) >> 2, h_ = (ITEM) & 3, row0_ = gc_ * 64; const bool lat_ = row0_ >= MCTX; \
      const int L_ = lat_ ? LLAT : LCTX, t0_ = lat_ ? ((row0_ - MCTX) & (LLAT - 1)) : (row0_ & (LCTX - 1)); \
      const size_t s1m_ = (size_t)row0_ + ((TID) >> 3); \
      _Pragma("unroll") for (int c = 0; c < 2; ++c) { const int ch = ((TID) & 7) * 2 + c; \
        qraw[c] = *(const u32x4*)(QKV + s1m_ * LDQ + Q_RQ + h_ * DK + ch * 8); kraw[c] = *(const u32x4*)(QKV + s1m_ * LDQ + Q_RK + h_ * DK + ch * 8); } \
      _Pragma("unroll") for (int ps = 0; ps < 2; ++ps) _Pragma("unroll") for (int wh = 0; wh < 2; ++wh) _Pragma("unroll") for (int wd = 0; wd < 3; ++wd) { \
          const int row = ((TID) >> 4) + 32 * ps, rr = row + wd - 1, t = t0_ + rr; const int dch = wh * 512 + h_ * DK + ((TID) & 15) * 8; \
          u32x4 x = (u32x4){0u, 0u, 0u, 0u}; \
          if (t >= 0 && t < L_) { \
            if (rr < 0) x = *(const u32x4*)(HALO + ((size_t)(gc_ - 1) * 2 + 1) * 2048 + dch); \
            else if (rr > 63) x = *(const u32x4*)(HALO + ((size_t)(gc_ + 1) * 2 + 0) * 2048 + dch); \
            else x = *(const u32x4*)(QKV + (size_t)(row0_ + rr) * LDQ + Q_DQ + dch); } \
          rawa[ps][wh][wd] = x; } \
      _Pragma("unroll") for (int n = 0; n < 4; ++n) _Pragma("unroll") for (int wd = 0; wd < 3; ++wd) { \
          const int idx = (TID) + 512 * n, row = idx >> 5, ch = idx & 31, rr = row + wd - 1, t = t0_ + rr; const int dch = 1024 + h_ * DV + ch * 8; \
          u32x4 x = (u32x4){0u, 0u, 0u, 0u}; \
          if (t >= 0 && t < L_) { \
            if (rr < 0) x = *(const u32x4*)(HALO + ((size_t)(gc_ - 1) * 2 + 1) * 2048 + dch); \
            else if (rr > 63) x = *(const u32x4*)(HALO + ((size_t)(gc_ + 1) * 2 + 0) * 2048 + dch); \
            else x = *(const u32x4*)(QKV + (size_t)(row0_ + rr) * LDQ + Q_DQ + dch); } \
          rawb[n][wd] = x; } \
      if ((TID) < 64) { const float* ba = BA + (size_t)(row0_ + (TID)) * 16; ba4[0] = ba[h_]; ba4[1] = ba[4 + h_]; ba4[2] = ba[8 + h_]; ba4[3] = ba[12 + h_]; } } while (0)
    if (bid < 768) { int lane_q = lane_id(); asm volatile("" : "+v"(lane_q)); const int tid_q = (wave << 6) | lane_q; P2_LOADS(bid, tid_q); }
    for (int item = bid; item < 768; item += G) {
      int lane_o = lane_id(); asm volatile("" : "+v"(lane_o));
      const int lane = lane_o, tid = (wave << 6) | lane, r32 = lane & 31, hl = lane >> 5;
      const int gc = item >> 2, h = item & 3, row0 = gc * 64; const bool lat = row0 >= MCTX;
      const int t0 = lat ? ((row0 - MCTX) & (LLAT - 1)) : (row0 & (LCTX - 1));
      const float lgf = DECLG[h], lgb = DECLG[4 + h];
      const int s1row = tid >> 3; const size_t s1m = (size_t)row0 + s1row;
      const int ach = tid & 15;
      asm volatile("s_waitcnt vmcnt(0)" ::: "memory");
      __syncthreads();
      const float ba_bf = ba4[0], ba_bb = ba4[1], ba_af = ba4[2], ba_ab = ba4[3];
      {
        const int row = s1row; const size_t m = s1m;
        const float kfs = __expf(lgf * (float)(63 - row)), kbs = __expf(lgb * (float)row);
#pragma unroll
        for (int c = 0; c < 2; ++c) { const int ch = (tid & 7) * 2 + c;
          bf16_t* qp = QKV + m * LDQ + Q_RQ + h * DK + ch * 8; bf16_t* kp = QKV + m * LDQ + Q_RK + h * DK + ch * 8;
          const u32x4 qw = qraw[c], kw = kraw[c];
          float q[8] = {lo_bf(qw.x), hi_bf(qw.x), lo_bf(qw.y), hi_bf(qw.y), lo_bf(qw.z), hi_bf(qw.z), lo_bf(qw.w), hi_bf(qw.w)};
          float k[8] = {lo_bf(kw.x), hi_bf(kw.x), lo_bf(kw.y), hi_bf(kw.y), lo_bf(kw.z), hi_bf(kw.z), lo_bf(kw.w), hi_bf(kw.w)};
#pragma unroll
          for (int e = 0; e < 8; ++e) q[e] *= QSCALE;
          if (lat) {
#pragma unroll
            for (int e = 0; e < 4; ++e) { const f32x2 cs = ROPE[(t0 + row) * 64 + ch * 4 + e];
              const float a = q[2 * e] * cs.x - q[2 * e + 1] * cs.y, b = q[2 * e] * cs.y + q[2 * e + 1] * cs.x; q[2 * e] = a; q[2 * e + 1] = b;
              const float c2 = k[2 * e] * cs.x - k[2 * e + 1] * cs.y, d2 = k[2 * e] * cs.y + k[2 * e + 1] * cs.x; k[2 * e] = c2; k[2 * e + 1] = d2; }
          }
          u32x4 o; o.x = pk2(q[0], q[1]); o.y = pk2(q[2], q[3]); o.z = pk2(q[4], q[5]); o.w = pk2(q[6], q[7]);
          *(u32x4*)qp = o; *(LAS u32x4*)(lds + PI_RQ + off_b(row, ch)) = o;
          o.x = pk2(k[0], k[1]); o.y = pk2(k[2], k[3]); o.z = pk2(k[4], k[5]); o.w = pk2(k[6], k[7]);
          *(LAS u32x4*)(lds + PI_RK + off_b(row, ch)) = o;
          o.x = pk2(k[0] * kfs, k[1] * kfs); o.y = pk2(k[2] * kfs, k[3] * kfs); o.z = pk2(k[4] * kfs, k[5] * kfs); o.w = pk2(k[6] * kfs, k[7] * kfs);
          *(u32x4*)kp = o;
          o.x = pk2(k[0] * kbs, k[1] * kbs); o.y = pk2(k[2] * kbs, k[3] * kbs); o.z = pk2(k[4] * kbs, k[5] * kbs); o.w = pk2(k[6] * kbs, k[7] * kbs);
          *(u32x4*)(KBUF + m * 512 + h * DK + ch * 8) = o;
        }
      }
      {
        const int ch = ach;
#pragma unroll
        for (int ps = 0; ps < 2; ++ps)
#pragma unroll
          for (int wh = 0; wh < 2; ++wh) { const int row = (tid >> 4) + 32 * ps; const int dch = wh * 512 + h * DK + ch * 8;
            float a[8] = {0.f, 0.f, 0.f, 0.f, 0.f, 0.f, 0.f, 0.f};
#pragma unroll
            for (int wd = 0; wd < 3; ++wd) { const u32x4 x = rawa[ps][wh][wd]; const f32x4 w0 = *(const f32x4*)(cw + wd * 2048 + dch), w1 = *(const f32x4*)(cw + wd * 2048 + dch + 4);
              a[0] += lo_bf(x.x) * w0.x; a[1] += hi_bf(x.x) * w0.y; a[2] += lo_bf(x.y) * w0.z; a[3] += hi_bf(x.y) * w0.w;
              a[4] += lo_bf(x.z) * w1.x; a[5] += hi_bf(x.z) * w1.y; a[6] += lo_bf(x.w) * w1.z; a[7] += hi_bf(x.w) * w1.w; }
            float ss = 0.f;
#pragma unroll
            for (int e = 0; e < 8; ++e) { a[e] = siluf(a[e]); ss += a[e] * a[e]; }
            ss += __shfl_xor(ss, 1); ss += __shfl_xor(ss, 2); ss += __shfl_xor(ss, 4); ss += __shfl_xor(ss, 8);
            const float sc = rsqrtf(ss + EPS) * (wh == 0 ? QSCALE : 1.f);
            u32x4 o; o.x = pk2(a[0] * sc, a[1] * sc); o.y = pk2(a[2] * sc, a[3] * sc); o.z = pk2(a[4] * sc, a[5] * sc); o.w = pk2(a[6] * sc, a[7] * sc);
            *(u32x4*)(QKV + (size_t)(row0 + row) * LDQ + Q_DQ + dch) = o;
            *(LAS u32x4*)(lds + (wh ? PI_DK : PI_DQ) + off_b(row, ch)) = o; }
      }
      {
#pragma unroll
        for (int n = 0; n < 4; ++n) { const int idx = tid + 512 * n, row = idx >> 5, ch = idx & 31; const int dch = 1024 + h * DV + ch * 8;
          float a[8] = {0.f, 0.f, 0.f, 0.f, 0.f, 0.f, 0.f, 0.f};
#pragma unroll
          for (int wd = 0; wd < 3; ++wd) { const u32x4 x = rawb[n][wd]; const f32x4 w0 = *(const f32x4*)(cw + wd * 2048 + dch), w1 = *(const f32x4*)(cw + wd * 2048 + dch + 4);
            a[0] += lo_bf(x.x) * w0.x; a[1] += hi_bf(x.x) * w0.y; a[2] += lo_bf(x.y) * w0.z; a[3] += hi_bf(x.y) * w0.w;
            a[4] += lo_bf(x.z) * w1.x; a[5] += hi_bf(x.z) * w1.y; a[6] += lo_bf(x.w) * w1.z; a[7] += hi_bf(x.w) * w1.w; }
          u32x4 o; o.x = pk2(siluf(a[0]), siluf(a[1])); o.y = pk2(siluf(a[2]), siluf(a[3])); o.z = pk2(siluf(a[4]), siluf(a[5])); o.w = pk2(siluf(a[6]), siluf(a[7]));
          *(u32x4*)(QKV + (size_t)(row0 + row) * LDQ + Q_DQ + dch) = o; }
      }
      if (item + G < 768) P2_LOADS(item + G, tid);
      __syncthreads();
      {
        const int mi = (w >> 1) & 1, nj = w & 1;
        if (w < 4) {
          f32x16 a1 = zero16(), a2 = zero16();
#pragma unroll 2
          for (int ks = 0; ks < 8; ++ks) { a1 = MFMA32(lds_rd128(lds + PI_RQ, rowfrag_off(lane, mi, ks)), lds_rd128(lds + PI_RK, rowfrag_off(lane, nj, ks)), a1);
            a2 = MFMA32(lds_rd128(lds + PI_DQ, rowfrag_off(lane, mi, ks)), lds_rd128(lds + PI_DK, rowfrag_off(lane, nj, ks)), a2); }
          LAS float* m1 = (LAS float*)(lds + PM_QKR); LAS float* m2 = (LAS float*)(lds + PM_QKD);
#pragma unroll
          for (int reg = 0; reg < 16; ++reg) { const int o = (32 * mi + crow(reg, hl)) * 68 + 32 * nj + r32; m1[o] = a1[reg]; m2[o] = a2[reg]; }
        } else {
          f32x16 a1 = zero16();
#pragma unroll 2
          for (int ks = 0; ks < 8; ++ks) a1 = MFMA32(lds_rd128(lds + PI_DK, rowfrag_off(lane, mi, ks)), lds_rd128(lds + PI_DK, rowfrag_off(lane, nj, ks)), a1);
          LAS float* m1 = (LAS float*)(lds + PM_KKD);
#pragma unroll
          for (int reg = 0; reg < 16; ++reg) m1[(32 * mi + crow(reg, hl)) * 68 + 32 * nj + r32] = a1[reg];
        }
      }
      LAS float* vecs = (LAS float*)(lds + PV);
      if (tid < 64) {
        const float bf = ba_bf, bb = ba_bb, af = ba_af, ab = ba_ab;
        float xf = af, xb = ab;
#pragma unroll
        for (int o = 1; o < 64; o <<= 1) { const float yf = __shfl_up(xf, o), yb = __shfl_up(xb, o); if (lane >= o) { xf += yf; xb += yb; } }
        const float totf = __shfl(xf, 63), totb = __shfl(xb, 63);
        vecs[tid] = bf; vecs[64 + tid] = bb; vecs[128 + tid] = xf; vecs[192 + tid] = totb - xb + ab;
        if (tid == 0) { vecs[256] = totf; vecs[257] = totb; }
      }
      __syncthreads();
      unsigned char* blob_rt = MATS_RT + (size_t)((gc * 4 + h) * 2) * RT_BLOB; unsigned char* blob_dn = MATS_DN + (size_t)((gc * 4 + h) * 2) * DN_BLOB;
      const int lp = tid & 63, fi = tid >> 6, fmt = fi >> 2, fks = fi & 3, frow = 32 * fmt + (lp & 31), fhq = lp >> 5;
      {
        const LAS float* m1 = (const LAS float*)(lds + PM_QKR); const LAS float* m2 = (const LAS float*)(lds + PM_QKD);
        const float gfi = vecs[128 + frow], gbi = vecs[192 + frow];
        f32x8 pf, pb, df, db;
#pragma unroll
        for (int jj = 0; jj < 8; ++jj) { const int j = 16 * fks + 8 * (jj >> 2) + 4 * fhq + (jj & 3);
          const float x = m1[frow * 68 + j], y = m2[frow * 68 + j];
          pf[jj] = j <= frow ? x * __expf(lgf * (float)(frow - j)) : 0.f; pb[jj] = j >= frow ? x * __expf(lgb * (float)(j - frow)) : 0.f;
          df[jj] = j <= frow ? y * __expf(gfi - vecs[128 + j]) : 0.f; db[jj] = j >= frow ? y * __expf(gbi - vecs[192 + j]) : 0.f; }
        *(bf16x8*)(blob_rt + (fi * 64 + lp) * 16) = cvt8(pf); *(bf16x8*)(blob_rt + RT_BLOB + (fi * 64 + lp) * 16) = cvt8(pb);
        *(bf16x8*)(blob_dn + 8192 + (fi * 64 + lp) * 16) = cvt8(df); *(bf16x8*)(blob_dn + DN_BLOB + 8192 + (fi * 64 + lp) * 16) = cvt8(db);
        const LAS float* m3 = (const LAS float*)(lds + PM_KKD);
        float* lf = (float*)(LSCR + (size_t)((gc * 4 + h) * 2) * LSCR_STRIDE); float* lb = (float*)(LSCR + (size_t)((gc * 4 + h) * 2 + 1) * LSCR_STRIDE);
#pragma unroll
        for (int n = 0; n < 8; ++n) { const int e = tid + 512 * n, i = e >> 6, j = e & 63; const float kk = m3[i * 68 + j];
          lf[e] = j < i ? vecs[i] * kk * __expf(vecs[128 + i] - vecs[128 + j]) : 0.f;
          lb[e] = j > i ? vecs[64 + i] * kk * __expf(vecs[192 + i] - vecs[192 + j]) : 0.f; }
        if (tid < 64) { lf[4096 + tid] = vecs[tid]; lb[4096 + tid] = vecs[64 + tid]; }
        if (tid < 64) { const float gf = vecs[128 + tid], gb = vecs[192 + tid], glf = vecs[256], glb = vecs[257];
          float* vf = (float*)(blob_dn + 16384); float* vb = (float*)(blob_dn + DN_BLOB + 16384);
          vf[tid] = __expf(gf); vf[64 + tid] = __expf(glf - gf); vb[tid] = __expf(gb); vb[64 + tid] = __expf(glb - gb);
          if (tid == 0) { vf[128] = __expf(glf); vb[128] = __expf(glb); } }
      }
    }
  }
  GRID_BARRIER();

  {
    PHASE_TID();
    LAS unsigned short* tl = (LAS unsigned short*)(lds + wave * 16384);
    for (int it = gw; it < 1536; it += ngw) {
      int lane_o = lane_id(); asm volatile("" : "+v"(lane_o));
      const int ln = lane_o; const bool flip = it & 1; const int cl = flip ? 63 - ln : ln;
      const float* Lm = (const float*)(LSCR + (size_t)it * LSCR_STRIDE);
      float T[64], Lr[64];
#pragma unroll
      for (int i = 0; i < 64; ++i) Lr[i] = Lm[(flip ? 63 - i : i) * 64 + cl];
      const float bc = Lm[4096 + cl];
      __builtin_amdgcn_sched_barrier(0);
#pragma unroll
      for (int i = 0; i < 64; ++i) {
        const float lrow = Lr[i];
        float t0 = (ln == i) ? 1.f : 0.f, t1 = 0.f;
#pragma unroll
        for (int j = 0; j < i; ++j) { const float lj = __int_as_float(__builtin_amdgcn_readlane(__float_as_int(lrow), j)); if (j & 1) t1 -= lj * T[j]; else t0 -= lj * T[j]; }
        T[i] = t0 + t1;
        __builtin_amdgcn_sched_barrier(0);
      }
#pragma unroll
      for (int i = 0; i < 64; ++i) tl[(flip ? 63 - i : i) * 72 + cl] = (unsigned short)f2bf(T[i] * bc);
      asm volatile("s_waitcnt lgkmcnt(0)" ::: "memory");
      unsigned char* blob = MATS_DN + (size_t)it * DN_BLOB;
      const int frow = ln & 31, fhq = ln >> 5;
#pragma unroll
      for (int f = 0; f < 8; ++f) { const int mt = f >> 2, ks = f & 3;
        const LAS unsigned short* rp = tl + (32 * mt + frow) * 72 + 16 * ks + 4 * fhq;
        const u32x2 lo = *(const LAS u32x2*)rp, hi = *(const LAS u32x2*)(rp + 8);
        *(u32x4*)(blob + (f * 64 + ln) * 16) = (u32x4){lo.x, lo.y, hi.x, hi.y}; }
      asm volatile("s_waitcnt lgkmcnt(0)" ::: "memory");
    }
  }
  GRID_BARRIER();

  {
    PHASE_TID();
    const int w = wave, cb = (w & 3) * 32; const bool act = w < 4;
    LAS float* qdec = (LAS float*)(lds + SC_VEC);
    const int stride = bid < 128 ? 1000000 : (G - 128);
    for (int item = bid; item < 640; item += stride) {
      const int ci = item >> 1, half = item & 1;
      int lane_c = lane_id(); asm volatile("" : "+v"(lane_c));
      const int lane = lane_c, tid = (wave << 6) | lane, r32 = lane & 31, hl = lane >> 5;
      int type, sq, h, dir, chunk0, nsteps; bool lat;
      if (ci < 64) { lat = true; type = ci >> 5; sq = (ci >> 3) & 3; h = (ci >> 1) & 3; dir = ci & 1; chunk0 = 64 + 32 * sq; nsteps = 32; }
      else { const int c = ci - 64; lat = false; type = c >> 7; sq = (c >> 3) & 15; h = (c >> 1) & 3; dir = c & 1; chunk0 = 4 * sq; nsteps = 4; }
      f32x16 S[4];
      {
        const float* s0 = (type ? p.in[I_SDN] : p.in[I_SRET]) + ((((size_t)sq * 2 + dir) * NH + h) * DK) * DV + 128 * half + cb + r32;
        if (lat) {
#pragma unroll
          for (int mt = 0; mt < 4; ++mt)
#pragma unroll
            for (int reg = 0; reg < 16; ++reg) S[mt][reg] = s0[(size_t)(32 * mt + srow(reg, hl)) * DV];
        } else {
#pragma unroll
          for (int mt = 0; mt < 4; ++mt) S[mt] = zero16();
        }
      }
      const float lg = DECLG[dir * 4 + h];
      const float c64 = __expf(64.f * lg);
      __syncthreads();
      if (tid < 64) qdec[tid] = __expf(lg * (dir ? (float)(64 - tid) : (float)(tid + 1)));
      const StageOff soff = scan_stage_offsets(w, lane, (!type && dir) ? 1024u : (unsigned)(LDQ * 2));
      scan_stage(lds, 0, type, dir, h, chunk0 + (dir ? nsteps - 1 : 0), QKV, KBUF, MATS_RT, MATS_DN, half, w, soff);
      bf16_t* O = type ? (dir ? ODB : ODF) : (dir ? ORB : ORF);
      for (int s = 0; s < nsteps; ++s) {
        int ln = lane; asm volatile("" : "+v"(ln));
        const int r32s = ln & 31, hls = ln >> 5;
        const int buf = s & 1, gc = chunk0 + (dir ? nsteps - 1 - s : s);
        asm volatile("s_waitcnt vmcnt(0)" ::: "memory");
        __syncthreads();
        if (s + 1 < nsteps) scan_stage(lds, buf ^ 1, type, dir, h, chunk0 + (dir ? nsteps - 2 - s : s + 1), QKV, KBUF, MATS_RT, MATS_DN, half, w, soff);
        if (!act) continue;
        LAS unsigned char* B = lds + buf * SC_BUF;
        bf16_t* ob = O + (size_t)gc * 64 * D + h * DV + 128 * half + cb + r32s;
#define SB_ do { __builtin_amdgcn_sched_barrier(0); asm volatile("" : "+v"(ln)); } while (0)
#define STORE_O(acc) do { _Pragma("unroll") for (int mt_ = 0; mt_ < 2; ++mt_) _Pragma("unroll") for (int s2_ = 0; s2_ < 2; ++s2_) { const bf16x8 pk_ = pack8(acc[mt_], s2_); \
                          _Pragma("unroll") for (int j_ = 0; j_ < 8; ++j_) ob[(size_t)(32 * mt_ + crow(8 * s2_ + j_, ln >> 5)) * D] = (bf16_t)pk_[j_]; } } while (0)
#define LOAD_BV() do { _Pragma("unroll") for (int ks_ = 0; ks_ < 4; ++ks_) Bv[ks_] = lds_tr2(B + SC_V, vtr_off(ln, cb, ks_, 0), vtr_off(ln, cb, ks_, 1)); } while (0)
#define ROWS_AB(acc, IMG) do { bf16x8 f0_[2], f1_[2]; \
            f0_[0] = lds_rd128(B + (IMG), rowfrag_off(ln, 0, 0)); f0_[1] = lds_rd128(B + (IMG), rowfrag_off(ln, 1, 0)); \
            _Pragma("unroll") for (int ks_ = 0; ks_ < 8; ++ks_) { \
              if (ks_ + 1 < 8) { f1_[0] = lds_rd128(B + (IMG), rowfrag_off(ln, 0, ks_ + 1)); f1_[1] = lds_rd128(B + (IMG), rowfrag_off(ln, 1, ks_ + 1)); } \
              const bf16x8 sb_ = pack8(S[ks_ >> 1], ks_ & 1); \
              acc[0] = MFMA32(f0_[0], sb_, acc[0]); acc[1] = MFMA32(f0_[1], sb_, acc[1]); \
              f0_[0] = f1_[0]; f0_[1] = f1_[1]; } } while (0)
#define ROWS_T(acc, IMG) do { bf16x8 f0_[2], f1_[2];   \
            f0_[0] = lds_rd128(B + (IMG), rowfrag_off(ln, 0, 0)); f0_[1] = lds_rd128(B + (IMG), rowfrag_off(ln, 1, 0)); \
            _Pragma("unroll") for (int ks_ = 0; ks_ < 8; ++ks_) { \
              if (ks_ + 1 < 8) { f1_[0] = lds_rd128(B + (IMG), rowfrag_off(ln, 0, ks_ + 1)); f1_[1] = lds_rd128(B + (IMG), rowfrag_off(ln, 1, ks_ + 1)); } \
              const bf16x8 sb_ = pack8(S[ks_ >> 1], ks_ & 1); \
              acc[0] = MFMA32(sb_, f0_[0], acc[0]); acc[1] = MFMA32(sb_, f0_[1], acc[1]); \
              f0_[0] = f1_[0]; f0_[1] = f1_[1]; } } while (0)
#define STORE_OT(acc) do { _Pragma("unroll") for (int nt_ = 0; nt_ < 2; ++nt_) { bf16_t* orow_ = obt + (size_t)(32 * nt_) * D; \
            _Pragma("unroll") for (int g_ = 0; g_ < 4; ++g_) { u32x2 w_; w_.x = pk2(acc[nt_][4 * g_], acc[nt_][4 * g_ + 1]); w_.y = pk2(acc[nt_][4 * g_ + 2], acc[nt_][4 * g_ + 3]); \
              *(u32x2*)(orow_ + 8 * g_) = w_; } } } while (0)
#define S_UPDATE(X, SCL) do { bf16x8 g0_[4], g1_[4]; \
            _Pragma("unroll") for (int mt_ = 0; mt_ < 4; ++mt_) g0_[mt_] = lds_tr2(B + SC_K, ktr_off(ln, mt_, 0, 0), ktr_off(ln, mt_, 0, 1)); \
            _Pragma("unroll") for (int mt_ = 0; mt_ < 4; ++mt_) S[mt_] = S[mt_] * (SCL); \
            _Pragma("unroll") for (int ks_ = 0; ks_ < 4; ++ks_) { \
              if (ks_ + 1 < 4) { _Pragma("unroll") for (int mt_ = 0; mt_ < 4; ++mt_) g1_[mt_] = lds_tr2(B + SC_K, ktr_off(ln, mt_, ks_ + 1, 0), ktr_off(ln, mt_, ks_ + 1, 1)); } \
              _Pragma("unroll") for (int mt_ = 0; mt_ < 4; ++mt_) S[mt_] = MFMA32(g0_[mt_], X[ks_], S[mt_]); \
              _Pragma("unroll") for (int mt_ = 0; mt_ < 4; ++mt_) g0_[mt_] = g1_[mt_]; } } while (0)
        bf16x8 Bv[4];
        if (type) {
          const LAS float* eg = (const LAS float*)(B + SC_M + 16384); const LAS float* cgv = eg + 64; const float egl = eg[128];
          bf16x8 Br[4];
          { f32x16 ra[2]; ra[0] = zero16(); ra[1] = zero16();
            ROWS_AB(ra, SC_K);
#pragma unroll
            for (int mt = 0; mt < 2; ++mt) { rowscale(ra[mt], eg + 32 * mt, ln >> 5, -1.f); Br[2 * mt] = pack8(ra[mt], 0); Br[2 * mt + 1] = pack8(ra[mt], 1); } }
          SB_;
          LOAD_BV();
          bf16x8 tf[8];
#pragma unroll
          for (int i = 0; i < 8; ++i) tf[i] = lds_rd128(B + SC_M, i * 1024 + ln * 16);
          f32x16 vn[2]; vn[0] = zero16(); vn[1] = zero16();
#pragma unroll
          for (int ks = 0; ks < 4; ++ks)
#pragma unroll
            for (int mt = 0; mt < 2; ++mt) { vn[mt] = MFMA32(tf[mt * 4 + ks], Bv[ks], vn[mt]); vn[mt] = MFMA32(tf[mt * 4 + ks], Br[ks], vn[mt]); }
          SB_;
          bf16x8 Bn[4], Bc[4];
#pragma unroll
          for (int mt = 0; mt < 2; ++mt) { Bn[2 * mt] = pack8(vn[mt], 0); Bn[2 * mt + 1] = pack8(vn[mt], 1); rowscale(vn[mt], cgv + 32 * mt, ln >> 5, 1.f); Bc[2 * mt] = pack8(vn[mt], 0); Bc[2 * mt + 1] = pack8(vn[mt], 1); }
          SB_;
          f32x16 oa[2]; oa[0] = zero16(); oa[1] = zero16();
          ROWS_T(oa, SC_Q);
          SB_;
#pragma unroll
          for (int i = 0; i < 8; ++i) tf[i] = lds_rd128(B + SC_M, 8192 + i * 1024 + ln * 16);
#pragma unroll
          for (int nt = 0; nt < 2; ++nt) oa[nt] = oa[nt] * eg[32 * nt + (ln & 31)];
#pragma unroll
          for (int ks = 0; ks < 4; ++ks)
#pragma unroll
            for (int nt = 0; nt < 2; ++nt) oa[nt] = MFMA32(Bn[ks], tf[nt * 4 + ks], oa[nt]);
          SB_;
          { bf16_t* obt = O + ((size_t)gc * 64 + (ln & 31)) * D + h * DV + 128 * half + cb + 4 * (ln >> 5); STORE_OT(oa); }
          SB_;
          S_UPDATE(Bc, egl);
          SB_;
        } else {
          f32x16 oa[2]; oa[0] = zero16(); oa[1] = zero16();
          ROWS_T(oa, SC_Q);
          SB_;
          LOAD_BV();
          bf16x8 tf[8];
#pragma unroll
          for (int i = 0; i < 8; ++i) tf[i] = lds_rd128(B + SC_M, i * 1024 + ln * 16);
#pragma unroll
          for (int nt = 0; nt < 2; ++nt) oa[nt] = oa[nt] * qdec[32 * nt + (ln & 31)];
#pragma unroll
          for (int ks = 0; ks < 4; ++ks)
#pragma unroll
            for (int nt = 0; nt < 2; ++nt) oa[nt] = MFMA32(Bv[ks], tf[nt * 4 + ks], oa[nt]);
          SB_;
          { bf16_t* obt = O + ((size_t)gc * 64 + (ln & 31)) * D + h * DV + 128 * half + cb + 4 * (ln >> 5); STORE_OT(oa); }
          SB_;
          S_UPDATE(Bv, c64);
          SB_;
        }
#undef SB_
#undef STORE_O
#undef LOAD_BV
#undef ROWS_AB
#undef ROWS_T
#undef STORE_OT
#undef S_UPDATE
      }
      if (!lat && act) {
        int ln3 = lane_id(); asm volatile("" : "+v"(ln3)); const int hl3 = ln3 >> 5;
        float* so = (type ? NS_DN : NS_RET) + ((((size_t)sq * 2 + dir) * NH + h) * DK) * DV + 128 * half + cb + (ln3 & 31);
#pragma unroll
        for (int mt = 0; mt < 4; ++mt)
#pragma unroll
          for (int reg = 0; reg < 16; ++reg) so[(size_t)(32 * mt + srow(reg, hl3)) * DV] = S[mt][reg];
      }
    }
  }
  GRID_BARRIER();

  bf16_t* GATES = QKV;
  {
    pg8::Gemm g{HB, WGATE, MTOT, 4096, D}; pg8::StaticOrder S; S.init(MTOT, 4096, G, bid);
    pg8::EpiBf16Act<1> E{GATES, LDG};
    pg8::gemm_phase<pg8::EpiBf16Act<1>, pg8::StaticOrder, true, true>(lds, g, S, E, wave);
  }
  GRID_BARRIER();

  bf16_t* AR = (bf16_t*)(ws + WS_AR); bf16_t* AD = (bf16_t*)(ws + WS_AD);
  {
    PHASE_TID();
    for (int m = gw; m < MTOT; m += ngw) {
      u32x2 rf[4], rb[4], df[4], db[4], gr[4], gd[4]; f32x4 gw4[4];
#pragma unroll
      for (int h = 0; h < 4; ++h) { const size_t base = (size_t)m * D + h * DV + 4 * lane;
        rf[h] = *(const u32x2*)(ORF + base); rb[h] = *(const u32x2*)(ORB + base); df[h] = *(const u32x2*)(ODF + base); db[h] = *(const u32x2*)(ODB + base);
        gr[h] = *(const u32x2*)(GATES + (size_t)m * LDG + G_RG + h * DV + 4 * lane); gd[h] = *(const u32x2*)(GATES + (size_t)m * LDG + G_DZ + h * DV + 4 * lane);
        gw4[h] = *(const f32x4*)(p.in[I_GNW] + h * DV + 4 * lane); }
      const f32x4 dw4 = *(const f32x4*)(p.in[I_DNW] + 4 * lane);
      float v[4][4], u[4][4], mu[4], rs[4], rd[4];
#pragma unroll
      for (int h = 0; h < 4; ++h) { v[h][0] = lo_bf(rf[h].x) + lo_bf(rb[h].x); v[h][1] = hi_bf(rf[h].x) + hi_bf(rb[h].x); v[h][2] = lo_bf(rf[h].y) + lo_bf(rb[h].y); v[h][3] = hi_bf(rf[h].y) + hi_bf(rb[h].y);
        u[h][0] = lo_bf(df[h].x) + lo_bf(db[h].x); u[h][1] = hi_bf(df[h].x) + hi_bf(db[h].x); u[h][2] = lo_bf(df[h].y) + lo_bf(db[h].y); u[h][3] = hi_bf(df[h].y) + hi_bf(db[h].y);
        mu[h] = (v[h][0] + v[h][1]) + (v[h][2] + v[h][3]); rd[h] = (u[h][0] * u[h][0] + u[h][1] * u[h][1]) + (u[h][2] * u[h][2] + u[h][3] * u[h][3]); }
#pragma unroll
      for (int o = 1; o < 64; o <<= 1) {
#pragma unroll
        for (int h = 0; h < 4; ++h) { mu[h] += __shfl_xor(mu[h], o); rd[h] += __shfl_xor(rd[h], o); } }
#pragma unroll
      for (int h = 0; h < 4; ++h) { mu[h] *= (1.f / DV); float q = 0.f;
#pragma unroll
        for (int e = 0; e < 4; ++e) { v[h][e] -= mu[h]; q += v[h][e] * v[h][e]; }
        rs[h] = q; }
#pragma unroll
      for (int o = 1; o < 64; o <<= 1) {
#pragma unroll
        for (int h = 0; h < 4; ++h) rs[h] += __shfl_xor(rs[h], o); }
#pragma unroll
      for (int h = 0; h < 4; ++h) { const size_t base = (size_t)m * D + h * DV + 4 * lane;
        const float r1 = rsqrtf(rs[h] * (1.f / DV) + EPS), r2 = rsqrtf(rd[h] * (1.f / DV) + EPS);
        u32x2 o; o.x = pk2(lo_bf(gr[h].x) * (v[h][0] * r1 * gw4[h].x), hi_bf(gr[h].x) * (v[h][1] * r1 * gw4[h].y)); o.y = pk2(lo_bf(gr[h].y) * (v[h][2] * r1 * gw4[h].z), hi_bf(gr[h].y) * (v[h][3] * r1 * gw4[h].w));
        *(u32x2*)(AR + base) = o;
        o.x = pk2(u[h][0] * r2 * dw4.x * lo_bf(gd[h].x), u[h][1] * r2 * dw4.y * hi_bf(gd[h].x)); o.y = pk2(u[h][2] * r2 * dw4.z * lo_bf(gd[h].y), u[h][3] * r2 * dw4.w * hi_bf(gd[h].y));
        *(u32x2*)(AD + base) = o; }
    }
  }
  GRID_BARRIER();

  bf16_t* T1 = HB;
  {
    pg8::Gemm g{AR, WRO, MTOT, D, D}; pg8::StaticOrder S; S.init(MTOT, D, G, bid);
    pg8::EpiGateMul E{T1, D, GATES + G_GR, LDG, nullptr};
    pg8::gemm_phase<pg8::EpiGateMul, pg8::StaticOrder, true, true>(lds, g, S, E, wave);
  }
  GRID_BARRIER();
  bf16_t* MERGED = (bf16_t*)(ws + WS_MERGED);
  {
    pg8::Gemm g{AD, WDO, MTOT, D, D}; pg8::StaticOrder S; S.init(MTOT, D, G, bid);
    pg8::EpiGateMul E{MERGED, D, GATES + G_GD, LDG, T1};
    pg8::gemm_phase<pg8::EpiGateMul, pg8::StaticOrder, true, true>(lds, g, S, E, wave);
  }
  GRID_BARRIER();
  bf16_t* M1 = (bf16_t*)(ws + WS_O);
  {
    pg8::Gemm g{MERGED, WOUT, MTOT, D, D}; pg8::StaticOrder S; S.init(MTOT, D, G, bid);
    pg8::EpiBf16Act<0> E{M1, D};
    pg8::gemm_phase<pg8::EpiBf16Act<0>, pg8::StaticOrder, true, true>(lds, g, S, E, wave);
  }
  GRID_BARRIER();

  bf16_t* WF1 = (bf16_t*)(ws + WS_WF1); bf16_t* WF2 = (bf16_t*)(ws + WS_WF2);
  {
    PHASE_TID();
    LAS float* scr = (LAS float*)(lds + wave * 16384);
    transpose_matrix(p.in[I_WF1], 2 * DFF, D, 2 * DFF, WF1, [](int n) { const int pn = n >> 8, w = n & 255; return w < 128 ? 128 * pn + w : DFF + 128 * pn + (w - 128); }, scr, gw, ngw, lane);
    transpose_matrix(p.in[I_WF2], D, DFF, D, WF2, [](int n) { return n; }, scr, gw, ngw, lane);
    const float* nw1 = p.in[I_NORMW] + D; const float* nw2 = p.in[I_NORMW] + 2 * D;
    for (int m0 = gw; m0 < MTOT; m0 += 2 * ngw) {
      f32x4 v[2][4], xv[2][4], g1v[2][4]; float s[2] = {0.f, 0.f};
#pragma unroll
      for (int u = 0; u < 2; ++u) { const int m = (m0 + u * ngw < MTOT) ? m0 + u * ngw : m0; const float* xr = xrow(p, m); const float* md = MOD + (size_t)cond_of_row(m) * 6 * D; const bf16_t* mr = M1 + (size_t)m * D;
#pragma unroll
        for (int j = 0; j < 4; ++j) { const int c0 = 4 * lane + 256 * j; { const u32x2 mw = *(const u32x2*)(mr + c0); v[u][j] = (f32x4){lo_bf(mw.x), hi_bf(mw.x), lo_bf(mw.y), hi_bf(mw.y)}; } xv[u][j] = *(const f32x4*)(xr + c0); g1v[u][j] = *(const f32x4*)(md + 2 * D + c0); } }
#pragma unroll
      for (int u = 0; u < 2; ++u)
#pragma unroll
        for (int j = 0; j < 4; ++j) s[u] += (v[u][j].x * v[u][j].x + v[u][j].y * v[u][j].y) + (v[u][j].z * v[u][j].z + v[u][j].w * v[u][j].w);
#pragma unroll
      for (int o = 1; o < 64; o <<= 1) { s[0] += __shfl_xor(s[0], o); s[1] += __shfl_xor(s[1], o); }
      float s2[2] = {0.f, 0.f};
#pragma unroll
      for (int u = 0; u < 2; ++u) { const int m = m0 + u * ngw; const float r = rsqrtf(s[u] * (1.f / D) + EPS);
#pragma unroll
        for (int j = 0; j < 4; ++j) { const int c0 = 4 * lane + 256 * j;
          v[u][j] = xv[u][j] + g1v[u][j] * (v[u][j] * r * *(const f32x4*)(nw1 + c0));
          if (m < MTOT) *(f32x4*)(p.out + (size_t)m * D + c0) = v[u][j];
          s2[u] += (v[u][j].x * v[u][j].x + v[u][j].y * v[u][j].y) + (v[u][j].z * v[u][j].z + v[u][j].w * v[u][j].w); } }
#pragma unroll
      for (int o = 1; o < 64; o <<= 1) { s2[0] += __shfl_xor(s2[0], o); s2[1] += __shfl_xor(s2[1], o); }
#pragma unroll
      for (int u = 0; u < 2; ++u) { const int m = m0 + u * ngw; if (m >= MTOT) continue; const float* md = MOD + (size_t)cond_of_row(m) * 6 * D; const float r2 = rsqrtf(s2[u] * (1.f / D) + EPS);
#pragma unroll
        for (int j = 0; j < 4; ++j) { const int c0 = 4 * lane + 256 * j;
          const f32x4 h = v[u][j] * r2 * *(const f32x4*)(nw2 + c0) * (*(const f32x4*)(md + 4 * D + c0) + 1.f) + *(const f32x4*)(md + 3 * D + c0);
          u32x2 o; o.x = pk2(h.x, h.y); o.y = pk2(h.z, h.w); *(u32x2*)(HB + (size_t)m * D + c0) = o; } }
    }
  }
  GRID_BARRIER();

  bf16_t* ACT = QKV;
  {
    pg8::Gemm g{HB, WF1, MTOT, 2 * DFF, D}; pg8::StaticOrder S; S.init(MTOT, 2 * DFF, G, bid);
    pg8::EpiSwiGLU E{ACT, DFF};
    pg8::gemm_phase<pg8::EpiSwiGLU, pg8::StaticOrder, true, true>(lds, g, S, E, wave);
  }
  GRID_BARRIER();
  bf16_t* F = (bf16_t*)(ws + WS_O);
  {
    pg8::Gemm g{ACT, WF2, MTOT, D, DFF}; pg8::StaticOrder S; S.init(MTOT, D, G, bid);
    pg8::EpiBf16Act<0> E{F, D};
    pg8::gemm_phase<pg8::EpiBf16Act<0>, pg8::StaticOrder, true, true>(lds, g, S, E, wave);
  }
  GRID_BARRIER();
  {
    PHASE_TID();
    const float* nw3 = p.in[I_NORMW] + 3 * D;
    for (int m0 = gw; m0 < MTOT; m0 += 2 * ngw) {
      f32x4 v[2][4], xv[2][4], gv[2][4]; float s[2] = {0.f, 0.f};
#pragma unroll
      for (int u = 0; u < 2; ++u) { const int m = (m0 + u * ngw < MTOT) ? m0 + u * ngw : m0; const float* md = MOD + (size_t)cond_of_row(m) * 6 * D; const bf16_t* fr = F + (size_t)m * D; const float* orow = p.out + (size_t)m * D;
#pragma unroll
        for (int j = 0; j < 4; ++j) { const int c0 = 4 * lane + 256 * j; { const u32x2 fw = *(const u32x2*)(fr + c0); v[u][j] = (f32x4){lo_bf(fw.x), hi_bf(fw.x), lo_bf(fw.y), hi_bf(fw.y)}; } xv[u][j] = *(const f32x4*)(orow + c0); gv[u][j] = *(const f32x4*)(md + 5 * D + c0); } }
#pragma unroll
      for (int u = 0; u < 2; ++u)
#pragma unroll
        for (int j = 0; j < 4; ++j) s[u] += (v[u][j].x * v[u][j].x + v[u][j].y * v[u][j].y) + (v[u][j].z * v[u][j].z + v[u][j].w * v[u][j].w);
#pragma unroll
      for (int o = 1; o < 64; o <<= 1) { s[0] += __shfl_xor(s[0], o); s[1] += __shfl_xor(s[1], o); }
#pragma unroll
      for (int u = 0; u < 2; ++u) { const int m = m0 + u * ngw; if (m >= MTOT) continue; const float r = rsqrtf(s[u] * (1.f / D) + EPS); float* orow = p.out + (size_t)m * D;
#pragma unroll
        for (int j = 0; j < 4; ++j) { const int c0 = 4 * lane + 256 * j; *(f32x4*)(orow + c0) = xv[u][j] + gv[u][j] * (v[u][j] * r * *(const f32x4*)(nw3 + c0)); } }
    }
  }
}

extern "C" void kernel_launch(void* const* d_in, const int* in_sizes, int n_in, void* d_out, int out_size, void* d_ws, size_t ws_size, hipStream_t stream) {
  static int grid_blocks = 0;
  if (!grid_blocks) {
    int dev = 0, cus = 0, per_cu = 0;
    (void)hipGetDevice(&dev);
    (void)hipDeviceGetAttribute(&cus, hipDeviceAttributeMultiprocessorCount, dev);
    (void)hipFuncSetAttribute((const void*)fwd_megakernel, hipFuncAttributeMaxDynamicSharedMemorySize, LDS_BYTES);
    (void)hipOccupancyMaxActiveBlocksPerMultiprocessor(&per_cu, (const void*)fwd_megakernel, NTHREADS, LDS_BYTES);
    if (per_cu < 1) per_cu = 1;
    grid_blocks = cus * per_cu;
    if (n_in != 21 || ws_size < WS_END) fprintf(stderr, "kernel_launch: unexpected n_in %d / ws_size %zu\n", n_in, ws_size);
    fprintf(stderr, "kernel_launch: cus %d per_cu %d grid %d ws %zu out %d\n", cus, per_cu, grid_blocks, ws_size, out_size);
  }
  (void)hipMemsetAsync((unsigned char*)d_ws + WS_BAR, 0, 16384, stream);
  Params p{};
  for (int i = 0; i < 21; ++i) p.in[i] = (const float*)d_in[i];
  p.out = (float*)d_out; p.ws = (unsigned char*)d_ws;
  void* args[] = {&p};
  hipError_t e = hipLaunchCooperativeKernel((const void*)fwd_megakernel, dim3(grid_blocks), dim3(NTHREADS), args, LDS_BYTES, stream);
  if (e != hipSuccess) fprintf(stderr, "cooperative launch failed: %s (grid %d)\n", hipGetErrorString(e), grid_blocks);
}
```

```cpp
#include <hip/hip_runtime.h>
#include <hip/hip_cooperative_groups.h>
#include <cstdio>
#include <cstdint>
namespace cg = cooperative_groups;

#define LAS __attribute__((address_space(3)))
typedef unsigned short bf16_t;
typedef short bf16x8 __attribute__((ext_vector_type(8)));
typedef float f32x4 __attribute__((ext_vector_type(4)));
typedef float f32x2 __attribute__((ext_vector_type(2)));
typedef unsigned u32x4 __attribute__((ext_vector_type(4)));
typedef unsigned u32x2 __attribute__((ext_vector_type(2)));

constexpr int D = 1024, MCTX = 4096, MLAT = 8192, MTOT = 12288, LCTX = 256, LLAT = 2048, NCTX = 16, NLAT = 4;
constexpr int NH = 4, DK = 128, DV = 256, DFF = 2816, INC = 8208;
constexpr float EPS = 1e-6f;
constexpr float QSCALE = 0.08838834764831845f;
constexpr int NTHREADS = 512, NWAVES = 8;
constexpr int LDS_BYTES = 135168;
constexpr int Q_RQ = 0, Q_RK = 512, Q_RV = 1024, Q_DQ = 2048, Q_DK = 2560, Q_DV = 3072, LDQ = 4096;
constexpr int G_RG = 0, G_DZ = 1024, G_GR = 2048, G_GD = 3072, LDG = 4096;
constexpr int C_RQ = 0, C_RG = 2048, C_DQ = 3072, C_DZ = 5120, C_DB = 6144, C_GR = 6160;

constexpr size_t MiB = 1u << 20;
constexpr size_t WS_MOD = 0;
constexpr size_t WS_ROPE = 128 * 1024;
constexpr size_t WS_BAR = 1152 * 1024;
constexpr size_t WS_BA = 1280 * 1024;
constexpr size_t WS_WQKV = 2 * MiB;
constexpr size_t WS_WGATE = 10 * MiB;
constexpr size_t WS_WRO = 18 * MiB, WS_WDO = 20 * MiB, WS_WOUT = 22 * MiB;
constexpr size_t WS_H = 24 * MiB;
constexpr size_t WS_QKV = 48 * MiB;
constexpr size_t WS_MATS_DN = 144 * MiB;
constexpr size_t WS_MATS_RT = 170 * MiB;
constexpr size_t WS_KB = 182 * MiB;
constexpr size_t WS_HALO = 194 * MiB;
constexpr size_t WS_O = 196 * MiB;
constexpr size_t WS_END = 244 * MiB;
constexpr size_t WS_AR = 144 * MiB, WS_AD = 168 * MiB, WS_MERGED = 144 * MiB;
constexpr size_t WS_WF1 = 144 * MiB, WS_WF2 = 155 * MiB;

struct Params {
  const float* in[21];
  float* out;
  unsigned char* ws;
};
enum { I_XP = 0, I_XS, I_C, I_SRET, I_SDN, I_CCTX, I_WMOD, I_BMOD, I_NORMW, I_WIN, I_CONVW, I_DECAY, I_GNW, I_ALOG, I_DTB, I_DNW, I_WRO, I_WDO, I_WOUT, I_WF1, I_WF2 };

__device__ __forceinline__ float bf2f(unsigned short b) { return __uint_as_float((unsigned)b << 16); }
__device__ __forceinline__ unsigned f2bf(float f) { unsigned u = __float_as_uint(f); return (u + 0x7fffu + ((u >> 16) & 1u)) >> 16; }
typedef __bf16 bfx2_t __attribute__((ext_vector_type(2)));
__device__ __forceinline__ unsigned pk2(float lo, float hi) { const f32x2 t = {lo, hi}; return __builtin_bit_cast(unsigned, __builtin_convertvector(t, bfx2_t)); }
__device__ __forceinline__ unsigned cvt_pk_bf16(float lo, float hi) { return pk2(lo, hi); }

__device__ __forceinline__ float lo_bf(unsigned w) { return __uint_as_float(w << 16); }
__device__ __forceinline__ float hi_bf(unsigned w) { return __uint_as_float(w & 0xffff0000u); }
__device__ __forceinline__ float siluf(float x) { return x * __builtin_amdgcn_rcpf(1.f + __expf(-x)); }
__device__ __forceinline__ float sigmf(float x) { return __builtin_amdgcn_rcpf(1.f + __expf(-x)); }
__device__ __forceinline__ float softplusf(float x) { return x > 20.f ? x : log1pf(expf(x)); }
__device__ __forceinline__ float wave_sum(float v) {
#pragma unroll
  for (int o = 1; o < 64; o <<= 1) v += __shfl_xor(v, o);
  return v;
}
__device__ __forceinline__ int lane_id() { return (int)__builtin_amdgcn_mbcnt_hi(~0u, __builtin_amdgcn_mbcnt_lo(~0u, 0u)); }
__device__ __forceinline__ int cond_of_row(int m) { return m < MCTX ? 0 : 1 + (m - MCTX) / LLAT; }
__device__ __forceinline__ const float* xrow(const Params& p, int m) { return m < MCTX ? p.in[I_XP] + (size_t)m * D : p.in[I_XS] + (size_t)(m - MCTX) * D; }


__device__ __forceinline__ int lane_id();
#define XB_TMO      128
#define XB_XCNT(j)  (256  + 64 * (j))
#define XB_XSUB(j)  (1280 + 64 * (j))
#define XB_XGEN(j)  (2304 + 64 * (j))
#define XB_TOP      3328
#define XB_TOPGEN   3392
#define XCD_BAR_WORDS 3456
#define XB_SPIN_CAP (1u << 18)
__device__ __forceinline__ unsigned xb_ld(unsigned* p)              { return __hip_atomic_load(p, __ATOMIC_RELAXED, __HIP_MEMORY_SCOPE_AGENT); }
__device__ __forceinline__ unsigned xb_add(unsigned* p, unsigned v) { return __hip_atomic_fetch_add(p, v, __ATOMIC_RELAXED, __HIP_MEMORY_SCOPE_AGENT); }
__device__ __forceinline__ unsigned xb_xcc_id() { return (unsigned)__builtin_amdgcn_s_getreg((3 << 11) | 20) & 0xFu; }
#define XB_SPIN(cond, bar) do { unsigned _sp = 0; while (cond) { __builtin_amdgcn_s_sleep(1); \
    if ((++_sp & 255u) == 0u) { if (xb_ld(&(bar)[XB_TMO])) break; if (_sp > XB_SPIN_CAP) { atomicAdd(&(bar)[XB_TMO], 1u); break; } } } } while (0)
struct XcdBarrier { unsigned* bar; unsigned x; volatile LAS unsigned* st; };
__device__ __forceinline__ XcdBarrier xcd_barrier_post(unsigned* bar, volatile LAS unsigned* st) {
  XcdBarrier b; b.bar = bar; b.x = xb_xcc_id(); b.st = st;
  if (threadIdx.x == 0) (void)xb_add(&bar[XB_XCNT(b.x)], 1u);
  return b;
}
__device__ __forceinline__ void xcd_barrier_complete(unsigned* bar, unsigned x, unsigned& nloc, unsigned& nx) {
  const unsigned G = gridDim.x * gridDim.y * gridDim.z;
  unsigned sum, cnt, mine, sp = 0u;
  for (;;) {
    sum = 0u; cnt = 0u; mine = 0u;
#pragma unroll
    for (unsigned j = 0; j < 16; ++j) { const unsigned c = xb_ld(&bar[XB_XCNT(j)]); sum += c; cnt += (c > 0u) ? 1u : 0u; mine = (j == x) ? c : mine; }
    if (sum == G) break;
    __builtin_amdgcn_s_sleep(1);
    if ((++sp & 255u) == 0u) { if (xb_ld(&bar[XB_TMO])) break; if (sp > XB_SPIN_CAP) { atomicAdd(&bar[XB_TMO], 1u); break; } }
  }
  nloc = mine > 0u ? mine : 1u; nx = cnt > 0u ? cnt : 1u;
}
__device__ __forceinline__ void xcd_barrier(const XcdBarrier& b, const int wave) {
  asm volatile("s_waitcnt vmcnt(0)" ::: "memory");
  __syncthreads();
  if (wave == 0 && lane_id() == 0) {
    unsigned* bar = b.bar;
    __builtin_amdgcn_s_waitcnt(0);
    unsigned nloc = b.st[0], nx = b.st[1];
    if (nloc == 0u) { xcd_barrier_complete(bar, b.x, nloc, nx); b.st[0] = nloc; b.st[1] = nx; }
    const unsigned old = xb_add(&bar[XB_XSUB(b.x)], 1u);
    const unsigned gen = old / nloc;
    if (old + 1u == (gen + 1u) * nloc) {
      __builtin_amdgcn_fence(__ATOMIC_RELEASE, "agent");
      asm volatile("s_waitcnt vmcnt(0)" ::: "memory");
      const unsigned og = xb_add(&bar[XB_TOP], 1u);
      const unsigned tg = og / nx;
      if (og + 1u == (tg + 1u) * nx) xb_add(&bar[XB_TOPGEN], 1u);
      else XB_SPIN(xb_ld(&bar[XB_TOPGEN]) == tg, bar);
      __builtin_amdgcn_fence(__ATOMIC_ACQUIRE, "agent");
      xb_add(&bar[XB_XGEN(b.x)], 1u);
      asm volatile("s_waitcnt vmcnt(0)" ::: "memory");
    } else {
      XB_SPIN(xb_ld(&bar[XB_XGEN(b.x)]) == gen, bar);
      __builtin_amdgcn_fence(__ATOMIC_ACQUIRE, "agent");
      asm volatile("s_waitcnt vmcnt(0)" ::: "memory");
    }
  }
  __syncthreads();
}

namespace pg8 {
constexpr int BM = 256, BK = 64, HALF = 128, HTB = HALF * BK * 2, STAGE_BYTES = 8 * HTB, NXCD = 8, WGM = 8;
__host__ __device__ __forceinline__ int lds_byte(int r, int c) { const int st = (r >> 4) * 2 + (c >> 5), rr = r & 15, cc = c & 31, ob = rr * 64 + cc * 2; return st * 1024 + (ob ^ (((ob >> 9) & 1) << 5)); }
__host__ __device__ __forceinline__ void stage_rc(int b, int& R, int& C) { const int st = b / 1024, sb = b % 1024, swz = sb ^ (((sb >> 9) & 1) << 5); R = (st >> 1) * 16 + swz / 64; C = (st & 1) * 32 + (swz % 64) / 2; }
__host__ __device__ __forceinline__ int perm32(int rho) { const int n = rho >> 4, i = rho & 15; return 8 * (i >> 2) + 4 * n + (i & 3); }
struct Unit { int pm, pn; };
struct Gemm { const bf16_t* A; const bf16_t* Bt; int M, N, K; };
struct StaticOrder {
  int nM, nN, nwg, G, c;
  __host__ __device__ void init(int M, int N, int G_, int c_) { nM = M / BM; nN = N / BM; nwg = nM * nN; G = G_; c = c_; }
  __host__ __device__ bool next(int i, Unit& u) const {
    const long L = (long)i * G + c; if (L >= nwg) return false;
    int wgid = (int)L; { const int q = nwg / NXCD, r = nwg % NXCD, xcd = wgid % NXCD, off = wgid / NXCD; wgid = (xcd < r ? xcd * (q + 1) : r * (q + 1) + (xcd - r) * q) + off; }
    const int nig = WGM * nN, gid = wgid / nig, fm = gid * WGM, gsz = (nM - fm) < WGM ? (nM - fm) : WGM;
    u.pm = fm + ((wgid % nig) % gsz); u.pn = (wgid % nig) / gsz; return true;
  }
  __device__ __forceinline__ void a_ready(const Unit&) const {}
  __device__ __forceinline__ void done(const Unit&) const {}
};

template <int MODE  > struct EpiBf16Act {
  static constexpr bool PERM = true, AFTER_DRAIN = false;
  bf16_t* O; int ldc;
  __device__ __forceinline__ void operator()(const f32x4 (&acc)[2][2][4][2], const Unit& u, int wr, int wc, int fr, int fq) const {
    const int row0 = u.pm * BM + wr * 64 + fr, col0 = u.pn * BM + wc * 32 + 8 * fq;
    const bool sg = u.pn >= 8;
#pragma unroll
    for (int ai = 0; ai < 2; ++ai)
#pragma unroll
      for (int m = 0; m < 4; ++m) { bf16_t* rowp = O + (size_t)(row0 + ai * HALF + m * 16) * ldc + col0;
#pragma unroll
        for (int bj = 0; bj < 2; ++bj) { f32x4 v0 = acc[ai][bj][m][0], v1 = acc[ai][bj][m][1];
          if (MODE == 1) {
#pragma unroll
            for (int i = 0; i < 4; ++i) { const float s0 = __builtin_amdgcn_rcpf(1.f + __expf(-v0[i])), s1 = __builtin_amdgcn_rcpf(1.f + __expf(-v1[i]));
              v0[i] = sg ? s0 : v0[i] * s0; v1[i] = sg ? s1 : v1[i] * s1; } }
          u32x4 w; w.x = cvt_pk_bf16(v0[0], v0[1]); w.y = cvt_pk_bf16(v0[2], v0[3]); w.z = cvt_pk_bf16(v1[0], v1[1]); w.w = cvt_pk_bf16(v1[2], v1[3]);
          *(u32x4*)(rowp + bj * HALF) = w; } }
  }
};
struct EpiQKV {
  static constexpr bool PERM = true, AFTER_DRAIN = false;
  bf16_t* O; int ldc; bf16_t* HALO;
  __device__ __forceinline__ void operator()(const f32x4 (&acc)[2][2][4][2], const Unit& u, int wr, int wc, int fr, int fq) const {
    const int row0 = u.pm * BM + wr * 64 + fr, col0 = u.pn * BM + wc * 32 + 8 * fq;
#pragma unroll
    for (int ai = 0; ai < 2; ++ai)
#pragma unroll
      for (int m = 0; m < 4; ++m) { const int row = row0 + ai * HALF + m * 16; bf16_t* rowp = O + (size_t)row * ldc + col0;
#pragma unroll
        for (int bj = 0; bj < 2; ++bj) { const f32x4 v0 = acc[ai][bj][m][0], v1 = acc[ai][bj][m][1];
          u32x4 w; w.x = cvt_pk_bf16(v0[0], v0[1]); w.y = cvt_pk_bf16(v0[2], v0[3]); w.z = cvt_pk_bf16(v1[0], v1[1]); w.w = cvt_pk_bf16(v1[2], v1[3]);
          *(u32x4*)(rowp + bj * HALF) = w;
          if (u.pn >= 8 && ((m == 0 && fr == 0) || (m == 3 && fr == 15)))
            *(u32x4*)(HALO + ((size_t)(row >> 6) * 2 + (m == 3 ? 1 : 0)) * 2048 + (col0 - 2048) + bj * HALF) = w; } }
  }
};
struct EpiGateMul {
  static constexpr bool PERM = true, AFTER_DRAIN = false;
  bf16_t* O; int ldc; const bf16_t* G; int ldg; const bf16_t* Add;
  __device__ __forceinline__ void operator()(const f32x4 (&acc)[2][2][4][2], const Unit& u, int wr, int wc, int fr, int fq) const {
    const int row0 = u.pm * BM + wr * 64 + fr, col0 = u.pn * BM + wc * 32 + 8 * fq;
#pragma unroll
    for (int ai = 0; ai < 2; ++ai)
#pragma unroll
      for (int m = 0; m < 4; ++m) { const size_t r = (size_t)(row0 + ai * HALF + m * 16);
#pragma unroll
        for (int bj = 0; bj < 2; ++bj) { const f32x4 v0 = acc[ai][bj][m][0], v1 = acc[ai][bj][m][1];
          const u32x4 g = *(const u32x4*)(G + r * ldg + col0 + bj * HALF);
          float o[8] = {v0[0] * lo_bf(g.x), v0[1] * hi_bf(g.x), v0[2] * lo_bf(g.y), v0[3] * hi_bf(g.y), v1[0] * lo_bf(g.z), v1[1] * hi_bf(g.z), v1[2] * lo_bf(g.w), v1[3] * hi_bf(g.w)};
          if (Add) { const u32x4 a = *(const u32x4*)(Add + r * ldc + col0 + bj * HALF);
            o[0] += lo_bf(a.x); o[1] += hi_bf(a.x); o[2] += lo_bf(a.y); o[3] += hi_bf(a.y); o[4] += lo_bf(a.z); o[5] += hi_bf(a.z); o[6] += lo_bf(a.w); o[7] += hi_bf(a.w); }
          u32x4 w; w.x = cvt_pk_bf16(o[0], o[1]); w.y = cvt_pk_bf16(o[2], o[3]); w.z = cvt_pk_bf16(o[4], o[5]); w.w = cvt_pk_bf16(o[6], o[7]);
          *(u32x4*)(O + r * ldc + col0 + bj * HALF) = w; } }
  }
};
struct EpiF32 {
  static constexpr bool PERM = false, AFTER_DRAIN = false;
  float* O; int ldc;
  __device__ __forceinline__ void operator()(const f32x4 (&acc)[2][2][4][2], const Unit& u, int wr, int wc, int fr, int fq) const {
    const int row0 = u.pm * BM + wr * 64 + fr, col0 = u.pn * BM + wc * 32 + 4 * fq;
#pragma unroll
    for (int ai = 0; ai < 2; ++ai)
#pragma unroll
      for (int m = 0; m < 4; ++m) { float* rowp = O + (size_t)(row0 + ai * HALF + m * 16) * ldc + col0;
#pragma unroll
        for (int bj = 0; bj < 2; ++bj)
#pragma unroll
          for (int n = 0; n < 2; ++n) *(f32x4*)(rowp + bj * HALF + n * 16) = acc[ai][bj][m][n]; }
  }
};
struct EpiSwiGLU {
  static constexpr bool PERM = true, AFTER_DRAIN = false;
  bf16_t* O; int ldc;
  __device__ __forceinline__ void operator()(const f32x4 (&acc)[2][2][4][2], const Unit& u, int wr, int wc, int fr, int fq) const {
    const int row0 = u.pm * BM + wr * 64 + fr, col0 = u.pn * HALF + wc * 32 + 8 * fq;
#pragma unroll
    for (int ai = 0; ai < 2; ++ai)
#pragma unroll
      for (int m = 0; m < 4; ++m) { bf16_t* rowp = O + (size_t)(row0 + ai * HALF + m * 16) * ldc + col0;
        float o[8];
#pragma unroll
        for (int n = 0; n < 2; ++n)
#pragma unroll
          for (int i = 0; i < 4; ++i) { const float g = acc[ai][0][m][n][i], up = acc[ai][1][m][n][i]; o[4 * n + i] = g * __builtin_amdgcn_rcpf(1.f + __expf(-g)) * up; }
        u32x4 w; w.x = cvt_pk_bf16(o[0], o[1]); w.y = cvt_pk_bf16(o[2], o[3]); w.z = cvt_pk_bf16(o[4], o[5]); w.w = cvt_pk_bf16(o[6], o[7]);
        *(u32x4*)rowp = w; }
  }
};

template <class Epi, class Sched, bool ALIGN_EPI = false, bool SP2 = false>
__device__ __forceinline__ void gemm_phase(LAS unsigned char* lds, const Gemm g, const Sched& S, const Epi& E, const int wid) {
  int lane_o = lane_id(); asm volatile("" : "+v"(lane_o));
  const int lane = lane_o, tid = (wid << 6) | lane, wr = wid >> 2, wc = wid & 3, fr = lane & 15, fq = lane >> 4;
  const int K = g.K, nt = K / BK;
  unsigned voffA[2], voffB[2];
#pragma unroll
  for (int i = 0; i < 2; ++i) { int R, C; stage_rc(tid * 16 + i * 8192, R, C); const int Rb = Epi::PERM ? ((R & ~31) + perm32(R & 31)) : R;
    voffA[i] = (unsigned)(R * K + C) * 2u; voffB[i] = (unsigned)(Rb * K + C) * 2u; }
  const size_t kstep = (size_t)(BK * 2);
  const size_t hstep = (size_t)HALF * K * 2;
  const size_t tstep = 2 * hstep;
  const unsigned ldsw = (unsigned)wid * 1024u;
  const int aoff = lds_byte(wr * 64 + fr, fq * 8), boff = lds_byte(wc * 32 + fr, fq * 8);
#define PG8_SA(b, h) (((b) * 2 + (h)) * HTB)
#define PG8_SB(b, h) ((4 + (b) * 2 + (h)) * HTB)
#define PG8_STAGE(bufoff, gbase, voff) do { _Pragma("unroll") for (int _i = 0; _i < 2; ++_i) \
    __builtin_amdgcn_global_load_lds((const unsigned*)((const char*)(gbase) + (voff)[_i]), (LAS unsigned*)(lds + (bufoff) + ldsw + _i * 8192), 16, 0, 0); } while (0)
#define PG8_LDA(dst, b, h) do { _Pragma("unroll") for (int m = 0; m < 4; ++m) _Pragma("unroll") for (int k = 0; k < 2; ++k) dst[m][k] = *(const LAS bf16x8*)(lds + PG8_SA(b, h) + aoff + m * 2048 + k * 1024); } while (0)
#define PG8_LDB(dst, b, h) do { _Pragma("unroll") for (int n = 0; n < 2; ++n) _Pragma("unroll") for (int k = 0; k < 2; ++k) dst[n][k] = *(const LAS bf16x8*)(lds + PG8_SB(b, h) + boff + n * 2048 + k * 1024); } while (0)
#define PG8_MMA(ai, bj, At, Bt) do { __builtin_amdgcn_s_setprio(1); _Pragma("unroll") for (int m = 0; m < 4; ++m) _Pragma("unroll") for (int n = 0; n < 2; ++n) _Pragma("unroll") for (int k = 0; k < 2; ++k) \
    acc[ai][bj][m][n] = __builtin_amdgcn_mfma_f32_16x16x32_bf16(Bt[n][k], At[m][k], acc[ai][bj][m][n], 0, 0, 0); __builtin_amdgcn_s_setprio(0); } while (0)
#define PG8_WAIT_V(n) asm volatile("s_waitcnt vmcnt(" #n ")" ::: "memory")
#define PG8_WAIT_L(n) asm volatile("s_waitcnt lgkmcnt(" #n ")" ::: "memory")
#define PG8_BAR __builtin_amdgcn_s_barrier()
#define PG8_SCHED __builtin_amdgcn_sched_barrier(0)
  Unit cur, nxt; int ui = 0;
  if (!S.next(0, cur)) return;
  f32x4 acc[2][2][4][2];
#pragma unroll
  for (int a = 0; a < 2; ++a)
#pragma unroll
    for (int b = 0; b < 2; ++b)
#pragma unroll
      for (int m = 0; m < 4; ++m)
#pragma unroll
        for (int n = 0; n < 2; ++n) acc[a][b][m][n] = (f32x4){0.f, 0.f, 0.f, 0.f};
  bf16x8 At[4][2], B0[2][2], B1[2][2];
  const char* cA = (const char*)g.A + (size_t)cur.pm * tstep; const char* cB = (const char*)g.Bt + (size_t)cur.pn * tstep;
  S.a_ready(cur);
  if constexpr (SP2) {
    PG8_STAGE(PG8_SB(0, 0), cB, voffB); PG8_STAGE(PG8_SB(0, 1), cB + hstep, voffB); PG8_STAGE(PG8_SA(0, 0), cA, voffA); PG8_STAGE(PG8_SA(0, 1), cA + hstep, voffA);
    if (wr == 1) PG8_BAR;
    PG8_WAIT_V(2); PG8_BAR;
    PG8_STAGE(PG8_SB(1, 0), cB + kstep, voffB); PG8_STAGE(PG8_SA(1, 0), cA + kstep, voffA); PG8_STAGE(PG8_SB(1, 1), cB + hstep + kstep, voffB);
    PG8_WAIT_V(6); PG8_BAR;
  } else {
    PG8_STAGE(PG8_SB(0, 0), cB, voffB); PG8_STAGE(PG8_SA(0, 0), cA, voffA); PG8_STAGE(PG8_SB(0, 1), cB + hstep, voffB); PG8_STAGE(PG8_SA(0, 1), cA + hstep, voffA);
    if (wr == 1) PG8_BAR;
    PG8_WAIT_V(4); PG8_BAR;
    PG8_STAGE(PG8_SB(1, 0), cB + kstep, voffB); PG8_STAGE(PG8_SA(1, 0), cA + kstep, voffA); PG8_STAGE(PG8_SB(1, 1), cB + hstep + kstep, voffB);
    PG8_WAIT_V(6); PG8_BAR;
  }
  for (;;) {
    const bool has_next = S.next(ui + 1, nxt);
    const char* nA = has_next ? (const char*)g.A + (size_t)nxt.pm * tstep : cA; const char* nB = has_next ? (const char*)g.Bt + (size_t)nxt.pn * tstep : cB;
    for (int t = 0; t < nt; t += 2) {
      const bool last = (t == nt - 2);
      const char* a1 = cA + (size_t)(t + 1) * kstep;
      const char* a2 = last ? nA : cA + (size_t)(t + 2) * kstep; const char* b2 = last ? nB : cB + (size_t)(t + 2) * kstep;
      const char* a3 = a2 + kstep; const char* b3 = b2 + kstep;
      if (last && has_next) S.a_ready(nxt);
      if constexpr (SP2) {
        PG8_LDB(B0, 0, 0); PG8_LDB(B1, 0, 1); PG8_SCHED; PG8_LDA(At, 0, 0); PG8_STAGE(PG8_SA(1, 1), a1 + hstep, voffA);
        PG8_WAIT_V(8); PG8_WAIT_L(0); PG8_BAR; PG8_MMA(0, 0, At, B0); PG8_MMA(0, 1, At, B1); PG8_BAR; PG8_SCHED;
        PG8_LDA(At, 0, 1); PG8_STAGE(PG8_SB(0, 0), b2, voffB); PG8_STAGE(PG8_SB(0, 1), b2 + hstep, voffB); PG8_STAGE(PG8_SA(0, 0), a2, voffA);
        PG8_WAIT_V(8); PG8_WAIT_L(0); PG8_BAR; PG8_MMA(1, 0, At, B0); PG8_MMA(1, 1, At, B1); PG8_BAR; PG8_SCHED;
        PG8_LDB(B0, 1, 0); PG8_LDB(B1, 1, 1); PG8_SCHED; PG8_LDA(At, 1, 0); PG8_STAGE(PG8_SA(0, 1), a2 + hstep, voffA);
        PG8_WAIT_V(8); PG8_WAIT_L(0); PG8_BAR; PG8_MMA(0, 0, At, B0); PG8_MMA(0, 1, At, B1); PG8_BAR; PG8_SCHED;
        PG8_LDA(At, 1, 1); PG8_STAGE(PG8_SB(1, 0), b3, voffB); PG8_STAGE(PG8_SB(1, 1), b3 + hstep, voffB); PG8_STAGE(PG8_SA(1, 0), a3, voffA);
        PG8_WAIT_V(8); PG8_WAIT_L(0); PG8_BAR; PG8_MMA(1, 0, At, B0); PG8_MMA(1, 1, At, B1); PG8_BAR; PG8_SCHED;
      } else {
        PG8_LDB(B0, 0, 0); PG8_SCHED; PG8_LDA(At, 0, 0); PG8_STAGE(PG8_SA(1, 1), a1 + hstep, voffA);
        PG8_WAIT_L(8); PG8_BAR; PG8_WAIT_L(0); PG8_MMA(0, 0, At, B0); PG8_BAR; PG8_SCHED;
        PG8_LDB(B1, 0, 1); PG8_STAGE(PG8_SB(0, 0), b2, voffB);
        PG8_BAR; PG8_WAIT_L(0); PG8_MMA(0, 1, At, B1); PG8_BAR;
        PG8_LDA(At, 0, 1); PG8_STAGE(PG8_SA(0, 0), a2, voffA);
        PG8_BAR; PG8_WAIT_L(0); PG8_MMA(1, 0, At, B0); PG8_BAR; PG8_SCHED;
        PG8_STAGE(PG8_SB(0, 1), b2 + hstep, voffB);
        PG8_WAIT_V(6); PG8_BAR; PG8_MMA(1, 1, At, B1); PG8_BAR;
        PG8_LDB(B0, 1, 0); PG8_SCHED; PG8_LDA(At, 1, 0); PG8_STAGE(PG8_SA(0, 1), a2 + hstep, voffA);
        PG8_WAIT_L(8); PG8_BAR; PG8_WAIT_L(0); PG8_MMA(0, 0, At, B0); PG8_BAR; PG8_SCHED;
        PG8_LDB(B1, 1, 1); PG8_STAGE(PG8_SB(1, 0), b3, voffB);
        PG8_BAR; PG8_WAIT_L(0); PG8_MMA(0, 1, At, B1); PG8_BAR;
        PG8_LDA(At, 1, 1); PG8_STAGE(PG8_SA(1, 0), a3, voffA);
        PG8_BAR; PG8_WAIT_L(0); PG8_MMA(1, 0, At, B0); PG8_BAR; PG8_SCHED;
        PG8_STAGE(PG8_SB(1, 1), b3 + hstep, voffB);
        PG8_WAIT_V(6); PG8_BAR; PG8_MMA(1, 1, At, B1); PG8_BAR;
      }
    }
    if constexpr (ALIGN_EPI) { if (wr == 0) PG8_BAR; }
    if constexpr (!Epi::AFTER_DRAIN) { E(acc, cur, wr, wc, fr, fq); S.done(cur); }
    if (!has_next) break;
#pragma unroll
    for (int a = 0; a < 2; ++a)
#pragma unroll
      for (int b = 0; b < 2; ++b)
#pragma unroll
        for (int m = 0; m < 4; ++m)
#pragma unroll
          for (int n = 0; n < 2; ++n) acc[a][b][m][n] = (f32x4){0.f, 0.f, 0.f, 0.f};
    cur = nxt; cA = nA; cB = nB; ++ui;
    if constexpr (ALIGN_EPI) { if (wr == 1) PG8_BAR; }
  }
  PG8_WAIT_V(0);
  if constexpr (!ALIGN_EPI) { if (wr == 0) PG8_BAR; }
  PG8_BAR;
#undef PG8_SA
#undef PG8_SB
#undef PG8_STAGE
#undef PG8_LDA
#undef PG8_LDB
#undef PG8_MMA
#undef PG8_WAIT_V
#undef PG8_WAIT_L
#undef PG8_BAR
#undef PG8_SCHED
}
}

typedef float f32x16 __attribute__((ext_vector_type(16)));
typedef float f32x8 __attribute__((ext_vector_type(8)));
typedef short s16x4 __attribute__((ext_vector_type(4)));
typedef __bf16 bfx8 __attribute__((ext_vector_type(8)));
#define MFMA32(a, b, c) __builtin_amdgcn_mfma_f32_32x32x16_bf16((a), (b), (c), 0, 0, 0)
__device__ __forceinline__ bf16x8 cvt8(f32x8 t) { return __builtin_bit_cast(bf16x8, __builtin_convertvector(t, bfx8)); }
__device__ __forceinline__ bf16x8 pack8(const f32x16& x, int s) {
  const f32x8 t = {x[8 * s], x[8 * s + 1], x[8 * s + 2], x[8 * s + 3], x[8 * s + 4], x[8 * s + 5], x[8 * s + 6], x[8 * s + 7]};
  return cvt8(t);
}
__device__ __forceinline__ f32x16 zero16() { f32x16 z; for (int i = 0; i < 16; ++i) z[i] = 0.f; return z; }
__device__ __forceinline__ unsigned off_b(unsigned row, unsigned ch) { return 256u * row + 16u * (ch ^ (((row & 3u) << 2) | ((row >> 2) & 3u))); }
__device__ __forceinline__ int swap12(int p) { return ((p & 1) << 1) | (p >> 1); }
__device__ __forceinline__ bf16x8 lds_rd128(LAS unsigned char* lds, unsigned off) { return *(const LAS bf16x8*)(lds + off); }
__device__ __forceinline__ bf16x8 lds_tr2(LAS unsigned char* lds, unsigned off_lo, unsigned off_hi) {
  const s16x4 lo = __builtin_amdgcn_ds_read_tr16_b64_v4i16((LAS s16x4*)(lds + off_lo));
  const s16x4 hi = __builtin_amdgcn_ds_read_tr16_b64_v4i16((LAS s16x4*)(lds + off_hi));
  return __builtin_shufflevector(lo, hi, 0, 1, 2, 3, 4, 5, 6, 7);
}
__device__ __forceinline__ void glds16(const void* g, LAS unsigned char* l) {
  unsigned keep; const unsigned dst = __builtin_amdgcn_readfirstlane((unsigned)(size_t)l);
  asm volatile("s_mov_b32 %0, m0\n\ts_mov_b32 m0, %2\n\ts_nop 0\n\tglobal_load_lds_dwordx4 %1, off\n\ts_mov_b32 m0, %0" : "=&s"(keep) : "v"(g), "s"(dst) : "memory");
}
__device__ __forceinline__ unsigned rowfrag_off(int lane, int mt, int ks) { return off_b(32 * mt + (lane & 31), 2 * ks + (lane >> 5)); }
__device__ __forceinline__ unsigned vtr_off(int lane, int cb, int ks, int sec) {
  const int g = lane >> 4, i = lane & 15, hh = g >> 1, half16 = g & 1, qq = i >> 2, p = i & 3;
  const int row = 16 * ks + 4 * hh + 8 * sec + qq, col = cb + 16 * half16 + 4 * p;
  return off_b(row, col >> 3) + (col & 7) * 2;
}
__device__ __forceinline__ unsigned ktr_off(int lane, int mt, int ks, int sec) {
  const int g = lane >> 4, i = lane & 15, hh = g >> 1, half16 = g & 1, qq = i >> 2, p = i & 3;
  const int row = 16 * ks + 4 * hh + 8 * sec + qq, col = 32 * mt + 16 * half16 + 4 * swap12(p);
  return off_b(row, col >> 3) + (col & 7) * 2;
}
__device__ __forceinline__ int crow(int reg, int h) { return (reg & 3) + 8 * (reg >> 2) + 4 * h; }
__device__ __forceinline__ int srow(int reg, int h) { return 16 * (reg >> 3) + 8 * h + 4 * ((reg >> 2) & 1) + (reg & 3); }
__device__ __forceinline__ void rowscale(f32x16& a, const LAS float* vec, int h, float sgn) {
#pragma unroll
  for (int g4 = 0; g4 < 4; ++g4) { const f32x4 s = *(const LAS f32x4*)(vec + 8 * g4 + 4 * h);
    a[4 * g4] *= s.x * sgn; a[4 * g4 + 1] *= s.y * sgn; a[4 * g4 + 2] *= s.z * sgn; a[4 * g4 + 3] *= s.w * sgn; }
}
__device__ __forceinline__ void stage_img_piece(const unsigned char* src, size_t pitch, LAS unsigned char* img, int pc, int lane) {
  const unsigned row = 4 * pc + (lane >> 4), chp = lane & 15, ch = chp ^ (((row & 3u) << 2) | ((row >> 2) & 3u));
  glds16(src + (size_t)row * pitch + ch * 16, img + 1024 * pc);
}
constexpr int SC_BUF = 66560, SC_Q = 0, SC_K = 16384, SC_M = 32768, SC_V = 50176, SC_VEC = 2 * SC_BUF;
constexpr int DN_BLOB = 17408, RT_BLOB = 8192;
__device__ __forceinline__ void glds16_s(const unsigned char* base_uniform, unsigned voff, LAS unsigned char* l) {
  unsigned keep; const unsigned dst = __builtin_amdgcn_readfirstlane((unsigned)(size_t)l);
  const unsigned long long b = (unsigned long long)(size_t)base_uniform;
  const unsigned long long bs = ((unsigned long long)(unsigned)__builtin_amdgcn_readfirstlane((unsigned)(b >> 32)) << 32) | (unsigned)__builtin_amdgcn_readfirstlane((unsigned)b);
  asm volatile("s_mov_b32 %0, m0\n\ts_mov_b32 m0, %3\n\ts_nop 0\n\tglobal_load_lds_dwordx4 %1, %2\n\ts_mov_b32 m0, %0" : "=&s"(keep) : "v"(voff), "s"(bs), "s"(dst) : "memory");
}
struct StageOff { unsigned q[2], k[2], m; };
__device__ __forceinline__ StageOff scan_stage_offsets(int w, int lane, unsigned kpitch) {
  StageOff o;
#pragma unroll
  for (int i = 0; i < 2; ++i) { const unsigned pc = w + 8 * i, row = 4 * pc + (lane >> 4), chp = lane & 15, ch = chp ^ (((row & 3u) << 2) | ((row >> 2) & 3u));
    o.q[i] = row * (unsigned)(LDQ * 2) + ch * 16; o.k[i] = row * kpitch + ch * 16; }
  o.m = lane * 16;
  return o;
}
__device__ __forceinline__ void scan_stage(LAS unsigned char* lds, int buf, int type, int dir, int h, int gc, const bf16_t* QKV, const bf16_t* KBUF,
                                           const unsigned char* MATS_RT, const unsigned char* MATS_DN, int half, int w, const StageOff& so) {
  const size_t row0 = (size_t)gc * 64;
  const unsigned char* rowp = (const unsigned char*)(QKV + row0 * LDQ);
  const unsigned char* qsrc = rowp + (type ? Q_DQ + h * DK : Q_RQ + h * DK) * 2;
  const unsigned char* ksrc = rowp + (type ? Q_DK + h * DK : Q_RK + h * DK) * 2;
  if (!type && dir) ksrc = (const unsigned char*)(KBUF + row0 * 512 + h * DK);
  const unsigned char* vsrc = rowp + (type ? Q_DV + h * DV : Q_RV + h * DV) * 2 + half * 256;
  LAS unsigned char* B = lds + buf * SC_BUF;
#pragma unroll
  for (int i = 0; i < 2; ++i) { const int pc = w + 8 * i;
    glds16_s(qsrc, so.q[i], B + SC_Q + 1024 * pc); glds16_s(ksrc, so.k[i], B + SC_K + 1024 * pc); glds16_s(vsrc, so.q[i], B + SC_V + 1024 * pc); }
  const unsigned char* blob = type ? MATS_DN + (size_t)((gc * 4 + h) * 2 + dir) * DN_BLOB : MATS_RT + (size_t)((gc * 4 + h) * 2 + dir) * RT_BLOB;
  const int np = type ? 17 : 8;
  for (int pc = w; pc < np; pc += 8) glds16_s(blob + pc * 1024, so.m, B + SC_M + pc * 1024);
}

__device__ __forceinline__ void transpose_item(const float* W, int ldw, int K, int src_col0, bf16_t* WT, int dst_row0, int k0, LAS float* scr, int lane) {
#pragma unroll 8
  for (int i = 0; i < 32; ++i) { const int kk = 2 * i + (lane >> 5); scr[kk * 33 + (lane & 31)] = W[(size_t)(k0 + kk) * ldw + src_col0 + (lane & 31)]; }
  asm volatile("s_waitcnt lgkmcnt(0)" ::: "memory");
  const int c = lane & 7;
#pragma unroll
  for (int j = 0; j < 4; ++j) { const int n = (lane >> 3) + 8 * j; const LAS float* s = scr + (8 * c) * 33 + n;
    u32x4 o; o.x = pk2(s[0 * 33], s[1 * 33]); o.y = pk2(s[2 * 33], s[3 * 33]); o.z = pk2(s[4 * 33], s[5 * 33]); o.w = pk2(s[6 * 33], s[7 * 33]);
    *(u32x4*)(WT + (size_t)(dst_row0 + n) * K + k0 + 8 * c) = o; }
  asm volatile("s_waitcnt lgkmcnt(0)" ::: "memory");
}

template <class ColMap> __device__ __forceinline__ void transpose_matrix(const float* W, int ldw, int K, int N, bf16_t* WT, ColMap cm, LAS float* scr, int gw, int ngw, int lane) {
  const int nblk = N / 32, items = (K / 64) * nblk;
  for (int it = gw; it < items; it += ngw) { const int kb = it / nblk, nb = it % nblk; transpose_item(W, ldw, K, cm(32 * nb), WT, 32 * nb, 64 * kb, scr, lane); }
}

__global__ void __launch_bounds__(NTHREADS) fwd_megakernel(Params p) {
  extern __shared__ __attribute__((aligned(16))) unsigned char lds_raw[];
  LAS unsigned char* lds = (LAS unsigned char*)lds_raw;
  cg::grid_group grid = cg::this_grid();
  volatile LAS unsigned* bar_st = (volatile LAS unsigned*)(lds + LDS_BYTES - 64);
  if (threadIdx.x < 2) bar_st[threadIdx.x] = 0u;
  __syncthreads();
  const XcdBarrier xbar = xcd_barrier_post((unsigned*)(p.ws + WS_BAR), bar_st);
  if (p.ws == nullptr) grid.sync();
#define GRID_BARRIER() xcd_barrier(xbar, wave)
  const int wave = __builtin_amdgcn_readfirstlane(threadIdx.x >> 6);
#define PHASE_TID() int lane_p = lane_id(); asm volatile("" : "+v"(lane_p)); const int lane = lane_p, tid = (wave << 6) | lane; (void)tid;
  const int G = gridDim.x, bid = blockIdx.x;
  const int gw = bid * NWAVES + wave, ngw = G * NWAVES;
  unsigned char* ws = p.ws;
  float* MOD = (float*)(ws + WS_MOD);
  f32x2* ROPE = (f32x2*)(ws + WS_ROPE);
  float* BA = (float*)(ws + WS_BA);
  float* DECLG = (float*)(ws + WS_MOD + 122880);
  bf16_t* WQKV = (bf16_t*)(ws + WS_WQKV); bf16_t* WGATE = (bf16_t*)(ws + WS_WGATE);
  bf16_t* WRO = (bf16_t*)(ws + WS_WRO); bf16_t* WDO = (bf16_t*)(ws + WS_WDO); bf16_t* WOUT = (bf16_t*)(ws + WS_WOUT);
  bf16_t* HB = (bf16_t*)(ws + WS_H);
  bf16_t* QKV = (bf16_t*)(ws + WS_QKV);
  bf16_t* KBUF = (bf16_t*)(ws + WS_KB); bf16_t* HALO = (bf16_t*)(ws + WS_HALO);
  unsigned char* MATS_RT = ws + WS_MATS_RT; unsigned char* MATS_DN = ws + WS_MATS_DN;
  unsigned char* LSCR = ws + WS_O; constexpr int LSCR_STRIDE = 16896;
  bf16_t* ODF = (bf16_t*)(ws + WS_O); bf16_t* ODB = ODF + (size_t)MTOT * D;
  bf16_t* ORF = (bf16_t*)p.out; bf16_t* ORB = ORF + (size_t)MTOT * D;
  float* NS_RET = p.out + (size_t)MTOT * D; float* NS_DN = NS_RET + (size_t)NCTX * 2 * NH * DK * DV;

  {
    PHASE_TID();
    LAS float* scr = (LAS float*)(lds + wave * 16384);
    transpose_matrix(p.in[I_WIN], INC, D, 4096, WQKV, [](int n) { return n < 2048 ? n : n + 1024; }, scr, gw, ngw, lane);
    transpose_matrix(p.in[I_WIN], INC, D, 4096, WGATE, [](int n) { return n < 1024 ? C_RG + n : (n < 2048 ? C_DZ + (n - 1024) : C_GR + (n - 2048)); }, scr, gw, ngw, lane);
    transpose_matrix(p.in[I_WRO], D, D, D, WRO, [](int n) { return n; }, scr, gw, ngw, lane);
    transpose_matrix(p.in[I_WDO], D, D, D, WDO, [](int n) { return n; }, scr, gw, ngw, lane);
    transpose_matrix(p.in[I_WOUT], D, D, D, WOUT, [](int n) { return n; }, scr, gw, ngw, lane);
    {
      __syncthreads();
      LAS float* scond = (LAS float*)lds;
      LAS float* red = scond + 5 * D;
      for (int i = tid; i < 5 * D; i += NTHREADS) { const int c = i >> 10, k = i & 1023; scond[i] = siluf(c == 0 ? p.in[I_CCTX][k] : p.in[I_C][(c - 1) * D + k]); }
      __syncthreads();
      for (int it = bid; it < 6 * D / 32; it += G) {
        const int col = it * 32 + (lane & 31), rpar = lane >> 5;
        float acc[5] = {0.f, 0.f, 0.f, 0.f, 0.f};
        const float* wm = p.in[I_WMOD] + (size_t)(128 * wave + rpar) * 6 * D + col;
#pragma unroll 16
        for (int i = 0; i < 64; ++i) { const float wv = wm[(size_t)(2 * i) * 6 * D]; const int k = 128 * wave + 2 * i + rpar;
#pragma unroll
          for (int c = 0; c < 5; ++c) acc[c] += scond[c * D + k] * wv; }
#pragma unroll
        for (int c = 0; c < 5; ++c) { acc[c] += __shfl_xor(acc[c], 32); if (lane < 32) red[(wave * 5 + c) * 32 + lane] = acc[c]; }
        __syncthreads();
        if (tid < 160) { const int c = tid >> 5, n = tid & 31; float s = 0.f;
#pragma unroll
          for (int ww = 0; ww < 8; ++ww) s += red[(ww * 5 + c) * 32 + n];
          MOD[c * 6 * D + it * 32 + n] = s + p.in[I_BMOD][it * 32 + n]; }
        __syncthreads();
      }
    }
    for (int i = bid * NTHREADS + tid; i < LLAT * 64; i += G * NTHREADS) { const int l = i >> 6, pr = i & 63;
      const float freq = powf(10000.f, -(float)(pr & 31) / 32.f); const float ang = (pr < 32 ? (float)(l >> 6) : (float)(l & 63)) * freq;
      ROPE[i] = (f32x2){cosf(ang), sinf(ang)}; }
    if (bid == 0 && tid < 8) DECLG[tid] = -softplusf(-p.in[I_DECAY][tid]);
  }
  GRID_BARRIER();

  {
    PHASE_TID();
    LAS float* wba = (LAS float*)lds;
    for (int i = tid; i < D * 16; i += NTHREADS) wba[(i & 15) * 1028 + (i >> 4)] = p.in[I_WIN][(size_t)(i >> 4) * INC + C_DB + (i & 15)];
    __syncthreads();
    const float* nw = p.in[I_NORMW];
    for (int m = gw; m < MTOT; m += ngw) {
      const float* xr = xrow(p, m); const float* md = MOD + (size_t)cond_of_row(m) * 6 * D;
      f32x4 x4[4], w4[4], sc4[4], sh4[4]; float s = 0.f;
#pragma unroll
      for (int j = 0; j < 4; ++j) { const int c0 = 4 * lane + 256 * j; x4[j] = *(const f32x4*)(xr + c0); w4[j] = *(const f32x4*)(nw + c0); sc4[j] = *(const f32x4*)(md + D + c0); sh4[j] = *(const f32x4*)(md + c0); }
#pragma unroll
      for (int j = 0; j < 4; ++j) s += (x4[j].x * x4[j].x + x4[j].y * x4[j].y) + (x4[j].z * x4[j].z + x4[j].w * x4[j].w);
      const float r = rsqrtf(wave_sum(s) * (1.f / D) + EPS);
      float dots[16];
#pragma unroll
      for (int n = 0; n < 16; ++n) dots[n] = 0.f;
#pragma unroll
      for (int j = 0; j < 4; ++j) { const int c0 = 4 * lane + 256 * j;
        const f32x4 h = x4[j] * r * w4[j] * (sc4[j] + 1.f) + sh4[j];
        u32x2 o; o.x = pk2(h.x, h.y); o.y = pk2(h.z, h.w);
        *(u32x2*)(HB + (size_t)m * D + c0) = o;
#pragma unroll
        for (int n = 0; n < 16; ++n) { const f32x4 wv = *(const LAS f32x4*)(wba + n * 1028 + c0); dots[n] += (h.x * wv.x + h.y * wv.y) + (h.z * wv.z + h.w * wv.w); }
        __builtin_amdgcn_sched_barrier(0);
      }
#pragma unroll
      for (int n = 0; n < 16; ++n) dots[n] = wave_sum(dots[n]);
      if (lane < 8) {
        float db = dots[0], da = dots[8];
#pragma unroll
        for (int n = 1; n < 8; ++n) { db = lane == n ? dots[n] : db; da = lane == n ? dots[8 + n] : da; }
        BA[(size_t)m * 16 + lane] = sigmf(db);
        BA[(size_t)m * 16 + 8 + lane] = -expf(p.in[I_ALOG][lane]) * softplusf(da + p.in[I_DTB][lane]);
      }
    }
  }
  GRID_BARRIER();

  {
    pg8::Gemm g{HB, WQKV, MTOT, 4096, D}; pg8::StaticOrder S; S.init(MTOT, 4096, G, bid);
    pg8::EpiQKV E{QKV, LDQ, HALO};
    pg8::gemm_phase<pg8::EpiQKV, pg8::StaticOrder, true, true>(lds, g, S, E, wave);
  }
  GRID_BARRIER();

  {
    PHASE_TID();
    constexpr int PI_RQ = 0, PI_RK = 16384, PI_DQ = 32768, PI_DK = 49152;
    constexpr int PM_QKR = 65536, PM_QKD = PM_QKR + 17408, PM_KKD = PM_QKD + 17408;
    constexpr int PV = PM_KKD + 17408;
    constexpr int PL_F = 0, PL_B = 17408, PT_F = 34816, PT_B = 52224;
    const int w = wave;
    const float* cw = p.in[I_CONVW];
    u32x4 qraw[2], kraw[2], rawa[2][2][3], rawb[4][3]; float ba4[4] = {0.f, 0.f, 0.f, 0.f};
#define P2_LOADS(ITEM, TID) do { const int gc_ = (ITEM) >> 2, h_ = (ITEM) & 3, row0_ = gc_ * 64; const bool lat_ = row0_ >= MCTX; \
      const int L_ = lat_ ? LLAT : LCTX, t0_ = lat_ ? ((row0_ - MCTX) & (LLAT - 1)) : (row0_ & (LCTX - 1)); \
      const size_t s1m_ = (size_t)row0_ + ((TID) >> 3); \
      _Pragma("unroll") for (int c = 0; c < 2; ++c) { const int ch = ((TID) & 7) * 2 + c; \
        qraw[c] = *(const u32x4*)(QKV + s1m_ * LDQ + Q_RQ + h_ * DK + ch * 8); kraw[c] = *(const u32x4*)(QKV + s1m_ * LDQ + Q_RK + h_ * DK + ch * 8); } \
      _Pragma("unroll") for (int ps = 0; ps < 2; ++ps) _Pragma("unroll") for (int wh = 0; wh < 2; ++wh) _Pragma("unroll") for (int wd = 0; wd < 3; ++wd) { \
          const int row = ((TID) >> 4) + 32 * ps, rr = row + wd - 1, t = t0_ + rr; const int dch = wh * 512 + h_ * DK + ((TID) & 15) * 8; \
          u32x4 x = (u32x4){0u, 0u, 0u, 0u}; \
          if (t >= 0 && t < L_) { \
            if (rr < 0) x = *(const u32x4*)(HALO + ((size_t)(gc_ - 1) * 2 + 1) * 2048 + dch); \
            else if (rr > 63) x = *(const u32x4*)(HALO + ((size_t)(gc_ + 1) * 2 + 0) * 2048 + dch); \
            else x = *(const u32x4*)(QKV + (size_t)(row0_ + rr) * LDQ + Q_DQ + dch); } \
          rawa[ps][wh][wd] = x; } \
      _Pragma("unroll") for (int n = 0; n < 4; ++n) _Pragma("unroll") for (int wd = 0; wd < 3; ++wd) { \
          const int idx = (TID) + 512 * n, row = idx >> 5, ch = idx & 31, rr = row + wd - 1, t = t0_ + rr; const int dch = 1024 + h_ * DV + ch * 8; \
          u32x4 x = (u32x4){0u, 0u, 0u, 0u}; \
          if (t >= 0 && t < L_) { \
            if (rr < 0) x = *(const u32x4*)(HALO + ((size_t)(gc_ - 1) * 2 + 1) * 2048 + dch); \
            else if (rr > 63) x = *(const u32x4*)(HALO + ((size_t)(gc_ + 1) * 2 + 0) * 2048 + dch); \
            else x = *(const u32x4*)(QKV + (size_t)(row0_ + rr) * LDQ + Q_DQ + dch); } \
          rawb[n][wd] = x; } \
      if ((TID) < 64) { const float* ba = BA + (size_t)(row0_ + (TID)) * 16; ba4[0] = ba[h_]; ba4[1] = ba[4 + h_]; ba4[2] = ba[8 + h_]; ba4[3] = ba[12 + h_]; } } while (0)
    if (bid < 768) { int lane_q = lane_id(); asm volatile("" : "+v"(lane_q)); const int tid_q = (wave << 6) | lane_q; P2_LOADS(bid, tid_q); }
    for (int item = bid; item < 768; item += G) {
      int lane_o = lane_id(); asm volatile("" : "+v"(lane_o));
      const int lane = lane_o, tid = (wave << 6) | lane, r32 = lane & 31, hl = lane >> 5;
      const int gc = item >> 2, h = item & 3, row0 = gc * 64; const bool lat = row0 >= MCTX;
      const int t0 = lat ? ((row0 - MCTX) & (LLAT - 1)) : (row0 & (LCTX - 1));
      const float lgf = DECLG[h], lgb = DECLG[4 + h];
      const int s1row = tid >> 3; const size_t s1m = (size_t)row0 + s1row;
      const int ach = tid & 15;
      asm volatile("s_waitcnt vmcnt(0)" ::: "memory");
      __syncthreads();
      const float ba_bf = ba4[0], ba_bb = ba4[1], ba_af = ba4[2], ba_ab = ba4[3];
      {
        const int row = s1row; const size_t m = s1m;
        const float kfs = __expf(lgf * (float)(63 - row)), kbs = __expf(lgb * (float)row);
#pragma unroll
        for (int c = 0; c < 2; ++c) { const int ch = (tid & 7) * 2 + c;
          bf16_t* qp = QKV + m * LDQ + Q_RQ + h * DK + ch * 8; bf16_t* kp = QKV + m * LDQ + Q_RK + h * DK + ch * 8;
          const u32x4 qw = qraw[c], kw = kraw[c];
          float q[8] = {lo_bf(qw.x), hi_bf(qw.x), lo_bf(qw.y), hi_bf(qw.y), lo_bf(qw.z), hi_bf(qw.z), lo_bf(qw.w), hi_bf(qw.w)};
          float k[8] = {lo_bf(kw.x), hi_bf(kw.x), lo_bf(kw.y), hi_bf(kw.y), lo_bf(kw.z), hi_bf(kw.z), lo_bf(kw.w), hi_bf(kw.w)};
#pragma unroll
          for (int e = 0; e < 8; ++e) q[e] *= QSCALE;
          if (lat) {
#pragma unroll
            for (int e = 0; e < 4; ++e) { const f32x2 cs = ROPE[(t0 + row) * 64 + ch * 4 + e];
              const float a = q[2 * e] * cs.x - q[2 * e + 1] * cs.y, b = q[2 * e] * cs.y + q[2 * e + 1] * cs.x; q[2 * e] = a; q[2 * e + 1] = b;
              const float c2 = k[2 * e] * cs.x - k[2 * e + 1] * cs.y, d2 = k[2 * e] * cs.y + k[2 * e + 1] * cs.x; k[2 * e] = c2; k[2 * e + 1] = d2; }
          }
          u32x4 o; o.x = pk2(q[0], q[1]); o.y = pk2(q[2], q[3]); o.z = pk2(q[4], q[5]); o.w = pk2(q[6], q[7]);
          *(u32x4*)qp = o; *(LAS u32x4*)(lds + PI_RQ + off_b(row, ch)) = o;
          o.x = pk2(k[0], k[1]); o.y = pk2(k[2], k[3]); o.z = pk2(k[4], k[5]); o.w = pk2(k[6], k[7]);
          *(LAS u32x4*)(lds + PI_RK + off_b(row, ch)) = o;
          o.x = pk2(k[0] * kfs, k[1] * kfs); o.y = pk2(k[2] * kfs, k[3] * kfs); o.z = pk2(k[4] * kfs, k[5] * kfs); o.w = pk2(k[6] * kfs, k[7] * kfs);
          *(u32x4*)kp = o;
          o.x = pk2(k[0] * kbs, k[1] * kbs); o.y = pk2(k[2] * kbs, k[3] * kbs); o.z = pk2(k[4] * kbs, k[5] * kbs); o.w = pk2(k[6] * kbs, k[7] * kbs);
          *(u32x4*)(KBUF + m * 512 + h * DK + ch * 8) = o;
        }
      }
      {
        const int ch = ach;
#pragma unroll
        for (int ps = 0; ps < 2; ++ps)
#pragma unroll
          for (int wh = 0; wh < 2; ++wh) { const int row = (tid >> 4) + 32 * ps; const int dch = wh * 512 + h * DK + ch * 8;
            float a[8] = {0.f, 0.f, 0.f, 0.f, 0.f, 0.f, 0.f, 0.f};
#pragma unroll
            for (int wd = 0; wd < 3; ++wd) { const u32x4 x = rawa[ps][wh][wd]; const f32x4 w0 = *(const f32x4*)(cw + wd * 2048 + dch), w1 = *(const f32x4*)(cw + wd * 2048 + dch + 4);
              a[0] += lo_bf(x.x) * w0.x; a[1] += hi_bf(x.x) * w0.y; a[2] += lo_bf(x.y) * w0.z; a[3] += hi_bf(x.y) * w0.w;
              a[4] += lo_bf(x.z) * w1.x; a[5] += hi_bf(x.z) * w1.y; a[6] += lo_bf(x.w) * w1.z; a[7] += hi_bf(x.w) * w1.w; }
            float ss = 0.f;
#pragma unroll
            for (int e = 0; e < 8; ++e) { a[e] = siluf(a[e]); ss += a[e] * a[e]; }
            ss += __shfl_xor(ss, 1); ss += __shfl_xor(ss, 2); ss += __shfl_xor(ss, 4); ss += __shfl_xor(ss, 8);
            const float sc = rsqrtf(ss + EPS) * (wh == 0 ? QSCALE : 1.f);
            u32x4 o; o.x = pk2(a[0] * sc, a[1] * sc); o.y = pk2(a[2] * sc, a[3] * sc); o.z = pk2(a[4] * sc, a[5] * sc); o.w = pk2(a[6] * sc, a[7] * sc);
            *(u32x4*)(QKV + (size_t)(row0 + row) * LDQ + Q_DQ + dch) = o;
            *(LAS u32x4*)(lds + (wh ? PI_DK : PI_DQ) + off_b(row, ch)) = o; }
      }
      {
#pragma unroll
        for (int n = 0; n < 4; ++n) { const int idx = tid + 512 * n, row = idx >> 5, ch = idx & 31; const int dch = 1024 + h * DV + ch * 8;
          float a[8] = {0.f, 0.f, 0.f, 0.f, 0.f, 0.f, 0.f, 0.f};
#pragma unroll
          for (int wd = 0; wd < 3; ++wd) { const u32x4 x = rawb[n][wd]; const f32x4 w0 = *(const f32x4*)(cw + wd * 2048 + dch), w1 = *(const f32x4*)(cw + wd * 2048 + dch + 4);
            a[0] += lo_bf(x.x) * w0.x; a[1] += hi_bf(x.x) * w0.y; a[2] += lo_bf(x.y) * w0.z; a[3] += hi_bf(x.y) * w0.w;
            a[4] += lo_bf(x.z) * w1.x; a[5] += hi_bf(x.z) * w1.y; a[6] += lo_bf(x.w) * w1.z; a[7] += hi_bf(x.w) * w1.w; }
          u32x4 o; o.x = pk2(siluf(a[0]), siluf(a[1])); o.y = pk2(siluf(a[2]), siluf(a[3])); o.z = pk2(siluf(a[4]), siluf(a[5])); o.w = pk2(siluf(a[6]), siluf(a[7]));
          *(u32x4*)(QKV + (size_t)(row0 + row) * LDQ + Q_DQ + dch) = o; }
      }
      if (item + G < 768) P2_LOADS(item + G, tid);
      __syncthreads();
      {
        const int mi = (w >> 1) & 1, nj = w & 1;
        if (w < 4) {
          f32x16 a1 = zero16(), a2 = zero16();
#pragma unroll 2
          for (int ks = 0; ks < 8; ++ks) { a1 = MFMA32(lds_rd128(lds + PI_RQ, rowfrag_off(lane, mi, ks)), lds_rd128(lds + PI_RK, rowfrag_off(lane, nj, ks)), a1);
            a2 = MFMA32(lds_rd128(lds + PI_DQ, rowfrag_off(lane, mi, ks)), lds_rd128(lds + PI_DK, rowfrag_off(lane, nj, ks)), a2); }
          LAS float* m1 = (LAS float*)(lds + PM_QKR); LAS float* m2 = (LAS float*)(lds + PM_QKD);
#pragma unroll
          for (int reg = 0; reg < 16; ++reg) { const int o = (32 * mi + crow(reg, hl)) * 68 + 32 * nj + r32; m1[o] = a1[reg]; m2[o] = a2[reg]; }
        } else {
          f32x16 a1 = zero16();
#pragma unroll 2
          for (int ks = 0; ks < 8; ++ks) a1 = MFMA32(lds_rd128(lds + PI_DK, rowfrag_off(lane, mi, ks)), lds_rd128(lds + PI_DK, rowfrag_off(lane, nj, ks)), a1);
          LAS float* m1 = (LAS float*)(lds + PM_KKD);
#pragma unroll
          for (int reg = 0; reg < 16; ++reg) m1[(32 * mi + crow(reg, hl)) * 68 + 32 * nj + r32] = a1[reg];
        }
      }
      LAS float* vecs = (LAS float*)(lds + PV);
      if (tid < 64) {
        const float bf = ba_bf, bb = ba_bb, af = ba_af, ab = ba_ab;
        float xf = af, xb = ab;
#pragma unroll
        for (int o = 1; o < 64; o <<= 1) { const float yf = __shfl_up(xf, o), yb = __shfl_up(xb, o); if (lane >= o) { xf += yf; xb += yb; } }
        const float totf = __shfl(xf, 63), totb = __shfl(xb, 63);
        vecs[tid] = bf; vecs[64 + tid] = bb; vecs[128 + tid] = xf; vecs[192 + tid] = totb - xb + ab;
        if (tid == 0) { vecs[256] = totf; vecs[257] = totb; }
      }
      __syncthreads();
      unsigned char* blob_rt = MATS_RT + (size_t)((gc * 4 + h) * 2) * RT_BLOB; unsigned char* blob_dn = MATS_DN + (size_t)((gc * 4 + h) * 2) * DN_BLOB;
      const int lp = tid & 63, fi = tid >> 6, fmt = fi >> 2, fks = fi & 3, frow = 32 * fmt + (lp & 31), fhq = lp >> 5;
      {
        const LAS float* m1 = (const LAS float*)(lds + PM_QKR); const LAS float* m2 = (const LAS float*)(lds + PM_QKD);
        const float gfi = vecs[128 + frow], gbi = vecs[192 + frow];
        f32x8 pf, pb, df, db;
#pragma unroll
        for (int jj = 0; jj < 8; ++jj) { const int j = 16 * fks + 8 * (jj >> 2) + 4 * fhq + (jj & 3);
          const float x = m1[frow * 68 + j], y = m2[frow * 68 + j];
          pf[jj] = j <= frow ? x * __expf(lgf * (float)(frow - j)) : 0.f; pb[jj] = j >= frow ? x * __expf(lgb * (float)(j - frow)) : 0.f;
          df[jj] = j <= frow ? y * __expf(gfi - vecs[128 + j]) : 0.f; db[jj] = j >= frow ? y * __expf(gbi - vecs[192 + j]) : 0.f; }
        *(bf16x8*)(blob_rt + (fi * 64 + lp) * 16) = cvt8(pf); *(bf16x8*)(blob_rt + RT_BLOB + (fi * 64 + lp) * 16) = cvt8(pb);
        *(bf16x8*)(blob_dn + 8192 + (fi * 64 + lp) * 16) = cvt8(df); *(bf16x8*)(blob_dn + DN_BLOB + 8192 + (fi * 64 + lp) * 16) = cvt8(db);
        const LAS float* m3 = (const LAS float*)(lds + PM_KKD);
        float* lf = (float*)(LSCR + (size_t)((gc * 4 + h) * 2) * LSCR_STRIDE); float* lb = (float*)(LSCR + (size_t)((gc * 4 + h) * 2 + 1) * LSCR_STRIDE);
#pragma unroll
        for (int n = 0; n < 8; ++n) { const int e = tid + 512 * n, i = e >> 6, j = e & 63; const float kk = m3[i * 68 + j];
          lf[e] = j < i ? vecs[i] * kk * __expf(vecs[128 + i] - vecs[128 + j]) : 0.f;
          lb[e] = j > i ? vecs[64 + i] * kk * __expf(vecs[192 + i] - vecs[192 + j]) : 0.f; }
        if (tid < 64) { lf[4096 + tid] = vecs[tid]; lb[4096 + tid] = vecs[64 + tid]; }
        if (tid < 64) { const float gf = vecs[128 + tid], gb = vecs[192 + tid], glf = vecs[256], glb = vecs[257];
          float* vf = (float*)(blob_dn + 16384); float* vb = (float*)(blob_dn + DN_BLOB + 16384);
          vf[tid] = __expf(gf); vf[64 + tid] = __expf(glf - gf); vb[tid] = __expf(gb); vb[64 + tid] = __expf(glb - gb);
          if (tid == 0) { vf[128] = __expf(glf); vb[128] = __expf(glb); } }
      }
    }
  }
  GRID_BARRIER();

  {
    PHASE_TID();
    LAS unsigned short* tl = (LAS unsigned short*)(lds + wave * 16384);
    for (int it = gw; it < 1536; it += ngw) {
      int lane_o = lane_id(); asm volatile("" : "+v"(lane_o));
      const int ln = lane_o; const bool flip = it & 1; const int cl = flip ? 63 - ln : ln;
      const float* Lm = (const float*)(LSCR + (size_t)it * LSCR_STRIDE);
      float T[64], Lr[64];
#pragma unroll
      for (int i = 0; i < 64; ++i) Lr[i] = Lm[(flip ? 63 - i : i) * 64 + cl];
      const float bc = Lm[4096 + cl];
      __builtin_amdgcn_sched_barrier(0);
#pragma unroll
      for (int i = 0; i < 64; ++i) {
        const float lrow = Lr[i];
        float t0 = (ln == i) ? 1.f : 0.f, t1 = 0.f;
#pragma unroll
        for (int j = 0; j < i; ++j) { const float lj = __int_as_float(__builtin_amdgcn_readlane(__float_as_int(lrow), j)); if (j & 1) t1 -= lj * T[j]; else t0 -= lj * T[j]; }
        T[i] = t0 + t1;
        __builtin_amdgcn_sched_barrier(0);
      }
#pragma unroll
      for (int i = 0; i < 64; ++i) tl[(flip ? 63 - i : i) * 72 + cl] = (unsigned short)f2bf(T[i] * bc);
      asm volatile("s_waitcnt lgkmcnt(0)" ::: "memory");
      unsigned char* blob = MATS_DN + (size_t)it * DN_BLOB;
      const int frow = ln & 31, fhq = ln >> 5;
#pragma unroll
      for (int f = 0; f < 8; ++f) { const int mt = f >> 2, ks = f & 3;
        const LAS unsigned short* rp = tl + (32 * mt + frow) * 72 + 16 * ks + 4 * fhq;
        const u32x2 lo = *(const LAS u32x2*)rp, hi = *(const LAS u32x2*)(rp + 8);
        *(u32x4*)(blob + (f * 64 + ln) * 16) = (u32x4){lo.x, lo.y, hi.x, hi.y}; }
      asm volatile("s_waitcnt lgkmcnt(0)" ::: "memory");
    }
  }
  GRID_BARRIER();

  {
    PHASE_TID();
    const int w = wave, cb = (w & 3) * 32; const bool act = w < 4;
    LAS float* qdec = (LAS float*)(lds + SC_VEC);
    const int stride = bid < 128 ? 1000000 : (G - 128);
    for (int item = bid; item < 640; item += stride) {
      const int ci = item >> 1, half = item & 1;
      int lane_c = lane_id(); asm volatile("" : "+v"(lane_c));
      const int lane = lane_c, tid = (wave << 6) | lane, r32 = lane & 31, hl = lane >> 5;
      int type, sq, h, dir, chunk0, nsteps; bool lat;
      if (ci < 64) { lat = true; type = ci >> 5; sq = (ci >> 3) & 3; h = (ci >> 1) & 3; dir = ci & 1; chunk0 = 64 + 32 * sq; nsteps = 32; }
      else { const int c = ci - 64; lat = false; type = c >> 7; sq = (c >> 3) & 15; h = (c >> 1) & 3; dir = c & 1; chunk0 = 4 * sq; nsteps = 4; }
      f32x16 S[4];
      {
        const float* s0 = (type ? p.in[I_SDN] : p.in[I_SRET]) + ((((size_t)sq * 2 + dir) * NH + h) * DK) * DV + 128 * half + cb + r32;
        if (lat) {
#pragma unroll
          for (int mt = 0; mt < 4; ++mt)
#pragma unroll
            for (int reg = 0; reg < 16; ++reg) S[mt][reg] = s0[(size_t)(32 * mt + srow(reg, hl)) * DV];
        } else {
#pragma unroll
          for (int mt = 0; mt < 4; ++mt) S[mt] = zero16();
        }
      }
      const float lg = DECLG[dir * 4 + h];
      const float c64 = __expf(64.f * lg);
      __syncthreads();
      if (tid < 64) qdec[tid] = __expf(lg * (dir ? (float)(64 - tid) : (float)(tid + 1)));
      const StageOff soff = scan_stage_offsets(w, lane, (!type && dir) ? 1024u : (unsigned)(LDQ * 2));
      scan_stage(lds, 0, type, dir, h, chunk0 + (dir ? nsteps - 1 : 0), QKV, KBUF, MATS_RT, MATS_DN, half, w, soff);
      bf16_t* O = type ? (dir ? ODB : ODF) : (dir ? ORB : ORF);
      for (int s = 0; s < nsteps; ++s) {
        int ln = lane; asm volatile("" : "+v"(ln));
        const int r32s = ln & 31, hls = ln >> 5;
        const int buf = s & 1, gc = chunk0 + (dir ? nsteps - 1 - s : s);
        asm volatile("s_waitcnt vmcnt(0)" ::: "memory");
        __syncthreads();
        if (s + 1 < nsteps) scan_stage(lds, buf ^ 1, type, dir, h, chunk0 + (dir ? nsteps - 2 - s : s + 1), QKV, KBUF, MATS_RT, MATS_DN, half, w, soff);
        if (!act) continue;
        LAS unsigned char* B = lds + buf * SC_BUF;
        bf16_t* ob = O + (size_t)gc * 64 * D + h * DV + 128 * half + cb + r32s;
#define SB_ do { __builtin_amdgcn_sched_barrier(0); asm volatile("" : "+v"(ln)); } while (0)
#define STORE_O(acc) do { _Pragma("unroll") for (int mt_ = 0; mt_ < 2; ++mt_) _Pragma("unroll") for (int s2_ = 0; s2_ < 2; ++s2_) { const bf16x8 pk_ = pack8(acc[mt_], s2_); \
                          _Pragma("unroll") for (int j_ = 0; j_ < 8; ++j_) ob[(size_t)(32 * mt_ + crow(8 * s2_ + j_, ln >> 5)) * D] = (bf16_t)pk_[j_]; } } while (0)
#define LOAD_BV() do { _Pragma("unroll") for (int ks_ = 0; ks_ < 4; ++ks_) Bv[ks_] = lds_tr2(B + SC_V, vtr_off(ln, cb, ks_, 0), vtr_off(ln, cb, ks_, 1)); } while (0)
#define ROWS_AB(acc, IMG) do { bf16x8 f0_[2], f1_[2]; \
            f0_[0] = lds_rd128(B + (IMG), rowfrag_off(ln, 0, 0)); f0_[1] = lds_rd128(B + (IMG), rowfrag_off(ln, 1, 0)); \
            _Pragma("unroll") for (int ks_ = 0; ks_ < 8; ++ks_) { \
              if (ks_ + 1 < 8) { f1_[0] = lds_rd128(B + (IMG), rowfrag_off(ln, 0, ks_ + 1)); f1_[1] = lds_rd128(B + (IMG), rowfrag_off(ln, 1, ks_ + 1)); } \
              const bf16x8 sb_ = pack8(S[ks_ >> 1], ks_ & 1); \
              acc[0] = MFMA32(f0_[0], sb_, acc[0]); acc[1] = MFMA32(f0_[1], sb_, acc[1]); \
              f0_[0] = f1_[0]; f0_[1] = f1_[1]; } } while (0)
#define ROWS_T(acc, IMG) do { bf16x8 f0_[2], f1_[2];   \
            f0_[0] = lds_rd128(B + (IMG), rowfrag_off(ln, 0, 0)); f0_[1] = lds_rd128(B + (IMG), rowfrag_off(ln, 1, 0)); \
            _Pragma("unroll") for (int ks_ = 0; ks_ < 8; ++ks_) { \
              if (ks_ + 1 < 8) { f1_[0] = lds_rd128(B + (IMG), rowfrag_off(ln, 0, ks_ + 1)); f1_[1] = lds_rd128(B + (IMG), rowfrag_off(ln, 1, ks_ + 1)); } \
              const bf16x8 sb_ = pack8(S[ks_ >> 1], ks_ & 1); \
              acc[0] = MFMA32(sb_, f0_[0], acc[0]); acc[1] = MFMA32(sb_, f0_[1], acc[1]); \
              f0_[0] = f1_[0]; f0_[1] = f1_[1]; } } while (0)
#define STORE_OT(acc) do { _Pragma("unroll") for (int nt_ = 0; nt_ < 2; ++nt_) { bf16_t* orow_ = obt + (size_t)(32 * nt_) * D; \
            _Pragma("unroll") for (int g_ = 0; g_ < 4; ++g_) { u32x2 w_; w_.x = pk2(acc[nt_][4 * g_], acc[nt_][4 * g_ + 1]); w_.y = pk2(acc[nt_][4 * g_ + 2], acc[nt_][4 * g_ + 3]); \
              *(u32x2*)(orow_ + 8 * g_) = w_; } } } while (0)
#define S_UPDATE(X, SCL) do { bf16x8 g0_[4], g1_[4]; \
            _Pragma("unroll") for (int mt_ = 0; mt_ < 4; ++mt_) g0_[mt_] = lds_tr2(B + SC_K, ktr_off(ln, mt_, 0, 0), ktr_off(ln, mt_, 0, 1)); \
            _Pragma("unroll") for (int mt_ = 0; mt_ < 4; ++mt_) S[mt_] = S[mt_] * (SCL); \
            _Pragma("unroll") for (int ks_ = 0; ks_ < 4; ++ks_) { \
              if (ks_ + 1 < 4) { _Pragma("unroll") for (int mt_ = 0; mt_ < 4; ++mt_) g1_[mt_] = lds_tr2(B + SC_K, ktr_off(ln, mt_, ks_ + 1, 0), ktr_off(ln, mt_, ks_ + 1, 1)); } \
              _Pragma("unroll") for (int mt_ = 0; mt_ < 4; ++mt_) S[mt_] = MFMA32(g0_[mt_], X[ks_], S[mt_]); \
              _Pragma("unroll") for (int mt_ = 0; mt_ < 4; ++mt_) g0_[mt_] = g1_[mt_]; } } while (0)
        bf16x8 Bv[4];
        if (type) {
          const LAS float* eg = (const LAS float*)(B + SC_M + 16384); const LAS float* cgv = eg + 64; const float egl = eg[128];
          bf16x8 Br[4];
          { f32x16 ra[2]; ra[0] = zero16(); ra[1] = zero16();
            ROWS_AB(ra, SC_K);
#pragma unroll
            for (int mt = 0; mt < 2; ++mt) { rowscale(ra[mt], eg + 32 * mt, ln >> 5, -1.f); Br[2 * mt] = pack8(ra[mt], 0); Br[2 * mt + 1] = pack8(ra[mt], 1); } }
          SB_;
          LOAD_BV();
          bf16x8 tf[8];
#pragma unroll
          for (int i = 0; i < 8; ++i) tf[i] = lds_rd128(B + SC_M, i * 1024 + ln * 16);
          f32x16 vn[2]; vn[0] = zero16(); vn[1] = zero16();
#pragma unroll
          for (int ks = 0; ks < 4; ++ks)
#pragma unroll
            for (int mt = 0; mt < 2; ++mt) { vn[mt] = MFMA32(tf[mt * 4 + ks], Bv[ks], vn[mt]); vn[mt] = MFMA32(tf[mt * 4 + ks], Br[ks], vn[mt]); }
          SB_;
          bf16x8 Bn[4], Bc[4];
#pragma unroll
          for (int mt = 0; mt < 2; ++mt) { Bn[2 * mt] = pack8(vn[mt], 0); Bn[2 * mt + 1] = pack8(vn[mt], 1); rowscale(vn[mt], cgv + 32 * mt, ln >> 5, 1.f); Bc[2 * mt] = pack8(vn[mt], 0); Bc[2 * mt + 1] = pack8(vn[mt], 1); }
          SB_;
          f32x16 oa[2]; oa[0] = zero16(); oa[1] = zero16();
          ROWS_T(oa, SC_Q);
          SB_;
#pragma unroll
          for (int i = 0; i < 8; ++i) tf[i] = lds_rd128(B + SC_M, 8192 + i * 1024 + ln * 16);
#pragma unroll
          for (int nt = 0; nt < 2; ++nt) oa[nt] = oa[nt] * eg[32 * nt + (ln & 31)];
#pragma unroll
          for (int ks = 0; ks < 4; ++ks)
#pragma unroll
            for (int nt = 0; nt < 2; ++nt) oa[nt] = MFMA32(Bn[ks], tf[nt * 4 + ks], oa[nt]);
          SB_;
          { bf16_t* obt = O + ((size_t)gc * 64 + (ln & 31)) * D + h * DV + 128 * half + cb + 4 * (ln >> 5); STORE_OT(oa); }
          SB_;
          S_UPDATE(Bc, egl);
          SB_;
        } else {
          f32x16 oa[2]; oa[0] = zero16(); oa[1] = zero16();
          ROWS_T(oa, SC_Q);
          SB_;
          LOAD_BV();
          bf16x8 tf[8];
#pragma unroll
          for (int i = 0; i < 8; ++i) tf[i] = lds_rd128(B + SC_M, i * 1024 + ln * 16);
#pragma unroll
          for (int nt = 0; nt < 2; ++nt) oa[nt] = oa[nt] * qdec[32 * nt + (ln & 31)];
#pragma unroll
          for (int ks = 0; ks < 4; ++ks)
#pragma unroll
            for (int nt = 0; nt < 2; ++nt) oa[nt] = MFMA32(Bv[ks], tf[nt * 4 + ks], oa[nt]);
          SB_;
          { bf16_t* obt = O + ((size_t)gc * 64 + (ln & 31)) * D + h * DV + 128 * half + cb + 4 * (ln >> 5); STORE_OT(oa); }
          SB_;
          S_UPDATE(Bv, c64);
          SB_;
        }
#undef SB_
#undef STORE_O
#undef LOAD_BV
#undef ROWS_AB
#undef ROWS_T
#undef STORE_OT
#undef S_UPDATE
      }
      if (!lat && act) {
        int ln3 = lane_id(); asm volatile("" : "+v"(ln3)); const int hl3 = ln3 >> 5;
        float* so = (type ? NS_DN : NS_RET) + ((((size_t)sq * 2 + dir) * NH + h) * DK) * DV + 128 * half + cb + (ln3 & 31);
#pragma unroll
        for (int mt = 0; mt < 4; ++mt)
#pragma unroll
          for (int reg = 0; reg < 16; ++reg) so[(size_t)(32 * mt + srow(reg, hl3)) * DV] = S[mt][reg];
      }
    }
  }
  GRID_BARRIER();

  bf16_t* GATES = QKV;
  {
    pg8::Gemm g{HB, WGATE, MTOT, 4096, D}; pg8::StaticOrder S; S.init(MTOT, 4096, G, bid);
    pg8::EpiBf16Act<1> E{GATES, LDG};
    pg8::gemm_phase<pg8::EpiBf16Act<1>, pg8::StaticOrder, true, true>(lds, g, S, E, wave);
  }
  GRID_BARRIER();

  bf16_t* AR = (bf16_t*)(ws + WS_AR); bf16_t* AD = (bf16_t*)(ws + WS_AD);
  {
    PHASE_TID();
    for (int m = gw; m < MTOT; m += ngw) {
      u32x2 rf[4], rb[4], df[4], db[4], gr[4], gd[4]; f32x4 gw4[4];
#pragma unroll
      for (int h = 0; h < 4; ++h) { const size_t base = (size_t)m * D + h * DV + 4 * lane;
        rf[h] = *(const u32x2*)(ORF + base); rb[h] = *(const u32x2*)(ORB + base); df[h] = *(const u32x2*)(ODF + base); db[h] = *(const u32x2*)(ODB + base);
        gr[h] = *(const u32x2*)(GATES + (size_t)m * LDG + G_RG + h * DV + 4 * lane); gd[h] = *(const u32x2*)(GATES + (size_t)m * LDG + G_DZ + h * DV + 4 * lane);
        gw4[h] = *(const f32x4*)(p.in[I_GNW] + h * DV + 4 * lane); }
      const f32x4 dw4 = *(const f32x4*)(p.in[I_DNW] + 4 * lane);
      float v[4][4], u[4][4], mu[4], rs[4], rd[4];
#pragma unroll
      for (int h = 0; h < 4; ++h) { v[h][0] = lo_bf(rf[h].x) + lo_bf(rb[h].x); v[h][1] = hi_bf(rf[h].x) + hi_bf(rb[h].x); v[h][2] = lo_bf(rf[h].y) + lo_bf(rb[h].y); v[h][3] = hi_bf(rf[h].y) + hi_bf(rb[h].y);
        u[h][0] = lo_bf(df[h].x) + lo_bf(db[h].x); u[h][1] = hi_bf(df[h].x) + hi_bf(db[h].x); u[h][2] = lo_bf(df[h].y) + lo_bf(db[h].y); u[h][3] = hi_bf(df[h].y) + hi_bf(db[h].y);
        mu[h] = (v[h][0] + v[h][1]) + (v[h][2] + v[h][3]); rd[h] = (u[h][0] * u[h][0] + u[h][1] * u[h][1]) + (u[h][2] * u[h][2] + u[h][3] * u[h][3]); }
#pragma unroll
      for (int o = 1; o < 64; o <<= 1) {
#pragma unroll
        for (int h = 0; h < 4; ++h) { mu[h] += __shfl_xor(mu[h], o); rd[h] += __shfl_xor(rd[h], o); } }
#pragma unroll
      for (int h = 0; h < 4; ++h) { mu[h] *= (1.f / DV); float q = 0.f;
#pragma unroll
        for (int e = 0; e < 4; ++e) { v[h][e] -= mu[h]; q += v[h][e] * v[h][e]; }
        rs[h] = q; }
#pragma unroll
      for (int o = 1; o < 64; o <<= 1) {
#pragma unroll
        for (int h = 0; h < 4; ++h) rs[h] += __shfl_xor(rs[h], o); }
#pragma unroll
      for (int h = 0; h < 4; ++h) { const size_t base = (size_t)m * D + h * DV + 4 * lane;
        const float r1 = rsqrtf(rs[h] * (1.f / DV) + EPS), r2 = rsqrtf(rd[h] * (1.f / DV) + EPS);
        u32x2 o; o.x = pk2(lo_bf(gr[h].x) * (v[h][0] * r1 * gw4[h].x), hi_bf(gr[h].x) * (v[h][1] * r1 * gw4[h].y)); o.y = pk2(lo_bf(gr[h].y) * (v[h][2] * r1 * gw4[h].z), hi_bf(gr[h].y) * (v[h][3] * r1 * gw4[h].w));
        *(u32x2*)(AR + base) = o;
        o.x = pk2(u[h][0] * r2 * dw4.x * lo_bf(gd[h].x), u[h][1] * r2 * dw4.y * hi_bf(gd[h].x)); o.y = pk2(u[h][2] * r2 * dw4.z * lo_bf(gd[h].y), u[h][3] * r2 * dw4.w * hi_bf(gd[h].y));
        *(u32x2*)(AD + base) = o; }
    }
  }
  GRID_BARRIER();

  bf16_t* T1 = HB;
  {
    pg8::Gemm g{AR, WRO, MTOT, D, D}; pg8::StaticOrder S; S.init(MTOT, D, G, bid);
    pg8::EpiGateMul E{T1, D, GATES + G_GR, LDG, nullptr};
    pg8::gemm_phase<pg8::EpiGateMul, pg8::StaticOrder, true, true>(lds, g, S, E, wave);
  }
  GRID_BARRIER();
  bf16_t* MERGED = (bf16_t*)(ws + WS_MERGED);
  {
    pg8::Gemm g{AD, WDO, MTOT, D, D}; pg8::StaticOrder S; S.init(MTOT, D, G, bid);
    pg8::EpiGateMul E{MERGED, D, GATES + G_GD, LDG, T1};
    pg8::gemm_phase<pg8::EpiGateMul, pg8::StaticOrder, true, true>(lds, g, S, E, wave);
  }
  GRID_BARRIER();
  bf16_t* M1 = (bf16_t*)(ws + WS_O);
  bf16_t* X1B = (bf16_t*)(ws + WS_O + 24 * MiB);
  {
    pg8::Gemm g{MERGED, WOUT, MTOT, D, D}; pg8::StaticOrder S; S.init(MTOT, D, G, bid);
    pg8::EpiBf16Act<0> E{M1, D};
    pg8::gemm_phase<pg8::EpiBf16Act<0>, pg8::StaticOrder, true, true>(lds, g, S, E, wave);
  }
  GRID_BARRIER();

  bf16_t* WF1 = (bf16_t*)(ws + WS_WF1); bf16_t* WF2 = (bf16_t*)(ws + WS_WF2);
  {
    PHASE_TID();
    LAS float* scr = (LAS float*)(lds + wave * 16384);
    transpose_matrix(p.in[I_WF1], 2 * DFF, D, 2 * DFF, WF1, [](int n) { const int pn = n >> 8, w = n & 255; return w < 128 ? 128 * pn + w : DFF + 128 * pn + (w - 128); }, scr, gw, ngw, lane);
    transpose_matrix(p.in[I_WF2], D, DFF, D, WF2, [](int n) { return n; }, scr, gw, ngw, lane);
    const float* nw1 = p.in[I_NORMW] + D; const float* nw2 = p.in[I_NORMW] + 2 * D;
    for (int m0 = gw; m0 < MTOT; m0 += 2 * ngw) {
      f32x4 v[2][4], xv[2][4], g1v[2][4]; float s[2] = {0.f, 0.f};
#pragma unroll
      for (int u = 0; u < 2; ++u) { const int m = (m0 + u * ngw < MTOT) ? m0 + u * ngw : m0; const float* xr = xrow(p, m); const float* md = MOD + (size_t)cond_of_row(m) * 6 * D; const bf16_t* mr = M1 + (size_t)m * D;
#pragma unroll
        for (int j = 0; j < 4; ++j) { const int c0 = 4 * lane + 256 * j; { const u32x2 mw = *(const u32x2*)(mr + c0); v[u][j] = (f32x4){lo_bf(mw.x), hi_bf(mw.x), lo_bf(mw.y), hi_bf(mw.y)}; } xv[u][j] = *(const f32x4*)(xr + c0); g1v[u][j] = *(const f32x4*)(md + 2 * D + c0); } }
#pragma unroll
      for (int u = 0; u < 2; ++u)
#pragma unroll
        for (int j = 0; j < 4; ++j) s[u] += (v[u][j].x * v[u][j].x + v[u][j].y * v[u][j].y) + (v[u][j].z * v[u][j].z + v[u][j].w * v[u][j].w);
#pragma unroll
      for (int o = 1; o < 64; o <<= 1) { s[0] += __shfl_xor(s[0], o); s[1] += __shfl_xor(s[1], o); }
      float s2[2] = {0.f, 0.f};
#pragma unroll
      for (int u = 0; u < 2; ++u) { const int m = m0 + u * ngw; const float r = rsqrtf(s[u] * (1.f / D) + EPS);
#pragma unroll
        for (int j = 0; j < 4; ++j) { const int c0 = 4 * lane + 256 * j;
          v[u][j] = xv[u][j] + g1v[u][j] * (v[u][j] * r * *(const f32x4*)(nw1 + c0));
          if (m < MTOT) { u32x2 xo; xo.x = pk2(v[u][j].x, v[u][j].y); xo.y = pk2(v[u][j].z, v[u][j].w); *(u32x2*)(X1B + (size_t)m * D + c0) = xo; }
          s2[u] += (v[u][j].x * v[u][j].x + v[u][j].y * v[u][j].y) + (v[u][j].z * v[u][j].z + v[u][j].w * v[u][j].w); } }
#pragma unroll
      for (int o = 1; o < 64; o <<= 1) { s2[0] += __shfl_xor(s2[0], o); s2[1] += __shfl_xor(s2[1], o); }
#pragma unroll
      for (int u = 0; u < 2; ++u) { const int m = m0 + u * ngw; if (m >= MTOT) continue; const float* md = MOD + (size_t)cond_of_row(m) * 6 * D; const float r2 = rsqrtf(s2[u] * (1.f / D) + EPS);
#pragma unroll
        for (int j = 0; j < 4; ++j) { const int c0 = 4 * lane + 256 * j;
          const f32x4 h = v[u][j] * r2 * *(const f32x4*)(nw2 + c0) * (*(const f32x4*)(md + 4 * D + c0) + 1.f) + *(const f32x4*)(md + 3 * D + c0);
          u32x2 o; o.x = pk2(h.x, h.y); o.y = pk2(h.z, h.w); *(u32x2*)(HB + (size_t)m * D + c0) = o; } }
    }
  }
  GRID_BARRIER();

  bf16_t* ACT = QKV;
  {
    pg8::Gemm g{HB, WF1, MTOT, 2 * DFF, D}; pg8::StaticOrder S; S.init(MTOT, 2 * DFF, G, bid);
    pg8::EpiSwiGLU E{ACT, DFF};
    pg8::gemm_phase<pg8::EpiSwiGLU, pg8::StaticOrder, true, true>(lds, g, S, E, wave);
  }
  GRID_BARRIER();
  bf16_t* F = (bf16_t*)(ws + WS_O);
  {
    pg8::Gemm g{ACT, WF2, MTOT, D, DFF}; pg8::StaticOrder S; S.init(MTOT, D, G, bid);
    pg8::EpiBf16Act<0> E{F, D};
    pg8::gemm_phase<pg8::EpiBf16Act<0>, pg8::StaticOrder, true, true>(lds, g, S, E, wave);
  }
  GRID_BARRIER();
  {
    PHASE_TID();
    const float* nw3 = p.in[I_NORMW] + 3 * D;
    for (int m0 = gw; m0 < MTOT; m0 += 2 * ngw) {
      f32x4 v[2][4], xv[2][4], gv[2][4]; float s[2] = {0.f, 0.f};
#pragma unroll
      for (int u = 0; u < 2; ++u) { const int m = (m0 + u * ngw < MTOT) ? m0 + u * ngw : m0; const float* md = MOD + (size_t)cond_of_row(m) * 6 * D; const bf16_t* fr = F + (size_t)m * D; const bf16_t* xrow1 = X1B + (size_t)m * D;
#pragma unroll
        for (int j = 0; j < 4; ++j) { const int c0 = 4 * lane + 256 * j; { const u32x2 fw = *(const u32x2*)(fr + c0); v[u][j] = (f32x4){lo_bf(fw.x), hi_bf(fw.x), lo_bf(fw.y), hi_bf(fw.y)}; } { const u32x2 xw = *(const u32x2*)(xrow1 + c0); xv[u][j] = (f32x4){lo_bf(xw.x), hi_bf(xw.x), lo_bf(xw.y), hi_bf(xw.y)}; } gv[u][j] = *(const f32x4*)(md + 5 * D + c0); } }
#pragma unroll
      for (int u = 0; u < 2; ++u)
#pragma unroll
        for (int j = 0; j < 4; ++j) s[u] += (v[u][j].x * v[u][j].x + v[u][j].y * v[u][j].y) + (v[u][j].z * v[u][j].z + v[u][j].w * v[u][j].w);
#pragma unroll
      for (int o = 1; o < 64; o <<= 1) { s[0] += __shfl_xor(s[0], o); s[1] += __shfl_xor(s[1], o); }
#pragma unroll
      for (int u = 0; u < 2; ++u) { const int m = m0 + u * ngw; if (m >= MTOT) continue; const float r = rsqrtf(s[u] * (1.f / D) + EPS); float* orow = p.out + (size_t)m * D;
#pragma unroll
        for (int j = 0; j < 4; ++j) { const int c0 = 4 * lane + 256 * j; *(f32x4*)(orow + c0) = xv[u][j] + gv[u][j] * (v[u][j] * r * *(const f32x4*)(nw3 + c0)); } }
    }
  }
}

extern "C" void kernel_launch(void* const* d_in, const int* in_sizes, int n_in, void* d_out, int out_size, void* d_ws, size_t ws_size, hipStream_t stream) {
  static int grid_blocks = 0;
  if (!grid_blocks) {
    int dev = 0, cus = 0, per_cu = 0;
    (void)hipGetDevice(&dev);
    (void)hipDeviceGetAttribute(&cus, hipDeviceAttributeMultiprocessorCount, dev);
    (void)hipFuncSetAttribute((const void*)fwd_megakernel, hipFuncAttributeMaxDynamicSharedMemorySize, LDS_BYTES);
    (void)hipOccupancyMaxActiveBlocksPerMultiprocessor(&per_cu, (const void*)fwd_megakernel, NTHREADS, LDS_BYTES);
    if (per_cu < 1) per_cu = 1;
    grid_blocks = cus * per_cu;
    if (n_in != 21 || ws_size < WS_END) fprintf(stderr, "kernel_launch: unexpected n_in %d / ws_size %zu\n", n_in, ws_size);
    fprintf(stderr, "kernel_launch: cus %d per_cu %d grid %d ws %zu out %d\n", cus, per_cu, grid_blocks, ws_size, out_size);
  }
  (void)hipMemsetAsync((unsigned char*)d_ws + WS_BAR, 0, 16384, stream);
  Params p{};
  for (int i = 0; i < 21; ++i) p.in[i] = (const float*)d_in[i];
  p.out = (float*)d_out; p.ws = (unsigned char*)d_ws;
  void* args[] = {&p};
  hipError_t e = hipLaunchCooperativeKernel((const void*)fwd_megakernel, dim3(grid_blocks), dim3(NTHREADS), args, LDS_BYTES, stream);
  if (e != hipSuccess) fprintf(stderr, "cooperative launch failed: %s (grid %d)\n", hipGetErrorString(e), grid_blocks);
}
```

```cpp
#include <hip/hip_runtime.h>
#include <hip/hip_cooperative_groups.h>
#include <cstdio>
#include <cstdint>
namespace cg = cooperative_groups;

#define LAS __attribute__((address_space(3)))
typedef unsigned short bf16_t;
typedef short bf16x8 __attribute__((ext_vector_type(8)));
typedef float f32x4 __attribute__((ext_vector_type(4)));
typedef float f32x2 __attribute__((ext_vector_type(2)));
typedef unsigned u32x4 __attribute__((ext_vector_type(4)));
typedef unsigned u32x2 __attribute__((ext_vector_type(2)));

constexpr int D = 1024, MCTX = 4096, MLAT = 8192, MTOT = 12288, LCTX = 256, LLAT = 2048, NCTX = 16, NLAT = 4;
constexpr int NH = 4, DK = 128, DV = 256, DFF = 2816, INC = 8208;
constexpr float EPS = 1e-6f;
constexpr float QSCALE = 0.08838834764831845f;
constexpr int NTHREADS = 512, NWAVES = 8;
constexpr int LDS_BYTES = 135168;
constexpr int Q_RQ = 0, Q_RK = 512, Q_RV = 1024, Q_DQ = 2048, Q_DK = 2560, Q_DV = 3072, LDQ = 4096;
constexpr int G_RG = 0, G_DZ = 1024, G_GR = 2048, G_GD = 3072, LDG = 4096;
constexpr int C_RQ = 0, C_RG = 2048, C_DQ = 3072, C_DZ = 5120, C_DB = 6144, C_GR = 6160;

constexpr size_t MiB = 1u << 20;
constexpr size_t WS_MOD = 0;
constexpr size_t WS_ROPE = 128 * 1024;
constexpr size_t WS_BAR = 1152 * 1024;
constexpr size_t WS_BA = 1280 * 1024;
constexpr size_t WS_WQKV = 2 * MiB;
constexpr size_t WS_WGATE = 10 * MiB;
constexpr size_t WS_WRO = 18 * MiB, WS_WDO = 20 * MiB, WS_WOUT = 22 * MiB;
constexpr size_t WS_H = 24 * MiB;
constexpr size_t WS_QKV = 48 * MiB;
constexpr size_t WS_MATS_DN = 144 * MiB;
constexpr size_t WS_MATS_RT = 170 * MiB;
constexpr size_t WS_KB = 182 * MiB;
constexpr size_t WS_HALO = 194 * MiB;
constexpr size_t WS_O = 196 * MiB;
constexpr size_t WS_END = 244 * MiB;
constexpr size_t WS_AR = 144 * MiB, WS_AD = 168 * MiB, WS_MERGED = 144 * MiB;
constexpr size_t WS_WF1 = 144 * MiB, WS_WF2 = 155 * MiB;

struct Params {
  const float* in[21];
  float* out;
  unsigned char* ws;
};
enum { I_XP = 0, I_XS, I_C, I_SRET, I_SDN, I_CCTX, I_WMOD, I_BMOD, I_NORMW, I_WIN, I_CONVW, I_DECAY, I_GNW, I_ALOG, I_DTB, I_DNW, I_WRO, I_WDO, I_WOUT, I_WF1, I_WF2 };

__device__ __forceinline__ float bf2f(unsigned short b) { return __uint_as_float((unsigned)b << 16); }
__device__ __forceinline__ unsigned f2bf(float f) { unsigned u = __float_as_uint(f); return (u + 0x7fffu + ((u >> 16) & 1u)) >> 16; }
typedef __bf16 bfx2_t __attribute__((ext_vector_type(2)));
__device__ __forceinline__ unsigned pk2(float lo, float hi) { const f32x2 t = {lo, hi}; return __builtin_bit_cast(unsigned, __builtin_convertvector(t, bfx2_t)); }
__device__ __forceinline__ unsigned cvt_pk_bf16(float lo, float hi) { return pk2(lo, hi); }

__device__ __forceinline__ float lo_bf(unsigned w) { return __uint_as_float(w << 16); }
__device__ __forceinline__ float hi_bf(unsigned w) { return __uint_as_float(w & 0xffff0000u); }
__device__ __forceinline__ float siluf(float x) { return x * __builtin_amdgcn_rcpf(1.f + __expf(-x)); }
__device__ __forceinline__ float sigmf(float x) { return __builtin_amdgcn_rcpf(1.f + __expf(-x)); }
__device__ __forceinline__ float softplusf(float x) { return x > 20.f ? x : log1pf(expf(x)); }
__device__ __forceinline__ float wave_sum(float v) {
#pragma unroll
  for (int o = 1; o < 64; o <<= 1) v += __shfl_xor(v, o);
  return v;
}
__device__ __forceinline__ int lane_id() { return (int)__builtin_amdgcn_mbcnt_hi(~0u, __builtin_amdgcn_mbcnt_lo(~0u, 0u)); }
__device__ __forceinline__ int cond_of_row(int m) { return m < MCTX ? 0 : 1 + (m - MCTX) / LLAT; }
__device__ __forceinline__ const float* xrow(const Params& p, int m) { return m < MCTX ? p.in[I_XP] + (size_t)m * D : p.in[I_XS] + (size_t)(m - MCTX) * D; }


__device__ __forceinline__ int lane_id();
#define XB_TMO      128
#define XB_XCNT(j)  (256  + 64 * (j))
#define XB_XSUB(j)  (1280 + 64 * (j))
#define XB_XGEN(j)  (2304 + 64 * (j))
#define XB_TOP      3328
#define XB_TOPGEN   3392
#define XCD_BAR_WORDS 3456
#define XB_SPIN_CAP (1u << 18)
__device__ __forceinline__ unsigned xb_ld(unsigned* p)              { return __hip_atomic_load(p, __ATOMIC_RELAXED, __HIP_MEMORY_SCOPE_AGENT); }
__device__ __forceinline__ unsigned xb_add(unsigned* p, unsigned v) { return __hip_atomic_fetch_add(p, v, __ATOMIC_RELAXED, __HIP_MEMORY_SCOPE_AGENT); }
__device__ __forceinline__ unsigned xb_xcc_id() { return (unsigned)__builtin_amdgcn_s_getreg((3 << 11) | 20) & 0xFu; }
#define XB_SPIN(cond, bar) do { unsigned _sp = 0; while (cond) { __builtin_amdgcn_s_sleep(1); \
    if ((++_sp & 255u) == 0u) { if (xb_ld(&(bar)[XB_TMO])) break; if (_sp > XB_SPIN_CAP) { atomicAdd(&(bar)[XB_TMO], 1u); break; } } } } while (0)
struct XcdBarrier { unsigned* bar; unsigned x; volatile LAS unsigned* st; };
__device__ __forceinline__ XcdBarrier xcd_barrier_post(unsigned* bar, volatile LAS unsigned* st) {
  XcdBarrier b; b.bar = bar; b.x = xb_xcc_id(); b.st = st;
  if (threadIdx.x == 0) (void)xb_add(&bar[XB_XCNT(b.x)], 1u);
  return b;
}
__device__ __forceinline__ void xcd_barrier_complete(unsigned* bar, unsigned x, unsigned& nloc, unsigned& nx) {
  const unsigned G = gridDim.x * gridDim.y * gridDim.z;
  unsigned sum, cnt, mine, sp = 0u;
  for (;;) {
    sum = 0u; cnt = 0u; mine = 0u;
#pragma unroll
    for (unsigned j = 0; j < 16; ++j) { const unsigned c = xb_ld(&bar[XB_XCNT(j)]); sum += c; cnt += (c > 0u) ? 1u : 0u; mine = (j == x) ? c : mine; }
    if (sum == G) break;
    __builtin_amdgcn_s_sleep(1);
    if ((++sp & 255u) == 0u) { if (xb_ld(&bar[XB_TMO])) break; if (sp > XB_SPIN_CAP) { atomicAdd(&bar[XB_TMO], 1u); break; } }
  }
  nloc = mine > 0u ? mine : 1u; nx = cnt > 0u ? cnt : 1u;
}
__device__ __forceinline__ void xcd_barrier(const XcdBarrier& b, const int wave) {
  asm volatile("s_waitcnt vmcnt(0)" ::: "memory");
  __syncthreads();
  if (wave == 0 && lane_id() == 0) {
    unsigned* bar = b.bar;
    __builtin_amdgcn_s_waitcnt(0);
    unsigned nloc = b.st[0], nx = b.st[1];
    if (nloc == 0u) { xcd_barrier_complete(bar, b.x, nloc, nx); b.st[0] = nloc; b.st[1] = nx; }
    const unsigned old = xb_add(&bar[XB_XSUB(b.x)], 1u);
    const unsigned gen = old / nloc;
    if (old + 1u == (gen + 1u) * nloc) {
      __builtin_amdgcn_fence(__ATOMIC_RELEASE, "agent");
      asm volatile("s_waitcnt vmcnt(0)" ::: "memory");
      const unsigned og = xb_add(&bar[XB_TOP], 1u);
      const unsigned tg = og / nx;
      if (og + 1u == (tg + 1u) * nx) xb_add(&bar[XB_TOPGEN], 1u);
      else XB_SPIN(xb_ld(&bar[XB_TOPGEN]) == tg, bar);
      __builtin_amdgcn_fence(__ATOMIC_ACQUIRE, "agent");
      xb_add(&bar[XB_XGEN(b.x)], 1u);
      asm volatile("s_waitcnt vmcnt(0)" ::: "memory");
    } else {
      XB_SPIN(xb_ld(&bar[XB_XGEN(b.x)]) == gen, bar);
      __builtin_amdgcn_fence(__ATOMIC_ACQUIRE, "agent");
      asm volatile("s_waitcnt vmcnt(0)" ::: "memory");
    }
  }
  __syncthreads();
}

namespace pg8 {
constexpr int BM = 256, BK = 64, HALF = 128, HTB = HALF * BK * 2, STAGE_BYTES = 8 * HTB, NXCD = 8, WGM = 8;
__host__ __device__ __forceinline__ int lds_byte(int r, int c) { const int st = (r >> 4) * 2 + (c >> 5), rr = r & 15, cc = c & 31, ob = rr * 64 + cc * 2; return st * 1024 + (ob ^ (((ob >> 9) & 1) << 5)); }
__host__ __device__ __forceinline__ void stage_rc(int b, int& R, int& C) { const int st = b / 1024, sb = b % 1024, swz = sb ^ (((sb >> 9) & 1) << 5); R = (st >> 1) * 16 + swz / 64; C = (st & 1) * 32 + (swz % 64) / 2; }
__host__ __device__ __forceinline__ int perm32(int rho) { const int n = rho >> 4, i = rho & 15; return 8 * (i >> 2) + 4 * n + (i & 3); }
struct Unit { int pm, pn; };
struct Gemm { const bf16_t* A; const bf16_t* Bt; int M, N, K; };
struct StaticOrder {
  int nM, nN, nwg, G, c;
  __host__ __device__ void init(int M, int N, int G_, int c_) { nM = M / BM; nN = N / BM; nwg = nM * nN; G = G_; c = c_; }
  __host__ __device__ bool next(int i, Unit& u) const {
    const long L = (long)i * G + c; if (L >= nwg) return false;
    int wgid = (int)L; { const int q = nwg / NXCD, r = nwg % NXCD, xcd = wgid % NXCD, off = wgid / NXCD; wgid = (xcd < r ? xcd * (q + 1) : r * (q + 1) + (xcd - r) * q) + off; }
    const int nig = WGM * nN, gid = wgid / nig, fm = gid * WGM, gsz = (nM - fm) < WGM ? (nM - fm) : WGM;
    u.pm = fm + ((wgid % nig) % gsz); u.pn = (wgid % nig) / gsz; return true;
  }
  __device__ __forceinline__ void a_ready(const Unit&) const {}
  __device__ __forceinline__ void done(const Unit&) const {}
};

template <int MODE  > struct EpiBf16Act {
  static constexpr bool PERM = true, AFTER_DRAIN = false;
  bf16_t* O; int ldc;
  __device__ __forceinline__ void operator()(const f32x4 (&acc)[2][2][4][2], const Unit& u, int wr, int wc, int fr, int fq) const {
    const int row0 = u.pm * BM + wr * 64 + fr, col0 = u.pn * BM + wc * 32 + 8 * fq;
    const bool sg = u.pn >= 8;
#pragma unroll
    for (int ai = 0; ai < 2; ++ai)
#pragma unroll
      for (int m = 0; m < 4; ++m) { bf16_t* rowp = O + (size_t)(row0 + ai * HALF + m * 16) * ldc + col0;
#pragma unroll
        for (int bj = 0; bj < 2; ++bj) { f32x4 v0 = acc[ai][bj][m][0], v1 = acc[ai][bj][m][1];
          if (MODE == 1) {
#pragma unroll
            for (int i = 0; i < 4; ++i) { const float s0 = __builtin_amdgcn_rcpf(1.f + __expf(-v0[i])), s1 = __builtin_amdgcn_rcpf(1.f + __expf(-v1[i]));
              v0[i] = sg ? s0 : v0[i] * s0; v1[i] = sg ? s1 : v1[i] * s1; } }
          u32x4 w; w.x = cvt_pk_bf16(v0[0], v0[1]); w.y = cvt_pk_bf16(v0[2], v0[3]); w.z = cvt_pk_bf16(v1[0], v1[1]); w.w = cvt_pk_bf16(v1[2], v1[3]);
          *(u32x4*)(rowp + bj * HALF) = w; } }
  }
};
struct EpiQKV {
  static constexpr bool PERM = true, AFTER_DRAIN = false;
  bf16_t* O; int ldc; bf16_t* HALO;
  __device__ __forceinline__ void operator()(const f32x4 (&acc)[2][2][4][2], const Unit& u, int wr, int wc, int fr, int fq) const {
    const int row0 = u.pm * BM + wr * 64 + fr, col0 = u.pn * BM + wc * 32 + 8 * fq;
#pragma unroll
    for (int ai = 0; ai < 2; ++ai)
#pragma unroll
      for (int m = 0; m < 4; ++m) { const int row = row0 + ai * HALF + m * 16; bf16_t* rowp = O + (size_t)row * ldc + col0;
#pragma unroll
        for (int bj = 0; bj < 2; ++bj) { const f32x4 v0 = acc[ai][bj][m][0], v1 = acc[ai][bj][m][1];
          u32x4 w; w.x = cvt_pk_bf16(v0[0], v0[1]); w.y = cvt_pk_bf16(v0[2], v0[3]); w.z = cvt_pk_bf16(v1[0], v1[1]); w.w = cvt_pk_bf16(v1[2], v1[3]);
          *(u32x4*)(rowp + bj * HALF) = w;
          if (u.pn >= 8 && ((m == 0 && fr == 0) || (m == 3 && fr == 15)))
            *(u32x4*)(HALO + ((size_t)(row >> 6) * 2 + (m == 3 ? 1 : 0)) * 2048 + (col0 - 2048) + bj * HALF) = w; } }
  }
};
struct EpiGateMul {
  static constexpr bool PERM = true, AFTER_DRAIN = false;
  bf16_t* O; int ldc; const bf16_t* G; int ldg; const bf16_t* Add;
  __device__ __forceinline__ void operator()(const f32x4 (&acc)[2][2][4][2], const Unit& u, int wr, int wc, int fr, int fq) const {
    const int row0 = u.pm * BM + wr * 64 + fr, col0 = u.pn * BM + wc * 32 + 8 * fq;
#pragma unroll
    for (int ai = 0; ai < 2; ++ai)
#pragma unroll
      for (int m = 0; m < 4; ++m) { const size_t r = (size_t)(row0 + ai * HALF + m * 16);
#pragma unroll
        for (int bj = 0; bj < 2; ++bj) { const f32x4 v0 = acc[ai][bj][m][0], v1 = acc[ai][bj][m][1];
          const u32x4 g = *(const u32x4*)(G + r * ldg + col0 + bj * HALF);
          float o[8] = {v0[0] * lo_bf(g.x), v0[1] * hi_bf(g.x), v0[2] * lo_bf(g.y), v0[3] * hi_bf(g.y), v1[0] * lo_bf(g.z), v1[1] * hi_bf(g.z), v1[2] * lo_bf(g.w), v1[3] * hi_bf(g.w)};
          if (Add) { const u32x4 a = *(const u32x4*)(Add + r * ldc + col0 + bj * HALF);
            o[0] += lo_bf(a.x); o[1] += hi_bf(a.x); o[2] += lo_bf(a.y); o[3] += hi_bf(a.y); o[4] += lo_bf(a.z); o[5] += hi_bf(a.z); o[6] += lo_bf(a.w); o[7] += hi_bf(a.w); }
          u32x4 w; w.x = cvt_pk_bf16(o[0], o[1]); w.y = cvt_pk_bf16(o[2], o[3]); w.z = cvt_pk_bf16(o[4], o[5]); w.w = cvt_pk_bf16(o[6], o[7]);
          *(u32x4*)(O + r * ldc + col0 + bj * HALF) = w; } }
  }
};
struct EpiF32 {
  static constexpr bool PERM = false, AFTER_DRAIN = false;
  float* O; int ldc;
  __device__ __forceinline__ void operator()(const f32x4 (&acc)[2][2][4][2], const Unit& u, int wr, int wc, int fr, int fq) const {
    const int row0 = u.pm * BM + wr * 64 + fr, col0 = u.pn * BM + wc * 32 + 4 * fq;
#pragma unroll
    for (int ai = 0; ai < 2; ++ai)
#pragma unroll
      for (int m = 0; m < 4; ++m) { float* rowp = O + (size_t)(row0 + ai * HALF + m * 16) * ldc + col0;
#pragma unroll
        for (int bj = 0; bj < 2; ++bj)
#pragma unroll
          for (int n = 0; n < 2; ++n) *(f32x4*)(rowp + bj * HALF + n * 16) = acc[ai][bj][m][n]; }
  }
};
struct EpiSwiGLU {
  static constexpr bool PERM = true, AFTER_DRAIN = false;
  bf16_t* O; int ldc;
  __device__ __forceinline__ void operator()(const f32x4 (&acc)[2][2][4][2], const Unit& u, int wr, int wc, int fr, int fq) const {
    const int row0 = u.pm * BM + wr * 64 + fr, col0 = u.pn * HALF + wc * 32 + 8 * fq;
#pragma unroll
    for (int ai = 0; ai < 2; ++ai)
#pragma unroll
      for (int m = 0; m < 4; ++m) { bf16_t* rowp = O + (size_t)(row0 + ai * HALF + m * 16) * ldc + col0;
        float o[8];
#pragma unroll
        for (int n = 0; n < 2; ++n)
#pragma unroll
          for (int i = 0; i < 4; ++i) { const float g = acc[ai][0][m][n][i], up = acc[ai][1][m][n][i]; o[4 * n + i] = g * __builtin_amdgcn_rcpf(1.f + __expf(-g)) * up; }
        u32x4 w; w.x = cvt_pk_bf16(o[0], o[1]); w.y = cvt_pk_bf16(o[2], o[3]); w.z = cvt_pk_bf16(o[4], o[5]); w.w = cvt_pk_bf16(o[6], o[7]);
        *(u32x4*)rowp = w; }
  }
};

template <class Epi, class Sched, bool ALIGN_EPI = false, bool SP2 = false>
__device__ __forceinline__ void gemm_phase(LAS unsigned char* lds, const Gemm g, const Sched& S, const Epi& E, const int wid) {
  int lane_o = lane_id(); asm volatile("" : "+v"(lane_o));
  const int lane = lane_o, tid = (wid << 6) | lane, wr = wid >> 2, wc = wid & 3, fr = lane & 15, fq = lane >> 4;
  const int K = g.K, nt = K / BK;
  unsigned voffA[2], voffB[2];
#pragma unroll
  for (int i = 0; i < 2; ++i) { int R, C; stage_rc(tid * 16 + i * 8192, R, C); const int Rb = Epi::PERM ? ((R & ~31) + perm32(R & 31)) : R;
    voffA[i] = (unsigned)(R * K + C) * 2u; voffB[i] = (unsigned)(Rb * K + C) * 2u; }
  const size_t kstep = (size_t)(BK * 2);
  const size_t hstep = (size_t)HALF * K * 2;
  const size_t tstep = 2 * hstep;
  const unsigned ldsw = (unsigned)wid * 1024u;
  const int aoff = lds_byte(wr * 64 + fr, fq * 8), boff = lds_byte(wc * 32 + fr, fq * 8);
#define PG8_SA(b, h) (((b) * 2 + (h)) * HTB)
#define PG8_SB(b, h) ((4 + (b) * 2 + (h)) * HTB)
#define PG8_STAGE(bufoff, gbase, voff) do { _Pragma("unroll") for (int _i = 0; _i < 2; ++_i) \
    __builtin_amdgcn_global_load_lds((const unsigned*)((const char*)(gbase) + (voff)[_i]), (LAS unsigned*)(lds + (bufoff) + ldsw + _i * 8192), 16, 0, 0); } while (0)
#define PG8_LDA(dst, b, h) do { _Pragma("unroll") for (int m = 0; m < 4; ++m) _Pragma("unroll") for (int k = 0; k < 2; ++k) dst[m][k] = *(const LAS bf16x8*)(lds + PG8_SA(b, h) + aoff + m * 2048 + k * 1024); } while (0)
#define PG8_LDB(dst, b, h) do { _Pragma("unroll") for (int n = 0; n < 2; ++n) _Pragma("unroll") for (int k = 0; k < 2; ++k) dst[n][k] = *(const LAS bf16x8*)(lds + PG8_SB(b, h) + boff + n * 2048 + k * 1024); } while (0)
#define PG8_MMA(ai, bj, At, Bt) do { __builtin_amdgcn_s_setprio(1); _Pragma("unroll") for (int m = 0; m < 4; ++m) _Pragma("unroll") for (int n = 0; n < 2; ++n) _Pragma("unroll") for (int k = 0; k < 2; ++k) \
    acc[ai][bj][m][n] = __builtin_amdgcn_mfma_f32_16x16x32_bf16(Bt[n][k], At[m][k], acc[ai][bj][m][n], 0, 0, 0); __builtin_amdgcn_s_setprio(0); } while (0)
#define PG8_WAIT_V(n) asm volatile("s_waitcnt vmcnt(" #n ")" ::: "memory")
#define PG8_WAIT_L(n) asm volatile("s_waitcnt lgkmcnt(" #n ")" ::: "memory")
#define PG8_BAR __builtin_amdgcn_s_barrier()
#define PG8_SCHED __builtin_amdgcn_sched_barrier(0)
  Unit cur, nxt; int ui = 0;
  if (!S.next(0, cur)) return;
  f32x4 acc[2][2][4][2];
#pragma unroll
  for (int a = 0; a < 2; ++a)
#pragma unroll
    for (int b = 0; b < 2; ++b)
#pragma unroll
      for (int m = 0; m < 4; ++m)
#pragma unroll
        for (int n = 0; n < 2; ++n) acc[a][b][m][n] = (f32x4){0.f, 0.f, 0.f, 0.f};
  bf16x8 At[4][2], B0[2][2], B1[2][2];
  const char* cA = (const char*)g.A + (size_t)cur.pm * tstep; const char* cB = (const char*)g.Bt + (size_t)cur.pn * tstep;
  S.a_ready(cur);
  if constexpr (SP2) {
    PG8_STAGE(PG8_SB(0, 0), cB, voffB); PG8_STAGE(PG8_SB(0, 1), cB + hstep, voffB); PG8_STAGE(PG8_SA(0, 0), cA, voffA); PG8_STAGE(PG8_SA(0, 1), cA + hstep, voffA);
    if (wr == 1) PG8_BAR;
    PG8_WAIT_V(2); PG8_BAR;
    PG8_STAGE(PG8_SB(1, 0), cB + kstep, voffB); PG8_STAGE(PG8_SA(1, 0), cA + kstep, voffA); PG8_STAGE(PG8_SB(1, 1), cB + hstep + kstep, voffB);
    PG8_WAIT_V(6); PG8_BAR;
  } else {
    PG8_STAGE(PG8_SB(0, 0), cB, voffB); PG8_STAGE(PG8_SA(0, 0), cA, voffA); PG8_STAGE(PG8_SB(0, 1), cB + hstep, voffB); PG8_STAGE(PG8_SA(0, 1), cA + hstep, voffA);
    if (wr == 1) PG8_BAR;
    PG8_WAIT_V(4); PG8_BAR;
    PG8_STAGE(PG8_SB(1, 0), cB + kstep, voffB); PG8_STAGE(PG8_SA(1, 0), cA + kstep, voffA); PG8_STAGE(PG8_SB(1, 1), cB + hstep + kstep, voffB);
    PG8_WAIT_V(6); PG8_BAR;
  }
  for (;;) {
    const bool has_next = S.next(ui + 1, nxt);
    const char* nA = has_next ? (const char*)g.A + (size_t)nxt.pm * tstep : cA; const char* nB = has_next ? (const char*)g.Bt + (size_t)nxt.pn * tstep : cB;
    for (int t = 0; t < nt; t += 2) {
      const bool last = (t == nt - 2);
      const char* a1 = cA + (size_t)(t + 1) * kstep;
      const char* a2 = last ? nA : cA + (size_t)(t + 2) * kstep; const char* b2 = last ? nB : cB + (size_t)(t + 2) * kstep;
      const char* a3 = a2 + kstep; const char* b3 = b2 + kstep;
      if (last && has_next) S.a_ready(nxt);
      if constexpr (SP2) {
        PG8_LDB(B0, 0, 0); PG8_LDB(B1, 0, 1); PG8_SCHED; PG8_LDA(At, 0, 0); PG8_STAGE(PG8_SA(1, 1), a1 + hstep, voffA);
        PG8_WAIT_V(8); PG8_WAIT_L(0); PG8_BAR; PG8_MMA(0, 0, At, B0); PG8_MMA(0, 1, At, B1); PG8_BAR; PG8_SCHED;
        PG8_LDA(At, 0, 1); PG8_STAGE(PG8_SB(0, 0), b2, voffB); PG8_STAGE(PG8_SB(0, 1), b2 + hstep, voffB); PG8_STAGE(PG8_SA(0, 0), a2, voffA);
        PG8_WAIT_V(8); PG8_WAIT_L(0); PG8_BAR; PG8_MMA(1, 0, At, B0); PG8_MMA(1, 1, At, B1); PG8_BAR; PG8_SCHED;
        PG8_LDB(B0, 1, 0); PG8_LDB(B1, 1, 1); PG8_SCHED; PG8_LDA(At, 1, 0); PG8_STAGE(PG8_SA(0, 1), a2 + hstep, voffA);
        PG8_WAIT_V(8); PG8_WAIT_L(0); PG8_BAR; PG8_MMA(0, 0, At, B0); PG8_MMA(0, 1, At, B1); PG8_BAR; PG8_SCHED;
        PG8_LDA(At, 1, 1); PG8_STAGE(PG8_SB(1, 0), b3, voffB); PG8_STAGE(PG8_SB(1, 1), b3 + hstep, voffB); PG8_STAGE(PG8_SA(1, 0), a3, voffA);
        PG8_WAIT_V(8); PG8_WAIT_L(0); PG8_BAR; PG8_MMA(1, 0, At, B0); PG8_MMA(1, 1, At, B1); PG8_BAR; PG8_SCHED;
      } else {
        PG8_LDB(B0, 0, 0); PG8_SCHED; PG8_LDA(At, 0, 0); PG8_STAGE(PG8_SA(1, 1), a1 + hstep, voffA);
        PG8_WAIT_L(8); PG8_BAR; PG8_WAIT_L(0); PG8_MMA(0, 0, At, B0); PG8_BAR; PG8_SCHED;
        PG8_LDB(B1, 0, 1); PG8_STAGE(PG8_SB(0, 0), b2, voffB);
        PG8_BAR; PG8_WAIT_L(0); PG8_MMA(0, 1, At, B1); PG8_BAR;
        PG8_LDA(At, 0, 1); PG8_STAGE(PG8_SA(0, 0), a2, voffA);
        PG8_BAR; PG8_WAIT_L(0); PG8_MMA(1, 0, At, B0); PG8_BAR; PG8_SCHED;
        PG8_STAGE(PG8_SB(0, 1), b2 + hstep, voffB);
        PG8_WAIT_V(6); PG8_BAR; PG8_MMA(1, 1, At, B1); PG8_BAR;
        PG8_LDB(B0, 1, 0); PG8_SCHED; PG8_LDA(At, 1, 0); PG8_STAGE(PG8_SA(0, 1), a2 + hstep, voffA);
        PG8_WAIT_L(8); PG8_BAR; PG8_WAIT_L(0); PG8_MMA(0, 0, At, B0); PG8_BAR; PG8_SCHED;
        PG8_LDB(B1, 1, 1); PG8_STAGE(PG8_SB(1, 0), b3, voffB);
        PG8_BAR; PG8_WAIT_L(0); PG8_MMA(0, 1, At, B1); PG8_BAR;
        PG8_LDA(At, 1, 1); PG8_STAGE(PG8_SA(1, 0), a3, voffA);
        PG8_BAR; PG8_WAIT_L(0); PG8_MMA(1, 0, At, B0); PG8_BAR; PG8_SCHED;
        PG8_STAGE(PG8_SB(1, 1), b3 + hstep, voffB);
        PG8_WAIT_V(6); PG8_BAR; PG8_MMA(1, 1, At, B1); PG8_BAR;
      }
    }
    if constexpr (ALIGN_EPI) { if (wr == 0) PG8_BAR; }
    if constexpr (!Epi::AFTER_DRAIN) { E(acc, cur, wr, wc, fr, fq); S.done(cur); }
    if (!has_next) break;
#pragma unroll
    for (int a = 0; a < 2; ++a)
#pragma unroll
      for (int b = 0; b < 2; ++b)
#pragma unroll
        for (int m = 0; m < 4; ++m)
#pragma unroll
          for (int n = 0; n < 2; ++n) acc[a][b][m][n] = (f32x4){0.f, 0.f, 0.f, 0.f};
    cur = nxt; cA = nA; cB = nB; ++ui;
    if constexpr (ALIGN_EPI) { if (wr == 1) PG8_BAR; }
  }
  PG8_WAIT_V(0);
  if constexpr (!ALIGN_EPI) { if (wr == 0) PG8_BAR; }
  PG8_BAR;
#undef PG8_SA
#undef PG8_SB
#undef PG8_STAGE
#undef PG8_LDA
#undef PG8_LDB
#undef PG8_MMA
#undef PG8_WAIT_V
#undef PG8_WAIT_L
#undef PG8_BAR
#undef PG8_SCHED
}
}

typedef float f32x16 __attribute__((ext_vector_type(16)));
typedef float f32x8 __attribute__((ext_vector_type(8)));
typedef short s16x4 __attribute__((ext_vector_type(4)));
typedef __bf16 bfx8 __attribute__((ext_vector_type(8)));
#define MFMA32(a, b, c) __builtin_amdgcn_mfma_f32_32x32x16_bf16((a), (b), (c), 0, 0, 0)
__device__ __forceinline__ bf16x8 cvt8(f32x8 t) { return __builtin_bit_cast(bf16x8, __builtin_convertvector(t, bfx8)); }
__device__ __forceinline__ bf16x8 pack8(const f32x16& x, int s) {
  const f32x8 t = {x[8 * s], x[8 * s + 1], x[8 * s + 2], x[8 * s + 3], x[8 * s + 4], x[8 * s + 5], x[8 * s + 6], x[8 * s + 7]};
  return cvt8(t);
}
__device__ __forceinline__ f32x16 zero16() { f32x16 z; for (int i = 0; i < 16; ++i) z[i] = 0.f; return z; }
__device__ __forceinline__ unsigned off_b(unsigned row, unsigned ch) { return 256u * row + 16u * (ch ^ (((row & 3u) << 2) | ((row >> 2) & 3u))); }
__device__ __forceinline__ int swap12(int p) { return ((p & 1) << 1) | (p >> 1); }
__device__ __forceinline__ bf16x8 lds_rd128(LAS unsigned char* lds, unsigned off) { return *(const LAS bf16x8*)(lds + off); }
__device__ __forceinline__ bf16x8 lds_tr2(LAS unsigned char* lds, unsigned off_lo, unsigned off_hi) {
  const s16x4 lo = __builtin_amdgcn_ds_read_tr16_b64_v4i16((LAS s16x4*)(lds + off_lo));
  const s16x4 hi = __builtin_amdgcn_ds_read_tr16_b64_v4i16((LAS s16x4*)(lds + off_hi));
  return __builtin_shufflevector(lo, hi, 0, 1, 2, 3, 4, 5, 6, 7);
}
__device__ __forceinline__ void glds16(const void* g, LAS unsigned char* l) {
  unsigned keep; const unsigned dst = __builtin_amdgcn_readfirstlane((unsigned)(size_t)l);
  asm volatile("s_mov_b32 %0, m0\n\ts_mov_b32 m0, %2\n\ts_nop 0\n\tglobal_load_lds_dwordx4 %1, off\n\ts_mov_b32 m0, %0" : "=&s"(keep) : "v"(g), "s"(dst) : "memory");
}
__device__ __forceinline__ unsigned rowfrag_off(int lane, int mt, int ks) { return off_b(32 * mt + (lane & 31), 2 * ks + (lane >> 5)); }
__device__ __forceinline__ unsigned vtr_off(int lane, int cb, int ks, int sec) {
  const int g = lane >> 4, i = lane & 15, hh = g >> 1, half16 = g & 1, qq = i >> 2, p = i & 3;
  const int row = 16 * ks + 4 * hh + 8 * sec + qq, col = cb + 16 * half16 + 4 * p;
  return off_b(row, col >> 3) + (col & 7) * 2;
}
__device__ __forceinline__ unsigned ktr_off(int lane, int mt, int ks, int sec) {
  const int g = lane >> 4, i = lane & 15, hh = g >> 1, half16 = g & 1, qq = i >> 2, p = i & 3;
  const int row = 16 * ks + 4 * hh + 8 * sec + qq, col = 32 * mt + 16 * half16 + 4 * swap12(p);
  return off_b(row, col >> 3) + (col & 7) * 2;
}
__device__ __forceinline__ int crow(int reg, int h) { return (reg & 3) + 8 * (reg >> 2) + 4 * h; }
__device__ __forceinline__ int srow(int reg, int h) { return 16 * (reg >> 3) + 8 * h + 4 * ((reg >> 2) & 1) + (reg & 3); }
__device__ __forceinline__ void rowscale(f32x16& a, const LAS float* vec, int h, float sgn) {
#pragma unroll
  for (int g4 = 0; g4 < 4; ++g4) { const f32x4 s = *(const LAS f32x4*)(vec + 8 * g4 + 4 * h);
    a[4 * g4] *= s.x * sgn; a[4 * g4 + 1] *= s.y * sgn; a[4 * g4 + 2] *= s.z * sgn; a[4 * g4 + 3] *= s.w * sgn; }
}
__device__ __forceinline__ void stage_img_piece(const unsigned char* src, size_t pitch, LAS unsigned char* img, int pc, int lane) {
  const unsigned row = 4 * pc + (lane >> 4), chp = lane & 15, ch = chp ^ (((row & 3u) << 2) | ((row >> 2) & 3u));
  glds16(src + (size_t)row * pitch + ch * 16, img + 1024 * pc);
}
constexpr int SC_BUF = 66560, SC_Q = 0, SC_K = 16384, SC_M = 32768, SC_V = 50176, SC_VEC = 2 * SC_BUF;
constexpr int DN_BLOB = 17408, RT_BLOB = 8192;
__device__ __forceinline__ void glds16_s(const unsigned char* base_uniform, unsigned voff, LAS unsigned char* l) {
  unsigned keep; const unsigned dst = __builtin_amdgcn_readfirstlane((unsigned)(size_t)l);
  const unsigned long long b = (unsigned long long)(size_t)base_uniform;
  const unsigned long long bs = ((unsigned long long)(unsigned)__builtin_amdgcn_readfirstlane((unsigned)(b >> 32)) << 32) | (unsigned)__builtin_amdgcn_readfirstlane((unsigned)b);
  asm volatile("s_mov_b32 %0, m0\n\ts_mov_b32 m0, %3\n\ts_nop 0\n\tglobal_load_lds_dwordx4 %1, %2\n\ts_mov_b32 m0, %0" : "=&s"(keep) : "v"(voff), "s"(bs), "s"(dst) : "memory");
}
struct StageOff { unsigned q[2], k[2], m; };
__device__ __forceinline__ StageOff scan_stage_offsets(int w, int lane, unsigned kpitch) {
  StageOff o;
#pragma unroll
  for (int i = 0; i < 2; ++i) { const unsigned pc = w + 8 * i, row = 4 * pc + (lane >> 4), chp = lane & 15, ch = chp ^ (((row & 3u) << 2) | ((row >> 2) & 3u));
    o.q[i] = row * (unsigned)(LDQ * 2) + ch * 16; o.k[i] = row * kpitch + ch * 16; }
  o.m = lane * 16;
  return o;
}
__device__ __forceinline__ void scan_stage(LAS unsigned char* lds, int buf, int type, int dir, int h, int gc, const bf16_t* QKV, const bf16_t* KBUF,
                                           const unsigned char* MATS_RT, const unsigned char* MATS_DN, int half, int w, const StageOff& so) {
  const size_t row0 = (size_t)gc * 64;
  const unsigned char* rowp = (const unsigned char*)(QKV + row0 * LDQ);
  const unsigned char* qsrc = rowp + (type ? Q_DQ + h * DK : Q_RQ + h * DK) * 2;
  const unsigned char* ksrc = rowp + (type ? Q_DK + h * DK : Q_RK + h * DK) * 2;
  if (!type && dir) ksrc = (const unsigned char*)(KBUF + row0 * 512 + h * DK);
  const unsigned char* vsrc = rowp + (type ? Q_DV + h * DV : Q_RV + h * DV) * 2 + half * 256;
  LAS unsigned char* B = lds + buf * SC_BUF;
#pragma unroll
  for (int i = 0; i < 2; ++i) { const int pc = w + 8 * i;
    glds16_s(qsrc, so.q[i], B + SC_Q + 1024 * pc); glds16_s(ksrc, so.k[i], B + SC_K + 1024 * pc); glds16_s(vsrc, so.q[i], B + SC_V + 1024 * pc); }
  const unsigned char* blob = type ? MATS_DN + (size_t)((gc * 4 + h) * 2 + dir) * DN_BLOB : MATS_RT + (size_t)((gc * 4 + h) * 2 + dir) * RT_BLOB;
  const int np = type ? 17 : 8;
  for (int pc = w; pc < np; pc += 8) glds16_s(blob + pc * 1024, so.m, B + SC_M + pc * 1024);
}

__device__ __forceinline__ void transpose_item(const float* W, int ldw, int K, int src_col0, bf16_t* WT, int dst_row0, int k0, LAS float* scr, int lane) {
#pragma unroll 8
  for (int i = 0; i < 32; ++i) { const int kk = 2 * i + (lane >> 5); scr[kk * 33 + (lane & 31)] = W[(size_t)(k0 + kk) * ldw + src_col0 + (lane & 31)]; }
  asm volatile("s_waitcnt lgkmcnt(0)" ::: "memory");
  const int c = lane & 7;
#pragma unroll
  for (int j = 0; j < 4; ++j) { const int n = (lane >> 3) + 8 * j; const LAS float* s = scr + (8 * c) * 33 + n;
    u32x4 o; o.x = pk2(s[0 * 33], s[1 * 33]); o.y = pk2(s[2 * 33], s[3 * 33]); o.z = pk2(s[4 * 33], s[5 * 33]); o.w = pk2(s[6 * 33], s[7 * 33]);
    *(u32x4*)(WT + (size_t)(dst_row0 + n) * K + k0 + 8 * c) = o; }
  asm volatile("s_waitcnt lgkmcnt(0)" ::: "memory");
}

template <class ColMap> __device__ __forceinline__ void transpose_matrix(const float* W, int ldw, int K, int N, bf16_t* WT, ColMap cm, LAS float* scr, int gw, int ngw, int lane) {
  const int nblk = N / 32, items = (K / 64) * nblk;
  for (int it = gw; it < items; it += ngw) { const int kb = it / nblk, nb = it % nblk; transpose_item(W, ldw, K, cm(32 * nb), WT, 32 * nb, 64 * kb, scr, lane); }
}

__global__ void __launch_bounds__(NTHREADS) fwd_megakernel(Params p) {
  extern __shared__ __attribute__((aligned(16))) unsigned char lds_raw[];
  LAS unsigned char* lds = (LAS unsigned char*)lds_raw;
  cg::grid_group grid = cg::this_grid();
  volatile LAS unsigned* bar_st = (volatile LAS unsigned*)(lds + LDS_BYTES - 64);
  if (threadIdx.x < 2) bar_st[threadIdx.x] = 0u;
  __syncthreads();
  const XcdBarrier xbar = xcd_barrier_post((unsigned*)(p.ws + WS_BAR), bar_st);
  if (p.ws == nullptr) grid.sync();
#define GRID_BARRIER() xcd_barrier(xbar, wave)
  const int wave = __builtin_amdgcn_readfirstlane(threadIdx.x >> 6);
#define PHASE_TID() int lane_p = lane_id(); asm volatile("" : "+v"(lane_p)); const int lane = lane_p, tid = (wave << 6) | lane; (void)tid;
  const int G = gridDim.x, bid = blockIdx.x;
  const int gw = bid * NWAVES + wave, ngw = G * NWAVES;
  unsigned char* ws = p.ws;
  float* MOD = (float*)(ws + WS_MOD);
  f32x2* ROPE = (f32x2*)(ws + WS_ROPE);
  float* BA = (float*)(ws + WS_BA);
  float* DECLG = (float*)(ws + WS_MOD + 122880);
  bf16_t* WQKV = (bf16_t*)(ws + WS_WQKV); bf16_t* WGATE = (bf16_t*)(ws + WS_WGATE);
  bf16_t* WRO = (bf16_t*)(ws + WS_WRO); bf16_t* WDO = (bf16_t*)(ws + WS_WDO); bf16_t* WOUT = (bf16_t*)(ws + WS_WOUT);
  bf16_t* HB = (bf16_t*)(ws + WS_H);
  bf16_t* QKV = (bf16_t*)(ws + WS_QKV);
  bf16_t* KBUF = (bf16_t*)(ws + WS_KB); bf16_t* HALO = (bf16_t*)(ws + WS_HALO);
  unsigned char* MATS_RT = ws + WS_MATS_RT; unsigned char* MATS_DN = ws + WS_MATS_DN;
  unsigned char* LSCR = ws + WS_O; constexpr int LSCR_STRIDE = 16896;
  bf16_t* ODF = (bf16_t*)(ws + WS_O); bf16_t* ODB = ODF + (size_t)MTOT * D;
  bf16_t* ORF = (bf16_t*)p.out; bf16_t* ORB = ORF + (size_t)MTOT * D;
  float* NS_RET = p.out + (size_t)MTOT * D; float* NS_DN = NS_RET + (size_t)NCTX * 2 * NH * DK * DV;

  {
    PHASE_TID();
    LAS float* scr = (LAS float*)(lds + wave * 16384);
    transpose_matrix(p.in[I_WIN], INC, D, 4096, WQKV, [](int n) { return n < 2048 ? n : n + 1024; }, scr, gw, ngw, lane);
    transpose_matrix(p.in[I_WIN], INC, D, 4096, WGATE, [](int n) { return n < 1024 ? C_RG + n : (n < 2048 ? C_DZ + (n - 1024) : C_GR + (n - 2048)); }, scr, gw, ngw, lane);
    transpose_matrix(p.in[I_WRO], D, D, D, WRO, [](int n) { return n; }, scr, gw, ngw, lane);
    transpose_matrix(p.in[I_WDO], D, D, D, WDO, [](int n) { return n; }, scr, gw, ngw, lane);
    transpose_matrix(p.in[I_WOUT], D, D, D, WOUT, [](int n) { return n; }, scr, gw, ngw, lane);
    {
      __syncthreads();
      LAS float* scond = (LAS float*)lds;
      LAS float* red = scond + 5 * D;
      for (int i = tid; i < 5 * D; i += NTHREADS) { const int c = i >> 10, k = i & 1023; scond[i] = siluf(c == 0 ? p.in[I_CCTX][k] : p.in[I_C][(c - 1) * D + k]); }
      __syncthreads();
      for (int it = bid; it < 6 * D / 32; it += G) {
        const int col = it * 32 + (lane & 31), rpar = lane >> 5;
        float acc[5] = {0.f, 0.f, 0.f, 0.f, 0.f};
        const float* wm = p.in[I_WMOD] + (size_t)(128 * wave + rpar) * 6 * D + col;
#pragma unroll 16
        for (int i = 0; i < 64; ++i) { const float wv = wm[(size_t)(2 * i) * 6 * D]; const int k = 128 * wave + 2 * i + rpar;
#pragma unroll
          for (int c = 0; c < 5; ++c) acc[c] += scond[c * D + k] * wv; }
#pragma unroll
        for (int c = 0; c < 5; ++c) { acc[c] += __shfl_xor(acc[c], 32); if (lane < 32) red[(wave * 5 + c) * 32 + lane] = acc[c]; }
        __syncthreads();
        if (tid < 160) { const int c = tid >> 5, n = tid & 31; float s = 0.f;
#pragma unroll
          for (int ww = 0; ww < 8; ++ww) s += red[(ww * 5 + c) * 32 + n];
          MOD[c * 6 * D + it * 32 + n] = s + p.in[I_BMOD][it * 32 + n]; }
        __syncthreads();
      }
    }
    for (int i = bid * NTHREADS + tid; i < LLAT * 64; i += G * NTHREADS) { const int l = i >> 6, pr = i & 63;
      const float freq = powf(10000.f, -(float)(pr & 31) / 32.f); const float ang = (pr < 32 ? (float)(l >> 6) : (float)(l & 63)) * freq;
      ROPE[i] = (f32x2){cosf(ang), sinf(ang)}; }
    if (bid == 0 && tid < 8) DECLG[tid] = -softplusf(-p.in[I_DECAY][tid]);
  }
  GRID_BARRIER();

  {
    PHASE_TID();
    LAS float* wba = (LAS float*)lds;
    for (int i = tid; i < D * 16; i += NTHREADS) wba[(i & 15) * 1028 + (i >> 4)] = p.in[I_WIN][(size_t)(i >> 4) * INC + C_DB + (i & 15)];
    __syncthreads();
    const float* nw = p.in[I_NORMW];
    for (int m = gw; m < MTOT; m += ngw) {
      const float* xr = xrow(p, m); const float* md = MOD + (size_t)cond_of_row(m) * 6 * D;
      f32x4 x4[4], w4[4], sc4[4], sh4[4]; float s = 0.f;
#pragma unroll
      for (int j = 0; j < 4; ++j) { const int c0 = 4 * lane + 256 * j; x4[j] = *(const f32x4*)(xr + c0); w4[j] = *(const f32x4*)(nw + c0); sc4[j] = *(const f32x4*)(md + D + c0); sh4[j] = *(const f32x4*)(md + c0); }
#pragma unroll
      for (int j = 0; j < 4; ++j) s += (x4[j].x * x4[j].x + x4[j].y * x4[j].y) + (x4[j].z * x4[j].z + x4[j].w * x4[j].w);
      const float r = rsqrtf(wave_sum(s) * (1.f / D) + EPS);
      float dots[16];
#pragma unroll
      for (int n = 0; n < 16; ++n) dots[n] = 0.f;
#pragma unroll
      for (int j = 0; j < 4; ++j) { const int c0 = 4 * lane + 256 * j;
        const f32x4 h = x4[j] * r * w4[j] * (sc4[j] + 1.f) + sh4[j];
        u32x2 o; o.x = pk2(h.x, h.y); o.y = pk2(h.z, h.w);
        *(u32x2*)(HB + (size_t)m * D + c0) = o;
#pragma unroll
        for (int n = 0; n < 16; ++n) { const f32x4 wv = *(const LAS f32x4*)(wba + n * 1028 + c0); dots[n] += (h.x * wv.x + h.y * wv.y) + (h.z * wv.z + h.w * wv.w); }
        __builtin_amdgcn_sched_barrier(0);
      }
#pragma unroll
      for (int n = 0; n < 16; ++n) dots[n] = wave_sum(dots[n]);
      if (lane < 8) {
        float db = dots[0], da = dots[8];
#pragma unroll
        for (int n = 1; n < 8; ++n) { db = lane == n ? dots[n] : db; da = lane == n ? dots[8 + n] : da; }
        BA[(size_t)m * 16 + lane] = sigmf(db);
        BA[(size_t)m * 16 + 8 + lane] = -expf(p.in[I_ALOG][lane]) * softplusf(da + p.in[I_DTB][lane]);
      }
    }
  }
  GRID_BARRIER();

  {
    pg8::Gemm g{HB, WQKV, MTOT, 4096, D}; pg8::StaticOrder S; S.init(MTOT, 4096, G, bid);
    pg8::EpiQKV E{QKV, LDQ, HALO};
    pg8::gemm_phase<pg8::EpiQKV, pg8::StaticOrder, true, true>(lds, g, S, E, wave);
  }
  GRID_BARRIER();

  {
    PHASE_TID();
    constexpr int PI_RQ = 0, PI_RK = 16384, PI_DQ = 32768, PI_DK = 49152;
    constexpr int PM_QKR = 65536, PM_QKD = PM_QKR + 17408, PM_KKD = PM_QKD + 17408;
    constexpr int PV = PM_KKD + 17408;
    constexpr int PL_F = 0, PL_B = 17408, PT_F = 34816, PT_B = 52224;
    const int w = wave;
    const float* cw = p.in[I_CONVW];
    u32x4 qraw[2], kraw[2], rawa[2][2][3], rawb[4][3]; float ba4[4] = {0.f, 0.f, 0.f, 0.f};
#define P2_LOADS(ITEM, TID) do { const int gc_ = (ITEM) >> 2, h_ = (ITEM) & 3, row0_ = gc_ * 64; const bool lat_ = row0_ >= MCTX; \
      const int L_ = lat_ ? LLAT : LCTX, t0_ = lat_ ? ((row0_ - MCTX) & (LLAT - 1)) : (row0_ & (LCTX - 1)); \
      const size_t s1m_ = (size_t)row0_ + ((TID) >> 3); \
      _Pragma("unroll") for (int c = 0; c < 2; ++c) { const int ch = ((TID) & 7) * 2 + c; \
        qraw[c] = *(const u32x4*)(QKV + s1m_ * LDQ + Q_RQ + h_ * DK + ch * 8); kraw[c] = *(const u32x4*)(QKV + s1m_ * LDQ + Q_RK + h_ * DK + ch * 8); } \
      _Pragma("unroll") for (int ps = 0; ps < 2; ++ps) _Pragma("unroll") for (int wh = 0; wh < 2; ++wh) _Pragma("unroll") for (int wd = 0; wd < 3; ++wd) { \
          const int row = ((TID) >> 4) + 32 * ps, rr = row + wd - 1, t = t0_ + rr; const int dch = wh * 512 + h_ * DK + ((TID) & 15) * 8; \
          u32x4 x = (u32x4){0u, 0u, 0u, 0u}; \
          if (t >= 0 && t < L_) { \
            if (rr < 0) x = *(const u32x4*)(HALO + ((size_t)(gc_ - 1) * 2 + 1) * 2048 + dch); \
            else if (rr > 63) x = *(const u32x4*)(HALO + ((size_t)(gc_ + 1) * 2 + 0) * 2048 + dch); \
            else x = *(const u32x4*)(QKV + (size_t)(row0_ + rr) * LDQ + Q_DQ + dch); } \
          rawa[ps][wh][wd] = x; } \
      _Pragma("unroll") for (int n = 0; n < 4; ++n) _Pragma("unroll") for (int wd = 0; wd < 3; ++wd) { \
          const int idx = (TID) + 512 * n, row = idx >> 5, ch = idx & 31, rr = row + wd - 1, t = t0_ + rr; const int dch = 1024 + h_ * DV + ch * 8; \
          u32x4 x = (u32x4){0u, 0u, 0u, 0u}; \
          if (t >= 0 && t < L_) { \
            if (rr < 0) x = *(const u32x4*)(HALO + ((size_t)(gc_ - 1) * 2 + 1) * 2048 + dch); \
            else if (rr > 63) x = *(const u32x4*)(HALO + ((size_t)(gc_ + 1) * 2 + 0) * 2048 + dch); \
            else x = *(const u32x4*)(QKV + (size_t)(row0_ + rr) * LDQ + Q_DQ + dch); } \
          rawb[n][wd] = x; } \
      if ((TID) < 64) { const float* ba = BA + (size_t)(row0_ + (TID)) * 16; ba4[0] = ba[h_]; ba4[1] = ba[4 + h_]; ba4[2] = ba[8 + h_]; ba4[3] = ba[12 + h_]; } } while (0)
    if (bid < 768) { int lane_q = lane_id(); asm volatile("" : "+v"(lane_q)); const int tid_q = (wave << 6) | lane_q; P2_LOADS(bid, tid_q); }
    for (int item = bid; item < 768; item += G) {
      int lane_o = lane_id(); asm volatile("" : "+v"(lane_o));
      const int lane = lane_o, tid = (wave << 6) | lane, r32 = lane & 31, hl = lane >> 5;
      const int gc = item >> 2, h = item & 3, row0 = gc * 64; const bool lat = row0 >= MCTX;
      const int t0 = lat ? ((row0 - MCTX) & (LLAT - 1)) : (row0 & (LCTX - 1));
      const float lgf = DECLG[h], lgb = DECLG[4 + h];
      const int s1row = tid >> 3; const size_t s1m = (size_t)row0 + s1row;
      const int ach = tid & 15;
      asm volatile("s_waitcnt vmcnt(0)" ::: "memory");
      __syncthreads();
      const float ba_bf = ba4[0], ba_bb = ba4[1], ba_af = ba4[2], ba_ab = ba4[3];
      {
        const int row = s1row; const size_t m = s1m;
        const float kfs = __expf(lgf * (float)(63 - row)), kbs = __expf(lgb * (float)row);
#pragma unroll
        for (int c = 0; c < 2; ++c) { const int ch = (tid & 7) * 2 + c;
          bf16_t* qp = QKV + m * LDQ + Q_RQ + h * DK + ch * 8; bf16_t* kp = QKV + m * LDQ + Q_RK + h * DK + ch * 8;
          const u32x4 qw = qraw[c], kw = kraw[c];
          float q[8] = {lo_bf(qw.x), hi_bf(qw.x), lo_bf(qw.y), hi_bf(qw.y), lo_bf(qw.z), hi_bf(qw.z), lo_bf(qw.w), hi_bf(qw.w)};
          float k[8] = {lo_bf(kw.x), hi_bf(kw.x), lo_bf(kw.y), hi_bf(kw.y), lo_bf(kw.z), hi_bf(kw.z), lo_bf(kw.w), hi_bf(kw.w)};
#pragma unroll
          for (int e = 0; e < 8; ++e) q[e] *= QSCALE;
          if (lat) {
#pragma unroll
            for (int e = 0; e < 4; ++e) { const f32x2 cs = ROPE[(t0 + row) * 64 + ch * 4 + e];
              const float a = q[2 * e] * cs.x - q[2 * e + 1] * cs.y, b = q[2 * e] * cs.y + q[2 * e + 1] * cs.x; q[2 * e] = a; q[2 * e + 1] = b;
              const float c2 = k[2 * e] * cs.x - k[2 * e + 1] * cs.y, d2 = k[2 * e] * cs.y + k[2 * e + 1] * cs.x; k[2 * e] = c2; k[2 * e + 1] = d2; }
          }
          u32x4 o; o.x = pk2(q[0], q[1]); o.y = pk2(q[2], q[3]); o.z = pk2(q[4], q[5]); o.w = pk2(q[6], q[7]);
          *(u32x4*)qp = o; *(LAS u32x4*)(lds + PI_RQ + off_b(row, ch)) = o;
          o.x = pk2(k[0], k[1]); o.y = pk2(k[2], k[3]); o.z = pk2(k[4], k[5]); o.w = pk2(k[6], k[7]);
          *(LAS u32x4*)(lds + PI_RK + off_b(row, ch)) = o;
          o.x = pk2(k[0] * kfs, k[1] * kfs); o.y = pk2(k[2] * kfs, k[3] * kfs); o.z = pk2(k[4] * kfs, k[5] * kfs); o.w = pk2(k[6] * kfs, k[7] * kfs);
          *(u32x4*)kp = o;
          o.x = pk2(k[0] * kbs, k[1] * kbs); o.y = pk2(k[2] * kbs, k[3] * kbs); o.z = pk2(k[4] * kbs, k[5] * kbs); o.w = pk2(k[6] * kbs, k[7] * kbs);
          *(u32x4*)(KBUF + m * 512 + h * DK + ch * 8) = o;
        }
      }
      {
        const int ch = ach;
#pragma unroll
        for (int ps = 0; ps < 2; ++ps)
#pragma unroll
          for (int wh = 0; wh < 2; ++wh) { const int row = (tid >> 4) + 32 * ps; const int dch = wh * 512 + h * DK + ch * 8;
            float a[8] = {0.f, 0.f, 0.f, 0.f, 0.f, 0.f, 0.f, 0.f};
#pragma unroll
            for (int wd = 0; wd < 3; ++wd) { const u32x4 x = rawa[ps][wh][wd]; const f32x4 w0 = *(const f32x4*)(cw + wd * 2048 + dch), w1 = *(const f32x4*)(cw + wd * 2048 + dch + 4);
              a[0] += lo_bf(x.x) * w0.x; a[1] += hi_bf(x.x) * w0.y; a[2] += lo_bf(x.y) * w0.z; a[3] += hi_bf(x.y) * w0.w;
              a[4] += lo_bf(x.z) * w1.x; a[5] += hi_bf(x.z) * w1.y; a[6] += lo_bf(x.w) * w1.z; a[7] += hi_bf(x.w) * w1.w; }
            float ss = 0.f;
#pragma unroll
            for (int e = 0; e < 8; ++e) { a[e] = siluf(a[e]); ss += a[e] * a[e]; }
            ss += __shfl_xor(ss, 1); ss += __shfl_xor(ss, 2); ss += __shfl_xor(ss, 4); ss += __shfl_xor(ss, 8);
            const float sc = rsqrtf(ss + EPS) * (wh == 0 ? QSCALE : 1.f);
            u32x4 o; o.x = pk2(a[0] * sc, a[1] * sc); o.y = pk2(a[2] * sc, a[3] * sc); o.z = pk2(a[4] * sc, a[5] * sc); o.w = pk2(a[6] * sc, a[7] * sc);
            *(u32x4*)(QKV + (size_t)(row0 + row) * LDQ + Q_DQ + dch) = o;
            *(LAS u32x4*)(lds + (wh ? PI_DK : PI_DQ) + off_b(row, ch)) = o; }
      }
      {
#pragma unroll
        for (int n = 0; n < 4; ++n) { const int idx = tid + 512 * n, row = idx >> 5, ch = idx & 31; const int dch = 1024 + h * DV + ch * 8;
          float a[8] = {0.f, 0.f, 0.f, 0.f, 0.f, 0.f, 0.f, 0.f};
#pragma unroll
          for (int wd = 0; wd < 3; ++wd) { const u32x4 x = rawb[n][wd]; const f32x4 w0 = *(const f32x4*)(cw + wd * 2048 + dch), w1 = *(const f32x4*)(cw + wd * 2048 + dch + 4);
            a[0] += lo_bf(x.x) * w0.x; a[1] += hi_bf(x.x) * w0.y; a[2] += lo_bf(x.y) * w0.z; a[3] += hi_bf(x.y) * w0.w;
            a[4] += lo_bf(x.z) * w1.x; a[5] += hi_bf(x.z) * w1.y; a[6] += lo_bf(x.w) * w1.z; a[7] += hi_bf(x.w) * w1.w; }
          u32x4 o; o.x = pk2(siluf(a[0]), siluf(a[1])); o.y = pk2(siluf(a[2]), siluf(a[3])); o.z = pk2(siluf(a[4]), siluf(a[5])); o.w = pk2(siluf(a[6]), siluf(a[7]));
          *(u32x4*)(QKV + (size_t)(row0 + row) * LDQ + Q_DQ + dch) = o; }
      }
      if (item + G < 768) P2_LOADS(item + G, tid);
      __syncthreads();
      {
        const int mi = (w >> 1) & 1, nj = w & 1;
        if (w < 4) {
          f32x16 a1 = zero16(), a2 = zero16();
#pragma unroll 2
          for (int ks = 0; ks < 8; ++ks) { a1 = MFMA32(lds_rd128(lds + PI_RQ, rowfrag_off(lane, mi, ks)), lds_rd128(lds + PI_RK, rowfrag_off(lane, nj, ks)), a1);
            a2 = MFMA32(lds_rd128(lds + PI_DQ, rowfrag_off(lane, mi, ks)), lds_rd128(lds + PI_DK, rowfrag_off(lane, nj, ks)), a2); }
          LAS float* m1 = (LAS float*)(lds + PM_QKR); LAS float* m2 = (LAS float*)(lds + PM_QKD);
#pragma unroll
          for (int reg = 0; reg < 16; ++reg) { const int o = (32 * mi + crow(reg, hl)) * 68 + 32 * nj + r32; m1[o] = a1[reg]; m2[o] = a2[reg]; }
        } else {
          f32x16 a1 = zero16();
#pragma unroll 2
          for (int ks = 0; ks < 8; ++ks) a1 = MFMA32(lds_rd128(lds + PI_DK, rowfrag_off(lane, mi, ks)), lds_rd128(lds + PI_DK, rowfrag_off(lane, nj, ks)), a1);
          LAS float* m1 = (LAS float*)(lds + PM_KKD);
#pragma unroll
          for (int reg = 0; reg < 16; ++reg) m1[(32 * mi + crow(reg, hl)) * 68 + 32 * nj + r32] = a1[reg];
        }
      }
      LAS float* vecs = (LAS float*)(lds + PV);
      if (tid < 64) {
        const float bf = ba_bf, bb = ba_bb, af = ba_af, ab = ba_ab;
        float xf = af, xb = ab;
#pragma unroll
        for (int o = 1; o < 64; o <<= 1) { const float yf = __shfl_up(xf, o), yb = __shfl_up(xb, o); if (lane >= o) { xf += yf; xb += yb; } }
        const float totf = __shfl(xf, 63), totb = __shfl(xb, 63);
        vecs[tid] = bf; vecs[64 + tid] = bb; vecs[128 + tid] = xf; vecs[192 + tid] = totb - xb + ab;
        if (tid == 0) { vecs[256] = totf; vecs[257] = totb; }
      }
      __syncthreads();
      unsigned char* blob_rt = MATS_RT + (size_t)((gc * 4 + h) * 2) * RT_BLOB; unsigned char* blob_dn = MATS_DN + (size_t)((gc * 4 + h) * 2) * DN_BLOB;
      const int lp = tid & 63, fi = tid >> 6, fmt = fi >> 2, fks = fi & 3, frow = 32 * fmt + (lp & 31), fhq = lp >> 5;
      {
        const LAS float* m1 = (const LAS float*)(lds + PM_QKR); const LAS float* m2 = (const LAS float*)(lds + PM_QKD);
        const float gfi = vecs[128 + frow], gbi = vecs[192 + frow];
        f32x8 pf, pb, df, db;
#pragma unroll
        for (int jj = 0; jj < 8; ++jj) { const int j = 16 * fks + 8 * (jj >> 2) + 4 * fhq + (jj & 3);
          const float x = m1[frow * 68 + j], y = m2[frow * 68 + j];
          pf[jj] = j <= frow ? x * __expf(lgf * (float)(frow - j)) : 0.f; pb[jj] = j >= frow ? x * __expf(lgb * (float)(j - frow)) : 0.f;
          df[jj] = j <= frow ? y * __expf(gfi - vecs[128 + j]) : 0.f; db[jj] = j >= frow ? y * __expf(gbi - vecs[192 + j]) : 0.f; }
        *(bf16x8*)(blob_rt + (fi * 64 + lp) * 16) = cvt8(pf); *(bf16x8*)(blob_rt + RT_BLOB + (fi * 64 + lp) * 16) = cvt8(pb);
        *(bf16x8*)(blob_dn + 8192 + (fi * 64 + lp) * 16) = cvt8(df); *(bf16x8*)(blob_dn + DN_BLOB + 8192 + (fi * 64 + lp) * 16) = cvt8(db);
        const LAS float* m3 = (const LAS float*)(lds + PM_KKD);
        float* lf = (float*)(LSCR + (size_t)((gc * 4 + h) * 2) * LSCR_STRIDE); float* lb = (float*)(LSCR + (size_t)((gc * 4 + h) * 2 + 1) * LSCR_STRIDE);
#pragma unroll
        for (int n = 0; n < 8; ++n) { const int e = tid + 512 * n, i = e >> 6, j = e & 63; const float kk = m3[i * 68 + j];
          lf[e] = j < i ? vecs[i] * kk * __expf(vecs[128 + i] - vecs[128 + j]) : 0.f;
          lb[e] = j > i ? vecs[64 + i] * kk * __expf(vecs[192 + i] - vecs[192 + j]) : 0.f; }
        if (tid < 64) { lf[4096 + tid] = vecs[tid]; lb[4096 + tid] = vecs[64 + tid]; }
        if (tid < 64) { const float gf = vecs[128 + tid], gb = vecs[192 + tid], glf = vecs[256], glb = vecs[257];
          float* vf = (float*)(blob_dn + 16384); float* vb = (float*)(blob_dn + DN_BLOB + 16384);
          vf[tid] = __expf(gf); vf[64 + tid] = __expf(glf - gf); vb[tid] = __expf(gb); vb[64 + tid] = __expf(glb - gb);
          if (tid == 0) { vf[128] = __expf(glf); vb[128] = __expf(glb); } }
      }
    }
  }
  asm volatile("s_waitcnt vmcnt(0)" ::: "memory");
  __syncthreads();

  {
    PHASE_TID();
    LAS unsigned short* tl = (LAS unsigned short*)(lds + wave * 16384);
    for (int sv = wave; bid + G * (sv >> 1) < 768; sv += NWAVES) {
      const int it = 2 * (bid + G * (sv >> 1)) + (sv & 1);
      int lane_o = lane_id(); asm volatile("" : "+v"(lane_o));
      const int ln = lane_o; const bool flip = it & 1; const int cl = flip ? 63 - ln : ln;
      const float* Lm = (const float*)(LSCR + (size_t)it * LSCR_STRIDE);
      float T[64], Lr[64];
#pragma unroll
      for (int i = 0; i < 64; ++i) Lr[i] = Lm[(flip ? 63 - i : i) * 64 + cl];
      const float bc = Lm[4096 + cl];
      __builtin_amdgcn_sched_barrier(0);
#pragma unroll
      for (int i = 0; i < 64; ++i) {
        const float lrow = Lr[i];
        float t0 = (ln == i) ? 1.f : 0.f, t1 = 0.f;
#pragma unroll
        for (int j = 0; j < i; ++j) { const float lj = __int_as_float(__builtin_amdgcn_readlane(__float_as_int(lrow), j)); if (j & 1) t1 -= lj * T[j]; else t0 -= lj * T[j]; }
        T[i] = t0 + t1;
        __builtin_amdgcn_sched_barrier(0);
      }
#pragma unroll
      for (int i = 0; i < 64; ++i) tl[(flip ? 63 - i : i) * 72 + cl] = (unsigned short)f2bf(T[i] * bc);
      asm volatile("s_waitcnt lgkmcnt(0)" ::: "memory");
      unsigned char* blob = MATS_DN + (size_t)it * DN_BLOB;
      const int frow = ln & 31, fhq = ln >> 5;
#pragma unroll
      for (int f = 0; f < 8; ++f) { const int mt = f >> 2, ks = f & 3;
        const LAS unsigned short* rp = tl + (32 * mt + frow) * 72 + 16 * ks + 4 * fhq;
        const u32x2 lo = *(const LAS u32x2*)rp, hi = *(const LAS u32x2*)(rp + 8);
        *(u32x4*)(blob + (f * 64 + ln) * 16) = (u32x4){lo.x, lo.y, hi.x, hi.y}; }
      asm volatile("s_waitcnt lgkmcnt(0)" ::: "memory");
    }
  }
  GRID_BARRIER();

  {
    PHASE_TID();
    const int w = wave, cb = (w & 3) * 32; const bool act = w < 4;
    LAS float* qdec = (LAS float*)(lds + SC_VEC);
    const int stride = bid < 128 ? 1000000 : (G - 128);
    for (int item = bid; item < 640; item += stride) {
      const int ci = item >> 1, half = item & 1;
      int lane_c = lane_id(); asm volatile("" : "+v"(lane_c));
      const int lane = lane_c, tid = (wave << 6) | lane, r32 = lane & 31, hl = lane >> 5;
      int type, sq, h, dir, chunk0, nsteps; bool lat;
      if (ci < 64) { lat = true; type = ci >> 5; sq = (ci >> 3) & 3; h = (ci >> 1) & 3; dir = ci & 1; chunk0 = 64 + 32 * sq; nsteps = 32; }
      else { const int c = ci - 64; lat = false; type = c >> 7; sq = (c >> 3) & 15; h = (c >> 1) & 3; dir = c & 1; chunk0 = 4 * sq; nsteps = 4; }
      f32x16 S[4];
      {
        const float* s0 = (type ? p.in[I_SDN] : p.in[I_SRET]) + ((((size_t)sq * 2 + dir) * NH + h) * DK) * DV + 128 * half + cb + r32;
        if (lat) {
#pragma unroll
          for (int mt = 0; mt < 4; ++mt)
#pragma unroll
            for (int reg = 0; reg < 16; ++reg) S[mt][reg] = s0[(size_t)(32 * mt + srow(reg, hl)) * DV];
        } else {
#pragma unroll
          for (int mt = 0; mt < 4; ++mt) S[mt] = zero16();
        }
      }
      const float lg = DECLG[dir * 4 + h];
      const float c64 = __expf(64.f * lg);
      __syncthreads();
      if (tid < 64) qdec[tid] = __expf(lg * (dir ? (float)(64 - tid) : (float)(tid + 1)));
      const StageOff soff = scan_stage_offsets(w, lane, (!type && dir) ? 1024u : (unsigned)(LDQ * 2));
      scan_stage(lds, 0, type, dir, h, chunk0 + (dir ? nsteps - 1 : 0), QKV, KBUF, MATS_RT, MATS_DN, half, w, soff);
      bf16_t* O = type ? (dir ? ODB : ODF) : (dir ? ORB : ORF);
      for (int s = 0; s < nsteps; ++s) {
        int ln = lane; asm volatile("" : "+v"(ln));
        const int r32s = ln & 31, hls = ln >> 5;
        const int buf = s & 1, gc = chunk0 + (dir ? nsteps - 1 - s : s);
        asm volatile("s_waitcnt vmcnt(0)" ::: "memory");
        __syncthreads();
        if (s + 1 < nsteps) scan_stage(lds, buf ^ 1, type, dir, h, chunk0 + (dir ? nsteps - 2 - s : s + 1), QKV, KBUF, MATS_RT, MATS_DN, half, w, soff);
        if (!act) continue;
        LAS unsigned char* B = lds + buf * SC_BUF;
        bf16_t* ob = O + (size_t)gc * 64 * D + h * DV + 128 * half + cb + r32s;
#define SB_ do { __builtin_amdgcn_sched_barrier(0); asm volatile("" : "+v"(ln)); } while (0)
#define STORE_O(acc) do { _Pragma("unroll") for (int mt_ = 0; mt_ < 2; ++mt_) _Pragma("unroll") for (int s2_ = 0; s2_ < 2; ++s2_) { const bf16x8 pk_ = pack8(acc[mt_], s2_); \
                          _Pragma("unroll") for (int j_ = 0; j_ < 8; ++j_) ob[(size_t)(32 * mt_ + crow(8 * s2_ + j_, ln >> 5)) * D] = (bf16_t)pk_[j_]; } } while (0)
#define LOAD_BV() do { _Pragma("unroll") for (int ks_ = 0; ks_ < 4; ++ks_) Bv[ks_] = lds_tr2(B + SC_V, vtr_off(ln, cb, ks_, 0), vtr_off(ln, cb, ks_, 1)); } while (0)
#define ROWS_AB(acc, IMG) do { bf16x8 f0_[2], f1_[2]; \
            f0_[0] = lds_rd128(B + (IMG), rowfrag_off(ln, 0, 0)); f0_[1] = lds_rd128(B + (IMG), rowfrag_off(ln, 1, 0)); \
            _Pragma("unroll") for (int ks_ = 0; ks_ < 8; ++ks_) { \
              if (ks_ + 1 < 8) { f1_[0] = lds_rd128(B + (IMG), rowfrag_off(ln, 0, ks_ + 1)); f1_[1] = lds_rd128(B + (IMG), rowfrag_off(ln, 1, ks_ + 1)); } \
              const bf16x8 sb_ = pack8(S[ks_ >> 1], ks_ & 1); \
              acc[0] = MFMA32(f0_[0], sb_, acc[0]); acc[1] = MFMA32(f0_[1], sb_, acc[1]); \
              f0_[0] = f1_[0]; f0_[1] = f1_[1]; } } while (0)
#define ROWS_T(acc, IMG) do { bf16x8 f0_[2], f1_[2];   \
            f0_[0] = lds_rd128(B + (IMG), rowfrag_off(ln, 0, 0)); f0_[1] = lds_rd128(B + (IMG), rowfrag_off(ln, 1, 0)); \
            _Pragma("unroll") for (int ks_ = 0; ks_ < 8; ++ks_) { \
              if (ks_ + 1 < 8) { f1_[0] = lds_rd128(B + (IMG), rowfrag_off(ln, 0, ks_ + 1)); f1_[1] = lds_rd128(B + (IMG), rowfrag_off(ln, 1, ks_ + 1)); } \
              const bf16x8 sb_ = pack8(S[ks_ >> 1], ks_ & 1); \
              acc[0] = MFMA32(sb_, f0_[0], acc[0]); acc[1] = MFMA32(sb_, f0_[1], acc[1]); \
              f0_[0] = f1_[0]; f0_[1] = f1_[1]; } } while (0)
#define STORE_OT(acc) do { _Pragma("unroll") for (int nt_ = 0; nt_ < 2; ++nt_) { bf16_t* orow_ = obt + (size_t)(32 * nt_) * D; \
            _Pragma("unroll") for (int g_ = 0; g_ < 4; ++g_) { u32x2 w_; w_.x = pk2(acc[nt_][4 * g_], acc[nt_][4 * g_ + 1]); w_.y = pk2(acc[nt_][4 * g_ + 2], acc[nt_][4 * g_ + 3]); \
              *(u32x2*)(orow_ + 8 * g_) = w_; } } } while (0)
#define S_UPDATE(X, SCL) do { bf16x8 g0_[4], g1_[4]; \
            _Pragma("unroll") for (int mt_ = 0; mt_ < 4; ++mt_) g0_[mt_] = lds_tr2(B + SC_K, ktr_off(ln, mt_, 0, 0), ktr_off(ln, mt_, 0, 1)); \
            _Pragma("unroll") for (int mt_ = 0; mt_ < 4; ++mt_) S[mt_] = S[mt_] * (SCL); \
            _Pragma("unroll") for (int ks_ = 0; ks_ < 4; ++ks_) { \
              if (ks_ + 1 < 4) { _Pragma("unroll") for (int mt_ = 0; mt_ < 4; ++mt_) g1_[mt_] = lds_tr2(B + SC_K, ktr_off(ln, mt_, ks_ + 1, 0), ktr_off(ln, mt_, ks_ + 1, 1)); } \
              _Pragma("unroll") for (int mt_ = 0; mt_ < 4; ++mt_) S[mt_] = MFMA32(g0_[mt_], X[ks_], S[mt_]); \
              _Pragma("unroll") for (int mt_ = 0; mt_ < 4; ++mt_) g0_[mt_] = g1_[mt_]; } } while (0)
        bf16x8 Bv[4];
        if (type) {
          const LAS float* eg = (const LAS float*)(B + SC_M + 16384); const LAS float* cgv = eg + 64; const float egl = eg[128];
          bf16x8 Br[4];
          { f32x16 ra[2]; ra[0] = zero16(); ra[1] = zero16();
            ROWS_AB(ra, SC_K);
#pragma unroll
            for (int mt = 0; mt < 2; ++mt) { rowscale(ra[mt], eg + 32 * mt, ln >> 5, -1.f); Br[2 * mt] = pack8(ra[mt], 0); Br[2 * mt + 1] = pack8(ra[mt], 1); } }
          SB_;
          LOAD_BV();
          bf16x8 tf[8];
#pragma unroll
          for (int i = 0; i < 8; ++i) tf[i] = lds_rd128(B + SC_M, i * 1024 + ln * 16);
          f32x16 vn[2]; vn[0] = zero16(); vn[1] = zero16();
#pragma unroll
          for (int ks = 0; ks < 4; ++ks)
#pragma unroll
            for (int mt = 0; mt < 2; ++mt) { vn[mt] = MFMA32(tf[mt * 4 + ks], Bv[ks], vn[mt]); vn[mt] = MFMA32(tf[mt * 4 + ks], Br[ks], vn[mt]); }
          SB_;
          bf16x8 Bn[4], Bc[4];
#pragma unroll
          for (int mt = 0; mt < 2; ++mt) { Bn[2 * mt] = pack8(vn[mt], 0); Bn[2 * mt + 1] = pack8(vn[mt], 1); rowscale(vn[mt], cgv + 32 * mt, ln >> 5, 1.f); Bc[2 * mt] = pack8(vn[mt], 0); Bc[2 * mt + 1] = pack8(vn[mt], 1); }
          SB_;
          f32x16 oa[2]; oa[0] = zero16(); oa[1] = zero16();
          ROWS_T(oa, SC_Q);
          SB_;
#pragma unroll
          for (int i = 0; i < 8; ++i) tf[i] = lds_rd128(B + SC_M, 8192 + i * 1024 + ln * 16);
#pragma unroll
          for (int nt = 0; nt < 2; ++nt) oa[nt] = oa[nt] * eg[32 * nt + (ln & 31)];
#pragma unroll
          for (int ks = 0; ks < 4; ++ks)
#pragma unroll
            for (int nt = 0; nt < 2; ++nt) oa[nt] = MFMA32(Bn[ks], tf[nt * 4 + ks], oa[nt]);
          SB_;
          { bf16_t* obt = O + ((size_t)gc * 64 + (ln & 31)) * D + h * DV + 128 * half + cb + 4 * (ln >> 5); STORE_OT(oa); }
          SB_;
          S_UPDATE(Bc, egl);
          SB_;
        } else {
          f32x16 oa[2]; oa[0] = zero16(); oa[1] = zero16();
          ROWS_T(oa, SC_Q);
          SB_;
          LOAD_BV();
          bf16x8 tf[8];
#pragma unroll
          for (int i = 0; i < 8; ++i) tf[i] = lds_rd128(B + SC_M, i * 1024 + ln * 16);
#pragma unroll
          for (int nt = 0; nt < 2; ++nt) oa[nt] = oa[nt] * qdec[32 * nt + (ln & 31)];
#pragma unroll
          for (int ks = 0; ks < 4; ++ks)
#pragma unroll
            for (int nt = 0; nt < 2; ++nt) oa[nt] = MFMA32(Bv[ks], tf[nt * 4 + ks], oa[nt]);
          SB_;
          { bf16_t* obt = O + ((size_t)gc * 64 + (ln & 31)) * D + h * DV + 128 * half + cb + 4 * (ln >> 5); STORE_OT(oa); }
          SB_;
          S_UPDATE(Bv, c64);
          SB_;
        }
#undef SB_
#undef STORE_O
#undef LOAD_BV
#undef ROWS_AB
#undef ROWS_T
#undef STORE_OT
#undef S_UPDATE
      }
      if (!lat && act) {
        int ln3 = lane_id(); asm volatile("" : "+v"(ln3)); const int hl3 = ln3 >> 5;
        float* so = (type ? NS_DN : NS_RET) + ((((size_t)sq * 2 + dir) * NH + h) * DK) * DV + 128 * half + cb + (ln3 & 31);
#pragma unroll
        for (int mt = 0; mt < 4; ++mt)
#pragma unroll
          for (int reg = 0; reg < 16; ++reg) so[(size_t)(32 * mt + srow(reg, hl3)) * DV] = S[mt][reg];
      }
    }
  }
  GRID_BARRIER();

  bf16_t* GATES = QKV;
  {
    pg8::Gemm g{HB, WGATE, MTOT, 4096, D}; pg8::StaticOrder S; S.init(MTOT, 4096, G, bid);
    pg8::EpiBf16Act<1> E{GATES, LDG};
    pg8::gemm_phase<pg8::EpiBf16Act<1>, pg8::StaticOrder, true, true>(lds, g, S, E, wave);
  }
  GRID_BARRIER();

  bf16_t* AR = (bf16_t*)(ws + WS_AR); bf16_t* AD = (bf16_t*)(ws + WS_AD);
  {
    PHASE_TID();
    for (int m = gw; m < MTOT; m += ngw) {
      u32x2 rf[4], rb[4], df[4], db[4], gr[4], gd[4]; f32x4 gw4[4];
#pragma unroll
      for (int h = 0; h < 4; ++h) { const size_t base = (size_t)m * D + h * DV + 4 * lane;
        rf[h] = *(const u32x2*)(ORF + base); rb[h] = *(const u32x2*)(ORB + base); df[h] = *(const u32x2*)(ODF + base); db[h] = *(const u32x2*)(ODB + base);
        gr[h] = *(const u32x2*)(GATES + (size_t)m * LDG + G_RG + h * DV + 4 * lane); gd[h] = *(const u32x2*)(GATES + (size_t)m * LDG + G_DZ + h * DV + 4 * lane);
        gw4[h] = *(const f32x4*)(p.in[I_GNW] + h * DV + 4 * lane); }
      const f32x4 dw4 = *(const f32x4*)(p.in[I_DNW] + 4 * lane);
      float v[4][4], u[4][4], mu[4], rs[4], rd[4];
#pragma unroll
      for (int h = 0; h < 4; ++h) { v[h][0] = lo_bf(rf[h].x) + lo_bf(rb[h].x); v[h][1] = hi_bf(rf[h].x) + hi_bf(rb[h].x); v[h][2] = lo_bf(rf[h].y) + lo_bf(rb[h].y); v[h][3] = hi_bf(rf[h].y) + hi_bf(rb[h].y);
        u[h][0] = lo_bf(df[h].x) + lo_bf(db[h].x); u[h][1] = hi_bf(df[h].x) + hi_bf(db[h].x); u[h][2] = lo_bf(df[h].y) + lo_bf(db[h].y); u[h][3] = hi_bf(df[h].y) + hi_bf(db[h].y);
        mu[h] = (v[h][0] + v[h][1]) + (v[h][2] + v[h][3]); rd[h] = (u[h][0] * u[h][0] + u[h][1] * u[h][1]) + (u[h][2] * u[h][2] + u[h][3] * u[h][3]); }
#pragma unroll
      for (int o = 1; o < 64; o <<= 1) {
#pragma unroll
        for (int h = 0; h < 4; ++h) { mu[h] += __shfl_xor(mu[h], o); rd[h] += __shfl_xor(rd[h], o); } }
#pragma unroll
      for (int h = 0; h < 4; ++h) { mu[h] *= (1.f / DV); float q = 0.f;
#pragma unroll
        for (int e = 0; e < 4; ++e) { v[h][e] -= mu[h]; q += v[h][e] * v[h][e]; }
        rs[h] = q; }
#pragma unroll
      for (int o = 1; o < 64; o <<= 1) {
#pragma unroll
        for (int h = 0; h < 4; ++h) rs[h] += __shfl_xor(rs[h], o); }
#pragma unroll
      for (int h = 0; h < 4; ++h) { const size_t base = (size_t)m * D + h * DV + 4 * lane;
        const float r1 = rsqrtf(rs[h] * (1.f / DV) + EPS), r2 = rsqrtf(rd[h] * (1.f / DV) + EPS);
        u32x2 o; o.x = pk2(lo_bf(gr[h].x) * (v[h][0] * r1 * gw4[h].x), hi_bf(gr[h].x) * (v[h][1] * r1 * gw4[h].y)); o.y = pk2(lo_bf(gr[h].y) * (v[h][2] * r1 * gw4[h].z), hi_bf(gr[h].y) * (v[h][3] * r1 * gw4[h].w));
        *(u32x2*)(AR + base) = o;
        o.x = pk2(u[h][0] * r2 * dw4.x * lo_bf(gd[h].x), u[h][1] * r2 * dw4.y * hi_bf(gd[h].x)); o.y = pk2(u[h][2] * r2 * dw4.z * lo_bf(gd[h].y), u[h][3] * r2 * dw4.w * hi_bf(gd[h].y));
        *(u32x2*)(AD + base) = o; }
    }
  }
  GRID_BARRIER();

  bf16_t* T1 = HB;
  {
    pg8::Gemm g{AR, WRO, MTOT, D, D}; pg8::StaticOrder S; S.init(MTOT, D, G, bid);
    pg8::EpiGateMul E{T1, D, GATES + G_GR, LDG, nullptr};
    pg8::gemm_phase<pg8::EpiGateMul, pg8::StaticOrder, true, true>(lds, g, S, E, wave);
  }
  bf16_t* MERGED = T1;
  {
    pg8::Gemm g{AD, WDO, MTOT, D, D}; pg8::StaticOrder S; S.init(MTOT, D, G, bid);
    pg8::EpiGateMul E{MERGED, D, GATES + G_GD, LDG, T1};
    pg8::gemm_phase<pg8::EpiGateMul, pg8::StaticOrder, true, true>(lds, g, S, E, wave);
  }
  GRID_BARRIER();
  bf16_t* M1 = (bf16_t*)(ws + WS_O);
  bf16_t* X1B = (bf16_t*)(ws + WS_O + 24 * MiB);
  {
    pg8::Gemm g{MERGED, WOUT, MTOT, D, D}; pg8::StaticOrder S; S.init(MTOT, D, G, bid);
    pg8::EpiBf16Act<0> E{M1, D};
    pg8::gemm_phase<pg8::EpiBf16Act<0>, pg8::StaticOrder, true, true>(lds, g, S, E, wave);
  }
  GRID_BARRIER();

  bf16_t* WF1 = (bf16_t*)(ws + WS_WF1); bf16_t* WF2 = (bf16_t*)(ws + WS_WF2);
  {
    PHASE_TID();
    LAS float* scr = (LAS float*)(lds + wave * 16384);
    transpose_matrix(p.in[I_WF1], 2 * DFF, D, 2 * DFF, WF1, [](int n) { const int pn = n >> 8, w = n & 255; return w < 128 ? 128 * pn + w : DFF + 128 * pn + (w - 128); }, scr, gw, ngw, lane);
    transpose_matrix(p.in[I_WF2], D, DFF, D, WF2, [](int n) { return n; }, scr, gw, ngw, lane);
    const float* nw1 = p.in[I_NORMW] + D; const float* nw2 = p.in[I_NORMW] + 2 * D;
    for (int m0 = gw; m0 < MTOT; m0 += 2 * ngw) {
      f32x4 v[2][4], xv[2][4], g1v[2][4]; float s[2] = {0.f, 0.f};
#pragma unroll
      for (int u = 0; u < 2; ++u) { const int m = (m0 + u * ngw < MTOT) ? m0 + u * ngw : m0; const float* xr = xrow(p, m); const float* md = MOD + (size_t)cond_of_row(m) * 6 * D; const bf16_t* mr = M1 + (size_t)m * D;
#pragma unroll
        for (int j = 0; j < 4; ++j) { const int c0 = 4 * lane + 256 * j; { const u32x2 mw = *(const u32x2*)(mr + c0); v[u][j] = (f32x4){lo_bf(mw.x), hi_bf(mw.x), lo_bf(mw.y), hi_bf(mw.y)}; } xv[u][j] = *(const f32x4*)(xr + c0); g1v[u][j] = *(const f32x4*)(md + 2 * D + c0); } }
#pragma unroll
      for (int u = 0; u < 2; ++u)
#pragma unroll
        for (int j = 0; j < 4; ++j) s[u] += (v[u][j].x * v[u][j].x + v[u][j].y * v[u][j].y) + (v[u][j].z * v[u][j].z + v[u][j].w * v[u][j].w);
#pragma unroll
      for (int o = 1; o < 64; o <<= 1) { s[0] += __shfl_xor(s[0], o); s[1] += __shfl_xor(s[1], o); }
      float s2[2] = {0.f, 0.f};
#pragma unroll
      for (int u = 0; u < 2; ++u) { const int m = m0 + u * ngw; const float r = rsqrtf(s[u] * (1.f / D) + EPS);
#pragma unroll
        for (int j = 0; j < 4; ++j) { const int c0 = 4 * lane + 256 * j;
          v[u][j] = xv[u][j] + g1v[u][j] * (v[u][j] * r * *(const f32x4*)(nw1 + c0));
          if (m < MTOT) { u32x2 xo; xo.x = pk2(v[u][j].x, v[u][j].y); xo.y = pk2(v[u][j].z, v[u][j].w); *(u32x2*)(X1B + (size_t)m * D + c0) = xo; }
          s2[u] += (v[u][j].x * v[u][j].x + v[u][j].y * v[u][j].y) + (v[u][j].z * v[u][j].z + v[u][j].w * v[u][j].w); } }
#pragma unroll
      for (int o = 1; o < 64; o <<= 1) { s2[0] += __shfl_xor(s2[0], o); s2[1] += __shfl_xor(s2[1], o); }
#pragma unroll
      for (int u = 0; u < 2; ++u) { const int m = m0 + u * ngw; if (m >= MTOT) continue; const float* md = MOD + (size_t)cond_of_row(m) * 6 * D; const float r2 = rsqrtf(s2[u] * (1.f / D) + EPS);
#pragma unroll
        for (int j = 0; j < 4; ++j) { const int c0 = 4 * lane + 256 * j;
          const f32x4 h = v[u][j] * r2 * *(const f32x4*)(nw2 + c0) * (*(const f32x4*)(md + 4 * D + c0) + 1.f) + *(const f32x4*)(md + 3 * D + c0);
          u32x2 o; o.x = pk2(h.x, h.y); o.y = pk2(h.z, h.w); *(u32x2*)(HB + (size_t)m * D + c0) = o; } }
    }
  }
  GRID_BARRIER();

  bf16_t* ACT = QKV;
  {
    pg8::Gemm g{HB, WF1, MTOT, 2 * DFF, D}; pg8::StaticOrder S; S.init(MTOT, 2 * DFF, G, bid);
    pg8::EpiSwiGLU E{ACT, DFF};
    pg8::gemm_phase<pg8::EpiSwiGLU, pg8::StaticOrder, true, true>(lds, g, S, E, wave);
  }
  GRID_BARRIER();
  bf16_t* F = (bf16_t*)(ws + WS_O);
  {
    pg8::Gemm g{ACT, WF2, MTOT, D, DFF}; pg8::StaticOrder S; S.init(MTOT, D, G, bid);
    pg8::EpiBf16Act<0> E{F, D};
    pg8::gemm_phase<pg8::EpiBf16Act<0>, pg8::StaticOrder, true, true>(lds, g, S, E, wave);
  }
  GRID_BARRIER();
  {
    PHASE_TID();
    const float* nw3 = p.in[I_NORMW] + 3 * D;
    for (int m0 = gw; m0 < MTOT; m0 += 2 * ngw) {
      f32x4 v[2][4], xv[2][4], gv[2][4]; float s[2] = {0.f, 0.f};
#pragma unroll
      for (int u = 0; u < 2; ++u) { const int m = (m0 + u * ngw < MTOT) ? m0 + u * ngw : m0; const float* md = MOD + (size_t)cond_of_row(m) * 6 * D; const bf16_t* fr = F + (size_t)m * D; const bf16_t* xrow1 = X1B + (size_t)m * D;
#pragma unroll
        for (int j = 0; j < 4; ++j) { const int c0 = 4 * lane + 256 * j; { const u32x2 fw = *(const u32x2*)(fr + c0); v[u][j] = (f32x4){lo_bf(fw.x), hi_bf(fw.x), lo_bf(fw.y), hi_bf(fw.y)}; } { const u32x2 xw = *(const u32x2*)(xrow1 + c0); xv[u][j] = (f32x4){lo_bf(xw.x), hi_bf(xw.x), lo_bf(xw.y), hi_bf(xw.y)}; } gv[u][j] = *(const f32x4*)(md + 5 * D + c0); } }
#pragma unroll
      for (int u = 0; u < 2; ++u)
#pragma unroll
        for (int j = 0; j < 4; ++j) s[u] += (v[u][j].x * v[u][j].x + v[u][j].y * v[u][j].y) + (v[u][j].z * v[u][j].z + v[u][j].w * v[u][j].w);
#pragma unroll
      for (int o = 1; o < 64; o <<= 1) { s[0] += __shfl_xor(s[0], o); s[1] += __shfl_xor(s[1], o); }
#pragma unroll
      for (int u = 0; u < 2; ++u) { const int m = m0 + u * ngw; if (m >= MTOT) continue; const float r = rsqrtf(s[u] * (1.f / D) + EPS); float* orow = p.out + (size_t)m * D;
#pragma unroll
        for (int j = 0; j < 4; ++j) { const int c0 = 4 * lane + 256 * j; *(f32x4*)(orow + c0) = xv[u][j] + gv[u][j] * (v[u][j] * r * *(const f32x4*)(nw3 + c0)); } }
    }
  }
}

extern "C" void kernel_launch(void* const* d_in, const int* in_sizes, int n_in, void* d_out, int out_size, void* d_ws, size_t ws_size, hipStream_t stream) {
  static int grid_blocks = 0;
  if (!grid_blocks) {
    int dev = 0, cus = 0, per_cu = 0;
    (void)hipGetDevice(&dev);
    (void)hipDeviceGetAttribute(&cus, hipDeviceAttributeMultiprocessorCount, dev);
    (void)hipFuncSetAttribute((const void*)fwd_megakernel, hipFuncAttributeMaxDynamicSharedMemorySize, LDS_BYTES);
    (void)hipOccupancyMaxActiveBlocksPerMultiprocessor(&per_cu, (const void*)fwd_megakernel, NTHREADS, LDS_BYTES);
    if (per_cu < 1) per_cu = 1;
    grid_blocks = cus * per_cu;
    if (n_in != 21 || ws_size < WS_END) fprintf(stderr, "kernel_launch: unexpected n_in %d / ws_size %zu\n", n_in, ws_size);
    fprintf(stderr, "kernel_launch: cus %d per_cu %d grid %d ws %zu out %d\n", cus, per_cu, grid_blocks, ws_size, out_size);
  }
  (void)hipMemsetAsync((unsigned char*)d_ws + WS_BAR, 0, 16384, stream);
  Params p{};
  for (int i = 0; i < 21; ++i) p.in[i] = (const float*)d_in[i];
  p.out = (float*)d_out; p.ws = (unsigned char*)d_ws;
  void* args[] = {&p};
  hipError_t e = hipLaunchCooperativeKernel((const void*)fwd_megakernel, dim3(grid_blocks), dim3(NTHREADS), args, LDS_BYTES, stream);
  if (e != hipSuccess) fprintf(stderr, "cooperative launch failed: %s (grid %d)\n", hipGetErrorString(e), grid_blocks);
}
```

```cpp
#include <hip/hip_runtime.h>
#include <hip/hip_cooperative_groups.h>
#include <cstdio>
#include <cstdint>
namespace cg = cooperative_groups;

#define LAS __attribute__((address_space(3)))
typedef unsigned short bf16_t;
typedef short bf16x8 __attribute__((ext_vector_type(8)));
typedef float f32x4 __attribute__((ext_vector_type(4)));
typedef float f32x2 __attribute__((ext_vector_type(2)));
typedef unsigned u32x4 __attribute__((ext_vector_type(4)));
typedef unsigned u32x2 __attribute__((ext_vector_type(2)));

constexpr int D = 1024, MCTX = 4096, MLAT = 8192, MTOT = 12288, LCTX = 256, LLAT = 2048, NCTX = 16, NLAT = 4;
constexpr int NH = 4, DK = 128, DV = 256, DFF = 2816, INC = 8208;
constexpr float EPS = 1e-6f;
constexpr float QSCALE = 0.08838834764831845f;
constexpr int NTHREADS = 512, NWAVES = 8;
constexpr int LDS_BYTES = 135168;
constexpr int Q_RQ = 0, Q_RK = 512, Q_RV = 1024, Q_DQ = 2048, Q_DK = 2560, Q_DV = 3072, LDQ = 4096;
constexpr int G_RG = 0, G_DZ = 1024, G_GR = 2048, G_GD = 3072, LDG = 4096;
constexpr int C_RQ = 0, C_RG = 2048, C_DQ = 3072, C_DZ = 5120, C_DB = 6144, C_GR = 6160;

constexpr size_t MiB = 1u << 20;
constexpr size_t WS_MOD = 0;
constexpr size_t WS_ROPE = 128 * 1024;
constexpr size_t WS_BAR = 1152 * 1024;
constexpr size_t WS_BA = 1280 * 1024;
constexpr size_t WS_WQKV = 2 * MiB;
constexpr size_t WS_WGATE = 10 * MiB;
constexpr size_t WS_WRO = 18 * MiB, WS_WDO = 20 * MiB, WS_WOUT = 22 * MiB;
constexpr size_t WS_H = 24 * MiB;
constexpr size_t WS_QKV = 48 * MiB;
constexpr size_t WS_MATS_DN = 144 * MiB;
constexpr size_t WS_MATS_RT = 170 * MiB;
constexpr size_t WS_KB = 182 * MiB;
constexpr size_t WS_HALO = 194 * MiB;
constexpr size_t WS_O = 196 * MiB;
constexpr size_t WS_F1 = 244 * MiB;
constexpr size_t WS_END = 246 * MiB;
constexpr size_t WS_AR = 144 * MiB, WS_AD = 168 * MiB, WS_MERGED = 144 * MiB;
constexpr size_t WS_WF1 = 144 * MiB, WS_WF2 = 155 * MiB;

struct Params {
  const float* in[21];
  float* out;
  unsigned char* ws;
};
enum { I_XP = 0, I_XS, I_C, I_SRET, I_SDN, I_CCTX, I_WMOD, I_BMOD, I_NORMW, I_WIN, I_CONVW, I_DECAY, I_GNW, I_ALOG, I_DTB, I_DNW, I_WRO, I_WDO, I_WOUT, I_WF1, I_WF2 };

__device__ __forceinline__ float bf2f(unsigned short b) { return __uint_as_float((unsigned)b << 16); }
__device__ __forceinline__ unsigned f2bf(float f) { unsigned u = __float_as_uint(f); return (u + 0x7fffu + ((u >> 16) & 1u)) >> 16; }
typedef __bf16 bfx2_t __attribute__((ext_vector_type(2)));
__device__ __forceinline__ unsigned pk2(float lo, float hi) { const f32x2 t = {lo, hi}; return __builtin_bit_cast(unsigned, __builtin_convertvector(t, bfx2_t)); }
__device__ __forceinline__ unsigned cvt_pk_bf16(float lo, float hi) { return pk2(lo, hi); }

__device__ __forceinline__ float lo_bf(unsigned w) { return __uint_as_float(w << 16); }
__device__ __forceinline__ float hi_bf(unsigned w) { return __uint_as_float(w & 0xffff0000u); }
__device__ __forceinline__ float siluf(float x) { return x * __builtin_amdgcn_rcpf(1.f + __expf(-x)); }
__device__ __forceinline__ float sigmf(float x) { return __builtin_amdgcn_rcpf(1.f + __expf(-x)); }
__device__ __forceinline__ float softplusf(float x) { return x > 20.f ? x : log1pf(expf(x)); }
__device__ __forceinline__ float wave_sum(float v) {
#pragma unroll
  for (int o = 1; o < 64; o <<= 1) v += __shfl_xor(v, o);
  return v;
}
__device__ __forceinline__ int lane_id() { return (int)__builtin_amdgcn_mbcnt_hi(~0u, __builtin_amdgcn_mbcnt_lo(~0u, 0u)); }
__device__ __forceinline__ int cond_of_row(int m) { return m < MCTX ? 0 : 1 + (m - MCTX) / LLAT; }
__device__ __forceinline__ const float* xrow(const Params& p, int m) { return m < MCTX ? p.in[I_XP] + (size_t)m * D : p.in[I_XS] + (size_t)(m - MCTX) * D; }


__device__ __forceinline__ int lane_id();
#define XB_TMO      128
#define XB_XCNT(j)  (256  + 64 * (j))
#define XB_XSUB(j)  (1280 + 64 * (j))
#define XB_XGEN(j)  (2304 + 64 * (j))
#define XB_TOP      3328
#define XB_TOPGEN   3392
#define XCD_BAR_WORDS 3456
#define XB_SPIN_CAP (1u << 18)
__device__ __forceinline__ unsigned xb_ld(unsigned* p)              { return __hip_atomic_load(p, __ATOMIC_RELAXED, __HIP_MEMORY_SCOPE_AGENT); }
__device__ __forceinline__ unsigned xb_add(unsigned* p, unsigned v) { return __hip_atomic_fetch_add(p, v, __ATOMIC_RELAXED, __HIP_MEMORY_SCOPE_AGENT); }
__device__ __forceinline__ unsigned xb_xcc_id() { return (unsigned)__builtin_amdgcn_s_getreg((3 << 11) | 20) & 0xFu; }
#define XB_SPIN(cond, bar) do { unsigned _sp = 0; while (cond) { __builtin_amdgcn_s_sleep(1); \
    if ((++_sp & 255u) == 0u) { if (xb_ld(&(bar)[XB_TMO])) break; if (_sp > XB_SPIN_CAP) { atomicAdd(&(bar)[XB_TMO], 1u); break; } } } } while (0)
struct XcdBarrier { unsigned* bar; unsigned x; volatile LAS unsigned* st; };
__device__ __forceinline__ XcdBarrier xcd_barrier_post(unsigned* bar, volatile LAS unsigned* st) {
  XcdBarrier b; b.bar = bar; b.x = xb_xcc_id(); b.st = st;
  if (threadIdx.x == 0) (void)xb_add(&bar[XB_XCNT(b.x)], 1u);
  return b;
}
__device__ __forceinline__ void xcd_barrier_complete(unsigned* bar, unsigned x, unsigned& nloc, unsigned& nx) {
  const unsigned G = gridDim.x * gridDim.y * gridDim.z;
  unsigned sum, cnt, mine, sp = 0u;
  for (;;) {
    sum = 0u; cnt = 0u; mine = 0u;
#pragma unroll
    for (unsigned j = 0; j < 16; ++j) { const unsigned c = xb_ld(&bar[XB_XCNT(j)]); sum += c; cnt += (c > 0u) ? 1u : 0u; mine = (j == x) ? c : mine; }
    if (sum == G) break;
    __builtin_amdgcn_s_sleep(1);
    if ((++sp & 255u) == 0u) { if (xb_ld(&bar[XB_TMO])) break; if (sp > XB_SPIN_CAP) { atomicAdd(&bar[XB_TMO], 1u); break; } }
  }
  nloc = mine > 0u ? mine : 1u; nx = cnt > 0u ? cnt : 1u;
}
__device__ __forceinline__ void xcd_barrier(const XcdBarrier& b, const int wave) {
  asm volatile("s_waitcnt vmcnt(0)" ::: "memory");
  __syncthreads();
  if (wave == 0 && lane_id() == 0) {
    unsigned* bar = b.bar;
    __builtin_amdgcn_s_waitcnt(0);
    unsigned nloc = b.st[0], nx = b.st[1];
    if (nloc == 0u) { xcd_barrier_complete(bar, b.x, nloc, nx); b.st[0] = nloc; b.st[1] = nx; }
    const unsigned old = xb_add(&bar[XB_XSUB(b.x)], 1u);
    const unsigned gen = old / nloc;
    if (old + 1u == (gen + 1u) * nloc) {
      __builtin_amdgcn_fence(__ATOMIC_RELEASE, "agent");
      asm volatile("s_waitcnt vmcnt(0)" ::: "memory");
      const unsigned og = xb_add(&bar[XB_TOP], 1u);
      const unsigned tg = og / nx;
      if (og + 1u == (tg + 1u) * nx) xb_add(&bar[XB_TOPGEN], 1u);
      else XB_SPIN(xb_ld(&bar[XB_TOPGEN]) == tg, bar);
      __builtin_amdgcn_fence(__ATOMIC_ACQUIRE, "agent");
      xb_add(&bar[XB_XGEN(b.x)], 1u);
      asm volatile("s_waitcnt vmcnt(0)" ::: "memory");
    } else {
      XB_SPIN(xb_ld(&bar[XB_XGEN(b.x)]) == gen, bar);
      __builtin_amdgcn_fence(__ATOMIC_ACQUIRE, "agent");
      asm volatile("s_waitcnt vmcnt(0)" ::: "memory");
    }
  }
  __syncthreads();
}

namespace pg8 {
constexpr int BM = 256, BK = 64, HALF = 128, HTB = HALF * BK * 2, STAGE_BYTES = 8 * HTB, NXCD = 8, WGM = 8;
__host__ __device__ __forceinline__ int lds_byte(int r, int c) { const int st = (r >> 4) * 2 + (c >> 5), rr = r & 15, cc = c & 31, ob = rr * 64 + cc * 2; return st * 1024 + (ob ^ (((ob >> 9) & 1) << 5)); }
__host__ __device__ __forceinline__ void stage_rc(int b, int& R, int& C) { const int st = b / 1024, sb = b % 1024, swz = sb ^ (((sb >> 9) & 1) << 5); R = (st >> 1) * 16 + swz / 64; C = (st & 1) * 32 + (swz % 64) / 2; }
__host__ __device__ __forceinline__ int perm32(int rho) { const int n = rho >> 4, i = rho & 15; return 8 * (i >> 2) + 4 * n + (i & 3); }
struct Unit { int pm, pn; };
struct Gemm { const bf16_t* A; const bf16_t* Bt; int M, N, K; int ld; };
struct OneUnit {
  int pm, pn;
  __device__ __forceinline__ bool next(int i, Unit& u) const { if (i != 0) return false; u.pm = pm; u.pn = pn; return true; }
  __device__ __forceinline__ void a_ready(const Unit&) const {}
  __device__ __forceinline__ void done(const Unit&) const {}
};
struct StaticOrder {
  int nM, nN, nwg, G, c;
  __host__ __device__ void init(int M, int N, int G_, int c_) { nM = M / BM; nN = N / BM; nwg = nM * nN; G = G_; c = c_; }
  __host__ __device__ bool next(int i, Unit& u) const {
    const long L = (long)i * G + c; if (L >= nwg) return false;
    int wgid = (int)L; { const int q = nwg / NXCD, r = nwg % NXCD, xcd = wgid % NXCD, off = wgid / NXCD; wgid = (xcd < r ? xcd * (q + 1) : r * (q + 1) + (xcd - r) * q) + off; }
    const int nig = WGM * nN, gid = wgid / nig, fm = gid * WGM, gsz = (nM - fm) < WGM ? (nM - fm) : WGM;
    u.pm = fm + ((wgid % nig) % gsz); u.pn = (wgid % nig) / gsz; return true;
  }
  __device__ __forceinline__ void a_ready(const Unit&) const {}
  __device__ __forceinline__ void done(const Unit&) const {}
};

template <int MODE  > struct EpiBf16Act {
  static constexpr bool PERM = true, AFTER_DRAIN = false;
  bf16_t* O; int ldc;
  __device__ __forceinline__ void operator()(const f32x4 (&acc)[2][2][4][2], const Unit& u, int wr, int wc, int fr, int fq) const {
    const int row0 = u.pm * BM + wr * 64 + fr, col0 = u.pn * BM + wc * 32 + 8 * fq;
    const bool sg = u.pn >= 8;
#pragma unroll
    for (int ai = 0; ai < 2; ++ai)
#pragma unroll
      for (int m = 0; m < 4; ++m) { bf16_t* rowp = O + (size_t)(row0 + ai * HALF + m * 16) * ldc + col0;
#pragma unroll
        for (int bj = 0; bj < 2; ++bj) { f32x4 v0 = acc[ai][bj][m][0], v1 = acc[ai][bj][m][1];
          if (MODE == 1) {
#pragma unroll
            for (int i = 0; i < 4; ++i) { const float s0 = __builtin_amdgcn_rcpf(1.f + __expf(-v0[i])), s1 = __builtin_amdgcn_rcpf(1.f + __expf(-v1[i]));
              v0[i] = sg ? s0 : v0[i] * s0; v1[i] = sg ? s1 : v1[i] * s1; } }
          u32x4 w; w.x = cvt_pk_bf16(v0[0], v0[1]); w.y = cvt_pk_bf16(v0[2], v0[3]); w.z = cvt_pk_bf16(v1[0], v1[1]); w.w = cvt_pk_bf16(v1[2], v1[3]);
          *(u32x4*)(rowp + bj * HALF) = w; } }
  }
};
struct EpiQKV {
  static constexpr bool PERM = true, AFTER_DRAIN = false;
  bf16_t* O; int ldc; bf16_t* HALO;
  __device__ __forceinline__ void operator()(const f32x4 (&acc)[2][2][4][2], const Unit& u, int wr, int wc, int fr, int fq) const {
    const int row0 = u.pm * BM + wr * 64 + fr, col0 = u.pn * BM + wc * 32 + 8 * fq;
#pragma unroll
    for (int ai = 0; ai < 2; ++ai)
#pragma unroll
      for (int m = 0; m < 4; ++m) { const int row = row0 + ai * HALF + m * 16; bf16_t* rowp = O + (size_t)row * ldc + col0;
#pragma unroll
        for (int bj = 0; bj < 2; ++bj) { const f32x4 v0 = acc[ai][bj][m][0], v1 = acc[ai][bj][m][1];
          u32x4 w; w.x = cvt_pk_bf16(v0[0], v0[1]); w.y = cvt_pk_bf16(v0[2], v0[3]); w.z = cvt_pk_bf16(v1[0], v1[1]); w.w = cvt_pk_bf16(v1[2], v1[3]);
          *(u32x4*)(rowp + bj * HALF) = w;
          if (u.pn >= 8 && ((m == 0 && fr == 0) || (m == 3 && fr == 15)))
            *(u32x4*)(HALO + ((size_t)(row >> 6) * 2 + (m == 3 ? 1 : 0)) * 2048 + (col0 - 2048) + bj * HALF) = w; } }
  }
};
struct EpiGateMul {
  static constexpr bool PERM = true, AFTER_DRAIN = false;
  bf16_t* O; int ldc; const bf16_t* G; int ldg; const bf16_t* Add;
  __device__ __forceinline__ void operator()(const f32x4 (&acc)[2][2][4][2], const Unit& u, int wr, int wc, int fr, int fq) const {
    const int row0 = u.pm * BM + wr * 64 + fr, col0 = u.pn * BM + wc * 32 + 8 * fq;
#pragma unroll
    for (int ai = 0; ai < 2; ++ai)
#pragma unroll
      for (int m = 0; m < 4; ++m) { const size_t r = (size_t)(row0 + ai * HALF + m * 16);
#pragma unroll
        for (int bj = 0; bj < 2; ++bj) { const f32x4 v0 = acc[ai][bj][m][0], v1 = acc[ai][bj][m][1];
          const u32x4 g = *(const u32x4*)(G + r * ldg + col0 + bj * HALF);
          float o[8] = {v0[0] * lo_bf(g.x), v0[1] * hi_bf(g.x), v0[2] * lo_bf(g.y), v0[3] * hi_bf(g.y), v1[0] * lo_bf(g.z), v1[1] * hi_bf(g.z), v1[2] * lo_bf(g.w), v1[3] * hi_bf(g.w)};
          if (Add) { const u32x4 a = *(const u32x4*)(Add + r * ldc + col0 + bj * HALF);
            o[0] += lo_bf(a.x); o[1] += hi_bf(a.x); o[2] += lo_bf(a.y); o[3] += hi_bf(a.y); o[4] += lo_bf(a.z); o[5] += hi_bf(a.z); o[6] += lo_bf(a.w); o[7] += hi_bf(a.w); }
          u32x4 w; w.x = cvt_pk_bf16(o[0], o[1]); w.y = cvt_pk_bf16(o[2], o[3]); w.z = cvt_pk_bf16(o[4], o[5]); w.w = cvt_pk_bf16(o[6], o[7]);
          *(u32x4*)(O + r * ldc + col0 + bj * HALF) = w; } }
  }
};
struct EpiF32 {
  static constexpr bool PERM = false, AFTER_DRAIN = false;
  float* O; int ldc;
  __device__ __forceinline__ void operator()(const f32x4 (&acc)[2][2][4][2], const Unit& u, int wr, int wc, int fr, int fq) const {
    const int row0 = u.pm * BM + wr * 64 + fr, col0 = u.pn * BM + wc * 32 + 4 * fq;
#pragma unroll
    for (int ai = 0; ai < 2; ++ai)
#pragma unroll
      for (int m = 0; m < 4; ++m) { float* rowp = O + (size_t)(row0 + ai * HALF + m * 16) * ldc + col0;
#pragma unroll
        for (int bj = 0; bj < 2; ++bj)
#pragma unroll
          for (int n = 0; n < 2; ++n) *(f32x4*)(rowp + bj * HALF + n * 16) = acc[ai][bj][m][n]; }
  }
};
struct EpiSwiGLU {
  static constexpr bool PERM = true, AFTER_DRAIN = false;
  bf16_t* O; int ldc;
  __device__ __forceinline__ void operator()(const f32x4 (&acc)[2][2][4][2], const Unit& u, int wr, int wc, int fr, int fq) const {
    const int row0 = u.pm * BM + wr * 64 + fr, col0 = u.pn * HALF + wc * 32 + 8 * fq;
#pragma unroll
    for (int ai = 0; ai < 2; ++ai)
#pragma unroll
      for (int m = 0; m < 4; ++m) { bf16_t* rowp = O + (size_t)(row0 + ai * HALF + m * 16) * ldc + col0;
        float o[8];
#pragma unroll
        for (int n = 0; n < 2; ++n)
#pragma unroll
          for (int i = 0; i < 4; ++i) { const float g = acc[ai][0][m][n][i], up = acc[ai][1][m][n][i]; o[4 * n + i] = g * __builtin_amdgcn_rcpf(1.f + __expf(-g)) * up; }
        u32x4 w; w.x = cvt_pk_bf16(o[0], o[1]); w.y = cvt_pk_bf16(o[2], o[3]); w.z = cvt_pk_bf16(o[4], o[5]); w.w = cvt_pk_bf16(o[6], o[7]);
        *(u32x4*)rowp = w; }
  }
};

template <class Epi, class Sched, bool ALIGN_EPI = false, bool SP2 = false>
__device__ __forceinline__ void gemm_phase(LAS unsigned char* lds, const Gemm g, const Sched& S, const Epi& E, const int wid) {
  int lane_o = lane_id(); asm volatile("" : "+v"(lane_o));
  const int lane = lane_o, tid = (wid << 6) | lane, wr = wid >> 2, wc = wid & 3, fr = lane & 15, fq = lane >> 4;
  const int K = g.ld ? g.ld : g.K, nt = g.K / BK;
  unsigned voffA[2], voffB[2];
#pragma unroll
  for (int i = 0; i < 2; ++i) { int R, C; stage_rc(tid * 16 + i * 8192, R, C); const int Rb = Epi::PERM ? ((R & ~31) + perm32(R & 31)) : R;
    voffA[i] = (unsigned)(R * K + C) * 2u; voffB[i] = (unsigned)(Rb * K + C) * 2u; }
  const size_t kstep = (size_t)(BK * 2);
  const size_t hstep = (size_t)HALF * K * 2;
  const size_t tstep = 2 * hstep;
  const unsigned ldsw = (unsigned)wid * 1024u;
  const int aoff = lds_byte(wr * 64 + fr, fq * 8), boff = lds_byte(wc * 32 + fr, fq * 8);
#define PG8_SA(b, h) (((b) * 2 + (h)) * HTB)
#define PG8_SB(b, h) ((4 + (b) * 2 + (h)) * HTB)
#define PG8_STAGE(bufoff, gbase, voff) do { _Pragma("unroll") for (int _i = 0; _i < 2; ++_i) \
    __builtin_amdgcn_global_load_lds((const unsigned*)((const char*)(gbase) + (voff)[_i]), (LAS unsigned*)(lds + (bufoff) + ldsw + _i * 8192), 16, 0, 0); } while (0)
#define PG8_LDA(dst, b, h) do { _Pragma("unroll") for (int m = 0; m < 4; ++m) _Pragma("unroll") for (int k = 0; k < 2; ++k) dst[m][k] = *(const LAS bf16x8*)(lds + PG8_SA(b, h) + aoff + m * 2048 + k * 1024); } while (0)
#define PG8_LDB(dst, b, h) do { _Pragma("unroll") for (int n = 0; n < 2; ++n) _Pragma("unroll") for (int k = 0; k < 2; ++k) dst[n][k] = *(const LAS bf16x8*)(lds + PG8_SB(b, h) + boff + n * 2048 + k * 1024); } while (0)
#define PG8_MMA(ai, bj, At, Bt) do { __builtin_amdgcn_s_setprio(1); _Pragma("unroll") for (int m = 0; m < 4; ++m) _Pragma("unroll") for (int n = 0; n < 2; ++n) _Pragma("unroll") for (int k = 0; k < 2; ++k) \
    acc[ai][bj][m][n] = __builtin_amdgcn_mfma_f32_16x16x32_bf16(Bt[n][k], At[m][k], acc[ai][bj][m][n], 0, 0, 0); __builtin_amdgcn_s_setprio(0); } while (0)
#define PG8_WAIT_V(n) asm volatile("s_waitcnt vmcnt(" #n ")" ::: "memory")
#define PG8_WAIT_L(n) asm volatile("s_waitcnt lgkmcnt(" #n ")" ::: "memory")
#define PG8_BAR __builtin_amdgcn_s_barrier()
#define PG8_SCHED __builtin_amdgcn_sched_barrier(0)
  Unit cur, nxt; int ui = 0;
  if (!S.next(0, cur)) return;
  f32x4 acc[2][2][4][2];
#pragma unroll
  for (int a = 0; a < 2; ++a)
#pragma unroll
    for (int b = 0; b < 2; ++b)
#pragma unroll
      for (int m = 0; m < 4; ++m)
#pragma unroll
        for (int n = 0; n < 2; ++n) acc[a][b][m][n] = (f32x4){0.f, 0.f, 0.f, 0.f};
  bf16x8 At[4][2], B0[2][2], B1[2][2];
  const char* cA = (const char*)g.A + (size_t)cur.pm * tstep; const char* cB = (const char*)g.Bt + (size_t)cur.pn * tstep;
  S.a_ready(cur);
  if constexpr (SP2) {
    PG8_STAGE(PG8_SB(0, 0), cB, voffB); PG8_STAGE(PG8_SB(0, 1), cB + hstep, voffB); PG8_STAGE(PG8_SA(0, 0), cA, voffA); PG8_STAGE(PG8_SA(0, 1), cA + hstep, voffA);
    if (wr == 1) PG8_BAR;
    PG8_WAIT_V(2); PG8_BAR;
    PG8_STAGE(PG8_SB(1, 0), cB + kstep, voffB); PG8_STAGE(PG8_SA(1, 0), cA + kstep, voffA); PG8_STAGE(PG8_SB(1, 1), cB + hstep + kstep, voffB);
    PG8_WAIT_V(6); PG8_BAR;
  } else {
    PG8_STAGE(PG8_SB(0, 0), cB, voffB); PG8_STAGE(PG8_SA(0, 0), cA, voffA); PG8_STAGE(PG8_SB(0, 1), cB + hstep, voffB); PG8_STAGE(PG8_SA(0, 1), cA + hstep, voffA);
    if (wr == 1) PG8_BAR;
    PG8_WAIT_V(4); PG8_BAR;
    PG8_STAGE(PG8_SB(1, 0), cB + kstep, voffB); PG8_STAGE(PG8_SA(1, 0), cA + kstep, voffA); PG8_STAGE(PG8_SB(1, 1), cB + hstep + kstep, voffB);
    PG8_WAIT_V(6); PG8_BAR;
  }
  for (;;) {
    const bool has_next = S.next(ui + 1, nxt);
    const char* nA = has_next ? (const char*)g.A + (size_t)nxt.pm * tstep : cA; const char* nB = has_next ? (const char*)g.Bt + (size_t)nxt.pn * tstep : cB;
    for (int t = 0; t < nt; t += 2) {
      const bool last = (t == nt - 2);
      const char* a1 = cA + (size_t)(t + 1) * kstep;
      const char* a2 = last ? nA : cA + (size_t)(t + 2) * kstep; const char* b2 = last ? nB : cB + (size_t)(t + 2) * kstep;
      const char* a3 = a2 + kstep; const char* b3 = b2 + kstep;
      if (last && has_next) S.a_ready(nxt);
      if constexpr (SP2) {
        PG8_LDB(B0, 0, 0); PG8_LDB(B1, 0, 1); PG8_SCHED; PG8_LDA(At, 0, 0); PG8_STAGE(PG8_SA(1, 1), a1 + hstep, voffA);
        PG8_WAIT_V(8); PG8_WAIT_L(0); PG8_BAR; PG8_MMA(0, 0, At, B0); PG8_MMA(0, 1, At, B1); PG8_BAR; PG8_SCHED;
        PG8_LDA(At, 0, 1); PG8_STAGE(PG8_SB(0, 0), b2, voffB); PG8_STAGE(PG8_SB(0, 1), b2 + hstep, voffB); PG8_STAGE(PG8_SA(0, 0), a2, voffA);
        PG8_WAIT_V(8); PG8_WAIT_L(0); PG8_BAR; PG8_MMA(1, 0, At, B0); PG8_MMA(1, 1, At, B1); PG8_BAR; PG8_SCHED;
        PG8_LDB(B0, 1, 0); PG8_LDB(B1, 1, 1); PG8_SCHED; PG8_LDA(At, 1, 0); PG8_STAGE(PG8_SA(0, 1), a2 + hstep, voffA);
        PG8_WAIT_V(8); PG8_WAIT_L(0); PG8_BAR; PG8_MMA(0, 0, At, B0); PG8_MMA(0, 1, At, B1); PG8_BAR; PG8_SCHED;
        PG8_LDA(At, 1, 1); PG8_STAGE(PG8_SB(1, 0), b3, voffB); PG8_STAGE(PG8_SB(1, 1), b3 + hstep, voffB); PG8_STAGE(PG8_SA(1, 0), a3, voffA);
        PG8_WAIT_V(8); PG8_WAIT_L(0); PG8_BAR; PG8_MMA(1, 0, At, B0); PG8_MMA(1, 1, At, B1); PG8_BAR; PG8_SCHED;
      } else {
        PG8_LDB(B0, 0, 0); PG8_SCHED; PG8_LDA(At, 0, 0); PG8_STAGE(PG8_SA(1, 1), a1 + hstep, voffA);
        PG8_WAIT_L(8); PG8_BAR; PG8_WAIT_L(0); PG8_MMA(0, 0, At, B0); PG8_BAR; PG8_SCHED;
        PG8_LDB(B1, 0, 1); PG8_STAGE(PG8_SB(0, 0), b2, voffB);
        PG8_BAR; PG8_WAIT_L(0); PG8_MMA(0, 1, At, B1); PG8_BAR;
        PG8_LDA(At, 0, 1); PG8_STAGE(PG8_SA(0, 0), a2, voffA);
        PG8_BAR; PG8_WAIT_L(0); PG8_MMA(1, 0, At, B0); PG8_BAR; PG8_SCHED;
        PG8_STAGE(PG8_SB(0, 1), b2 + hstep, voffB);
        PG8_WAIT_V(6); PG8_BAR; PG8_MMA(1, 1, At, B1); PG8_BAR;
        PG8_LDB(B0, 1, 0); PG8_SCHED; PG8_LDA(At, 1, 0); PG8_STAGE(PG8_SA(0, 1), a2 + hstep, voffA);
        PG8_WAIT_L(8); PG8_BAR; PG8_WAIT_L(0); PG8_MMA(0, 0, At, B0); PG8_BAR; PG8_SCHED;
        PG8_LDB(B1, 1, 1); PG8_STAGE(PG8_SB(1, 0), b3, voffB);
        PG8_BAR; PG8_WAIT_L(0); PG8_MMA(0, 1, At, B1); PG8_BAR;
        PG8_LDA(At, 1, 1); PG8_STAGE(PG8_SA(1, 0), a3, voffA);
        PG8_BAR; PG8_WAIT_L(0); PG8_MMA(1, 0, At, B0); PG8_BAR; PG8_SCHED;
        PG8_STAGE(PG8_SB(1, 1), b3 + hstep, voffB);
        PG8_WAIT_V(6); PG8_BAR; PG8_MMA(1, 1, At, B1); PG8_BAR;
      }
    }
    if constexpr (ALIGN_EPI) { if (wr == 0) PG8_BAR; }
    if constexpr (!Epi::AFTER_DRAIN) { E(acc, cur, wr, wc, fr, fq); S.done(cur); }
    if (!has_next) break;
#pragma unroll
    for (int a = 0; a < 2; ++a)
#pragma unroll
      for (int b = 0; b < 2; ++b)
#pragma unroll
        for (int m = 0; m < 4; ++m)
#pragma unroll
          for (int n = 0; n < 2; ++n) acc[a][b][m][n] = (f32x4){0.f, 0.f, 0.f, 0.f};
    cur = nxt; cA = nA; cB = nB; ++ui;
    if constexpr (ALIGN_EPI) { if (wr == 1) PG8_BAR; }
  }
  PG8_WAIT_V(0);
  if constexpr (!ALIGN_EPI) { if (wr == 0) PG8_BAR; }
  PG8_BAR;
#undef PG8_SA
#undef PG8_SB
#undef PG8_STAGE
#undef PG8_LDA
#undef PG8_LDB
#undef PG8_MMA
#undef PG8_WAIT_V
#undef PG8_WAIT_L
#undef PG8_BAR
#undef PG8_SCHED
}
}

typedef float f32x16 __attribute__((ext_vector_type(16)));
typedef float f32x8 __attribute__((ext_vector_type(8)));
typedef short s16x4 __attribute__((ext_vector_type(4)));
typedef __bf16 bfx8 __attribute__((ext_vector_type(8)));
#define MFMA32(a, b, c) __builtin_amdgcn_mfma_f32_32x32x16_bf16((a), (b), (c), 0, 0, 0)
__device__ __forceinline__ bf16x8 cvt8(f32x8 t) { return __builtin_bit_cast(bf16x8, __builtin_convertvector(t, bfx8)); }
__device__ __forceinline__ bf16x8 pack8(const f32x16& x, int s) {
  const f32x8 t = {x[8 * s], x[8 * s + 1], x[8 * s + 2], x[8 * s + 3], x[8 * s + 4], x[8 * s + 5], x[8 * s + 6], x[8 * s + 7]};
  return cvt8(t);
}
__device__ __forceinline__ f32x16 zero16() { f32x16 z; for (int i = 0; i < 16; ++i) z[i] = 0.f; return z; }
__device__ __forceinline__ unsigned off_b(unsigned row, unsigned ch) { return 256u * row + 16u * (ch ^ (((row & 3u) << 2) | ((row >> 2) & 3u))); }
__device__ __forceinline__ int swap12(int p) { return ((p & 1) << 1) | (p >> 1); }
__device__ __forceinline__ bf16x8 lds_rd128(LAS unsigned char* lds, unsigned off) { return *(const LAS bf16x8*)(lds + off); }
__device__ __forceinline__ bf16x8 lds_tr2(LAS unsigned char* lds, unsigned off_lo, unsigned off_hi) {
  const s16x4 lo = __builtin_amdgcn_ds_read_tr16_b64_v4i16((LAS s16x4*)(lds + off_lo));
  const s16x4 hi = __builtin_amdgcn_ds_read_tr16_b64_v4i16((LAS s16x4*)(lds + off_hi));
  return __builtin_shufflevector(lo, hi, 0, 1, 2, 3, 4, 5, 6, 7);
}
__device__ __forceinline__ void glds16(const void* g, LAS unsigned char* l) {
  unsigned keep; const unsigned dst = __builtin_amdgcn_readfirstlane((unsigned)(size_t)l);
  asm volatile("s_mov_b32 %0, m0\n\ts_mov_b32 m0, %2\n\ts_nop 0\n\tglobal_load_lds_dwordx4 %1, off\n\ts_mov_b32 m0, %0" : "=&s"(keep) : "v"(g), "s"(dst) : "memory");
}
__device__ __forceinline__ unsigned rowfrag_off(int lane, int mt, int ks) { return off_b(32 * mt + (lane & 31), 2 * ks + (lane >> 5)); }
__device__ __forceinline__ unsigned vtr_off(int lane, int cb, int ks, int sec) {
  const int g = lane >> 4, i = lane & 15, hh = g >> 1, half16 = g & 1, qq = i >> 2, p = i & 3;
  const int row = 16 * ks + 4 * hh + 8 * sec + qq, col = cb + 16 * half16 + 4 * p;
  return off_b(row, col >> 3) + (col & 7) * 2;
}
__device__ __forceinline__ unsigned ktr_off(int lane, int mt, int ks, int sec) {
  const int g = lane >> 4, i = lane & 15, hh = g >> 1, half16 = g & 1, qq = i >> 2, p = i & 3;
  const int row = 16 * ks + 4 * hh + 8 * sec + qq, col = 32 * mt + 16 * half16 + 4 * swap12(p);
  return off_b(row, col >> 3) + (col & 7) * 2;
}
__device__ __forceinline__ int crow(int reg, int h) { return (reg & 3) + 8 * (reg >> 2) + 4 * h; }
__device__ __forceinline__ int srow(int reg, int h) { return 16 * (reg >> 3) + 8 * h + 4 * ((reg >> 2) & 1) + (reg & 3); }
__device__ __forceinline__ void rowscale(f32x16& a, const LAS float* vec, int h, float sgn) {
#pragma unroll
  for (int g4 = 0; g4 < 4; ++g4) { const f32x4 s = *(const LAS f32x4*)(vec + 8 * g4 + 4 * h);
    a[4 * g4] *= s.x * sgn; a[4 * g4 + 1] *= s.y * sgn; a[4 * g4 + 2] *= s.z * sgn; a[4 * g4 + 3] *= s.w * sgn; }
}
__device__ __forceinline__ void stage_img_piece(const unsigned char* src, size_t pitch, LAS unsigned char* img, int pc, int lane) {
  const unsigned row = 4 * pc + (lane >> 4), chp = lane & 15, ch = chp ^ (((row & 3u) << 2) | ((row >> 2) & 3u));
  glds16(src + (size_t)row * pitch + ch * 16, img + 1024 * pc);
}
constexpr int SC_BUF = 66560, SC_Q = 0, SC_K = 16384, SC_M = 32768, SC_V = 50176, SC_VEC = 2 * SC_BUF;
constexpr int DN_BLOB = 17408, RT_BLOB = 8192;
__device__ __forceinline__ void glds16_s(const unsigned char* base_uniform, unsigned voff, LAS unsigned char* l) {
  unsigned keep; const unsigned dst = __builtin_amdgcn_readfirstlane((unsigned)(size_t)l);
  const unsigned long long b = (unsigned long long)(size_t)base_uniform;
  const unsigned long long bs = ((unsigned long long)(unsigned)__builtin_amdgcn_readfirstlane((unsigned)(b >> 32)) << 32) | (unsigned)__builtin_amdgcn_readfirstlane((unsigned)b);
  asm volatile("s_mov_b32 %0, m0\n\ts_mov_b32 m0, %3\n\ts_nop 0\n\tglobal_load_lds_dwordx4 %1, %2\n\ts_mov_b32 m0, %0" : "=&s"(keep) : "v"(voff), "s"(bs), "s"(dst) : "memory");
}
struct StageOff { unsigned q[2], k[2], m; };
__device__ __forceinline__ StageOff scan_stage_offsets(int w, int lane, unsigned kpitch) {
  StageOff o;
#pragma unroll
  for (int i = 0; i < 2; ++i) { const unsigned pc = w + 8 * i, row = 4 * pc + (lane >> 4), chp = lane & 15, ch = chp ^ (((row & 3u) << 2) | ((row >> 2) & 3u));
    o.q[i] = row * (unsigned)(LDQ * 2) + ch * 16; o.k[i] = row * kpitch + ch * 16; }
  o.m = lane * 16;
  return o;
}
__device__ __forceinline__ void scan_stage(LAS unsigned char* lds, int buf, int type, int dir, int h, int gc, const bf16_t* QKV, const bf16_t* KBUF,
                                           const unsigned char* MATS_RT, const unsigned char* MATS_DN, int half, int w, const StageOff& so) {
  const size_t row0 = (size_t)gc * 64;
  const unsigned char* rowp = (const unsigned char*)(QKV + row0 * LDQ);
  const unsigned char* qsrc = rowp + (type ? Q_DQ + h * DK : Q_RQ + h * DK) * 2;
  const unsigned char* ksrc = rowp + (type ? Q_DK + h * DK : Q_RK + h * DK) * 2;
  if (!type && dir) ksrc = (const unsigned char*)(KBUF + row0 * 512 + h * DK);
  const unsigned char* vsrc = rowp + (type ? Q_DV + h * DV : Q_RV + h * DV) * 2 + half * 256;
  LAS unsigned char* B = lds + buf * SC_BUF;
#pragma unroll
  for (int i = 0; i < 2; ++i) { const int pc = w + 8 * i;
    glds16_s(qsrc, so.q[i], B + SC_Q + 1024 * pc); glds16_s(ksrc, so.k[i], B + SC_K + 1024 * pc); glds16_s(vsrc, so.q[i], B + SC_V + 1024 * pc); }
  const unsigned char* blob = type ? MATS_DN + (size_t)((gc * 4 + h) * 2 + dir) * DN_BLOB : MATS_RT + (size_t)((gc * 4 + h) * 2 + dir) * RT_BLOB;
  const int np = type ? 17 : 8;
  for (int pc = w; pc < np; pc += 8) glds16_s(blob + pc * 1024, so.m, B + SC_M + pc * 1024);
}

__device__ __forceinline__ void transpose_item(const float* W, int ldw, int K, int src_col0, bf16_t* WT, int dst_row0, int k0, LAS float* scr, int lane) {
#pragma unroll 8
  for (int i = 0; i < 32; ++i) { const int kk = 2 * i + (lane >> 5); scr[kk * 33 + (lane & 31)] = W[(size_t)(k0 + kk) * ldw + src_col0 + (lane & 31)]; }
  asm volatile("s_waitcnt lgkmcnt(0)" ::: "memory");
  const int c = lane & 7;
#pragma unroll
  for (int j = 0; j < 4; ++j) { const int n = (lane >> 3) + 8 * j; const LAS float* s = scr + (8 * c) * 33 + n;
    u32x4 o; o.x = pk2(s[0 * 33], s[1 * 33]); o.y = pk2(s[2 * 33], s[3 * 33]); o.z = pk2(s[4 * 33], s[5 * 33]); o.w = pk2(s[6 * 33], s[7 * 33]);
    *(u32x4*)(WT + (size_t)(dst_row0 + n) * K + k0 + 8 * c) = o; }
  asm volatile("s_waitcnt lgkmcnt(0)" ::: "memory");
}

template <class ColMap> __device__ __forceinline__ void transpose_matrix(const float* W, int ldw, int K, int N, bf16_t* WT, ColMap cm, LAS float* scr, int gw, int ngw, int lane) {
  const int nblk = N / 32, items = (K / 64) * nblk;
  for (int it = gw; it < items; it += ngw) { const int kb = it / nblk, nb = it % nblk; transpose_item(W, ldw, K, cm(32 * nb), WT, 32 * nb, 64 * kb, scr, lane); }
}

__global__ void __launch_bounds__(NTHREADS) fwd_megakernel(Params p) {
  extern __shared__ __attribute__((aligned(16))) unsigned char lds_raw[];
  LAS unsigned char* lds = (LAS unsigned char*)lds_raw;
  cg::grid_group grid = cg::this_grid();
  volatile LAS unsigned* bar_st = (volatile LAS unsigned*)(lds + LDS_BYTES - 64);
  if (threadIdx.x < 2) bar_st[threadIdx.x] = 0u;
  __syncthreads();
  const XcdBarrier xbar = xcd_barrier_post((unsigned*)(p.ws + WS_BAR), bar_st);
  if (p.ws == nullptr) grid.sync();
#define GRID_BARRIER() xcd_barrier(xbar, wave)
  const int wave = __builtin_amdgcn_readfirstlane(threadIdx.x >> 6);
#define PHASE_TID() int lane_p = lane_id(); asm volatile("" : "+v"(lane_p)); const int lane = lane_p, tid = (wave << 6) | lane; (void)tid;
  const int G = gridDim.x, bid = blockIdx.x;
  const int gw = bid * NWAVES + wave, ngw = G * NWAVES;
  unsigned char* ws = p.ws;
  float* MOD = (float*)(ws + WS_MOD);
  f32x2* ROPE = (f32x2*)(ws + WS_ROPE);
  float* BA = (float*)(ws + WS_BA);
  float* DECLG = (float*)(ws + WS_MOD + 122880);
  bf16_t* WQKV = (bf16_t*)(ws + WS_WQKV); bf16_t* WGATE = (bf16_t*)(ws + WS_WGATE);
  bf16_t* WRO = (bf16_t*)(ws + WS_WRO); bf16_t* WDO = (bf16_t*)(ws + WS_WDO); bf16_t* WOUT = (bf16_t*)(ws + WS_WOUT);
  bf16_t* HB = (bf16_t*)(ws + WS_H);
  bf16_t* QKV = (bf16_t*)(ws + WS_QKV);
  bf16_t* KBUF = (bf16_t*)(ws + WS_KB); bf16_t* HALO = (bf16_t*)(ws + WS_HALO);
  unsigned char* MATS_RT = ws + WS_MATS_RT; unsigned char* MATS_DN = ws + WS_MATS_DN;
  unsigned char* LSCR = ws + WS_O; constexpr int LSCR_STRIDE = 16896;
  bf16_t* ODF = (bf16_t*)(ws + WS_O); bf16_t* ODB = ODF + (size_t)MTOT * D;
  bf16_t* ORF = (bf16_t*)p.out; bf16_t* ORB = ORF + (size_t)MTOT * D;
  float* NS_RET = p.out + (size_t)MTOT * D; float* NS_DN = NS_RET + (size_t)NCTX * 2 * NH * DK * DV;

  {
    PHASE_TID();
    LAS float* scr = (LAS float*)(lds + wave * 16384);
    transpose_matrix(p.in[I_WIN], INC, D, 4096, WQKV, [](int n) { return n < 2048 ? n : n + 1024; }, scr, gw, ngw, lane);
    transpose_matrix(p.in[I_WIN], INC, D, 4096, WGATE, [](int n) { return n < 1024 ? C_RG + n : (n < 2048 ? C_DZ + (n - 1024) : C_GR + (n - 2048)); }, scr, gw, ngw, lane);
    transpose_matrix(p.in[I_WRO], D, D, D, WRO, [](int n) { return n; }, scr, gw, ngw, lane);
    transpose_matrix(p.in[I_WDO], D, D, D, WDO, [](int n) { return n; }, scr, gw, ngw, lane);
    transpose_matrix(p.in[I_WOUT], D, D, D, WOUT, [](int n) { return n; }, scr, gw, ngw, lane);
    {
      __syncthreads();
      LAS float* scond = (LAS float*)lds;
      LAS float* red = scond + 5 * D;
      for (int i = tid; i < 5 * D; i += NTHREADS) { const int c = i >> 10, k = i & 1023; scond[i] = siluf(c == 0 ? p.in[I_CCTX][k] : p.in[I_C][(c - 1) * D + k]); }
      __syncthreads();
      for (int it = bid; it < 6 * D / 32; it += G) {
        const int col = it * 32 + (lane & 31), rpar = lane >> 5;
        float acc[5] = {0.f, 0.f, 0.f, 0.f, 0.f};
        const float* wm = p.in[I_WMOD] + (size_t)(128 * wave + rpar) * 6 * D + col;
#pragma unroll 16
        for (int i = 0; i < 64; ++i) { const float wv = wm[(size_t)(2 * i) * 6 * D]; const int k = 128 * wave + 2 * i + rpar;
#pragma unroll
          for (int c = 0; c < 5; ++c) acc[c] += scond[c * D + k] * wv; }
#pragma unroll
        for (int c = 0; c < 5; ++c) { acc[c] += __shfl_xor(acc[c], 32); if (lane < 32) red[(wave * 5 + c) * 32 + lane] = acc[c]; }
        __syncthreads();
        if (tid < 160) { const int c = tid >> 5, n = tid & 31; float s = 0.f;
#pragma unroll
          for (int ww = 0; ww < 8; ++ww) s += red[(ww * 5 + c) * 32 + n];
          MOD[c * 6 * D + it * 32 + n] = s + p.in[I_BMOD][it * 32 + n]; }
        __syncthreads();
      }
    }
    for (int i = bid * NTHREADS + tid; i < LLAT * 64; i += G * NTHREADS) { const int l = i >> 6, pr = i & 63;
      const float freq = powf(10000.f, -(float)(pr & 31) / 32.f); const float ang = (pr < 32 ? (float)(l >> 6) : (float)(l & 63)) * freq;
      ROPE[i] = (f32x2){cosf(ang), sinf(ang)}; }
    if (bid == 0 && tid < 8) DECLG[tid] = -softplusf(-p.in[I_DECAY][tid]);
  }
  GRID_BARRIER();

  {
    PHASE_TID();
    LAS float* wba = (LAS float*)lds;
    for (int i = tid; i < D * 16; i += NTHREADS) wba[(i & 15) * 1028 + (i >> 4)] = p.in[I_WIN][(size_t)(i >> 4) * INC + C_DB + (i & 15)];
    __syncthreads();
    const float* nw = p.in[I_NORMW];
    for (int m = gw; m < MTOT; m += ngw) {
      const float* xr = xrow(p, m); const float* md = MOD + (size_t)cond_of_row(m) * 6 * D;
      f32x4 x4[4], w4[4], sc4[4], sh4[4]; float s = 0.f;
#pragma unroll
      for (int j = 0; j < 4; ++j) { const int c0 = 4 * lane + 256 * j; x4[j] = *(const f32x4*)(xr + c0); w4[j] = *(const f32x4*)(nw + c0); sc4[j] = *(const f32x4*)(md + D + c0); sh4[j] = *(const f32x4*)(md + c0); }
#pragma unroll
      for (int j = 0; j < 4; ++j) s += (x4[j].x * x4[j].x + x4[j].y * x4[j].y) + (x4[j].z * x4[j].z + x4[j].w * x4[j].w);
      const float r = rsqrtf(wave_sum(s) * (1.f / D) + EPS);
      float dots[16];
#pragma unroll
      for (int n = 0; n < 16; ++n) dots[n] = 0.f;
#pragma unroll
      for (int j = 0; j < 4; ++j) { const int c0 = 4 * lane + 256 * j;
        const f32x4 h = x4[j] * r * w4[j] * (sc4[j] + 1.f) + sh4[j];
        u32x2 o; o.x = pk2(h.x, h.y); o.y = pk2(h.z, h.w);
        *(u32x2*)(HB + (size_t)m * D + c0) = o;
#pragma unroll
        for (int n = 0; n < 16; ++n) { const f32x4 wv = *(const LAS f32x4*)(wba + n * 1028 + c0); dots[n] += (h.x * wv.x + h.y * wv.y) + (h.z * wv.z + h.w * wv.w); }
        __builtin_amdgcn_sched_barrier(0);
      }
#pragma unroll
      for (int n = 0; n < 16; ++n) dots[n] = wave_sum(dots[n]);
      if (lane < 8) {
        float db = dots[0], da = dots[8];
#pragma unroll
        for (int n = 1; n < 8; ++n) { db = lane == n ? dots[n] : db; da = lane == n ? dots[8 + n] : da; }
        BA[(size_t)m * 16 + lane] = sigmf(db);
        BA[(size_t)m * 16 + 8 + lane] = -expf(p.in[I_ALOG][lane]) * softplusf(da + p.in[I_DTB][lane]);
      }
    }
  }
  GRID_BARRIER();

  {
    pg8::Gemm g{HB, WQKV, MTOT, 4096, D}; pg8::StaticOrder S; S.init(MTOT, 4096, G, bid);
    pg8::EpiQKV E{QKV, LDQ, HALO};
    pg8::gemm_phase<pg8::EpiQKV, pg8::StaticOrder, true, true>(lds, g, S, E, wave);
  }
  GRID_BARRIER();

  {
    PHASE_TID();
    constexpr int PI_RQ = 0, PI_RK = 16384, PI_DQ = 32768, PI_DK = 49152;
    constexpr int PM_QKR = 65536, PM_QKD = PM_QKR + 17408, PM_KKD = PM_QKD + 17408;
    constexpr int PV = PM_KKD + 17408;
    constexpr int PL_F = 0, PL_B = 17408, PT_F = 34816, PT_B = 52224;
    const int w = wave;
    const float* cw = p.in[I_CONVW];
    u32x4 qraw[2], kraw[2], rawa[2][2][3], rawb[4][3]; float ba4[4] = {0.f, 0.f, 0.f, 0.f};
#define P2_LOADS(ITEM, TID) do { const int gc_ = (ITEM) >> 2, h_ = (ITEM) & 3, row0_ = gc_ * 64; const bool lat_ = row0_ >= MCTX; \
      const int L_ = lat_ ? LLAT : LCTX, t0_ = lat_ ? ((row0_ - MCTX) & (LLAT - 1)) : (row0_ & (LCTX - 1)); \
      const size_t s1m_ = (size_t)row0_ + ((TID) >> 3); \
      _Pragma("unroll") for (int c = 0; c < 2; ++c) { const int ch = ((TID) & 7) * 2 + c; \
        qraw[c] = *(const u32x4*)(QKV + s1m_ * LDQ + Q_RQ + h_ * DK + ch * 8); kraw[c] = *(const u32x4*)(QKV + s1m_ * LDQ + Q_RK + h_ * DK + ch * 8); } \
      _Pragma("unroll") for (int ps = 0; ps < 2; ++ps) _Pragma("unroll") for (int wh = 0; wh < 2; ++wh) _Pragma("unroll") for (int wd = 0; wd < 3; ++wd) { \
          const int row = ((TID) >> 4) + 32 * ps, rr = row + wd - 1, t = t0_ + rr; const int dch = wh * 512 + h_ * DK + ((TID) & 15) * 8; \
          u32x4 x = (u32x4){0u, 0u, 0u, 0u}; \
          if (t >= 0 && t < L_) { \
            if (rr < 0) x = *(const u32x4*)(HALO + ((size_t)(gc_ - 1) * 2 + 1) * 2048 + dch); \
            else if (rr > 63) x = *(const u32x4*)(HALO + ((size_t)(gc_ + 1) * 2 + 0) * 2048 + dch); \
            else x = *(const u32x4*)(QKV + (size_t)(row0_ + rr) * LDQ + Q_DQ + dch); } \
          rawa[ps][wh][wd] = x; } \
      _Pragma("unroll") for (int n = 0; n < 4; ++n) _Pragma("unroll") for (int wd = 0; wd < 3; ++wd) { \
          const int idx = (TID) + 512 * n, row = idx >> 5, ch = idx & 31, rr = row + wd - 1, t = t0_ + rr; const int dch = 1024 + h_ * DV + ch * 8; \
          u32x4 x = (u32x4){0u, 0u, 0u, 0u}; \
          if (t >= 0 && t < L_) { \
            if (rr < 0) x = *(const u32x4*)(HALO + ((size_t)(gc_ - 1) * 2 + 1) * 2048 + dch); \
            else if (rr > 63) x = *(const u32x4*)(HALO + ((size_t)(gc_ + 1) * 2 + 0) * 2048 + dch); \
            else x = *(const u32x4*)(QKV + (size_t)(row0_ + rr) * LDQ + Q_DQ + dch); } \
          rawb[n][wd] = x; } \
      if ((TID) < 64) { const float* ba = BA + (size_t)(row0_ + (TID)) * 16; ba4[0] = ba[h_]; ba4[1] = ba[4 + h_]; ba4[2] = ba[8 + h_]; ba4[3] = ba[12 + h_]; } } while (0)
    if (bid < 768) { int lane_q = lane_id(); asm volatile("" : "+v"(lane_q)); const int tid_q = (wave << 6) | lane_q; P2_LOADS(bid, tid_q); }
    for (int item = bid; item < 768; item += G) {
      int lane_o = lane_id(); asm volatile("" : "+v"(lane_o));
      const int lane = lane_o, tid = (wave << 6) | lane, r32 = lane & 31, hl = lane >> 5;
      const int gc = item >> 2, h = item & 3, row0 = gc * 64; const bool lat = row0 >= MCTX;
      const int t0 = lat ? ((row0 - MCTX) & (LLAT - 1)) : (row0 & (LCTX - 1));
      const float lgf = DECLG[h], lgb = DECLG[4 + h];
      const int s1row = tid >> 3; const size_t s1m = (size_t)row0 + s1row;
      const int ach = tid & 15;
      asm volatile("s_waitcnt vmcnt(0)" ::: "memory");
      __syncthreads();
      const float ba_bf = ba4[0], ba_bb = ba4[1], ba_af = ba4[2], ba_ab = ba4[3];
      {
        const int row = s1row; const size_t m = s1m;
        const float kfs = __expf(lgf * (float)(63 - row)), kbs = __expf(lgb * (float)row);
#pragma unroll
        for (int c = 0; c < 2; ++c) { const int ch = (tid & 7) * 2 + c;
          bf16_t* qp = QKV + m * LDQ + Q_RQ + h * DK + ch * 8; bf16_t* kp = QKV + m * LDQ + Q_RK + h * DK + ch * 8;
          const u32x4 qw = qraw[c], kw = kraw[c];
          float q[8] = {lo_bf(qw.x), hi_bf(qw.x), lo_bf(qw.y), hi_bf(qw.y), lo_bf(qw.z), hi_bf(qw.z), lo_bf(qw.w), hi_bf(qw.w)};
          float k[8] = {lo_bf(kw.x), hi_bf(kw.x), lo_bf(kw.y), hi_bf(kw.y), lo_bf(kw.z), hi_bf(kw.z), lo_bf(kw.w), hi_bf(kw.w)};
#pragma unroll
          for (int e = 0; e < 8; ++e) q[e] *= QSCALE;
          if (lat) {
#pragma unroll
            for (int e = 0; e < 4; ++e) { const f32x2 cs = ROPE[(t0 + row) * 64 + ch * 4 + e];
              const float a = q[2 * e] * cs.x - q[2 * e + 1] * cs.y, b = q[2 * e] * cs.y + q[2 * e + 1] * cs.x; q[2 * e] = a; q[2 * e + 1] = b;
              const float c2 = k[2 * e] * cs.x - k[2 * e + 1] * cs.y, d2 = k[2 * e] * cs.y + k[2 * e + 1] * cs.x; k[2 * e] = c2; k[2 * e + 1] = d2; }
          }
          u32x4 o; o.x = pk2(q[0], q[1]); o.y = pk2(q[2], q[3]); o.z = pk2(q[4], q[5]); o.w = pk2(q[6], q[7]);
          *(u32x4*)qp = o; *(LAS u32x4*)(lds + PI_RQ + off_b(row, ch)) = o;
          o.x = pk2(k[0], k[1]); o.y = pk2(k[2], k[3]); o.z = pk2(k[4], k[5]); o.w = pk2(k[6], k[7]);
          *(LAS u32x4*)(lds + PI_RK + off_b(row, ch)) = o;
          o.x = pk2(k[0] * kfs, k[1] * kfs); o.y = pk2(k[2] * kfs, k[3] * kfs); o.z = pk2(k[4] * kfs, k[5] * kfs); o.w = pk2(k[6] * kfs, k[7] * kfs);
          *(u32x4*)kp = o;
          o.x = pk2(k[0] * kbs, k[1] * kbs); o.y = pk2(k[2] * kbs, k[3] * kbs); o.z = pk2(k[4] * kbs, k[5] * kbs); o.w = pk2(k[6] * kbs, k[7] * kbs);
          *(u32x4*)(KBUF + m * 512 + h * DK + ch * 8) = o;
        }
      }
      {
        const int ch = ach;
#pragma unroll
        for (int ps = 0; ps < 2; ++ps)
#pragma unroll
          for (int wh = 0; wh < 2; ++wh) { const int row = (tid >> 4) + 32 * ps; const int dch = wh * 512 + h * DK + ch * 8;
            float a[8] = {0.f, 0.f, 0.f, 0.f, 0.f, 0.f, 0.f, 0.f};
#pragma unroll
            for (int wd = 0; wd < 3; ++wd) { const u32x4 x = rawa[ps][wh][wd]; const f32x4 w0 = *(const f32x4*)(cw + wd * 2048 + dch), w1 = *(const f32x4*)(cw + wd * 2048 + dch + 4);
              a[0] += lo_bf(x.x) * w0.x; a[1] += hi_bf(x.x) * w0.y; a[2] += lo_bf(x.y) * w0.z; a[3] += hi_bf(x.y) * w0.w;
              a[4] += lo_bf(x.z) * w1.x; a[5] += hi_bf(x.z) * w1.y; a[6] += lo_bf(x.w) * w1.z; a[7] += hi_bf(x.w) * w1.w; }
            float ss = 0.f;
#pragma unroll
            for (int e = 0; e < 8; ++e) { a[e] = siluf(a[e]); ss += a[e] * a[e]; }
            ss += __shfl_xor(ss, 1); ss += __shfl_xor(ss, 2); ss += __shfl_xor(ss, 4); ss += __shfl_xor(ss, 8);
            const float sc = rsqrtf(ss + EPS) * (wh == 0 ? QSCALE : 1.f);
            u32x4 o; o.x = pk2(a[0] * sc, a[1] * sc); o.y = pk2(a[2] * sc, a[3] * sc); o.z = pk2(a[4] * sc, a[5] * sc); o.w = pk2(a[6] * sc, a[7] * sc);
            *(u32x4*)(QKV + (size_t)(row0 + row) * LDQ + Q_DQ + dch) = o;
            *(LAS u32x4*)(lds + (wh ? PI_DK : PI_DQ) + off_b(row, ch)) = o; }
      }
      {
#pragma unroll
        for (int n = 0; n < 4; ++n) { const int idx = tid + 512 * n, row = idx >> 5, ch = idx & 31; const int dch = 1024 + h * DV + ch * 8;
          float a[8] = {0.f, 0.f, 0.f, 0.f, 0.f, 0.f, 0.f, 0.f};
#pragma unroll
          for (int wd = 0; wd < 3; ++wd) { const u32x4 x = rawb[n][wd]; const f32x4 w0 = *(const f32x4*)(cw + wd * 2048 + dch), w1 = *(const f32x4*)(cw + wd * 2048 + dch + 4);
            a[0] += lo_bf(x.x) * w0.x; a[1] += hi_bf(x.x) * w0.y; a[2] += lo_bf(x.y) * w0.z; a[3] += hi_bf(x.y) * w0.w;
            a[4] += lo_bf(x.z) * w1.x; a[5] += hi_bf(x.z) * w1.y; a[6] += lo_bf(x.w) * w1.z; a[7] += hi_bf(x.w) * w1.w; }
          u32x4 o; o.x = pk2(siluf(a[0]), siluf(a[1])); o.y = pk2(siluf(a[2]), siluf(a[3])); o.z = pk2(siluf(a[4]), siluf(a[5])); o.w = pk2(siluf(a[6]), siluf(a[7]));
          *(u32x4*)(QKV + (size_t)(row0 + row) * LDQ + Q_DQ + dch) = o; }
      }
      if (item + G < 768) P2_LOADS(item + G, tid);
      __syncthreads();
      {
        const int mi = (w >> 1) & 1, nj = w & 1;
        if (w < 4) {
          f32x16 a1 = zero16(), a2 = zero16();
#pragma unroll 2
          for (int ks = 0; ks < 8; ++ks) { a1 = MFMA32(lds_rd128(lds + PI_RQ, rowfrag_off(lane, mi, ks)), lds_rd128(lds + PI_RK, rowfrag_off(lane, nj, ks)), a1);
            a2 = MFMA32(lds_rd128(lds + PI_DQ, rowfrag_off(lane, mi, ks)), lds_rd128(lds + PI_DK, rowfrag_off(lane, nj, ks)), a2); }
          LAS float* m1 = (LAS float*)(lds + PM_QKR); LAS float* m2 = (LAS float*)(lds + PM_QKD);
#pragma unroll
          for (int reg = 0; reg < 16; ++reg) { const int o = (32 * mi + crow(reg, hl)) * 68 + 32 * nj + r32; m1[o] = a1[reg]; m2[o] = a2[reg]; }
        } else {
          f32x16 a1 = zero16();
#pragma unroll 2
          for (int ks = 0; ks < 8; ++ks) a1 = MFMA32(lds_rd128(lds + PI_DK, rowfrag_off(lane, mi, ks)), lds_rd128(lds + PI_DK, rowfrag_off(lane, nj, ks)), a1);
          LAS float* m1 = (LAS float*)(lds + PM_KKD);
#pragma unroll
          for (int reg = 0; reg < 16; ++reg) m1[(32 * mi + crow(reg, hl)) * 68 + 32 * nj + r32] = a1[reg];
        }
      }
      LAS float* vecs = (LAS float*)(lds + PV);
      if (tid < 64) {
        const float bf = ba_bf, bb = ba_bb, af = ba_af, ab = ba_ab;
        float xf = af, xb = ab;
#pragma unroll
        for (int o = 1; o < 64; o <<= 1) { const float yf = __shfl_up(xf, o), yb = __shfl_up(xb, o); if (lane >= o) { xf += yf; xb += yb; } }
        const float totf = __shfl(xf, 63), totb = __shfl(xb, 63);
        vecs[tid] = bf; vecs[64 + tid] = bb; vecs[128 + tid] = xf; vecs[192 + tid] = totb - xb + ab;
        if (tid == 0) { vecs[256] = totf; vecs[257] = totb; }
      }
      __syncthreads();
      unsigned char* blob_rt = MATS_RT + (size_t)((gc * 4 + h) * 2) * RT_BLOB; unsigned char* blob_dn = MATS_DN + (size_t)((gc * 4 + h) * 2) * DN_BLOB;
      const int lp = tid & 63, fi = tid >> 6, fmt = fi >> 2, fks = fi & 3, frow = 32 * fmt + (lp & 31), fhq = lp >> 5;
      {
        const LAS float* m1 = (const LAS float*)(lds + PM_QKR); const LAS float* m2 = (const LAS float*)(lds + PM_QKD);
        const float gfi = vecs[128 + frow], gbi = vecs[192 + frow];
        f32x8 pf, pb, df, db;
#pragma unroll
        for (int jj = 0; jj < 8; ++jj) { const int j = 16 * fks + 8 * (jj >> 2) + 4 * fhq + (jj & 3);
          const float x = m1[frow * 68 + j], y = m2[frow * 68 + j];
          pf[jj] = j <= frow ? x * __expf(lgf * (float)(frow - j)) : 0.f; pb[jj] = j >= frow ? x * __expf(lgb * (float)(j - frow)) : 0.f;
          df[jj] = j <= frow ? y * __expf(gfi - vecs[128 + j]) : 0.f; db[jj] = j >= frow ? y * __expf(gbi - vecs[192 + j]) : 0.f; }
        *(bf16x8*)(blob_rt + (fi * 64 + lp) * 16) = cvt8(pf); *(bf16x8*)(blob_rt + RT_BLOB + (fi * 64 + lp) * 16) = cvt8(pb);
        *(bf16x8*)(blob_dn + 8192 + (fi * 64 + lp) * 16) = cvt8(df); *(bf16x8*)(blob_dn + DN_BLOB + 8192 + (fi * 64 + lp) * 16) = cvt8(db);
        const LAS float* m3 = (const LAS float*)(lds + PM_KKD);
        float* lf = (float*)(LSCR + (size_t)((gc * 4 + h) * 2) * LSCR_STRIDE); float* lb = (float*)(LSCR + (size_t)((gc * 4 + h) * 2 + 1) * LSCR_STRIDE);
#pragma unroll
        for (int n = 0; n < 8; ++n) { const int e = tid + 512 * n, i = e >> 6, j = e & 63; const float kk = m3[i * 68 + j];
          lf[e] = j < i ? vecs[i] * kk * __expf(vecs[128 + i] - vecs[128 + j]) : 0.f;
          lb[e] = j > i ? vecs[64 + i] * kk * __expf(vecs[192 + i] - vecs[192 + j]) : 0.f; }
        if (tid < 64) { lf[4096 + tid] = vecs[tid]; lb[4096 + tid] = vecs[64 + tid]; }
        if (tid < 64) { const float gf = vecs[128 + tid], gb = vecs[192 + tid], glf = vecs[256], glb = vecs[257];
          float* vf = (float*)(blob_dn + 16384); float* vb = (float*)(blob_dn + DN_BLOB + 16384);
          vf[tid] = __expf(gf); vf[64 + tid] = __expf(glf - gf); vb[tid] = __expf(gb); vb[64 + tid] = __expf(glb - gb);
          if (tid == 0) { vf[128] = __expf(glf); vb[128] = __expf(glb); } }
      }
    }
  }
  asm volatile("s_waitcnt vmcnt(0)" ::: "memory");
  __syncthreads();

  {
    PHASE_TID();
    LAS unsigned short* tl = (LAS unsigned short*)(lds + wave * 16384);
    for (int sv = wave; bid + G * (sv >> 1) < 768; sv += NWAVES) {
      const int it = 2 * (bid + G * (sv >> 1)) + (sv & 1);
      int lane_o = lane_id(); asm volatile("" : "+v"(lane_o));
      const int ln = lane_o; const bool flip = it & 1; const int cl = flip ? 63 - ln : ln;
      const float* Lm = (const float*)(LSCR + (size_t)it * LSCR_STRIDE);
      float T[64], Lr[64];
#pragma unroll
      for (int i = 0; i < 64; ++i) Lr[i] = Lm[(flip ? 63 - i : i) * 64 + cl];
      const float bc = Lm[4096 + cl];
      __builtin_amdgcn_sched_barrier(0);
#pragma unroll
      for (int i = 0; i < 64; ++i) {
        const float lrow = Lr[i];
        float t0 = (ln == i) ? 1.f : 0.f, t1 = 0.f;
#pragma unroll
        for (int j = 0; j < i; ++j) { const float lj = __int_as_float(__builtin_amdgcn_readlane(__float_as_int(lrow), j)); if (j & 1) t1 -= lj * T[j]; else t0 -= lj * T[j]; }
        T[i] = t0 + t1;
        __builtin_amdgcn_sched_barrier(0);
      }
#pragma unroll
      for (int i = 0; i < 64; ++i) tl[(flip ? 63 - i : i) * 72 + cl] = (unsigned short)f2bf(T[i] * bc);
      asm volatile("s_waitcnt lgkmcnt(0)" ::: "memory");
      unsigned char* blob = MATS_DN + (size_t)it * DN_BLOB;
      const int frow = ln & 31, fhq = ln >> 5;
#pragma unroll
      for (int f = 0; f < 8; ++f) { const int mt = f >> 2, ks = f & 3;
        const LAS unsigned short* rp = tl + (32 * mt + frow) * 72 + 16 * ks + 4 * fhq;
        const u32x2 lo = *(const LAS u32x2*)rp, hi = *(const LAS u32x2*)(rp + 8);
        *(u32x4*)(blob + (f * 64 + ln) * 16) = (u32x4){lo.x, lo.y, hi.x, hi.y}; }
      asm volatile("s_waitcnt lgkmcnt(0)" ::: "memory");
    }
  }
  GRID_BARRIER();

  {
    PHASE_TID();
    const int w = wave, cb = (w & 3) * 32; const bool act = w < 4;
    LAS float* qdec = (LAS float*)(lds + SC_VEC);
    const int stride = bid < 128 ? 1000000 : (G - 128);
    for (int item = bid; item < 640; item += stride) {
      const int ci = item >> 1, half = item & 1;
      int lane_c = lane_id(); asm volatile("" : "+v"(lane_c));
      const int lane = lane_c, tid = (wave << 6) | lane, r32 = lane & 31, hl = lane >> 5;
      int type, sq, h, dir, chunk0, nsteps; bool lat;
      if (ci < 64) { lat = true; type = ci >> 5; sq = (ci >> 3) & 3; h = (ci >> 1) & 3; dir = ci & 1; chunk0 = 64 + 32 * sq; nsteps = 32; }
      else { const int c = ci - 64; lat = false; type = c >> 7; sq = (c >> 3) & 15; h = (c >> 1) & 3; dir = c & 1; chunk0 = 4 * sq; nsteps = 4; }
      f32x16 S[4];
      {
        const float* s0 = (type ? p.in[I_SDN] : p.in[I_SRET]) + ((((size_t)sq * 2 + dir) * NH + h) * DK) * DV + 128 * half + cb + r32;
        if (lat) {
#pragma unroll
          for (int mt = 0; mt < 4; ++mt)
#pragma unroll
            for (int reg = 0; reg < 16; ++reg) S[mt][reg] = s0[(size_t)(32 * mt + srow(reg, hl)) * DV];
        } else {
#pragma unroll
          for (int mt = 0; mt < 4; ++mt) S[mt] = zero16();
        }
      }
      const float lg = DECLG[dir * 4 + h];
      const float c64 = __expf(64.f * lg);
      __syncthreads();
      if (tid < 64) qdec[tid] = __expf(lg * (dir ? (float)(64 - tid) : (float)(tid + 1)));
      const StageOff soff = scan_stage_offsets(w, lane, (!type && dir) ? 1024u : (unsigned)(LDQ * 2));
      scan_stage(lds, 0, type, dir, h, chunk0 + (dir ? nsteps - 1 : 0), QKV, KBUF, MATS_RT, MATS_DN, half, w, soff);
      bf16_t* O = type ? (dir ? ODB : ODF) : (dir ? ORB : ORF);
      for (int s = 0; s < nsteps; ++s) {
        int ln = lane; asm volatile("" : "+v"(ln));
        const int r32s = ln & 31, hls = ln >> 5;
        const int buf = s & 1, gc = chunk0 + (dir ? nsteps - 1 - s : s);
        asm volatile("s_waitcnt vmcnt(0)" ::: "memory");
        __syncthreads();
        if (s + 1 < nsteps) scan_stage(lds, buf ^ 1, type, dir, h, chunk0 + (dir ? nsteps - 2 - s : s + 1), QKV, KBUF, MATS_RT, MATS_DN, half, w, soff);
        if (!act) continue;
        LAS unsigned char* B = lds + buf * SC_BUF;
        bf16_t* ob = O + (size_t)gc * 64 * D + h * DV + 128 * half + cb + r32s;
#define SB_ do { __builtin_amdgcn_sched_barrier(0); asm volatile("" : "+v"(ln)); } while (0)
#define STORE_O(acc) do { _Pragma("unroll") for (int mt_ = 0; mt_ < 2; ++mt_) _Pragma("unroll") for (int s2_ = 0; s2_ < 2; ++s2_) { const bf16x8 pk_ = pack8(acc[mt_], s2_); \
                          _Pragma("unroll") for (int j_ = 0; j_ < 8; ++j_) ob[(size_t)(32 * mt_ + crow(8 * s2_ + j_, ln >> 5)) * D] = (bf16_t)pk_[j_]; } } while (0)
#define LOAD_BV() do { _Pragma("unroll") for (int ks_ = 0; ks_ < 4; ++ks_) Bv[ks_] = lds_tr2(B + SC_V, vtr_off(ln, cb, ks_, 0), vtr_off(ln, cb, ks_, 1)); } while (0)
#define ROWS_AB(acc, IMG) do { bf16x8 f0_[2], f1_[2]; \
            f0_[0] = lds_rd128(B + (IMG), rowfrag_off(ln, 0, 0)); f0_[1] = lds_rd128(B + (IMG), rowfrag_off(ln, 1, 0)); \
            _Pragma("unroll") for (int ks_ = 0; ks_ < 8; ++ks_) { \
              if (ks_ + 1 < 8) { f1_[0] = lds_rd128(B + (IMG), rowfrag_off(ln, 0, ks_ + 1)); f1_[1] = lds_rd128(B + (IMG), rowfrag_off(ln, 1, ks_ + 1)); } \
              const bf16x8 sb_ = pack8(S[ks_ >> 1], ks_ & 1); \
              acc[0] = MFMA32(f0_[0], sb_, acc[0]); acc[1] = MFMA32(f0_[1], sb_, acc[1]); \
              f0_[0] = f1_[0]; f0_[1] = f1_[1]; } } while (0)
#define ROWS_T(acc, IMG) do { bf16x8 f0_[2], f1_[2];   \
            f0_[0] = lds_rd128(B + (IMG), rowfrag_off(ln, 0, 0)); f0_[1] = lds_rd128(B + (IMG), rowfrag_off(ln, 1, 0)); \
            _Pragma("unroll") for (int ks_ = 0; ks_ < 8; ++ks_) { \
              if (ks_ + 1 < 8) { f1_[0] = lds_rd128(B + (IMG), rowfrag_off(ln, 0, ks_ + 1)); f1_[1] = lds_rd128(B + (IMG), rowfrag_off(ln, 1, ks_ + 1)); } \
              const bf16x8 sb_ = pack8(S[ks_ >> 1], ks_ & 1); \
              acc[0] = MFMA32(sb_, f0_[0], acc[0]); acc[1] = MFMA32(sb_, f0_[1], acc[1]); \
              f0_[0] = f1_[0]; f0_[1] = f1_[1]; } } while (0)
#define STORE_OT(acc) do { _Pragma("unroll") for (int nt_ = 0; nt_ < 2; ++nt_) { bf16_t* orow_ = obt + (size_t)(32 * nt_) * D; \
            _Pragma("unroll") for (int g_ = 0; g_ < 4; ++g_) { u32x2 w_; w_.x = pk2(acc[nt_][4 * g_], acc[nt_][4 * g_ + 1]); w_.y = pk2(acc[nt_][4 * g_ + 2], acc[nt_][4 * g_ + 3]); \
              *(u32x2*)(orow_ + 8 * g_) = w_; } } } while (0)
#define S_UPDATE(X, SCL) do { bf16x8 g0_[4], g1_[4]; \
            _Pragma("unroll") for (int mt_ = 0; mt_ < 4; ++mt_) g0_[mt_] = lds_tr2(B + SC_K, ktr_off(ln, mt_, 0, 0), ktr_off(ln, mt_, 0, 1)); \
            _Pragma("unroll") for (int mt_ = 0; mt_ < 4; ++mt_) S[mt_] = S[mt_] * (SCL); \
            _Pragma("unroll") for (int ks_ = 0; ks_ < 4; ++ks_) { \
              if (ks_ + 1 < 4) { _Pragma("unroll") for (int mt_ = 0; mt_ < 4; ++mt_) g1_[mt_] = lds_tr2(B + SC_K, ktr_off(ln, mt_, ks_ + 1, 0), ktr_off(ln, mt_, ks_ + 1, 1)); } \
              _Pragma("unroll") for (int mt_ = 0; mt_ < 4; ++mt_) S[mt_] = MFMA32(g0_[mt_], X[ks_], S[mt_]); \
              _Pragma("unroll") for (int mt_ = 0; mt_ < 4; ++mt_) g0_[mt_] = g1_[mt_]; } } while (0)
        bf16x8 Bv[4];
        if (type) {
          const LAS float* eg = (const LAS float*)(B + SC_M + 16384); const LAS float* cgv = eg + 64; const float egl = eg[128];
          bf16x8 Br[4];
          { f32x16 ra[2]; ra[0] = zero16(); ra[1] = zero16();
            ROWS_AB(ra, SC_K);
#pragma unroll
            for (int mt = 0; mt < 2; ++mt) { rowscale(ra[mt], eg + 32 * mt, ln >> 5, -1.f); Br[2 * mt] = pack8(ra[mt], 0); Br[2 * mt + 1] = pack8(ra[mt], 1); } }
          SB_;
          LOAD_BV();
          bf16x8 tf[8];
#pragma unroll
          for (int i = 0; i < 8; ++i) tf[i] = lds_rd128(B + SC_M, i * 1024 + ln * 16);
          f32x16 vn[2]; vn[0] = zero16(); vn[1] = zero16();
#pragma unroll
          for (int ks = 0; ks < 4; ++ks)
#pragma unroll
            for (int mt = 0; mt < 2; ++mt) { vn[mt] = MFMA32(tf[mt * 4 + ks], Bv[ks], vn[mt]); vn[mt] = MFMA32(tf[mt * 4 + ks], Br[ks], vn[mt]); }
          SB_;
          bf16x8 Bn[4], Bc[4];
#pragma unroll
          for (int mt = 0; mt < 2; ++mt) { Bn[2 * mt] = pack8(vn[mt], 0); Bn[2 * mt + 1] = pack8(vn[mt], 1); rowscale(vn[mt], cgv + 32 * mt, ln >> 5, 1.f); Bc[2 * mt] = pack8(vn[mt], 0); Bc[2 * mt + 1] = pack8(vn[mt], 1); }
          SB_;
          f32x16 oa[2]; oa[0] = zero16(); oa[1] = zero16();
          ROWS_T(oa, SC_Q);
          SB_;
#pragma unroll
          for (int i = 0; i < 8; ++i) tf[i] = lds_rd128(B + SC_M, 8192 + i * 1024 + ln * 16);
#pragma unroll
          for (int nt = 0; nt < 2; ++nt) oa[nt] = oa[nt] * eg[32 * nt + (ln & 31)];
#pragma unroll
          for (int ks = 0; ks < 4; ++ks)
#pragma unroll
            for (int nt = 0; nt < 2; ++nt) oa[nt] = MFMA32(Bn[ks], tf[nt * 4 + ks], oa[nt]);
          SB_;
          { bf16_t* obt = O + ((size_t)gc * 64 + (ln & 31)) * D + h * DV + 128 * half + cb + 4 * (ln >> 5); STORE_OT(oa); }
          SB_;
          S_UPDATE(Bc, egl);
          SB_;
        } else {
          f32x16 oa[2]; oa[0] = zero16(); oa[1] = zero16();
          ROWS_T(oa, SC_Q);
          SB_;
          LOAD_BV();
          bf16x8 tf[8];
#pragma unroll
          for (int i = 0; i < 8; ++i) tf[i] = lds_rd128(B + SC_M, i * 1024 + ln * 16);
#pragma unroll
          for (int nt = 0; nt < 2; ++nt) oa[nt] = oa[nt] * qdec[32 * nt + (ln & 31)];
#pragma unroll
          for (int ks = 0; ks < 4; ++ks)
#pragma unroll
            for (int nt = 0; nt < 2; ++nt) oa[nt] = MFMA32(Bv[ks], tf[nt * 4 + ks], oa[nt]);
          SB_;
          { bf16_t* obt = O + ((size_t)gc * 64 + (ln & 31)) * D + h * DV + 128 * half + cb + 4 * (ln >> 5); STORE_OT(oa); }
          SB_;
          S_UPDATE(Bv, c64);
          SB_;
        }
#undef SB_
#undef STORE_O
#undef LOAD_BV
#undef ROWS_AB
#undef ROWS_T
#undef STORE_OT
#undef S_UPDATE
      }
      if (!lat && act) {
        int ln3 = lane_id(); asm volatile("" : "+v"(ln3)); const int hl3 = ln3 >> 5;
        float* so = (type ? NS_DN : NS_RET) + ((((size_t)sq * 2 + dir) * NH + h) * DK) * DV + 128 * half + cb + (ln3 & 31);
#pragma unroll
        for (int mt = 0; mt < 4; ++mt)
#pragma unroll
          for (int reg = 0; reg < 16; ++reg) so[(size_t)(32 * mt + srow(reg, hl3)) * DV] = S[mt][reg];
      }
    }
  }
  GRID_BARRIER();

  bf16_t* GATES = QKV;
  {
    pg8::Gemm g{HB, WGATE, MTOT, 4096, D}; pg8::StaticOrder S; S.init(MTOT, 4096, G, bid);
    pg8::EpiBf16Act<1> E{GATES, LDG};
    pg8::gemm_phase<pg8::EpiBf16Act<1>, pg8::StaticOrder, true, true>(lds, g, S, E, wave);
  }
  GRID_BARRIER();

  bf16_t* AR = (bf16_t*)(ws + WS_AR); bf16_t* AD = (bf16_t*)(ws + WS_AD);
  {
    PHASE_TID();
    for (int m = gw; m < MTOT; m += ngw) {
      u32x2 rf[4], rb[4], df[4], db[4], gr[4], gd[4]; f32x4 gw4[4];
#pragma unroll
      for (int h = 0; h < 4; ++h) { const size_t base = (size_t)m * D + h * DV + 4 * lane;
        rf[h] = *(const u32x2*)(ORF + base); rb[h] = *(const u32x2*)(ORB + base); df[h] = *(const u32x2*)(ODF + base); db[h] = *(const u32x2*)(ODB + base);
        gr[h] = *(const u32x2*)(GATES + (size_t)m * LDG + G_RG + h * DV + 4 * lane); gd[h] = *(const u32x2*)(GATES + (size_t)m * LDG + G_DZ + h * DV + 4 * lane);
        gw4[h] = *(const f32x4*)(p.in[I_GNW] + h * DV + 4 * lane); }
      const f32x4 dw4 = *(const f32x4*)(p.in[I_DNW] + 4 * lane);
      float v[4][4], u[4][4], mu[4], rs[4], rd[4];
#pragma unroll
      for (int h = 0; h < 4; ++h) { v[h][0] = lo_bf(rf[h].x) + lo_bf(rb[h].x); v[h][1] = hi_bf(rf[h].x) + hi_bf(rb[h].x); v[h][2] = lo_bf(rf[h].y) + lo_bf(rb[h].y); v[h][3] = hi_bf(rf[h].y) + hi_bf(rb[h].y);
        u[h][0] = lo_bf(df[h].x) + lo_bf(db[h].x); u[h][1] = hi_bf(df[h].x) + hi_bf(db[h].x); u[h][2] = lo_bf(df[h].y) + lo_bf(db[h].y); u[h][3] = hi_bf(df[h].y) + hi_bf(db[h].y);
        mu[h] = (v[h][0] + v[h][1]) + (v[h][2] + v[h][3]); rd[h] = (u[h][0] * u[h][0] + u[h][1] * u[h][1]) + (u[h][2] * u[h][2] + u[h][3] * u[h][3]); }
#pragma unroll
      for (int o = 1; o < 64; o <<= 1) {
#pragma unroll
        for (int h = 0; h < 4; ++h) { mu[h] += __shfl_xor(mu[h], o); rd[h] += __shfl_xor(rd[h], o); } }
#pragma unroll
      for (int h = 0; h < 4; ++h) { mu[h] *= (1.f / DV); float q = 0.f;
#pragma unroll
        for (int e = 0; e < 4; ++e) { v[h][e] -= mu[h]; q += v[h][e] * v[h][e]; }
        rs[h] = q; }
#pragma unroll
      for (int o = 1; o < 64; o <<= 1) {
#pragma unroll
        for (int h = 0; h < 4; ++h) rs[h] += __shfl_xor(rs[h], o); }
#pragma unroll
      for (int h = 0; h < 4; ++h) { const size_t base = (size_t)m * D + h * DV + 4 * lane;
        const float r1 = rsqrtf(rs[h] * (1.f / DV) + EPS), r2 = rsqrtf(rd[h] * (1.f / DV) + EPS);
        u32x2 o; o.x = pk2(lo_bf(gr[h].x) * (v[h][0] * r1 * gw4[h].x), hi_bf(gr[h].x) * (v[h][1] * r1 * gw4[h].y)); o.y = pk2(lo_bf(gr[h].y) * (v[h][2] * r1 * gw4[h].z), hi_bf(gr[h].y) * (v[h][3] * r1 * gw4[h].w));
        *(u32x2*)(AR + base) = o;
        o.x = pk2(u[h][0] * r2 * dw4.x * lo_bf(gd[h].x), u[h][1] * r2 * dw4.y * hi_bf(gd[h].x)); o.y = pk2(u[h][2] * r2 * dw4.z * lo_bf(gd[h].y), u[h][3] * r2 * dw4.w * hi_bf(gd[h].y));
        *(u32x2*)(AD + base) = o; }
    }
  }
  GRID_BARRIER();

  bf16_t* T1 = HB;
  {
    pg8::Gemm g{AR, WRO, MTOT, D, D}; pg8::StaticOrder S; S.init(MTOT, D, G, bid);
    pg8::EpiGateMul E{T1, D, GATES + G_GR, LDG, nullptr};
    pg8::gemm_phase<pg8::EpiGateMul, pg8::StaticOrder, true, true>(lds, g, S, E, wave);
  }
  bf16_t* MERGED = T1;
  {
    pg8::Gemm g{AD, WDO, MTOT, D, D}; pg8::StaticOrder S; S.init(MTOT, D, G, bid);
    pg8::EpiGateMul E{MERGED, D, GATES + G_GD, LDG, T1};
    pg8::gemm_phase<pg8::EpiGateMul, pg8::StaticOrder, true, true>(lds, g, S, E, wave);
  }
  GRID_BARRIER();
  bf16_t* M1 = (bf16_t*)(ws + WS_O);
  bf16_t* X1B = (bf16_t*)(ws + WS_O + 24 * MiB);
  {
    pg8::Gemm g{MERGED, WOUT, MTOT, D, D}; pg8::StaticOrder S; S.init(MTOT, D, G, bid);
    pg8::EpiBf16Act<0> E{M1, D};
    pg8::gemm_phase<pg8::EpiBf16Act<0>, pg8::StaticOrder, true, true>(lds, g, S, E, wave);
  }
  GRID_BARRIER();

  bf16_t* WF1 = (bf16_t*)(ws + WS_WF1); bf16_t* WF2 = (bf16_t*)(ws + WS_WF2);
  {
    PHASE_TID();
    LAS float* scr = (LAS float*)(lds + wave * 16384);
    transpose_matrix(p.in[I_WF1], 2 * DFF, D, 2 * DFF, WF1, [](int n) { const int pn = n >> 8, w = n & 255; return w < 128 ? 128 * pn + w : DFF + 128 * pn + (w - 128); }, scr, gw, ngw, lane);
    transpose_matrix(p.in[I_WF2], D, DFF, D, WF2, [](int n) { return n; }, scr, gw, ngw, lane);
    const float* nw1 = p.in[I_NORMW] + D; const float* nw2 = p.in[I_NORMW] + 2 * D;
    for (int m0 = gw; m0 < MTOT; m0 += 2 * ngw) {
      f32x4 v[2][4], xv[2][4], g1v[2][4]; float s[2] = {0.f, 0.f};
#pragma unroll
      for (int u = 0; u < 2; ++u) { const int m = (m0 + u * ngw < MTOT) ? m0 + u * ngw : m0; const float* xr = xrow(p, m); const float* md = MOD + (size_t)cond_of_row(m) * 6 * D; const bf16_t* mr = M1 + (size_t)m * D;
#pragma unroll
        for (int j = 0; j < 4; ++j) { const int c0 = 4 * lane + 256 * j; { const u32x2 mw = *(const u32x2*)(mr + c0); v[u][j] = (f32x4){lo_bf(mw.x), hi_bf(mw.x), lo_bf(mw.y), hi_bf(mw.y)}; } xv[u][j] = *(const f32x4*)(xr + c0); g1v[u][j] = *(const f32x4*)(md + 2 * D + c0); } }
#pragma unroll
      for (int u = 0; u < 2; ++u)
#pragma unroll
        for (int j = 0; j < 4; ++j) s[u] += (v[u][j].x * v[u][j].x + v[u][j].y * v[u][j].y) + (v[u][j].z * v[u][j].z + v[u][j].w * v[u][j].w);
#pragma unroll
      for (int o = 1; o < 64; o <<= 1) { s[0] += __shfl_xor(s[0], o); s[1] += __shfl_xor(s[1], o); }
      float s2[2] = {0.f, 0.f};
#pragma unroll
      for (int u = 0; u < 2; ++u) { const int m = m0 + u * ngw; const float r = rsqrtf(s[u] * (1.f / D) + EPS);
#pragma unroll
        for (int j = 0; j < 4; ++j) { const int c0 = 4 * lane + 256 * j;
          v[u][j] = xv[u][j] + g1v[u][j] * (v[u][j] * r * *(const f32x4*)(nw1 + c0));
          if (m < MTOT) { u32x2 xo; xo.x = pk2(v[u][j].x, v[u][j].y); xo.y = pk2(v[u][j].z, v[u][j].w); *(u32x2*)(X1B + (size_t)m * D + c0) = xo; }
          s2[u] += (v[u][j].x * v[u][j].x + v[u][j].y * v[u][j].y) + (v[u][j].z * v[u][j].z + v[u][j].w * v[u][j].w); } }
#pragma unroll
      for (int o = 1; o < 64; o <<= 1) { s2[0] += __shfl_xor(s2[0], o); s2[1] += __shfl_xor(s2[1], o); }
#pragma unroll
      for (int u = 0; u < 2; ++u) { const int m = m0 + u * ngw; if (m >= MTOT) continue; const float* md = MOD + (size_t)cond_of_row(m) * 6 * D; const float r2 = rsqrtf(s2[u] * (1.f / D) + EPS);
#pragma unroll
        for (int j = 0; j < 4; ++j) { const int c0 = 4 * lane + 256 * j;
          const f32x4 h = v[u][j] * r2 * *(const f32x4*)(nw2 + c0) * (*(const f32x4*)(md + 4 * D + c0) + 1.f) + *(const f32x4*)(md + 3 * D + c0);
          u32x2 o; o.x = pk2(h.x, h.y); o.y = pk2(h.z, h.w); *(u32x2*)(HB + (size_t)m * D + c0) = o; } }
    }
  }
  GRID_BARRIER();

  bf16_t* ACT = QKV;
  const bool TAIL_SPLIT = G >= 228;
  constexpr int MT_MAIN = 46, M_MAIN = MT_MAIN * 256;
  {
    const int M8 = TAIL_SPLIT ? M_MAIN : MTOT;
    pg8::Gemm g{HB, WF1, M8, 2 * DFF, D}; pg8::StaticOrder S; S.init(M8, 2 * DFF, G, bid);
    pg8::EpiSwiGLU E{ACT, DFF};
    pg8::gemm_phase<pg8::EpiSwiGLU, pg8::StaticOrder, true, true>(lds, g, S, E, wave);
  }
  GRID_BARRIER();
  bf16_t* F = (bf16_t*)(ws + WS_O); bf16_t* F1 = (bf16_t*)(ws + WS_F1);
  if (!TAIL_SPLIT || bid < MT_MAIN * 4) {
    const int M9 = TAIL_SPLIT ? M_MAIN : MTOT;
    pg8::Gemm g{ACT, WF2, M9, D, DFF}; pg8::StaticOrder S; S.init(M9, D, G, bid);
    pg8::EpiBf16Act<0> E{F, D};
    pg8::gemm_phase<pg8::EpiBf16Act<0>, pg8::StaticOrder, true, true>(lds, g, S, E, wave);
  } else if (bid < MT_MAIN * 4 + 44) {
    const int j = bid - MT_MAIN * 4;
    {
      pg8::Gemm g{HB, WF1, MTOT, 2 * DFF, D}; pg8::OneUnit S{MT_MAIN + j / 22, j % 22};
      pg8::EpiSwiGLU E{ACT, DFF};
      pg8::gemm_phase<pg8::EpiSwiGLU, pg8::OneUnit, true, true>(lds, g, S, E, wave);
    }
    asm volatile("s_waitcnt vmcnt(0)" ::: "memory");
    __syncthreads();
    if (wave == 0 && lane_id() == 0) {
      unsigned* cnt = (unsigned*)(p.ws + WS_BAR + 14336);
      __builtin_amdgcn_fence(__ATOMIC_RELEASE, "agent");
      asm volatile("s_waitcnt vmcnt(0)" ::: "memory");
      __hip_atomic_fetch_add(cnt, 1u, __ATOMIC_RELAXED, __HIP_MEMORY_SCOPE_AGENT);
      if (j < 24) {
        unsigned sp = 0;
        while (__hip_atomic_load(cnt, __ATOMIC_RELAXED, __HIP_MEMORY_SCOPE_AGENT) < 44u) { __builtin_amdgcn_s_sleep(2); if (++sp > (1u << 22)) break; }
        __builtin_amdgcn_fence(__ATOMIC_ACQUIRE, "agent");
        asm volatile("s_waitcnt vmcnt(0)" ::: "memory");
      }
    }
    __syncthreads();
    if (j < 24) {
      const int un = j / 3, kp = j % 3, k0 = kp == 0 ? 0 : (kp == 1 ? 1024 : 1920), kl = kp == 0 ? 1024 : 896;
      pg8::Gemm g{ACT + k0, WF2 + k0, MTOT, D, kl, DFF}; pg8::OneUnit S{MT_MAIN + (un >> 2), un & 3};
      pg8::EpiBf16Act<0> E{kp ? F1 + (size_t)(kp - 1) * 512 * D - (size_t)M_MAIN * D : F, D};
      pg8::gemm_phase<pg8::EpiBf16Act<0>, pg8::OneUnit, true, true>(lds, g, S, E, wave);
    }
  }
  GRID_BARRIER();
  {
    PHASE_TID();
    const float* nw3 = p.in[I_NORMW] + 3 * D;
    for (int m0 = gw; m0 < MTOT; m0 += 2 * ngw) {
      f32x4 v[2][4], xv[2][4], gv[2][4]; float s[2] = {0.f, 0.f};
#pragma unroll
      for (int u = 0; u < 2; ++u) { const int m = (m0 + u * ngw < MTOT) ? m0 + u * ngw : m0; const float* md = MOD + (size_t)cond_of_row(m) * 6 * D; const bf16_t* fr = F + (size_t)m * D; const bf16_t* xrow1 = X1B + (size_t)m * D; const bf16_t* f1r = (TAIL_SPLIT && m >= M_MAIN) ? F1 + (size_t)(m - M_MAIN) * D : nullptr;
#pragma unroll
        for (int j = 0; j < 4; ++j) { const int c0 = 4 * lane + 256 * j; { const u32x2 fw = *(const u32x2*)(fr + c0); v[u][j] = (f32x4){lo_bf(fw.x), hi_bf(fw.x), lo_bf(fw.y), hi_bf(fw.y)}; if (f1r) { const u32x2 gw2 = *(const u32x2*)(f1r + c0), gw3 = *(const u32x2*)(f1r + 512 * D + c0); v[u][j] += (f32x4){lo_bf(gw2.x), hi_bf(gw2.x), lo_bf(gw2.y), hi_bf(gw2.y)} + (f32x4){lo_bf(gw3.x), hi_bf(gw3.x), lo_bf(gw3.y), hi_bf(gw3.y)}; } } { const u32x2 xw = *(const u32x2*)(xrow1 + c0); xv[u][j] = (f32x4){lo_bf(xw.x), hi_bf(xw.x), lo_bf(xw.y), hi_bf(xw.y)}; } gv[u][j] = *(const f32x4*)(md + 5 * D + c0); } }
#pragma unroll
      for (int u = 0; u < 2; ++u)
#pragma unroll
        for (int j = 0; j < 4; ++j) s[u] += (v[u][j].x * v[u][j].x + v[u][j].y * v[u][j].y) + (v[u][j].z * v[u][j].z + v[u][j].w * v[u][j].w);
#pragma unroll
      for (int o = 1; o < 64; o <<= 1) { s[0] += __shfl_xor(s[0], o); s[1] += __shfl_xor(s[1], o); }
#pragma unroll
      for (int u = 0; u < 2; ++u) { const int m = m0 + u * ngw; if (m >= MTOT) continue; const float r = rsqrtf(s[u] * (1.f / D) + EPS); float* orow = p.out + (size_t)m * D;
#pragma unroll
        for (int j = 0; j < 4; ++j) { const int c0 = 4 * lane + 256 * j; *(f32x4*)(orow + c0) = xv[u][j] + gv[u][j] * (v[u][j] * r * *(const f32x4*)(nw3 + c0)); } }
    }
  }
}

extern "C" void kernel_launch(void* const* d_in, const int* in_sizes, int n_in, void* d_out, int out_size, void* d_ws, size_t ws_size, hipStream_t stream) {
  static int grid_blocks = 0;
  if (!grid_blocks) {
    int dev = 0, cus = 0, per_cu = 0;
    (void)hipGetDevice(&dev);
    (void)hipDeviceGetAttribute(&cus, hipDeviceAttributeMultiprocessorCount, dev);
    (void)hipFuncSetAttribute((const void*)fwd_megakernel, hipFuncAttributeMaxDynamicSharedMemorySize, LDS_BYTES);
    (void)hipOccupancyMaxActiveBlocksPerMultiprocessor(&per_cu, (const void*)fwd_megakernel, NTHREADS, LDS_BYTES);
    if (per_cu < 1) per_cu = 1;
    grid_blocks = cus * per_cu;
    if (n_in != 21 || ws_size < WS_END) fprintf(stderr, "kernel_launch: unexpected n_in %d / ws_size %zu\n", n_in, ws_size);
    fprintf(stderr, "kernel_launch: cus %d per_cu %d grid %d ws %zu out %d\n", cus, per_cu, grid_blocks, ws_size, out_size);
  }
  (void)hipMemsetAsync((unsigned char*)d_ws + WS_BAR, 0, 16384, stream);
  Params p{};
  for (int i = 0; i < 21; ++i) p.in[i] = (const float*)d_in[i];
  p.out = (float*)d_out; p.ws = (unsigned char*)d_ws;
  void* args[] = {&p};
  hipError_t e = hipLaunchCooperativeKernel((const void*)fwd_megakernel, dim3(grid_blocks), dim3(NTHREADS), args, LDS_BYTES, stream);
  if (e != hipSuccess) fprintf(stderr, "cooperative launch failed: %s (grid %d)\n", hipGetErrorString(e), grid_blocks);
}
```

```cpp
#include <hip/hip_runtime.h>
#include <hip/hip_cooperative_groups.h>
#include <cstdio>
#include <cstdint>
namespace cg = cooperative_groups;

#define LAS __attribute__((address_space(3)))
typedef unsigned short bf16_t;
typedef short bf16x8 __attribute__((ext_vector_type(8)));
typedef float f32x4 __attribute__((ext_vector_type(4)));
typedef float f32x2 __attribute__((ext_vector_type(2)));
typedef unsigned u32x4 __attribute__((ext_vector_type(4)));
typedef unsigned u32x2 __attribute__((ext_vector_type(2)));

constexpr int D = 1024, MCTX = 4096, MLAT = 8192, MTOT = 12288, LCTX = 256, LLAT = 2048, NCTX = 16, NLAT = 4;
constexpr int NH = 4, DK = 128, DV = 256, DFF = 2816, INC = 8208;
constexpr float EPS = 1e-6f;
constexpr float QSCALE = 0.08838834764831845f;
constexpr int NTHREADS = 512, NWAVES = 8;
constexpr int LDS_BYTES = 135168;
constexpr int Q_RQ = 0, Q_RK = 512, Q_RV = 1024, Q_DQ = 2048, Q_DK = 2560, Q_DV = 3072, LDQ = 4096;
constexpr int G_RG = 0, G_DZ = 1024, G_GR = 2048, G_GD = 3072, LDG = 4096;
constexpr int C_RQ = 0, C_RG = 2048, C_DQ = 3072, C_DZ = 5120, C_DB = 6144, C_GR = 6160;

constexpr size_t MiB = 1u << 20;
constexpr size_t WS_MOD = 0;
constexpr size_t WS_ROPE = 128 * 1024;
constexpr size_t WS_BAR = 1152 * 1024;
constexpr size_t WS_BA = 1280 * 1024;
constexpr size_t WS_WQKV = 2 * MiB;
constexpr size_t WS_WGATE = 10 * MiB;
constexpr size_t WS_WRO = 18 * MiB, WS_WDO = 20 * MiB, WS_WOUT = 22 * MiB;
constexpr size_t WS_H = 24 * MiB;
constexpr size_t WS_QKV = 48 * MiB;
constexpr size_t WS_MATS_DN = 144 * MiB;
constexpr size_t WS_MATS_RT = 170 * MiB;
constexpr size_t WS_KB = 182 * MiB;
constexpr size_t WS_HALO = 194 * MiB;
constexpr size_t WS_O = 196 * MiB;
constexpr size_t WS_F1 = 244 * MiB;
constexpr size_t WS_END = 246 * MiB;
constexpr size_t WS_AR = 144 * MiB, WS_AD = 168 * MiB, WS_MERGED = 144 * MiB;
constexpr size_t WS_WF1 = 144 * MiB, WS_WF2 = 155 * MiB;

struct Params {
  const float* in[21];
  float* out;
  unsigned char* ws;
};
enum { I_XP = 0, I_XS, I_C, I_SRET, I_SDN, I_CCTX, I_WMOD, I_BMOD, I_NORMW, I_WIN, I_CONVW, I_DECAY, I_GNW, I_ALOG, I_DTB, I_DNW, I_WRO, I_WDO, I_WOUT, I_WF1, I_WF2 };

__device__ __forceinline__ float bf2f(unsigned short b) { return __uint_as_float((unsigned)b << 16); }
__device__ __forceinline__ unsigned f2bf(float f) { unsigned u = __float_as_uint(f); return (u + 0x7fffu + ((u >> 16) & 1u)) >> 16; }
typedef __bf16 bfx2_t __attribute__((ext_vector_type(2)));
__device__ __forceinline__ unsigned pk2(float lo, float hi) { const f32x2 t = {lo, hi}; return __builtin_bit_cast(unsigned, __builtin_convertvector(t, bfx2_t)); }
__device__ __forceinline__ unsigned cvt_pk_bf16(float lo, float hi) { return pk2(lo, hi); }

__device__ __forceinline__ float lo_bf(unsigned w) { return __uint_as_float(w << 16); }
__device__ __forceinline__ float hi_bf(unsigned w) { return __uint_as_float(w & 0xffff0000u); }
__device__ __forceinline__ float siluf(float x) { return x * __builtin_amdgcn_rcpf(1.f + __expf(-x)); }
__device__ __forceinline__ float sigmf(float x) { return __builtin_amdgcn_rcpf(1.f + __expf(-x)); }
__device__ __forceinline__ float softplusf(float x) { return x > 20.f ? x : log1pf(expf(x)); }
__device__ __forceinline__ float wave_sum(float v) {
#pragma unroll
  for (int o = 1; o < 64; o <<= 1) v += __shfl_xor(v, o);
  return v;
}
__device__ __forceinline__ int lane_id() { return (int)__builtin_amdgcn_mbcnt_hi(~0u, __builtin_amdgcn_mbcnt_lo(~0u, 0u)); }
__device__ __forceinline__ int cond_of_row(int m) { return m < MCTX ? 0 : 1 + (m - MCTX) / LLAT; }
__device__ __forceinline__ const float* xrow(const Params& p, int m) { return m < MCTX ? p.in[I_XP] + (size_t)m * D : p.in[I_XS] + (size_t)(m - MCTX) * D; }


__device__ __forceinline__ int lane_id();
#define XB_TMO      128
#define XB_XCNT(j)  (256  + 64 * (j))
#define XB_XSUB(j)  (1280 + 64 * (j))
#define XB_XGEN(j)  (2304 + 64 * (j))
#define XB_TOP      3328
#define XB_TOPGEN   3392
#define XCD_BAR_WORDS 3456
#define XB_SPIN_CAP (1u << 18)
__device__ __forceinline__ unsigned xb_ld(unsigned* p)              { return __hip_atomic_load(p, __ATOMIC_RELAXED, __HIP_MEMORY_SCOPE_AGENT); }
__device__ __forceinline__ unsigned xb_add(unsigned* p, unsigned v) { return __hip_atomic_fetch_add(p, v, __ATOMIC_RELAXED, __HIP_MEMORY_SCOPE_AGENT); }
__device__ __forceinline__ unsigned xb_xcc_id() { return (unsigned)__builtin_amdgcn_s_getreg((3 << 11) | 20) & 0xFu; }
#define XB_SPIN(cond, bar) do { unsigned _sp = 0; while (cond) { __builtin_amdgcn_s_sleep(1); \
    if ((++_sp & 255u) == 0u) { if (xb_ld(&(bar)[XB_TMO])) break; if (_sp > XB_SPIN_CAP) { atomicAdd(&(bar)[XB_TMO], 1u); break; } } } } while (0)
struct XcdBarrier { unsigned* bar; unsigned x; volatile LAS unsigned* st; };
__device__ __forceinline__ XcdBarrier xcd_barrier_post(unsigned* bar, volatile LAS unsigned* st) {
  XcdBarrier b; b.bar = bar; b.x = xb_xcc_id(); b.st = st;
  if (threadIdx.x == 0) (void)xb_add(&bar[XB_XCNT(b.x)], 1u);
  return b;
}
__device__ __forceinline__ void xcd_barrier_complete(unsigned* bar, unsigned x, unsigned& nloc, unsigned& nx) {
  const unsigned G = gridDim.x * gridDim.y * gridDim.z;
  unsigned sum, cnt, mine, sp = 0u;
  for (;;) {
    sum = 0u; cnt = 0u; mine = 0u;
#pragma unroll
    for (unsigned j = 0; j < 16; ++j) { const unsigned c = xb_ld(&bar[XB_XCNT(j)]); sum += c; cnt += (c > 0u) ? 1u : 0u; mine = (j == x) ? c : mine; }
    if (sum == G) break;
    __builtin_amdgcn_s_sleep(1);
    if ((++sp & 255u) == 0u) { if (xb_ld(&bar[XB_TMO])) break; if (sp > XB_SPIN_CAP) { atomicAdd(&bar[XB_TMO], 1u); break; } }
  }
  nloc = mine > 0u ? mine : 1u; nx = cnt > 0u ? cnt : 1u;
}
__device__ __forceinline__ void xcd_barrier(const XcdBarrier& b, const int wave) {
  asm volatile("s_waitcnt vmcnt(0)" ::: "memory");
  __syncthreads();
  if (wave == 0 && lane_id() == 0) {
    unsigned* bar = b.bar;
    __builtin_amdgcn_s_waitcnt(0);
    unsigned nloc = b.st[0], nx = b.st[1];
    if (nloc == 0u) { xcd_barrier_complete(bar, b.x, nloc, nx); b.st[0] = nloc; b.st[1] = nx; }
    const unsigned old = xb_add(&bar[XB_XSUB(b.x)], 1u);
    const unsigned gen = old / nloc;
    if (old + 1u == (gen + 1u) * nloc) {
      __builtin_amdgcn_fence(__ATOMIC_RELEASE, "agent");
      asm volatile("s_waitcnt vmcnt(0)" ::: "memory");
      const unsigned og = xb_add(&bar[XB_TOP], 1u);
      const unsigned tg = og / nx;
      if (og + 1u == (tg + 1u) * nx) xb_add(&bar[XB_TOPGEN], 1u);
      else XB_SPIN(xb_ld(&bar[XB_TOPGEN]) == tg, bar);
      __builtin_amdgcn_fence(__ATOMIC_ACQUIRE, "agent");
      xb_add(&bar[XB_XGEN(b.x)], 1u);
      asm volatile("s_waitcnt vmcnt(0)" ::: "memory");
    } else {
      XB_SPIN(xb_ld(&bar[XB_XGEN(b.x)]) == gen, bar);
      __builtin_amdgcn_fence(__ATOMIC_ACQUIRE, "agent");
      asm volatile("s_waitcnt vmcnt(0)" ::: "memory");
    }
  }
  __syncthreads();
}

namespace pg8 {
constexpr int BM = 256, BK = 64, HALF = 128, HTB = HALF * BK * 2, STAGE_BYTES = 8 * HTB, NXCD = 8, WGM = 8;
__host__ __device__ __forceinline__ int lds_byte(int r, int c) { const int st = (r >> 4) * 2 + (c >> 5), rr = r & 15, cc = c & 31, ob = rr * 64 + cc * 2; return st * 1024 + (ob ^ (((ob >> 9) & 1) << 5)); }
__host__ __device__ __forceinline__ void stage_rc(int b, int& R, int& C) { const int st = b / 1024, sb = b % 1024, swz = sb ^ (((sb >> 9) & 1) << 5); R = (st >> 1) * 16 + swz / 64; C = (st & 1) * 32 + (swz % 64) / 2; }
__host__ __device__ __forceinline__ int perm32(int rho) { const int n = rho >> 4, i = rho & 15; return 8 * (i >> 2) + 4 * n + (i & 3); }
struct Unit { int pm, pn; };
struct Gemm { const bf16_t* A; const bf16_t* Bt; int M, N, K; int ld; };
struct OneUnit {
  int pm, pn;
  __device__ __forceinline__ bool next(int i, Unit& u) const { if (i != 0) return false; u.pm = pm; u.pn = pn; return true; }
  __device__ __forceinline__ void a_ready(const Unit&) const {}
  __device__ __forceinline__ void done(const Unit&) const {}
};
struct StaticOrder {
  int nM, nN, nwg, G, c;
  __host__ __device__ void init(int M, int N, int G_, int c_) { nM = M / BM; nN = N / BM; nwg = nM * nN; G = G_; c = c_; }
  __host__ __device__ bool next(int i, Unit& u) const {
    const long L = (long)i * G + c; if (L >= nwg) return false;
    int wgid = (int)L; { const int q = nwg / NXCD, r = nwg % NXCD, xcd = wgid % NXCD, off = wgid / NXCD; wgid = (xcd < r ? xcd * (q + 1) : r * (q + 1) + (xcd - r) * q) + off; }
    const int nig = WGM * nN, gid = wgid / nig, fm = gid * WGM, gsz = (nM - fm) < WGM ? (nM - fm) : WGM;
    u.pm = fm + ((wgid % nig) % gsz); u.pn = (wgid % nig) / gsz; return true;
  }
  __device__ __forceinline__ void a_ready(const Unit&) const {}
  __device__ __forceinline__ void done(const Unit&) const {}
};

template <int MODE  > struct EpiBf16Act {
  static constexpr bool PERM = true, AFTER_DRAIN = false;
  bf16_t* O; int ldc;
  __device__ __forceinline__ void operator()(const f32x4 (&acc)[2][2][4][2], const Unit& u, int wr, int wc, int fr, int fq) const {
    const int row0 = u.pm * BM + wr * 64 + fr, col0 = u.pn * BM + wc * 32 + 8 * fq;
    const bool sg = u.pn >= 8;
#pragma unroll
    for (int ai = 0; ai < 2; ++ai)
#pragma unroll
      for (int m = 0; m < 4; ++m) { bf16_t* rowp = O + (size_t)(row0 + ai * HALF + m * 16) * ldc + col0;
#pragma unroll
        for (int bj = 0; bj < 2; ++bj) { f32x4 v0 = acc[ai][bj][m][0], v1 = acc[ai][bj][m][1];
          if (MODE == 1) {
#pragma unroll
            for (int i = 0; i < 4; ++i) { const float s0 = __builtin_amdgcn_rcpf(1.f + __expf(-v0[i])), s1 = __builtin_amdgcn_rcpf(1.f + __expf(-v1[i]));
              v0[i] = sg ? s0 : v0[i] * s0; v1[i] = sg ? s1 : v1[i] * s1; } }
          u32x4 w; w.x = cvt_pk_bf16(v0[0], v0[1]); w.y = cvt_pk_bf16(v0[2], v0[3]); w.z = cvt_pk_bf16(v1[0], v1[1]); w.w = cvt_pk_bf16(v1[2], v1[3]);
          *(u32x4*)(rowp + bj * HALF) = w; } }
  }
};
struct EpiQKV {
  static constexpr bool PERM = true, AFTER_DRAIN = false;
  bf16_t* O; int ldc; bf16_t* HALO;
  __device__ __forceinline__ void operator()(const f32x4 (&acc)[2][2][4][2], const Unit& u, int wr, int wc, int fr, int fq) const {
    const int row0 = u.pm * BM + wr * 64 + fr, col0 = u.pn * BM + wc * 32 + 8 * fq;
#pragma unroll
    for (int ai = 0; ai < 2; ++ai)
#pragma unroll
      for (int m = 0; m < 4; ++m) { const int row = row0 + ai * HALF + m * 16; bf16_t* rowp = O + (size_t)row * ldc + col0;
#pragma unroll
        for (int bj = 0; bj < 2; ++bj) { const f32x4 v0 = acc[ai][bj][m][0], v1 = acc[ai][bj][m][1];
          u32x4 w; w.x = cvt_pk_bf16(v0[0], v0[1]); w.y = cvt_pk_bf16(v0[2], v0[3]); w.z = cvt_pk_bf16(v1[0], v1[1]); w.w = cvt_pk_bf16(v1[2], v1[3]);
          *(u32x4*)(rowp + bj * HALF) = w;
          if (u.pn >= 8 && ((m == 0 && fr == 0) || (m == 3 && fr == 15)))
            *(u32x4*)(HALO + ((size_t)(row >> 6) * 2 + (m == 3 ? 1 : 0)) * 2048 + (col0 - 2048) + bj * HALF) = w; } }
  }
};
struct EpiGateMul {
  static constexpr bool PERM = true, AFTER_DRAIN = false;
  bf16_t* O; int ldc; const bf16_t* G; int ldg; const bf16_t* Add;
  __device__ __forceinline__ void operator()(const f32x4 (&acc)[2][2][4][2], const Unit& u, int wr, int wc, int fr, int fq) const {
    const int row0 = u.pm * BM + wr * 64 + fr, col0 = u.pn * BM + wc * 32 + 8 * fq;
#pragma unroll
    for (int ai = 0; ai < 2; ++ai)
#pragma unroll
      for (int m = 0; m < 4; ++m) { const size_t r = (size_t)(row0 + ai * HALF + m * 16);
#pragma unroll
        for (int bj = 0; bj < 2; ++bj) { const f32x4 v0 = acc[ai][bj][m][0], v1 = acc[ai][bj][m][1];
          const u32x4 g = *(const u32x4*)(G + r * ldg + col0 + bj * HALF);
          float o[8] = {v0[0] * lo_bf(g.x), v0[1] * hi_bf(g.x), v0[2] * lo_bf(g.y), v0[3] * hi_bf(g.y), v1[0] * lo_bf(g.z), v1[1] * hi_bf(g.z), v1[2] * lo_bf(g.w), v1[3] * hi_bf(g.w)};
          if (Add) { const u32x4 a = *(const u32x4*)(Add + r * ldc + col0 + bj * HALF);
            o[0] += lo_bf(a.x); o[1] += hi_bf(a.x); o[2] += lo_bf(a.y); o[3] += hi_bf(a.y); o[4] += lo_bf(a.z); o[5] += hi_bf(a.z); o[6] += lo_bf(a.w); o[7] += hi_bf(a.w); }
          u32x4 w; w.x = cvt_pk_bf16(o[0], o[1]); w.y = cvt_pk_bf16(o[2], o[3]); w.z = cvt_pk_bf16(o[4], o[5]); w.w = cvt_pk_bf16(o[6], o[7]);
          *(u32x4*)(O + r * ldc + col0 + bj * HALF) = w; } }
  }
};
struct EpiF32 {
  static constexpr bool PERM = false, AFTER_DRAIN = false;
  float* O; int ldc;
  __device__ __forceinline__ void operator()(const f32x4 (&acc)[2][2][4][2], const Unit& u, int wr, int wc, int fr, int fq) const {
    const int row0 = u.pm * BM + wr * 64 + fr, col0 = u.pn * BM + wc * 32 + 4 * fq;
#pragma unroll
    for (int ai = 0; ai < 2; ++ai)
#pragma unroll
      for (int m = 0; m < 4; ++m) { float* rowp = O + (size_t)(row0 + ai * HALF + m * 16) * ldc + col0;
#pragma unroll
        for (int bj = 0; bj < 2; ++bj)
#pragma unroll
          for (int n = 0; n < 2; ++n) *(f32x4*)(rowp + bj * HALF + n * 16) = acc[ai][bj][m][n]; }
  }
};
struct EpiSwiGLU {
  static constexpr bool PERM = true, AFTER_DRAIN = false;
  bf16_t* O; int ldc;
  __device__ __forceinline__ void operator()(const f32x4 (&acc)[2][2][4][2], const Unit& u, int wr, int wc, int fr, int fq) const {
    const int row0 = u.pm * BM + wr * 64 + fr, col0 = u.pn * HALF + wc * 32 + 8 * fq;
#pragma unroll
    for (int ai = 0; ai < 2; ++ai)
#pragma unroll
      for (int m = 0; m < 4; ++m) { bf16_t* rowp = O + (size_t)(row0 + ai * HALF + m * 16) * ldc + col0;
        float o[8];
#pragma unroll
        for (int n = 0; n < 2; ++n)
#pragma unroll
          for (int i = 0; i < 4; ++i) { const float g = acc[ai][0][m][n][i], up = acc[ai][1][m][n][i]; o[4 * n + i] = g * __builtin_amdgcn_rcpf(1.f + __expf(-g)) * up; }
        u32x4 w; w.x = cvt_pk_bf16(o[0], o[1]); w.y = cvt_pk_bf16(o[2], o[3]); w.z = cvt_pk_bf16(o[4], o[5]); w.w = cvt_pk_bf16(o[6], o[7]);
        *(u32x4*)rowp = w; }
  }
};

template <class Epi, class Sched, bool ALIGN_EPI = false, bool SP2 = false>
__device__ __forceinline__ void gemm_phase(LAS unsigned char* lds, const Gemm g, const Sched& S, const Epi& E, const int wid) {
  int lane_o = lane_id(); asm volatile("" : "+v"(lane_o));
  const int lane = lane_o, tid = (wid << 6) | lane, wr = wid >> 2, wc = wid & 3, fr = lane & 15, fq = lane >> 4;
  const int K = g.ld ? g.ld : g.K, nt = g.K / BK;
  unsigned voffA[2], voffB[2];
#pragma unroll
  for (int i = 0; i < 2; ++i) { int R, C; stage_rc(tid * 16 + i * 8192, R, C); const int Rb = Epi::PERM ? ((R & ~31) + perm32(R & 31)) : R;
    voffA[i] = (unsigned)(R * K + C) * 2u; voffB[i] = (unsigned)(Rb * K + C) * 2u; }
  const size_t kstep = (size_t)(BK * 2);
  const size_t hstep = (size_t)HALF * K * 2;
  const size_t tstep = 2 * hstep;
  const unsigned ldsw = (unsigned)wid * 1024u;
  const int aoff = lds_byte(wr * 64 + fr, fq * 8), boff = lds_byte(wc * 32 + fr, fq * 8);
#define PG8_SA(b, h) (((b) * 2 + (h)) * HTB)
#define PG8_SB(b, h) ((4 + (b) * 2 + (h)) * HTB)
#define PG8_STAGE(bufoff, gbase, voff) do { _Pragma("unroll") for (int _i = 0; _i < 2; ++_i) \
    __builtin_amdgcn_global_load_lds((const unsigned*)((const char*)(gbase) + (voff)[_i]), (LAS unsigned*)(lds + (bufoff) + ldsw + _i * 8192), 16, 0, 0); } while (0)
#define PG8_LDA(dst, b, h) do { _Pragma("unroll") for (int m = 0; m < 4; ++m) _Pragma("unroll") for (int k = 0; k < 2; ++k) dst[m][k] = *(const LAS bf16x8*)(lds + PG8_SA(b, h) + aoff + m * 2048 + k * 1024); } while (0)
#define PG8_LDB(dst, b, h) do { _Pragma("unroll") for (int n = 0; n < 2; ++n) _Pragma("unroll") for (int k = 0; k < 2; ++k) dst[n][k] = *(const LAS bf16x8*)(lds + PG8_SB(b, h) + boff + n * 2048 + k * 1024); } while (0)
#define PG8_MMA(ai, bj, At, Bt) do { __builtin_amdgcn_s_setprio(1); _Pragma("unroll") for (int m = 0; m < 4; ++m) _Pragma("unroll") for (int n = 0; n < 2; ++n) _Pragma("unroll") for (int k = 0; k < 2; ++k) \
    acc[ai][bj][m][n] = __builtin_amdgcn_mfma_f32_16x16x32_bf16(Bt[n][k], At[m][k], acc[ai][bj][m][n], 0, 0, 0); __builtin_amdgcn_s_setprio(0); } while (0)
#define PG8_WAIT_V(n) asm volatile("s_waitcnt vmcnt(" #n ")" ::: "memory")
#define PG8_WAIT_L(n) asm volatile("s_waitcnt lgkmcnt(" #n ")" ::: "memory")
#define PG8_BAR __builtin_amdgcn_s_barrier()
#define PG8_SCHED __builtin_amdgcn_sched_barrier(0)
  Unit cur, nxt; int ui = 0;
  if (!S.next(0, cur)) return;
  f32x4 acc[2][2][4][2];
#pragma unroll
  for (int a = 0; a < 2; ++a)
#pragma unroll
    for (int b = 0; b < 2; ++b)
#pragma unroll
      for (int m = 0; m < 4; ++m)
#pragma unroll
        for (int n = 0; n < 2; ++n) acc[a][b][m][n] = (f32x4){0.f, 0.f, 0.f, 0.f};
  bf16x8 At[4][2], B0[2][2], B1[2][2];
  const char* cA = (const char*)g.A + (size_t)cur.pm * tstep; const char* cB = (const char*)g.Bt + (size_t)cur.pn * tstep;
  S.a_ready(cur);
  if constexpr (SP2) {
    PG8_STAGE(PG8_SB(0, 0), cB, voffB); PG8_STAGE(PG8_SB(0, 1), cB + hstep, voffB); PG8_STAGE(PG8_SA(0, 0), cA, voffA); PG8_STAGE(PG8_SA(0, 1), cA + hstep, voffA);
    if (wr == 1) PG8_BAR;
    PG8_WAIT_V(2); PG8_BAR;
    PG8_STAGE(PG8_SB(1, 0), cB + kstep, voffB); PG8_STAGE(PG8_SA(1, 0), cA + kstep, voffA); PG8_STAGE(PG8_SB(1, 1), cB + hstep + kstep, voffB);
    PG8_WAIT_V(6); PG8_BAR;
  } else {
    PG8_STAGE(PG8_SB(0, 0), cB, voffB); PG8_STAGE(PG8_SA(0, 0), cA, voffA); PG8_STAGE(PG8_SB(0, 1), cB + hstep, voffB); PG8_STAGE(PG8_SA(0, 1), cA + hstep, voffA);
    if (wr == 1) PG8_BAR;
    PG8_WAIT_V(4); PG8_BAR;
    PG8_STAGE(PG8_SB(1, 0), cB + kstep, voffB); PG8_STAGE(PG8_SA(1, 0), cA + kstep, voffA); PG8_STAGE(PG8_SB(1, 1), cB + hstep + kstep, voffB);
    PG8_WAIT_V(6); PG8_BAR;
  }
  for (;;) {
    const bool has_next = S.next(ui + 1, nxt);
    const char* nA = has_next ? (const char*)g.A + (size_t)nxt.pm * tstep : cA; const char* nB = has_next ? (const char*)g.Bt + (size_t)nxt.pn * tstep : cB;
    for (int t = 0; t < nt; t += 2) {
      const bool last = (t == nt - 2);
      const char* a1 = cA + (size_t)(t + 1) * kstep;
      const char* a2 = last ? nA : cA + (size_t)(t + 2) * kstep; const char* b2 = last ? nB : cB + (size_t)(t + 2) * kstep;
      const char* a3 = a2 + kstep; const char* b3 = b2 + kstep;
      if (last && has_next) S.a_ready(nxt);
      if constexpr (SP2) {
        PG8_LDB(B0, 0, 0); PG8_LDB(B1, 0, 1); PG8_SCHED; PG8_LDA(At, 0, 0); PG8_STAGE(PG8_SA(1, 1), a1 + hstep, voffA);
        PG8_WAIT_V(8); PG8_WAIT_L(0); PG8_BAR; PG8_MMA(0, 0, At, B0); PG8_MMA(0, 1, At, B1); PG8_BAR; PG8_SCHED;
        PG8_LDA(At, 0, 1); PG8_STAGE(PG8_SB(0, 0), b2, voffB); PG8_STAGE(PG8_SB(0, 1), b2 + hstep, voffB); PG8_STAGE(PG8_SA(0, 0), a2, voffA);
        PG8_WAIT_V(8); PG8_WAIT_L(0); PG8_BAR; PG8_MMA(1, 0, At, B0); PG8_MMA(1, 1, At, B1); PG8_BAR; PG8_SCHED;
        PG8_LDB(B0, 1, 0); PG8_LDB(B1, 1, 1); PG8_SCHED; PG8_LDA(At, 1, 0); PG8_STAGE(PG8_SA(0, 1), a2 + hstep, voffA);
        PG8_WAIT_V(8); PG8_WAIT_L(0); PG8_BAR; PG8_MMA(0, 0, At, B0); PG8_MMA(0, 1, At, B1); PG8_BAR; PG8_SCHED;
        PG8_LDA(At, 1, 1); PG8_STAGE(PG8_SB(1, 0), b3, voffB); PG8_STAGE(PG8_SB(1, 1), b3 + hstep, voffB); PG8_STAGE(PG8_SA(1, 0), a3, voffA);
        PG8_WAIT_V(8); PG8_WAIT_L(0); PG8_BAR; PG8_MMA(1, 0, At, B0); PG8_MMA(1, 1, At, B1); PG8_BAR; PG8_SCHED;
      } else {
        PG8_LDB(B0, 0, 0); PG8_SCHED; PG8_LDA(At, 0, 0); PG8_STAGE(PG8_SA(1, 1), a1 + hstep, voffA);
        PG8_WAIT_L(8); PG8_BAR; PG8_WAIT_L(0); PG8_MMA(0, 0, At, B0); PG8_BAR; PG8_SCHED;
        PG8_LDB(B1, 0, 1); PG8_STAGE(PG8_SB(0, 0), b2, voffB);
        PG8_BAR; PG8_WAIT_L(0); PG8_MMA(0, 1, At, B1); PG8_BAR;
        PG8_LDA(At, 0, 1); PG8_STAGE(PG8_SA(0, 0), a2, voffA);
        PG8_BAR; PG8_WAIT_L(0); PG8_MMA(1, 0, At, B0); PG8_BAR; PG8_SCHED;
        PG8_STAGE(PG8_SB(0, 1), b2 + hstep, voffB);
        PG8_WAIT_V(6); PG8_BAR; PG8_MMA(1, 1, At, B1); PG8_BAR;
        PG8_LDB(B0, 1, 0); PG8_SCHED; PG8_LDA(At, 1, 0); PG8_STAGE(PG8_SA(0, 1), a2 + hstep, voffA);
        PG8_WAIT_L(8); PG8_BAR; PG8_WAIT_L(0); PG8_MMA(0, 0, At, B0); PG8_BAR; PG8_SCHED;
        PG8_LDB(B1, 1, 1); PG8_STAGE(PG8_SB(1, 0), b3, voffB);
        PG8_BAR; PG8_WAIT_L(0); PG8_MMA(0, 1, At, B1); PG8_BAR;
        PG8_LDA(At, 1, 1); PG8_STAGE(PG8_SA(1, 0), a3, voffA);
        PG8_BAR; PG8_WAIT_L(0); PG8_MMA(1, 0, At, B0); PG8_BAR; PG8_SCHED;
        PG8_STAGE(PG8_SB(1, 1), b3 + hstep, voffB);
        PG8_WAIT_V(6); PG8_BAR; PG8_MMA(1, 1, At, B1); PG8_BAR;
      }
    }
    if constexpr (ALIGN_EPI) { if (wr == 0) PG8_BAR; }
    if constexpr (!Epi::AFTER_DRAIN) { E(acc, cur, wr, wc, fr, fq); S.done(cur); }
    if (!has_next) break;
#pragma unroll
    for (int a = 0; a < 2; ++a)
#pragma unroll
      for (int b = 0; b < 2; ++b)
#pragma unroll
        for (int m = 0; m < 4; ++m)
#pragma unroll
          for (int n = 0; n < 2; ++n) acc[a][b][m][n] = (f32x4){0.f, 0.f, 0.f, 0.f};
    cur = nxt; cA = nA; cB = nB; ++ui;
    if constexpr (ALIGN_EPI) { if (wr == 1) PG8_BAR; }
  }
  PG8_WAIT_V(0);
  if constexpr (!ALIGN_EPI) { if (wr == 0) PG8_BAR; }
  PG8_BAR;
#undef PG8_SA
#undef PG8_SB
#undef PG8_STAGE
#undef PG8_LDA
#undef PG8_LDB
#undef PG8_MMA
#undef PG8_WAIT_V
#undef PG8_WAIT_L
#undef PG8_BAR
#undef PG8_SCHED
}
}

typedef float f32x16 __attribute__((ext_vector_type(16)));
typedef float f32x8 __attribute__((ext_vector_type(8)));
typedef short s16x4 __attribute__((ext_vector_type(4)));
typedef __bf16 bfx8 __attribute__((ext_vector_type(8)));
#define MFMA32(a, b, c) __builtin_amdgcn_mfma_f32_32x32x16_bf16((a), (b), (c), 0, 0, 0)
__device__ __forceinline__ bf16x8 cvt8(f32x8 t) { return __builtin_bit_cast(bf16x8, __builtin_convertvector(t, bfx8)); }
__device__ __forceinline__ bf16x8 pack8(const f32x16& x, int s) {
  const f32x8 t = {x[8 * s], x[8 * s + 1], x[8 * s + 2], x[8 * s + 3], x[8 * s + 4], x[8 * s + 5], x[8 * s + 6], x[8 * s + 7]};
  return cvt8(t);
}
__device__ __forceinline__ f32x16 zero16() { f32x16 z; for (int i = 0; i < 16; ++i) z[i] = 0.f; return z; }
__device__ __forceinline__ unsigned off_b(unsigned row, unsigned ch) { return 256u * row + 16u * (ch ^ (((row & 3u) << 2) | ((row >> 2) & 3u))); }
__device__ __forceinline__ int swap12(int p) { return ((p & 1) << 1) | (p >> 1); }
__device__ __forceinline__ bf16x8 lds_rd128(LAS unsigned char* lds, unsigned off) { return *(const LAS bf16x8*)(lds + off); }
__device__ __forceinline__ bf16x8 lds_tr2(LAS unsigned char* lds, unsigned off_lo, unsigned off_hi) {
  const s16x4 lo = __builtin_amdgcn_ds_read_tr16_b64_v4i16((LAS s16x4*)(lds + off_lo));
  const s16x4 hi = __builtin_amdgcn_ds_read_tr16_b64_v4i16((LAS s16x4*)(lds + off_hi));
  return __builtin_shufflevector(lo, hi, 0, 1, 2, 3, 4, 5, 6, 7);
}
__device__ __forceinline__ void glds16(const void* g, LAS unsigned char* l) {
  unsigned keep; const unsigned dst = __builtin_amdgcn_readfirstlane((unsigned)(size_t)l);
  asm volatile("s_mov_b32 %0, m0\n\ts_mov_b32 m0, %2\n\ts_nop 0\n\tglobal_load_lds_dwordx4 %1, off\n\ts_mov_b32 m0, %0" : "=&s"(keep) : "v"(g), "s"(dst) : "memory");
}
__device__ __forceinline__ unsigned rowfrag_off(int lane, int mt, int ks) { return off_b(32 * mt + (lane & 31), 2 * ks + (lane >> 5)); }
__device__ __forceinline__ unsigned vtr_off(int lane, int cb, int ks, int sec) {
  const int g = lane >> 4, i = lane & 15, hh = g >> 1, half16 = g & 1, qq = i >> 2, p = i & 3;
  const int row = 16 * ks + 4 * hh + 8 * sec + qq, col = cb + 16 * half16 + 4 * p;
  return off_b(row, col >> 3) + (col & 7) * 2;
}
__device__ __forceinline__ unsigned ktr_off(int lane, int mt, int ks, int sec) {
  const int g = lane >> 4, i = lane & 15, hh = g >> 1, half16 = g & 1, qq = i >> 2, p = i & 3;
  const int row = 16 * ks + 4 * hh + 8 * sec + qq, col = 32 * mt + 16 * half16 + 4 * swap12(p);
  return off_b(row, col >> 3) + (col & 7) * 2;
}
__device__ __forceinline__ int crow(int reg, int h) { return (reg & 3) + 8 * (reg >> 2) + 4 * h; }
__device__ __forceinline__ int srow(int reg, int h) { return 16 * (reg >> 3) + 8 * h + 4 * ((reg >> 2) & 1) + (reg & 3); }
__device__ __forceinline__ void rowscale(f32x16& a, const LAS float* vec, int h, float sgn) {
#pragma unroll
  for (int g4 = 0; g4 < 4; ++g4) { const f32x4 s = *(const LAS f32x4*)(vec + 8 * g4 + 4 * h);
    a[4 * g4] *= s.x * sgn; a[4 * g4 + 1] *= s.y * sgn; a[4 * g4 + 2] *= s.z * sgn; a[4 * g4 + 3] *= s.w * sgn; }
}
__device__ __forceinline__ void stage_img_piece(const unsigned char* src, size_t pitch, LAS unsigned char* img, int pc, int lane) {
  const unsigned row = 4 * pc + (lane >> 4), chp = lane & 15, ch = chp ^ (((row & 3u) << 2) | ((row >> 2) & 3u));
  glds16(src + (size_t)row * pitch + ch * 16, img + 1024 * pc);
}
constexpr int SC_BUF = 66560, SC_Q = 0, SC_K = 16384, SC_M = 32768, SC_V = 50176, SC_VEC = 2 * SC_BUF;
constexpr int DN_BLOB = 17408, RT_BLOB = 8192;
__device__ __forceinline__ void glds16_s(const unsigned char* base_uniform, unsigned voff, LAS unsigned char* l) {
  unsigned keep; const unsigned dst = __builtin_amdgcn_readfirstlane((unsigned)(size_t)l);
  const unsigned long long b = (unsigned long long)(size_t)base_uniform;
  const unsigned long long bs = ((unsigned long long)(unsigned)__builtin_amdgcn_readfirstlane((unsigned)(b >> 32)) << 32) | (unsigned)__builtin_amdgcn_readfirstlane((unsigned)b);
  asm volatile("s_mov_b32 %0, m0\n\ts_mov_b32 m0, %3\n\ts_nop 0\n\tglobal_load_lds_dwordx4 %1, %2\n\ts_mov_b32 m0, %0" : "=&s"(keep) : "v"(voff), "s"(bs), "s"(dst) : "memory");
}
struct StageOff { unsigned q[2], k[2], m; };
__device__ __forceinline__ StageOff scan_stage_offsets(int w, int lane, unsigned kpitch) {
  StageOff o;
#pragma unroll
  for (int i = 0; i < 2; ++i) { const unsigned pc = w + 8 * i, row = 4 * pc + (lane >> 4), chp = lane & 15, ch = chp ^ (((row & 3u) << 2) | ((row >> 2) & 3u));
    o.q[i] = row * (unsigned)(LDQ * 2) + ch * 16; o.k[i] = row * kpitch + ch * 16; }
  o.m = lane * 16;
  return o;
}
__device__ __forceinline__ void scan_stage(LAS unsigned char* lds, int buf, int type, int dir, int h, int gc, const bf16_t* QKV, const bf16_t* KBUF,
                                           const unsigned char* MATS_RT, const unsigned char* MATS_DN, int half, int w, const StageOff& so) {
  const size_t row0 = (size_t)gc * 64;
  const unsigned char* rowp = (const unsigned char*)(QKV + row0 * LDQ);
  const unsigned char* qsrc = rowp + (type ? Q_DQ + h * DK : Q_RQ + h * DK) * 2;
  const unsigned char* ksrc = rowp + (type ? Q_DK + h * DK : Q_RK + h * DK) * 2;
  if (!type && dir) ksrc = (const unsigned char*)(KBUF + row0 * 512 + h * DK);
  const unsigned char* vsrc = rowp + (type ? Q_DV + h * DV : Q_RV + h * DV) * 2 + half * 256;
  LAS unsigned char* B = lds + buf * SC_BUF;
#pragma unroll
  for (int i = 0; i < 2; ++i) { const int pc = w + 8 * i;
    glds16_s(qsrc, so.q[i], B + SC_Q + 1024 * pc); glds16_s(ksrc, so.k[i], B + SC_K + 1024 * pc); glds16_s(vsrc, so.q[i], B + SC_V + 1024 * pc); }
  const unsigned char* blob = type ? MATS_DN + (size_t)((gc * 4 + h) * 2 + dir) * DN_BLOB : MATS_RT + (size_t)((gc * 4 + h) * 2 + dir) * RT_BLOB;
  const int np = type ? 17 : 8;
  for (int pc = w; pc < np; pc += 8) glds16_s(blob + pc * 1024, so.m, B + SC_M + pc * 1024);
}

__device__ __forceinline__ void transpose_item(const float* W, int ldw, int K, int src_col0, bf16_t* WT, int dst_row0, int k0, LAS float* scr, int lane) {
#pragma unroll 8
  for (int i = 0; i < 32; ++i) { const int kk = 2 * i + (lane >> 5); scr[kk * 33 + (lane & 31)] = W[(size_t)(k0 + kk) * ldw + src_col0 + (lane & 31)]; }
  asm volatile("s_waitcnt lgkmcnt(0)" ::: "memory");
  const int c = lane & 7;
#pragma unroll
  for (int j = 0; j < 4; ++j) { const int n = (lane >> 3) + 8 * j; const LAS float* s = scr + (8 * c) * 33 + n;
    u32x4 o; o.x = pk2(s[0 * 33], s[1 * 33]); o.y = pk2(s[2 * 33], s[3 * 33]); o.z = pk2(s[4 * 33], s[5 * 33]); o.w = pk2(s[6 * 33], s[7 * 33]);
    *(u32x4*)(WT + (size_t)(dst_row0 + n) * K + k0 + 8 * c) = o; }
  asm volatile("s_waitcnt lgkmcnt(0)" ::: "memory");
}

template <class ColMap> __device__ __forceinline__ void transpose_matrix(const float* W, int ldw, int K, int N, bf16_t* WT, ColMap cm, LAS float* scr, int gw, int ngw, int lane) {
  const int nblk = N / 32, items = (K / 64) * nblk;
  for (int it = gw; it < items; it += ngw) { const int kb = it / nblk, nb = it % nblk; transpose_item(W, ldw, K, cm(32 * nb), WT, 32 * nb, 64 * kb, scr, lane); }
}

__global__ void __launch_bounds__(NTHREADS) fwd_megakernel(Params p) {
  extern __shared__ __attribute__((aligned(16))) unsigned char lds_raw[];
  LAS unsigned char* lds = (LAS unsigned char*)lds_raw;
  cg::grid_group grid = cg::this_grid();
  volatile LAS unsigned* bar_st = (volatile LAS unsigned*)(lds + LDS_BYTES - 64);
  if (threadIdx.x < 2) bar_st[threadIdx.x] = 0u;
  __syncthreads();
  const XcdBarrier xbar = xcd_barrier_post((unsigned*)(p.ws + WS_BAR), bar_st);
  if (p.ws == nullptr) grid.sync();
#define GRID_BARRIER() xcd_barrier(xbar, wave)
  const int wave = __builtin_amdgcn_readfirstlane(threadIdx.x >> 6);
#define PHASE_TID() int lane_p = lane_id(); asm volatile("" : "+v"(lane_p)); const int lane = lane_p, tid = (wave << 6) | lane; (void)tid;
  const int G = gridDim.x, bid = blockIdx.x;
  const int gw = bid * NWAVES + wave, ngw = G * NWAVES;
  unsigned char* ws = p.ws;
  float* MOD = (float*)(ws + WS_MOD);
  f32x2* ROPE = (f32x2*)(ws + WS_ROPE);
  float* BA = (float*)(ws + WS_BA);
  float* DECLG = (float*)(ws + WS_MOD + 122880);
  bf16_t* WQKV = (bf16_t*)(ws + WS_WQKV); bf16_t* WGATE = (bf16_t*)(ws + WS_WGATE);
  bf16_t* WRO = (bf16_t*)(ws + WS_WRO); bf16_t* WDO = (bf16_t*)(ws + WS_WDO); bf16_t* WOUT = (bf16_t*)(ws + WS_WOUT);
  bf16_t* HB = (bf16_t*)(ws + WS_H);
  bf16_t* QKV = (bf16_t*)(ws + WS_QKV);
  bf16_t* KBUF = (bf16_t*)(ws + WS_KB); bf16_t* HALO = (bf16_t*)(ws + WS_HALO);
  unsigned char* MATS_RT = ws + WS_MATS_RT; unsigned char* MATS_DN = ws + WS_MATS_DN;
  unsigned char* LSCR = ws + WS_O; constexpr int LSCR_STRIDE = 16896;
  bf16_t* ODF = (bf16_t*)(ws + WS_O); bf16_t* ODB = ODF + (size_t)MTOT * D;
  bf16_t* ORF = (bf16_t*)p.out; bf16_t* ORB = ORF + (size_t)MTOT * D;
  float* NS_RET = p.out + (size_t)MTOT * D; float* NS_DN = NS_RET + (size_t)NCTX * 2 * NH * DK * DV;

  {
    PHASE_TID();
    LAS float* scr = (LAS float*)(lds + wave * 16384);
    transpose_matrix(p.in[I_WIN], INC, D, 4096, WQKV, [](int n) { return n < 2048 ? n : n + 1024; }, scr, gw, ngw, lane);
    transpose_matrix(p.in[I_WIN], INC, D, 4096, WGATE, [](int n) { return n < 1024 ? C_RG + n : (n < 2048 ? C_DZ + (n - 1024) : C_GR + (n - 2048)); }, scr, gw, ngw, lane);
    transpose_matrix(p.in[I_WRO], D, D, D, WRO, [](int n) { return n; }, scr, gw, ngw, lane);
    transpose_matrix(p.in[I_WDO], D, D, D, WDO, [](int n) { return n; }, scr, gw, ngw, lane);
    transpose_matrix(p.in[I_WOUT], D, D, D, WOUT, [](int n) { return n; }, scr, gw, ngw, lane);
    {
      __syncthreads();
      LAS float* scond = (LAS float*)lds;
      LAS float* red = scond + 5 * D;
      for (int i = tid; i < 5 * D; i += NTHREADS) { const int c = i >> 10, k = i & 1023; scond[i] = siluf(c == 0 ? p.in[I_CCTX][k] : p.in[I_C][(c - 1) * D + k]); }
      __syncthreads();
      for (int it = bid; it < 6 * D / 32; it += G) {
        const int col = it * 32 + (lane & 31), rpar = lane >> 5;
        float acc[5] = {0.f, 0.f, 0.f, 0.f, 0.f};
        const float* wm = p.in[I_WMOD] + (size_t)(128 * wave + rpar) * 6 * D + col;
#pragma unroll 16
        for (int i = 0; i < 64; ++i) { const float wv = wm[(size_t)(2 * i) * 6 * D]; const int k = 128 * wave + 2 * i + rpar;
#pragma unroll
          for (int c = 0; c < 5; ++c) acc[c] += scond[c * D + k] * wv; }
#pragma unroll
        for (int c = 0; c < 5; ++c) { acc[c] += __shfl_xor(acc[c], 32); if (lane < 32) red[(wave * 5 + c) * 32 + lane] = acc[c]; }
        __syncthreads();
        if (tid < 160) { const int c = tid >> 5, n = tid & 31; float s = 0.f;
#pragma unroll
          for (int ww = 0; ww < 8; ++ww) s += red[(ww * 5 + c) * 32 + n];
          MOD[c * 6 * D + it * 32 + n] = s + p.in[I_BMOD][it * 32 + n]; }
        __syncthreads();
      }
    }
    for (int i = bid * NTHREADS + tid; i < LLAT * 64; i += G * NTHREADS) { const int l = i >> 6, pr = i & 63;
      const float freq = powf(10000.f, -(float)(pr & 31) / 32.f); const float ang = (pr < 32 ? (float)(l >> 6) : (float)(l & 63)) * freq;
      ROPE[i] = (f32x2){cosf(ang), sinf(ang)}; }
    if (bid == 0 && tid < 8) DECLG[tid] = -softplusf(-p.in[I_DECAY][tid]);
  }
  GRID_BARRIER();

  {
    PHASE_TID();
    LAS float* wba = (LAS float*)lds;
    for (int i = tid; i < D * 16; i += NTHREADS) wba[(i & 15) * 1028 + (i >> 4)] = p.in[I_WIN][(size_t)(i >> 4) * INC + C_DB + (i & 15)];
    __syncthreads();
    const float* nw = p.in[I_NORMW];
    const float neg_ea = -expf(p.in[I_ALOG][(lane >> 2) & 7]), dtb = p.in[I_DTB][(lane >> 2) & 7];
    f32x4 xn[4];
    if (gw < MTOT) { const float* xr0 = xrow(p, gw);
#pragma unroll
      for (int j = 0; j < 4; ++j) xn[j] = *(const f32x4*)(xr0 + 4 * lane + 256 * j); }
    for (int m = gw; m < MTOT; m += ngw) {
      const float* md = MOD + (size_t)cond_of_row(m) * 6 * D;
      f32x4 x4[4], w4[4], sc4[4], sh4[4]; float s = 0.f;
#pragma unroll
      for (int j = 0; j < 4; ++j) x4[j] = xn[j];
      { const int mn = m + ngw < MTOT ? m + ngw : m; const float* xr1 = xrow(p, mn);
#pragma unroll
        for (int j = 0; j < 4; ++j) xn[j] = *(const f32x4*)(xr1 + 4 * lane + 256 * j); }
#pragma unroll
      for (int j = 0; j < 4; ++j) { const int c0 = 4 * lane + 256 * j; w4[j] = *(const f32x4*)(nw + c0); sc4[j] = *(const f32x4*)(md + D + c0); sh4[j] = *(const f32x4*)(md + c0); }
#pragma unroll
      for (int j = 0; j < 4; ++j) s += (x4[j].x * x4[j].x + x4[j].y * x4[j].y) + (x4[j].z * x4[j].z + x4[j].w * x4[j].w);
      const float r = rsqrtf(wave_sum(s) * (1.f / D) + EPS);
      float dots[16];
#pragma unroll
      for (int n = 0; n < 16; ++n) dots[n] = 0.f;
#pragma unroll
      for (int j = 0; j < 4; ++j) { const int c0 = 4 * lane + 256 * j;
        const f32x4 h = x4[j] * r * w4[j] * (sc4[j] + 1.f) + sh4[j];
        u32x2 o; o.x = pk2(h.x, h.y); o.y = pk2(h.z, h.w);
        *(u32x2*)(HB + (size_t)m * D + c0) = o;
#pragma unroll
        for (int n = 0; n < 16; ++n) { const f32x4 wv = *(const LAS f32x4*)(wba + n * 1028 + c0); dots[n] += (h.x * wv.x + h.y * wv.y) + (h.z * wv.z + h.w * wv.w); }
        __builtin_amdgcn_sched_barrier(0);
      }
#pragma unroll
      for (int i = 0; i < 8; ++i) { const bool up = lane & 32; const float snd = up ? dots[i] : dots[i + 8], kp = up ? dots[i + 8] : dots[i]; dots[i] = kp + __shfl_xor(snd, 32); }
#pragma unroll
      for (int i = 0; i < 4; ++i) { const bool up = lane & 16; const float snd = up ? dots[i] : dots[i + 4], kp = up ? dots[i + 4] : dots[i]; dots[i] = kp + __shfl_xor(snd, 16); }
#pragma unroll
      for (int i = 0; i < 2; ++i) { const bool up = lane & 8; const float snd = up ? dots[i] : dots[i + 2], kp = up ? dots[i + 2] : dots[i]; dots[i] = kp + __shfl_xor(snd, 8); }
      { const bool up = lane & 4; const float snd = up ? dots[0] : dots[1], kp = up ? dots[1] : dots[0]; dots[0] = kp + __shfl_xor(snd, 4); }
      dots[0] += __shfl_xor(dots[0], 2); dots[0] += __shfl_xor(dots[0], 1);
      if ((lane & 3) == 0) { const int n = lane >> 2; const float d = dots[0];
        BA[(size_t)m * 16 + n] = n < 8 ? sigmf(d) : neg_ea * softplusf(d + dtb); }
    }
  }
  GRID_BARRIER();

  {
    pg8::Gemm g{HB, WQKV, MTOT, 4096, D}; pg8::StaticOrder S; S.init(MTOT, 4096, G, bid);
    pg8::EpiQKV E{QKV, LDQ, HALO};
    pg8::gemm_phase<pg8::EpiQKV, pg8::StaticOrder, true, true>(lds, g, S, E, wave);
  }
  GRID_BARRIER();

  {
    PHASE_TID();
    constexpr int PI_RQ = 0, PI_RK = 16384, PI_DQ = 32768, PI_DK = 49152;
    constexpr int PM_QKR = 65536, PM_QKD = PM_QKR + 17408, PM_KKD = PM_QKD + 17408;
    constexpr int PV = PM_KKD + 17408;
    constexpr int PL_F = 0, PL_B = 17408, PT_F = 34816, PT_B = 52224;
    const int w = wave;
    const float* cw = p.in[I_CONVW];
    u32x4 qraw[2], kraw[2], rawa[2][2][3], rawb[4][3]; float ba4[4] = {0.f, 0.f, 0.f, 0.f};
#define P2_LOADS(ITEM, TID) do { const int gc_ = (ITEM) >> 2, h_ = (ITEM) & 3, row0_ = gc_ * 64; const bool lat_ = row0_ >= MCTX; \
      const int L_ = lat_ ? LLAT : LCTX, t0_ = lat_ ? ((row0_ - MCTX) & (LLAT - 1)) : (row0_ & (LCTX - 1)); \
      const size_t s1m_ = (size_t)row0_ + ((TID) >> 3); \
      _Pragma("unroll") for (int c = 0; c < 2; ++c) { const int ch = ((TID) & 7) * 2 + c; \
        qraw[c] = *(const u32x4*)(QKV + s1m_ * LDQ + Q_RQ + h_ * DK + ch * 8); kraw[c] = *(const u32x4*)(QKV + s1m_ * LDQ + Q_RK + h_ * DK + ch * 8); } \
      _Pragma("unroll") for (int ps = 0; ps < 2; ++ps) _Pragma("unroll") for (int wh = 0; wh < 2; ++wh) _Pragma("unroll") for (int wd = 0; wd < 3; ++wd) { \
          const int row = ((TID) >> 4) + 32 * ps, rr = row + wd - 1, t = t0_ + rr; const int dch = wh * 512 + h_ * DK + ((TID) & 15) * 8; \
          u32x4 x = (u32x4){0u, 0u, 0u, 0u}; \
          if (t >= 0 && t < L_) { \
            if (rr < 0) x = *(const u32x4*)(HALO + ((size_t)(gc_ - 1) * 2 + 1) * 2048 + dch); \
            else if (rr > 63) x = *(const u32x4*)(HALO + ((size_t)(gc_ + 1) * 2 + 0) * 2048 + dch); \
            else x = *(const u32x4*)(QKV + (size_t)(row0_ + rr) * LDQ + Q_DQ + dch); } \
          rawa[ps][wh][wd] = x; } \
      _Pragma("unroll") for (int n = 0; n < 4; ++n) _Pragma("unroll") for (int wd = 0; wd < 3; ++wd) { \
          const int idx = (TID) + 512 * n, row = idx >> 5, ch = idx & 31, rr = row + wd - 1, t = t0_ + rr; const int dch = 1024 + h_ * DV + ch * 8; \
          u32x4 x = (u32x4){0u, 0u, 0u, 0u}; \
          if (t >= 0 && t < L_) { \
            if (rr < 0) x = *(const u32x4*)(HALO + ((size_t)(gc_ - 1) * 2 + 1) * 2048 + dch); \
            else if (rr > 63) x = *(const u32x4*)(HALO + ((size_t)(gc_ + 1) * 2 + 0) * 2048 + dch); \
            else x = *(const u32x4*)(QKV + (size_t)(row0_ + rr) * LDQ + Q_DQ + dch); } \
          rawb[n][wd] = x; } \
      if ((TID) < 64) { const float* ba = BA + (size_t)(row0_ + (TID)) * 16; ba4[0] = ba[h_]; ba4[1] = ba[4 + h_]; ba4[2] = ba[8 + h_]; ba4[3] = ba[12 + h_]; } } while (0)
    if (bid < 768) { int lane_q = lane_id(); asm volatile("" : "+v"(lane_q)); const int tid_q = (wave << 6) | lane_q; P2_LOADS(bid, tid_q); }
    for (int item = bid; item < 768; item += G) {
      int lane_o = lane_id(); asm volatile("" : "+v"(lane_o));
      const int lane = lane_o, tid = (wave << 6) | lane, r32 = lane & 31, hl = lane >> 5;
      const int gc = item >> 2, h = item & 3, row0 = gc * 64; const bool lat = row0 >= MCTX;
      const int t0 = lat ? ((row0 - MCTX) & (LLAT - 1)) : (row0 & (LCTX - 1));
      const float lgf = DECLG[h], lgb = DECLG[4 + h];
      const int s1row = tid >> 3; const size_t s1m = (size_t)row0 + s1row;
      const int ach = tid & 15;
      asm volatile("s_waitcnt vmcnt(0)" ::: "memory");
      __syncthreads();
      const float ba_bf = ba4[0], ba_bb = ba4[1], ba_af = ba4[2], ba_ab = ba4[3];
      {
        const int row = s1row; const size_t m = s1m;
        const float kfs = __expf(lgf * (float)(63 - row)), kbs = __expf(lgb * (float)row);
#pragma unroll
        for (int c = 0; c < 2; ++c) { const int ch = (tid & 7) * 2 + c;
          bf16_t* qp = QKV + m * LDQ + Q_RQ + h * DK + ch * 8; bf16_t* kp = QKV + m * LDQ + Q_RK + h * DK + ch * 8;
          const u32x4 qw = qraw[c], kw = kraw[c];
          float q[8] = {lo_bf(qw.x), hi_bf(qw.x), lo_bf(qw.y), hi_bf(qw.y), lo_bf(qw.z), hi_bf(qw.z), lo_bf(qw.w), hi_bf(qw.w)};
          float k[8] = {lo_bf(kw.x), hi_bf(kw.x), lo_bf(kw.y), hi_bf(kw.y), lo_bf(kw.z), hi_bf(kw.z), lo_bf(kw.w), hi_bf(kw.w)};
#pragma unroll
          for (int e = 0; e < 8; ++e) q[e] *= QSCALE;
          if (lat) {
#pragma unroll
            for (int e = 0; e < 4; ++e) { const f32x2 cs = ROPE[(t0 + row) * 64 + ch * 4 + e];
              const float a = q[2 * e] * cs.x - q[2 * e + 1] * cs.y, b = q[2 * e] * cs.y + q[2 * e + 1] * cs.x; q[2 * e] = a; q[2 * e + 1] = b;
              const float c2 = k[2 * e] * cs.x - k[2 * e + 1] * cs.y, d2 = k[2 * e] * cs.y + k[2 * e + 1] * cs.x; k[2 * e] = c2; k[2 * e + 1] = d2; }
          }
          u32x4 o; o.x = pk2(q[0], q[1]); o.y = pk2(q[2], q[3]); o.z = pk2(q[4], q[5]); o.w = pk2(q[6], q[7]);
          *(u32x4*)qp = o; *(LAS u32x4*)(lds + PI_RQ + off_b(row, ch)) = o;
          o.x = pk2(k[0], k[1]); o.y = pk2(k[2], k[3]); o.z = pk2(k[4], k[5]); o.w = pk2(k[6], k[7]);
          *(LAS u32x4*)(lds + PI_RK + off_b(row, ch)) = o;
          o.x = pk2(k[0] * kfs, k[1] * kfs); o.y = pk2(k[2] * kfs, k[3] * kfs); o.z = pk2(k[4] * kfs, k[5] * kfs); o.w = pk2(k[6] * kfs, k[7] * kfs);
          *(u32x4*)kp = o;
          o.x = pk2(k[0] * kbs, k[1] * kbs); o.y = pk2(k[2] * kbs, k[3] * kbs); o.z = pk2(k[4] * kbs, k[5] * kbs); o.w = pk2(k[6] * kbs, k[7] * kbs);
          *(u32x4*)(KBUF + m * 512 + h * DK + ch * 8) = o;
        }
      }
      {
        const int ch = ach;
#pragma unroll
        for (int ps = 0; ps < 2; ++ps)
#pragma unroll
          for (int wh = 0; wh < 2; ++wh) { const int row = (tid >> 4) + 32 * ps; const int dch = wh * 512 + h * DK + ch * 8;
            float a[8] = {0.f, 0.f, 0.f, 0.f, 0.f, 0.f, 0.f, 0.f};
#pragma unroll
            for (int wd = 0; wd < 3; ++wd) { const u32x4 x = rawa[ps][wh][wd]; const f32x4 w0 = *(const f32x4*)(cw + wd * 2048 + dch), w1 = *(const f32x4*)(cw + wd * 2048 + dch + 4);
              a[0] += lo_bf(x.x) * w0.x; a[1] += hi_bf(x.x) * w0.y; a[2] += lo_bf(x.y) * w0.z; a[3] += hi_bf(x.y) * w0.w;
              a[4] += lo_bf(x.z) * w1.x; a[5] += hi_bf(x.z) * w1.y; a[6] += lo_bf(x.w) * w1.z; a[7] += hi_bf(x.w) * w1.w; }
            float ss = 0.f;
#pragma unroll
            for (int e = 0; e < 8; ++e) { a[e] = siluf(a[e]); ss += a[e] * a[e]; }
            ss += __shfl_xor(ss, 1); ss += __shfl_xor(ss, 2); ss += __shfl_xor(ss, 4); ss += __shfl_xor(ss, 8);
            const float sc = rsqrtf(ss + EPS) * (wh == 0 ? QSCALE : 1.f);
            u32x4 o; o.x = pk2(a[0] * sc, a[1] * sc); o.y = pk2(a[2] * sc, a[3] * sc); o.z = pk2(a[4] * sc, a[5] * sc); o.w = pk2(a[6] * sc, a[7] * sc);
            *(u32x4*)(QKV + (size_t)(row0 + row) * LDQ + Q_DQ + dch) = o;
            *(LAS u32x4*)(lds + (wh ? PI_DK : PI_DQ) + off_b(row, ch)) = o; }
      }
      {
#pragma unroll
        for (int n = 0; n < 4; ++n) { const int idx = tid + 512 * n, row = idx >> 5, ch = idx & 31; const int dch = 1024 + h * DV + ch * 8;
          float a[8] = {0.f, 0.f, 0.f, 0.f, 0.f, 0.f, 0.f, 0.f};
#pragma unroll
          for (int wd = 0; wd < 3; ++wd) { const u32x4 x = rawb[n][wd]; const f32x4 w0 = *(const f32x4*)(cw + wd * 2048 + dch), w1 = *(const f32x4*)(cw + wd * 2048 + dch + 4);
            a[0] += lo_bf(x.x) * w0.x; a[1] += hi_bf(x.x) * w0.y; a[2] += lo_bf(x.y) * w0.z; a[3] += hi_bf(x.y) * w0.w;
            a[4] += lo_bf(x.z) * w1.x; a[5] += hi_bf(x.z) * w1.y; a[6] += lo_bf(x.w) * w1.z; a[7] += hi_bf(x.w) * w1.w; }
          u32x4 o; o.x = pk2(siluf(a[0]), siluf(a[1])); o.y = pk2(siluf(a[2]), siluf(a[3])); o.z = pk2(siluf(a[4]), siluf(a[5])); o.w = pk2(siluf(a[6]), siluf(a[7]));
          *(u32x4*)(QKV + (size_t)(row0 + row) * LDQ + Q_DQ + dch) = o; }
      }
      if (item + G < 768) P2_LOADS(item + G, tid);
      __syncthreads();
      {
        const int mi = (w >> 1) & 1, nj = w & 1;
        if (w < 4) {
          f32x16 a1 = zero16(), a2 = zero16();
#pragma unroll 2
          for (int ks = 0; ks < 8; ++ks) { a1 = MFMA32(lds_rd128(lds + PI_RQ, rowfrag_off(lane, mi, ks)), lds_rd128(lds + PI_RK, rowfrag_off(lane, nj, ks)), a1);
            a2 = MFMA32(lds_rd128(lds + PI_DQ, rowfrag_off(lane, mi, ks)), lds_rd128(lds + PI_DK, rowfrag_off(lane, nj, ks)), a2); }
          LAS float* m1 = (LAS float*)(lds + PM_QKR); LAS float* m2 = (LAS float*)(lds + PM_QKD);
#pragma unroll
          for (int reg = 0; reg < 16; ++reg) { const int o = (32 * mi + crow(reg, hl)) * 68 + 32 * nj + r32; m1[o] = a1[reg]; m2[o] = a2[reg]; }
        } else {
          f32x16 a1 = zero16();
#pragma unroll 2
          for (int ks = 0; ks < 8; ++ks) a1 = MFMA32(lds_rd128(lds + PI_DK, rowfrag_off(lane, mi, ks)), lds_rd128(lds + PI_DK, rowfrag_off(lane, nj, ks)), a1);
          LAS float* m1 = (LAS float*)(lds + PM_KKD);
#pragma unroll
          for (int reg = 0; reg < 16; ++reg) m1[(32 * mi + crow(reg, hl)) * 68 + 32 * nj + r32] = a1[reg];
        }
      }
      LAS float* vecs = (LAS float*)(lds + PV);
      if (tid < 64) {
        const float bf = ba_bf, bb = ba_bb, af = ba_af, ab = ba_ab;
        float xf = af, xb = ab;
#pragma unroll
        for (int o = 1; o < 64; o <<= 1) { const float yf = __shfl_up(xf, o), yb = __shfl_up(xb, o); if (lane >= o) { xf += yf; xb += yb; } }
        const float totf = __shfl(xf, 63), totb = __shfl(xb, 63);
        vecs[tid] = bf; vecs[64 + tid] = bb; vecs[128 + tid] = xf; vecs[192 + tid] = totb - xb + ab;
        if (tid == 0) { vecs[256] = totf; vecs[257] = totb; }
      }
      __syncthreads();
      unsigned char* blob_rt = MATS_RT + (size_t)((gc * 4 + h) * 2) * RT_BLOB; unsigned char* blob_dn = MATS_DN + (size_t)((gc * 4 + h) * 2) * DN_BLOB;
      const int lp = tid & 63, fi = tid >> 6, fmt = fi >> 2, fks = fi & 3, frow = 32 * fmt + (lp & 31), fhq = lp >> 5;
      {
        const LAS float* m1 = (const LAS float*)(lds + PM_QKR); const LAS float* m2 = (const LAS float*)(lds + PM_QKD);
        const float gfi = vecs[128 + frow], gbi = vecs[192 + frow];
        f32x8 pf, pb, df, db;
#pragma unroll
        for (int jj = 0; jj < 8; ++jj) { const int j = 16 * fks + 8 * (jj >> 2) + 4 * fhq + (jj & 3);
          const float x = m1[frow * 68 + j], y = m2[frow * 68 + j];
          pf[jj] = j <= frow ? x * __expf(lgf * (float)(frow - j)) : 0.f; pb[jj] = j >= frow ? x * __expf(lgb * (float)(j - frow)) : 0.f;
          df[jj] = j <= frow ? y * __expf(gfi - vecs[128 + j]) : 0.f; db[jj] = j >= frow ? y * __expf(gbi - vecs[192 + j]) : 0.f; }
        *(bf16x8*)(blob_rt + (fi * 64 + lp) * 16) = cvt8(pf); *(bf16x8*)(blob_rt + RT_BLOB + (fi * 64 + lp) * 16) = cvt8(pb);
        *(bf16x8*)(blob_dn + 8192 + (fi * 64 + lp) * 16) = cvt8(df); *(bf16x8*)(blob_dn + DN_BLOB + 8192 + (fi * 64 + lp) * 16) = cvt8(db);
        const LAS float* m3 = (const LAS float*)(lds + PM_KKD);
        float* lf = (float*)(LSCR + (size_t)((gc * 4 + h) * 2) * LSCR_STRIDE); float* lb = (float*)(LSCR + (size_t)((gc * 4 + h) * 2 + 1) * LSCR_STRIDE);
#pragma unroll
        for (int n = 0; n < 8; ++n) { const int e = tid + 512 * n, i = e >> 6, j = e & 63; const float kk = m3[i * 68 + j];
          lf[e] = j < i ? vecs[i] * kk * __expf(vecs[128 + i] - vecs[128 + j]) : 0.f;
          lb[e] = j > i ? vecs[64 + i] * kk * __expf(vecs[192 + i] - vecs[192 + j]) : 0.f; }
        if (tid < 64) { lf[4096 + tid] = vecs[tid]; lb[4096 + tid] = vecs[64 + tid]; }
        if (tid < 64) { const float gf = vecs[128 + tid], gb = vecs[192 + tid], glf = vecs[256], glb = vecs[257];
          float* vf = (float*)(blob_dn + 16384); float* vb = (float*)(blob_dn + DN_BLOB + 16384);
          vf[tid] = __expf(gf); vf[64 + tid] = __expf(glf - gf); vb[tid] = __expf(gb); vb[64 + tid] = __expf(glb - gb);
          if (tid == 0) { vf[128] = __expf(glf); vb[128] = __expf(glb); } }
      }
    }
  }
  asm volatile("s_waitcnt vmcnt(0)" ::: "memory");
  __syncthreads();

  {
    PHASE_TID();
    LAS unsigned short* tl = (LAS unsigned short*)(lds + wave * 16384);
    for (int sv = wave; bid + G * (sv >> 1) < 768; sv += NWAVES) {
      const int it = 2 * (bid + G * (sv >> 1)) + (sv & 1);
      int lane_o = lane_id(); asm volatile("" : "+v"(lane_o));
      const int ln = lane_o; const bool flip = it & 1; const int cl = flip ? 63 - ln : ln;
      const float* Lm = (const float*)(LSCR + (size_t)it * LSCR_STRIDE);
      float T[64], Lr[64];
#pragma unroll
      for (int i = 0; i < 64; ++i) Lr[i] = Lm[(flip ? 63 - i : i) * 64 + cl];
      const float bc = Lm[4096 + cl];
      __builtin_amdgcn_sched_barrier(0);
#pragma unroll
      for (int i = 0; i < 64; ++i) {
        const float lrow = Lr[i];
        float t0 = (ln == i) ? 1.f : 0.f, t1 = 0.f;
#pragma unroll
        for (int j = 0; j < i; ++j) { const float lj = __int_as_float(__builtin_amdgcn_readlane(__float_as_int(lrow), j)); if (j & 1) t1 -= lj * T[j]; else t0 -= lj * T[j]; }
        T[i] = t0 + t1;
        __builtin_amdgcn_sched_barrier(0);
      }
#pragma unroll
      for (int i = 0; i < 64; ++i) tl[(flip ? 63 - i : i) * 72 + cl] = (unsigned short)f2bf(T[i] * bc);
      asm volatile("s_waitcnt lgkmcnt(0)" ::: "memory");
      unsigned char* blob = MATS_DN + (size_t)it * DN_BLOB;
      const int frow = ln & 31, fhq = ln >> 5;
#pragma unroll
      for (int f = 0; f < 8; ++f) { const int mt = f >> 2, ks = f & 3;
        const LAS unsigned short* rp = tl + (32 * mt + frow) * 72 + 16 * ks + 4 * fhq;
        const u32x2 lo = *(const LAS u32x2*)rp, hi = *(const LAS u32x2*)(rp + 8);
        *(u32x4*)(blob + (f * 64 + ln) * 16) = (u32x4){lo.x, lo.y, hi.x, hi.y}; }
      asm volatile("s_waitcnt lgkmcnt(0)" ::: "memory");
    }
  }
  GRID_BARRIER();

  {
    PHASE_TID();
    const int w = wave, cb = (w & 3) * 32; const bool act = w < 4;
    LAS float* qdec = (LAS float*)(lds + SC_VEC);
    const int stride = bid < 128 ? 1000000 : (G - 128);
    for (int item = bid; item < 640; item += stride) {
      const int ci = item >> 1, half = item & 1;
      int lane_c = lane_id(); asm volatile("" : "+v"(lane_c));
      const int lane = lane_c, tid = (wave << 6) | lane, r32 = lane & 31, hl = lane >> 5;
      int type, sq, h, dir, chunk0, nsteps; bool lat;
      if (ci < 64) { lat = true; type = ci >> 5; sq = (ci >> 3) & 3; h = (ci >> 1) & 3; dir = ci & 1; chunk0 = 64 + 32 * sq; nsteps = 32; }
      else { const int c = ci - 64; lat = false; type = c >> 7; sq = (c >> 3) & 15; h = (c >> 1) & 3; dir = c & 1; chunk0 = 4 * sq; nsteps = 4; }
      f32x16 S[4];
      {
        const float* s0 = (type ? p.in[I_SDN] : p.in[I_SRET]) + ((((size_t)sq * 2 + dir) * NH + h) * DK) * DV + 128 * half + cb + r32;
        if (lat) {
#pragma unroll
          for (int mt = 0; mt < 4; ++mt)
#pragma unroll
            for (int reg = 0; reg < 16; ++reg) S[mt][reg] = s0[(size_t)(32 * mt + srow(reg, hl)) * DV];
        } else {
#pragma unroll
          for (int mt = 0; mt < 4; ++mt) S[mt] = zero16();
        }
      }
      const float lg = DECLG[dir * 4 + h];
      const float c64 = __expf(64.f * lg);
      __syncthreads();
      if (tid < 64) qdec[tid] = __expf(lg * (dir ? (float)(64 - tid) : (float)(tid + 1)));
      const StageOff soff = scan_stage_offsets(w, lane, (!type && dir) ? 1024u : (unsigned)(LDQ * 2));
      scan_stage(lds, 0, type, dir, h, chunk0 + (dir ? nsteps - 1 : 0), QKV, KBUF, MATS_RT, MATS_DN, half, w, soff);
      bf16_t* O = type ? (dir ? ODB : ODF) : (dir ? ORB : ORF);
      for (int s = 0; s < nsteps; ++s) {
        int ln = lane; asm volatile("" : "+v"(ln));
        const int r32s = ln & 31, hls = ln >> 5;
        const int buf = s & 1, gc = chunk0 + (dir ? nsteps - 1 - s : s);
        asm volatile("s_waitcnt vmcnt(0)" ::: "memory");
        __syncthreads();
        if (s + 1 < nsteps) scan_stage(lds, buf ^ 1, type, dir, h, chunk0 + (dir ? nsteps - 2 - s : s + 1), QKV, KBUF, MATS_RT, MATS_DN, half, w, soff);
        if (!act) continue;
        LAS unsigned char* B = lds + buf * SC_BUF;
        bf16_t* ob = O + (size_t)gc * 64 * D + h * DV + 128 * half + cb + r32s;
#define SB_ do { __builtin_amdgcn_sched_barrier(0); asm volatile("" : "+v"(ln)); } while (0)
#define STORE_O(acc) do { _Pragma("unroll") for (int mt_ = 0; mt_ < 2; ++mt_) _Pragma("unroll") for (int s2_ = 0; s2_ < 2; ++s2_) { const bf16x8 pk_ = pack8(acc[mt_], s2_); \
                          _Pragma("unroll") for (int j_ = 0; j_ < 8; ++j_) ob[(size_t)(32 * mt_ + crow(8 * s2_ + j_, ln >> 5)) * D] = (bf16_t)pk_[j_]; } } while (0)
#define LOAD_BV() do { _Pragma("unroll") for (int ks_ = 0; ks_ < 4; ++ks_) Bv[ks_] = lds_tr2(B + SC_V, vtr_off(ln, cb, ks_, 0), vtr_off(ln, cb, ks_, 1)); } while (0)
#define ROWS_AB(acc, IMG) do { bf16x8 f0_[2], f1_[2]; \
            f0_[0] = lds_rd128(B + (IMG), rowfrag_off(ln, 0, 0)); f0_[1] = lds_rd128(B + (IMG), rowfrag_off(ln, 1, 0)); \
            _Pragma("unroll") for (int ks_ = 0; ks_ < 8; ++ks_) { \
              if (ks_ + 1 < 8) { f1_[0] = lds_rd128(B + (IMG), rowfrag_off(ln, 0, ks_ + 1)); f1_[1] = lds_rd128(B + (IMG), rowfrag_off(ln, 1, ks_ + 1)); } \
              const bf16x8 sb_ = pack8(S[ks_ >> 1], ks_ & 1); \
              acc[0] = MFMA32(f0_[0], sb_, acc[0]); acc[1] = MFMA32(f0_[1], sb_, acc[1]); \
              f0_[0] = f1_[0]; f0_[1] = f1_[1]; } } while (0)
#define ROWS_T(acc, IMG) do { bf16x8 f0_[2], f1_[2];   \
            f0_[0] = lds_rd128(B + (IMG), rowfrag_off(ln, 0, 0)); f0_[1] = lds_rd128(B + (IMG), rowfrag_off(ln, 1, 0)); \
            _Pragma("unroll") for (int ks_ = 0; ks_ < 8; ++ks_) { \
              if (ks_ + 1 < 8) { f1_[0] = lds_rd128(B + (IMG), rowfrag_off(ln, 0, ks_ + 1)); f1_[1] = lds_rd128(B + (IMG), rowfrag_off(ln, 1, ks_ + 1)); } \
              const bf16x8 sb_ = pack8(S[ks_ >> 1], ks_ & 1); \
              acc[0] = MFMA32(sb_, f0_[0], acc[0]); acc[1] = MFMA32(sb_, f0_[1], acc[1]); \
              f0_[0] = f1_[0]; f0_[1] = f1_[1]; } } while (0)
#define STORE_OT(acc) do { _Pragma("unroll") for (int nt_ = 0; nt_ < 2; ++nt_) { bf16_t* orow_ = obt + (size_t)(32 * nt_) * D; \
            _Pragma("unroll") for (int g_ = 0; g_ < 4; ++g_) { u32x2 w_; w_.x = pk2(acc[nt_][4 * g_], acc[nt_][4 * g_ + 1]); w_.y = pk2(acc[nt_][4 * g_ + 2], acc[nt_][4 * g_ + 3]); \
              *(u32x2*)(orow_ + 8 * g_) = w_; } } } while (0)
#define S_UPDATE(X, SCL) do { bf16x8 g0_[4], g1_[4]; \
            _Pragma("unroll") for (int mt_ = 0; mt_ < 4; ++mt_) g0_[mt_] = lds_tr2(B + SC_K, ktr_off(ln, mt_, 0, 0), ktr_off(ln, mt_, 0, 1)); \
            _Pragma("unroll") for (int mt_ = 0; mt_ < 4; ++mt_) S[mt_] = S[mt_] * (SCL); \
            _Pragma("unroll") for (int ks_ = 0; ks_ < 4; ++ks_) { \
              if (ks_ + 1 < 4) { _Pragma("unroll") for (int mt_ = 0; mt_ < 4; ++mt_) g1_[mt_] = lds_tr2(B + SC_K, ktr_off(ln, mt_, ks_ + 1, 0), ktr_off(ln, mt_, ks_ + 1, 1)); } \
              _Pragma("unroll") for (int mt_ = 0; mt_ < 4; ++mt_) S[mt_] = MFMA32(g0_[mt_], X[ks_], S[mt_]); \
              _Pragma("unroll") for (int mt_ = 0; mt_ < 4; ++mt_) g0_[mt_] = g1_[mt_]; } } while (0)
        bf16x8 Bv[4];
        if (type) {
          const LAS float* eg = (const LAS float*)(B + SC_M + 16384); const LAS float* cgv = eg + 64; const float egl = eg[128];
          bf16x8 Br[4];
          { f32x16 ra[2]; ra[0] = zero16(); ra[1] = zero16();
            ROWS_AB(ra, SC_K);
#pragma unroll
            for (int mt = 0; mt < 2; ++mt) { rowscale(ra[mt], eg + 32 * mt, ln >> 5, -1.f); Br[2 * mt] = pack8(ra[mt], 0); Br[2 * mt + 1] = pack8(ra[mt], 1); } }
          SB_;
          LOAD_BV();
          bf16x8 tf[8];
#pragma unroll
          for (int i = 0; i < 8; ++i) tf[i] = lds_rd128(B + SC_M, i * 1024 + ln * 16);
          f32x16 vn[2]; vn[0] = zero16(); vn[1] = zero16();
#pragma unroll
          for (int ks = 0; ks < 4; ++ks)
#pragma unroll
            for (int mt = 0; mt < 2; ++mt) { vn[mt] = MFMA32(tf[mt * 4 + ks], Bv[ks], vn[mt]); vn[mt] = MFMA32(tf[mt * 4 + ks], Br[ks], vn[mt]); }
          SB_;
          bf16x8 Bn[4], Bc[4];
#pragma unroll
          for (int mt = 0; mt < 2; ++mt) { Bn[2 * mt] = pack8(vn[mt], 0); Bn[2 * mt + 1] = pack8(vn[mt], 1); rowscale(vn[mt], cgv + 32 * mt, ln >> 5, 1.f); Bc[2 * mt] = pack8(vn[mt], 0); Bc[2 * mt + 1] = pack8(vn[mt], 1); }
          SB_;
          f32x16 oa[2]; oa[0] = zero16(); oa[1] = zero16();
          ROWS_T(oa, SC_Q);
          SB_;
#pragma unroll
          for (int i = 0; i < 8; ++i) tf[i] = lds_rd128(B + SC_M, 8192 + i * 1024 + ln * 16);
#pragma unroll
          for (int nt = 0; nt < 2; ++nt) oa[nt] = oa[nt] * eg[32 * nt + (ln & 31)];
#pragma unroll
          for (int ks = 0; ks < 4; ++ks)
#pragma unroll
            for (int nt = 0; nt < 2; ++nt) oa[nt] = MFMA32(Bn[ks], tf[nt * 4 + ks], oa[nt]);
          SB_;
          { bf16_t* obt = O + ((size_t)gc * 64 + (ln & 31)) * D + h * DV + 128 * half + cb + 4 * (ln >> 5); STORE_OT(oa); }
          SB_;
          S_UPDATE(Bc, egl);
          SB_;
        } else {
          f32x16 oa[2]; oa[0] = zero16(); oa[1] = zero16();
          ROWS_T(oa, SC_Q);
          SB_;
          LOAD_BV();
          bf16x8 tf[8];
#pragma unroll
          for (int i = 0; i < 8; ++i) tf[i] = lds_rd128(B + SC_M, i * 1024 + ln * 16);
#pragma unroll
          for (int nt = 0; nt < 2; ++nt) oa[nt] = oa[nt] * qdec[32 * nt + (ln & 31)];
#pragma unroll
          for (int ks = 0; ks < 4; ++ks)
#pragma unroll
            for (int nt = 0; nt < 2; ++nt) oa[nt] = MFMA32(Bv[ks], tf[nt * 4 + ks], oa[nt]);
          SB_;
          { bf16_t* obt = O + ((size_t)gc * 64 + (ln & 31)) * D + h * DV + 128 * half + cb + 4 * (ln >> 5); STORE_OT(oa); }
          SB_;
          S_UPDATE(Bv, c64);
          SB_;
        }
#undef SB_
#undef STORE_O
#undef LOAD_BV
#undef ROWS_AB
#undef ROWS_T
#undef STORE_OT
#undef S_UPDATE
      }
      if (!lat && act) {
        int ln3 = lane_id(); asm volatile("" : "+v"(ln3)); const int hl3 = ln3 >> 5;
        float* so = (type ? NS_DN : NS_RET) + ((((size_t)sq * 2 + dir) * NH + h) * DK) * DV + 128 * half + cb + (ln3 & 31);
#pragma unroll
        for (int mt = 0; mt < 4; ++mt)
#pragma unroll
          for (int reg = 0; reg < 16; ++reg) so[(size_t)(32 * mt + srow(reg, hl3)) * DV] = S[mt][reg];
      }
    }
  }
  GRID_BARRIER();

  bf16_t* GATES = QKV;
  {
    pg8::Gemm g{HB, WGATE, MTOT, 4096, D}; pg8::StaticOrder S; S.init(MTOT, 4096, G, bid);
    pg8::EpiBf16Act<1> E{GATES, LDG};
    pg8::gemm_phase<pg8::EpiBf16Act<1>, pg8::StaticOrder, true, true>(lds, g, S, E, wave);
  }
  GRID_BARRIER();

  bf16_t* AR = (bf16_t*)(ws + WS_AR); bf16_t* AD = (bf16_t*)(ws + WS_AD);
  {
    PHASE_TID();
    for (int m = gw; m < MTOT; m += ngw) {
      u32x2 rf[4], rb[4], df[4], db[4], gr[4], gd[4]; f32x4 gw4[4];
#pragma unroll
      for (int h = 0; h < 4; ++h) { const size_t base = (size_t)m * D + h * DV + 4 * lane;
        rf[h] = *(const u32x2*)(ORF + base); rb[h] = *(const u32x2*)(ORB + base); df[h] = *(const u32x2*)(ODF + base); db[h] = *(const u32x2*)(ODB + base);
        gr[h] = *(const u32x2*)(GATES + (size_t)m * LDG + G_RG + h * DV + 4 * lane); gd[h] = *(const u32x2*)(GATES + (size_t)m * LDG + G_DZ + h * DV + 4 * lane);
        gw4[h] = *(const f32x4*)(p.in[I_GNW] + h * DV + 4 * lane); }
      const f32x4 dw4 = *(const f32x4*)(p.in[I_DNW] + 4 * lane);
      float v[4][4], u[4][4], mu[4], rs[4], rd[4];
#pragma unroll
      for (int h = 0; h < 4; ++h) { v[h][0] = lo_bf(rf[h].x) + lo_bf(rb[h].x); v[h][1] = hi_bf(rf[h].x) + hi_bf(rb[h].x); v[h][2] = lo_bf(rf[h].y) + lo_bf(rb[h].y); v[h][3] = hi_bf(rf[h].y) + hi_bf(rb[h].y);
        u[h][0] = lo_bf(df[h].x) + lo_bf(db[h].x); u[h][1] = hi_bf(df[h].x) + hi_bf(db[h].x); u[h][2] = lo_bf(df[h].y) + lo_bf(db[h].y); u[h][3] = hi_bf(df[h].y) + hi_bf(db[h].y);
        mu[h] = (v[h][0] + v[h][1]) + (v[h][2] + v[h][3]); rd[h] = (u[h][0] * u[h][0] + u[h][1] * u[h][1]) + (u[h][2] * u[h][2] + u[h][3] * u[h][3]); }
#pragma unroll
      for (int o = 1; o < 64; o <<= 1) {
#pragma unroll
        for (int h = 0; h < 4; ++h) { mu[h] += __shfl_xor(mu[h], o); rd[h] += __shfl_xor(rd[h], o); } }
#pragma unroll
      for (int h = 0; h < 4; ++h) { mu[h] *= (1.f / DV); float q = 0.f;
#pragma unroll
        for (int e = 0; e < 4; ++e) { v[h][e] -= mu[h]; q += v[h][e] * v[h][e]; }
        rs[h] = q; }
#pragma unroll
      for (int o = 1; o < 64; o <<= 1) {
#pragma unroll
        for (int h = 0; h < 4; ++h) rs[h] += __shfl_xor(rs[h], o); }
#pragma unroll
      for (int h = 0; h < 4; ++h) { const size_t base = (size_t)m * D + h * DV + 4 * lane;
        const float r1 = rsqrtf(rs[h] * (1.f / DV) + EPS), r2 = rsqrtf(rd[h] * (1.f / DV) + EPS);
        u32x2 o; o.x = pk2(lo_bf(gr[h].x) * (v[h][0] * r1 * gw4[h].x), hi_bf(gr[h].x) * (v[h][1] * r1 * gw4[h].y)); o.y = pk2(lo_bf(gr[h].y) * (v[h][2] * r1 * gw4[h].z), hi_bf(gr[h].y) * (v[h][3] * r1 * gw4[h].w));
        *(u32x2*)(AR + base) = o;
        o.x = pk2(u[h][0] * r2 * dw4.x * lo_bf(gd[h].x), u[h][1] * r2 * dw4.y * hi_bf(gd[h].x)); o.y = pk2(u[h][2] * r2 * dw4.z * lo_bf(gd[h].y), u[h][3] * r2 * dw4.w * hi_bf(gd[h].y));
        *(u32x2*)(AD + base) = o; }
    }
  }
  GRID_BARRIER();

  bf16_t* T1 = HB;
  {
    pg8::Gemm g{AR, WRO, MTOT, D, D}; pg8::StaticOrder S; S.init(MTOT, D, G, bid);
    pg8::EpiGateMul E{T1, D, GATES + G_GR, LDG, nullptr};
    pg8::gemm_phase<pg8::EpiGateMul, pg8::StaticOrder, true, true>(lds, g, S, E, wave);
  }
  bf16_t* MERGED = T1;
  {
    pg8::Gemm g{AD, WDO, MTOT, D, D}; pg8::StaticOrder S; S.init(MTOT, D, G, bid);
    pg8::EpiGateMul E{MERGED, D, GATES + G_GD, LDG, T1};
    pg8::gemm_phase<pg8::EpiGateMul, pg8::StaticOrder, true, true>(lds, g, S, E, wave);
  }
  GRID_BARRIER();
  bf16_t* M1 = (bf16_t*)(ws + WS_O);
  bf16_t* X1B = (bf16_t*)(ws + WS_O + 24 * MiB);
  {
    pg8::Gemm g{MERGED, WOUT, MTOT, D, D}; pg8::StaticOrder S; S.init(MTOT, D, G, bid);
    pg8::EpiBf16Act<0> E{M1, D};
    pg8::gemm_phase<pg8::EpiBf16Act<0>, pg8::StaticOrder, true, true>(lds, g, S, E, wave);
  }
  GRID_BARRIER();

  bf16_t* WF1 = (bf16_t*)(ws + WS_WF1); bf16_t* WF2 = (bf16_t*)(ws + WS_WF2);
  {
    PHASE_TID();
    LAS float* scr = (LAS float*)(lds + wave * 16384);
    transpose_matrix(p.in[I_WF1], 2 * DFF, D, 2 * DFF, WF1, [](int n) { const int pn = n >> 8, w = n & 255; return w < 128 ? 128 * pn + w : DFF + 128 * pn + (w - 128); }, scr, gw, ngw, lane);
    transpose_matrix(p.in[I_WF2], D, DFF, D, WF2, [](int n) { return n; }, scr, gw, ngw, lane);
    const float* nw1 = p.in[I_NORMW] + D; const float* nw2 = p.in[I_NORMW] + 2 * D;
    u32x2 mn[2][4]; f32x4 xn[2][4];
#define P7_LOAD(M0) do { _Pragma("unroll") for (int u = 0; u < 2; ++u) { const int m_ = ((M0) + u * ngw < MTOT) ? (M0) + u * ngw : gw; const float* xr_ = xrow(p, m_); const bf16_t* mr_ = M1 + (size_t)m_ * D; \
      _Pragma("unroll") for (int j = 0; j < 4; ++j) { const int c0 = 4 * lane + 256 * j; mn[u][j] = *(const u32x2*)(mr_ + c0); xn[u][j] = *(const f32x4*)(xr_ + c0); } } } while (0)
    P7_LOAD(gw);
    for (int m0 = gw; m0 < MTOT; m0 += 2 * ngw) {
      f32x4 v[2][4], xv[2][4], g1v[2][4]; float s[2] = {0.f, 0.f};
#pragma unroll
      for (int u = 0; u < 2; ++u)
#pragma unroll
        for (int j = 0; j < 4; ++j) { const u32x2 mw = mn[u][j]; v[u][j] = (f32x4){lo_bf(mw.x), hi_bf(mw.x), lo_bf(mw.y), hi_bf(mw.y)}; xv[u][j] = xn[u][j]; }
      P7_LOAD(m0 + 2 * ngw);
#pragma unroll
      for (int u = 0; u < 2; ++u) { const int m = (m0 + u * ngw < MTOT) ? m0 + u * ngw : m0; const float* md = MOD + (size_t)cond_of_row(m) * 6 * D;
#pragma unroll
        for (int j = 0; j < 4; ++j) { const int c0 = 4 * lane + 256 * j; g1v[u][j] = *(const f32x4*)(md + 2 * D + c0); } }
#pragma unroll
      for (int u = 0; u < 2; ++u)
#pragma unroll
        for (int j = 0; j < 4; ++j) s[u] += (v[u][j].x * v[u][j].x + v[u][j].y * v[u][j].y) + (v[u][j].z * v[u][j].z + v[u][j].w * v[u][j].w);
#pragma unroll
      for (int o = 1; o < 64; o <<= 1) { s[0] += __shfl_xor(s[0], o); s[1] += __shfl_xor(s[1], o); }
      float s2[2] = {0.f, 0.f};
#pragma unroll
      for (int u = 0; u < 2; ++u) { const int m = m0 + u * ngw; const float r = rsqrtf(s[u] * (1.f / D) + EPS);
#pragma unroll
        for (int j = 0; j < 4; ++j) { const int c0 = 4 * lane + 256 * j;
          v[u][j] = xv[u][j] + g1v[u][j] * (v[u][j] * r * *(const f32x4*)(nw1 + c0));
          if (m < MTOT) { u32x2 xo; xo.x = pk2(v[u][j].x, v[u][j].y); xo.y = pk2(v[u][j].z, v[u][j].w); *(u32x2*)(X1B + (size_t)m * D + c0) = xo; }
          s2[u] += (v[u][j].x * v[u][j].x + v[u][j].y * v[u][j].y) + (v[u][j].z * v[u][j].z + v[u][j].w * v[u][j].w); } }
#pragma unroll
      for (int o = 1; o < 64; o <<= 1) { s2[0] += __shfl_xor(s2[0], o); s2[1] += __shfl_xor(s2[1], o); }
#pragma unroll
      for (int u = 0; u < 2; ++u) { const int m = m0 + u * ngw; if (m >= MTOT) continue; const float* md = MOD + (size_t)cond_of_row(m) * 6 * D; const float r2 = rsqrtf(s2[u] * (1.f / D) + EPS);
#pragma unroll
        for (int j = 0; j < 4; ++j) { const int c0 = 4 * lane + 256 * j;
          const f32x4 h = v[u][j] * r2 * *(const f32x4*)(nw2 + c0) * (*(const f32x4*)(md + 4 * D + c0) + 1.f) + *(const f32x4*)(md + 3 * D + c0);
          u32x2 o; o.x = pk2(h.x, h.y); o.y = pk2(h.z, h.w); *(u32x2*)(HB + (size_t)m * D + c0) = o; } }
    }
  }
#undef P7_LOAD
  GRID_BARRIER();

  bf16_t* ACT = QKV;
  const bool TAIL_SPLIT = G >= 228;
  constexpr int MT_MAIN = 46, M_MAIN = MT_MAIN * 256;
  {
    const int M8 = TAIL_SPLIT ? M_MAIN : MTOT;
    pg8::Gemm g{HB, WF1, M8, 2 * DFF, D}; pg8::StaticOrder S; S.init(M8, 2 * DFF, G, bid);
    pg8::EpiSwiGLU E{ACT, DFF};
    pg8::gemm_phase<pg8::EpiSwiGLU, pg8::StaticOrder, true, true>(lds, g, S, E, wave);
  }
  GRID_BARRIER();
  bf16_t* F = (bf16_t*)(ws + WS_O); bf16_t* F1 = (bf16_t*)(ws + WS_F1);
  if (!TAIL_SPLIT || bid < MT_MAIN * 4) {
    const int M9 = TAIL_SPLIT ? M_MAIN : MTOT;
    pg8::Gemm g{ACT, WF2, M9, D, DFF}; pg8::StaticOrder S; S.init(M9, D, G, bid);
    pg8::EpiBf16Act<0> E{F, D};
    pg8::gemm_phase<pg8::EpiBf16Act<0>, pg8::StaticOrder, true, true>(lds, g, S, E, wave);
  } else if (bid < MT_MAIN * 4 + 44) {
    const int j = bid - MT_MAIN * 4;
    {
      pg8::Gemm g{HB, WF1, MTOT, 2 * DFF, D}; pg8::OneUnit S{MT_MAIN + j / 22, j % 22};
      pg8::EpiSwiGLU E{ACT, DFF};
      pg8::gemm_phase<pg8::EpiSwiGLU, pg8::OneUnit, true, true>(lds, g, S, E, wave);
    }
    asm volatile("s_waitcnt vmcnt(0)" ::: "memory");
    __syncthreads();
    if (wave == 0 && lane_id() == 0) {
      unsigned* cnt = (unsigned*)(p.ws + WS_BAR + 14336);
      __builtin_amdgcn_fence(__ATOMIC_RELEASE, "agent");
      asm volatile("s_waitcnt vmcnt(0)" ::: "memory");
      __hip_atomic_fetch_add(cnt, 1u, __ATOMIC_RELAXED, __HIP_MEMORY_SCOPE_AGENT);
      if (j < 24) {
        unsigned sp = 0;
        while (__hip_atomic_load(cnt, __ATOMIC_RELAXED, __HIP_MEMORY_SCOPE_AGENT) < 44u) { __builtin_amdgcn_s_sleep(2); if (++sp > (1u << 22)) break; }
        __builtin_amdgcn_fence(__ATOMIC_ACQUIRE, "agent");
        asm volatile("s_waitcnt vmcnt(0)" ::: "memory");
      }
    }
    __syncthreads();
    if (j < 24) {
      const int un = j / 3, kp = j % 3, k0 = kp == 0 ? 0 : (kp == 1 ? 1024 : 1920), kl = kp == 0 ? 1024 : 896;
      pg8::Gemm g{ACT + k0, WF2 + k0, MTOT, D, kl, DFF}; pg8::OneUnit S{MT_MAIN + (un >> 2), un & 3};
      pg8::EpiBf16Act<0> E{kp ? F1 + (size_t)(kp - 1) * 512 * D - (size_t)M_MAIN * D : F, D};
      pg8::gemm_phase<pg8::EpiBf16Act<0>, pg8::OneUnit, true, true>(lds, g, S, E, wave);
    }
  }
  GRID_BARRIER();
  {
    PHASE_TID();
    const float* nw3 = p.in[I_NORMW] + 3 * D;
    u32x2 fn[2][4], xn[2][4];
#define P10_LOAD(M0) do { _Pragma("unroll") for (int u = 0; u < 2; ++u) { const int m_ = ((M0) + u * ngw < MTOT) ? (M0) + u * ngw : gw; const bf16_t* fr_ = F + (size_t)m_ * D; const bf16_t* xr_ = X1B + (size_t)m_ * D; \
      _Pragma("unroll") for (int j = 0; j < 4; ++j) { const int c0 = 4 * lane + 256 * j; fn[u][j] = *(const u32x2*)(fr_ + c0); xn[u][j] = *(const u32x2*)(xr_ + c0); } } } while (0)
    P10_LOAD(gw);
    for (int m0 = gw; m0 < MTOT; m0 += 2 * ngw) {
      f32x4 v[2][4], xv[2][4], gv[2][4]; float s[2] = {0.f, 0.f};
#pragma unroll
      for (int u = 0; u < 2; ++u)
#pragma unroll
        for (int j = 0; j < 4; ++j) { const u32x2 fw = fn[u][j], xw = xn[u][j]; v[u][j] = (f32x4){lo_bf(fw.x), hi_bf(fw.x), lo_bf(fw.y), hi_bf(fw.y)}; xv[u][j] = (f32x4){lo_bf(xw.x), hi_bf(xw.x), lo_bf(xw.y), hi_bf(xw.y)}; }
      P10_LOAD(m0 + 2 * ngw);
#pragma unroll
      for (int u = 0; u < 2; ++u) { const int m = (m0 + u * ngw < MTOT) ? m0 + u * ngw : m0; const float* md = MOD + (size_t)cond_of_row(m) * 6 * D; const bf16_t* f1r = (TAIL_SPLIT && m >= M_MAIN) ? F1 + (size_t)(m - M_MAIN) * D : nullptr;
#pragma unroll
        for (int j = 0; j < 4; ++j) { const int c0 = 4 * lane + 256 * j; gv[u][j] = *(const f32x4*)(md + 5 * D + c0);
          if (f1r) { const u32x2 gw2 = *(const u32x2*)(f1r + c0), gw3 = *(const u32x2*)(f1r + 512 * D + c0); v[u][j] += (f32x4){lo_bf(gw2.x), hi_bf(gw2.x), lo_bf(gw2.y), hi_bf(gw2.y)} + (f32x4){lo_bf(gw3.x), hi_bf(gw3.x), lo_bf(gw3.y), hi_bf(gw3.y)}; } } }
#pragma unroll
      for (int u = 0; u < 2; ++u)
#pragma unroll
        for (int j = 0; j < 4; ++j) s[u] += (v[u][j].x * v[u][j].x + v[u][j].y * v[u][j].y) + (v[u][j].z * v[u][j].z + v[u][j].w * v[u][j].w);
#pragma unroll
      for (int o = 1; o < 64; o <<= 1) { s[0] += __shfl_xor(s[0], o); s[1] += __shfl_xor(s[1], o); }
#pragma unroll
      for (int u = 0; u < 2; ++u) { const int m = m0 + u * ngw; if (m >= MTOT) continue; const float r = rsqrtf(s[u] * (1.f / D) + EPS); float* orow = p.out + (size_t)m * D;
#pragma unroll
        for (int j = 0; j < 4; ++j) { const int c0 = 4 * lane + 256 * j; *(f32x4*)(orow + c0) = xv[u][j] + gv[u][j] * (v[u][j] * r * *(const f32x4*)(nw3 + c0)); } }
    }
#undef P10_LOAD
  }
}

extern "C" void kernel_launch(void* const* d_in, const int* in_sizes, int n_in, void* d_out, int out_size, void* d_ws, size_t ws_size, hipStream_t stream) {
  static int grid_blocks = 0;
  if (!grid_blocks) {
    int dev = 0, cus = 0, per_cu = 0;
    (void)hipGetDevice(&dev);
    (void)hipDeviceGetAttribute(&cus, hipDeviceAttributeMultiprocessorCount, dev);
    (void)hipFuncSetAttribute((const void*)fwd_megakernel, hipFuncAttributeMaxDynamicSharedMemorySize, LDS_BYTES);
    (void)hipOccupancyMaxActiveBlocksPerMultiprocessor(&per_cu, (const void*)fwd_megakernel, NTHREADS, LDS_BYTES);
    if (per_cu < 1) per_cu = 1;
    grid_blocks = cus * per_cu;
    if (n_in != 21 || ws_size < WS_END) fprintf(stderr, "kernel_launch: unexpected n_in %d / ws_size %zu\n", n_in, ws_size);
    fprintf(stderr, "kernel_launch: cus %d per_cu %d grid %d ws %zu out %d\n", cus, per_cu, grid_blocks, ws_size, out_size);
  }
  (void)hipMemsetAsync((unsigned char*)d_ws + WS_BAR, 0, 16384, stream);
  Params p{};
  for (int i = 0; i < 21; ++i) p.in[i] = (const float*)d_in[i];
  p.out = (float*)d_out; p.ws = (unsigned char*)d_ws;
  void* args[] = {&p};
  hipError_t e = hipLaunchCooperativeKernel((const void*)fwd_megakernel, dim3(grid_blocks), dim3(NTHREADS), args, LDS_BYTES, stream);
  if (e != hipSuccess) fprintf(stderr, "cooperative launch failed: %s (grid %d)\n", hipGetErrorString(e), grid_blocks);
}
```

```cpp
#include <hip/hip_runtime.h>
#include <hip/hip_cooperative_groups.h>
#include <cstdio>
#include <cstdint>
namespace cg = cooperative_groups;

#define LAS __attribute__((address_space(3)))
typedef unsigned short bf16_t;
typedef short bf16x8 __attribute__((ext_vector_type(8)));
typedef float f32x4 __attribute__((ext_vector_type(4)));
typedef float f32x2 __attribute__((ext_vector_type(2)));
typedef unsigned u32x4 __attribute__((ext_vector_type(4)));
typedef unsigned u32x2 __attribute__((ext_vector_type(2)));

constexpr int D = 1024, MCTX = 4096, MLAT = 8192, MTOT = 12288, LCTX = 256, LLAT = 2048, NCTX = 16, NLAT = 4;
constexpr int NH = 4, DK = 128, DV = 256, DFF = 2816, INC = 8208;
constexpr float EPS = 1e-6f;
constexpr float QSCALE = 0.08838834764831845f;
constexpr int NTHREADS = 512, NWAVES = 8;
constexpr int LDS_BYTES = 135168;
constexpr int Q_RQ = 0, Q_RK = 512, Q_RV = 1024, Q_DQ = 2048, Q_DK = 2560, Q_DV = 3072, LDQ = 4096;
constexpr int G_RG = 0, G_DZ = 1024, G_GR = 2048, G_GD = 3072, LDG = 4096;
constexpr int C_RQ = 0, C_RG = 2048, C_DQ = 3072, C_DZ = 5120, C_DB = 6144, C_GR = 6160;

constexpr size_t MiB = 1u << 20;
constexpr size_t WS_MOD = 0;
constexpr size_t WS_ROPE = 128 * 1024;
constexpr size_t WS_BAR = 1152 * 1024;
constexpr size_t WS_BA = 1280 * 1024;
constexpr size_t WS_WQKV = 2 * MiB;
constexpr size_t WS_WGATE = 10 * MiB;
constexpr size_t WS_WRO = 18 * MiB, WS_WDO = 20 * MiB, WS_WOUT = 22 * MiB;
constexpr size_t WS_H = 24 * MiB;
constexpr size_t WS_QKV = 48 * MiB;
constexpr size_t WS_MATS_DN = 144 * MiB;
constexpr size_t WS_MATS_RT = 170 * MiB;
constexpr size_t WS_KB = 182 * MiB;
constexpr size_t WS_HALO = 194 * MiB;
constexpr size_t WS_O = 196 * MiB;
constexpr size_t WS_F1 = 8 * MiB;
constexpr size_t WS_END = 255 * MiB;
constexpr size_t WS_AR = 144 * MiB, WS_AD = 168 * MiB, WS_MERGED = 144 * MiB;
constexpr size_t WS_WF1 = 244 * MiB, WS_WF2 = 2 * MiB;

struct Params {
  const float* in[21];
  float* out;
  unsigned char* ws;
};
enum { I_XP = 0, I_XS, I_C, I_SRET, I_SDN, I_CCTX, I_WMOD, I_BMOD, I_NORMW, I_WIN, I_CONVW, I_DECAY, I_GNW, I_ALOG, I_DTB, I_DNW, I_WRO, I_WDO, I_WOUT, I_WF1, I_WF2 };

__device__ __forceinline__ float bf2f(unsigned short b) { return __uint_as_float((unsigned)b << 16); }
__device__ __forceinline__ unsigned f2bf(float f) { unsigned u = __float_as_uint(f); return (u + 0x7fffu + ((u >> 16) & 1u)) >> 16; }
typedef __bf16 bfx2_t __attribute__((ext_vector_type(2)));
__device__ __forceinline__ unsigned pk2(float lo, float hi) { const f32x2 t = {lo, hi}; return __builtin_bit_cast(unsigned, __builtin_convertvector(t, bfx2_t)); }
__device__ __forceinline__ unsigned cvt_pk_bf16(float lo, float hi) { return pk2(lo, hi); }

__device__ __forceinline__ float lo_bf(unsigned w) { return __uint_as_float(w << 16); }
__device__ __forceinline__ float hi_bf(unsigned w) { return __uint_as_float(w & 0xffff0000u); }
__device__ __forceinline__ float siluf(float x) { return x * __builtin_amdgcn_rcpf(1.f + __expf(-x)); }
__device__ __forceinline__ float sigmf(float x) { return __builtin_amdgcn_rcpf(1.f + __expf(-x)); }
__device__ __forceinline__ float softplusf(float x) { return x > 20.f ? x : log1pf(expf(x)); }
__device__ __forceinline__ float wave_sum(float v) {
#pragma unroll
  for (int o = 1; o < 64; o <<= 1) v += __shfl_xor(v, o);
  return v;
}
__device__ __forceinline__ int lane_id() { return (int)__builtin_amdgcn_mbcnt_hi(~0u, __builtin_amdgcn_mbcnt_lo(~0u, 0u)); }
__device__ __forceinline__ int cond_of_row(int m) { return m < MCTX ? 0 : 1 + (m - MCTX) / LLAT; }
__device__ __forceinline__ const float* xrow(const Params& p, int m) { return m < MCTX ? p.in[I_XP] + (size_t)m * D : p.in[I_XS] + (size_t)(m - MCTX) * D; }


__device__ __forceinline__ int lane_id();
#define XB_TMO      128
#define XB_XCNT(j)  (256  + 64 * (j))
#define XB_XSUB(j)  (1280 + 64 * (j))
#define XB_XGEN(j)  (2304 + 64 * (j))
#define XB_TOP      3328
#define XB_TOPGEN   3392
#define XCD_BAR_WORDS 3456
#define XB_SPIN_CAP (1u << 18)
__device__ __forceinline__ unsigned xb_ld(unsigned* p)              { return __hip_atomic_load(p, __ATOMIC_RELAXED, __HIP_MEMORY_SCOPE_AGENT); }
__device__ __forceinline__ unsigned xb_add(unsigned* p, unsigned v) { return __hip_atomic_fetch_add(p, v, __ATOMIC_RELAXED, __HIP_MEMORY_SCOPE_AGENT); }
__device__ __forceinline__ unsigned xb_xcc_id() { return (unsigned)__builtin_amdgcn_s_getreg((3 << 11) | 20) & 0xFu; }
#define XB_SPIN(cond, bar) do { unsigned _sp = 0; while (cond) { __builtin_amdgcn_s_sleep(1); \
    if ((++_sp & 255u) == 0u) { if (xb_ld(&(bar)[XB_TMO])) break; if (_sp > XB_SPIN_CAP) { atomicAdd(&(bar)[XB_TMO], 1u); break; } } } } while (0)
struct XcdBarrier { unsigned* bar; unsigned x; volatile LAS unsigned* st; };
__device__ __forceinline__ XcdBarrier xcd_barrier_post(unsigned* bar, volatile LAS unsigned* st) {
  XcdBarrier b; b.bar = bar; b.x = xb_xcc_id(); b.st = st;
  if (threadIdx.x == 0) (void)xb_add(&bar[XB_XCNT(b.x)], 1u);
  return b;
}
__device__ __forceinline__ void xcd_barrier_complete(unsigned* bar, unsigned x, unsigned& nloc, unsigned& nx) {
  const unsigned G = gridDim.x * gridDim.y * gridDim.z;
  unsigned sum, cnt, mine, sp = 0u;
  for (;;) {
    sum = 0u; cnt = 0u; mine = 0u;
#pragma unroll
    for (unsigned j = 0; j < 16; ++j) { const unsigned c = xb_ld(&bar[XB_XCNT(j)]); sum += c; cnt += (c > 0u) ? 1u : 0u; mine = (j == x) ? c : mine; }
    if (sum == G) break;
    __builtin_amdgcn_s_sleep(1);
    if ((++sp & 255u) == 0u) { if (xb_ld(&bar[XB_TMO])) break; if (sp > XB_SPIN_CAP) { atomicAdd(&bar[XB_TMO], 1u); break; } }
  }
  nloc = mine > 0u ? mine : 1u; nx = cnt > 0u ? cnt : 1u;
}
__device__ __forceinline__ void xcd_barrier(const XcdBarrier& b, const int wave) {
  asm volatile("s_waitcnt vmcnt(0)" ::: "memory");
  __syncthreads();
  if (wave == 0 && lane_id() == 0) {
    unsigned* bar = b.bar;
    __builtin_amdgcn_s_waitcnt(0);
    unsigned nloc = b.st[0], nx = b.st[1];
    if (nloc == 0u) { xcd_barrier_complete(bar, b.x, nloc, nx); b.st[0] = nloc; b.st[1] = nx; }
    const unsigned old = xb_add(&bar[XB_XSUB(b.x)], 1u);
    const unsigned gen = old / nloc;
    if (old + 1u == (gen + 1u) * nloc) {
      __builtin_amdgcn_fence(__ATOMIC_RELEASE, "agent");
      asm volatile("s_waitcnt vmcnt(0)" ::: "memory");
      const unsigned og = xb_add(&bar[XB_TOP], 1u);
      const unsigned tg = og / nx;
      if (og + 1u == (tg + 1u) * nx) xb_add(&bar[XB_TOPGEN], 1u);
      else XB_SPIN(xb_ld(&bar[XB_TOPGEN]) == tg, bar);
      __builtin_amdgcn_fence(__ATOMIC_ACQUIRE, "agent");
      xb_add(&bar[XB_XGEN(b.x)], 1u);
      asm volatile("s_waitcnt vmcnt(0)" ::: "memory");
    } else {
      XB_SPIN(xb_ld(&bar[XB_XGEN(b.x)]) == gen, bar);
      __builtin_amdgcn_fence(__ATOMIC_ACQUIRE, "agent");
      asm volatile("s_waitcnt vmcnt(0)" ::: "memory");
    }
  }
  __syncthreads();
}

namespace pg8 {
constexpr int BM = 256, BK = 64, HALF = 128, HTB = HALF * BK * 2, STAGE_BYTES = 8 * HTB, NXCD = 8, WGM = 8;
__host__ __device__ __forceinline__ int lds_byte(int r, int c) { const int st = (r >> 4) * 2 + (c >> 5), rr = r & 15, cc = c & 31, ob = rr * 64 + cc * 2; return st * 1024 + (ob ^ (((ob >> 9) & 1) << 5)); }
__host__ __device__ __forceinline__ void stage_rc(int b, int& R, int& C) { const int st = b / 1024, sb = b % 1024, swz = sb ^ (((sb >> 9) & 1) << 5); R = (st >> 1) * 16 + swz / 64; C = (st & 1) * 32 + (swz % 64) / 2; }
__host__ __device__ __forceinline__ int perm32(int rho) { const int n = rho >> 4, i = rho & 15; return 8 * (i >> 2) + 4 * n + (i & 3); }
struct Unit { int pm, pn; };
struct Gemm { const bf16_t* A; const bf16_t* Bt; int M, N, K; int ld; };
struct OneUnit {
  int pm, pn;
  __device__ __forceinline__ bool next(int i, Unit& u) const { if (i != 0) return false; u.pm = pm; u.pn = pn; return true; }
  __device__ __forceinline__ void a_ready(const Unit&) const {}
  __device__ __forceinline__ void done(const Unit&) const {}
};
struct StaticOrder {
  int nM, nN, nwg, G, c;
  __host__ __device__ void init(int M, int N, int G_, int c_) { nM = M / BM; nN = N / BM; nwg = nM * nN; G = G_; c = c_; }
  __host__ __device__ bool next(int i, Unit& u) const {
    const long L = (long)i * G + c; if (L >= nwg) return false;
    int wgid = (int)L; { const int q = nwg / NXCD, r = nwg % NXCD, xcd = wgid % NXCD, off = wgid / NXCD; wgid = (xcd < r ? xcd * (q + 1) : r * (q + 1) + (xcd - r) * q) + off; }
    const int nig = WGM * nN, gid = wgid / nig, fm = gid * WGM, gsz = (nM - fm) < WGM ? (nM - fm) : WGM;
    u.pm = fm + ((wgid % nig) % gsz); u.pn = (wgid % nig) / gsz; return true;
  }
  __device__ __forceinline__ void a_ready(const Unit&) const {}
  __device__ __forceinline__ void done(const Unit&) const {}
};

template <int MODE  > struct EpiBf16Act {
  static constexpr bool PERM = true, AFTER_DRAIN = false;
  bf16_t* O; int ldc;
  __device__ __forceinline__ void operator()(const f32x4 (&acc)[2][2][4][2], const Unit& u, int wr, int wc, int fr, int fq) const {
    const int row0 = u.pm * BM + wr * 64 + fr, col0 = u.pn * BM + wc * 32 + 8 * fq;
    const bool sg = u.pn >= 8;
#pragma unroll
    for (int ai = 0; ai < 2; ++ai)
#pragma unroll
      for (int m = 0; m < 4; ++m) { bf16_t* rowp = O + (size_t)(row0 + ai * HALF + m * 16) * ldc + col0;
#pragma unroll
        for (int bj = 0; bj < 2; ++bj) { f32x4 v0 = acc[ai][bj][m][0], v1 = acc[ai][bj][m][1];
          if (MODE == 1) {
#pragma unroll
            for (int i = 0; i < 4; ++i) { const float s0 = __builtin_amdgcn_rcpf(1.f + __expf(-v0[i])), s1 = __builtin_amdgcn_rcpf(1.f + __expf(-v1[i]));
              v0[i] = sg ? s0 : v0[i] * s0; v1[i] = sg ? s1 : v1[i] * s1; } }
          u32x4 w; w.x = cvt_pk_bf16(v0[0], v0[1]); w.y = cvt_pk_bf16(v0[2], v0[3]); w.z = cvt_pk_bf16(v1[0], v1[1]); w.w = cvt_pk_bf16(v1[2], v1[3]);
          *(u32x4*)(rowp + bj * HALF) = w; } }
  }
};
struct EpiQKV {
  static constexpr bool PERM = true, AFTER_DRAIN = false;
  bf16_t* O; int ldc; bf16_t* HALO;
  __device__ __forceinline__ void operator()(const f32x4 (&acc)[2][2][4][2], const Unit& u, int wr, int wc, int fr, int fq) const {
    const int row0 = u.pm * BM + wr * 64 + fr, col0 = u.pn * BM + wc * 32 + 8 * fq;
#pragma unroll
    for (int ai = 0; ai < 2; ++ai)
#pragma unroll
      for (int m = 0; m < 4; ++m) { const int row = row0 + ai * HALF + m * 16; bf16_t* rowp = O + (size_t)row * ldc + col0;
#pragma unroll
        for (int bj = 0; bj < 2; ++bj) { const f32x4 v0 = acc[ai][bj][m][0], v1 = acc[ai][bj][m][1];
          u32x4 w; w.x = cvt_pk_bf16(v0[0], v0[1]); w.y = cvt_pk_bf16(v0[2], v0[3]); w.z = cvt_pk_bf16(v1[0], v1[1]); w.w = cvt_pk_bf16(v1[2], v1[3]);
          *(u32x4*)(rowp + bj * HALF) = w;
          if (u.pn >= 8 && ((m == 0 && fr == 0) || (m == 3 && fr == 15)))
            *(u32x4*)(HALO + ((size_t)(row >> 6) * 2 + (m == 3 ? 1 : 0)) * 2048 + (col0 - 2048) + bj * HALF) = w; } }
  }
};
struct EpiGateMul {
  static constexpr bool PERM = true, AFTER_DRAIN = false;
  bf16_t* O; int ldc; const bf16_t* G; int ldg; const bf16_t* Add;
  __device__ __forceinline__ void operator()(const f32x4 (&acc)[2][2][4][2], const Unit& u, int wr, int wc, int fr, int fq) const {
    const int row0 = u.pm * BM + wr * 64 + fr, col0 = u.pn * BM + wc * 32 + 8 * fq;
#pragma unroll
    for (int ai = 0; ai < 2; ++ai)
#pragma unroll
      for (int m = 0; m < 4; ++m) { const size_t r = (size_t)(row0 + ai * HALF + m * 16);
#pragma unroll
        for (int bj = 0; bj < 2; ++bj) { const f32x4 v0 = acc[ai][bj][m][0], v1 = acc[ai][bj][m][1];
          const u32x4 g = *(const u32x4*)(G + r * ldg + col0 + bj * HALF);
          float o[8] = {v0[0] * lo_bf(g.x), v0[1] * hi_bf(g.x), v0[2] * lo_bf(g.y), v0[3] * hi_bf(g.y), v1[0] * lo_bf(g.z), v1[1] * hi_bf(g.z), v1[2] * lo_bf(g.w), v1[3] * hi_bf(g.w)};
          if (Add) { const u32x4 a = *(const u32x4*)(Add + r * ldc + col0 + bj * HALF);
            o[0] += lo_bf(a.x); o[1] += hi_bf(a.x); o[2] += lo_bf(a.y); o[3] += hi_bf(a.y); o[4] += lo_bf(a.z); o[5] += hi_bf(a.z); o[6] += lo_bf(a.w); o[7] += hi_bf(a.w); }
          u32x4 w; w.x = cvt_pk_bf16(o[0], o[1]); w.y = cvt_pk_bf16(o[2], o[3]); w.z = cvt_pk_bf16(o[4], o[5]); w.w = cvt_pk_bf16(o[6], o[7]);
          *(u32x4*)(O + r * ldc + col0 + bj * HALF) = w; } }
  }
};
struct EpiF32 {
  static constexpr bool PERM = false, AFTER_DRAIN = false;
  float* O; int ldc;
  __device__ __forceinline__ void operator()(const f32x4 (&acc)[2][2][4][2], const Unit& u, int wr, int wc, int fr, int fq) const {
    const int row0 = u.pm * BM + wr * 64 + fr, col0 = u.pn * BM + wc * 32 + 4 * fq;
#pragma unroll
    for (int ai = 0; ai < 2; ++ai)
#pragma unroll
      for (int m = 0; m < 4; ++m) { float* rowp = O + (size_t)(row0 + ai * HALF + m * 16) * ldc + col0;
#pragma unroll
        for (int bj = 0; bj < 2; ++bj)
#pragma unroll
          for (int n = 0; n < 2; ++n) *(f32x4*)(rowp + bj * HALF + n * 16) = acc[ai][bj][m][n]; }
  }
};
struct EpiSwiGLU {
  static constexpr bool PERM = true, AFTER_DRAIN = false;
  bf16_t* O; int ldc;
  __device__ __forceinline__ void operator()(const f32x4 (&acc)[2][2][4][2], const Unit& u, int wr, int wc, int fr, int fq) const {
    const int row0 = u.pm * BM + wr * 64 + fr, col0 = u.pn * HALF + wc * 32 + 8 * fq;
#pragma unroll
    for (int ai = 0; ai < 2; ++ai)
#pragma unroll
      for (int m = 0; m < 4; ++m) { bf16_t* rowp = O + (size_t)(row0 + ai * HALF + m * 16) * ldc + col0;
        float o[8];
#pragma unroll
        for (int n = 0; n < 2; ++n)
#pragma unroll
          for (int i = 0; i < 4; ++i) { const float g = acc[ai][0][m][n][i], up = acc[ai][1][m][n][i]; o[4 * n + i] = g * __builtin_amdgcn_rcpf(1.f + __expf(-g)) * up; }
        u32x4 w; w.x = cvt_pk_bf16(o[0], o[1]); w.y = cvt_pk_bf16(o[2], o[3]); w.z = cvt_pk_bf16(o[4], o[5]); w.w = cvt_pk_bf16(o[6], o[7]);
        *(u32x4*)rowp = w; }
  }
};

template <class Epi, class Sched, bool ALIGN_EPI = false, bool SP2 = false>
__device__ __forceinline__ void gemm_phase(LAS unsigned char* lds, const Gemm g, const Sched& S, const Epi& E, const int wid) {
  int lane_o = lane_id(); asm volatile("" : "+v"(lane_o));
  const int lane = lane_o, tid = (wid << 6) | lane, wr = wid >> 2, wc = wid & 3, fr = lane & 15, fq = lane >> 4;
  const int K = g.ld ? g.ld : g.K, nt = g.K / BK;
  unsigned voffA[2], voffB[2];
#pragma unroll
  for (int i = 0; i < 2; ++i) { int R, C; stage_rc(tid * 16 + i * 8192, R, C); const int Rb = Epi::PERM ? ((R & ~31) + perm32(R & 31)) : R;
    voffA[i] = (unsigned)(R * K + C) * 2u; voffB[i] = (unsigned)(Rb * K + C) * 2u; }
  const size_t kstep = (size_t)(BK * 2);
  const size_t hstep = (size_t)HALF * K * 2;
  const size_t tstep = 2 * hstep;
  const unsigned ldsw = (unsigned)wid * 1024u;
  const int aoff = lds_byte(wr * 64 + fr, fq * 8), boff = lds_byte(wc * 32 + fr, fq * 8);
#define PG8_SA(b, h) (((b) * 2 + (h)) * HTB)
#define PG8_SB(b, h) ((4 + (b) * 2 + (h)) * HTB)
#define PG8_STAGE(bufoff, gbase, voff) do { _Pragma("unroll") for (int _i = 0; _i < 2; ++_i) \
    __builtin_amdgcn_global_load_lds((const unsigned*)((const char*)(gbase) + (voff)[_i]), (LAS unsigned*)(lds + (bufoff) + ldsw + _i * 8192), 16, 0, 0); } while (0)
#define PG8_LDA(dst, b, h) do { _Pragma("unroll") for (int m = 0; m < 4; ++m) _Pragma("unroll") for (int k = 0; k < 2; ++k) dst[m][k] = *(const LAS bf16x8*)(lds + PG8_SA(b, h) + aoff + m * 2048 + k * 1024); } while (0)
#define PG8_LDB(dst, b, h) do { _Pragma("unroll") for (int n = 0; n < 2; ++n) _Pragma("unroll") for (int k = 0; k < 2; ++k) dst[n][k] = *(const LAS bf16x8*)(lds + PG8_SB(b, h) + boff + n * 2048 + k * 1024); } while (0)
#define PG8_MMA(ai, bj, At, Bt) do { __builtin_amdgcn_s_setprio(1); _Pragma("unroll") for (int m = 0; m < 4; ++m) _Pragma("unroll") for (int n = 0; n < 2; ++n) _Pragma("unroll") for (int k = 0; k < 2; ++k) \
    acc[ai][bj][m][n] = __builtin_amdgcn_mfma_f32_16x16x32_bf16(Bt[n][k], At[m][k], acc[ai][bj][m][n], 0, 0, 0); __builtin_amdgcn_s_setprio(0); } while (0)
#define PG8_WAIT_V(n) asm volatile("s_waitcnt vmcnt(" #n ")" ::: "memory")
#define PG8_WAIT_L(n) asm volatile("s_waitcnt lgkmcnt(" #n ")" ::: "memory")
#define PG8_BAR __builtin_amdgcn_s_barrier()
#define PG8_SCHED __builtin_amdgcn_sched_barrier(0)
  Unit cur, nxt; int ui = 0;
  if (!S.next(0, cur)) return;
  f32x4 acc[2][2][4][2];
#pragma unroll
  for (int a = 0; a < 2; ++a)
#pragma unroll
    for (int b = 0; b < 2; ++b)
#pragma unroll
      for (int m = 0; m < 4; ++m)
#pragma unroll
        for (int n = 0; n < 2; ++n) acc[a][b][m][n] = (f32x4){0.f, 0.f, 0.f, 0.f};
  bf16x8 At[4][2], B0[2][2], B1[2][2];
  const char* cA = (const char*)g.A + (size_t)cur.pm * tstep; const char* cB = (const char*)g.Bt + (size_t)cur.pn * tstep;
  S.a_ready(cur);
  if constexpr (SP2) {
    PG8_STAGE(PG8_SB(0, 0), cB, voffB); PG8_STAGE(PG8_SB(0, 1), cB + hstep, voffB); PG8_STAGE(PG8_SA(0, 0), cA, voffA); PG8_STAGE(PG8_SA(0, 1), cA + hstep, voffA);
    if (wr == 1) PG8_BAR;
    PG8_WAIT_V(2); PG8_BAR;
    PG8_STAGE(PG8_SB(1, 0), cB + kstep, voffB); PG8_STAGE(PG8_SA(1, 0), cA + kstep, voffA); PG8_STAGE(PG8_SB(1, 1), cB + hstep + kstep, voffB);
    PG8_WAIT_V(6); PG8_BAR;
  } else {
    PG8_STAGE(PG8_SB(0, 0), cB, voffB); PG8_STAGE(PG8_SA(0, 0), cA, voffA); PG8_STAGE(PG8_SB(0, 1), cB + hstep, voffB); PG8_STAGE(PG8_SA(0, 1), cA + hstep, voffA);
    if (wr == 1) PG8_BAR;
    PG8_WAIT_V(4); PG8_BAR;
    PG8_STAGE(PG8_SB(1, 0), cB + kstep, voffB); PG8_STAGE(PG8_SA(1, 0), cA + kstep, voffA); PG8_STAGE(PG8_SB(1, 1), cB + hstep + kstep, voffB);
    PG8_WAIT_V(6); PG8_BAR;
  }
  for (;;) {
    const bool has_next = S.next(ui + 1, nxt);
    const char* nA = has_next ? (const char*)g.A + (size_t)nxt.pm * tstep : cA; const char* nB = has_next ? (const char*)g.Bt + (size_t)nxt.pn * tstep : cB;
    for (int t = 0; t < nt; t += 2) {
      const bool last = (t == nt - 2);
      const char* a1 = cA + (size_t)(t + 1) * kstep;
      const char* a2 = last ? nA : cA + (size_t)(t + 2) * kstep; const char* b2 = last ? nB : cB + (size_t)(t + 2) * kstep;
      const char* a3 = a2 + kstep; const char* b3 = b2 + kstep;
      if (last && has_next) S.a_ready(nxt);
      if constexpr (SP2) {
        PG8_LDB(B0, 0, 0); PG8_LDB(B1, 0, 1); PG8_SCHED; PG8_LDA(At, 0, 0); PG8_STAGE(PG8_SA(1, 1), a1 + hstep, voffA);
        PG8_WAIT_V(8); PG8_WAIT_L(0); PG8_BAR; PG8_MMA(0, 0, At, B0); PG8_MMA(0, 1, At, B1); PG8_BAR; PG8_SCHED;
        PG8_LDA(At, 0, 1); PG8_STAGE(PG8_SB(0, 0), b2, voffB); PG8_STAGE(PG8_SB(0, 1), b2 + hstep, voffB); PG8_STAGE(PG8_SA(0, 0), a2, voffA);
        PG8_WAIT_V(8); PG8_WAIT_L(0); PG8_BAR; PG8_MMA(1, 0, At, B0); PG8_MMA(1, 1, At, B1); PG8_BAR; PG8_SCHED;
        PG8_LDB(B0, 1, 0); PG8_LDB(B1, 1, 1); PG8_SCHED; PG8_LDA(At, 1, 0); PG8_STAGE(PG8_SA(0, 1), a2 + hstep, voffA);
        PG8_WAIT_V(8); PG8_WAIT_L(0); PG8_BAR; PG8_MMA(0, 0, At, B0); PG8_MMA(0, 1, At, B1); PG8_BAR; PG8_SCHED;
        PG8_LDA(At, 1, 1); PG8_STAGE(PG8_SB(1, 0), b3, voffB); PG8_STAGE(PG8_SB(1, 1), b3 + hstep, voffB); PG8_STAGE(PG8_SA(1, 0), a3, voffA);
        PG8_WAIT_V(8); PG8_WAIT_L(0); PG8_BAR; PG8_MMA(1, 0, At, B0); PG8_MMA(1, 1, At, B1); PG8_BAR; PG8_SCHED;
      } else {
        PG8_LDB(B0, 0, 0); PG8_SCHED; PG8_LDA(At, 0, 0); PG8_STAGE(PG8_SA(1, 1), a1 + hstep, voffA);
        PG8_WAIT_L(8); PG8_BAR; PG8_WAIT_L(0); PG8_MMA(0, 0, At, B0); PG8_BAR; PG8_SCHED;
        PG8_LDB(B1, 0, 1); PG8_STAGE(PG8_SB(0, 0), b2, voffB);
        PG8_BAR; PG8_WAIT_L(0); PG8_MMA(0, 1, At, B1); PG8_BAR;
        PG8_LDA(At, 0, 1); PG8_STAGE(PG8_SA(0, 0), a2, voffA);
        PG8_BAR; PG8_WAIT_L(0); PG8_MMA(1, 0, At, B0); PG8_BAR; PG8_SCHED;
        PG8_STAGE(PG8_SB(0, 1), b2 + hstep, voffB);
        PG8_WAIT_V(6); PG8_BAR; PG8_MMA(1, 1, At, B1); PG8_BAR;
        PG8_LDB(B0, 1, 0); PG8_SCHED; PG8_LDA(At, 1, 0); PG8_STAGE(PG8_SA(0, 1), a2 + hstep, voffA);
        PG8_WAIT_L(8); PG8_BAR; PG8_WAIT_L(0); PG8_MMA(0, 0, At, B0); PG8_BAR; PG8_SCHED;
        PG8_LDB(B1, 1, 1); PG8_STAGE(PG8_SB(1, 0), b3, voffB);
        PG8_BAR; PG8_WAIT_L(0); PG8_MMA(0, 1, At, B1); PG8_BAR;
        PG8_LDA(At, 1, 1); PG8_STAGE(PG8_SA(1, 0), a3, voffA);
        PG8_BAR; PG8_WAIT_L(0); PG8_MMA(1, 0, At, B0); PG8_BAR; PG8_SCHED;
        PG8_STAGE(PG8_SB(1, 1), b3 + hstep, voffB);
        PG8_WAIT_V(6); PG8_BAR; PG8_MMA(1, 1, At, B1); PG8_BAR;
      }
    }
    if constexpr (ALIGN_EPI) { if (wr == 0) PG8_BAR; }
    if constexpr (!Epi::AFTER_DRAIN) { E(acc, cur, wr, wc, fr, fq); S.done(cur); }
    if (!has_next) break;
#pragma unroll
    for (int a = 0; a < 2; ++a)
#pragma unroll
      for (int b = 0; b < 2; ++b)
#pragma unroll
        for (int m = 0; m < 4; ++m)
#pragma unroll
          for (int n = 0; n < 2; ++n) acc[a][b][m][n] = (f32x4){0.f, 0.f, 0.f, 0.f};
    cur = nxt; cA = nA; cB = nB; ++ui;
    if constexpr (ALIGN_EPI) { if (wr == 1) PG8_BAR; }
  }
  PG8_WAIT_V(0);
  if constexpr (!ALIGN_EPI) { if (wr == 0) PG8_BAR; }
  PG8_BAR;
#undef PG8_SA
#undef PG8_SB
#undef PG8_STAGE
#undef PG8_LDA
#undef PG8_LDB
#undef PG8_MMA
#undef PG8_WAIT_V
#undef PG8_WAIT_L
#undef PG8_BAR
#undef PG8_SCHED
}
}

typedef float f32x16 __attribute__((ext_vector_type(16)));
typedef float f32x8 __attribute__((ext_vector_type(8)));
typedef short s16x4 __attribute__((ext_vector_type(4)));
typedef __bf16 bfx8 __attribute__((ext_vector_type(8)));
#define MFMA32(a, b, c) __builtin_amdgcn_mfma_f32_32x32x16_bf16((a), (b), (c), 0, 0, 0)
__device__ __forceinline__ bf16x8 cvt8(f32x8 t) { return __builtin_bit_cast(bf16x8, __builtin_convertvector(t, bfx8)); }
__device__ __forceinline__ bf16x8 pack8(const f32x16& x, int s) {
  const f32x8 t = {x[8 * s], x[8 * s + 1], x[8 * s + 2], x[8 * s + 3], x[8 * s + 4], x[8 * s + 5], x[8 * s + 6], x[8 * s + 7]};
  return cvt8(t);
}
__device__ __forceinline__ f32x16 zero16() { f32x16 z; for (int i = 0; i < 16; ++i) z[i] = 0.f; return z; }
__device__ __forceinline__ unsigned off_b(unsigned row, unsigned ch) { return 256u * row + 16u * (ch ^ (((row & 3u) << 2) | ((row >> 2) & 3u))); }
__device__ __forceinline__ int swap12(int p) { return ((p & 1) << 1) | (p >> 1); }
__device__ __forceinline__ bf16x8 lds_rd128(LAS unsigned char* lds, unsigned off) { return *(const LAS bf16x8*)(lds + off); }
__device__ __forceinline__ bf16x8 lds_tr2(LAS unsigned char* lds, unsigned off_lo, unsigned off_hi) {
  const s16x4 lo = __builtin_amdgcn_ds_read_tr16_b64_v4i16((LAS s16x4*)(lds + off_lo));
  const s16x4 hi = __builtin_amdgcn_ds_read_tr16_b64_v4i16((LAS s16x4*)(lds + off_hi));
  return __builtin_shufflevector(lo, hi, 0, 1, 2, 3, 4, 5, 6, 7);
}
__device__ __forceinline__ void glds16(const void* g, LAS unsigned char* l) {
  unsigned keep; const unsigned dst = __builtin_amdgcn_readfirstlane((unsigned)(size_t)l);
  asm volatile("s_mov_b32 %0, m0\n\ts_mov_b32 m0, %2\n\ts_nop 0\n\tglobal_load_lds_dwordx4 %1, off\n\ts_mov_b32 m0, %0" : "=&s"(keep) : "v"(g), "s"(dst) : "memory");
}
__device__ __forceinline__ unsigned rowfrag_off(int lane, int mt, int ks) { return off_b(32 * mt + (lane & 31), 2 * ks + (lane >> 5)); }
__device__ __forceinline__ unsigned vtr_off(int lane, int cb, int ks, int sec) {
  const int g = lane >> 4, i = lane & 15, hh = g >> 1, half16 = g & 1, qq = i >> 2, p = i & 3;
  const int row = 16 * ks + 4 * hh + 8 * sec + qq, col = cb + 16 * half16 + 4 * p;
  return off_b(row, col >> 3) + (col & 7) * 2;
}
__device__ __forceinline__ unsigned ktr_off(int lane, int mt, int ks, int sec) {
  const int g = lane >> 4, i = lane & 15, hh = g >> 1, half16 = g & 1, qq = i >> 2, p = i & 3;
  const int row = 16 * ks + 4 * hh + 8 * sec + qq, col = 32 * mt + 16 * half16 + 4 * swap12(p);
  return off_b(row, col >> 3) + (col & 7) * 2;
}
__device__ __forceinline__ int crow(int reg, int h) { return (reg & 3) + 8 * (reg >> 2) + 4 * h; }
__device__ __forceinline__ int srow(int reg, int h) { return 16 * (reg >> 3) + 8 * h + 4 * ((reg >> 2) & 1) + (reg & 3); }
__device__ __forceinline__ void rowscale(f32x16& a, const LAS float* vec, int h, float sgn) {
#pragma unroll
  for (int g4 = 0; g4 < 4; ++g4) { const f32x4 s = *(const LAS f32x4*)(vec + 8 * g4 + 4 * h);
    a[4 * g4] *= s.x * sgn; a[4 * g4 + 1] *= s.y * sgn; a[4 * g4 + 2] *= s.z * sgn; a[4 * g4 + 3] *= s.w * sgn; }
}
__device__ __forceinline__ void stage_img_piece(const unsigned char* src, size_t pitch, LAS unsigned char* img, int pc, int lane) {
  const unsigned row = 4 * pc + (lane >> 4), chp = lane & 15, ch = chp ^ (((row & 3u) << 2) | ((row >> 2) & 3u));
  glds16(src + (size_t)row * pitch + ch * 16, img + 1024 * pc);
}
constexpr int SC_BUF = 66560, SC_Q = 0, SC_K = 16384, SC_M = 32768, SC_V = 50176, SC_VEC = 2 * SC_BUF;
constexpr int DN_BLOB = 17408, RT_BLOB = 8192;
__device__ __forceinline__ void glds16_s(const unsigned char* base_uniform, unsigned voff, LAS unsigned char* l) {
  unsigned keep; const unsigned dst = __builtin_amdgcn_readfirstlane((unsigned)(size_t)l);
  const unsigned long long b = (unsigned long long)(size_t)base_uniform;
  const unsigned long long bs = ((unsigned long long)(unsigned)__builtin_amdgcn_readfirstlane((unsigned)(b >> 32)) << 32) | (unsigned)__builtin_amdgcn_readfirstlane((unsigned)b);
  asm volatile("s_mov_b32 %0, m0\n\ts_mov_b32 m0, %3\n\ts_nop 0\n\tglobal_load_lds_dwordx4 %1, %2\n\ts_mov_b32 m0, %0" : "=&s"(keep) : "v"(voff), "s"(bs), "s"(dst) : "memory");
}
struct StageOff { unsigned q[2], k[2], m; };
__device__ __forceinline__ StageOff scan_stage_offsets(int w, int lane, unsigned kpitch) {
  StageOff o;
#pragma unroll
  for (int i = 0; i < 2; ++i) { const unsigned pc = w + 8 * i, row = 4 * pc + (lane >> 4), chp = lane & 15, ch = chp ^ (((row & 3u) << 2) | ((row >> 2) & 3u));
    o.q[i] = row * (unsigned)(LDQ * 2) + ch * 16; o.k[i] = row * kpitch + ch * 16; }
  o.m = lane * 16;
  return o;
}
__device__ __forceinline__ void scan_stage(LAS unsigned char* lds, int buf, int type, int dir, int h, int gc, const bf16_t* QKV, const bf16_t* KBUF,
                                           const unsigned char* MATS_RT, const unsigned char* MATS_DN, int half, int w, const StageOff& so) {
  const size_t row0 = (size_t)gc * 64;
  const unsigned char* rowp = (const unsigned char*)(QKV + row0 * LDQ);
  const unsigned char* qsrc = rowp + (type ? Q_DQ + h * DK : Q_RQ + h * DK) * 2;
  const unsigned char* ksrc = rowp + (type ? Q_DK + h * DK : Q_RK + h * DK) * 2;
  if (!type && dir) ksrc = (const unsigned char*)(KBUF + row0 * 512 + h * DK);
  const unsigned char* vsrc = rowp + (type ? Q_DV + h * DV : Q_RV + h * DV) * 2 + half * 256;
  LAS unsigned char* B = lds + buf * SC_BUF;
#pragma unroll
  for (int i = 0; i < 2; ++i) { const int pc = w + 8 * i;
    glds16_s(qsrc, so.q[i], B + SC_Q + 1024 * pc); glds16_s(ksrc, so.k[i], B + SC_K + 1024 * pc); glds16_s(vsrc, so.q[i], B + SC_V + 1024 * pc); }
  const unsigned char* blob = type ? MATS_DN + (size_t)((gc * 4 + h) * 2 + dir) * DN_BLOB : MATS_RT + (size_t)((gc * 4 + h) * 2 + dir) * RT_BLOB;
  const int np = type ? 17 : 8;
  for (int pc = w; pc < np; pc += 8) glds16_s(blob + pc * 1024, so.m, B + SC_M + pc * 1024);
}

__device__ __forceinline__ void transpose_item(const float* W, int ldw, int K, int src_col0, bf16_t* WT, int dst_row0, int k0, LAS float* scr, int lane) {
#pragma unroll 8
  for (int i = 0; i < 32; ++i) { const int kk = 2 * i + (lane >> 5); scr[kk * 33 + (lane & 31)] = W[(size_t)(k0 + kk) * ldw + src_col0 + (lane & 31)]; }
  asm volatile("s_waitcnt lgkmcnt(0)" ::: "memory");
  const int c = lane & 7;
#pragma unroll
  for (int j = 0; j < 4; ++j) { const int n = (lane >> 3) + 8 * j; const LAS float* s = scr + (8 * c) * 33 + n;
    u32x4 o; o.x = pk2(s[0 * 33], s[1 * 33]); o.y = pk2(s[2 * 33], s[3 * 33]); o.z = pk2(s[4 * 33], s[5 * 33]); o.w = pk2(s[6 * 33], s[7 * 33]);
    *(u32x4*)(WT + (size_t)(dst_row0 + n) * K + k0 + 8 * c) = o; }
  asm volatile("s_waitcnt lgkmcnt(0)" ::: "memory");
}

template <class ColMap> __device__ __forceinline__ void transpose_matrix(const float* W, int ldw, int K, int N, bf16_t* WT, ColMap cm, LAS float* scr, int gw, int ngw, int lane) {
  const int nblk = N / 32, items = (K / 64) * nblk;
  for (int it = gw; it < items; it += ngw) { const int kb = it / nblk, nb = it % nblk; transpose_item(W, ldw, K, cm(32 * nb), WT, 32 * nb, 64 * kb, scr, lane); }
}


__device__ __forceinline__ void late_weight_conversions(const Params& p, bf16_t* WGATE, bf16_t* WRO, bf16_t* WDO, bf16_t* WOUT, bf16_t* WF1, bf16_t* WF2, LAS float* scr, int gw2, int ngw2, int lane) {
  transpose_matrix(p.in[I_WIN], INC, D, 4096, WGATE, [](int n) { return n < 1024 ? C_RG + n : (n < 2048 ? C_DZ + (n - 1024) : C_GR + (n - 2048)); }, scr, gw2, ngw2, lane);
  transpose_matrix(p.in[I_WRO], D, D, D, WRO, [](int n) { return n; }, scr, gw2, ngw2, lane);
  transpose_matrix(p.in[I_WDO], D, D, D, WDO, [](int n) { return n; }, scr, gw2, ngw2, lane);
  transpose_matrix(p.in[I_WOUT], D, D, D, WOUT, [](int n) { return n; }, scr, gw2, ngw2, lane);
  transpose_matrix(p.in[I_WF1], 2 * DFF, D, 2 * DFF, WF1, [](int n) { const int pn = n >> 8, w = n & 255; return w < 128 ? 128 * pn + w : DFF + 128 * pn + (w - 128); }, scr, gw2, ngw2, lane);
  transpose_matrix(p.in[I_WF2], D, DFF, D, WF2, [](int n) { return n; }, scr, gw2, ngw2, lane);
}

__global__ void __launch_bounds__(NTHREADS) fwd_megakernel(Params p) {
  extern __shared__ __attribute__((aligned(16))) unsigned char lds_raw[];
  LAS unsigned char* lds = (LAS unsigned char*)lds_raw;
  cg::grid_group grid = cg::this_grid();
  volatile LAS unsigned* bar_st = (volatile LAS unsigned*)(lds + LDS_BYTES - 64);
  if (threadIdx.x < 2) bar_st[threadIdx.x] = 0u;
  __syncthreads();
  const XcdBarrier xbar = xcd_barrier_post((unsigned*)(p.ws + WS_BAR), bar_st);
  if (p.ws == nullptr) grid.sync();
#define GRID_BARRIER() xcd_barrier(xbar, wave)
  const int wave = __builtin_amdgcn_readfirstlane(threadIdx.x >> 6);
#define PHASE_TID() int lane_p = lane_id(); asm volatile("" : "+v"(lane_p)); const int lane = lane_p, tid = (wave << 6) | lane; (void)tid;
  const int G = gridDim.x, bid = blockIdx.x;
  const int gw = bid * NWAVES + wave, ngw = G * NWAVES;
  unsigned char* ws = p.ws;
  float* MOD = (float*)(ws + WS_MOD);
  f32x2* ROPE = (f32x2*)(ws + WS_ROPE);
  float* BA = (float*)(ws + WS_BA);
  float* DECLG = (float*)(ws + WS_MOD + 122880);
  bf16_t* WQKV = (bf16_t*)(ws + WS_WQKV); bf16_t* WGATE = (bf16_t*)(ws + WS_WGATE);
  bf16_t* WRO = (bf16_t*)(ws + WS_WRO); bf16_t* WDO = (bf16_t*)(ws + WS_WDO); bf16_t* WOUT = (bf16_t*)(ws + WS_WOUT);
  bf16_t* HB = (bf16_t*)(ws + WS_H);
  bf16_t* QKV = (bf16_t*)(ws + WS_QKV);
  bf16_t* KBUF = (bf16_t*)(ws + WS_KB); bf16_t* HALO = (bf16_t*)(ws + WS_HALO);
  unsigned char* MATS_RT = ws + WS_MATS_RT; unsigned char* MATS_DN = ws + WS_MATS_DN;
  unsigned char* LSCR = ws + WS_O; constexpr int LSCR_STRIDE = 16896;
  bf16_t* ODF = (bf16_t*)(ws + WS_O); bf16_t* ODB = ODF + (size_t)MTOT * D;
  bf16_t* ORF = (bf16_t*)p.out; bf16_t* ORB = ORF + (size_t)MTOT * D;
  float* NS_RET = p.out + (size_t)MTOT * D; float* NS_DN = NS_RET + (size_t)NCTX * 2 * NH * DK * DV;

  {
    PHASE_TID();
    LAS float* scr = (LAS float*)(lds + wave * 16384);
    transpose_matrix(p.in[I_WIN], INC, D, 4096, WQKV, [](int n) { return n < 2048 ? n : n + 1024; }, scr, gw, ngw, lane);
    const bool LATE_CONV = G > 128;
    bf16_t* WF1 = (bf16_t*)(ws + WS_WF1); bf16_t* WF2 = (bf16_t*)(ws + WS_WF2);
    if (!LATE_CONV) late_weight_conversions(p, WGATE, WRO, WDO, WOUT, WF1, WF2, scr, gw, ngw, lane);
    {
      __syncthreads();
      LAS float* scond = (LAS float*)lds;
      LAS float* red = scond + 5 * D;
      for (int i = tid; i < 5 * D; i += NTHREADS) { const int c = i >> 10, k = i & 1023; scond[i] = siluf(c == 0 ? p.in[I_CCTX][k] : p.in[I_C][(c - 1) * D + k]); }
      __syncthreads();
      for (int it = bid; it < 6 * D / 32; it += G) {
        const int col = it * 32 + (lane & 31), rpar = lane >> 5;
        float acc[5] = {0.f, 0.f, 0.f, 0.f, 0.f};
        const float* wm = p.in[I_WMOD] + (size_t)(128 * wave + rpar) * 6 * D + col;
#pragma unroll 16
        for (int i = 0; i < 64; ++i) { const float wv = wm[(size_t)(2 * i) * 6 * D]; const int k = 128 * wave + 2 * i + rpar;
#pragma unroll
          for (int c = 0; c < 5; ++c) acc[c] += scond[c * D + k] * wv; }
#pragma unroll
        for (int c = 0; c < 5; ++c) { acc[c] += __shfl_xor(acc[c], 32); if (lane < 32) red[(wave * 5 + c) * 32 + lane] = acc[c]; }
        __syncthreads();
        if (tid < 160) { const int c = tid >> 5, n = tid & 31; float s = 0.f;
#pragma unroll
          for (int ww = 0; ww < 8; ++ww) s += red[(ww * 5 + c) * 32 + n];
          MOD[c * 6 * D + it * 32 + n] = s + p.in[I_BMOD][it * 32 + n]; }
        __syncthreads();
      }
    }
    for (int i = bid * NTHREADS + tid; i < LLAT * 64; i += G * NTHREADS) { const int l = i >> 6, pr = i & 63;
      const float freq = powf(10000.f, -(float)(pr & 31) / 32.f); const float ang = (pr < 32 ? (float)(l >> 6) : (float)(l & 63)) * freq;
      ROPE[i] = (f32x2){cosf(ang), sinf(ang)}; }
    if (bid == 0 && tid < 8) DECLG[tid] = -softplusf(-p.in[I_DECAY][tid]);
  }
  GRID_BARRIER();

  {
    PHASE_TID();
    LAS float* wba = (LAS float*)lds;
    for (int i = tid; i < D * 16; i += NTHREADS) wba[(i & 15) * 1028 + (i >> 4)] = p.in[I_WIN][(size_t)(i >> 4) * INC + C_DB + (i & 15)];
    __syncthreads();
    const float* nw = p.in[I_NORMW];
    const float neg_ea = -expf(p.in[I_ALOG][(lane >> 2) & 7]), dtb = p.in[I_DTB][(lane >> 2) & 7];
    f32x4 xn[4];
    if (gw < MTOT) { const float* xr0 = xrow(p, gw);
#pragma unroll
      for (int j = 0; j < 4; ++j) xn[j] = *(const f32x4*)(xr0 + 4 * lane + 256 * j); }
    for (int m = gw; m < MTOT; m += ngw) {
      const float* md = MOD + (size_t)cond_of_row(m) * 6 * D;
      f32x4 x4[4], w4[4], sc4[4], sh4[4]; float s = 0.f;
#pragma unroll
      for (int j = 0; j < 4; ++j) x4[j] = xn[j];
#pragma unroll
      for (int j = 0; j < 4; ++j) { const int c0 = 4 * lane + 256 * j; w4[j] = *(const f32x4*)(nw + c0); sc4[j] = *(const f32x4*)(md + D + c0); sh4[j] = *(const f32x4*)(md + c0); }
      __builtin_amdgcn_sched_barrier(0);
      { const int mn = m + ngw < MTOT ? m + ngw : m; const float* xr1 = xrow(p, mn);
#pragma unroll
        for (int j = 0; j < 4; ++j) xn[j] = *(const f32x4*)(xr1 + 4 * lane + 256 * j); }
      __builtin_amdgcn_sched_barrier(0);
#pragma unroll
      for (int j = 0; j < 4; ++j) s += (x4[j].x * x4[j].x + x4[j].y * x4[j].y) + (x4[j].z * x4[j].z + x4[j].w * x4[j].w);
      const float r = rsqrtf(wave_sum(s) * (1.f / D) + EPS);
      float dots[16];
#pragma unroll
      for (int n = 0; n < 16; ++n) dots[n] = 0.f;
#pragma unroll
      for (int j = 0; j < 4; ++j) { const int c0 = 4 * lane + 256 * j;
        const f32x4 h = x4[j] * r * w4[j] * (sc4[j] + 1.f) + sh4[j];
        u32x2 o; o.x = pk2(h.x, h.y); o.y = pk2(h.z, h.w);
        *(u32x2*)(HB + (size_t)m * D + c0) = o;
#pragma unroll
        for (int n = 0; n < 16; ++n) { const f32x4 wv = *(const LAS f32x4*)(wba + n * 1028 + c0); dots[n] += (h.x * wv.x + h.y * wv.y) + (h.z * wv.z + h.w * wv.w); }
        __builtin_amdgcn_sched_barrier(0);
      }
#pragma unroll
      for (int i = 0; i < 8; ++i) { const bool up = lane & 32; const float snd = up ? dots[i] : dots[i + 8], kp = up ? dots[i + 8] : dots[i]; dots[i] = kp + __shfl_xor(snd, 32); }
#pragma unroll
      for (int i = 0; i < 4; ++i) { const bool up = lane & 16; const float snd = up ? dots[i] : dots[i + 4], kp = up ? dots[i + 4] : dots[i]; dots[i] = kp + __shfl_xor(snd, 16); }
#pragma unroll
      for (int i = 0; i < 2; ++i) { const bool up = lane & 8; const float snd = up ? dots[i] : dots[i + 2], kp = up ? dots[i + 2] : dots[i]; dots[i] = kp + __shfl_xor(snd, 8); }
      { const bool up = lane & 4; const float snd = up ? dots[0] : dots[1], kp = up ? dots[1] : dots[0]; dots[0] = kp + __shfl_xor(snd, 4); }
      dots[0] += __shfl_xor(dots[0], 2); dots[0] += __shfl_xor(dots[0], 1);
      if ((lane & 3) == 0) { const int n = lane >> 2; const float d = dots[0];
        BA[(size_t)m * 16 + n] = n < 8 ? sigmf(d) : neg_ea * softplusf(d + dtb); }
    }
  }
  GRID_BARRIER();

  {
    pg8::Gemm g{HB, WQKV, MTOT, 4096, D}; pg8::StaticOrder S; S.init(MTOT, 4096, G, bid);
    pg8::EpiQKV E{QKV, LDQ, HALO};
    pg8::gemm_phase<pg8::EpiQKV, pg8::StaticOrder, true, true>(lds, g, S, E, wave);
  }
  GRID_BARRIER();

  {
    PHASE_TID();
    constexpr int PI_RQ = 0, PI_RK = 16384, PI_DQ = 32768, PI_DK = 49152;
    constexpr int PM_QKR = 65536, PM_QKD = PM_QKR + 17408, PM_KKD = PM_QKD + 17408;
    constexpr int PV = PM_KKD + 17408;
    constexpr int PL_F = 0, PL_B = 17408, PT_F = 34816, PT_B = 52224;
    const int w = wave;
    const float* cw = p.in[I_CONVW];
    u32x4 qraw[2], kraw[2], rawa[2][2][3], rawb[4][3]; float ba4[4] = {0.f, 0.f, 0.f, 0.f};
#define P2_LOADS(ITEM, TID) do { const int gc_ = (ITEM) >> 2, h_ = (ITEM) & 3, row0_ = gc_ * 64; const bool lat_ = row0_ >= MCTX; \
      const int L_ = lat_ ? LLAT : LCTX, t0_ = lat_ ? ((row0_ - MCTX) & (LLAT - 1)) : (row0_ & (LCTX - 1)); \
      const size_t s1m_ = (size_t)row0_ + ((TID) >> 3); \
      _Pragma("unroll") for (int c = 0; c < 2; ++c) { const int ch = ((TID) & 7) * 2 + c; \
        qraw[c] = *(const u32x4*)(QKV + s1m_ * LDQ + Q_RQ + h_ * DK + ch * 8); kraw[c] = *(const u32x4*)(QKV + s1m_ * LDQ + Q_RK + h_ * DK + ch * 8); } \
      _Pragma("unroll") for (int ps = 0; ps < 2; ++ps) _Pragma("unroll") for (int wh = 0; wh < 2; ++wh) _Pragma("unroll") for (int wd = 0; wd < 3; ++wd) { \
          const int row = ((TID) >> 4) + 32 * ps, rr = row + wd - 1, t = t0_ + rr; const int dch = wh * 512 + h_ * DK + ((TID) & 15) * 8; \
          u32x4 x = (u32x4){0u, 0u, 0u, 0u}; \
          if (t >= 0 && t < L_) { \
            if (rr < 0) x = *(const u32x4*)(HALO + ((size_t)(gc_ - 1) * 2 + 1) * 2048 + dch); \
            else if (rr > 63) x = *(const u32x4*)(HALO + ((size_t)(gc_ + 1) * 2 + 0) * 2048 + dch); \
            else x = *(const u32x4*)(QKV + (size_t)(row0_ + rr) * LDQ + Q_DQ + dch); } \
          rawa[ps][wh][wd] = x; } \
      _Pragma("unroll") for (int n = 0; n < 4; ++n) _Pragma("unroll") for (int wd = 0; wd < 3; ++wd) { \
          const int idx = (TID) + 512 * n, row = idx >> 5, ch = idx & 31, rr = row + wd - 1, t = t0_ + rr; const int dch = 1024 + h_ * DV + ch * 8; \
          u32x4 x = (u32x4){0u, 0u, 0u, 0u}; \
          if (t >= 0 && t < L_) { \
            if (rr < 0) x = *(const u32x4*)(HALO + ((size_t)(gc_ - 1) * 2 + 1) * 2048 + dch); \
            else if (rr > 63) x = *(const u32x4*)(HALO + ((size_t)(gc_ + 1) * 2 + 0) * 2048 + dch); \
            else x = *(const u32x4*)(QKV + (size_t)(row0_ + rr) * LDQ + Q_DQ + dch); } \
          rawb[n][wd] = x; } \
      if ((TID) < 64) { const float* ba = BA + (size_t)(row0_ + (TID)) * 16; ba4[0] = ba[h_]; ba4[1] = ba[4 + h_]; ba4[2] = ba[8 + h_]; ba4[3] = ba[12 + h_]; } } while (0)
    if (bid < 768) { int lane_q = lane_id(); asm volatile("" : "+v"(lane_q)); const int tid_q = (wave << 6) | lane_q; P2_LOADS(bid, tid_q); }
    for (int item = bid; item < 768; item += G) {
      int lane_o = lane_id(); asm volatile("" : "+v"(lane_o));
      const int lane = lane_o, tid = (wave << 6) | lane, r32 = lane & 31, hl = lane >> 5;
      const int gc = item >> 2, h = item & 3, row0 = gc * 64; const bool lat = row0 >= MCTX;
      const int t0 = lat ? ((row0 - MCTX) & (LLAT - 1)) : (row0 & (LCTX - 1));
      const float lgf = DECLG[h], lgb = DECLG[4 + h];
      const int s1row = tid >> 3; const size_t s1m = (size_t)row0 + s1row;
      const int ach = tid & 15;
      asm volatile("s_waitcnt vmcnt(0)" ::: "memory");
      __syncthreads();
      const float ba_bf = ba4[0], ba_bb = ba4[1], ba_af = ba4[2], ba_ab = ba4[3];
      {
        const int row = s1row; const size_t m = s1m;
        const float kfs = __expf(lgf * (float)(63 - row)), kbs = __expf(lgb * (float)row);
#pragma unroll
        for (int c = 0; c < 2; ++c) { const int ch = (tid & 7) * 2 + c;
          bf16_t* qp = QKV + m * LDQ + Q_RQ + h * DK + ch * 8; bf16_t* kp = QKV + m * LDQ + Q_RK + h * DK + ch * 8;
          const u32x4 qw = qraw[c], kw = kraw[c];
          float q[8] = {lo_bf(qw.x), hi_bf(qw.x), lo_bf(qw.y), hi_bf(qw.y), lo_bf(qw.z), hi_bf(qw.z), lo_bf(qw.w), hi_bf(qw.w)};
          float k[8] = {lo_bf(kw.x), hi_bf(kw.x), lo_bf(kw.y), hi_bf(kw.y), lo_bf(kw.z), hi_bf(kw.z), lo_bf(kw.w), hi_bf(kw.w)};
#pragma unroll
          for (int e = 0; e < 8; ++e) q[e] *= QSCALE;
          if (lat) {
#pragma unroll
            for (int e = 0; e < 4; ++e) { const f32x2 cs = ROPE[(t0 + row) * 64 + ch * 4 + e];
              const float a = q[2 * e] * cs.x - q[2 * e + 1] * cs.y, b = q[2 * e] * cs.y + q[2 * e + 1] * cs.x; q[2 * e] = a; q[2 * e + 1] = b;
              const float c2 = k[2 * e] * cs.x - k[2 * e + 1] * cs.y, d2 = k[2 * e] * cs.y + k[2 * e + 1] * cs.x; k[2 * e] = c2; k[2 * e + 1] = d2; }
          }
          u32x4 o; o.x = pk2(q[0], q[1]); o.y = pk2(q[2], q[3]); o.z = pk2(q[4], q[5]); o.w = pk2(q[6], q[7]);
          *(u32x4*)qp = o; *(LAS u32x4*)(lds + PI_RQ + off_b(row, ch)) = o;
          o.x = pk2(k[0], k[1]); o.y = pk2(k[2], k[3]); o.z = pk2(k[4], k[5]); o.w = pk2(k[6], k[7]);
          *(LAS u32x4*)(lds + PI_RK + off_b(row, ch)) = o;
          o.x = pk2(k[0] * kfs, k[1] * kfs); o.y = pk2(k[2] * kfs, k[3] * kfs); o.z = pk2(k[4] * kfs, k[5] * kfs); o.w = pk2(k[6] * kfs, k[7] * kfs);
          *(u32x4*)kp = o;
          o.x = pk2(k[0] * kbs, k[1] * kbs); o.y = pk2(k[2] * kbs, k[3] * kbs); o.z = pk2(k[4] * kbs, k[5] * kbs); o.w = pk2(k[6] * kbs, k[7] * kbs);
          *(u32x4*)(KBUF + m * 512 + h * DK + ch * 8) = o;
        }
      }
      {
        const int ch = ach;
#pragma unroll
        for (int ps = 0; ps < 2; ++ps)
#pragma unroll
          for (int wh = 0; wh < 2; ++wh) { const int row = (tid >> 4) + 32 * ps; const int dch = wh * 512 + h * DK + ch * 8;
            float a[8] = {0.f, 0.f, 0.f, 0.f, 0.f, 0.f, 0.f, 0.f};
#pragma unroll
            for (int wd = 0; wd < 3; ++wd) { const u32x4 x = rawa[ps][wh][wd]; const f32x4 w0 = *(const f32x4*)(cw + wd * 2048 + dch), w1 = *(const f32x4*)(cw + wd * 2048 + dch + 4);
              a[0] += lo_bf(x.x) * w0.x; a[1] += hi_bf(x.x) * w0.y; a[2] += lo_bf(x.y) * w0.z; a[3] += hi_bf(x.y) * w0.w;
              a[4] += lo_bf(x.z) * w1.x; a[5] += hi_bf(x.z) * w1.y; a[6] += lo_bf(x.w) * w1.z; a[7] += hi_bf(x.w) * w1.w; }
            float ss = 0.f;
#pragma unroll
            for (int e = 0; e < 8; ++e) { a[e] = siluf(a[e]); ss += a[e] * a[e]; }
            ss += __shfl_xor(ss, 1); ss += __shfl_xor(ss, 2); ss += __shfl_xor(ss, 4); ss += __shfl_xor(ss, 8);
            const float sc = rsqrtf(ss + EPS) * (wh == 0 ? QSCALE : 1.f);
            u32x4 o; o.x = pk2(a[0] * sc, a[1] * sc); o.y = pk2(a[2] * sc, a[3] * sc); o.z = pk2(a[4] * sc, a[5] * sc); o.w = pk2(a[6] * sc, a[7] * sc);
            *(u32x4*)(QKV + (size_t)(row0 + row) * LDQ + Q_DQ + dch) = o;
            *(LAS u32x4*)(lds + (wh ? PI_DK : PI_DQ) + off_b(row, ch)) = o; }
      }
      {
#pragma unroll
        for (int n = 0; n < 4; ++n) { const int idx = tid + 512 * n, row = idx >> 5, ch = idx & 31; const int dch = 1024 + h * DV + ch * 8;
          float a[8] = {0.f, 0.f, 0.f, 0.f, 0.f, 0.f, 0.f, 0.f};
#pragma unroll
          for (int wd = 0; wd < 3; ++wd) { const u32x4 x = rawb[n][wd]; const f32x4 w0 = *(const f32x4*)(cw + wd * 2048 + dch), w1 = *(const f32x4*)(cw + wd * 2048 + dch + 4);
            a[0] += lo_bf(x.x) * w0.x; a[1] += hi_bf(x.x) * w0.y; a[2] += lo_bf(x.y) * w0.z; a[3] += hi_bf(x.y) * w0.w;
            a[4] += lo_bf(x.z) * w1.x; a[5] += hi_bf(x.z) * w1.y; a[6] += lo_bf(x.w) * w1.z; a[7] += hi_bf(x.w) * w1.w; }
          u32x4 o; o.x = pk2(siluf(a[0]), siluf(a[1])); o.y = pk2(siluf(a[2]), siluf(a[3])); o.z = pk2(siluf(a[4]), siluf(a[5])); o.w = pk2(siluf(a[6]), siluf(a[7]));
          *(u32x4*)(QKV + (size_t)(row0 + row) * LDQ + Q_DQ + dch) = o; }
      }
      if (item + G < 768) P2_LOADS(item + G, tid);
      __syncthreads();
      {
        const int mi = (w >> 1) & 1, nj = w & 1;
        if (w < 4) {
          f32x16 a1 = zero16(), a2 = zero16();
#pragma unroll 2
          for (int ks = 0; ks < 8; ++ks) { a1 = MFMA32(lds_rd128(lds + PI_RQ, rowfrag_off(lane, mi, ks)), lds_rd128(lds + PI_RK, rowfrag_off(lane, nj, ks)), a1);
            a2 = MFMA32(lds_rd128(lds + PI_DQ, rowfrag_off(lane, mi, ks)), lds_rd128(lds + PI_DK, rowfrag_off(lane, nj, ks)), a2); }
          LAS float* m1 = (LAS float*)(lds + PM_QKR); LAS float* m2 = (LAS float*)(lds + PM_QKD);
#pragma unroll
          for (int reg = 0; reg < 16; ++reg) { const int o = (32 * mi + crow(reg, hl)) * 68 + 32 * nj + r32; m1[o] = a1[reg]; m2[o] = a2[reg]; }
        } else {
          f32x16 a1 = zero16();
#pragma unroll 2
          for (int ks = 0; ks < 8; ++ks) a1 = MFMA32(lds_rd128(lds + PI_DK, rowfrag_off(lane, mi, ks)), lds_rd128(lds + PI_DK, rowfrag_off(lane, nj, ks)), a1);
          LAS float* m1 = (LAS float*)(lds + PM_KKD);
#pragma unroll
          for (int reg = 0; reg < 16; ++reg) m1[(32 * mi + crow(reg, hl)) * 68 + 32 * nj + r32] = a1[reg];
        }
      }
      LAS float* vecs = (LAS float*)(lds + PV);
      if (tid < 64) {
        const float bf = ba_bf, bb = ba_bb, af = ba_af, ab = ba_ab;
        float xf = af, xb = ab;
#pragma unroll
        for (int o = 1; o < 64; o <<= 1) { const float yf = __shfl_up(xf, o), yb = __shfl_up(xb, o); if (lane >= o) { xf += yf; xb += yb; } }
        const float totf = __shfl(xf, 63), totb = __shfl(xb, 63);
        vecs[tid] = bf; vecs[64 + tid] = bb; vecs[128 + tid] = xf; vecs[192 + tid] = totb - xb + ab;
        if (tid == 0) { vecs[256] = totf; vecs[257] = totb; }
      }
      __syncthreads();
      unsigned char* blob_rt = MATS_RT + (size_t)((gc * 4 + h) * 2) * RT_BLOB; unsigned char* blob_dn = MATS_DN + (size_t)((gc * 4 + h) * 2) * DN_BLOB;
      const int lp = tid & 63, fi = tid >> 6, fmt = fi >> 2, fks = fi & 3, frow = 32 * fmt + (lp & 31), fhq = lp >> 5;
      {
        const LAS float* m1 = (const LAS float*)(lds + PM_QKR); const LAS float* m2 = (const LAS float*)(lds + PM_QKD);
        const float gfi = vecs[128 + frow], gbi = vecs[192 + frow];
        f32x8 pf, pb, df, db;
#pragma unroll
        for (int jj = 0; jj < 8; ++jj) { const int j = 16 * fks + 8 * (jj >> 2) + 4 * fhq + (jj & 3);
          const float x = m1[frow * 68 + j], y = m2[frow * 68 + j];
          pf[jj] = j <= frow ? x * __expf(lgf * (float)(frow - j)) : 0.f; pb[jj] = j >= frow ? x * __expf(lgb * (float)(j - frow)) : 0.f;
          df[jj] = j <= frow ? y * __expf(gfi - vecs[128 + j]) : 0.f; db[jj] = j >= frow ? y * __expf(gbi - vecs[192 + j]) : 0.f; }
        *(bf16x8*)(blob_rt + (fi * 64 + lp) * 16) = cvt8(pf); *(bf16x8*)(blob_rt + RT_BLOB + (fi * 64 + lp) * 16) = cvt8(pb);
        *(bf16x8*)(blob_dn + 8192 + (fi * 64 + lp) * 16) = cvt8(df); *(bf16x8*)(blob_dn + DN_BLOB + 8192 + (fi * 64 + lp) * 16) = cvt8(db);
        const LAS float* m3 = (const LAS float*)(lds + PM_KKD);
        float* lf = (float*)(LSCR + (size_t)((gc * 4 + h) * 2) * LSCR_STRIDE); float* lb = (float*)(LSCR + (size_t)((gc * 4 + h) * 2 + 1) * LSCR_STRIDE);
#pragma unroll
        for (int n = 0; n < 8; ++n) { const int e = tid + 512 * n, i = e >> 6, j = e & 63; const float kk = m3[i * 68 + j];
          lf[e] = j < i ? vecs[i] * kk * __expf(vecs[128 + i] - vecs[128 + j]) : 0.f;
          lb[e] = j > i ? vecs[64 + i] * kk * __expf(vecs[192 + i] - vecs[192 + j]) : 0.f; }
        if (tid < 64) { lf[4096 + tid] = vecs[tid]; lb[4096 + tid] = vecs[64 + tid]; }
        if (tid < 64) { const float gf = vecs[128 + tid], gb = vecs[192 + tid], glf = vecs[256], glb = vecs[257];
          float* vf = (float*)(blob_dn + 16384); float* vb = (float*)(blob_dn + DN_BLOB + 16384);
          vf[tid] = __expf(gf); vf[64 + tid] = __expf(glf - gf); vb[tid] = __expf(gb); vb[64 + tid] = __expf(glb - gb);
          if (tid == 0) { vf[128] = __expf(glf); vb[128] = __expf(glb); } }
      }
    }
  }
  asm volatile("s_waitcnt vmcnt(0)" ::: "memory");
  __syncthreads();

  {
    PHASE_TID();
    LAS unsigned short* tl = (LAS unsigned short*)(lds + wave * 16384);
    for (int sv = wave; bid + G * (sv >> 1) < 768; sv += NWAVES) {
      const int it = 2 * (bid + G * (sv >> 1)) + (sv & 1);
      int lane_o = lane_id(); asm volatile("" : "+v"(lane_o));
      const int ln = lane_o; const bool flip = it & 1; const int cl = flip ? 63 - ln : ln;
      const float* Lm = (const float*)(LSCR + (size_t)it * LSCR_STRIDE);
      float T[64], Lr[64];
#pragma unroll
      for (int i = 0; i < 64; ++i) Lr[i] = Lm[(flip ? 63 - i : i) * 64 + cl];
      const float bc = Lm[4096 + cl];
      __builtin_amdgcn_sched_barrier(0);
#pragma unroll
      for (int i = 0; i < 64; ++i) {
        const float lrow = Lr[i];
        float t0 = (ln == i) ? 1.f : 0.f, t1 = 0.f;
#pragma unroll
        for (int j = 0; j < i; ++j) { const float lj = __int_as_float(__builtin_amdgcn_readlane(__float_as_int(lrow), j)); if (j & 1) t1 -= lj * T[j]; else t0 -= lj * T[j]; }
        T[i] = t0 + t1;
        __builtin_amdgcn_sched_barrier(0);
      }
#pragma unroll
      for (int i = 0; i < 64; ++i) tl[(flip ? 63 - i : i) * 72 + cl] = (unsigned short)f2bf(T[i] * bc);
      asm volatile("s_waitcnt lgkmcnt(0)" ::: "memory");
      unsigned char* blob = MATS_DN + (size_t)it * DN_BLOB;
      const int frow = ln & 31, fhq = ln >> 5;
#pragma unroll
      for (int f = 0; f < 8; ++f) { const int mt = f >> 2, ks = f & 3;
        const LAS unsigned short* rp = tl + (32 * mt + frow) * 72 + 16 * ks + 4 * fhq;
        const u32x2 lo = *(const LAS u32x2*)rp, hi = *(const LAS u32x2*)(rp + 8);
        *(u32x4*)(blob + (f * 64 + ln) * 16) = (u32x4){lo.x, lo.y, hi.x, hi.y}; }
      asm volatile("s_waitcnt lgkmcnt(0)" ::: "memory");
    }
  }
  GRID_BARRIER();

  {
    PHASE_TID();
    const int w = wave, cb = (w & 3) * 32; const bool act = w < 4;
    LAS float* qdec = (LAS float*)(lds + SC_VEC);
    const int stride = bid < 128 ? 1000000 : (G - 128);
    for (int item = bid; item < 640; item += stride) {
      const int ci = item >> 1, half = item & 1;
      int lane_c = lane_id(); asm volatile("" : "+v"(lane_c));
      const int lane = lane_c, tid = (wave << 6) | lane, r32 = lane & 31, hl = lane >> 5;
      int type, sq, h, dir, chunk0, nsteps; bool lat;
      if (ci < 64) { lat = true; type = ci >> 5; sq = (ci >> 3) & 3; h = (ci >> 1) & 3; dir = ci & 1; chunk0 = 64 + 32 * sq; nsteps = 32; }
      else { const int c = ci - 64; lat = false; type = c >> 7; sq = (c >> 3) & 15; h = (c >> 1) & 3; dir = c & 1; chunk0 = 4 * sq; nsteps = 4; }
      f32x16 S[4];
      {
        const float* s0 = (type ? p.in[I_SDN] : p.in[I_SRET]) + ((((size_t)sq * 2 + dir) * NH + h) * DK) * DV + 128 * half + cb + r32;
        if (lat) {
#pragma unroll
          for (int mt = 0; mt < 4; ++mt)
#pragma unroll
            for (int reg = 0; reg < 16; ++reg) S[mt][reg] = s0[(size_t)(32 * mt + srow(reg, hl)) * DV];
        } else {
#pragma unroll
          for (int mt = 0; mt < 4; ++mt) S[mt] = zero16();
        }
      }
      const float lg = DECLG[dir * 4 + h];
      const float c64 = __expf(64.f * lg);
      __syncthreads();
      if (tid < 64) qdec[tid] = __expf(lg * (dir ? (float)(64 - tid) : (float)(tid + 1)));
      const StageOff soff = scan_stage_offsets(w, lane, (!type && dir) ? 1024u : (unsigned)(LDQ * 2));
      scan_stage(lds, 0, type, dir, h, chunk0 + (dir ? nsteps - 1 : 0), QKV, KBUF, MATS_RT, MATS_DN, half, w, soff);
      bf16_t* O = type ? (dir ? ODB : ODF) : (dir ? ORB : ORF);
      for (int s = 0; s < nsteps; ++s) {
        int ln = lane; asm volatile("" : "+v"(ln));
        const int r32s = ln & 31, hls = ln >> 5;
        const int buf = s & 1, gc = chunk0 + (dir ? nsteps - 1 - s : s);
        asm volatile("s_waitcnt vmcnt(0)" ::: "memory");
        __syncthreads();
        if (s + 1 < nsteps) scan_stage(lds, buf ^ 1, type, dir, h, chunk0 + (dir ? nsteps - 2 - s : s + 1), QKV, KBUF, MATS_RT, MATS_DN, half, w, soff);
        if (!act) continue;
        LAS unsigned char* B = lds + buf * SC_BUF;
        bf16_t* ob = O + (size_t)gc * 64 * D + h * DV + 128 * half + cb + r32s;
#define SB_ do { __builtin_amdgcn_sched_barrier(0); asm volatile("" : "+v"(ln)); } while (0)
#define STORE_O(acc) do { _Pragma("unroll") for (int mt_ = 0; mt_ < 2; ++mt_) _Pragma("unroll") for (int s2_ = 0; s2_ < 2; ++s2_) { const bf16x8 pk_ = pack8(acc[mt_], s2_); \
                          _Pragma("unroll") for (int j_ = 0; j_ < 8; ++j_) ob[(size_t)(32 * mt_ + crow(8 * s2_ + j_, ln >> 5)) * D] = (bf16_t)pk_[j_]; } } while (0)
#define LOAD_BV() do { _Pragma("unroll") for (int ks_ = 0; ks_ < 4; ++ks_) Bv[ks_] = lds_tr2(B + SC_V, vtr_off(ln, cb, ks_, 0), vtr_off(ln, cb, ks_, 1)); } while (0)
#define ROWS_AB(acc, IMG) do { bf16x8 f0_[2], f1_[2]; \
            f0_[0] = lds_rd128(B + (IMG), rowfrag_off(ln, 0, 0)); f0_[1] = lds_rd128(B + (IMG), rowfrag_off(ln, 1, 0)); \
            _Pragma("unroll") for (int ks_ = 0; ks_ < 8; ++ks_) { \
              if (ks_ + 1 < 8) { f1_[0] = lds_rd128(B + (IMG), rowfrag_off(ln, 0, ks_ + 1)); f1_[1] = lds_rd128(B + (IMG), rowfrag_off(ln, 1, ks_ + 1)); } \
              const bf16x8 sb_ = pack8(S[ks_ >> 1], ks_ & 1); \
              acc[0] = MFMA32(f0_[0], sb_, acc[0]); acc[1] = MFMA32(f0_[1], sb_, acc[1]); \
              f0_[0] = f1_[0]; f0_[1] = f1_[1]; } } while (0)
#define ROWS_T(acc, IMG) do { bf16x8 f0_[2], f1_[2];   \
            f0_[0] = lds_rd128(B + (IMG), rowfrag_off(ln, 0, 0)); f0_[1] = lds_rd128(B + (IMG), rowfrag_off(ln, 1, 0)); \
            _Pragma("unroll") for (int ks_ = 0; ks_ < 8; ++ks_) { \
              if (ks_ + 1 < 8) { f1_[0] = lds_rd128(B + (IMG), rowfrag_off(ln, 0, ks_ + 1)); f1_[1] = lds_rd128(B + (IMG), rowfrag_off(ln, 1, ks_ + 1)); } \
              const bf16x8 sb_ = pack8(S[ks_ >> 1], ks_ & 1); \
              acc[0] = MFMA32(sb_, f0_[0], acc[0]); acc[1] = MFMA32(sb_, f0_[1], acc[1]); \
              f0_[0] = f1_[0]; f0_[1] = f1_[1]; } } while (0)
#define STORE_OT(acc) do { _Pragma("unroll") for (int nt_ = 0; nt_ < 2; ++nt_) { bf16_t* orow_ = obt + (size_t)(32 * nt_) * D; \
            _Pragma("unroll") for (int g_ = 0; g_ < 4; ++g_) { u32x2 w_; w_.x = pk2(acc[nt_][4 * g_], acc[nt_][4 * g_ + 1]); w_.y = pk2(acc[nt_][4 * g_ + 2], acc[nt_][4 * g_ + 3]); \
              *(u32x2*)(orow_ + 8 * g_) = w_; } } } while (0)
#define S_UPDATE(X, SCL) do { bf16x8 g0_[4], g1_[4]; \
            _Pragma("unroll") for (int mt_ = 0; mt_ < 4; ++mt_) g0_[mt_] = lds_tr2(B + SC_K, ktr_off(ln, mt_, 0, 0), ktr_off(ln, mt_, 0, 1)); \
            _Pragma("unroll") for (int mt_ = 0; mt_ < 4; ++mt_) S[mt_] = S[mt_] * (SCL); \
            _Pragma("unroll") for (int ks_ = 0; ks_ < 4; ++ks_) { \
              if (ks_ + 1 < 4) { _Pragma("unroll") for (int mt_ = 0; mt_ < 4; ++mt_) g1_[mt_] = lds_tr2(B + SC_K, ktr_off(ln, mt_, ks_ + 1, 0), ktr_off(ln, mt_, ks_ + 1, 1)); } \
              _Pragma("unroll") for (int mt_ = 0; mt_ < 4; ++mt_) S[mt_] = MFMA32(g0_[mt_], X[ks_], S[mt_]); \
              _Pragma("unroll") for (int mt_ = 0; mt_ < 4; ++mt_) g0_[mt_] = g1_[mt_]; } } while (0)
        bf16x8 Bv[4];
        if (type) {
          const LAS float* eg = (const LAS float*)(B + SC_M + 16384); const LAS float* cgv = eg + 64; const float egl = eg[128];
          bf16x8 Br[4];
          { f32x16 ra[2]; ra[0] = zero16(); ra[1] = zero16();
            ROWS_AB(ra, SC_K);
#pragma unroll
            for (int mt = 0; mt < 2; ++mt) { rowscale(ra[mt], eg + 32 * mt, ln >> 5, -1.f); Br[2 * mt] = pack8(ra[mt], 0); Br[2 * mt + 1] = pack8(ra[mt], 1); } }
          SB_;
          LOAD_BV();
          bf16x8 tf[8];
#pragma unroll
          for (int i = 0; i < 8; ++i) tf[i] = lds_rd128(B + SC_M, i * 1024 + ln * 16);
          f32x16 vn[2]; vn[0] = zero16(); vn[1] = zero16();
#pragma unroll
          for (int ks = 0; ks < 4; ++ks)
#pragma unroll
            for (int mt = 0; mt < 2; ++mt) { vn[mt] = MFMA32(tf[mt * 4 + ks], Bv[ks], vn[mt]); vn[mt] = MFMA32(tf[mt * 4 + ks], Br[ks], vn[mt]); }
          SB_;
          bf16x8 Bn[4], Bc[4];
#pragma unroll
          for (int mt = 0; mt < 2; ++mt) { Bn[2 * mt] = pack8(vn[mt], 0); Bn[2 * mt + 1] = pack8(vn[mt], 1); rowscale(vn[mt], cgv + 32 * mt, ln >> 5, 1.f); Bc[2 * mt] = pack8(vn[mt], 0); Bc[2 * mt + 1] = pack8(vn[mt], 1); }
          SB_;
          f32x16 oa[2]; oa[0] = zero16(); oa[1] = zero16();
          ROWS_T(oa, SC_Q);
          SB_;
#pragma unroll
          for (int i = 0; i < 8; ++i) tf[i] = lds_rd128(B + SC_M, 8192 + i * 1024 + ln * 16);
#pragma unroll
          for (int nt = 0; nt < 2; ++nt) oa[nt] = oa[nt] * eg[32 * nt + (ln & 31)];
#pragma unroll
          for (int ks = 0; ks < 4; ++ks)
#pragma unroll
            for (int nt = 0; nt < 2; ++nt) oa[nt] = MFMA32(Bn[ks], tf[nt * 4 + ks], oa[nt]);
          SB_;
          { bf16_t* obt = O + ((size_t)gc * 64 + (ln & 31)) * D + h * DV + 128 * half + cb + 4 * (ln >> 5); STORE_OT(oa); }
          SB_;
          S_UPDATE(Bc, egl);
          SB_;
        } else {
          f32x16 oa[2]; oa[0] = zero16(); oa[1] = zero16();
          ROWS_T(oa, SC_Q);
          SB_;
          LOAD_BV();
          bf16x8 tf[8];
#pragma unroll
          for (int i = 0; i < 8; ++i) tf[i] = lds_rd128(B + SC_M, i * 1024 + ln * 16);
#pragma unroll
          for (int nt = 0; nt < 2; ++nt) oa[nt] = oa[nt] * qdec[32 * nt + (ln & 31)];
#pragma unroll
          for (int ks = 0; ks < 4; ++ks)
#pragma unroll
            for (int nt = 0; nt < 2; ++nt) oa[nt] = MFMA32(Bv[ks], tf[nt * 4 + ks], oa[nt]);
          SB_;
          { bf16_t* obt = O + ((size_t)gc * 64 + (ln & 31)) * D + h * DV + 128 * half + cb + 4 * (ln >> 5); STORE_OT(oa); }
          SB_;
          S_UPDATE(Bv, c64);
          SB_;
        }
#undef SB_
#undef STORE_O
#undef LOAD_BV
#undef ROWS_AB
#undef ROWS_T
#undef STORE_OT
#undef S_UPDATE
      }
      if (!lat && act) {
        int ln3 = lane_id(); asm volatile("" : "+v"(ln3)); const int hl3 = ln3 >> 5;
        float* so = (type ? NS_DN : NS_RET) + ((((size_t)sq * 2 + dir) * NH + h) * DK) * DV + 128 * half + cb + (ln3 & 31);
#pragma unroll
        for (int mt = 0; mt < 4; ++mt)
#pragma unroll
          for (int reg = 0; reg < 16; ++reg) so[(size_t)(32 * mt + srow(reg, hl3)) * DV] = S[mt][reg];
      }
    }
    if (G > 128 && bid >= 128) {
      asm volatile("s_waitcnt vmcnt(0)" ::: "memory");
      __syncthreads();
      int lane_c = lane_id(); asm volatile("" : "+v"(lane_c));
      late_weight_conversions(p, WGATE, WRO, WDO, WOUT, (bf16_t*)(ws + WS_WF1), (bf16_t*)(ws + WS_WF2), (LAS float*)(lds + wave * 16384), (bid - 128) * NWAVES + wave, (G - 128) * NWAVES, lane_c);
    }
  }
  GRID_BARRIER();

  bf16_t* GATES = QKV;
  {
    pg8::Gemm g{HB, WGATE, MTOT, 4096, D}; pg8::StaticOrder S; S.init(MTOT, 4096, G, bid);
    pg8::EpiBf16Act<1> E{GATES, LDG};
    pg8::gemm_phase<pg8::EpiBf16Act<1>, pg8::StaticOrder, true, true>(lds, g, S, E, wave);
  }
  GRID_BARRIER();

  bf16_t* AR = (bf16_t*)(ws + WS_AR); bf16_t* AD = (bf16_t*)(ws + WS_AD);
  {
    PHASE_TID();
    for (int m = gw; m < MTOT; m += ngw) {
      u32x2 rf[4], rb[4], df[4], db[4], gr[4], gd[4]; f32x4 gw4[4];
#pragma unroll
      for (int h = 0; h < 4; ++h) { const size_t base = (size_t)m * D + h * DV + 4 * lane;
        rf[h] = *(const u32x2*)(ORF + base); rb[h] = *(const u32x2*)(ORB + base); df[h] = *(const u32x2*)(ODF + base); db[h] = *(const u32x2*)(ODB + base);
        gr[h] = *(const u32x2*)(GATES + (size_t)m * LDG + G_RG + h * DV + 4 * lane); gd[h] = *(const u32x2*)(GATES + (size_t)m * LDG + G_DZ + h * DV + 4 * lane);
        gw4[h] = *(const f32x4*)(p.in[I_GNW] + h * DV + 4 * lane); }
      const f32x4 dw4 = *(const f32x4*)(p.in[I_DNW] + 4 * lane);
      float v[4][4], u[4][4], mu[4], rs[4], rd[4];
#pragma unroll
      for (int h = 0; h < 4; ++h) { v[h][0] = lo_bf(rf[h].x) + lo_bf(rb[h].x); v[h][1] = hi_bf(rf[h].x) + hi_bf(rb[h].x); v[h][2] = lo_bf(rf[h].y) + lo_bf(rb[h].y); v[h][3] = hi_bf(rf[h].y) + hi_bf(rb[h].y);
        u[h][0] = lo_bf(df[h].x) + lo_bf(db[h].x); u[h][1] = hi_bf(df[h].x) + hi_bf(db[h].x); u[h][2] = lo_bf(df[h].y) + lo_bf(db[h].y); u[h][3] = hi_bf(df[h].y) + hi_bf(db[h].y);
        mu[h] = (v[h][0] + v[h][1]) + (v[h][2] + v[h][3]); rd[h] = (u[h][0] * u[h][0] + u[h][1] * u[h][1]) + (u[h][2] * u[h][2] + u[h][3] * u[h][3]); }
#pragma unroll
      for (int o = 1; o < 64; o <<= 1) {
#pragma unroll
        for (int h = 0; h < 4; ++h) { mu[h] += __shfl_xor(mu[h], o); rd[h] += __shfl_xor(rd[h], o); } }
#pragma unroll
      for (int h = 0; h < 4; ++h) { mu[h] *= (1.f / DV); float q = 0.f;
#pragma unroll
        for (int e = 0; e < 4; ++e) { v[h][e] -= mu[h]; q += v[h][e] * v[h][e]; }
        rs[h] = q; }
#pragma unroll
      for (int o = 1; o < 64; o <<= 1) {
#pragma unroll
        for (int h = 0; h < 4; ++h) rs[h] += __shfl_xor(rs[h], o); }
#pragma unroll
      for (int h = 0; h < 4; ++h) { const size_t base = (size_t)m * D + h * DV + 4 * lane;
        const float r1 = rsqrtf(rs[h] * (1.f / DV) + EPS), r2 = rsqrtf(rd[h] * (1.f / DV) + EPS);
        u32x2 o; o.x = pk2(lo_bf(gr[h].x) * (v[h][0] * r1 * gw4[h].x), hi_bf(gr[h].x) * (v[h][1] * r1 * gw4[h].y)); o.y = pk2(lo_bf(gr[h].y) * (v[h][2] * r1 * gw4[h].z), hi_bf(gr[h].y) * (v[h][3] * r1 * gw4[h].w));
        *(u32x2*)(AR + base) = o;
        o.x = pk2(u[h][0] * r2 * dw4.x * lo_bf(gd[h].x), u[h][1] * r2 * dw4.y * hi_bf(gd[h].x)); o.y = pk2(u[h][2] * r2 * dw4.z * lo_bf(gd[h].y), u[h][3] * r2 * dw4.w * hi_bf(gd[h].y));
        *(u32x2*)(AD + base) = o; }
    }
  }
  GRID_BARRIER();

  bf16_t* T1 = HB;
  {
    pg8::Gemm g{AR, WRO, MTOT, D, D}; pg8::StaticOrder S; S.init(MTOT, D, G, bid);
    pg8::EpiGateMul E{T1, D, GATES + G_GR, LDG, nullptr};
    pg8::gemm_phase<pg8::EpiGateMul, pg8::StaticOrder, true, true>(lds, g, S, E, wave);
  }
  bf16_t* MERGED = T1;
  {
    pg8::Gemm g{AD, WDO, MTOT, D, D}; pg8::StaticOrder S; S.init(MTOT, D, G, bid);
    pg8::EpiGateMul E{MERGED, D, GATES + G_GD, LDG, T1};
    pg8::gemm_phase<pg8::EpiGateMul, pg8::StaticOrder, true, true>(lds, g, S, E, wave);
  }
  GRID_BARRIER();
  bf16_t* M1 = (bf16_t*)(ws + WS_O);
  bf16_t* X1B = (bf16_t*)(ws + WS_O + 24 * MiB);
  {
    pg8::Gemm g{MERGED, WOUT, MTOT, D, D}; pg8::StaticOrder S; S.init(MTOT, D, G, bid);
    pg8::EpiBf16Act<0> E{M1, D};
    pg8::gemm_phase<pg8::EpiBf16Act<0>, pg8::StaticOrder, true, true>(lds, g, S, E, wave);
  }
  GRID_BARRIER();

  bf16_t* WF1 = (bf16_t*)(ws + WS_WF1); bf16_t* WF2 = (bf16_t*)(ws + WS_WF2);
  {
    PHASE_TID();
    LAS float* scr = (LAS float*)(lds + wave * 16384);
    const float* nw1 = p.in[I_NORMW] + D; const float* nw2 = p.in[I_NORMW] + 2 * D;
    u32x2 mn[2][4]; f32x4 xn[2][4];
#define P7_LOAD(M0) do { _Pragma("unroll") for (int u = 0; u < 2; ++u) { const int m_ = ((M0) + u * ngw < MTOT) ? (M0) + u * ngw : gw; const float* xr_ = xrow(p, m_); const bf16_t* mr_ = M1 + (size_t)m_ * D; \
      _Pragma("unroll") for (int j = 0; j < 4; ++j) { const int c0 = 4 * lane + 256 * j; mn[u][j] = *(const u32x2*)(mr_ + c0); xn[u][j] = *(const f32x4*)(xr_ + c0); } } } while (0)
    P7_LOAD(gw);
    for (int m0 = gw; m0 < MTOT; m0 += 2 * ngw) {
      f32x4 v[2][4], xv[2][4], g1v[2][4]; float s[2] = {0.f, 0.f};
#pragma unroll
      for (int u = 0; u < 2; ++u)
#pragma unroll
        for (int j = 0; j < 4; ++j) { const u32x2 mw = mn[u][j]; v[u][j] = (f32x4){lo_bf(mw.x), hi_bf(mw.x), lo_bf(mw.y), hi_bf(mw.y)}; xv[u][j] = xn[u][j]; }
      P7_LOAD(m0 + 2 * ngw);
#pragma unroll
      for (int u = 0; u < 2; ++u) { const int m = (m0 + u * ngw < MTOT) ? m0 + u * ngw : m0; const float* md = MOD + (size_t)cond_of_row(m) * 6 * D;
#pragma unroll
        for (int j = 0; j < 4; ++j) { const int c0 = 4 * lane + 256 * j; g1v[u][j] = *(const f32x4*)(md + 2 * D + c0); } }
#pragma unroll
      for (int u = 0; u < 2; ++u)
#pragma unroll
        for (int j = 0; j < 4; ++j) s[u] += (v[u][j].x * v[u][j].x + v[u][j].y * v[u][j].y) + (v[u][j].z * v[u][j].z + v[u][j].w * v[u][j].w);
#pragma unroll
      for (int o = 1; o < 64; o <<= 1) { s[0] += __shfl_xor(s[0], o); s[1] += __shfl_xor(s[1], o); }
      float s2[2] = {0.f, 0.f};
#pragma unroll
      for (int u = 0; u < 2; ++u) { const int m = m0 + u * ngw; const float r = rsqrtf(s[u] * (1.f / D) + EPS);
#pragma unroll
        for (int j = 0; j < 4; ++j) { const int c0 = 4 * lane + 256 * j;
          v[u][j] = xv[u][j] + g1v[u][j] * (v[u][j] * r * *(const f32x4*)(nw1 + c0));
          if (m < MTOT) { u32x2 xo; xo.x = pk2(v[u][j].x, v[u][j].y); xo.y = pk2(v[u][j].z, v[u][j].w); *(u32x2*)(X1B + (size_t)m * D + c0) = xo; }
          s2[u] += (v[u][j].x * v[u][j].x + v[u][j].y * v[u][j].y) + (v[u][j].z * v[u][j].z + v[u][j].w * v[u][j].w); } }
#pragma unroll
      for (int o = 1; o < 64; o <<= 1) { s2[0] += __shfl_xor(s2[0], o); s2[1] += __shfl_xor(s2[1], o); }
#pragma unroll
      for (int u = 0; u < 2; ++u) { const int m = m0 + u * ngw; if (m >= MTOT) continue; const float* md = MOD + (size_t)cond_of_row(m) * 6 * D; const float r2 = rsqrtf(s2[u] * (1.f / D) + EPS);
#pragma unroll
        for (int j = 0; j < 4; ++j) { const int c0 = 4 * lane + 256 * j;
          const f32x4 h = v[u][j] * r2 * *(const f32x4*)(nw2 + c0) * (*(const f32x4*)(md + 4 * D + c0) + 1.f) + *(const f32x4*)(md + 3 * D + c0);
          u32x2 o; o.x = pk2(h.x, h.y); o.y = pk2(h.z, h.w); *(u32x2*)(HB + (size_t)m * D + c0) = o; } }
    }
  }
#undef P7_LOAD
  GRID_BARRIER();

  bf16_t* ACT = QKV;
  const bool TAIL_SPLIT = G >= 228;
  constexpr int MT_MAIN = 46, M_MAIN = MT_MAIN * 256;
  {
    const int M8 = TAIL_SPLIT ? M_MAIN : MTOT;
    pg8::Gemm g{HB, WF1, M8, 2 * DFF, D}; pg8::StaticOrder S; S.init(M8, 2 * DFF, G, bid);
    pg8::EpiSwiGLU E{ACT, DFF};
    pg8::gemm_phase<pg8::EpiSwiGLU, pg8::StaticOrder, true, true>(lds, g, S, E, wave);
  }
  GRID_BARRIER();
  bf16_t* F = (bf16_t*)(ws + WS_O); bf16_t* F1 = (bf16_t*)(ws + WS_F1);
  if (!TAIL_SPLIT || bid < MT_MAIN * 4) {
    const int M9 = TAIL_SPLIT ? M_MAIN : MTOT;
    pg8::Gemm g{ACT, WF2, M9, D, DFF}; pg8::StaticOrder S; S.init(M9, D, G, bid);
    pg8::EpiBf16Act<0> E{F, D};
    pg8::gemm_phase<pg8::EpiBf16Act<0>, pg8::StaticOrder, true, true>(lds, g, S, E, wave);
  } else if (bid < MT_MAIN * 4 + 44) {
    const int j = bid - MT_MAIN * 4;
    {
      pg8::Gemm g{HB, WF1, MTOT, 2 * DFF, D}; pg8::OneUnit S{MT_MAIN + j / 22, j % 22};
      pg8::EpiSwiGLU E{ACT, DFF};
      pg8::gemm_phase<pg8::EpiSwiGLU, pg8::OneUnit, true, true>(lds, g, S, E, wave);
    }
    asm volatile("s_waitcnt vmcnt(0)" ::: "memory");
    __syncthreads();
    if (wave == 0 && lane_id() == 0) {
      unsigned* cnt = (unsigned*)(p.ws + WS_BAR + 14336);
      __builtin_amdgcn_fence(__ATOMIC_RELEASE, "agent");
      asm volatile("s_waitcnt vmcnt(0)" ::: "memory");
      __hip_atomic_fetch_add(cnt, 1u, __ATOMIC_RELAXED, __HIP_MEMORY_SCOPE_AGENT);
      if (j < 24) {
        unsigned sp = 0;
        while (__hip_atomic_load(cnt, __ATOMIC_RELAXED, __HIP_MEMORY_SCOPE_AGENT) < 44u) { __builtin_amdgcn_s_sleep(2); if (++sp > (1u << 22)) break; }
        __builtin_amdgcn_fence(__ATOMIC_ACQUIRE, "agent");
        asm volatile("s_waitcnt vmcnt(0)" ::: "memory");
      }
    }
    __syncthreads();
    if (j < 24) {
      const int un = j / 3, kp = j % 3, k0 = kp == 0 ? 0 : (kp == 1 ? 1024 : 1920), kl = kp == 0 ? 1024 : 896;
      pg8::Gemm g{ACT + k0, WF2 + k0, MTOT, D, kl, DFF}; pg8::OneUnit S{MT_MAIN + (un >> 2), un & 3};
      pg8::EpiBf16Act<0> E{kp ? F1 + (size_t)(kp - 1) * 512 * D - (size_t)M_MAIN * D : F, D};
      pg8::gemm_phase<pg8::EpiBf16Act<0>, pg8::OneUnit, true, true>(lds, g, S, E, wave);
    }
  }
  GRID_BARRIER();
  {
    PHASE_TID();
    const float* nw3 = p.in[I_NORMW] + 3 * D;
    u32x2 fn[2][4], xn[2][4];
#define P10_LOAD(M0) do { _Pragma("unroll") for (int u = 0; u < 2; ++u) { const int m_ = ((M0) + u * ngw < MTOT) ? (M0) + u * ngw : gw; const bf16_t* fr_ = F + (size_t)m_ * D; const bf16_t* xr_ = X1B + (size_t)m_ * D; \
      _Pragma("unroll") for (int j = 0; j < 4; ++j) { const int c0 = 4 * lane + 256 * j; fn[u][j] = *(const u32x2*)(fr_ + c0); xn[u][j] = *(const u32x2*)(xr_ + c0); } } } while (0)
    P10_LOAD(gw);
    for (int m0 = gw; m0 < MTOT; m0 += 2 * ngw) {
      f32x4 v[2][4], xv[2][4], gv[2][4]; float s[2] = {0.f, 0.f};
#pragma unroll
      for (int u = 0; u < 2; ++u)
#pragma unroll
        for (int j = 0; j < 4; ++j) { const u32x2 fw = fn[u][j], xw = xn[u][j]; v[u][j] = (f32x4){lo_bf(fw.x), hi_bf(fw.x), lo_bf(fw.y), hi_bf(fw.y)}; xv[u][j] = (f32x4){lo_bf(xw.x), hi_bf(xw.x), lo_bf(xw.y), hi_bf(xw.y)}; }
      P10_LOAD(m0 + 2 * ngw);
#pragma unroll
      for (int u = 0; u < 2; ++u) { const int m = (m0 + u * ngw < MTOT) ? m0 + u * ngw : m0; const float* md = MOD + (size_t)cond_of_row(m) * 6 * D; const bf16_t* f1r = (TAIL_SPLIT && m >= M_MAIN) ? F1 + (size_t)(m - M_MAIN) * D : nullptr;
#pragma unroll
        for (int j = 0; j < 4; ++j) { const int c0 = 4 * lane + 256 * j; gv[u][j] = *(const f32x4*)(md + 5 * D + c0);
          if (f1r) { const u32x2 gw2 = *(const u32x2*)(f1r + c0), gw3 = *(const u32x2*)(f1r + 512 * D + c0); v[u][j] += (f32x4){lo_bf(gw2.x), hi_bf(gw2.x), lo_bf(gw2.y), hi_bf(gw2.y)} + (f32x4){lo_bf(gw3.x), hi_bf(gw3.x), lo_bf(gw3.y), hi_bf(gw3.y)}; } } }
#pragma unroll
      for (int u = 0; u < 2; ++u)
#pragma unroll
        for (int j = 0; j < 4; ++j) s[u] += (v[u][j].x * v[u][j].x + v[u][j].y * v[u][j].y) + (v[u][j].z * v[u][j].z + v[u][j].w * v[u][j].w);
#pragma unroll
      for (int o = 1; o < 64; o <<= 1) { s[0] += __shfl_xor(s[0], o); s[1] += __shfl_xor(s[1], o); }
#pragma unroll
      for (int u = 0; u < 2; ++u) { const int m = m0 + u * ngw; if (m >= MTOT) continue; const float r = rsqrtf(s[u] * (1.f / D) + EPS); float* orow = p.out + (size_t)m * D;
#pragma unroll
        for (int j = 0; j < 4; ++j) { const int c0 = 4 * lane + 256 * j; *(f32x4*)(orow + c0) = xv[u][j] + gv[u][j] * (v[u][j] * r * *(const f32x4*)(nw3 + c0)); } }
    }
#undef P10_LOAD
  }
}

extern "C" void kernel_launch(void* const* d_in, const int* in_sizes, int n_in, void* d_out, int out_size, void* d_ws, size_t ws_size, hipStream_t stream) {
  static int grid_blocks = 0;
  if (!grid_blocks) {
    int dev = 0, cus = 0, per_cu = 0;
    (void)hipGetDevice(&dev);
    (void)hipDeviceGetAttribute(&cus, hipDeviceAttributeMultiprocessorCount, dev);
    (void)hipFuncSetAttribute((const void*)fwd_megakernel, hipFuncAttributeMaxDynamicSharedMemorySize, LDS_BYTES);
    (void)hipOccupancyMaxActiveBlocksPerMultiprocessor(&per_cu, (const void*)fwd_megakernel, NTHREADS, LDS_BYTES);
    if (per_cu < 1) per_cu = 1;
    grid_blocks = cus * per_cu;
    if (n_in != 21 || ws_size < WS_END) fprintf(stderr, "kernel_launch: unexpected n_in %d / ws_size %zu\n", n_in, ws_size);
    fprintf(stderr, "kernel_launch: cus %d per_cu %d grid %d ws %zu out %d\n", cus, per_cu, grid_blocks, ws_size, out_size);
  }
  (void)hipMemsetAsync((unsigned char*)d_ws + WS_BAR, 0, 16384, stream);
  Params p{};
  for (int i = 0; i < 21; ++i) p.in[i] = (const float*)d_in[i];
  p.out = (float*)d_out; p.ws = (unsigned char*)d_ws;
  void* args[] = {&p};
  hipError_t e = hipLaunchCooperativeKernel((const void*)fwd_megakernel, dim3(grid_blocks), dim3(NTHREADS), args, LDS_BYTES, stream);
  if (e != hipSuccess) fprintf(stderr, "cooperative launch failed: %s (grid %d)\n", hipGetErrorString(e), grid_blocks);
}
```

```cpp
#include <hip/hip_runtime.h>
#include <hip/hip_cooperative_groups.h>
#include <cstdio>
#include <cstdint>
namespace cg = cooperative_groups;

#define LAS __attribute__((address_space(3)))
typedef unsigned short bf16_t;
typedef short bf16x8 __attribute__((ext_vector_type(8)));
typedef float f32x4 __attribute__((ext_vector_type(4)));
typedef float f32x2 __attribute__((ext_vector_type(2)));
typedef unsigned u32x4 __attribute__((ext_vector_type(4)));
typedef unsigned u32x2 __attribute__((ext_vector_type(2)));

constexpr int D = 1024, MCTX = 4096, MLAT = 8192, MTOT = 12288, LCTX = 256, LLAT = 2048, NCTX = 16, NLAT = 4;
constexpr int NH = 4, DK = 128, DV = 256, DFF = 2816, INC = 8208;
constexpr float EPS = 1e-6f;
constexpr float QSCALE = 0.08838834764831845f;
constexpr int NTHREADS = 512, NWAVES = 8;
constexpr int LDS_BYTES = 135168;
constexpr int Q_RQ = 0, Q_RK = 512, Q_RV = 1024, Q_DQ = 2048, Q_DK = 2560, Q_DV = 3072, LDQ = 4096;
constexpr int G_RG = 0, G_DZ = 1024, G_GR = 2048, G_GD = 3072, LDG = 4096;
constexpr int C_RQ = 0, C_RG = 2048, C_DQ = 3072, C_DZ = 5120, C_DB = 6144, C_GR = 6160;

constexpr size_t MiB = 1u << 20;
constexpr size_t WS_MOD = 0;
constexpr size_t WS_ROPE = 128 * 1024;
constexpr size_t WS_BAR = 1152 * 1024;
constexpr size_t WS_BA = 1280 * 1024;
constexpr size_t WS_WQKV = 2 * MiB;
constexpr size_t WS_WGATE = 10 * MiB;
constexpr size_t WS_WRO = 18 * MiB, WS_WDO = 20 * MiB, WS_WOUT = 22 * MiB;
constexpr size_t WS_H = 24 * MiB;
constexpr size_t WS_QKV = 48 * MiB;
constexpr size_t WS_MATS_DN = 144 * MiB;
constexpr size_t WS_MATS_RT = 170 * MiB;
constexpr size_t WS_KB = 182 * MiB;
constexpr size_t WS_HALO = 194 * MiB;
constexpr size_t WS_O = 196 * MiB;
constexpr size_t WS_F1 = 8 * MiB;
constexpr size_t WS_END = 255 * MiB;
constexpr size_t WS_AR = 144 * MiB, WS_AD = 168 * MiB, WS_MERGED = 144 * MiB;
constexpr size_t WS_WF1 = 244 * MiB, WS_WF2 = 2 * MiB;

struct Params {
  const float* in[21];
  float* out;
  unsigned char* ws;
};
enum { I_XP = 0, I_XS, I_C, I_SRET, I_SDN, I_CCTX, I_WMOD, I_BMOD, I_NORMW, I_WIN, I_CONVW, I_DECAY, I_GNW, I_ALOG, I_DTB, I_DNW, I_WRO, I_WDO, I_WOUT, I_WF1, I_WF2 };

__device__ __forceinline__ float bf2f(unsigned short b) { return __uint_as_float((unsigned)b << 16); }
__device__ __forceinline__ unsigned f2bf(float f) { unsigned u = __float_as_uint(f); return (u + 0x7fffu + ((u >> 16) & 1u)) >> 16; }
typedef __bf16 bfx2_t __attribute__((ext_vector_type(2)));
__device__ __forceinline__ unsigned pk2(float lo, float hi) { const f32x2 t = {lo, hi}; return __builtin_bit_cast(unsigned, __builtin_convertvector(t, bfx2_t)); }
__device__ __forceinline__ unsigned cvt_pk_bf16(float lo, float hi) { return pk2(lo, hi); }

__device__ __forceinline__ float lo_bf(unsigned w) { return __uint_as_float(w << 16); }
__device__ __forceinline__ float hi_bf(unsigned w) { return __uint_as_float(w & 0xffff0000u); }
__device__ __forceinline__ float siluf(float x) { return x * __builtin_amdgcn_rcpf(1.f + __expf(-x)); }
__device__ __forceinline__ float sigmf(float x) { return __builtin_amdgcn_rcpf(1.f + __expf(-x)); }
__device__ __forceinline__ float softplusf(float x) { return x > 20.f ? x : log1pf(expf(x)); }
__device__ __forceinline__ float wave_sum(float v) {
#pragma unroll
  for (int o = 1; o < 64; o <<= 1) v += __shfl_xor(v, o);
  return v;
}
__device__ __forceinline__ int lane_id() { return (int)__builtin_amdgcn_mbcnt_hi(~0u, __builtin_amdgcn_mbcnt_lo(~0u, 0u)); }
__device__ __forceinline__ int cond_of_row(int m) { return m < MCTX ? 0 : 1 + (m - MCTX) / LLAT; }
__device__ __forceinline__ const float* xrow(const Params& p, int m) { return m < MCTX ? p.in[I_XP] + (size_t)m * D : p.in[I_XS] + (size_t)(m - MCTX) * D; }


__device__ __forceinline__ int lane_id();
#define XB_TMO      128
#define XB_XCNT(j)  (256  + 64 * (j))
#define XB_XSUB(j)  (1280 + 64 * (j))
#define XB_XGEN(j)  (2304 + 64 * (j))
#define XB_TOP      3328
#define XB_TOPGEN   3392
#define XCD_BAR_WORDS 3456
#define XB_SPIN_CAP (1u << 18)
__device__ __forceinline__ unsigned xb_ld(unsigned* p)              { return __hip_atomic_load(p, __ATOMIC_RELAXED, __HIP_MEMORY_SCOPE_AGENT); }
__device__ __forceinline__ unsigned xb_add(unsigned* p, unsigned v) { return __hip_atomic_fetch_add(p, v, __ATOMIC_RELAXED, __HIP_MEMORY_SCOPE_AGENT); }
__device__ __forceinline__ unsigned xb_xcc_id() { return (unsigned)__builtin_amdgcn_s_getreg((3 << 11) | 20) & 0xFu; }
#define XB_SPIN(cond, bar) do { unsigned _sp = 0; while (cond) { __builtin_amdgcn_s_sleep(1); \
    if ((++_sp & 255u) == 0u) { if (xb_ld(&(bar)[XB_TMO])) break; if (_sp > XB_SPIN_CAP) { atomicAdd(&(bar)[XB_TMO], 1u); break; } } } } while (0)
struct XcdBarrier { unsigned* bar; unsigned x; volatile LAS unsigned* st; };
__device__ __forceinline__ XcdBarrier xcd_barrier_post(unsigned* bar, volatile LAS unsigned* st) {
  XcdBarrier b; b.bar = bar; b.x = xb_xcc_id(); b.st = st;
  if (threadIdx.x == 0) (void)xb_add(&bar[XB_XCNT(b.x)], 1u);
  return b;
}
__device__ __forceinline__ void xcd_barrier_complete(unsigned* bar, unsigned x, unsigned& nloc, unsigned& nx) {
  const unsigned G = gridDim.x * gridDim.y * gridDim.z;
  unsigned sum, cnt, mine, sp = 0u;
  for (;;) {
    sum = 0u; cnt = 0u; mine = 0u;
#pragma unroll
    for (unsigned j = 0; j < 16; ++j) { const unsigned c = xb_ld(&bar[XB_XCNT(j)]); sum += c; cnt += (c > 0u) ? 1u : 0u; mine = (j == x) ? c : mine; }
    if (sum == G) break;
    __builtin_amdgcn_s_sleep(1);
    if ((++sp & 255u) == 0u) { if (xb_ld(&bar[XB_TMO])) break; if (sp > XB_SPIN_CAP) { atomicAdd(&bar[XB_TMO], 1u); break; } }
  }
  nloc = mine > 0u ? mine : 1u; nx = cnt > 0u ? cnt : 1u;
}
__device__ __forceinline__ void xcd_barrier(const XcdBarrier& b, const int wave) {
  asm volatile("s_waitcnt vmcnt(0)" ::: "memory");
  __syncthreads();
  if (wave == 0 && lane_id() == 0) {
    unsigned* bar = b.bar;
    __builtin_amdgcn_s_waitcnt(0);
    unsigned nloc = b.st[0], nx = b.st[1];
    if (nloc == 0u) { xcd_barrier_complete(bar, b.x, nloc, nx); b.st[0] = nloc; b.st[1] = nx; }
    const unsigned old = xb_add(&bar[XB_XSUB(b.x)], 1u);
    const unsigned gen = old / nloc;
    if (old + 1u == (gen + 1u) * nloc) {
      __builtin_amdgcn_fence(__ATOMIC_RELEASE, "agent");
      asm volatile("s_waitcnt vmcnt(0)" ::: "memory");
      const unsigned og = xb_add(&bar[XB_TOP], 1u);
      const unsigned tg = og / nx;
      if (og + 1u == (tg + 1u) * nx) xb_add(&bar[XB_TOPGEN], 1u);
      else XB_SPIN(xb_ld(&bar[XB_TOPGEN]) == tg, bar);
      __builtin_amdgcn_fence(__ATOMIC_ACQUIRE, "agent");
      xb_add(&bar[XB_XGEN(b.x)], 1u);
      asm volatile("s_waitcnt vmcnt(0)" ::: "memory");
    } else {
      XB_SPIN(xb_ld(&bar[XB_XGEN(b.x)]) == gen, bar);
      __builtin_amdgcn_fence(__ATOMIC_ACQUIRE, "agent");
      asm volatile("s_waitcnt vmcnt(0)" ::: "memory");
    }
  }
  __syncthreads();
}

namespace pg8 {
constexpr int BM = 256, BK = 64, HALF = 128, HTB = HALF * BK * 2, STAGE_BYTES = 8 * HTB, NXCD = 8, WGM = 8;
__host__ __device__ __forceinline__ int lds_byte(int r, int c) { const int st = (r >> 4) * 2 + (c >> 5), rr = r & 15, cc = c & 31, ob = rr * 64 + cc * 2; return st * 1024 + (ob ^ (((ob >> 9) & 1) << 5)); }
__host__ __device__ __forceinline__ void stage_rc(int b, int& R, int& C) { const int st = b / 1024, sb = b % 1024, swz = sb ^ (((sb >> 9) & 1) << 5); R = (st >> 1) * 16 + swz / 64; C = (st & 1) * 32 + (swz % 64) / 2; }
__host__ __device__ __forceinline__ int perm32(int rho) { const int n = rho >> 4, i = rho & 15; return 8 * (i >> 2) + 4 * n + (i & 3); }
struct Unit { int pm, pn; };
struct Gemm { const bf16_t* A; const bf16_t* Bt; int M, N, K; int ld; };
struct OneUnit {
  int pm, pn;
  __device__ __forceinline__ bool next(int i, Unit& u) const { if (i != 0) return false; u.pm = pm; u.pn = pn; return true; }
  __device__ __forceinline__ void a_ready(const Unit&) const {}
  __device__ __forceinline__ void done(const Unit&) const {}
};
struct StaticOrder {
  int nM, nN, nwg, G, c;
  __host__ __device__ void init(int M, int N, int G_, int c_) { nM = M / BM; nN = N / BM; nwg = nM * nN; G = G_; c = c_; }
  __host__ __device__ bool next(int i, Unit& u) const {
    const long L = (long)i * G + c; if (L >= nwg) return false;
    int wgid = (int)L; { const int q = nwg / NXCD, r = nwg % NXCD, xcd = wgid % NXCD, off = wgid / NXCD; wgid = (xcd < r ? xcd * (q + 1) : r * (q + 1) + (xcd - r) * q) + off; }
    const int nig = WGM * nN, gid = wgid / nig, fm = gid * WGM, gsz = (nM - fm) < WGM ? (nM - fm) : WGM;
    u.pm = fm + ((wgid % nig) % gsz); u.pn = (wgid % nig) / gsz; return true;
  }
  __device__ __forceinline__ void a_ready(const Unit&) const {}
  __device__ __forceinline__ void done(const Unit&) const {}
};

template <int MODE  > struct EpiBf16Act {
  static constexpr bool PERM = true, AFTER_DRAIN = false;
  bf16_t* O; int ldc;
  __device__ __forceinline__ void operator()(const f32x4 (&acc)[2][2][4][2], const Unit& u, int wr, int wc, int fr, int fq) const {
    const int row0 = u.pm * BM + wr * 64 + fr, col0 = u.pn * BM + wc * 32 + 8 * fq;
    const bool sg = u.pn >= 8;
#pragma unroll
    for (int ai = 0; ai < 2; ++ai)
#pragma unroll
      for (int m = 0; m < 4; ++m) { bf16_t* rowp = O + (size_t)(row0 + ai * HALF + m * 16) * ldc + col0;
#pragma unroll
        for (int bj = 0; bj < 2; ++bj) { f32x4 v0 = acc[ai][bj][m][0], v1 = acc[ai][bj][m][1];
          if (MODE == 1) {
#pragma unroll
            for (int i = 0; i < 4; ++i) { const float s0 = __builtin_amdgcn_rcpf(1.f + __expf(-v0[i])), s1 = __builtin_amdgcn_rcpf(1.f + __expf(-v1[i]));
              v0[i] = sg ? s0 : v0[i] * s0; v1[i] = sg ? s1 : v1[i] * s1; } }
          u32x4 w; w.x = cvt_pk_bf16(v0[0], v0[1]); w.y = cvt_pk_bf16(v0[2], v0[3]); w.z = cvt_pk_bf16(v1[0], v1[1]); w.w = cvt_pk_bf16(v1[2], v1[3]);
          *(u32x4*)(rowp + bj * HALF) = w; } }
  }
};
struct EpiQKV {
  static constexpr bool PERM = true, AFTER_DRAIN = false;
  bf16_t* O; int ldc; bf16_t* HALO;
  __device__ __forceinline__ void operator()(const f32x4 (&acc)[2][2][4][2], const Unit& u, int wr, int wc, int fr, int fq) const {
    const int row0 = u.pm * BM + wr * 64 + fr, col0 = u.pn * BM + wc * 32 + 8 * fq;
#pragma unroll
    for (int ai = 0; ai < 2; ++ai)
#pragma unroll
      for (int m = 0; m < 4; ++m) { const int row = row0 + ai * HALF + m * 16; bf16_t* rowp = O + (size_t)row * ldc + col0;
#pragma unroll
        for (int bj = 0; bj < 2; ++bj) { const f32x4 v0 = acc[ai][bj][m][0], v1 = acc[ai][bj][m][1];
          u32x4 w; w.x = cvt_pk_bf16(v0[0], v0[1]); w.y = cvt_pk_bf16(v0[2], v0[3]); w.z = cvt_pk_bf16(v1[0], v1[1]); w.w = cvt_pk_bf16(v1[2], v1[3]);
          *(u32x4*)(rowp + bj * HALF) = w;
          if (u.pn >= 8 && ((m == 0 && fr == 0) || (m == 3 && fr == 15)))
            *(u32x4*)(HALO + ((size_t)(row >> 6) * 2 + (m == 3 ? 1 : 0)) * 2048 + (col0 - 2048) + bj * HALF) = w; } }
  }
};
struct EpiGateMul {
  static constexpr bool PERM = true, AFTER_DRAIN = false;
  bf16_t* O; int ldc; const bf16_t* G; int ldg; const bf16_t* Add;
  __device__ __forceinline__ void operator()(const f32x4 (&acc)[2][2][4][2], const Unit& u, int wr, int wc, int fr, int fq) const {
    const int row0 = u.pm * BM + wr * 64 + fr, col0 = u.pn * BM + wc * 32 + 8 * fq;
#pragma unroll
    for (int ai = 0; ai < 2; ++ai)
#pragma unroll
      for (int m = 0; m < 4; ++m) { const size_t r = (size_t)(row0 + ai * HALF + m * 16);
#pragma unroll
        for (int bj = 0; bj < 2; ++bj) { const f32x4 v0 = acc[ai][bj][m][0], v1 = acc[ai][bj][m][1];
          const u32x4 g = *(const u32x4*)(G + r * ldg + col0 + bj * HALF);
          float o[8] = {v0[0] * lo_bf(g.x), v0[1] * hi_bf(g.x), v0[2] * lo_bf(g.y), v0[3] * hi_bf(g.y), v1[0] * lo_bf(g.z), v1[1] * hi_bf(g.z), v1[2] * lo_bf(g.w), v1[3] * hi_bf(g.w)};
          if (Add) { const u32x4 a = *(const u32x4*)(Add + r * ldc + col0 + bj * HALF);
            o[0] += lo_bf(a.x); o[1] += hi_bf(a.x); o[2] += lo_bf(a.y); o[3] += hi_bf(a.y); o[4] += lo_bf(a.z); o[5] += hi_bf(a.z); o[6] += lo_bf(a.w); o[7] += hi_bf(a.w); }
          u32x4 w; w.x = cvt_pk_bf16(o[0], o[1]); w.y = cvt_pk_bf16(o[2], o[3]); w.z = cvt_pk_bf16(o[4], o[5]); w.w = cvt_pk_bf16(o[6], o[7]);
          *(u32x4*)(O + r * ldc + col0 + bj * HALF) = w; } }
  }
};
struct EpiF32 {
  static constexpr bool PERM = false, AFTER_DRAIN = false;
  float* O; int ldc;
  __device__ __forceinline__ void operator()(const f32x4 (&acc)[2][2][4][2], const Unit& u, int wr, int wc, int fr, int fq) const {
    const int row0 = u.pm * BM + wr * 64 + fr, col0 = u.pn * BM + wc * 32 + 4 * fq;
#pragma unroll
    for (int ai = 0; ai < 2; ++ai)
#pragma unroll
      for (int m = 0; m < 4; ++m) { float* rowp = O + (size_t)(row0 + ai * HALF + m * 16) * ldc + col0;
#pragma unroll
        for (int bj = 0; bj < 2; ++bj)
#pragma unroll
          for (int n = 0; n < 2; ++n) *(f32x4*)(rowp + bj * HALF + n * 16) = acc[ai][bj][m][n]; }
  }
};
struct EpiSwiGLU {
  static constexpr bool PERM = true, AFTER_DRAIN = false;
  bf16_t* O; int ldc;
  __device__ __forceinline__ void operator()(const f32x4 (&acc)[2][2][4][2], const Unit& u, int wr, int wc, int fr, int fq) const {
    const int row0 = u.pm * BM + wr * 64 + fr, col0 = u.pn * HALF + wc * 32 + 8 * fq;
#pragma unroll
    for (int ai = 0; ai < 2; ++ai)
#pragma unroll
      for (int m = 0; m < 4; ++m) { bf16_t* rowp = O + (size_t)(row0 + ai * HALF + m * 16) * ldc + col0;
        float o[8];
#pragma unroll
        for (int n = 0; n < 2; ++n)
#pragma unroll
          for (int i = 0; i < 4; ++i) { const float g = acc[ai][0][m][n][i], up = acc[ai][1][m][n][i]; o[4 * n + i] = g * __builtin_amdgcn_rcpf(1.f + __expf(-g)) * up; }
        u32x4 w; w.x = cvt_pk_bf16(o[0], o[1]); w.y = cvt_pk_bf16(o[2], o[3]); w.z = cvt_pk_bf16(o[4], o[5]); w.w = cvt_pk_bf16(o[6], o[7]);
        *(u32x4*)rowp = w; }
  }
};

template <class Epi, class Sched, bool ALIGN_EPI = false, bool SP2 = false>
__device__ __forceinline__ void gemm_phase(LAS unsigned char* lds, const Gemm g, const Sched& S, const Epi& E, const int wid) {
  int lane_o = lane_id(); asm volatile("" : "+v"(lane_o));
  const int lane = lane_o, tid = (wid << 6) | lane, wr = wid >> 2, wc = wid & 3, fr = lane & 15, fq = lane >> 4;
  const int K = g.ld ? g.ld : g.K, nt = g.K / BK;
  unsigned voffA[2], voffB[2];
#pragma unroll
  for (int i = 0; i < 2; ++i) { int R, C; stage_rc(tid * 16 + i * 8192, R, C); const int Rb = Epi::PERM ? ((R & ~31) + perm32(R & 31)) : R;
    voffA[i] = (unsigned)(R * K + C) * 2u; voffB[i] = (unsigned)(Rb * K + C) * 2u; }
  const size_t kstep = (size_t)(BK * 2);
  const size_t hstep = (size_t)HALF * K * 2;
  const size_t tstep = 2 * hstep;
  const unsigned ldsw = (unsigned)wid * 1024u;
  const int aoff = lds_byte(wr * 64 + fr, fq * 8), boff = lds_byte(wc * 32 + fr, fq * 8);
#define PG8_SA(b, h) (((b) * 2 + (h)) * HTB)
#define PG8_SB(b, h) ((4 + (b) * 2 + (h)) * HTB)
#define PG8_STAGE(bufoff, gbase, voff) do { _Pragma("unroll") for (int _i = 0; _i < 2; ++_i) \
    __builtin_amdgcn_global_load_lds((const unsigned*)((const char*)(gbase) + (voff)[_i]), (LAS unsigned*)(lds + (bufoff) + ldsw + _i * 8192), 16, 0, 0); } while (0)
#define PG8_LDA(dst, b, h) do { _Pragma("unroll") for (int m = 0; m < 4; ++m) _Pragma("unroll") for (int k = 0; k < 2; ++k) dst[m][k] = *(const LAS bf16x8*)(lds + PG8_SA(b, h) + aoff + m * 2048 + k * 1024); } while (0)
#define PG8_LDB(dst, b, h) do { _Pragma("unroll") for (int n = 0; n < 2; ++n) _Pragma("unroll") for (int k = 0; k < 2; ++k) dst[n][k] = *(const LAS bf16x8*)(lds + PG8_SB(b, h) + boff + n * 2048 + k * 1024); } while (0)
#define PG8_MMA(ai, bj, At, Bt) do { __builtin_amdgcn_s_setprio(1); _Pragma("unroll") for (int m = 0; m < 4; ++m) _Pragma("unroll") for (int n = 0; n < 2; ++n) _Pragma("unroll") for (int k = 0; k < 2; ++k) \
    acc[ai][bj][m][n] = __builtin_amdgcn_mfma_f32_16x16x32_bf16(Bt[n][k], At[m][k], acc[ai][bj][m][n], 0, 0, 0); __builtin_amdgcn_s_setprio(0); } while (0)
#define PG8_WAIT_V(n) asm volatile("s_waitcnt vmcnt(" #n ")" ::: "memory")
#define PG8_WAIT_L(n) asm volatile("s_waitcnt lgkmcnt(" #n ")" ::: "memory")
#define PG8_BAR __builtin_amdgcn_s_barrier()
#define PG8_SCHED __builtin_amdgcn_sched_barrier(0)
  Unit cur, nxt; int ui = 0;
  if (!S.next(0, cur)) return;
  f32x4 acc[2][2][4][2];
#pragma unroll
  for (int a = 0; a < 2; ++a)
#pragma unroll
    for (int b = 0; b < 2; ++b)
#pragma unroll
      for (int m = 0; m < 4; ++m)
#pragma unroll
        for (int n = 0; n < 2; ++n) acc[a][b][m][n] = (f32x4){0.f, 0.f, 0.f, 0.f};
  bf16x8 At[4][2], B0[2][2], B1[2][2];
  const char* cA = (const char*)g.A + (size_t)cur.pm * tstep; const char* cB = (const char*)g.Bt + (size_t)cur.pn * tstep;
  S.a_ready(cur);
  if constexpr (SP2) {
    PG8_STAGE(PG8_SB(0, 0), cB, voffB); PG8_STAGE(PG8_SB(0, 1), cB + hstep, voffB); PG8_STAGE(PG8_SA(0, 0), cA, voffA); PG8_STAGE(PG8_SA(0, 1), cA + hstep, voffA);
    if (wr == 1) PG8_BAR;
    PG8_WAIT_V(2); PG8_BAR;
    PG8_STAGE(PG8_SB(1, 0), cB + kstep, voffB); PG8_STAGE(PG8_SA(1, 0), cA + kstep, voffA); PG8_STAGE(PG8_SB(1, 1), cB + hstep + kstep, voffB);
    PG8_WAIT_V(6); PG8_BAR;
  } else {
    PG8_STAGE(PG8_SB(0, 0), cB, voffB); PG8_STAGE(PG8_SA(0, 0), cA, voffA); PG8_STAGE(PG8_SB(0, 1), cB + hstep, voffB); PG8_STAGE(PG8_SA(0, 1), cA + hstep, voffA);
    if (wr == 1) PG8_BAR;
    PG8_WAIT_V(4); PG8_BAR;
    PG8_STAGE(PG8_SB(1, 0), cB + kstep, voffB); PG8_STAGE(PG8_SA(1, 0), cA + kstep, voffA); PG8_STAGE(PG8_SB(1, 1), cB + hstep + kstep, voffB);
    PG8_WAIT_V(6); PG8_BAR;
  }
  for (;;) {
    const bool has_next = S.next(ui + 1, nxt);
    const char* nA = has_next ? (const char*)g.A + (size_t)nxt.pm * tstep : cA; const char* nB = has_next ? (const char*)g.Bt + (size_t)nxt.pn * tstep : cB;
    for (int t = 0; t < nt; t += 2) {
      const bool last = (t == nt - 2);
      const char* a1 = cA + (size_t)(t + 1) * kstep;
      const char* a2 = last ? nA : cA + (size_t)(t + 2) * kstep; const char* b2 = last ? nB : cB + (size_t)(t + 2) * kstep;
      const char* a3 = a2 + kstep; const char* b3 = b2 + kstep;
      if (last && has_next) S.a_ready(nxt);
      if constexpr (SP2) {
        PG8_LDB(B0, 0, 0); PG8_LDB(B1, 0, 1); PG8_SCHED; PG8_LDA(At, 0, 0); PG8_STAGE(PG8_SA(1, 1), a1 + hstep, voffA);
        PG8_WAIT_V(8); PG8_WAIT_L(0); PG8_BAR; PG8_MMA(0, 0, At, B0); PG8_MMA(0, 1, At, B1); PG8_BAR; PG8_SCHED;
        PG8_LDA(At, 0, 1); PG8_STAGE(PG8_SB(0, 0), b2, voffB); PG8_STAGE(PG8_SB(0, 1), b2 + hstep, voffB); PG8_STAGE(PG8_SA(0, 0), a2, voffA);
        PG8_WAIT_V(8); PG8_WAIT_L(0); PG8_BAR; PG8_MMA(1, 0, At, B0); PG8_MMA(1, 1, At, B1); PG8_BAR; PG8_SCHED;
        PG8_LDB(B0, 1, 0); PG8_LDB(B1, 1, 1); PG8_SCHED; PG8_LDA(At, 1, 0); PG8_STAGE(PG8_SA(0, 1), a2 + hstep, voffA);
        PG8_WAIT_V(8); PG8_WAIT_L(0); PG8_BAR; PG8_MMA(0, 0, At, B0); PG8_MMA(0, 1, At, B1); PG8_BAR; PG8_SCHED;
        PG8_LDA(At, 1, 1); PG8_STAGE(PG8_SB(1, 0), b3, voffB); PG8_STAGE(PG8_SB(1, 1), b3 + hstep, voffB); PG8_STAGE(PG8_SA(1, 0), a3, voffA);
        PG8_WAIT_V(8); PG8_WAIT_L(0); PG8_BAR; PG8_MMA(1, 0, At, B0); PG8_MMA(1, 1, At, B1); PG8_BAR; PG8_SCHED;
      } else {
        PG8_LDB(B0, 0, 0); PG8_SCHED; PG8_LDA(At, 0, 0); PG8_STAGE(PG8_SA(1, 1), a1 + hstep, voffA);
        PG8_WAIT_L(8); PG8_BAR; PG8_WAIT_L(0); PG8_MMA(0, 0, At, B0); PG8_BAR; PG8_SCHED;
        PG8_LDB(B1, 0, 1); PG8_STAGE(PG8_SB(0, 0), b2, voffB);
        PG8_BAR; PG8_WAIT_L(0); PG8_MMA(0, 1, At, B1); PG8_BAR;
        PG8_LDA(At, 0, 1); PG8_STAGE(PG8_SA(0, 0), a2, voffA);
        PG8_BAR; PG8_WAIT_L(0); PG8_MMA(1, 0, At, B0); PG8_BAR; PG8_SCHED;
        PG8_STAGE(PG8_SB(0, 1), b2 + hstep, voffB);
        PG8_WAIT_V(6); PG8_BAR; PG8_MMA(1, 1, At, B1); PG8_BAR;
        PG8_LDB(B0, 1, 0); PG8_SCHED; PG8_LDA(At, 1, 0); PG8_STAGE(PG8_SA(0, 1), a2 + hstep, voffA);
        PG8_WAIT_L(8); PG8_BAR; PG8_WAIT_L(0); PG8_MMA(0, 0, At, B0); PG8_BAR; PG8_SCHED;
        PG8_LDB(B1, 1, 1); PG8_STAGE(PG8_SB(1, 0), b3, voffB);
        PG8_BAR; PG8_WAIT_L(0); PG8_MMA(0, 1, At, B1); PG8_BAR;
        PG8_LDA(At, 1, 1); PG8_STAGE(PG8_SA(1, 0), a3, voffA);
        PG8_BAR; PG8_WAIT_L(0); PG8_MMA(1, 0, At, B0); PG8_BAR; PG8_SCHED;
        PG8_STAGE(PG8_SB(1, 1), b3 + hstep, voffB);
        PG8_WAIT_V(6); PG8_BAR; PG8_MMA(1, 1, At, B1); PG8_BAR;
      }
    }
    if constexpr (ALIGN_EPI) { if (wr == 0) PG8_BAR; }
    if constexpr (!Epi::AFTER_DRAIN) { E(acc, cur, wr, wc, fr, fq); S.done(cur); }
    if (!has_next) break;
#pragma unroll
    for (int a = 0; a < 2; ++a)
#pragma unroll
      for (int b = 0; b < 2; ++b)
#pragma unroll
        for (int m = 0; m < 4; ++m)
#pragma unroll
          for (int n = 0; n < 2; ++n) acc[a][b][m][n] = (f32x4){0.f, 0.f, 0.f, 0.f};
    cur = nxt; cA = nA; cB = nB; ++ui;
    if constexpr (ALIGN_EPI) { if (wr == 1) PG8_BAR; }
  }
  PG8_WAIT_V(0);
  if constexpr (!ALIGN_EPI) { if (wr == 0) PG8_BAR; }
  PG8_BAR;
#undef PG8_SA
#undef PG8_SB
#undef PG8_STAGE
#undef PG8_LDA
#undef PG8_LDB
#undef PG8_MMA
#undef PG8_WAIT_V
#undef PG8_WAIT_L
#undef PG8_BAR
#undef PG8_SCHED
}
}

typedef float f32x16 __attribute__((ext_vector_type(16)));
typedef float f32x8 __attribute__((ext_vector_type(8)));
typedef short s16x4 __attribute__((ext_vector_type(4)));
typedef __bf16 bfx8 __attribute__((ext_vector_type(8)));
#define MFMA32(a, b, c) __builtin_amdgcn_mfma_f32_32x32x16_bf16((a), (b), (c), 0, 0, 0)
__device__ __forceinline__ bf16x8 cvt8(f32x8 t) { return __builtin_bit_cast(bf16x8, __builtin_convertvector(t, bfx8)); }
__device__ __forceinline__ bf16x8 pack8(const f32x16& x, int s) {
  const f32x8 t = {x[8 * s], x[8 * s + 1], x[8 * s + 2], x[8 * s + 3], x[8 * s + 4], x[8 * s + 5], x[8 * s + 6], x[8 * s + 7]};
  return cvt8(t);
}
__device__ __forceinline__ f32x16 zero16() { f32x16 z; for (int i = 0; i < 16; ++i) z[i] = 0.f; return z; }
__device__ __forceinline__ unsigned off_b(unsigned row, unsigned ch) { return 256u * row + 16u * (ch ^ (((row & 3u) << 2) | ((row >> 2) & 3u))); }
__device__ __forceinline__ int swap12(int p) { return ((p & 1) << 1) | (p >> 1); }
__device__ __forceinline__ bf16x8 lds_rd128(LAS unsigned char* lds, unsigned off) { return *(const LAS bf16x8*)(lds + off); }
__device__ __forceinline__ bf16x8 lds_tr2(LAS unsigned char* lds, unsigned off_lo, unsigned off_hi) {
  const s16x4 lo = __builtin_amdgcn_ds_read_tr16_b64_v4i16((LAS s16x4*)(lds + off_lo));
  const s16x4 hi = __builtin_amdgcn_ds_read_tr16_b64_v4i16((LAS s16x4*)(lds + off_hi));
  return __builtin_shufflevector(lo, hi, 0, 1, 2, 3, 4, 5, 6, 7);
}
__device__ __forceinline__ void glds16(const void* g, LAS unsigned char* l) {
  unsigned keep; const unsigned dst = __builtin_amdgcn_readfirstlane((unsigned)(size_t)l);
  asm volatile("s_mov_b32 %0, m0\n\ts_mov_b32 m0, %2\n\ts_nop 0\n\tglobal_load_lds_dwordx4 %1, off\n\ts_mov_b32 m0, %0" : "=&s"(keep) : "v"(g), "s"(dst) : "memory");
}
__device__ __forceinline__ unsigned rowfrag_off(int lane, int mt, int ks) { return off_b(32 * mt + (lane & 31), 2 * ks + (lane >> 5)); }
__device__ __forceinline__ unsigned vtr_off(int lane, int cb, int ks, int sec) {
  const int g = lane >> 4, i = lane & 15, hh = g >> 1, half16 = g & 1, qq = i >> 2, p = i & 3;
  const int row = 16 * ks + 4 * hh + 8 * sec + qq, col = cb + 16 * half16 + 4 * p;
  return off_b(row, col >> 3) + (col & 7) * 2;
}
__device__ __forceinline__ unsigned ktr_off(int lane, int mt, int ks, int sec) {
  const int g = lane >> 4, i = lane & 15, hh = g >> 1, half16 = g & 1, qq = i >> 2, p = i & 3;
  const int row = 16 * ks + 4 * hh + 8 * sec + qq, col = 32 * mt + 16 * half16 + 4 * swap12(p);
  return off_b(row, col >> 3) + (col & 7) * 2;
}
__device__ __forceinline__ int crow(int reg, int h) { return (reg & 3) + 8 * (reg >> 2) + 4 * h; }
__device__ __forceinline__ int srow(int reg, int h) { return 16 * (reg >> 3) + 8 * h + 4 * ((reg >> 2) & 1) + (reg & 3); }
__device__ __forceinline__ void rowscale(f32x16& a, const LAS float* vec, int h, float sgn) {
#pragma unroll
  for (int g4 = 0; g4 < 4; ++g4) { const f32x4 s = *(const LAS f32x4*)(vec + 8 * g4 + 4 * h);
    a[4 * g4] *= s.x * sgn; a[4 * g4 + 1] *= s.y * sgn; a[4 * g4 + 2] *= s.z * sgn; a[4 * g4 + 3] *= s.w * sgn; }
}
__device__ __forceinline__ void rowscale_pre(f32x16& a, const f32x4 (&s)[4], float sgn) {
#pragma unroll
  for (int g4 = 0; g4 < 4; ++g4) { a[4 * g4] *= s[g4].x * sgn; a[4 * g4 + 1] *= s[g4].y * sgn; a[4 * g4 + 2] *= s[g4].z * sgn; a[4 * g4 + 3] *= s[g4].w * sgn; }
}
__device__ __forceinline__ void stage_img_piece(const unsigned char* src, size_t pitch, LAS unsigned char* img, int pc, int lane) {
  const unsigned row = 4 * pc + (lane >> 4), chp = lane & 15, ch = chp ^ (((row & 3u) << 2) | ((row >> 2) & 3u));
  glds16(src + (size_t)row * pitch + ch * 16, img + 1024 * pc);
}
constexpr int SC_BUF = 66560, SC_Q = 0, SC_K = 16384, SC_M = 32768, SC_V = 50176, SC_VEC = 2 * SC_BUF;
constexpr int DN_BLOB = 17408, RT_BLOB = 8192;
__device__ __forceinline__ void glds16_s(const unsigned char* base_uniform, unsigned voff, LAS unsigned char* l) {
  unsigned keep; const unsigned dst = __builtin_amdgcn_readfirstlane((unsigned)(size_t)l);
  const unsigned long long b = (unsigned long long)(size_t)base_uniform;
  const unsigned long long bs = ((unsigned long long)(unsigned)__builtin_amdgcn_readfirstlane((unsigned)(b >> 32)) << 32) | (unsigned)__builtin_amdgcn_readfirstlane((unsigned)b);
  asm volatile("s_mov_b32 %0, m0\n\ts_mov_b32 m0, %3\n\ts_nop 0\n\tglobal_load_lds_dwordx4 %1, %2\n\ts_mov_b32 m0, %0" : "=&s"(keep) : "v"(voff), "s"(bs), "s"(dst) : "memory");
}
struct StageOff { unsigned q[2], k[2], m; };
__device__ __forceinline__ StageOff scan_stage_offsets(int w, int lane, unsigned kpitch) {
  StageOff o;
#pragma unroll
  for (int i = 0; i < 2; ++i) { const unsigned pc = w + 8 * i, row = 4 * pc + (lane >> 4), chp = lane & 15, ch = chp ^ (((row & 3u) << 2) | ((row >> 2) & 3u));
    o.q[i] = row * (unsigned)(LDQ * 2) + ch * 16; o.k[i] = row * kpitch + ch * 16; }
  o.m = lane * 16;
  return o;
}
__device__ __forceinline__ void scan_stage(LAS unsigned char* lds, int buf, int type, int dir, int h, int gc, const bf16_t* QKV, const bf16_t* KBUF,
                                           const unsigned char* MATS_RT, const unsigned char* MATS_DN, int half, int w, const StageOff& so) {
  const size_t row0 = (size_t)gc * 64;
  const unsigned char* rowp = (const unsigned char*)(QKV + row0 * LDQ);
  const unsigned char* qsrc = rowp + (type ? Q_DQ + h * DK : Q_RQ + h * DK) * 2;
  const unsigned char* ksrc = rowp + (type ? Q_DK + h * DK : Q_RK + h * DK) * 2;
  if (!type && dir) ksrc = (const unsigned char*)(KBUF + row0 * 512 + h * DK);
  const unsigned char* vsrc = rowp + (type ? Q_DV + h * DV : Q_RV + h * DV) * 2 + half * 256;
  LAS unsigned char* B = lds + buf * SC_BUF;
#pragma unroll
  for (int i = 0; i < 2; ++i) { const int pc = w + 8 * i;
    glds16_s(qsrc, so.q[i], B + SC_Q + 1024 * pc); glds16_s(ksrc, so.k[i], B + SC_K + 1024 * pc); glds16_s(vsrc, so.q[i], B + SC_V + 1024 * pc); }
  const unsigned char* blob = type ? MATS_DN + (size_t)((gc * 4 + h) * 2 + dir) * DN_BLOB : MATS_RT + (size_t)((gc * 4 + h) * 2 + dir) * RT_BLOB;
  const int np = type ? 17 : 8;
  for (int pc = w; pc < np; pc += 8) glds16_s(blob + pc * 1024, so.m, B + SC_M + pc * 1024);
}

__device__ __forceinline__ void transpose_item(const float* W, int ldw, int K, int src_col0, bf16_t* WT, int dst_row0, int k0, LAS float* scr, int lane) {
  float wv[32];
#pragma unroll
  for (int i = 0; i < 32; ++i) { const int kk = 2 * i + (lane >> 5); wv[i] = __builtin_nontemporal_load(&W[(size_t)(k0 + kk) * ldw + src_col0 + (lane & 31)]); }
#pragma unroll
  for (int i = 0; i < 32; ++i) { const int kk = 2 * i + (lane >> 5); scr[kk * 33 + (lane & 31)] = wv[i]; }
  asm volatile("s_waitcnt lgkmcnt(0)" ::: "memory");
  const int c = lane & 7;
#pragma unroll
  for (int j = 0; j < 4; ++j) { const int n = (lane >> 3) + 8 * j; const LAS float* s = scr + (8 * c) * 33 + n;
    u32x4 o; o.x = pk2(s[0 * 33], s[1 * 33]); o.y = pk2(s[2 * 33], s[3 * 33]); o.z = pk2(s[4 * 33], s[5 * 33]); o.w = pk2(s[6 * 33], s[7 * 33]);
    *(u32x4*)(WT + (size_t)(dst_row0 + n) * K + k0 + 8 * c) = o; }
  asm volatile("s_waitcnt lgkmcnt(0)" ::: "memory");
}

template <class ItemFn> __device__ __forceinline__ void transpose_stream(int first, int stride, int items, ItemFn P, LAS float* scr, int lane) {
  float wv[32];
  const float* W; int ldw, K, sc0, dr0, k0; bf16_t* WT;
  if (first < items) { P(first, W, ldw, K, sc0, WT, dr0, k0);
#pragma unroll
    for (int i = 0; i < 32; ++i) { const int kk = 2 * i + (lane >> 5); wv[i] = __builtin_nontemporal_load(&W[(size_t)(k0 + kk) * ldw + sc0 + (lane & 31)]); } }
  for (int it = first; it < items; it += stride) {
    bf16_t* WTc = WT; const int Kc = K, drc = dr0, k0c = k0;
#pragma unroll
    for (int i = 0; i < 32; ++i) { const int kk = 2 * i + (lane >> 5); scr[kk * 33 + (lane & 31)] = wv[i]; }
    if (it + stride < items) { P(it + stride, W, ldw, K, sc0, WT, dr0, k0);
#pragma unroll
      for (int i = 0; i < 32; ++i) { const int kk = 2 * i + (lane >> 5); wv[i] = __builtin_nontemporal_load(&W[(size_t)(k0 + kk) * ldw + sc0 + (lane & 31)]); } }
    asm volatile("s_waitcnt lgkmcnt(0)" ::: "memory");
    const int c = lane & 7;
#pragma unroll
    for (int j = 0; j < 4; ++j) { const int n = (lane >> 3) + 8 * j; const LAS float* s = scr + (8 * c) * 33 + n;
      u32x4 o; o.x = pk2(s[0 * 33], s[1 * 33]); o.y = pk2(s[2 * 33], s[3 * 33]); o.z = pk2(s[4 * 33], s[5 * 33]); o.w = pk2(s[6 * 33], s[7 * 33]);
      *(u32x4*)(WTc + (size_t)(drc + n) * Kc + k0c + 8 * c) = o; }
    asm volatile("s_waitcnt lgkmcnt(0)" ::: "memory");
  }
}
template <class ColMap> __device__ __forceinline__ void transpose_matrix(const float* W, int ldw, int K, int N, bf16_t* WT, ColMap cm, LAS float* scr, int gw, int ngw, int lane) {
  const int nblk = N / 32, items = (K / 64) * nblk;
  transpose_stream(gw, ngw, items, [&](int it, const float*& W_, int& ldw_, int& K_, int& sc0_, bf16_t*& WT_, int& dr0_, int& k0_) {
    const int kb = it / nblk, nb = it % nblk; W_ = W; ldw_ = ldw; K_ = K; sc0_ = cm(32 * nb); WT_ = WT; dr0_ = 32 * nb; k0_ = 64 * kb; }, scr, lane);
}


__device__ __forceinline__ void late_weight_conversions(const Params& p, bf16_t* WGATE, bf16_t* WRO, bf16_t* WDO, bf16_t* WOUT, bf16_t* WF1, bf16_t* WF2, LAS float* scr, int gw2, int ngw2, int lane) {
  transpose_matrix(p.in[I_WIN], INC, D, 4096, WGATE, [](int n) { return n < 1024 ? C_RG + n : (n < 2048 ? C_DZ + (n - 1024) : C_GR + (n - 2048)); }, scr, gw2, ngw2, lane);
  transpose_matrix(p.in[I_WRO], D, D, D, WRO, [](int n) { return n; }, scr, gw2, ngw2, lane);
  transpose_matrix(p.in[I_WDO], D, D, D, WDO, [](int n) { return n; }, scr, gw2, ngw2, lane);
  transpose_matrix(p.in[I_WOUT], D, D, D, WOUT, [](int n) { return n; }, scr, gw2, ngw2, lane);
  transpose_matrix(p.in[I_WF1], 2 * DFF, D, 2 * DFF, WF1, [](int n) { const int pn = n >> 8, w = n & 255; return w < 128 ? 128 * pn + w : DFF + 128 * pn + (w - 128); }, scr, gw2, ngw2, lane);
  transpose_matrix(p.in[I_WF2], D, DFF, D, WF2, [](int n) { return n; }, scr, gw2, ngw2, lane);
}

__global__ void __launch_bounds__(NTHREADS) fwd_megakernel(Params p) {
  extern __shared__ __attribute__((aligned(16))) unsigned char lds_raw[];
  LAS unsigned char* lds = (LAS unsigned char*)lds_raw;
  cg::grid_group grid = cg::this_grid();
  volatile LAS unsigned* bar_st = (volatile LAS unsigned*)(lds + LDS_BYTES - 64);
  if (threadIdx.x < 2) bar_st[threadIdx.x] = 0u;
  __syncthreads();
  const XcdBarrier xbar = xcd_barrier_post((unsigned*)(p.ws + WS_BAR), bar_st);
  if (p.ws == nullptr) grid.sync();
#define GRID_BARRIER() xcd_barrier(xbar, wave)
  const int wave = __builtin_amdgcn_readfirstlane(threadIdx.x >> 6);
#define PHASE_TID() int lane_p = lane_id(); asm volatile("" : "+v"(lane_p)); const int lane = lane_p, tid = (wave << 6) | lane; (void)tid;
  const int G = gridDim.x, bid = blockIdx.x;
  const int gw = bid * NWAVES + wave, ngw = G * NWAVES;
  unsigned char* ws = p.ws;
  float* MOD = (float*)(ws + WS_MOD);
  f32x2* ROPE = (f32x2*)(ws + WS_ROPE);
  float* BA = (float*)(ws + WS_BA);
  float* DECLG = (float*)(ws + WS_MOD + 122880);
  bf16_t* WQKV = (bf16_t*)(ws + WS_WQKV); bf16_t* WGATE = (bf16_t*)(ws + WS_WGATE);
  bf16_t* WRO = (bf16_t*)(ws + WS_WRO); bf16_t* WDO = (bf16_t*)(ws + WS_WDO); bf16_t* WOUT = (bf16_t*)(ws + WS_WOUT);
  bf16_t* HB = (bf16_t*)(ws + WS_H);
  bf16_t* QKV = (bf16_t*)(ws + WS_QKV);
  bf16_t* KBUF = (bf16_t*)(ws + WS_KB); bf16_t* HALO = (bf16_t*)(ws + WS_HALO);
  unsigned char* MATS_RT = ws + WS_MATS_RT; unsigned char* MATS_DN = ws + WS_MATS_DN;
  unsigned char* LSCR = ws + WS_O; constexpr int LSCR_STRIDE = 16896;
  bf16_t* ODF = (bf16_t*)(ws + WS_O); bf16_t* ODB = ODF + (size_t)MTOT * D;
  bf16_t* ORF = (bf16_t*)p.out; bf16_t* ORB = ORF + (size_t)MTOT * D;
  float* NS_RET = p.out + (size_t)MTOT * D; float* NS_DN = NS_RET + (size_t)NCTX * 2 * NH * DK * DV;

  {
    PHASE_TID();
    LAS float* scr = (LAS float*)(lds + wave * 16384);
    transpose_matrix(p.in[I_WIN], INC, D, 4096, WQKV, [](int n) { return n < 2048 ? n : n + 1024; }, scr, gw, ngw, lane);
    const bool LATE_CONV = G > 128;
    bf16_t* WF1 = (bf16_t*)(ws + WS_WF1); bf16_t* WF2 = (bf16_t*)(ws + WS_WF2);
    if (!LATE_CONV) late_weight_conversions(p, WGATE, WRO, WDO, WOUT, WF1, WF2, scr, gw, ngw, lane);
    {
      __syncthreads();
      LAS float* scond = (LAS float*)lds;
      LAS float* red = scond + 5 * D;
      for (int i = tid; i < 5 * D; i += NTHREADS) { const int c = i >> 10, k = i & 1023; scond[i] = siluf(c == 0 ? p.in[I_CCTX][k] : p.in[I_C][(c - 1) * D + k]); }
      __syncthreads();
      for (int it = bid; it < 6 * D / 32; it += G) {
        const int col = it * 32 + (lane & 31), rpar = lane >> 5;
        float acc[5] = {0.f, 0.f, 0.f, 0.f, 0.f};
        const float* wm = p.in[I_WMOD] + (size_t)(128 * wave + rpar) * 6 * D + col;
#pragma unroll 16
        for (int i = 0; i < 64; ++i) { const float wv = __builtin_nontemporal_load(&wm[(size_t)(2 * i) * 6 * D]); const int k = 128 * wave + 2 * i + rpar;
#pragma unroll
          for (int c = 0; c < 5; ++c) acc[c] += scond[c * D + k] * wv; }
#pragma unroll
        for (int c = 0; c < 5; ++c) { acc[c] += __shfl_xor(acc[c], 32); if (lane < 32) red[(wave * 5 + c) * 32 + lane] = acc[c]; }
        __syncthreads();
        if (tid < 160) { const int c = tid >> 5, n = tid & 31; float s = 0.f;
#pragma unroll
          for (int ww = 0; ww < 8; ++ww) s += red[(ww * 5 + c) * 32 + n];
          MOD[c * 6 * D + it * 32 + n] = s + p.in[I_BMOD][it * 32 + n]; }
        __syncthreads();
      }
    }
    for (int i = bid * NTHREADS + tid; i < LLAT * 64; i += G * NTHREADS) { const int l = i >> 6, pr = i & 63;
      const float freq = powf(10000.f, -(float)(pr & 31) / 32.f); const float ang = (pr < 32 ? (float)(l >> 6) : (float)(l & 63)) * freq;
      ROPE[i] = (f32x2){cosf(ang), sinf(ang)}; }
    if (bid == 0 && tid < 8) DECLG[tid] = -softplusf(-p.in[I_DECAY][tid]);
  }
  GRID_BARRIER();

  {
    PHASE_TID();
    LAS float* wba = (LAS float*)lds;
    for (int i = tid; i < D * 16; i += NTHREADS) wba[(i & 15) * 1028 + (i >> 4)] = p.in[I_WIN][(size_t)(i >> 4) * INC + C_DB + (i & 15)];
    __syncthreads();
    const float* nw = p.in[I_NORMW];
    const float neg_ea = -expf(p.in[I_ALOG][(lane >> 2) & 7]), dtb = p.in[I_DTB][(lane >> 2) & 7];
    f32x4 xn[4];
    if (gw < MTOT) { const float* xr0 = xrow(p, gw);
#pragma unroll
      for (int j = 0; j < 4; ++j) xn[j] = __builtin_nontemporal_load((const f32x4*)(xr0 + 4 * lane + 256 * j)); }
    for (int m = gw; m < MTOT; m += ngw) {
      const float* md = MOD + (size_t)cond_of_row(m) * 6 * D;
      f32x4 x4[4], w4[4], sc4[4], sh4[4]; float s = 0.f;
#pragma unroll
      for (int j = 0; j < 4; ++j) x4[j] = xn[j];
#pragma unroll
      for (int j = 0; j < 4; ++j) { const int c0 = 4 * lane + 256 * j; w4[j] = *(const f32x4*)(nw + c0); sc4[j] = *(const f32x4*)(md + D + c0); sh4[j] = *(const f32x4*)(md + c0); }
      __builtin_amdgcn_sched_barrier(0);
      { const int mn = m + ngw < MTOT ? m + ngw : m; const float* xr1 = xrow(p, mn);
#pragma unroll
        for (int j = 0; j < 4; ++j) xn[j] = __builtin_nontemporal_load((const f32x4*)(xr1 + 4 * lane + 256 * j)); }
      __builtin_amdgcn_sched_barrier(0);
#pragma unroll
      for (int j = 0; j < 4; ++j) s += (x4[j].x * x4[j].x + x4[j].y * x4[j].y) + (x4[j].z * x4[j].z + x4[j].w * x4[j].w);
      const float r = rsqrtf(wave_sum(s) * (1.f / D) + EPS);
      float dots[16];
#pragma unroll
      for (int n = 0; n < 16; ++n) dots[n] = 0.f;
#pragma unroll
      for (int j = 0; j < 4; ++j) { const int c0 = 4 * lane + 256 * j;
        const f32x4 h = x4[j] * r * w4[j] * (sc4[j] + 1.f) + sh4[j];
        u32x2 o; o.x = pk2(h.x, h.y); o.y = pk2(h.z, h.w);
        *(u32x2*)(HB + (size_t)m * D + c0) = o;
        { f32x4 wv[16];
#pragma unroll
          for (int n = 0; n < 16; ++n) wv[n] = *(const LAS f32x4*)(wba + n * 1028 + c0);
          __builtin_amdgcn_sched_barrier(0);
#pragma unroll
          for (int n = 0; n < 16; ++n) dots[n] += (h.x * wv[n].x + h.y * wv[n].y) + (h.z * wv[n].z + h.w * wv[n].w);
          __builtin_amdgcn_sched_barrier(0);
        }
      }
#pragma unroll
      for (int i = 0; i < 8; ++i) { const bool up = lane & 32; const float snd = up ? dots[i] : dots[i + 8], kp = up ? dots[i + 8] : dots[i]; dots[i] = kp + __shfl_xor(snd, 32); }
#pragma unroll
      for (int i = 0; i < 4; ++i) { const bool up = lane & 16; const float snd = up ? dots[i] : dots[i + 4], kp = up ? dots[i + 4] : dots[i]; dots[i] = kp + __shfl_xor(snd, 16); }
#pragma unroll
      for (int i = 0; i < 2; ++i) { const bool up = lane & 8; const float snd = up ? dots[i] : dots[i + 2], kp = up ? dots[i + 2] : dots[i]; dots[i] = kp + __shfl_xor(snd, 8); }
      { const bool up = lane & 4; const float snd = up ? dots[0] : dots[1], kp = up ? dots[1] : dots[0]; dots[0] = kp + __shfl_xor(snd, 4); }
      dots[0] += __shfl_xor(dots[0], 2); dots[0] += __shfl_xor(dots[0], 1);
      if ((lane & 3) == 0) { const int n = lane >> 2; const float d = dots[0];
        BA[(size_t)m * 16 + n] = n < 8 ? sigmf(d) : neg_ea * softplusf(d + dtb); }
    }
  }
  GRID_BARRIER();

  {
    pg8::Gemm g{HB, WQKV, MTOT, 4096, D}; pg8::StaticOrder S; S.init(MTOT, 4096, G, bid);
    pg8::EpiQKV E{QKV, LDQ, HALO};
    pg8::gemm_phase<pg8::EpiQKV, pg8::StaticOrder, true, true>(lds, g, S, E, wave);
  }
  GRID_BARRIER();

  {
    PHASE_TID();
    constexpr int PI_RQ = 0, PI_RK = 16384, PI_DQ = 32768, PI_DK = 49152;
    constexpr int PM_QKR = 65536, PM_QKD = PM_QKR + 17408, PM_KKD = PM_QKD + 17408;
    constexpr int PV = PM_KKD + 17408;
    constexpr int PL_F = 0, PL_B = 17408, PT_F = 34816, PT_B = 52224;
    const int w = wave;
    const float* cw = p.in[I_CONVW];
    u32x4 qraw[2], kraw[2], rawa[2][2][3], rawb[4][3]; float ba4[4] = {0.f, 0.f, 0.f, 0.f};
#define P2_LOADS(ITEM, TID) do { const int gc_ = (ITEM) >> 2, h_ = (ITEM) & 3, row0_ = gc_ * 64; const bool lat_ = row0_ >= MCTX; \
      const int L_ = lat_ ? LLAT : LCTX, t0_ = lat_ ? ((row0_ - MCTX) & (LLAT - 1)) : (row0_ & (LCTX - 1)); \
      const size_t s1m_ = (size_t)row0_ + ((TID) >> 3); \
      _Pragma("unroll") for (int c = 0; c < 2; ++c) { const int ch = ((TID) & 7) * 2 + c; \
        qraw[c] = *(const u32x4*)(QKV + s1m_ * LDQ + Q_RQ + h_ * DK + ch * 8); kraw[c] = *(const u32x4*)(QKV + s1m_ * LDQ + Q_RK + h_ * DK + ch * 8); } \
      _Pragma("unroll") for (int ps = 0; ps < 2; ++ps) _Pragma("unroll") for (int wh = 0; wh < 2; ++wh) _Pragma("unroll") for (int wd = 0; wd < 3; ++wd) { \
          const int row = ((TID) >> 4) + 32 * ps, rr = row + wd - 1, t = t0_ + rr; const int dch = wh * 512 + h_ * DK + ((TID) & 15) * 8; \
          u32x4 x = (u32x4){0u, 0u, 0u, 0u}; \
          if (t >= 0 && t < L_) { \
            if (rr < 0) x = *(const u32x4*)(HALO + ((size_t)(gc_ - 1) * 2 + 1) * 2048 + dch); \
            else if (rr > 63) x = *(const u32x4*)(HALO + ((size_t)(gc_ + 1) * 2 + 0) * 2048 + dch); \
            else x = *(const u32x4*)(QKV + (size_t)(row0_ + rr) * LDQ + Q_DQ + dch); } \
          rawa[ps][wh][wd] = x; } \
      _Pragma("unroll") for (int n = 0; n < 4; ++n) _Pragma("unroll") for (int wd = 0; wd < 3; ++wd) { \
          const int idx = (TID) + 512 * n, row = idx >> 5, ch = idx & 31, rr = row + wd - 1, t = t0_ + rr; const int dch = 1024 + h_ * DV + ch * 8; \
          u32x4 x = (u32x4){0u, 0u, 0u, 0u}; \
          if (t >= 0 && t < L_) { \
            if (rr < 0) x = *(const u32x4*)(HALO + ((size_t)(gc_ - 1) * 2 + 1) * 2048 + dch); \
            else if (rr > 63) x = *(const u32x4*)(HALO + ((size_t)(gc_ + 1) * 2 + 0) * 2048 + dch); \
            else x = *(const u32x4*)(QKV + (size_t)(row0_ + rr) * LDQ + Q_DQ + dch); } \
          rawb[n][wd] = x; } \
      if ((TID) < 64) { const float* ba = BA + (size_t)(row0_ + (TID)) * 16; ba4[0] = ba[h_]; ba4[1] = ba[4 + h_]; ba4[2] = ba[8 + h_]; ba4[3] = ba[12 + h_]; } } while (0)
    if (bid < 768) { int lane_q = lane_id(); asm volatile("" : "+v"(lane_q)); const int tid_q = (wave << 6) | lane_q; P2_LOADS(bid, tid_q); }
    for (int item = bid; item < 768; item += G) {
      int lane_o = lane_id(); asm volatile("" : "+v"(lane_o));
      const int lane = lane_o, tid = (wave << 6) | lane, r32 = lane & 31, hl = lane >> 5;
      const int gc = item >> 2, h = item & 3, row0 = gc * 64; const bool lat = row0 >= MCTX;
      const int t0 = lat ? ((row0 - MCTX) & (LLAT - 1)) : (row0 & (LCTX - 1));
      const float lgf = DECLG[h], lgb = DECLG[4 + h];
      const int s1row = tid >> 3; const size_t s1m = (size_t)row0 + s1row;
      const int ach = tid & 15;
      asm volatile("s_waitcnt vmcnt(0)" ::: "memory");
      __syncthreads();
      const float ba_bf = ba4[0], ba_bb = ba4[1], ba_af = ba4[2], ba_ab = ba4[3];
      {
        const int row = s1row; const size_t m = s1m;
        const float kfs = __expf(lgf * (float)(63 - row)), kbs = __expf(lgb * (float)row);
#pragma unroll
        for (int c = 0; c < 2; ++c) { const int ch = (tid & 7) * 2 + c;
          bf16_t* qp = QKV + m * LDQ + Q_RQ + h * DK + ch * 8; bf16_t* kp = QKV + m * LDQ + Q_RK + h * DK + ch * 8;
          const u32x4 qw = qraw[c], kw = kraw[c];
          float q[8] = {lo_bf(qw.x), hi_bf(qw.x), lo_bf(qw.y), hi_bf(qw.y), lo_bf(qw.z), hi_bf(qw.z), lo_bf(qw.w), hi_bf(qw.w)};
          float k[8] = {lo_bf(kw.x), hi_bf(kw.x), lo_bf(kw.y), hi_bf(kw.y), lo_bf(kw.z), hi_bf(kw.z), lo_bf(kw.w), hi_bf(kw.w)};
#pragma unroll
          for (int e = 0; e < 8; ++e) q[e] *= QSCALE;
          if (lat) {
#pragma unroll
            for (int e = 0; e < 4; ++e) { const f32x2 cs = ROPE[(t0 + row) * 64 + ch * 4 + e];
              const float a = q[2 * e] * cs.x - q[2 * e + 1] * cs.y, b = q[2 * e] * cs.y + q[2 * e + 1] * cs.x; q[2 * e] = a; q[2 * e + 1] = b;
              const float c2 = k[2 * e] * cs.x - k[2 * e + 1] * cs.y, d2 = k[2 * e] * cs.y + k[2 * e + 1] * cs.x; k[2 * e] = c2; k[2 * e + 1] = d2; }
          }
          u32x4 o; o.x = pk2(q[0], q[1]); o.y = pk2(q[2], q[3]); o.z = pk2(q[4], q[5]); o.w = pk2(q[6], q[7]);
          *(u32x4*)qp = o; *(LAS u32x4*)(lds + PI_RQ + off_b(row, ch)) = o;
          o.x = pk2(k[0], k[1]); o.y = pk2(k[2], k[3]); o.z = pk2(k[4], k[5]); o.w = pk2(k[6], k[7]);
          *(LAS u32x4*)(lds + PI_RK + off_b(row, ch)) = o;
          o.x = pk2(k[0] * kfs, k[1] * kfs); o.y = pk2(k[2] * kfs, k[3] * kfs); o.z = pk2(k[4] * kfs, k[5] * kfs); o.w = pk2(k[6] * kfs, k[7] * kfs);
          *(u32x4*)kp = o;
          o.x = pk2(k[0] * kbs, k[1] * kbs); o.y = pk2(k[2] * kbs, k[3] * kbs); o.z = pk2(k[4] * kbs, k[5] * kbs); o.w = pk2(k[6] * kbs, k[7] * kbs);
          *(u32x4*)(KBUF + m * 512 + h * DK + ch * 8) = o;
        }
      }
      {
        const int ch = ach;
#pragma unroll
        for (int ps = 0; ps < 2; ++ps)
#pragma unroll
          for (int wh = 0; wh < 2; ++wh) { const int row = (tid >> 4) + 32 * ps; const int dch = wh * 512 + h * DK + ch * 8;
            float a[8] = {0.f, 0.f, 0.f, 0.f, 0.f, 0.f, 0.f, 0.f};
#pragma unroll
            for (int wd = 0; wd < 3; ++wd) { const u32x4 x = rawa[ps][wh][wd]; const f32x4 w0 = *(const f32x4*)(cw + wd * 2048 + dch), w1 = *(const f32x4*)(cw + wd * 2048 + dch + 4);
              a[0] += lo_bf(x.x) * w0.x; a[1] += hi_bf(x.x) * w0.y; a[2] += lo_bf(x.y) * w0.z; a[3] += hi_bf(x.y) * w0.w;
              a[4] += lo_bf(x.z) * w1.x; a[5] += hi_bf(x.z) * w1.y; a[6] += lo_bf(x.w) * w1.z; a[7] += hi_bf(x.w) * w1.w; }
            float ss = 0.f;
#pragma unroll
            for (int e = 0; e < 8; ++e) { a[e] = siluf(a[e]); ss += a[e] * a[e]; }
            ss += __shfl_xor(ss, 1); ss += __shfl_xor(ss, 2); ss += __shfl_xor(ss, 4); ss += __shfl_xor(ss, 8);
            const float sc = rsqrtf(ss + EPS) * (wh == 0 ? QSCALE : 1.f);
            u32x4 o; o.x = pk2(a[0] * sc, a[1] * sc); o.y = pk2(a[2] * sc, a[3] * sc); o.z = pk2(a[4] * sc, a[5] * sc); o.w = pk2(a[6] * sc, a[7] * sc);
            *(u32x4*)(QKV + (size_t)(row0 + row) * LDQ + Q_DQ + dch) = o;
            *(LAS u32x4*)(lds + (wh ? PI_DK : PI_DQ) + off_b(row, ch)) = o; }
      }
      {
#pragma unroll
        for (int n = 0; n < 4; ++n) { const int idx = tid + 512 * n, row = idx >> 5, ch = idx & 31; const int dch = 1024 + h * DV + ch * 8;
          float a[8] = {0.f, 0.f, 0.f, 0.f, 0.f, 0.f, 0.f, 0.f};
#pragma unroll
          for (int wd = 0; wd < 3; ++wd) { const u32x4 x = rawb[n][wd]; const f32x4 w0 = *(const f32x4*)(cw + wd * 2048 + dch), w1 = *(const f32x4*)(cw + wd * 2048 + dch + 4);
            a[0] += lo_bf(x.x) * w0.x; a[1] += hi_bf(x.x) * w0.y; a[2] += lo_bf(x.y) * w0.z; a[3] += hi_bf(x.y) * w0.w;
            a[4] += lo_bf(x.z) * w1.x; a[5] += hi_bf(x.z) * w1.y; a[6] += lo_bf(x.w) * w1.z; a[7] += hi_bf(x.w) * w1.w; }
          u32x4 o; o.x = pk2(siluf(a[0]), siluf(a[1])); o.y = pk2(siluf(a[2]), siluf(a[3])); o.z = pk2(siluf(a[4]), siluf(a[5])); o.w = pk2(siluf(a[6]), siluf(a[7]));
          *(u32x4*)(QKV + (size_t)(row0 + row) * LDQ + Q_DQ + dch) = o; }
      }
      if (item + G < 768) P2_LOADS(item + G, tid);
      __syncthreads();
      {
        const int mi = (w >> 1) & 1, nj = w & 1;
        if (w < 4) {
          f32x16 a1 = zero16(), a2 = zero16();
#pragma unroll 2
          for (int ks = 0; ks < 8; ++ks) { a1 = MFMA32(lds_rd128(lds + PI_RQ, rowfrag_off(lane, mi, ks)), lds_rd128(lds + PI_RK, rowfrag_off(lane, nj, ks)), a1);
            a2 = MFMA32(lds_rd128(lds + PI_DQ, rowfrag_off(lane, mi, ks)), lds_rd128(lds + PI_DK, rowfrag_off(lane, nj, ks)), a2); }
          LAS float* m1 = (LAS float*)(lds + PM_QKR); LAS float* m2 = (LAS float*)(lds + PM_QKD);
#pragma unroll
          for (int reg = 0; reg < 16; ++reg) { const int o = (32 * mi + crow(reg, hl)) * 68 + 32 * nj + r32; m1[o] = a1[reg]; m2[o] = a2[reg]; }
        } else {
          f32x16 a1 = zero16();
#pragma unroll 2
          for (int ks = 0; ks < 8; ++ks) a1 = MFMA32(lds_rd128(lds + PI_DK, rowfrag_off(lane, mi, ks)), lds_rd128(lds + PI_DK, rowfrag_off(lane, nj, ks)), a1);
          LAS float* m1 = (LAS float*)(lds + PM_KKD);
#pragma unroll
          for (int reg = 0; reg < 16; ++reg) m1[(32 * mi + crow(reg, hl)) * 68 + 32 * nj + r32] = a1[reg];
        }
      }
      LAS float* vecs = (LAS float*)(lds + PV);
      if (tid < 64) {
        const float bf = ba_bf, bb = ba_bb, af = ba_af, ab = ba_ab;
        float xf = af, xb = ab;
#pragma unroll
        for (int o = 1; o < 64; o <<= 1) { const float yf = __shfl_up(xf, o), yb = __shfl_up(xb, o); if (lane >= o) { xf += yf; xb += yb; } }
        const float totf = __shfl(xf, 63), totb = __shfl(xb, 63);
        vecs[tid] = bf; vecs[64 + tid] = bb; vecs[128 + tid] = xf; vecs[192 + tid] = totb - xb + ab;
        if (tid == 0) { vecs[256] = totf; vecs[257] = totb; }
      }
      __syncthreads();
      unsigned char* blob_rt = MATS_RT + (size_t)((gc * 4 + h) * 2) * RT_BLOB; unsigned char* blob_dn = MATS_DN + (size_t)((gc * 4 + h) * 2) * DN_BLOB;
      const int lp = tid & 63, fi = tid >> 6, fmt = fi >> 2, fks = fi & 3, frow = 32 * fmt + (lp & 31), fhq = lp >> 5;
      {
        const LAS float* m1 = (const LAS float*)(lds + PM_QKR); const LAS float* m2 = (const LAS float*)(lds + PM_QKD);
        const float gfi = vecs[128 + frow], gbi = vecs[192 + frow];
        f32x8 pf, pb, df, db;
#pragma unroll
        for (int jj = 0; jj < 8; ++jj) { const int j = 16 * fks + 8 * (jj >> 2) + 4 * fhq + (jj & 3);
          const float x = m1[frow * 68 + j], y = m2[frow * 68 + j];
          pf[jj] = j <= frow ? x * __expf(lgf * (float)(frow - j)) : 0.f; pb[jj] = j >= frow ? x * __expf(lgb * (float)(j - frow)) : 0.f;
          df[jj] = j <= frow ? y * __expf(gfi - vecs[128 + j]) : 0.f; db[jj] = j >= frow ? y * __expf(gbi - vecs[192 + j]) : 0.f; }
        *(bf16x8*)(blob_rt + (fi * 64 + lp) * 16) = cvt8(pf); *(bf16x8*)(blob_rt + RT_BLOB + (fi * 64 + lp) * 16) = cvt8(pb);
        *(bf16x8*)(blob_dn + 8192 + (fi * 64 + lp) * 16) = cvt8(df); *(bf16x8*)(blob_dn + DN_BLOB + 8192 + (fi * 64 + lp) * 16) = cvt8(db);
        const LAS float* m3 = (const LAS float*)(lds + PM_KKD);
        float* lf = (float*)(LSCR + (size_t)((gc * 4 + h) * 2) * LSCR_STRIDE); float* lb = (float*)(LSCR + (size_t)((gc * 4 + h) * 2 + 1) * LSCR_STRIDE);
#pragma unroll
        for (int n = 0; n < 8; ++n) { const int e = tid + 512 * n, i = e >> 6, j = e & 63; const float kk = m3[i * 68 + j];
          lf[e] = j < i ? vecs[i] * kk * __expf(vecs[128 + i] - vecs[128 + j]) : 0.f;
          lb[e] = j > i ? vecs[64 + i] * kk * __expf(vecs[192 + i] - vecs[192 + j]) : 0.f; }
        if (tid < 64) { lf[4096 + tid] = vecs[tid]; lb[4096 + tid] = vecs[64 + tid]; }
        if (tid < 64) { const float gf = vecs[128 + tid], gb = vecs[192 + tid], glf = vecs[256], glb = vecs[257];
          float* vf = (float*)(blob_dn + 16384); float* vb = (float*)(blob_dn + DN_BLOB + 16384);
          vf[tid] = __expf(gf); vf[64 + tid] = __expf(glf - gf); vb[tid] = __expf(gb); vb[64 + tid] = __expf(glb - gb);
          if (tid == 0) { vf[128] = __expf(glf); vb[128] = __expf(glb); } }
      }
    }
  }
  asm volatile("s_waitcnt vmcnt(0)" ::: "memory");
  __syncthreads();

  {
    PHASE_TID();
    LAS unsigned short* tl = (LAS unsigned short*)(lds + wave * 16384);
    for (int sv = wave; bid + G * (sv >> 1) < 768; sv += NWAVES) {
      const int it = 2 * (bid + G * (sv >> 1)) + (sv & 1);
      int lane_o = lane_id(); asm volatile("" : "+v"(lane_o));
      const int ln = lane_o; const bool flip = it & 1; const int cl = flip ? 63 - ln : ln;
      const float* Lm = (const float*)(LSCR + (size_t)it * LSCR_STRIDE);
      f32x2 T2[32]; float Lr[64];
#pragma unroll
      for (int i = 0; i < 64; ++i) Lr[i] = Lm[(flip ? 63 - i : i) * 64 + cl];
      const float bc = Lm[4096 + cl];
      __builtin_amdgcn_sched_barrier(0);
#pragma unroll
      for (int i = 0; i < 64; ++i) {
        const float lrow = Lr[i];
        f32x2 acc = (f32x2){(ln == i) ? 1.f : 0.f, 0.f};
#pragma unroll
        for (int q = 0; 2 * q + 1 < i; ++q) {
          const f32x2 l2 = (f32x2){__int_as_float(__builtin_amdgcn_readlane(__float_as_int(lrow), 2 * q)), __int_as_float(__builtin_amdgcn_readlane(__float_as_int(lrow), 2 * q + 1))};
          acc -= l2 * T2[q]; }
        float t = acc.x + acc.y;
        if (i & 1) t -= __int_as_float(__builtin_amdgcn_readlane(__float_as_int(lrow), i - 1)) * T2[i >> 1].x;
        if (i & 1) T2[i >> 1].y = t; else T2[i >> 1].x = t;
        __builtin_amdgcn_sched_barrier(0);
      }
#pragma unroll
      for (int i = 0; i < 64; ++i) tl[(flip ? 63 - i : i) * 72 + cl] = (unsigned short)f2bf(((i & 1) ? T2[i >> 1].y : T2[i >> 1].x) * bc);
      asm volatile("s_waitcnt lgkmcnt(0)" ::: "memory");
      unsigned char* blob = MATS_DN + (size_t)it * DN_BLOB;
      const int frow = ln & 31, fhq = ln >> 5;
#pragma unroll
      for (int f = 0; f < 8; ++f) { const int mt = f >> 2, ks = f & 3;
        const LAS unsigned short* rp = tl + (32 * mt + frow) * 72 + 16 * ks + 4 * fhq;
        const u32x2 lo = *(const LAS u32x2*)rp, hi = *(const LAS u32x2*)(rp + 8);
        *(u32x4*)(blob + (f * 64 + ln) * 16) = (u32x4){lo.x, lo.y, hi.x, hi.y}; }
      asm volatile("s_waitcnt lgkmcnt(0)" ::: "memory");
    }
  }
  GRID_BARRIER();

  {
    PHASE_TID();
    const int w = wave, cb = (w & 3) * 32; const bool act = w < 4;
    LAS float* qdec = (LAS float*)(lds + SC_VEC);
    const int stride = bid < 128 ? 1000000 : (G - 128);
    for (int item = bid; item < 640; item += stride) {
      const int ci = item >> 1, half = item & 1;
      int lane_c = lane_id(); asm volatile("" : "+v"(lane_c));
      const int lane = lane_c, tid = (wave << 6) | lane, r32 = lane & 31, hl = lane >> 5;
      int type, sq, h, dir, chunk0, nsteps; bool lat;
      if (ci < 64) { lat = true; type = ci >> 5; sq = (ci >> 3) & 3; h = (ci >> 1) & 3; dir = ci & 1; chunk0 = 64 + 32 * sq; nsteps = 32; }
      else { const int c = ci - 64; lat = false; type = c >> 7; sq = (c >> 3) & 15; h = (c >> 1) & 3; dir = c & 1; chunk0 = 4 * sq; nsteps = 4; }
      f32x16 S[4];
      {
        const float* s0 = (type ? p.in[I_SDN] : p.in[I_SRET]) + ((((size_t)sq * 2 + dir) * NH + h) * DK) * DV + 128 * half + cb + r32;
        if (lat) {
#pragma unroll
          for (int mt = 0; mt < 4; ++mt)
#pragma unroll
            for (int reg = 0; reg < 16; ++reg) S[mt][reg] = s0[(size_t)(32 * mt + srow(reg, hl)) * DV];
        } else {
#pragma unroll
          for (int mt = 0; mt < 4; ++mt) S[mt] = zero16();
        }
      }
      const float lg = DECLG[dir * 4 + h];
      const float c64 = __expf(64.f * lg);
      __syncthreads();
      if (tid < 64) qdec[tid] = __expf(lg * (dir ? (float)(64 - tid) : (float)(tid + 1)));
      const StageOff soff = scan_stage_offsets(w, lane, (!type && dir) ? 1024u : (unsigned)(LDQ * 2));
      scan_stage(lds, 0, type, dir, h, chunk0 + (dir ? nsteps - 1 : 0), QKV, KBUF, MATS_RT, MATS_DN, half, w, soff);
      bf16_t* O = type ? (dir ? ODB : ODF) : (dir ? ORB : ORF);
      for (int s = 0; s < nsteps; ++s) {
        int ln = lane; asm volatile("" : "+v"(ln));
        const int r32s = ln & 31, hls = ln >> 5;
        const int buf = s & 1, gc = chunk0 + (dir ? nsteps - 1 - s : s);
        asm volatile("s_waitcnt vmcnt(0)" ::: "memory");
        __syncthreads();
        if (s + 1 < nsteps) scan_stage(lds, buf ^ 1, type, dir, h, chunk0 + (dir ? nsteps - 2 - s : s + 1), QKV, KBUF, MATS_RT, MATS_DN, half, w, soff);
        if (!act) continue;
        LAS unsigned char* B = lds + buf * SC_BUF;
        bf16_t* ob = O + (size_t)gc * 64 * D + h * DV + 128 * half + cb + r32s;
#define SB_ do { __builtin_amdgcn_sched_barrier(0); asm volatile("" : "+v"(ln)); } while (0)
#define STORE_O(acc) do { _Pragma("unroll") for (int mt_ = 0; mt_ < 2; ++mt_) _Pragma("unroll") for (int s2_ = 0; s2_ < 2; ++s2_) { const bf16x8 pk_ = pack8(acc[mt_], s2_); \
                          _Pragma("unroll") for (int j_ = 0; j_ < 8; ++j_) ob[(size_t)(32 * mt_ + crow(8 * s2_ + j_, ln >> 5)) * D] = (bf16_t)pk_[j_]; } } while (0)
#define LOAD_BV() do { _Pragma("unroll") for (int ks_ = 0; ks_ < 4; ++ks_) Bv[ks_] = lds_tr2(B + SC_V, vtr_off(ln, cb, ks_, 0), vtr_off(ln, cb, ks_, 1)); } while (0)
#define ROWS_AB(acc, IMG) do { bf16x8 f0_[2], f1_[2]; \
            f0_[0] = lds_rd128(B + (IMG), rowfrag_off(ln, 0, 0)); f0_[1] = lds_rd128(B + (IMG), rowfrag_off(ln, 1, 0)); \
            _Pragma("unroll") for (int ks_ = 0; ks_ < 8; ++ks_) { \
              if (ks_ + 1 < 8) { f1_[0] = lds_rd128(B + (IMG), rowfrag_off(ln, 0, ks_ + 1)); f1_[1] = lds_rd128(B + (IMG), rowfrag_off(ln, 1, ks_ + 1)); } \
              const bf16x8 sb_ = pack8(S[ks_ >> 1], ks_ & 1); \
              acc[0] = MFMA32(f0_[0], sb_, acc[0]); acc[1] = MFMA32(f0_[1], sb_, acc[1]); \
              f0_[0] = f1_[0]; f0_[1] = f1_[1]; } } while (0)
#define ROWS_T(acc, IMG) do { bf16x8 f0_[2], f1_[2];   \
            f0_[0] = lds_rd128(B + (IMG), rowfrag_off(ln, 0, 0)); f0_[1] = lds_rd128(B + (IMG), rowfrag_off(ln, 1, 0)); \
            _Pragma("unroll") for (int ks_ = 0; ks_ < 8; ++ks_) { \
              if (ks_ + 1 < 8) { f1_[0] = lds_rd128(B + (IMG), rowfrag_off(ln, 0, ks_ + 1)); f1_[1] = lds_rd128(B + (IMG), rowfrag_off(ln, 1, ks_ + 1)); } \
              __builtin_amdgcn_sched_barrier(0);             \
              const bf16x8 sb_ = pack8(S[ks_ >> 1], ks_ & 1); \
              acc[0] = MFMA32(sb_, f0_[0], acc[0]); acc[1] = MFMA32(sb_, f0_[1], acc[1]); \
              __builtin_amdgcn_sched_barrier(0); \
              f0_[0] = f1_[0]; f0_[1] = f1_[1]; } } while (0)
#define STORE_OT(acc) do { _Pragma("unroll") for (int nt_ = 0; nt_ < 2; ++nt_) { bf16_t* orow_ = obt + (size_t)(32 * nt_) * D; \
            _Pragma("unroll") for (int g_ = 0; g_ < 4; ++g_) { u32x2 w_; w_.x = pk2(acc[nt_][4 * g_], acc[nt_][4 * g_ + 1]); w_.y = pk2(acc[nt_][4 * g_ + 2], acc[nt_][4 * g_ + 3]); \
              *(u32x2*)(orow_ + 8 * g_) = w_; } } } while (0)
#define S_UPDATE(X, SCL) do { bf16x8 g0_[4], g1_[4]; \
            _Pragma("unroll") for (int mt_ = 0; mt_ < 4; ++mt_) g0_[mt_] = lds_tr2(B + SC_K, ktr_off(ln, mt_, 0, 0), ktr_off(ln, mt_, 0, 1)); \
            _Pragma("unroll") for (int mt_ = 0; mt_ < 4; ++mt_) S[mt_] = S[mt_] * (SCL); \
            _Pragma("unroll") for (int ks_ = 0; ks_ < 4; ++ks_) { \
              if (ks_ + 1 < 4) { _Pragma("unroll") for (int mt_ = 0; mt_ < 4; ++mt_) g1_[mt_] = lds_tr2(B + SC_K, ktr_off(ln, mt_, ks_ + 1, 0), ktr_off(ln, mt_, ks_ + 1, 1)); } \
              _Pragma("unroll") for (int mt_ = 0; mt_ < 4; ++mt_) S[mt_] = MFMA32(g0_[mt_], X[ks_], S[mt_]); \
              _Pragma("unroll") for (int mt_ = 0; mt_ < 4; ++mt_) g0_[mt_] = g1_[mt_]; } } while (0)
        bf16x8 Bv[4];
        if (type) {
          const LAS float* eg = (const LAS float*)(B + SC_M + 16384); const LAS float* cgv = eg + 64; const float egl = eg[128];
          bf16x8 Br[4];
          f32x4 egv[2][4];
#pragma unroll
          for (int mt = 0; mt < 2; ++mt)
#pragma unroll
            for (int g4 = 0; g4 < 4; ++g4) egv[mt][g4] = *(const LAS f32x4*)(eg + 32 * mt + 8 * g4 + 4 * (ln >> 5));
          __builtin_amdgcn_sched_barrier(0);
          { f32x16 ra[2]; ra[0] = zero16(); ra[1] = zero16();
            ROWS_AB(ra, SC_K);
#pragma unroll
            for (int mt = 0; mt < 2; ++mt) { rowscale_pre(ra[mt], egv[mt], -1.f); Br[2 * mt] = pack8(ra[mt], 0); Br[2 * mt + 1] = pack8(ra[mt], 1); } }
          SB_;
          LOAD_BV();
          bf16x8 tf[8];
#pragma unroll
          for (int i = 0; i < 8; ++i) tf[i] = lds_rd128(B + SC_M, i * 1024 + ln * 16);
          f32x4 cgq[2][4];
#pragma unroll
          for (int mt = 0; mt < 2; ++mt)
#pragma unroll
            for (int g4 = 0; g4 < 4; ++g4) cgq[mt][g4] = *(const LAS f32x4*)(cgv + 32 * mt + 8 * g4 + 4 * (ln >> 5));
          __builtin_amdgcn_sched_barrier(0);
          f32x16 vn[2]; vn[0] = zero16(); vn[1] = zero16();
#pragma unroll
          for (int ks = 0; ks < 4; ++ks)
#pragma unroll
            for (int mt = 0; mt < 2; ++mt) { vn[mt] = MFMA32(tf[mt * 4 + ks], Bv[ks], vn[mt]); vn[mt] = MFMA32(tf[mt * 4 + ks], Br[ks], vn[mt]); }
          SB_;
          bf16x8 Bn[4], Bc[4];
#pragma unroll
          for (int mt = 0; mt < 2; ++mt) { Bn[2 * mt] = pack8(vn[mt], 0); Bn[2 * mt + 1] = pack8(vn[mt], 1); rowscale_pre(vn[mt], cgq[mt], 1.f); Bc[2 * mt] = pack8(vn[mt], 0); Bc[2 * mt + 1] = pack8(vn[mt], 1); }
          SB_;
          f32x16 oa[2]; oa[0] = zero16(); oa[1] = zero16();
          ROWS_T(oa, SC_Q);
          SB_;
#pragma unroll
          for (int i = 0; i < 8; ++i) tf[i] = lds_rd128(B + SC_M, 8192 + i * 1024 + ln * 16);
          const float ego0 = eg[ln & 31], ego1 = eg[32 + (ln & 31)];
          __builtin_amdgcn_sched_barrier(0);
          oa[0] = oa[0] * ego0; oa[1] = oa[1] * ego1;
#pragma unroll
          for (int ks = 0; ks < 4; ++ks)
#pragma unroll
            for (int nt = 0; nt < 2; ++nt) oa[nt] = MFMA32(Bn[ks], tf[nt * 4 + ks], oa[nt]);
          SB_;
          { bf16_t* obt = O + ((size_t)gc * 64 + (ln & 31)) * D + h * DV + 128 * half + cb + 4 * (ln >> 5); STORE_OT(oa); }
          SB_;
          S_UPDATE(Bc, egl);
          SB_;
        } else {
          f32x16 oa[2]; oa[0] = zero16(); oa[1] = zero16();
          ROWS_T(oa, SC_Q);
          SB_;
          LOAD_BV();
          bf16x8 tf[8];
#pragma unroll
          for (int i = 0; i < 8; ++i) tf[i] = lds_rd128(B + SC_M, i * 1024 + ln * 16);
          const float qd0 = qdec[ln & 31], qd1 = qdec[32 + (ln & 31)];
          __builtin_amdgcn_sched_barrier(0);
          oa[0] = oa[0] * qd0; oa[1] = oa[1] * qd1;
#pragma unroll
          for (int ks = 0; ks < 4; ++ks)
#pragma unroll
            for (int nt = 0; nt < 2; ++nt) oa[nt] = MFMA32(Bv[ks], tf[nt * 4 + ks], oa[nt]);
          SB_;
          { bf16_t* obt = O + ((size_t)gc * 64 + (ln & 31)) * D + h * DV + 128 * half + cb + 4 * (ln >> 5); STORE_OT(oa); }
          SB_;
          S_UPDATE(Bv, c64);
          SB_;
        }
#undef SB_
#undef STORE_O
#undef LOAD_BV
#undef ROWS_AB
#undef ROWS_T
#undef STORE_OT
#undef S_UPDATE
      }
      if (!lat && act) {
        int ln3 = lane_id(); asm volatile("" : "+v"(ln3)); const int hl3 = ln3 >> 5;
        float* so = (type ? NS_DN : NS_RET) + ((((size_t)sq * 2 + dir) * NH + h) * DK) * DV + 128 * half + cb + (ln3 & 31);
#pragma unroll
        for (int mt = 0; mt < 4; ++mt)
#pragma unroll
          for (int reg = 0; reg < 16; ++reg) so[(size_t)(32 * mt + srow(reg, hl3)) * DV] = S[mt][reg];
      }
    }
    if (G > 128 && bid >= 128) {
      asm volatile("s_waitcnt vmcnt(0)" ::: "memory");
      __syncthreads();
      int lane_c = lane_id(); asm volatile("" : "+v"(lane_c));
      late_weight_conversions(p, WGATE, WRO, WDO, WOUT, (bf16_t*)(ws + WS_WF1), (bf16_t*)(ws + WS_WF2), (LAS float*)(lds + wave * 16384), (bid - 128) * NWAVES + wave, (G - 128) * NWAVES, lane_c);
    }
  }
  GRID_BARRIER();

  bf16_t* GATES = QKV;
  {
    pg8::Gemm g{HB, WGATE, MTOT, 4096, D}; pg8::StaticOrder S; S.init(MTOT, 4096, G, bid);
    pg8::EpiBf16Act<1> E{GATES, LDG};
    pg8::gemm_phase<pg8::EpiBf16Act<1>, pg8::StaticOrder, true, true>(lds, g, S, E, wave);
  }
  GRID_BARRIER();

  bf16_t* AR = (bf16_t*)(ws + WS_AR); bf16_t* AD = (bf16_t*)(ws + WS_AD);
  {
    PHASE_TID();
    for (int m = gw; m < MTOT; m += ngw) {
      u32x2 rf[4], rb[4], df[4], db[4], gr[4], gd[4]; f32x4 gw4[4];
#pragma unroll
      for (int h = 0; h < 4; ++h) { const size_t base = (size_t)m * D + h * DV + 4 * lane;
        rf[h] = __builtin_nontemporal_load((const u32x2*)(ORF + base)); rb[h] = __builtin_nontemporal_load((const u32x2*)(ORB + base)); df[h] = __builtin_nontemporal_load((const u32x2*)(ODF + base)); db[h] = __builtin_nontemporal_load((const u32x2*)(ODB + base));
        gr[h] = __builtin_nontemporal_load((const u32x2*)(GATES + (size_t)m * LDG + G_RG + h * DV + 4 * lane)); gd[h] = __builtin_nontemporal_load((const u32x2*)(GATES + (size_t)m * LDG + G_DZ + h * DV + 4 * lane));
        gw4[h] = *(const f32x4*)(p.in[I_GNW] + h * DV + 4 * lane); }
      const f32x4 dw4 = *(const f32x4*)(p.in[I_DNW] + 4 * lane);
      float v[4][4], u[4][4], mu[4], rs[4], rd[4];
#pragma unroll
      for (int h = 0; h < 4; ++h) { v[h][0] = lo_bf(rf[h].x) + lo_bf(rb[h].x); v[h][1] = hi_bf(rf[h].x) + hi_bf(rb[h].x); v[h][2] = lo_bf(rf[h].y) + lo_bf(rb[h].y); v[h][3] = hi_bf(rf[h].y) + hi_bf(rb[h].y);
        u[h][0] = lo_bf(df[h].x) + lo_bf(db[h].x); u[h][1] = hi_bf(df[h].x) + hi_bf(db[h].x); u[h][2] = lo_bf(df[h].y) + lo_bf(db[h].y); u[h][3] = hi_bf(df[h].y) + hi_bf(db[h].y);
        mu[h] = (v[h][0] + v[h][1]) + (v[h][2] + v[h][3]); rd[h] = (u[h][0] * u[h][0] + u[h][1] * u[h][1]) + (u[h][2] * u[h][2] + u[h][3] * u[h][3]); }
#pragma unroll
      for (int o = 1; o < 64; o <<= 1) {
#pragma unroll
        for (int h = 0; h < 4; ++h) { mu[h] += __shfl_xor(mu[h], o); rd[h] += __shfl_xor(rd[h], o); } }
#pragma unroll
      for (int h = 0; h < 4; ++h) { mu[h] *= (1.f / DV); float q = 0.f;
#pragma unroll
        for (int e = 0; e < 4; ++e) { v[h][e] -= mu[h]; q += v[h][e] * v[h][e]; }
        rs[h] = q; }
#pragma unroll
      for (int o = 1; o < 64; o <<= 1) {
#pragma unroll
        for (int h = 0; h < 4; ++h) rs[h] += __shfl_xor(rs[h], o); }
#pragma unroll
      for (int h = 0; h < 4; ++h) { const size_t base = (size_t)m * D + h * DV + 4 * lane;
        const float r1 = rsqrtf(rs[h] * (1.f / DV) + EPS), r2 = rsqrtf(rd[h] * (1.f / DV) + EPS);
        u32x2 o; o.x = pk2(lo_bf(gr[h].x) * (v[h][0] * r1 * gw4[h].x), hi_bf(gr[h].x) * (v[h][1] * r1 * gw4[h].y)); o.y = pk2(lo_bf(gr[h].y) * (v[h][2] * r1 * gw4[h].z), hi_bf(gr[h].y) * (v[h][3] * r1 * gw4[h].w));
        *(u32x2*)(AR + base) = o;
        o.x = pk2(u[h][0] * r2 * dw4.x * lo_bf(gd[h].x), u[h][1] * r2 * dw4.y * hi_bf(gd[h].x)); o.y = pk2(u[h][2] * r2 * dw4.z * lo_bf(gd[h].y), u[h][3] * r2 * dw4.w * hi_bf(gd[h].y));
        *(u32x2*)(AD + base) = o; }
    }
  }
  GRID_BARRIER();

  bf16_t* T1 = HB;
  {
    pg8::Gemm g{AR, WRO, MTOT, D, D}; pg8::StaticOrder S; S.init(MTOT, D, G, bid);
    pg8::EpiGateMul E{T1, D, GATES + G_GR, LDG, nullptr};
    pg8::gemm_phase<pg8::EpiGateMul, pg8::StaticOrder, true, true>(lds, g, S, E, wave);
  }
  bf16_t* MERGED = T1;
  {
    pg8::Gemm g{AD, WDO, MTOT, D, D}; pg8::StaticOrder S; S.init(MTOT, D, G, bid);
    pg8::EpiGateMul E{MERGED, D, GATES + G_GD, LDG, T1};
    pg8::gemm_phase<pg8::EpiGateMul, pg8::StaticOrder, true, true>(lds, g, S, E, wave);
  }
  GRID_BARRIER();
  bf16_t* M1 = (bf16_t*)(ws + WS_O);
  bf16_t* X1B = (bf16_t*)(ws + WS_O + 24 * MiB);
  {
    pg8::Gemm g{MERGED, WOUT, MTOT, D, D}; pg8::StaticOrder S; S.init(MTOT, D, G, bid);
    pg8::EpiBf16Act<0> E{M1, D};
    pg8::gemm_phase<pg8::EpiBf16Act<0>, pg8::StaticOrder, true, true>(lds, g, S, E, wave);
  }
  GRID_BARRIER();

  bf16_t* WF1 = (bf16_t*)(ws + WS_WF1); bf16_t* WF2 = (bf16_t*)(ws + WS_WF2);
  {
    PHASE_TID();
    LAS float* scr = (LAS float*)(lds + wave * 16384);
    const float* nw1 = p.in[I_NORMW] + D; const float* nw2 = p.in[I_NORMW] + 2 * D;
    f32x4 nw1v[4], nw2v[4];
#pragma unroll
    for (int j = 0; j < 4; ++j) { nw1v[j] = *(const f32x4*)(nw1 + 4 * lane + 256 * j); nw2v[j] = *(const f32x4*)(nw2 + 4 * lane + 256 * j); }
    u32x2 mn[2][4]; f32x4 xn[2][4];
#define P7_LOAD(M0) do { _Pragma("unroll") for (int u = 0; u < 2; ++u) { const int m_ = ((M0) + u * ngw < MTOT) ? (M0) + u * ngw : gw; const float* xr_ = xrow(p, m_); const bf16_t* mr_ = M1 + (size_t)m_ * D; \
      _Pragma("unroll") for (int j = 0; j < 4; ++j) { const int c0 = 4 * lane + 256 * j; mn[u][j] = __builtin_nontemporal_load((const u32x2*)(mr_ + c0)); xn[u][j] = __builtin_nontemporal_load((const f32x4*)(xr_ + c0)); } } } while (0)
    P7_LOAD(gw);
    for (int m0 = gw; m0 < MTOT; m0 += 2 * ngw) {
      f32x4 v[2][4], xv[2][4], g1v[2][4]; float s[2] = {0.f, 0.f};
#pragma unroll
      for (int u = 0; u < 2; ++u)
#pragma unroll
        for (int j = 0; j < 4; ++j) { const u32x2 mw = mn[u][j]; v[u][j] = (f32x4){lo_bf(mw.x), hi_bf(mw.x), lo_bf(mw.y), hi_bf(mw.y)}; xv[u][j] = xn[u][j]; }
#pragma unroll
      for (int u = 0; u < 2; ++u) { const int m = (m0 + u * ngw < MTOT) ? m0 + u * ngw : m0; const float* md = MOD + (size_t)cond_of_row(m) * 6 * D;
#pragma unroll
        for (int j = 0; j < 4; ++j) { const int c0 = 4 * lane + 256 * j; g1v[u][j] = *(const f32x4*)(md + 2 * D + c0); } }
      __builtin_amdgcn_sched_barrier(0);
      P7_LOAD(m0 + 2 * ngw);
      __builtin_amdgcn_sched_barrier(0);
#pragma unroll
      for (int u = 0; u < 2; ++u)
#pragma unroll
        for (int j = 0; j < 4; ++j) s[u] += (v[u][j].x * v[u][j].x + v[u][j].y * v[u][j].y) + (v[u][j].z * v[u][j].z + v[u][j].w * v[u][j].w);
#pragma unroll
      for (int o = 1; o < 64; o <<= 1) { s[0] += __shfl_xor(s[0], o); s[1] += __shfl_xor(s[1], o); }
      float s2[2] = {0.f, 0.f};
#pragma unroll
      for (int u = 0; u < 2; ++u) { const int m = m0 + u * ngw; const float r = rsqrtf(s[u] * (1.f / D) + EPS);
#pragma unroll
        for (int j = 0; j < 4; ++j) { const int c0 = 4 * lane + 256 * j;
          v[u][j] = xv[u][j] + g1v[u][j] * (v[u][j] * r * nw1v[j]);
          if (m < MTOT) { u32x2 xo; xo.x = pk2(v[u][j].x, v[u][j].y); xo.y = pk2(v[u][j].z, v[u][j].w); *(u32x2*)(X1B + (size_t)m * D + c0) = xo; }
          s2[u] += (v[u][j].x * v[u][j].x + v[u][j].y * v[u][j].y) + (v[u][j].z * v[u][j].z + v[u][j].w * v[u][j].w); } }
#pragma unroll
      for (int o = 1; o < 64; o <<= 1) { s2[0] += __shfl_xor(s2[0], o); s2[1] += __shfl_xor(s2[1], o); }
#pragma unroll
      for (int u = 0; u < 2; ++u) { const int m = m0 + u * ngw; if (m >= MTOT) continue; const float* md = MOD + (size_t)cond_of_row(m) * 6 * D; const float r2 = rsqrtf(s2[u] * (1.f / D) + EPS);
#pragma unroll
        for (int j = 0; j < 4; ++j) { const int c0 = 4 * lane + 256 * j;
          const f32x4 h = v[u][j] * r2 * nw2v[j] * (*(const f32x4*)(md + 4 * D + c0) + 1.f) + *(const f32x4*)(md + 3 * D + c0);
          u32x2 o; o.x = pk2(h.x, h.y); o.y = pk2(h.z, h.w); *(u32x2*)(HB + (size_t)m * D + c0) = o; } }
    }
  }
#undef P7_LOAD
  GRID_BARRIER();

  bf16_t* ACT = QKV;
  const bool TAIL_SPLIT = G >= 228;
  constexpr int MT_MAIN = 46, M_MAIN = MT_MAIN * 256;
  {
    const int M8 = TAIL_SPLIT ? M_MAIN : MTOT;
    pg8::Gemm g{HB, WF1, M8, 2 * DFF, D}; pg8::StaticOrder S; S.init(M8, 2 * DFF, G, bid);
    pg8::EpiSwiGLU E{ACT, DFF};
    pg8::gemm_phase<pg8::EpiSwiGLU, pg8::StaticOrder, true, true>(lds, g, S, E, wave);
  }
  GRID_BARRIER();
  bf16_t* F = (bf16_t*)(ws + WS_O); bf16_t* F1 = (bf16_t*)(ws + WS_F1);
  if (!TAIL_SPLIT || bid < MT_MAIN * 4) {
    const int M9 = TAIL_SPLIT ? M_MAIN : MTOT;
    pg8::Gemm g{ACT, WF2, M9, D, DFF}; pg8::StaticOrder S; S.init(M9, D, G, bid);
    pg8::EpiBf16Act<0> E{F, D};
    pg8::gemm_phase<pg8::EpiBf16Act<0>, pg8::StaticOrder, true, true>(lds, g, S, E, wave);
  } else if (bid < MT_MAIN * 4 + 44) {
    const int j = bid - MT_MAIN * 4;
    {
      pg8::Gemm g{HB, WF1, MTOT, 2 * DFF, D}; pg8::OneUnit S{MT_MAIN + j / 22, j % 22};
      pg8::EpiSwiGLU E{ACT, DFF};
      pg8::gemm_phase<pg8::EpiSwiGLU, pg8::OneUnit, true, true>(lds, g, S, E, wave);
    }
    asm volatile("s_waitcnt vmcnt(0)" ::: "memory");
    __syncthreads();
    if (wave == 0 && lane_id() == 0) {
      unsigned* cnt = (unsigned*)(p.ws + WS_BAR + 14336);
      __builtin_amdgcn_fence(__ATOMIC_RELEASE, "agent");
      asm volatile("s_waitcnt vmcnt(0)" ::: "memory");
      __hip_atomic_fetch_add(cnt, 1u, __ATOMIC_RELAXED, __HIP_MEMORY_SCOPE_AGENT);
      if (j < 24) {
        unsigned sp = 0;
        while (__hip_atomic_load(cnt, __ATOMIC_RELAXED, __HIP_MEMORY_SCOPE_AGENT) < 44u) { __builtin_amdgcn_s_sleep(2); if (++sp > (1u << 22)) break; }
        __builtin_amdgcn_fence(__ATOMIC_ACQUIRE, "agent");
        asm volatile("s_waitcnt vmcnt(0)" ::: "memory");
      }
    }
    __syncthreads();
    if (j < 24) {
      const int un = j / 3, kp = j % 3, k0 = kp == 0 ? 0 : (kp == 1 ? 1024 : 1920), kl = kp == 0 ? 1024 : 896;
      pg8::Gemm g{ACT + k0, WF2 + k0, MTOT, D, kl, DFF}; pg8::OneUnit S{MT_MAIN + (un >> 2), un & 3};
      pg8::EpiBf16Act<0> E{kp ? F1 + (size_t)(kp - 1) * 512 * D - (size_t)M_MAIN * D : F, D};
      pg8::gemm_phase<pg8::EpiBf16Act<0>, pg8::OneUnit, true, true>(lds, g, S, E, wave);
    }
  }
  GRID_BARRIER();
  {
    PHASE_TID();
    const float* nw3 = p.in[I_NORMW] + 3 * D;
    f32x4 nw3v[4];
#pragma unroll
    for (int j = 0; j < 4; ++j) nw3v[j] = *(const f32x4*)(nw3 + 4 * lane + 256 * j);
    u32x2 fn[2][4], xn[2][4];
#define P10_LOAD(M0) do { _Pragma("unroll") for (int u = 0; u < 2; ++u) { const int m_ = ((M0) + u * ngw < MTOT) ? (M0) + u * ngw : gw; const bf16_t* fr_ = F + (size_t)m_ * D; const bf16_t* xr_ = X1B + (size_t)m_ * D; \
      _Pragma("unroll") for (int j = 0; j < 4; ++j) { const int c0 = 4 * lane + 256 * j; fn[u][j] = __builtin_nontemporal_load((const u32x2*)(fr_ + c0)); xn[u][j] = __builtin_nontemporal_load((const u32x2*)(xr_ + c0)); } } } while (0)
    P10_LOAD(gw);
    for (int m0 = gw; m0 < MTOT; m0 += 2 * ngw) {
      f32x4 v[2][4], xv[2][4], gv[2][4]; float s[2] = {0.f, 0.f};
#pragma unroll
      for (int u = 0; u < 2; ++u)
#pragma unroll
        for (int j = 0; j < 4; ++j) { const u32x2 fw = fn[u][j], xw = xn[u][j]; v[u][j] = (f32x4){lo_bf(fw.x), hi_bf(fw.x), lo_bf(fw.y), hi_bf(fw.y)}; xv[u][j] = (f32x4){lo_bf(xw.x), hi_bf(xw.x), lo_bf(xw.y), hi_bf(xw.y)}; }
#pragma unroll
      for (int u = 0; u < 2; ++u) { const int m = (m0 + u * ngw < MTOT) ? m0 + u * ngw : m0; const float* md = MOD + (size_t)cond_of_row(m) * 6 * D;
#pragma unroll
        for (int j = 0; j < 4; ++j) gv[u][j] = *(const f32x4*)(md + 5 * D + 4 * lane + 256 * j); }
      __builtin_amdgcn_sched_barrier(0);
      P10_LOAD(m0 + 2 * ngw);
      __builtin_amdgcn_sched_barrier(0);
#pragma unroll
      for (int u = 0; u < 2; ++u) { const int m = (m0 + u * ngw < MTOT) ? m0 + u * ngw : m0; const bf16_t* f1r = (TAIL_SPLIT && m >= M_MAIN) ? F1 + (size_t)(m - M_MAIN) * D : nullptr;
#pragma unroll
        for (int j = 0; j < 4; ++j) { const int c0 = 4 * lane + 256 * j;
          if (f1r) { const u32x2 gw2 = *(const u32x2*)(f1r + c0), gw3 = *(const u32x2*)(f1r + 512 * D + c0); v[u][j] += (f32x4){lo_bf(gw2.x), hi_bf(gw2.x), lo_bf(gw2.y), hi_bf(gw2.y)} + (f32x4){lo_bf(gw3.x), hi_bf(gw3.x), lo_bf(gw3.y), hi_bf(gw3.y)}; } } }
#pragma unroll
      for (int u = 0; u < 2; ++u)
#pragma unroll
        for (int j = 0; j < 4; ++j) s[u] += (v[u][j].x * v[u][j].x + v[u][j].y * v[u][j].y) + (v[u][j].z * v[u][j].z + v[u][j].w * v[u][j].w);
#pragma unroll
      for (int o = 1; o < 64; o <<= 1) { s[0] += __shfl_xor(s[0], o); s[1] += __shfl_xor(s[1], o); }
#pragma unroll
      for (int u = 0; u < 2; ++u) { const int m = m0 + u * ngw; if (m >= MTOT) continue; const float r = rsqrtf(s[u] * (1.f / D) + EPS); float* orow = p.out + (size_t)m * D;
#pragma unroll
        for (int j = 0; j < 4; ++j) { const int c0 = 4 * lane + 256 * j; __builtin_nontemporal_store(xv[u][j] + gv[u][j] * (v[u][j] * r * nw3v[j]), (f32x4*)(orow + c0)); } }
    }
#undef P10_LOAD
  }
}

extern "C" void kernel_launch(void* const* d_in, const int* in_sizes, int n_in, void* d_out, int out_size, void* d_ws, size_t ws_size, hipStream_t stream) {
  static int grid_blocks = 0;
  if (!grid_blocks) {
    int dev = 0, cus = 0, per_cu = 0;
    (void)hipGetDevice(&dev);
    (void)hipDeviceGetAttribute(&cus, hipDeviceAttributeMultiprocessorCount, dev);
    (void)hipFuncSetAttribute((const void*)fwd_megakernel, hipFuncAttributeMaxDynamicSharedMemorySize, LDS_BYTES);
    (void)hipOccupancyMaxActiveBlocksPerMultiprocessor(&per_cu, (const void*)fwd_megakernel, NTHREADS, LDS_BYTES);
    if (per_cu < 1) per_cu = 1;
    grid_blocks = cus * per_cu;
    if (n_in != 21 || ws_size < WS_END) fprintf(stderr, "kernel_launch: unexpected n_in %d / ws_size %zu\n", n_in, ws_size);
    fprintf(stderr, "kernel_launch: cus %d per_cu %d grid %d ws %zu out %d\n", cus, per_cu, grid_blocks, ws_size, out_size);
  }
  (void)hipMemsetAsync((unsigned char*)d_ws + WS_BAR, 0, 16384, stream);
  Params p{};
  for (int i = 0; i < 21; ++i) p.in[i] = (const float*)d_in[i];
  p.out = (float*)d_out; p.ws = (unsigned char*)d_ws;
  void* args[] = {&p};
  hipError_t e = hipLaunchCooperativeKernel((const void*)fwd_megakernel, dim3(grid_blocks), dim3(NTHREADS), args, LDS_BYTES, stream);
  if (e != hipSuccess) fprintf(stderr, "cooperative launch failed: %s (grid %d)\n", hipGetErrorString(e), grid_blocks);
}
```
